# Optimizing an MI355X kernel written in HIP

```python
import jax, jax.numpy as jnp
from jax import lax
import numpy as np

D_MODEL = 1024
BATCH = 4
SEQ = 4096
DEPTH = 1

NORM_EPS = 1e-6
RW_HEADS = 8
RW_HEAD = 64
RW_WIDTH = RW_HEADS * RW_HEAD
W_LORA = 64
A_LORA = 64
G_LORA = 128
RW_COLS = 3 * RW_WIDTH + W_LORA + A_LORA + G_LORA
GN_EPS = 64e-5
NSA_HEADS = 8
NSA_KV = 2
NSA_HPG = NSA_HEADS // NSA_KV
NSA_DK = 64
NSA_WIDTH = NSA_HEADS * NSA_DK
NSA_KVW = NSA_KV * NSA_DK
CMP_LEN = 32
CMP_STRIDE = 16
CMP_HIDDEN = 256
SEL_BLOCK = 64
SEL_TOPN = 16
FORCE_BONUS = 1000.0
WINDOW = 512
Q_BLOCK = 128
PEER_HEADS = 8
PEER_KEYS = 128
PEER_EXPERTS = PEER_KEYS * PEER_KEYS
PEER_DKEY = 256
PEER_TOPK = 16
PEER_CHUNK = 128
IN_WIDTHS = (RW_COLS, NSA_WIDTH, NSA_KVW, NSA_KVW, NSA_KVW, NSA_KVW, NSA_KVW, NSA_KVW, NSA_HEADS * 3, D_MODEL, D_MODEL)
IN_TOTAL = sum(IN_WIDTHS)

kernel_name = 'hybrid_rwkv7_nsa_peer_block'


def _rmsnorm(x, g):
    xf = x.astype(jnp.float32)
    y = xf * lax.rsqrt(jnp.mean(xf * xf, axis=-1, keepdims=True) + NORM_EPS)
    return (y * g.astype(jnp.float32)).astype(x.dtype)


def _masked_softmax(s, mask):
    s = jnp.where(mask, s.astype(jnp.float32), -1e30)
    m = jnp.max(s, axis=-1, keepdims=True)
    e = jnp.where(mask, jnp.exp(s - m), 0.0)
    return e / jnp.maximum(jnp.sum(e, axis=-1, keepdims=True), 1e-30)


def _rwkv7(p, mu, w0, w_up, a0, a_up, g_up, k_k, k_a, r_k, ln_w, ln_b):
    B, T, _ = p.shape
    prev = jnp.pad(p[:, :-1], ((0, 0), (1, 0), (0, 0)))
    p = p + (prev - p) * mu
    r, k, v, wd, ad, gd = jnp.split(p, [RW_WIDTH, 2 * RW_WIDTH, 3 * RW_WIDTH, 3 * RW_WIDTH + W_LORA, 3 * RW_WIDTH + W_LORA + A_LORA], axis=-1)
    w_log = -jax.nn.softplus(-(w0 + jnp.tanh(wd) @ w_up)) - 0.5
    decay = jnp.exp(-jnp.exp(w_log.astype(jnp.float32)))
    a = jax.nn.sigmoid(a0 + ad @ a_up)
    g = jax.nn.sigmoid(gd) @ g_up
    kk = k * k_k
    k = k * (1.0 + (a - 1.0) * k_a)
    hs = lambda t: t.reshape(B, T, RW_HEADS, RW_HEAD).astype(jnp.float32)
    r, k, v, kk, a, decay = hs(r), hs(k), hs(v), hs(kk), hs(a), hs(decay)
    kk = kk / jnp.maximum(jnp.linalg.norm(kk, axis=-1, keepdims=True), 1e-12)

    def step(S, inp):
        r_t, w_t, k_t, v_t, kk_t, a_t = inp
        sa = jnp.einsum('bhvk,bhk->bhv', S, -kk_t)
        S = S * w_t[:, :, None, :] + sa[..., None] * (kk_t * a_t)[:, :, None, :] + v_t[..., None] * k_t[:, :, None, :]
        return S, jnp.einsum('bhvk,bhk->bhv', S, r_t)

    xs = tuple(jnp.moveaxis(t, 1, 0) for t in (r, decay, k, v, kk, a))
    S0 = jnp.zeros((B, RW_HEADS, RW_HEAD, RW_HEAD), jnp.float32)
    _, y = lax.scan(step, S0, xs)
    y = jnp.moveaxis(y, 0, 1)
    mean = jnp.mean(y, axis=-1, keepdims=True)
    var = jnp.var(y, axis=-1, keepdims=True)
    y = ((y - mean) * lax.rsqrt(var + GN_EPS)).reshape(B, T, RW_WIDTH) * ln_w + ln_b
    bonus = jnp.sum(r * k * r_k, axis=-1, keepdims=True) * v
    y = (y + bonus.reshape(B, T, RW_WIDTH)) * g
    return y.astype(p.dtype)


def _compress(t, pos, w1, w2):
    B, T, G, DK = t.shape
    n_c = (T - CMP_LEN) // CMP_STRIDE + 1
    idx = jnp.arange(n_c)[:, None] * CMP_STRIDE + jnp.arange(CMP_LEN)[None, :]
    blk = t[:, idx] + pos[:, None, :]
    blk = jnp.moveaxis(blk, 3, 2).reshape(B, n_c, G, CMP_LEN * DK)
    return jax.nn.gelu(blk @ w1) @ w2


def _nsa(q, k_c, v_c, k_s, v_s, k_w, v_w, gate_logits, q_g, kc_g, ks_g, kw_g, pos_k, pos_v, ck1, ck2, cv1, cv2):
    B, T, _ = q.shape
    G, HPG, DK = NSA_KV, NSA_HPG, NSA_DK
    q = (_rmsnorm(q.reshape(B, T, NSA_HEADS, DK), q_g) * (DK ** -0.5)).reshape(B, T, G, HPG, DK)
    gates = jax.nn.sigmoid(gate_logits.reshape(B, T, G, HPG, 3))
    kv = lambda t: t.reshape(B, T, G, DK)
    kc = _rmsnorm(_compress(kv(k_c), pos_k, ck1, ck2), kc_g)
    vc = _compress(kv(v_c), pos_v, cv1, cv2)
    n_c = kc.shape[1]
    n_b = T // SEL_BLOCK
    n_top = min(SEL_TOPN, n_b)
    ks = _rmsnorm(kv(k_s), ks_g).reshape(B, n_b, SEL_BLOCK, G, DK).transpose(0, 3, 1, 2, 4)
    vs = kv(v_s).reshape(B, n_b, SEL_BLOCK, G, DK).transpose(0, 3, 1, 2, 4)
    pad = ((0, 0), (WINDOW, 0), (0, 0), (0, 0))
    kw = jnp.pad(_rmsnorm(kv(k_w), kw_g), pad)
    vw = jnp.pad(kv(v_w), pad)
    cmp_start = jnp.arange(n_c) * CMP_STRIDE
    cmp_end = cmp_start + CMP_LEN - 1
    sel_start = jnp.arange(n_b) * SEL_BLOCK
    overlap = jnp.clip(jnp.minimum(cmp_start[:, None] + CMP_LEN, sel_start[None, :] + SEL_BLOCK) - jnp.maximum(cmp_start[:, None], sel_start[None, :]), 0, None)
    overlap = overlap.astype(jnp.float32) / CMP_LEN
    blk_ids = jnp.arange(n_b)
    b_idx = jnp.arange(B)[:, None, None, None]
    g_idx = jnp.arange(G)[None, :, None, None]
    m_sel = n_top * SEL_BLOCK

    def q_block(c):
        t0 = c * Q_BLOCK
        qc = lax.dynamic_slice_in_dim(q, t0, Q_BLOCK, axis=1)
        gc = lax.dynamic_slice_in_dim(gates, t0, Q_BLOCK, axis=1)
        tpos = t0 + jnp.arange(Q_BLOCK)
        s = jnp.einsum('bqghd,bngd->bgqhn', qc, kc)
        p_cmp = _masked_softmax(s, (cmp_end[None, :] <= tpos[:, None])[None, None, :, None, :])
        o_cmp = jnp.einsum('bgqhn,bngd->bqghd', p_cmp.astype(vc.dtype), vc)
        imp = jnp.einsum('bgqhn,nj->bgqj', p_cmp, overlap)
        cur = (tpos // SEL_BLOCK)[:, None]
        valid = blk_ids[None, :] <= cur
        forced = (blk_ids[None, :] == 0) | (blk_ids[None, :] == cur) | (blk_ids[None, :] == cur - 1)
        score = jnp.where(valid, imp + FORCE_BONUS * forced.astype(jnp.float32), -1.0)
        top_s, top_i = lax.top_k(score, n_top)
        k_sel = ks[b_idx, g_idx, top_i].reshape(B, G, Q_BLOCK, m_sel, DK)
        v_sel = vs[b_idx, g_idx, top_i].reshape(B, G, Q_BLOCK, m_sel, DK)
        tok = (top_i[..., None] * SEL_BLOCK + jnp.arange(SEL_BLOCK)).reshape(B, G, Q_BLOCK, m_sel)
        smask = jnp.repeat(top_s > -0.5, SEL_BLOCK, axis=-1) & (tok <= tpos[None, None, :, None])
        s = jnp.einsum('bqghd,bgqmd->bgqhm', qc, k_sel)
        p_sel = _masked_softmax(s, smask[:, :, :, None, :])
        o_sel = jnp.einsum('bgqhm,bgqmd->bqghd', p_sel.astype(v_sel.dtype), v_sel)
        kwc = lax.dynamic_slice_in_dim(kw, t0, WINDOW + Q_BLOCK, axis=1)
        vwc = lax.dynamic_slice_in_dim(vw, t0, WINDOW + Q_BLOCK, axis=1)
        kpos = t0 - WINDOW + jnp.arange(WINDOW + Q_BLOCK)
        wmask = (kpos[None, :] <= tpos[:, None]) & (kpos[None, :] > tpos[:, None] - WINDOW) & (kpos[None, :] >= 0)
        s = jnp.einsum('bqghd,bkgd->bgqhk', qc, kwc)
        p_win = _masked_softmax(s, wmask[None, None, :, None, :])
        o_win = jnp.einsum('bgqhk,bkgd->bqghd', p_win.astype(vwc.dtype), vwc)
        o = gc[..., 0:1] * o_cmp + gc[..., 1:2] * o_sel + gc[..., 2:3] * o_win
        return o.reshape(B, Q_BLOCK, NSA_WIDTH)

    out = lax.map(q_block, jnp.arange(T // Q_BLOCK))
    return jnp.moveaxis(out, 0, 1).reshape(B, T, NSA_WIDTH)


def _peer(h, wq, sub_k1, sub_k2, u_tab, v_tab):
    B, T, D = h.shape
    n_tok = B * T
    hf = h.reshape(n_tok, D)
    qry = (hf @ wq).reshape(n_tok, PEER_HEADS, 2, PEER_DKEY // 2)
    s1, i1 = lax.top_k(jnp.einsum('nhd,kd->nhk', qry[:, :, 0], sub_k1), PEER_TOPK)
    s2, i2 = lax.top_k(jnp.einsum('nhd,kd->nhk', qry[:, :, 1], sub_k2), PEER_TOPK)
    n_cand = PEER_TOPK * PEER_TOPK
    cand_s = (s1[..., :, None] + s2[..., None, :]).reshape(n_tok, PEER_HEADS, n_cand)
    cand_e = (i1[..., :, None] * PEER_KEYS + i2[..., None, :]).reshape(n_tok, PEER_HEADS, n_cand)
    best_s, best_pos = lax.top_k(cand_s, PEER_TOPK)
    expert = jnp.take_along_axis(cand_e, best_pos, axis=-1)
    gate = jax.nn.softmax(best_s.astype(jnp.float32), axis=-1).astype(h.dtype)
    n_ch = n_tok // PEER_CHUNK
    k_all = PEER_HEADS * PEER_TOPK

    def chunk(args):
        x_c, e_c, g_c = args
        act = jax.nn.gelu(jnp.einsum('cd,ced->ce', x_c, u_tab[e_c]), approximate=False)
        return jnp.einsum('ce,ced->cd', g_c * act, v_tab[e_c])

    out = lax.map(chunk, (hf.reshape(n_ch, PEER_CHUNK, D), expert.reshape(n_ch, PEER_CHUNK, k_all), gate.reshape(n_ch, PEER_CHUNK, k_all)))
    return out.reshape(B, T, D)


def _layer(x, norm1_g, w_in, rw_mu, rw_w0, rw_w_up, rw_a0, rw_a_up, rw_g_up, rw_k_k, rw_k_a, rw_r_k, rw_ln_w, rw_ln_b, nsa_q_g, nsa_kc_g, nsa_ks_g, nsa_kw_g, cmp_pos_k, cmp_pos_v, cmp_k_w1, cmp_k_w2, cmp_v_w1, cmp_v_w2, w_branch_a, w_branch_b, w_out, norm2_g, peer_wq, peer_k1, peer_k2, peer_u, peer_v):
    h = _rmsnorm(x, norm1_g)
    offs = np.cumsum(IN_WIDTHS)[:-1].tolist()
    p_rw, q, k_c, v_c, k_s, v_s, k_w, v_w, b_gate, m_gate_a, m_gate_b = jnp.split(h @ w_in, offs, axis=-1)
    y_a = _rwkv7(p_rw, rw_mu, rw_w0, rw_w_up, rw_a0, rw_a_up, rw_g_up, rw_k_k, rw_k_a, rw_r_k, rw_ln_w, rw_ln_b)
    y_b = _nsa(q, k_c, v_c, k_s, v_s, k_w, v_w, b_gate, nsa_q_g, nsa_kc_g, nsa_ks_g, nsa_kw_g, cmp_pos_k, cmp_pos_v, cmp_k_w1, cmp_k_w2, cmp_v_w1, cmp_v_w2)
    mixed = jax.nn.sigmoid(m_gate_a) * (y_a @ w_branch_a) + jax.nn.sigmoid(m_gate_b) * (y_b @ w_branch_b)
    x = x + mixed @ w_out
    return x + _peer(_rmsnorm(x, norm2_g), peer_wq, peer_k1, peer_k2, peer_u, peer_v)


def setup_inputs(seed: int = 0) -> dict:
    key = jax.random.key(seed)
    ks = iter(jax.random.split(key, 40))
    L = DEPTH
    nrm = lambda shape, scale: jax.random.normal(next(ks), shape, jnp.float32) * scale
    gain = lambda shape: 1.0 + nrm(shape, 0.02)
    uni = lambda shape, lo, hi: jax.random.uniform(next(ks), shape, jnp.float32, lo, hi)
    return {
        'x': nrm((BATCH, SEQ, D_MODEL), 1.0),
        'norm1_g': gain((L, D_MODEL)),
        'w_in': nrm((L, D_MODEL, IN_TOTAL), D_MODEL ** -0.5),
        'rw_mu': uni((L, RW_COLS), 0.0, 1.0),
        'rw_w0': uni((L, RW_WIDTH), -4.0, 1.0),
        'rw_w_up': nrm((L, W_LORA, RW_WIDTH), 0.05),
        'rw_a0': nrm((L, RW_WIDTH), 0.5),
        'rw_a_up': nrm((L, A_LORA, RW_WIDTH), A_LORA ** -0.5),
        'rw_g_up': nrm((L, G_LORA, RW_WIDTH), G_LORA ** -0.5),
        'rw_k_k': 0.85 + nrm((L, RW_WIDTH), 0.05),
        'rw_k_a': 1.0 + nrm((L, RW_WIDTH), 0.05),
        'rw_r_k': nrm((L, RW_HEADS, RW_HEAD), 0.1),
        'rw_ln_w': gain((L, RW_WIDTH)),
        'rw_ln_b': nrm((L, RW_WIDTH), 0.02),
        'nsa_q_g': gain((L, NSA_DK)),
        'nsa_kc_g': gain((L, NSA_DK)),
        'nsa_ks_g': gain((L, NSA_DK)),
        'nsa_kw_g': gain((L, NSA_DK)),
        'cmp_pos_k': nrm((L, CMP_LEN, NSA_DK), 0.5),
        'cmp_pos_v': nrm((L, CMP_LEN, NSA_DK), 0.5),
        'cmp_k_w1': nrm((L, CMP_LEN * NSA_DK, CMP_HIDDEN), (CMP_LEN * NSA_DK) ** -0.5),
        'cmp_k_w2': nrm((L, CMP_HIDDEN, NSA_DK), CMP_HIDDEN ** -0.5),
        'cmp_v_w1': nrm((L, CMP_LEN * NSA_DK, CMP_HIDDEN), (CMP_LEN * NSA_DK) ** -0.5),
        'cmp_v_w2': nrm((L, CMP_HIDDEN, NSA_DK), CMP_HIDDEN ** -0.5),
        'w_branch_a': nrm((L, RW_WIDTH, D_MODEL), RW_WIDTH ** -0.5),
        'w_branch_b': nrm((L, NSA_WIDTH, D_MODEL), NSA_WIDTH ** -0.5),
        'w_out': nrm((L, D_MODEL, D_MODEL), D_MODEL ** -0.5),
        'norm2_g': gain((L, D_MODEL)),
        'peer_wq': nrm((L, D_MODEL, PEER_HEADS * PEER_DKEY), D_MODEL ** -0.5),
        'peer_k1': nrm((L, PEER_KEYS, PEER_DKEY // 2), (PEER_DKEY // 2) ** -0.5),
        'peer_k2': nrm((L, PEER_KEYS, PEER_DKEY // 2), (PEER_DKEY // 2) ** -0.5),
        'peer_u': nrm((L, PEER_EXPERTS, D_MODEL), D_MODEL ** -0.5),
        'peer_v': nrm((L, PEER_EXPERTS, D_MODEL), D_MODEL ** -0.5),
    }


def reference(x, norm1_g, w_in, rw_mu, rw_w0, rw_w_up, rw_a0, rw_a_up, rw_g_up, rw_k_k, rw_k_a, rw_r_k, rw_ln_w, rw_ln_b, nsa_q_g, nsa_kc_g, nsa_ks_g, nsa_kw_g, cmp_pos_k, cmp_pos_v, cmp_k_w1, cmp_k_w2, cmp_v_w1, cmp_v_w2, w_branch_a, w_branch_b, w_out, norm2_g, peer_wq, peer_k1, peer_k2, peer_u, peer_v):
    for i in range(DEPTH):
        x = _layer(x, norm1_g[i], w_in[i], rw_mu[i], rw_w0[i], rw_w_up[i], rw_a0[i], rw_a_up[i], rw_g_up[i], rw_k_k[i], rw_k_a[i], rw_r_k[i], rw_ln_w[i], rw_ln_b[i], nsa_q_g[i], nsa_kc_g[i], nsa_ks_g[i], nsa_kw_g[i], cmp_pos_k[i], cmp_pos_v[i], cmp_k_w1[i], cmp_k_w2[i], cmp_v_w1[i], cmp_v_w2[i], w_branch_a[i], w_branch_b[i], w_out[i], norm2_g[i], peer_wq[i], peer_k1[i], peer_k2[i], peer_u[i], peer_v[i])
    return x
```

```cpp
#include <hip/hip_runtime.h>
#include <cstdio>
#include <cstdint>
#define MK_ONE_LAUNCH 1
namespace pg8 {
#define PG8_LAS __attribute__((address_space(3)))
typedef unsigned short bf16_t;
typedef short bf16x8 __attribute__((ext_vector_type(8)));
typedef float f32x4 __attribute__((ext_vector_type(4)));
typedef unsigned u32x4 __attribute__((ext_vector_type(4)));
constexpr int BM = 256, BK = 64, HALF = 128, HTB = HALF * BK * 2  , STAGE_BYTES = 8 * HTB, NXCD = 8, WGM = 8;

__host__ __device__ __forceinline__ int lds_byte(int r, int c) { const int st = (r >> 4) * 2 + (c >> 5), rr = r & 15, cc = c & 31, ob = rr * 64 + cc * 2; return st * 1024 + (ob ^ (((ob >> 9) & 1) << 5)); }
__host__ __device__ __forceinline__ void stage_rc(int b, int& R, int& C) { const int st = b / 1024, sb = b % 1024, swz = sb ^ (((sb >> 9) & 1) << 5); R = (st >> 1) * 16 + swz / 64; C = (st & 1) * 32 + (swz % 64) / 2; }
__host__ __device__ __forceinline__ int perm32(int rho) { const int n = rho >> 4, i = rho & 15; return 8 * (i >> 2) + 4 * n + (i & 3); }

struct Unit { int pm, pn; };
struct Gemm { const bf16_t* A; const bf16_t* Bt; int M, N, K; };

struct StaticOrder {
    int nM, nN, nwg, G, c;
    __host__ __device__ void init(int M, int N, int G_, int c_) { nM = M / BM; nN = N / BM; nwg = nM * nN; G = G_; c = c_; }
    __host__ __device__ bool next(int i, Unit& u) const {
        const long L = (long)i * G + c; if (L >= nwg) return false;
        int wgid = (int)L; { const int q = nwg / NXCD, r = nwg % NXCD, xcd = wgid % NXCD, off = wgid / NXCD; wgid = (xcd < r ? xcd * (q + 1) : r * (q + 1) + (xcd - r) * q) + off; }
        const int nig = WGM * nN, gid = wgid / nig, fm = gid * WGM, gsz = (nM - fm) < WGM ? (nM - fm) : WGM;
        u.pm = fm + ((wgid % nig) % gsz); u.pn = (wgid % nig) / gsz; return true;
    }
    __device__ __forceinline__ void a_ready(const Unit&) const {}
    __device__ __forceinline__ void done(const Unit&) const {}
};

__device__ __forceinline__ unsigned cvt_pk_bf16(float lo, float hi) { unsigned r; asm volatile("v_cvt_pk_bf16_f32 %0, %1, %2" : "=v"(r) : "v"(lo), "v"(hi)); return r; }
typedef float f32x2 __attribute__((ext_vector_type(2)));
__device__ __forceinline__ f32x2 gelu_pk(f32x2 v) {
    const f32x2 av = __builtin_elementwise_abs(v), d = av * 0.2316418882f + 1.0f;
    f32x2 t; t.x = __builtin_amdgcn_rcpf(d.x); t.y = __builtin_amdgcn_rcpf(d.y);
    f32x2 q = t * 0.5307027145f + (-0.7265760135f); q = q * t + 0.7107068705f; q = q * t + (-0.142248368f); q = q * t + 0.127414796f; q = q * t;
    const f32x2 s = (v * v) * (-0.72134752044f);
    f32x2 e; e.x = __builtin_amdgcn_exp2f(s.x); e.y = __builtin_amdgcn_exp2f(s.y);
    const f32x2 m = v * (q * e), r = v - m;
    f32x2 o; o.x = v.x < 0.f ? m.x : r.x; o.y = v.y < 0.f ? m.y : r.y; return o;
}

template <int ACT  > struct EpiBf16 {
    static constexpr bool PERM = true, AFTER_DRAIN = false; static_assert(ACT == 0 || ACT == 1, "EpiBf16: ACT is 0 (none) or 1 (gelu_pk)");
    bf16_t* O; int ldc; const float* bias; int split_cols; size_t split_stride; float scale0;
    __device__ __forceinline__ void operator()(const f32x4 (&acc)[2][2][4][2], const Unit& u, int wr, int wc, int fr, int fq) const {
        const int row0 = u.pm * BM + wr * 64 + fr; int colt = u.pn * BM; bf16_t* base = O;
        float sc = 1.f; if (split_cols) { const int t = colt / split_cols; base += (size_t)t * split_stride; colt -= t * split_cols; if (t == 0) sc = scale0; }
        const int col0 = colt + wc * 32 + 8 * fq, bcol0 = u.pn * BM + wc * 32 + 8 * fq;
        f32x4 bv[2][2];
#pragma unroll
        for (int bj = 0; bj < 2; ++bj)
#pragma unroll
            for (int n = 0; n < 2; ++n) bv[bj][n] = bias ? *(const f32x4*)(bias + bcol0 + bj * HALF + 4 * n) : (f32x4){0.f, 0.f, 0.f, 0.f};
#pragma unroll
        for (int ai = 0; ai < 2; ++ai)
#pragma unroll
            for (int m = 0; m < 4; ++m) { bf16_t* rowp = base + (size_t)(row0 + ai * HALF + m * 16) * ldc + col0;
#pragma unroll
                for (int bj = 0; bj < 2; ++bj) { f32x4 v0 = acc[ai][bj][m][0] + bv[bj][0], v1 = acc[ai][bj][m][1] + bv[bj][1];
                    if (ACT == 1) { f32x2 a = gelu_pk((f32x2){v0[0], v0[1]}), b = gelu_pk((f32x2){v0[2], v0[3]}), c = gelu_pk((f32x2){v1[0], v1[1]}), d = gelu_pk((f32x2){v1[2], v1[3]});
                        v0 = (f32x4){a.x, a.y, b.x, b.y}; v1 = (f32x4){c.x, c.y, d.x, d.y}; }
                    v0 = v0 * sc; v1 = v1 * sc; u32x4 w; w.x = cvt_pk_bf16(v0[0], v0[1]); w.y = cvt_pk_bf16(v0[2], v0[3]); w.z = cvt_pk_bf16(v1[0], v1[1]); w.w = cvt_pk_bf16(v1[2], v1[3]);
                    *(u32x4*)(rowp + bj * HALF) = w; } }
    }
};
__device__ __forceinline__ float bf_lo(unsigned w) { return __uint_as_float(w << 16); }
__device__ __forceinline__ float bf_hi(unsigned w) { return __uint_as_float(w & 0xffff0000u); }
__device__ __forceinline__ float sigm(float x) { return 1.0f / (1.0f + __expf(-x)); }
__device__ __forceinline__ u32x4 pack8(const f32x4 v0, const f32x4 v1) { u32x4 w; w.x = cvt_pk_bf16(v0[0], v0[1]); w.y = cvt_pk_bf16(v0[2], v0[3]); w.z = cvt_pk_bf16(v1[0], v1[1]); w.w = cvt_pk_bf16(v1[2], v1[3]); return w; }

struct EpiG1 {
    static constexpr bool PERM = true, AFTER_DRAIN = false;
    float* PRW; float* BND; bf16_t* PNSA; bf16_t* MG; float* GLOG;
    __device__ __forceinline__ void operator()(const f32x4 (&acc)[2][2][4][2], const Unit& u, int wr, int wc, int fr, int fq) const {
        const int row0 = u.pm * BM + wr * 64 + fr, c0 = wc * 32 + 8 * fq;
#pragma unroll
        for (int ai = 0; ai < 2; ++ai)
#pragma unroll
            for (int m = 0; m < 4; ++m) { const int row = row0 + ai * HALF + m * 16;
#pragma unroll
                for (int bj = 0; bj < 2; ++bj) { const f32x4 v0 = acc[ai][bj][m][0], v1 = acc[ai][bj][m][1]; const int col = c0 + bj * HALF;
                    if (u.pn < 7) { float* p = PRW + (size_t)row * 1792 + u.pn * 256 + col; *(f32x4*)p = v0; *(f32x4*)(p + 4) = v1;
                        if ((row & 63) == 63) { float* q = BND + (size_t)(row >> 6) * 1792 + u.pn * 256 + col; *(f32x4*)q = v0; *(f32x4*)(q + 4) = v1; } }
                    else if (u.pn < 12) { *(u32x4*)(PNSA + (size_t)row * 1280 + (u.pn - 7) * 256 + col) = pack8(v0, v1); }
                    else if (u.pn < 20) { *(u32x4*)(MG + (size_t)row * 2048 + (u.pn - 12) * 256 + col) = pack8(v0, v1); }
                    else { if (col < 32) { float* p = GLOG + (size_t)row * 32 + col; *(f32x4*)p = v0; *(f32x4*)(p + 4) = v1; } }
                } }
    }
};
struct EpiGate1 {
    static constexpr bool PERM = true, AFTER_DRAIN = false;
    float* T1; const bf16_t* MG; int goff;
    __device__ __forceinline__ void operator()(const f32x4 (&acc)[2][2][4][2], const Unit& u, int wr, int wc, int fr, int fq) const {
        const int row0 = u.pm * BM + wr * 64 + fr, c0 = u.pn * BM + wc * 32 + 8 * fq;
#pragma unroll
        for (int ai = 0; ai < 2; ++ai)
#pragma unroll
            for (int m = 0; m < 4; ++m) { const int row = row0 + ai * HALF + m * 16;
#pragma unroll
                for (int bj = 0; bj < 2; ++bj) { const f32x4 v0 = acc[ai][bj][m][0], v1 = acc[ai][bj][m][1]; const int col = c0 + bj * HALF;
                    const u32x4 g = *(const u32x4*)(MG + (size_t)row * 2048 + goff + col);
                    f32x4 o0, o1; o0[0] = sigm(bf_lo(g.x)) * v0[0]; o0[1] = sigm(bf_hi(g.x)) * v0[1]; o0[2] = sigm(bf_lo(g.y)) * v0[2]; o0[3] = sigm(bf_hi(g.y)) * v0[3];
                    o1[0] = sigm(bf_lo(g.z)) * v1[0]; o1[1] = sigm(bf_hi(g.z)) * v1[1]; o1[2] = sigm(bf_lo(g.w)) * v1[2]; o1[3] = sigm(bf_hi(g.w)) * v1[3];
                    float* p = T1 + (size_t)row * 1024 + col; *(f32x4*)p = o0; *(f32x4*)(p + 4) = o1; } }
    }
};
struct EpiGate2 {
    static constexpr bool PERM = true, AFTER_DRAIN = false;
    const float* T1; const bf16_t* MG; int goff; bf16_t* MIX;
    __device__ __forceinline__ void operator()(const f32x4 (&acc)[2][2][4][2], const Unit& u, int wr, int wc, int fr, int fq) const {
        const int row0 = u.pm * BM + wr * 64 + fr, c0 = u.pn * BM + wc * 32 + 8 * fq;
#pragma unroll
        for (int ai = 0; ai < 2; ++ai)
#pragma unroll
            for (int m = 0; m < 4; ++m) { const int row = row0 + ai * HALF + m * 16;
#pragma unroll
                for (int bj = 0; bj < 2; ++bj) { const f32x4 v0 = acc[ai][bj][m][0], v1 = acc[ai][bj][m][1]; const int col = c0 + bj * HALF;
                    const u32x4 g = *(const u32x4*)(MG + (size_t)row * 2048 + goff + col);
                    const float* p = T1 + (size_t)row * 1024 + col; const f32x4 t0 = *(const f32x4*)p, t1 = *(const f32x4*)(p + 4);
                    f32x4 o0, o1; o0[0] = t0[0] + sigm(bf_lo(g.x)) * v0[0]; o0[1] = t0[1] + sigm(bf_hi(g.x)) * v0[1]; o0[2] = t0[2] + sigm(bf_lo(g.y)) * v0[2]; o0[3] = t0[3] + sigm(bf_hi(g.y)) * v0[3];
                    o1[0] = t1[0] + sigm(bf_lo(g.z)) * v1[0]; o1[1] = t1[1] + sigm(bf_hi(g.z)) * v1[1]; o1[2] = t1[2] + sigm(bf_lo(g.w)) * v1[2]; o1[3] = t1[3] + sigm(bf_hi(g.w)) * v1[3];
                    *(u32x4*)(MIX + (size_t)row * 1024 + col) = pack8(o0, o1); } }
    }
};
struct EpiRes {
    static constexpr bool PERM = true, AFTER_DRAIN = false;
    const float* X; float* OUT;
    __device__ __forceinline__ void operator()(const f32x4 (&acc)[2][2][4][2], const Unit& u, int wr, int wc, int fr, int fq) const {
        const int row0 = u.pm * BM + wr * 64 + fr, c0 = u.pn * BM + wc * 32 + 8 * fq;
#pragma unroll
        for (int ai = 0; ai < 2; ++ai)
#pragma unroll
            for (int m = 0; m < 4; ++m) { const int row = row0 + ai * HALF + m * 16;
#pragma unroll
                for (int bj = 0; bj < 2; ++bj) { const size_t off = (size_t)row * 1024 + c0 + bj * HALF;
                    const f32x4 x0 = *(const f32x4*)(X + off), x1 = *(const f32x4*)(X + off + 4);
                    *(f32x4*)(OUT + off) = x0 + acc[ai][bj][m][0]; *(f32x4*)(OUT + off + 4) = x1 + acc[ai][bj][m][1]; } }
    }
};
template <class Epi, class Sched, bool ALIGN_EPI = false, bool SP2 = false>
__device__ __forceinline__ void gemm_phase(PG8_LAS unsigned char* lds, const Gemm g, const Sched& S, const Epi& E) {
    const int tid = threadIdx.x, wid = __builtin_amdgcn_readfirstlane(tid >> 6), lane = tid & 63, wr = wid >> 2, wc = wid & 3, fr = lane & 15, fq = lane >> 4;
    const int K = g.K, nt = K / BK;
    unsigned voffA[2], voffB[2];
#pragma unroll
    for (int i = 0; i < 2; ++i) { int R, C; stage_rc(tid * 16 + i * 8192, R, C); const int Rb = Epi::PERM ? ((R & ~31) + perm32(R & 31)) : R;
        voffA[i] = (unsigned)(R * K + C) * 2u; voffB[i] = (unsigned)(Rb * K + C) * 2u; }
    const size_t kstep = (size_t)(BK * 2);
    const size_t hstep = (size_t)HALF * K * 2;
    const size_t tstep = 2 * hstep;
    const unsigned ldsw = (unsigned)wid * 1024u;
    const int aoff = lds_byte(wr * 64 + fr, fq * 8), boff = lds_byte(wc * 32 + fr, fq * 8);
#define PG8_SA(b, h) (((b) * 2 + (h)) * HTB)
#define PG8_SB(b, h) ((4 + (b) * 2 + (h)) * HTB)
#define PG8_STAGE(bufoff, gbase, voff) do { _Pragma("unroll") for (int _i = 0; _i < 2; ++_i) \
        __builtin_amdgcn_global_load_lds((const unsigned*)((const char*)(gbase) + (voff)[_i]), (PG8_LAS unsigned*)(lds + (bufoff) + ldsw + _i * 8192), 16, 0, 0); } while (0)
#define PG8_LDA(dst, b, h) do { _Pragma("unroll") for (int m = 0; m < 4; ++m) _Pragma("unroll") for (int k = 0; k < 2; ++k) dst[m][k] = *(const PG8_LAS bf16x8*)(lds + PG8_SA(b, h) + aoff + m * 2048 + k * 1024); } while (0)
#define PG8_LDB(dst, b, h) do { _Pragma("unroll") for (int n = 0; n < 2; ++n) _Pragma("unroll") for (int k = 0; k < 2; ++k) dst[n][k] = *(const PG8_LAS bf16x8*)(lds + PG8_SB(b, h) + boff + n * 2048 + k * 1024); } while (0)
#define PG8_MMA(ai, bj, At, Bt) do { __builtin_amdgcn_s_setprio(1); _Pragma("unroll") for (int m = 0; m < 4; ++m) _Pragma("unroll") for (int n = 0; n < 2; ++n) _Pragma("unroll") for (int k = 0; k < 2; ++k) \
        acc[ai][bj][m][n] = __builtin_amdgcn_mfma_f32_16x16x32_bf16(Bt[n][k], At[m][k], acc[ai][bj][m][n], 0, 0, 0); __builtin_amdgcn_s_setprio(0); } while (0)
#define PG8_WAIT_V(n) asm volatile("s_waitcnt vmcnt(" #n ")" ::: "memory")
#define PG8_WAIT_L(n) asm volatile("s_waitcnt lgkmcnt(" #n ")" ::: "memory")
#define PG8_BAR __builtin_amdgcn_s_barrier()
#define PG8_SCHED __builtin_amdgcn_sched_barrier(0)
    Unit cur, nxt; int ui = 0;
    if (!S.next(0, cur)) return;
    f32x4 acc[2][2][4][2];
#pragma unroll
    for (int a = 0; a < 2; ++a)
#pragma unroll
        for (int b = 0; b < 2; ++b)
#pragma unroll
            for (int m = 0; m < 4; ++m)
#pragma unroll
                for (int n = 0; n < 2; ++n) acc[a][b][m][n] = (f32x4){0.f, 0.f, 0.f, 0.f};
    bf16x8 At[4][2], B0[2][2], B1[2][2];
    const char* cA = (const char*)g.A + (size_t)cur.pm * tstep; const char* cB = (const char*)g.Bt + (size_t)cur.pn * tstep;
    S.a_ready(cur);
    if constexpr (SP2) {
        PG8_STAGE(PG8_SB(0, 0), cB, voffB); PG8_STAGE(PG8_SB(0, 1), cB + hstep, voffB); PG8_STAGE(PG8_SA(0, 0), cA, voffA); PG8_STAGE(PG8_SA(0, 1), cA + hstep, voffA);
        if (wr == 1) PG8_BAR;
        PG8_WAIT_V(2); PG8_BAR;
        PG8_STAGE(PG8_SB(1, 0), cB + kstep, voffB); PG8_STAGE(PG8_SA(1, 0), cA + kstep, voffA); PG8_STAGE(PG8_SB(1, 1), cB + hstep + kstep, voffB);
        PG8_WAIT_V(6); PG8_BAR;
    } else {
        PG8_STAGE(PG8_SB(0, 0), cB, voffB); PG8_STAGE(PG8_SA(0, 0), cA, voffA); PG8_STAGE(PG8_SB(0, 1), cB + hstep, voffB); PG8_STAGE(PG8_SA(0, 1), cA + hstep, voffA);
        if (wr == 1) PG8_BAR;
        PG8_WAIT_V(4); PG8_BAR;
        PG8_STAGE(PG8_SB(1, 0), cB + kstep, voffB); PG8_STAGE(PG8_SA(1, 0), cA + kstep, voffA); PG8_STAGE(PG8_SB(1, 1), cB + hstep + kstep, voffB);
        PG8_WAIT_V(6); PG8_BAR;
    }
    for (;;) {
        const bool has_next = S.next(ui + 1, nxt);
        const char* nA = has_next ? (const char*)g.A + (size_t)nxt.pm * tstep : cA; const char* nB = has_next ? (const char*)g.Bt + (size_t)nxt.pn * tstep : cB;
        for (int t = 0; t < nt; t += 2) {
            const bool last = (t == nt - 2);
            const char* a1 = cA + (size_t)(t + 1) * kstep;
            const char* a2 = last ? nA : cA + (size_t)(t + 2) * kstep; const char* b2 = last ? nB : cB + (size_t)(t + 2) * kstep;
            const char* a3 = a2 + kstep; const char* b3 = b2 + kstep;
            if (last && has_next) S.a_ready(nxt);
            if constexpr (SP2) {
            PG8_LDB(B0, 0, 0); PG8_LDB(B1, 0, 1); PG8_SCHED; PG8_LDA(At, 0, 0); PG8_STAGE(PG8_SA(1, 1), a1 + hstep, voffA);
            PG8_WAIT_V(8); PG8_WAIT_L(0); PG8_BAR; PG8_MMA(0, 0, At, B0); PG8_MMA(0, 1, At, B1); PG8_BAR; PG8_SCHED;
            PG8_LDA(At, 0, 1); PG8_STAGE(PG8_SB(0, 0), b2, voffB); PG8_STAGE(PG8_SB(0, 1), b2 + hstep, voffB); PG8_STAGE(PG8_SA(0, 0), a2, voffA);
            PG8_WAIT_V(8); PG8_WAIT_L(0); PG8_BAR; PG8_MMA(1, 0, At, B0); PG8_MMA(1, 1, At, B1); PG8_BAR; PG8_SCHED;
            PG8_LDB(B0, 1, 0); PG8_LDB(B1, 1, 1); PG8_SCHED; PG8_LDA(At, 1, 0); PG8_STAGE(PG8_SA(0, 1), a2 + hstep, voffA);
            PG8_WAIT_V(8); PG8_WAIT_L(0); PG8_BAR; PG8_MMA(0, 0, At, B0); PG8_MMA(0, 1, At, B1); PG8_BAR; PG8_SCHED;
            PG8_LDA(At, 1, 1); PG8_STAGE(PG8_SB(1, 0), b3, voffB); PG8_STAGE(PG8_SB(1, 1), b3 + hstep, voffB); PG8_STAGE(PG8_SA(1, 0), a3, voffA);
            PG8_WAIT_V(8); PG8_WAIT_L(0); PG8_BAR; PG8_MMA(1, 0, At, B0); PG8_MMA(1, 1, At, B1); PG8_BAR; PG8_SCHED;
            } else {
            PG8_LDB(B0, 0, 0); PG8_SCHED; PG8_LDA(At, 0, 0); PG8_STAGE(PG8_SA(1, 1), a1 + hstep, voffA);
            PG8_WAIT_L(8); PG8_BAR; PG8_WAIT_L(0); PG8_MMA(0, 0, At, B0); PG8_BAR; PG8_SCHED;
            PG8_LDB(B1, 0, 1); PG8_STAGE(PG8_SB(0, 0), b2, voffB);
            PG8_BAR; PG8_WAIT_L(0); PG8_MMA(0, 1, At, B1); PG8_BAR;
            PG8_LDA(At, 0, 1); PG8_STAGE(PG8_SA(0, 0), a2, voffA);
            PG8_BAR; PG8_WAIT_L(0); PG8_MMA(1, 0, At, B0); PG8_BAR; PG8_SCHED;
            PG8_STAGE(PG8_SB(0, 1), b2 + hstep, voffB);
            PG8_WAIT_V(6); PG8_BAR; PG8_MMA(1, 1, At, B1); PG8_BAR;
            PG8_LDB(B0, 1, 0); PG8_SCHED; PG8_LDA(At, 1, 0); PG8_STAGE(PG8_SA(0, 1), a2 + hstep, voffA);
            PG8_WAIT_L(8); PG8_BAR; PG8_WAIT_L(0); PG8_MMA(0, 0, At, B0); PG8_BAR; PG8_SCHED;
            PG8_LDB(B1, 1, 1); PG8_STAGE(PG8_SB(1, 0), b3, voffB);
            PG8_BAR; PG8_WAIT_L(0); PG8_MMA(0, 1, At, B1); PG8_BAR;
            PG8_LDA(At, 1, 1); PG8_STAGE(PG8_SA(1, 0), a3, voffA);
            PG8_BAR; PG8_WAIT_L(0); PG8_MMA(1, 0, At, B0); PG8_BAR; PG8_SCHED;
            PG8_STAGE(PG8_SB(1, 1), b3 + hstep, voffB);
            PG8_WAIT_V(6); PG8_BAR; PG8_MMA(1, 1, At, B1); PG8_BAR;
            }
        }
        if constexpr (ALIGN_EPI) { if (wr == 0) PG8_BAR; }
        if constexpr (!Epi::AFTER_DRAIN) { E(acc, cur, wr, wc, fr, fq); S.done(cur); }
        if (!has_next) break;
#pragma unroll
        for (int a = 0; a < 2; ++a)
#pragma unroll
            for (int b = 0; b < 2; ++b)
#pragma unroll
                for (int m = 0; m < 4; ++m)
#pragma unroll
                    for (int n = 0; n < 2; ++n) acc[a][b][m][n] = (f32x4){0.f, 0.f, 0.f, 0.f};
        cur = nxt; cA = nA; cB = nB; ++ui;
        if constexpr (ALIGN_EPI) { if (wr == 1) PG8_BAR; }
    }
    PG8_WAIT_V(0);
    if constexpr (!ALIGN_EPI) { if (wr == 0) PG8_BAR; }
    PG8_BAR;
    if constexpr (Epi::AFTER_DRAIN) { E.fused(acc, cur, wr, wc, fr, fq, lds, wid, lane); S.done(cur); }
#undef PG8_SA
#undef PG8_SB
#undef PG8_STAGE
#undef PG8_LDA
#undef PG8_LDB
#undef PG8_MMA
#undef PG8_WAIT_V
#undef PG8_WAIT_L
#undef PG8_BAR
#undef PG8_SCHED
}
}
#define GAS __attribute__((address_space(1)))
#define LAS __attribute__((address_space(3)))
typedef unsigned short bf16;
typedef unsigned v4u __attribute__((ext_vector_type(4)));
typedef float f32x4 __attribute__((ext_vector_type(4)));
typedef short bf16x8 __attribute__((ext_vector_type(8)));
typedef GAS unsigned gu32;
typedef GAS unsigned long long gu64;
#define RLX_AGENT __ATOMIC_RELAXED, __HIP_MEMORY_SCOPE_AGENT
#define LDS_WAIT() asm volatile("s_waitcnt lgkmcnt(0)" ::: "memory")
#define VM_WAIT() asm volatile("s_waitcnt vmcnt(0)" ::: "memory")
__device__ __forceinline__ unsigned long long rt() { return __builtin_amdgcn_s_memrealtime(); }
__device__ __forceinline__ unsigned f2bf(float f) { unsigned u = __builtin_bit_cast(unsigned, f); return (u + 0x7fffu + ((u >> 16) & 1u)) >> 16; }
__device__ __forceinline__ unsigned pk2(float lo, float hi) { return f2bf(lo) | (f2bf(hi) << 16); }

#define XB_TMO      128
#define XB_XCNT(j)  (256  + 64 * (j))
#define XB_XSUB(j)  (1280 + 64 * (j))
#define XB_XGEN(j)  (2304 + 64 * (j))
#define XB_TOP      3328
#define XB_TOPGEN   3392
#define XCD_BAR_WORDS 3456
#define XB_SPIN_CAP (1u << 18)

__device__ __forceinline__ unsigned xb_ld(unsigned* p)              { return __hip_atomic_load(p, __ATOMIC_RELAXED, __HIP_MEMORY_SCOPE_AGENT); }
__device__ __forceinline__ unsigned xb_add(unsigned* p, unsigned v) { return __hip_atomic_fetch_add(p, v, __ATOMIC_RELAXED, __HIP_MEMORY_SCOPE_AGENT); }
__device__ __forceinline__ unsigned xb_xcc_id() { return (unsigned)__builtin_amdgcn_s_getreg((3 << 11) | 20) & 0xFu; }
#define XB_SPIN(cond, bar) do { unsigned _sp = 0; while (cond) { __builtin_amdgcn_s_sleep(1); \
    if ((++_sp & 255u) == 0u) { if (xb_ld(&(bar)[XB_TMO])) break; if (_sp > XB_SPIN_CAP) { atomicAdd(&(bar)[XB_TMO], 1u); break; } } } } while (0)

struct XcdBarrier {
    unsigned* bar; unsigned x;
    volatile LAS unsigned* st;
};

__device__ __forceinline__ XcdBarrier xcd_barrier_post(unsigned* bar, volatile LAS unsigned* st) {
    XcdBarrier b; b.bar = bar; b.x = xb_xcc_id(); b.st = st;
    if (threadIdx.x == 0) (void)xb_add(&bar[XB_XCNT(b.x)], 1u);
    return b;
}
__device__ __forceinline__ void xcd_barrier_complete(unsigned* bar, unsigned x, unsigned& nloc, unsigned& nx) {
    const unsigned G = gridDim.x * gridDim.y * gridDim.z;
    unsigned sum, cnt, mine, sp = 0u;
    for (;;) {
        sum = 0u; cnt = 0u; mine = 0u;
#pragma unroll
        for (unsigned j = 0; j < 16; ++j) { const unsigned c = xb_ld(&bar[XB_XCNT(j)]); sum += c; cnt += (c > 0u) ? 1u : 0u; mine = (j == x) ? c : mine; }
        if (sum == G) break;
        __builtin_amdgcn_s_sleep(1);
        if ((++sp & 255u) == 0u) { if (xb_ld(&bar[XB_TMO])) break; if (sp > XB_SPIN_CAP) { atomicAdd(&bar[XB_TMO], 1u); break; } }
    }
    nloc = mine > 0u ? mine : 1u; nx = cnt > 0u ? cnt : 1u;
}

__device__ __forceinline__ void xcd_barrier(const XcdBarrier& b) {
    asm volatile("s_waitcnt vmcnt(0)" ::: "memory");
    __syncthreads();
    if (threadIdx.x == 0) {
        unsigned* bar = b.bar;
        __builtin_amdgcn_s_waitcnt(0);
        unsigned nloc = b.st[0], nx = b.st[1];
        if (nloc == 0u) { xcd_barrier_complete(bar, b.x, nloc, nx); b.st[0] = nloc; b.st[1] = nx; }
        const unsigned old = xb_add(&bar[XB_XSUB(b.x)], 1u);
        const unsigned gen = old / nloc;
        if (old + 1u == (gen + 1u) * nloc) {
            __builtin_amdgcn_fence(__ATOMIC_RELEASE, "agent");
            asm volatile("s_waitcnt vmcnt(0)" ::: "memory");
            const unsigned og = xb_add(&bar[XB_TOP], 1u);
            const unsigned tg = og / nx;
            if (og + 1u == (tg + 1u) * nx) xb_add(&bar[XB_TOPGEN], 1u);
            else XB_SPIN(xb_ld(&bar[XB_TOPGEN]) == tg, bar);
            __builtin_amdgcn_fence(__ATOMIC_ACQUIRE, "agent");
            xb_add(&bar[XB_XGEN(b.x)], 1u);
            asm volatile("s_waitcnt vmcnt(0)" ::: "memory");
        } else {
            XB_SPIN(xb_ld(&bar[XB_XGEN(b.x)]) == gen, bar);
            __builtin_amdgcn_fence(__ATOMIC_ACQUIRE, "agent");
            asm volatile("s_waitcnt vmcnt(0)" ::: "memory");
        }
    }
    __syncthreads();
}
constexpr int NWAVES = 8;
constexpr int BATCH = 4, T = 4096, D = 1024, M = BATCH * T;
constexpr int RWC = 1792;
constexpr int NG1 = 5376;
constexpr float NORM_EPS = 1e-6f, GN_EPS = 64e-5f;
constexpr float LOG2E = 1.4426950408889634f;
constexpr int N_PHASES = 11;
#ifndef MK_ONE_LAUNCH
#define MK_ONE_LAUNCH 0
#endif
#ifndef SCAN_BLOCKS
#define SCAN_BLOCKS 64
#endif

constexpr size_t MiB = 1u << 20;
constexpr size_t WS_CTL = 0, CTL_ZERO_BYTES = 1 * MiB;
constexpr size_t WS_WIN = 1 * MiB;
constexpr size_t WS_WA = 12 * MiB, WS_WB = 13 * MiB;
constexpr size_t WS_WOUT = 14 * MiB;
constexpr size_t WS_WQ = 16 * MiB;
constexpr size_t WS_CW1K = 20 * MiB, WS_CW1V = 21 * MiB;
constexpr size_t WS_CW2K = 22 * MiB, WS_CW2V = 22 * MiB + 65536;
constexpr size_t WS_SK1 = 22 * MiB + 131072, WS_SK2 = 22 * MiB + 196608;
constexpr size_t WS_BND = 23 * MiB;
constexpr size_t WS_KC = 25 * MiB;
constexpr size_t WS_VCT = 25 * MiB + 262144;
constexpr size_t WS_H = 26 * MiB;
constexpr size_t WS_PRW = 58 * MiB;
constexpr size_t WS_MG = 170 * MiB;
constexpr size_t WS_VST = 234 * MiB, WS_VWT = 238 * MiB;
constexpr size_t WS_END = 256 * MiB;
constexpr size_t DO_PNSA = 0, DO_G = 40 * MiB, DO_GLOG = 56 * MiB;
constexpr int CW_TMO = 0, CW_CODE = 1, CW_NSAQ = 64, CW_BAR = 4096;

constexpr int RING_OFF = 0, RING_BYTES = 131072;
constexpr int LDSCTL_OFF = RING_BYTES, MISC_OFF = LDSCTL_OFF + 320;
constexpr int LDS_BYTES = 147456;
typedef unsigned short u16;
typedef unsigned u32x2 __attribute__((ext_vector_type(2)));
struct Frame {
    LAS unsigned char* lds;
    volatile LAS unsigned* MISC;
    gu32* ctl;
    int tid, lane, wave, vcu, G;
    const float* in[33];
    float* out; unsigned char* ws;
};
__device__ __forceinline__ float wave_sum(float v) {
#pragma unroll
    for (int o = 1; o < 64; o <<= 1) v += __shfl_xor(v, o);
    return v;
}
__device__ __forceinline__ float bf2f(u16 b) { return __uint_as_float((unsigned)b << 16); }
__device__ __forceinline__ float bflo(unsigned w) { return __uint_as_float(w << 16); }
__device__ __forceinline__ float bfhi(unsigned w) { return __uint_as_float(w & 0xffff0000u); }
__device__ __forceinline__ u16 f2b(float f) { return (u16)f2bf(f); }
__device__ __forceinline__ float sigmf(float x) { return 1.0f / (1.0f + __expf(-x)); }
__device__ __forceinline__ f32x4 mfma16(const bf16x8 a, const bf16x8 b, const f32x4 c) { return __builtin_amdgcn_mfma_f32_16x16x32_bf16(a, b, c, 0, 0, 0); }
__device__ __forceinline__ bf16x8 as_bf16x8(const v4u v) { return __builtin_bit_cast(bf16x8, v); }

__device__ __forceinline__ void tr_item(const float* W, int K, int ldw, int sc0, int nblk, int ncols_valid, bf16* WT, int dr0, LAS float* scr, int item, int lane) {
    const int kb = item / nblk, nb = item % nblk, k0 = 64 * kb, n0 = 32 * nb;
#pragma unroll 8
    for (int i = 0; i < 32; ++i) { const int kk = 2 * i + (lane >> 5); const int n = n0 + (lane & 31);
        scr[kk * 33 + (lane & 31)] = (n < ncols_valid) ? W[(size_t)(k0 + kk) * ldw + sc0 + n] : 0.f; }
    LDS_WAIT(); asm volatile("" ::: "memory");
    const int c = lane & 7;
#pragma unroll
    for (int j = 0; j < 4; ++j) { const int n = (lane >> 3) + 8 * j; const LAS float* s = scr + (8 * c) * 33 + n;
        v4u o; o.x = pk2(s[0 * 33], s[1 * 33]); o.y = pk2(s[2 * 33], s[3 * 33]); o.z = pk2(s[4 * 33], s[5 * 33]); o.w = pk2(s[6 * 33], s[7 * 33]);
        *(GAS v4u*)(WT + (size_t)(dr0 + n0 + n) * K + k0 + 8 * c) = o; }
    LDS_WAIT(); asm volatile("" ::: "memory");
}
__device__ __forceinline__ void rms_row_to_bf16(int lane, const float* xrow, const float* gain, bf16* orow) {
    const GAS f32x4* xr = (const GAS f32x4*)xrow + lane; const GAS f32x4* gr = (const GAS f32x4*)gain + lane;
    f32x4 v[4]; float s2 = 0.f;
#pragma unroll
    for (int j = 0; j < 4; ++j) { v[j] = xr[64 * j]; s2 += (v[j].x * v[j].x + v[j].y * v[j].y) + (v[j].z * v[j].z + v[j].w * v[j].w); }
    const float rstd = 1.f / sqrtf(wave_sum(s2) * (1.f / D) + NORM_EPS);
    GAS unsigned long long* o8 = (GAS unsigned long long*)orow + lane;
#pragma unroll
    for (int j = 0; j < 4; ++j) { const f32x4 g = gr[64 * j];
        o8[64 * j] = (unsigned long long)pk2(v[j].x * rstd * g.x, v[j].y * rstd * g.y) | ((unsigned long long)pk2(v[j].z * rstd * g.z, v[j].w * rstd * g.w) << 32); }
}
__device__ __forceinline__ void p0_prologue(const Frame& F) {
    LAS float* scr = (LAS float*)(F.lds + RING_OFF + F.wave * 16384);
    const int gw = F.vcu * NWAVES + F.wave, NGW = F.G * NWAVES;
    unsigned char* ws = F.ws;
    constexpr int I0 = 16 * 96, I1 = 16 * 64, I2 = 16 * 8, I3 = 8 * 32, I4 = 8 * 32, I5 = 16 * 32, I6 = 16 * 64, I7 = 32 * 8, I8 = 32 * 8, I9 = 4 * 2, I10 = 4 * 2;
    constexpr int NITEMS = I0 + I1 + I2 + I3 + I4 + I5 + I6 + I7 + I8 + I9 + I10;
    for (int it = gw; it < NITEMS; it += NGW) {
        int r = it;
        if (r < I0) { tr_item(F.in[2], 1024, 5144, 0, 96, 3072, (bf16*)(ws + WS_WIN), 0, scr, r, F.lane); continue; } r -= I0;
        if (r < I1) { tr_item(F.in[2], 1024, 5144, 3096, 64, 2048, (bf16*)(ws + WS_WIN), 3072, scr, r, F.lane); continue; } r -= I1;
        if (r < I2) { tr_item(F.in[2], 1024, 5144, 3072, 8, 24, (bf16*)(ws + WS_WIN), 5120, scr, r, F.lane); continue; } r -= I2;
        if (r < I3) { tr_item(F.in[24], 512, 1024, 0, 32, 1024, (bf16*)(ws + WS_WA), 0, scr, r, F.lane); continue; } r -= I3;
        if (r < I4) { tr_item(F.in[25], 512, 1024, 0, 32, 1024, (bf16*)(ws + WS_WB), 0, scr, r, F.lane); continue; } r -= I4;
        if (r < I5) { tr_item(F.in[26], 1024, 1024, 0, 32, 1024, (bf16*)(ws + WS_WOUT), 0, scr, r, F.lane); continue; } r -= I5;
        if (r < I6) { tr_item(F.in[28], 1024, 2048, 0, 64, 2048, (bf16*)(ws + WS_WQ), 0, scr, r, F.lane); continue; } r -= I6;
        if (r < I7) { tr_item(F.in[20], 2048, 256, 0, 8, 256, (bf16*)(ws + WS_CW1K), 0, scr, r, F.lane); continue; } r -= I7;
        if (r < I8) { tr_item(F.in[22], 2048, 256, 0, 8, 256, (bf16*)(ws + WS_CW1V), 0, scr, r, F.lane); continue; } r -= I8;
        if (r < I9) { tr_item(F.in[21], 256, 64, 0, 2, 64, (bf16*)(ws + WS_CW2K), 0, scr, r, F.lane); continue; } r -= I9;
        tr_item(F.in[23], 256, 64, 0, 2, 64, (bf16*)(ws + WS_CW2V), 0, scr, r, F.lane);
    }
    { const int gt = F.vcu * (NWAVES * 64) + F.tid, NT = F.G * NWAVES * 64;
      bf16* s1 = (bf16*)(ws + WS_SK1); bf16* s2 = (bf16*)(ws + WS_SK2);
      for (int i = gt; i < 128 * 128; i += NT) { s1[i] = f2b(F.in[29][i]); s2[i] = f2b(F.in[30][i]); } }
    for (int m = gw; m < M; m += NGW) rms_row_to_bf16(F.lane, F.in[0] + (size_t)m * D, F.in[1], (bf16*)(ws + WS_H) + (size_t)m * D);
}
__device__ __forceinline__ void rwkv_prep_tile(const Frame& F, int u) {
    const int tid = F.tid, lane = F.lane, h = F.wave;
    const int R0 = 64 * u, t0 = R0 & (T - 1);
    LAS float* lin = (LAS float*)(F.lds);
    float* PRW = (float*)(F.ws + WS_PRW);
    const float* BND = (const float*)(F.ws + WS_BND);
    bf16* G = (bf16*)((unsigned char*)F.out + DO_G);
    const float* mu = F.in[3];
    const float mu_r = mu[tid], mu_k = mu[512 + tid], mu_v = mu[1024 + tid], mu_l = (tid < 256) ? mu[1536 + tid] : 0.f;
    const float w0c = F.in[4][tid], a0c = F.in[6][tid], kkc = F.in[9][tid], kac = F.in[10][tid];
    const float* w_up = F.in[5]; const float* a_up = F.in[7]; const float* g_up = F.in[8];
    float pr = 0.f, pk = 0.f, pv = 0.f, pl = 0.f;
    if (t0 != 0) { const float* b = BND + (size_t)(u - 1) * RWC; pr = b[tid]; pk = b[512 + tid]; pv = b[1024 + tid]; if (tid < 256) pl = b[1536 + tid]; }
    for (int batch = 0; batch < 4; ++batch) {
        const int Rb = R0 + 16 * batch;
        float xr[16], xk[16], xv[16], xl[16];
#pragma unroll
        for (int j = 0; j < 16; ++j) { const float* p = PRW + (size_t)(Rb + j) * RWC; xr[j] = p[tid]; xk[j] = p[512 + tid]; xv[j] = p[1024 + tid]; xl[j] = (tid < 256) ? p[1536 + tid] : 0.f; }
        VM_WAIT();
#pragma unroll
        for (int j = 0; j < 16; ++j) { float n;
            n = xr[j]; xr[j] = n + (pr - n) * mu_r; pr = n;
            n = xk[j]; xk[j] = n + (pk - n) * mu_k; pk = n;
            n = xv[j]; xv[j] = n + (pv - n) * mu_v; pv = n;
            n = xl[j]; xl[j] = n + (pl - n) * mu_l; pl = n; }
        if (tid < 256) {
#pragma unroll
            for (int j = 0; j < 16; ++j) { const float v = xl[j]; const float f = (tid < 64) ? tanhf(v) : ((tid < 128) ? v : sigmf(v)); lin[tid * 16 + j] = f; }
        }
        __syncthreads();
        float accw[16], acca[16], accg[16];
#pragma unroll
        for (int j = 0; j < 16; ++j) { accw[j] = 0.f; acca[j] = 0.f; accg[j] = 0.f; }
#pragma unroll 2
        for (int jj = 0; jj < 64; ++jj) { const float wv = w_up[jj * 512 + tid], av = a_up[jj * 512 + tid];
            const LAS f32x4* iw = (const LAS f32x4*)(lin + jj * 16); const LAS f32x4* ia = (const LAS f32x4*)(lin + (64 + jj) * 16);
#pragma unroll
            for (int q = 0; q < 4; ++q) { const f32x4 a = iw[q], b = ia[q];
#pragma unroll
                for (int e = 0; e < 4; ++e) { accw[4 * q + e] += a[e] * wv; acca[4 * q + e] += b[e] * av; } } }
#pragma unroll 2
        for (int jj = 0; jj < 128; ++jj) { const float gv = g_up[jj * 512 + tid];
            const LAS f32x4* ig = (const LAS f32x4*)(lin + (128 + jj) * 16);
#pragma unroll
            for (int q = 0; q < 4; ++q) { const f32x4 a = ig[q];
#pragma unroll
                for (int e = 0; e < 4; ++e) accg[4 * q + e] += a[e] * gv; } }
#pragma unroll
        for (int j = 0; j < 16; ++j) { const int row = Rb + j;
            const float z = -(w0c + accw[j]); const float sp = fmaxf(z, 0.f) + log1pf(__expf(-fabsf(z)));
            const float e = __expf(-sp - 0.5f); const float omw = -expm1f(-e);
            const float a = sigmf(a0c + acca[j]);
            const float kkv = xk[j] * kkc, kmod = xk[j] * (1.f + (a - 1.f) * kac);
            const float ss = wave_sum(kkv * kkv); const float kkn = kkv / fmaxf(sqrtf(ss), 1e-12f);
            bf16* rec = (bf16*)(PRW + (size_t)row * RWC) + h * 384;
            rec[lane] = f2b(xr[j]); rec[64 + lane] = f2b(omw); rec[128 + lane] = f2b(kmod); rec[192 + lane] = f2b(xv[j]); rec[256 + lane] = f2b(kkn); rec[320 + lane] = f2b(a);
            G[(size_t)row * 512 + tid] = f2b(accg[j]); }
        __syncthreads();
    }
}
__device__ __forceinline__ void nsa_prep_tile(const Frame& F, int u) {
    const int lane = F.lane, w = F.wave;
    const int R0 = 64 * u, t0 = R0 & (T - 1), b = R0 / T;
    bf16* PNSA = (bf16*)((unsigned char*)F.out + DO_PNSA);
    const float qg = F.in[14][lane] * (0.125f * LOG2E);
    const float kg = (w < 2) ? F.in[16][lane] : F.in[17][lane];
    const int kcol = ((w < 2) ? 768 : 1024) + (w & 1) * 64 + lane;
    for (int tok = 0; tok < 64; ++tok) { bf16* p = PNSA + (size_t)(R0 + tok) * 1280;
        const float q = bf2f(p[w * 64 + lane]); const float ss = wave_sum(q * q) * (1.f / 64.f);
        float k = 0.f; if (w < 4) k = bf2f(p[kcol]);
        const float ks = wave_sum(k * k) * (1.f / 64.f);
        p[w * 64 + lane] = f2b(q * rsqrtf(ss + NORM_EPS) * qg);
        if (w < 4) p[kcol] = f2b(k * rsqrtf(ks + NORM_EPS) * kg); }
    if (w >= 4) {
        const int g = w & 1; const int scol = ((w < 6) ? 896 : 1152) + g * 64;
        bf16* VT = (bf16*)(F.ws + ((w < 6) ? WS_VST : WS_VWT)) + (size_t)((b * 2 + g) * 64) * T + t0 + lane;
        const v4u* src = (const v4u*)(PNSA + (size_t)(R0 + lane) * 1280 + scol);
        v4u v[8];
#pragma unroll
        for (int i = 0; i < 8; ++i) v[i] = src[i];
#pragma unroll
        for (int i = 0; i < 8; ++i) {
            VT[(size_t)(8 * i + 0) * T] = (u16)(v[i].x & 0xffffu); VT[(size_t)(8 * i + 1) * T] = (u16)(v[i].x >> 16);
            VT[(size_t)(8 * i + 2) * T] = (u16)(v[i].y & 0xffffu); VT[(size_t)(8 * i + 3) * T] = (u16)(v[i].y >> 16);
            VT[(size_t)(8 * i + 4) * T] = (u16)(v[i].z & 0xffffu); VT[(size_t)(8 * i + 5) * T] = (u16)(v[i].z >> 16);
            VT[(size_t)(8 * i + 6) * T] = (u16)(v[i].w & 0xffffu); VT[(size_t)(8 * i + 7) * T] = (u16)(v[i].w >> 16); }
    }
}
__device__ __forceinline__ float gelu_tanh(float x) { const float t = 0.7978845608028654f * (x + 0.044715f * x * x * x); return 0.5f * x * (1.f + tanhf(t)); }
__device__ __forceinline__ void compress_unit(const Frame& F, int u) {
    const int lane = F.lane, w = F.wave, r16 = lane & 15, q4 = lane >> 4;
    const int kvsel = u >> 7, b = (u >> 5) & 3, g = (u >> 4) & 1, ntile = u & 15;
    const bf16* X = (const bf16*)((unsigned char*)F.out + DO_PNSA) + (size_t)(b * T) * 1280 + (kvsel ? 640 : 512) + g * 64;
    const float* pos = kvsel ? F.in[19] : F.in[18];
    const bf16* W1t = (const bf16*)(F.ws + (kvsel ? WS_CW1V : WS_CW1K));
    const bf16* W2t = (const bf16*)(F.ws + (kvsel ? WS_CW2V : WS_CW2K));
    LAS bf16* hid = (LAS bf16*)(F.lds);
    LAS float* outb = (LAS float*)(F.lds + 16 * 528);
    int n = 16 * ntile + r16; if (n > 254) n = 254;
    f32x4 acc[2] = {{0.f, 0.f, 0.f, 0.f}, {0.f, 0.f, 0.f, 0.f}};
#pragma unroll 4
    for (int s = 0; s < 64; ++s) { const int lp = s >> 1, d0 = (s & 1) * 32 + 8 * q4;
        const v4u xa = *(const v4u*)(X + (size_t)(16 * n + lp) * 1280 + d0);
        const f32x4 p0 = *(const f32x4*)(pos + lp * 64 + d0), p1 = *(const f32x4*)(pos + lp * 64 + d0 + 4);
        v4u af; af.x = pk2(bflo(xa.x) + p0[0], bfhi(xa.x) + p0[1]); af.y = pk2(bflo(xa.y) + p0[2], bfhi(xa.y) + p0[3]);
        af.z = pk2(bflo(xa.z) + p1[0], bfhi(xa.z) + p1[1]); af.w = pk2(bflo(xa.w) + p1[2], bfhi(xa.w) + p1[3]);
#pragma unroll
        for (int nt = 0; nt < 2; ++nt) { const v4u bfg = *(const v4u*)(W1t + (size_t)(32 * w + 16 * nt + r16) * 2048 + 32 * s + 8 * q4);
            acc[nt] = mfma16(as_bf16x8(af), as_bf16x8(bfg), acc[nt]); } }
#pragma unroll
    for (int nt = 0; nt < 2; ++nt)
#pragma unroll
        for (int r = 0; r < 4; ++r) hid[(4 * q4 + r) * 264 + 32 * w + 16 * nt + r16] = f2b(gelu_tanh(acc[nt][r]));
    __syncthreads();
    if (w < 4) { f32x4 a2 = {0.f, 0.f, 0.f, 0.f};
#pragma unroll
        for (int s = 0; s < 8; ++s) { const v4u af = *(const LAS v4u*)(hid + r16 * 264 + 32 * s + 8 * q4);
            const v4u bfg = *(const v4u*)(W2t + (size_t)(16 * w + r16) * 256 + 32 * s + 8 * q4);
            a2 = mfma16(as_bf16x8(af), as_bf16x8(bfg), a2); }
#pragma unroll
        for (int r = 0; r < 4; ++r) outb[(4 * q4 + r) * 64 + 16 * w + r16] = a2[r]; }
    __syncthreads();
#pragma unroll
    for (int rr = 0; rr < 2; ++rr) { const int row = 2 * w + rr; const int nn = 16 * ntile + row; float val = outb[row * 64 + lane];
        if (kvsel == 0) { const float ss = wave_sum(val * val) * (1.f / 64.f); val = val * rsqrtf(ss + NORM_EPS) * F.in[15][lane];
            ((bf16*)(F.ws + WS_KC))[(size_t)((b * 2 + g) * 256 + nn) * 64 + lane] = (nn < 255) ? f2b(val) : (u16)0; }
        else ((bf16*)(F.ws + WS_VCT))[(size_t)((b * 2 + g) * 64 + lane) * 256 + nn] = (nn < 255) ? f2b(val) : (u16)0; }
    __syncthreads();
}
struct KFr { bf16x8 a0, a1, b0, b1; };
__device__ __forceinline__ KFr load_k(const bf16* Kb, int rstride, int k0, int r16, int q4) {
    const int keyA = k0 + 8 * (r16 >> 2) + (r16 & 3);
    const bf16* pa = Kb + (size_t)keyA * rstride + 8 * q4; const bf16* pb = pa + (size_t)4 * rstride;
    KFr f; f.a0 = as_bf16x8(*(const v4u*)pa); f.a1 = as_bf16x8(*(const v4u*)(pa + 32)); f.b0 = as_bf16x8(*(const v4u*)pb); f.b1 = as_bf16x8(*(const v4u*)(pb + 32)); return f;
}
struct VFr { bf16x8 v[4]; };
__device__ __forceinline__ VFr load_v(const bf16* Vt, int dstride, int k0, int r16, int q4) {
    VFr f;
#pragma unroll
    for (int dt = 0; dt < 4; ++dt) f.v[dt] = as_bf16x8(*(const v4u*)(Vt + (size_t)(16 * dt + r16) * dstride + k0 + 8 * q4));
    return f;
}
__device__ __forceinline__ bf16x8 pack_p(const f32x4 a, const f32x4 b) {
    v4u w; w.x = pg8::cvt_pk_bf16(a[0], a[1]); w.y = pg8::cvt_pk_bf16(a[2], a[3]); w.z = pg8::cvt_pk_bf16(b[0], b[1]); w.w = pg8::cvt_pk_bf16(b[2], b[3]); return as_bf16x8(w);
}
#define NSA_FENCE() asm volatile("s_waitcnt lgkmcnt(0)" ::: "memory")
__device__ __forceinline__ void nsa_wave_unit(const Frame& F, int b, int g, int t0, LAS float* wl) {
    const int lane = F.lane, r16 = lane & 15, q4 = lane >> 4;
    const f32x4 Z4 = {0.f, 0.f, 0.f, 0.f};
    const bf16* PN = (const bf16*)((unsigned char*)F.out + DO_PNSA) + (size_t)(b * T) * 1280;
    const float* GL = (const float*)((unsigned char*)F.out + DO_GLOG) + (size_t)(b * T) * 32;
    LAS float* impT = wl; LAS float* imp2T = wl + 8 * 65; LAS unsigned* selT = (LAS unsigned*)(wl + 16 * 65);
    bf16x8 qf[2][2]; int tq[2];
#pragma unroll
    for (int mt = 0; mt < 2; ++mt) { tq[mt] = t0 + 4 * mt + (r16 >> 2);
#pragma unroll
        for (int dh = 0; dh < 2; ++dh) qf[mt][dh] = as_bf16x8(*(const v4u*)(PN + (size_t)tq[mt] * 1280 + (g * 4 + (r16 & 3)) * 64 + 32 * dh + 8 * q4)); }
    f32x4 Oc[2][4];
#pragma unroll
    for (int mt = 0; mt < 2; ++mt)
#pragma unroll
        for (int dt = 0; dt < 4; ++dt) Oc[mt][dt] = Z4;
    float gate[2][4][3];
#pragma unroll
    for (int mt = 0; mt < 2; ++mt)
#pragma unroll
        for (int r = 0; r < 4; ++r)
#pragma unroll
            for (int br = 0; br < 3; ++br) gate[mt][r][br] = sigmf(GL[(size_t)(t0 + 4 * mt + q4) * 32 + g * 12 + r * 3 + br]);

    const bf16* KC = (const bf16*)(F.ws + WS_KC) + (size_t)((b * 2 + g) * 256) * 64;
    const bf16* VCT = (const bf16*)(F.ws + WS_VCT) + (size_t)((b * 2 + g) * 64) * 256;
    for (int i = lane; i < 16 * 65; i += 64) wl[i] = 0.f;
    const int ncmp = (t0 + 7 >= 31) ? ((t0 + 7 - 31) >> 4) + 1 : 0;
    const int nst = (ncmp + 31) >> 5;
    float inv[2] = {0.f, 0.f};
    {   float ls[2] = {0.f, 0.f};
        for (int st = 0; st < nst; ++st) { const int k0 = 32 * st; const KFr kf = load_k(KC, 64, k0, r16, q4);
#pragma unroll
            for (int mt = 0; mt < 2; ++mt) { f32x4 sA = mfma16(kf.a0, qf[mt][0], Z4); sA = mfma16(kf.a1, qf[mt][1], sA); f32x4 sB = mfma16(kf.b0, qf[mt][0], Z4); sB = mfma16(kf.b1, qf[mt][1], sB);
#pragma unroll
                for (int r = 0; r < 4; ++r) { const int nA = k0 + 8 * q4 + r, nB = nA + 4;
                    ls[mt] += (16 * nA + 31 <= tq[mt]) ? __builtin_amdgcn_exp2f(sA[r]) : 0.f; ls[mt] += (16 * nB + 31 <= tq[mt]) ? __builtin_amdgcn_exp2f(sB[r]) : 0.f; } } }
#pragma unroll
        for (int mt = 0; mt < 2; ++mt) { float l = ls[mt]; l += __shfl_xor(l, 16); l += __shfl_xor(l, 32); inv[mt] = 1.0f / fmaxf(l, 1e-30f); }
    }
    {   f32x4 O[2][4];
#pragma unroll
        for (int mt = 0; mt < 2; ++mt)
#pragma unroll
            for (int dt = 0; dt < 4; ++dt) O[mt][dt] = Z4;
        for (int st = 0; st < nst; ++st) { const int k0 = 32 * st; const KFr kf = load_k(KC, 64, k0, r16, q4); const VFr vf = load_v(VCT, 256, k0, r16, q4);
#pragma unroll
            for (int mt = 0; mt < 2; ++mt) { f32x4 sA = mfma16(kf.a0, qf[mt][0], Z4); sA = mfma16(kf.a1, qf[mt][1], sA); f32x4 sB = mfma16(kf.b0, qf[mt][0], Z4); sB = mfma16(kf.b1, qf[mt][1], sB);
                f32x4 pA, pB;
#pragma unroll
                for (int r = 0; r < 4; ++r) { const int nA = k0 + 8 * q4 + r, nB = nA + 4;
                    pA[r] = (16 * nA + 31 <= tq[mt]) ? __builtin_amdgcn_exp2f(sA[r]) * inv[mt] : 0.f; pB[r] = (16 * nB + 31 <= tq[mt]) ? __builtin_amdgcn_exp2f(sB[r]) * inv[mt] : 0.f; }
                float vA = pA[0] + pA[1] + pA[2] + 0.5f * pA[3], cA = 0.5f * pA[3], vB = pB[0] + pB[1] + pB[2] + 0.5f * pB[3], cB = 0.5f * pB[3];
                vA += __shfl_xor(vA, 1); vA += __shfl_xor(vA, 2); cA += __shfl_xor(cA, 1); cA += __shfl_xor(cA, 2);
                vB += __shfl_xor(vB, 1); vB += __shfl_xor(vB, 2); cB += __shfl_xor(cB, 1); cB += __shfl_xor(cB, 2);
                if ((lane & 3) == 0) { const int tl = 4 * mt + (r16 >> 2), j = (k0 >> 2) + 2 * q4;
                    impT[tl * 65 + j] = vA; imp2T[tl * 65 + j + 1] = cA; impT[tl * 65 + j + 1] = vB; imp2T[tl * 65 + j + 2] = cB; }
                const bf16x8 pf = pack_p(pA, pB);
#pragma unroll
                for (int dt = 0; dt < 4; ++dt) O[mt][dt] = mfma16(pf, vf.v[dt], O[mt][dt]); } }
#pragma unroll
        for (int mt = 0; mt < 2; ++mt)
#pragma unroll
            for (int dt = 0; dt < 4; ++dt)
#pragma unroll
                for (int r = 0; r < 4; ++r) Oc[mt][dt][r] += gate[mt][r][0] * O[mt][dt][r];
    }
    NSA_FENCE();
    const int cur = t0 >> 6;
    unsigned long long uni = 0ull;
    for (int tl = 0; tl < 8; ++tl) {
        unsigned long long mask;
        if (cur < 16) mask = (2ull << cur) - 1ull;
        else {
            const float sc = impT[tl * 65 + lane] + imp2T[tl * 65 + lane];
            const unsigned key = __float_as_uint(fmaxf(sc, 0.f));
            const bool elig = (lane <= cur) && (lane != 0) && (lane != cur) && (lane != cur - 1);
            unsigned prefix = 0u;
            for (int bit = 30; bit >= 0; --bit) { const unsigned cand = prefix | (1u << bit);
                const int cnt = __popcll(__ballot(elig && key >= cand)); if (cnt >= 13) prefix = cand; }
            const unsigned long long gt = __ballot(elig && key > prefix); unsigned long long ties = __ballot(elig && key == prefix);
            int need = 13 - __popcll(gt); unsigned long long keep = 0ull;
            while (need > 0 && ties) { const unsigned long long low = ties & (0ull - ties); keep |= low; ties ^= low; --need; }
            mask = gt | keep | 1ull | (1ull << cur) | (1ull << (cur - 1));
        }
        uni |= mask;
        if (lane == 0) { selT[2 * tl] = (unsigned)mask; selT[2 * tl + 1] = (unsigned)(mask >> 32); }
    }
    NSA_FENCE();
    unsigned long long mk[2];
#pragma unroll
    for (int mt = 0; mt < 2; ++mt) { const int tl = 4 * mt + (r16 >> 2); mk[mt] = (unsigned long long)selT[2 * tl] | ((unsigned long long)selT[2 * tl + 1] << 32); }
    NSA_FENCE();

#pragma unroll 1
    for (int br = 1; br < 3; ++br) {
        const bf16* Kb = PN + (br == 1 ? 768 : 1024) + g * 64;
        const bf16* Vt = (const bf16*)(F.ws + (br == 1 ? WS_VST : WS_VWT)) + (size_t)((b * 2 + g) * 64) * T;
        f32x4 O[2][4]; float ls[2] = {0.f, 0.f};
#pragma unroll
        for (int mt = 0; mt < 2; ++mt)
#pragma unroll
            for (int dt = 0; dt < 4; ++dt) O[mt][dt] = Z4;
        int k0 = 0, kend = 0; unsigned long long rem = uni;
        if (br == 2) { const int lo = t0 - 511; k0 = (lo > 0 ? lo : 0) & ~31; kend = t0 + 8; }
        for (;;) {
            int j = 0;
            if (br == 1) { if (k0 == kend) { if (!rem) break; j = __builtin_ctzll(rem); rem &= rem - 1; k0 = 64 * j; kend = k0 + 64; } else j = k0 >> 6; }
            else { if (k0 >= kend) break; }
            const KFr kf = load_k(Kb, 1280, k0, r16, q4); const VFr vf = load_v(Vt, T, k0, r16, q4);
#pragma unroll
            for (int mt = 0; mt < 2; ++mt) { f32x4 sA = mfma16(kf.a0, qf[mt][0], Z4); sA = mfma16(kf.a1, qf[mt][1], sA); f32x4 sB = mfma16(kf.b0, qf[mt][0], Z4); sB = mfma16(kf.b1, qf[mt][1], sB);
                f32x4 pA, pB; const bool sb = (br == 1) ? (((mk[mt] >> j) & 1ull) != 0ull) : true;
#pragma unroll
                for (int r = 0; r < 4; ++r) { const int kA = k0 + 8 * q4 + r, kB = kA + 4;
                    const bool mA = sb && (kA <= tq[mt]) && (br == 1 || kA + 512 > tq[mt]), mB = sb && (kB <= tq[mt]) && (br == 1 || kB + 512 > tq[mt]);
                    pA[r] = mA ? __builtin_amdgcn_exp2f(sA[r]) : 0.f; pB[r] = mB ? __builtin_amdgcn_exp2f(sB[r]) : 0.f; }
                ls[mt] += (pA[0] + pA[1]) + (pA[2] + pA[3]) + (pB[0] + pB[1]) + (pB[2] + pB[3]);
                const bf16x8 pf = pack_p(pA, pB);
#pragma unroll
                for (int dt = 0; dt < 4; ++dt) O[mt][dt] = mfma16(pf, vf.v[dt], O[mt][dt]); }
            k0 += 32;
        }
#pragma unroll
        for (int mt = 0; mt < 2; ++mt) { float l = ls[mt]; l += __shfl_xor(l, 16); l += __shfl_xor(l, 32); const float il = 1.0f / fmaxf(l, 1e-30f);
#pragma unroll
            for (int r = 0; r < 4; ++r) { const float ilr = __shfl(il, 4 * q4 + r) * (br == 1 ? gate[mt][r][1] : gate[mt][r][2]);
#pragma unroll
                for (int dt = 0; dt < 4; ++dt) Oc[mt][dt][r] += ilr * O[mt][dt][r]; } }
    }
    bf16* YB = (bf16*)(F.ws + WS_H + 16 * MiB) + (size_t)(b * T) * 512;
#pragma unroll
    for (int mt = 0; mt < 2; ++mt)
#pragma unroll
        for (int r = 0; r < 4; ++r)
#pragma unroll
            for (int dt = 0; dt < 4; ++dt) YB[(size_t)(t0 + 4 * mt + q4) * 512 + (g * 4 + r) * 64 + 16 * dt + r16] = f2b(Oc[mt][dt][r]);
}
__device__ __forceinline__ void nsa_phase(const Frame& F) {
    LAS float* wl = (LAS float*)(F.lds + F.wave * 4608);
    for (;;) {
        unsigned c = 0;
        if (F.lane == 0) c = __hip_atomic_fetch_add(F.ctl + CW_NSAQ, 1u, RLX_AGENT);
        c = (unsigned)__builtin_amdgcn_readfirstlane((int)c);
        if (c >= 4096u) break;
        const int b = c & 3, g = (c >> 2) & 1, tqi = 511 - (int)(c >> 3);
        nsa_wave_unit(F, b, g, 8 * tqi, wl);
    }
}
template <int CTRL> __device__ __forceinline__ float dppf(float x) { return __builtin_bit_cast(float, __builtin_amdgcn_update_dpp(0, __builtin_bit_cast(int, x), CTRL, 0xf, 0xf, true)); }
__device__ __forceinline__ float allsum16(float x) { x += dppf<0x128>(x); x += dppf<0x124>(x); x += dppf<0x122>(x); x += dppf<0x121>(x); return x; }
__device__ __forceinline__ f32x4 unpk4(const u32x2 w) { f32x4 r; r[0] = bflo(w.x); r[1] = bfhi(w.x); r[2] = bflo(w.y); r[3] = bfhi(w.y); return r; }
__device__ __forceinline__ void rwkv_scan_block(const Frame& F, int sb) {
    const int tid = F.tid, lane = F.lane, w = F.wave;
    const int bh = sb >> 1, half = sb & 1, b = bh >> 3, h = bh & 7;
    const int lrow = 4 * w + (lane >> 4), kq = lane & 15;
    LAS float* buf = (LAS float*)F.lds;
    LAS float* ybuf = (LAS float*)(F.lds + 98304);
    const unsigned char* recb = F.ws + WS_PRW + (size_t)(b * T) * 7168 + h * 768;
    unsigned char* yb8 = F.ws + WS_PRW + (size_t)(b * T) * 7168 + 6144 + h * 128 + half * 64;
    const int fs = tid >> 4, o4 = (tid & 15) * 4;
    u32x2 st[6];
#define SCAN_LOAD(c) do { _Pragma("unroll") for (int sec = 0; sec < 6; ++sec) st[sec] = *(const u32x2*)(recb + (size_t)(32 * (c) + fs) * 7168 + sec * 128 + o4 * 2); } while (0)
#define SCAN_WRITE(bi) do { LAS float* d = buf + (bi) * 12288 + fs * 384 + o4; const f32x4 r_ = unpk4(st[0]), om_ = unpk4(st[1]), k_ = unpk4(st[2]), v_ = unpk4(st[3]), kk_ = unpk4(st[4]), a_ = unpk4(st[5]); \
        *(LAS f32x4*)(d) = kk_; *(LAS f32x4*)(d + 64) = kk_ * a_; *(LAS f32x4*)(d + 128) = 1.0f - om_; *(LAS f32x4*)(d + 192) = k_; *(LAS f32x4*)(d + 256) = r_; *(LAS f32x4*)(d + 320) = v_; } while (0)
    SCAN_LOAD(0); SCAN_WRITE(0); __syncthreads();
    float S0 = 0.f, S1 = 0.f, S2 = 0.f, S3 = 0.f;
    for (int c = 0; c < T / 32; ++c) {
        if (c + 1 < T / 32) SCAN_LOAD(c + 1);
        const LAS float* cb = buf + (c & 1) * 12288; LAS float* yb = ybuf + (c & 1) * 1024;
#pragma unroll 4
        for (int s = 0; s < 32; ++s) { const LAS float* p = cb + s * 384 + 4 * kq;
            const f32x4 kk4 = *(const LAS f32x4*)(p), ka4 = *(const LAS f32x4*)(p + 64), w4 = *(const LAS f32x4*)(p + 128), k4 = *(const LAS f32x4*)(p + 192), r4 = *(const LAS f32x4*)(p + 256);
            const float vv = cb[s * 384 + 320 + 32 * half + lrow];
            float sa = -((S0 * kk4[0] + S1 * kk4[1]) + (S2 * kk4[2] + S3 * kk4[3])); sa = allsum16(sa);
            S0 = S0 * w4[0] + (sa * ka4[0] + vv * k4[0]); S1 = S1 * w4[1] + (sa * ka4[1] + vv * k4[1]); S2 = S2 * w4[2] + (sa * ka4[2] + vv * k4[2]); S3 = S3 * w4[3] + (sa * ka4[3] + vv * k4[3]);
            float y = (S0 * r4[0] + S1 * r4[1]) + (S2 * r4[2] + S3 * r4[3]); y = allsum16(y);
            if (kq == 0) yb[s * 32 + lrow] = y; }
        if (c + 1 < T / 32) SCAN_WRITE((c + 1) & 1);
        __syncthreads();
        { const int rr = 2 * (tid & 15); const float y0 = yb[fs * 32 + rr], y1 = yb[fs * 32 + rr + 1];
          *(unsigned*)(yb8 + (size_t)(32 * c + fs) * 7168 + rr * 2) = pk2(y0, y1); }
    }
#undef SCAN_LOAD
#undef SCAN_WRITE
    __syncthreads();
}
__device__ __forceinline__ void rwkv_epilogue(const Frame& F) {
    const int lane = F.lane; const int gw = F.vcu * NWAVES + F.wave, NGW = F.G * NWAVES;
    const unsigned char* prw = F.ws + WS_PRW; const bf16* G = (const bf16*)((unsigned char*)F.out + DO_G); bf16* YA = (bf16*)(F.ws + WS_H);
    for (int idx = gw; idx < M * 8; idx += NGW) { const int row = idx >> 3, h = idx & 7, c = h * 64 + lane;
        const bf16* rec = (const bf16*)(prw + (size_t)row * 7168) + h * 384;
        const float y = bf2f(((const bf16*)(prw + (size_t)row * 7168 + 6144))[c]);
        const float mean = wave_sum(y) * (1.f / 64.f); const float d = y - mean; const float var = wave_sum(d * d) * (1.f / 64.f);
        const float yn = d * rsqrtf(var + GN_EPS) * F.in[12][c] + F.in[13][c];
        const float r = bf2f(rec[lane]), k = bf2f(rec[128 + lane]), v = bf2f(rec[192 + lane]);
        const float bon = wave_sum(r * k * F.in[11][c]) * v;
        YA[(size_t)row * 512 + c] = f2b((yn + bon) * bf2f(G[(size_t)row * 512 + c])); }
}
__device__ __forceinline__ unsigned sortable(float x) { const unsigned u = __float_as_uint(x); return (u & 0x80000000u) ? ~u : (u | 0x80000000u); }
__device__ __forceinline__ float unsortable(unsigned k) { const unsigned u = (k & 0x80000000u) ? (k & 0x7fffffffu) : ~k; return __uint_as_float(u); }
#define TK_INSERT(L, key_) do { unsigned k_ = (key_); _Pragma("unroll") for (int s_ = 0; s_ < 16; ++s_) { const unsigned hi_ = L[s_] > k_ ? L[s_] : k_; k_ = L[s_] > k_ ? k_ : L[s_]; L[s_] = hi_; } } while (0)
__device__ __forceinline__ void peer_topk_pass(const Frame& F, int wp, LAS float* sc) {
    const int lane = F.lane, r16 = lane & 15, q4 = lane >> 4;
    const bf16* QRY = (const bf16*)(F.ws + WS_PRW);
    int* EID = (int*)(F.ws + WS_PRW + 64 * MiB); float* EG = (float*)(F.ws + WS_PRW + 72 * MiB);
    const int row = lane & 31, part = lane >> 5;
    unsigned L1[16], L2[16];
#pragma unroll
    for (int half = 0; half < 2; ++half) {
        const bf16* SK = (const bf16*)(F.ws + (half ? WS_SK2 : WS_SK1));
#pragma unroll
        for (int mt = 0; mt < 2; ++mt) { const int rho = 32 * wp + 16 * mt + r16;
            const bf16* qp = QRY + (size_t)(rho >> 3) * 2048 + (rho & 7) * 256 + half * 128 + 8 * q4;
            bf16x8 af[4];
#pragma unroll
            for (int s = 0; s < 4; ++s) af[s] = as_bf16x8(*(const v4u*)(qp + 32 * s));
#pragma unroll
            for (int kt = 0; kt < 8; ++kt) { f32x4 acc = {0.f, 0.f, 0.f, 0.f};
#pragma unroll
                for (int s = 0; s < 4; ++s) acc = mfma16(af[s], as_bf16x8(*(const v4u*)(SK + (size_t)(16 * kt + r16) * 128 + 32 * s + 8 * q4)), acc);
#pragma unroll
                for (int r = 0; r < 4; ++r) { const int rw = 16 * mt + 4 * q4 + r; sc[rw * 128 + ((16 * kt + r16) ^ rw)] = acc[r]; } } }
        NSA_FENCE();
        unsigned Ls[16];
#pragma unroll
        for (int s = 0; s < 16; ++s) Ls[s] = 0u;
#pragma unroll 4
        for (int i = 0; i < 64; ++i) { const int c = 64 * part + i; const float x = sc[row * 128 + (c ^ row)];
            TK_INSERT(Ls, (sortable(x) & ~0x7Fu) | (unsigned)(127 - c)); }
        unsigned Lo[16];
#pragma unroll
        for (int s = 0; s < 16; ++s) Lo[s] = (unsigned)__shfl_xor((int)Ls[s], 32);
#pragma unroll
        for (int s = 0; s < 16; ++s) TK_INSERT(Ls, Lo[s]);
#pragma unroll
        for (int s = 0; s < 16; ++s) { if (half == 0) L1[s] = Ls[s]; else L2[s] = Ls[s]; }
        NSA_FENCE();
    }
    float v1[16], v2[16];
#pragma unroll
    for (int s = 0; s < 16; ++s) { v1[s] = unsortable(L1[s]); v2[s] = unsortable(L2[s]); }
    unsigned C[16];
#pragma unroll
    for (int s = 0; s < 16; ++s) C[s] = 0u;
#pragma unroll
    for (int i = 0; i < 16; ++i)
#pragma unroll
        for (int j = 0; j < 16; ++j) if ((i + 1) * (j + 1) <= 16) { TK_INSERT(C, (sortable(v1[i] + v2[j]) & ~0xFFu) | (unsigned)(255 - (16 * i + j))); }
    LAS unsigned* il = (LAS unsigned*)sc;
    if (part == 0) {
#pragma unroll
        for (int s = 0; s < 16; ++s) { il[row * 33 + s] = 127u - (L1[s] & 127u); il[row * 33 + 16 + s] = 127u - (L2[s] & 127u); }
    }
    NSA_FENCE();
    if (part == 0) { const int rho = 32 * wp + row;
        float val[16], e[16]; float sum = 0.f;
#pragma unroll
        for (int s = 0; s < 16; ++s) val[s] = unsortable(C[s]);
#pragma unroll
        for (int s = 0; s < 16; ++s) { e[s] = __expf(val[s] - val[0]); sum += e[s]; }
        const float is = 1.0f / sum;
#pragma unroll
        for (int s = 0; s < 16; ++s) { const unsigned pos = 255u - (C[s] & 255u); const unsigned i = pos >> 4, j = pos & 15u;
            EID[(size_t)rho * 16 + s] = (int)(il[row * 33 + i] * 128u + il[row * 33 + 16 + j]); EG[(size_t)rho * 16 + s] = e[s] * is; }
    }
    NSA_FENCE();
}
__device__ __forceinline__ void peer_gather(const Frame& F) {
    const int lane = F.lane; const int gw = F.vcu * NWAVES + F.wave, NGW = F.G * NWAVES;
    const bf16* H2 = (const bf16*)(F.ws + WS_H);
    const int* EID = (const int*)(F.ws + WS_PRW + 64 * MiB); const float* EG = (const float*)(F.ws + WS_PRW + 72 * MiB);
    const float* U = F.in[31]; const float* V = F.in[32];
    for (int tok = gw; tok < M; tok += NGW) {
        f32x4 hv[4], o[4];
#pragma unroll
        for (int j = 0; j < 4; ++j) { const u32x2 w = *(const u32x2*)(H2 + (size_t)tok * D + 256 * j + 4 * lane); hv[j] = unpk4(w); o[j] = (f32x4){0.f, 0.f, 0.f, 0.f}; }
#pragma unroll 2
        for (int e = 0; e < 128; ++e) { const int id = __builtin_amdgcn_readfirstlane(EID[(size_t)tok * 128 + e]); const float gt = EG[(size_t)tok * 128 + e];
            const f32x4* ur = (const f32x4*)(U + (size_t)id * D) + lane; const f32x4* vr = (const f32x4*)(V + (size_t)id * D) + lane;
            float dot = 0.f;
#pragma unroll
            for (int j = 0; j < 4; ++j) { const f32x4 u4 = ur[64 * j]; dot += (hv[j][0] * u4[0] + hv[j][1] * u4[1]) + (hv[j][2] * u4[2] + hv[j][3] * u4[3]); }
            dot = wave_sum(dot);
            const float cf = gt * 0.5f * dot * (1.f + erff(dot * 0.70710678118654752f));
#pragma unroll
            for (int j = 0; j < 4; ++j) o[j] += cf * vr[64 * j]; }
        float* orow = F.out + (size_t)tok * D;
#pragma unroll
        for (int j = 0; j < 4; ++j) { f32x4* p = (f32x4*)orow + 64 * j + lane; *p = *p + o[j]; }
    }
}
struct Args { const float* in[33]; float* out; unsigned char* ws; int ph_lo, ph_hi; };
__global__ void __launch_bounds__(NWAVES * 64, 2) mk_fwd(Args args) {
    extern __shared__ __attribute__((aligned(16))) unsigned char lds[];
    Frame F;
    F.lds = (LAS unsigned char*)lds;
    F.MISC = (volatile LAS unsigned*)(F.lds + MISC_OFF);
    F.tid = threadIdx.x; F.lane = F.tid & 63; F.wave = __builtin_amdgcn_readfirstlane(F.tid >> 6);
    F.G = gridDim.x; { const int bx = blockIdx.x; F.vcu = (F.G % 8 == 0) ? (bx % 8) * (F.G / 8) + bx / 8 : bx; }
    unsigned char* ws = args.ws; F.ws = ws; F.out = args.out;
    F.ctl = (gu32*)(ws + WS_CTL);
#pragma unroll
    for (int i = 0; i < 33; ++i) F.in[i] = args.in[i];
    for (int u = F.tid; u < (LDS_BYTES - LDSCTL_OFF) / 4; u += NWAVES * 64) ((LAS unsigned*)(F.lds + LDSCTL_OFF))[u] = 0u;
    __syncthreads();
    const int lo = args.ph_lo, hi = args.ph_hi;
    const bool multi = (hi - lo) > 1;
    XcdBarrier bar; bar.bar = (unsigned*)(F.ctl + CW_BAR); bar.x = 0; bar.st = nullptr;
    if (multi) bar = xcd_barrier_post((unsigned*)(F.ctl + CW_BAR), F.MISC + 8);
#define IN(k) (lo <= (k) && (k) < hi)
#define SEAM(k) do { if (IN(k) && IN((k) + 1)) xcd_barrier(bar); } while (0)

    if (IN(0)) { p0_prologue(F); } SEAM(0);
    if (IN(1)) {
        pg8::Gemm g{(const pg8::bf16_t*)(ws + WS_H), (const pg8::bf16_t*)(ws + WS_WIN), M, NG1, D}; pg8::StaticOrder S; S.init(M, NG1, F.G, (int)blockIdx.x);
        pg8::EpiG1 E{(float*)(ws + WS_PRW), (float*)(ws + WS_BND), (pg8::bf16_t*)((unsigned char*)F.out + DO_PNSA), (pg8::bf16_t*)(ws + WS_MG), (float*)((unsigned char*)F.out + DO_GLOG)};
        pg8::gemm_phase<pg8::EpiG1, pg8::StaticOrder, true, true>(F.lds + RING_OFF, g, S, E);
    } SEAM(1);
    if (IN(2)) {
        for (int u = F.vcu; u < 256; u += F.G) { nsa_prep_tile(F, u); rwkv_prep_tile(F, u); compress_unit(F, u); }
    } SEAM(2);
    if (IN(3)) {
        if ((int)blockIdx.x < SCAN_BLOCKS) { for (int sb = blockIdx.x; sb < 64; sb += SCAN_BLOCKS) rwkv_scan_block(F, sb); }
        else nsa_phase(F);
    } SEAM(3);
    if (IN(4)) { rwkv_epilogue(F); } SEAM(4);
    if (IN(5)) {
        { pg8::Gemm g{(const pg8::bf16_t*)(ws + WS_H), (const pg8::bf16_t*)(ws + WS_WA), M, D, 512}; pg8::StaticOrder S; S.init(M, D, F.G, (int)blockIdx.x);
          pg8::EpiGate1 E{(float*)(ws + WS_PRW), (const pg8::bf16_t*)(ws + WS_MG), 0};
          pg8::gemm_phase<pg8::EpiGate1, pg8::StaticOrder, true, true>(F.lds + RING_OFF, g, S, E); }
        VM_WAIT(); __syncthreads();
        { pg8::Gemm g{(const pg8::bf16_t*)(ws + WS_H + 16 * MiB), (const pg8::bf16_t*)(ws + WS_WB), M, D, 512}; pg8::StaticOrder S; S.init(M, D, F.G, (int)blockIdx.x);
          pg8::EpiGate2 E{(const float*)(ws + WS_PRW), (const pg8::bf16_t*)(ws + WS_MG), 1024, (pg8::bf16_t*)(ws + WS_PRW + 64 * MiB)};
          pg8::gemm_phase<pg8::EpiGate2, pg8::StaticOrder, true, true>(F.lds + RING_OFF, g, S, E); }
    } SEAM(5);
    if (IN(6)) {
        pg8::Gemm g{(const pg8::bf16_t*)(ws + WS_PRW + 64 * MiB), (const pg8::bf16_t*)(ws + WS_WOUT), M, D, D}; pg8::StaticOrder S; S.init(M, D, F.G, (int)blockIdx.x);
        pg8::EpiRes E{F.in[0], F.out};
        pg8::gemm_phase<pg8::EpiRes, pg8::StaticOrder, true, true>(F.lds + RING_OFF, g, S, E);
    } SEAM(6);
    if (IN(7)) { const int gw = F.vcu * NWAVES + F.wave, NGW = F.G * NWAVES;
        for (int m = gw; m < M; m += NGW) rms_row_to_bf16(F.lane, F.out + (size_t)m * D, F.in[27], (bf16*)(ws + WS_H) + (size_t)m * D);
    } SEAM(7);
    if (IN(8)) {
        pg8::Gemm g{(const pg8::bf16_t*)(ws + WS_H), (const pg8::bf16_t*)(ws + WS_WQ), M, 2048, D}; pg8::StaticOrder S; S.init(M, 2048, F.G, (int)blockIdx.x);
        pg8::EpiBf16<0> E{(pg8::bf16_t*)(ws + WS_PRW), 2048, nullptr, 0, 0, 1.f};
        pg8::gemm_phase<pg8::EpiBf16<0>, pg8::StaticOrder, true, true>(F.lds + RING_OFF, g, S, E);
    } SEAM(8);
    if (IN(9)) { const int gw = F.vcu * NWAVES + F.wave, NGW = F.G * NWAVES; LAS float* sc = (LAS float*)(F.lds + F.wave * 16384);
        for (int wp = gw; wp < M * 8 / 32; wp += NGW) peer_topk_pass(F, wp, sc);
    } SEAM(9);
    if (IN(10)) { peer_gather(F); }
#undef IN
#undef SEAM
}

extern "C" void kernel_launch(void* const* d_in, const int* in_sizes, int n_in, void* d_out, int out_size, void* d_ws, size_t ws_size, hipStream_t stream) {
    static int grid = 0;
    if (grid == 0) {
        if (n_in != 33 || out_size != M * D || ws_size < WS_END) { fprintf(stderr, "kernel_launch: unexpected shapes (n_in %d out %d ws %zu)\n", n_in, out_size, ws_size); grid = -1; return; }
        int dev = 0, cus = 0, per_cu = 0;
        if (hipGetDevice(&dev) != hipSuccess || hipDeviceGetAttribute(&cus, hipDeviceAttributeMultiprocessorCount, dev) != hipSuccess) { grid = -1; return; }
        if (hipFuncSetAttribute((const void*)mk_fwd, hipFuncAttributeMaxDynamicSharedMemorySize, LDS_BYTES) != hipSuccess) { fprintf(stderr, "kernel_launch: hipFuncSetAttribute failed\n"); grid = -1; return; }
        if (hipOccupancyMaxActiveBlocksPerMultiprocessor(&per_cu, (const void*)mk_fwd, NWAVES * 64, LDS_BYTES) != hipSuccess || per_cu < 1)
            fprintf(stderr, "kernel_launch: occupancy query reports %d blocks per CU\n", per_cu);
        (void)hipGetLastError();
        grid = cus;
        if (grid > 256) grid = 256;
    }
    if (grid < 0) return;
    if (hipMemsetAsync((char*)d_ws + WS_CTL, 0, CTL_ZERO_BYTES, stream) != hipSuccess) return;
    Args a{};
    for (int i = 0; i < 33; ++i) a.in[i] = (const float*)d_in[i];
    a.out = (float*)d_out; a.ws = (unsigned char*)d_ws;
#if MK_ONE_LAUNCH
    a.ph_lo = 0; a.ph_hi = N_PHASES;
    hipLaunchKernelGGL(mk_fwd, dim3(grid), dim3(NWAVES * 64), LDS_BYTES, stream, a);
#else
    for (int p = 0; p < N_PHASES; ++p) { a.ph_lo = p; a.ph_hi = p + 1; hipLaunchKernelGGL(mk_fwd, dim3(grid), dim3(NWAVES * 64), LDS_BYTES, stream, a); }
#endif
}
```

```cpp
#include <hip/hip_runtime.h>
#include <cstdio>
#include <cstdint>
#define MK_ONE_LAUNCH 1
namespace pg8 {
#define PG8_LAS __attribute__((address_space(3)))
typedef unsigned short bf16_t;
typedef short bf16x8 __attribute__((ext_vector_type(8)));
typedef float f32x4 __attribute__((ext_vector_type(4)));
typedef unsigned u32x4 __attribute__((ext_vector_type(4)));
constexpr int BM = 256, BK = 64, HALF = 128, HTB = HALF * BK * 2  , STAGE_BYTES = 8 * HTB, NXCD = 8, WGM = 8;

__host__ __device__ __forceinline__ int lds_byte(int r, int c) { const int st = (r >> 4) * 2 + (c >> 5), rr = r & 15, cc = c & 31, ob = rr * 64 + cc * 2; return st * 1024 + (ob ^ (((ob >> 9) & 1) << 5)); }
__host__ __device__ __forceinline__ void stage_rc(int b, int& R, int& C) { const int st = b / 1024, sb = b % 1024, swz = sb ^ (((sb >> 9) & 1) << 5); R = (st >> 1) * 16 + swz / 64; C = (st & 1) * 32 + (swz % 64) / 2; }
__host__ __device__ __forceinline__ int perm32(int rho) { const int n = rho >> 4, i = rho & 15; return 8 * (i >> 2) + 4 * n + (i & 3); }

struct Unit { int pm, pn; };
struct Gemm { const bf16_t* A; const bf16_t* Bt; int M, N, K; };

struct StaticOrder {
    int nM, nN, nwg, G, c;
    __host__ __device__ void init(int M, int N, int G_, int c_) { nM = M / BM; nN = N / BM; nwg = nM * nN; G = G_; c = c_; }
    __host__ __device__ bool next(int i, Unit& u) const {
        const long L = (long)i * G + c; if (L >= nwg) return false;
        int wgid = (int)L; { const int q = nwg / NXCD, r = nwg % NXCD, xcd = wgid % NXCD, off = wgid / NXCD; wgid = (xcd < r ? xcd * (q + 1) : r * (q + 1) + (xcd - r) * q) + off; }
        const int nig = WGM * nN, gid = wgid / nig, fm = gid * WGM, gsz = (nM - fm) < WGM ? (nM - fm) : WGM;
        u.pm = fm + ((wgid % nig) % gsz); u.pn = (wgid % nig) / gsz; return true;
    }
    __device__ __forceinline__ void a_ready(const Unit&) const {}
    __device__ __forceinline__ void done(const Unit&) const {}
};

__device__ __forceinline__ unsigned cvt_pk_bf16(float lo, float hi) { unsigned r; asm volatile("v_cvt_pk_bf16_f32 %0, %1, %2" : "=v"(r) : "v"(lo), "v"(hi)); return r; }
typedef float f32x2 __attribute__((ext_vector_type(2)));
__device__ __forceinline__ f32x2 gelu_pk(f32x2 v) {
    const f32x2 av = __builtin_elementwise_abs(v), d = av * 0.2316418882f + 1.0f;
    f32x2 t; t.x = __builtin_amdgcn_rcpf(d.x); t.y = __builtin_amdgcn_rcpf(d.y);
    f32x2 q = t * 0.5307027145f + (-0.7265760135f); q = q * t + 0.7107068705f; q = q * t + (-0.142248368f); q = q * t + 0.127414796f; q = q * t;
    const f32x2 s = (v * v) * (-0.72134752044f);
    f32x2 e; e.x = __builtin_amdgcn_exp2f(s.x); e.y = __builtin_amdgcn_exp2f(s.y);
    const f32x2 m = v * (q * e), r = v - m;
    f32x2 o; o.x = v.x < 0.f ? m.x : r.x; o.y = v.y < 0.f ? m.y : r.y; return o;
}

template <int ACT  > struct EpiBf16 {
    static constexpr bool PERM = true, AFTER_DRAIN = false; static_assert(ACT == 0 || ACT == 1, "EpiBf16: ACT is 0 (none) or 1 (gelu_pk)");
    bf16_t* O; int ldc; const float* bias; int split_cols; size_t split_stride; float scale0;
    __device__ __forceinline__ void operator()(const f32x4 (&acc)[2][2][4][2], const Unit& u, int wr, int wc, int fr, int fq) const {
        const int row0 = u.pm * BM + wr * 64 + fr; int colt = u.pn * BM; bf16_t* base = O;
        float sc = 1.f; if (split_cols) { const int t = colt / split_cols; base += (size_t)t * split_stride; colt -= t * split_cols; if (t == 0) sc = scale0; }
        const int col0 = colt + wc * 32 + 8 * fq, bcol0 = u.pn * BM + wc * 32 + 8 * fq;
        f32x4 bv[2][2];
#pragma unroll
        for (int bj = 0; bj < 2; ++bj)
#pragma unroll
            for (int n = 0; n < 2; ++n) bv[bj][n] = bias ? *(const f32x4*)(bias + bcol0 + bj * HALF + 4 * n) : (f32x4){0.f, 0.f, 0.f, 0.f};
#pragma unroll
        for (int ai = 0; ai < 2; ++ai)
#pragma unroll
            for (int m = 0; m < 4; ++m) { bf16_t* rowp = base + (size_t)(row0 + ai * HALF + m * 16) * ldc + col0;
#pragma unroll
                for (int bj = 0; bj < 2; ++bj) { f32x4 v0 = acc[ai][bj][m][0] + bv[bj][0], v1 = acc[ai][bj][m][1] + bv[bj][1];
                    if (ACT == 1) { f32x2 a = gelu_pk((f32x2){v0[0], v0[1]}), b = gelu_pk((f32x2){v0[2], v0[3]}), c = gelu_pk((f32x2){v1[0], v1[1]}), d = gelu_pk((f32x2){v1[2], v1[3]});
                        v0 = (f32x4){a.x, a.y, b.x, b.y}; v1 = (f32x4){c.x, c.y, d.x, d.y}; }
                    v0 = v0 * sc; v1 = v1 * sc; u32x4 w; w.x = cvt_pk_bf16(v0[0], v0[1]); w.y = cvt_pk_bf16(v0[2], v0[3]); w.z = cvt_pk_bf16(v1[0], v1[1]); w.w = cvt_pk_bf16(v1[2], v1[3]);
                    *(u32x4*)(rowp + bj * HALF) = w; } }
    }
};
__device__ __forceinline__ float bf_lo(unsigned w) { return __uint_as_float(w << 16); }
__device__ __forceinline__ float bf_hi(unsigned w) { return __uint_as_float(w & 0xffff0000u); }
__device__ __forceinline__ float sigm(float x) { return 1.0f / (1.0f + __expf(-x)); }
__device__ __forceinline__ u32x4 pack8(const f32x4 v0, const f32x4 v1) { u32x4 w; w.x = cvt_pk_bf16(v0[0], v0[1]); w.y = cvt_pk_bf16(v0[2], v0[3]); w.z = cvt_pk_bf16(v1[0], v1[1]); w.w = cvt_pk_bf16(v1[2], v1[3]); return w; }

struct EpiG1 {
    static constexpr bool PERM = true, AFTER_DRAIN = false;
    float* PRW; float* BND; bf16_t* PNSA; bf16_t* MG; float* GLOG;
    __device__ __forceinline__ void operator()(const f32x4 (&acc)[2][2][4][2], const Unit& u, int wr, int wc, int fr, int fq) const {
        const int row0 = u.pm * BM + wr * 64 + fr, c0 = wc * 32 + 8 * fq;
#pragma unroll
        for (int ai = 0; ai < 2; ++ai)
#pragma unroll
            for (int m = 0; m < 4; ++m) { const int row = row0 + ai * HALF + m * 16;
#pragma unroll
                for (int bj = 0; bj < 2; ++bj) { const f32x4 v0 = acc[ai][bj][m][0], v1 = acc[ai][bj][m][1]; const int col = c0 + bj * HALF;
                    if (u.pn < 7) { float* p = PRW + (size_t)row * 1792 + u.pn * 256 + col; *(f32x4*)p = v0; *(f32x4*)(p + 4) = v1;
                        if ((row & 63) == 63) { float* q = BND + (size_t)(row >> 6) * 1792 + u.pn * 256 + col; *(f32x4*)q = v0; *(f32x4*)(q + 4) = v1; } }
                    else if (u.pn < 12) { *(u32x4*)(PNSA + (size_t)row * 1280 + (u.pn - 7) * 256 + col) = pack8(v0, v1); }
                    else if (u.pn < 20) { *(u32x4*)(MG + (size_t)row * 2048 + (u.pn - 12) * 256 + col) = pack8(v0, v1); }
                    else { if (col < 32) { float* p = GLOG + (size_t)row * 32 + col; *(f32x4*)p = v0; *(f32x4*)(p + 4) = v1; } }
                } }
    }
};
struct EpiGate1 {
    static constexpr bool PERM = true, AFTER_DRAIN = false;
    float* T1; const bf16_t* MG; int goff;
    __device__ __forceinline__ void operator()(const f32x4 (&acc)[2][2][4][2], const Unit& u, int wr, int wc, int fr, int fq) const {
        const int row0 = u.pm * BM + wr * 64 + fr, c0 = u.pn * BM + wc * 32 + 8 * fq;
#pragma unroll
        for (int ai = 0; ai < 2; ++ai)
#pragma unroll
            for (int m = 0; m < 4; ++m) { const int row = row0 + ai * HALF + m * 16;
#pragma unroll
                for (int bj = 0; bj < 2; ++bj) { const f32x4 v0 = acc[ai][bj][m][0], v1 = acc[ai][bj][m][1]; const int col = c0 + bj * HALF;
                    const u32x4 g = *(const u32x4*)(MG + (size_t)row * 2048 + goff + col);
                    f32x4 o0, o1; o0[0] = sigm(bf_lo(g.x)) * v0[0]; o0[1] = sigm(bf_hi(g.x)) * v0[1]; o0[2] = sigm(bf_lo(g.y)) * v0[2]; o0[3] = sigm(bf_hi(g.y)) * v0[3];
                    o1[0] = sigm(bf_lo(g.z)) * v1[0]; o1[1] = sigm(bf_hi(g.z)) * v1[1]; o1[2] = sigm(bf_lo(g.w)) * v1[2]; o1[3] = sigm(bf_hi(g.w)) * v1[3];
                    float* p = T1 + (size_t)row * 1024 + col; *(f32x4*)p = o0; *(f32x4*)(p + 4) = o1; } }
    }
};
struct EpiGate2 {
    static constexpr bool PERM = true, AFTER_DRAIN = false;
    const float* T1; const bf16_t* MG; int goff; bf16_t* MIX;
    __device__ __forceinline__ void operator()(const f32x4 (&acc)[2][2][4][2], const Unit& u, int wr, int wc, int fr, int fq) const {
        const int row0 = u.pm * BM + wr * 64 + fr, c0 = u.pn * BM + wc * 32 + 8 * fq;
#pragma unroll
        for (int ai = 0; ai < 2; ++ai)
#pragma unroll
            for (int m = 0; m < 4; ++m) { const int row = row0 + ai * HALF + m * 16;
#pragma unroll
                for (int bj = 0; bj < 2; ++bj) { const f32x4 v0 = acc[ai][bj][m][0], v1 = acc[ai][bj][m][1]; const int col = c0 + bj * HALF;
                    const u32x4 g = *(const u32x4*)(MG + (size_t)row * 2048 + goff + col);
                    const float* p = T1 + (size_t)row * 1024 + col; const f32x4 t0 = *(const f32x4*)p, t1 = *(const f32x4*)(p + 4);
                    f32x4 o0, o1; o0[0] = t0[0] + sigm(bf_lo(g.x)) * v0[0]; o0[1] = t0[1] + sigm(bf_hi(g.x)) * v0[1]; o0[2] = t0[2] + sigm(bf_lo(g.y)) * v0[2]; o0[3] = t0[3] + sigm(bf_hi(g.y)) * v0[3];
                    o1[0] = t1[0] + sigm(bf_lo(g.z)) * v1[0]; o1[1] = t1[1] + sigm(bf_hi(g.z)) * v1[1]; o1[2] = t1[2] + sigm(bf_lo(g.w)) * v1[2]; o1[3] = t1[3] + sigm(bf_hi(g.w)) * v1[3];
                    *(u32x4*)(MIX + (size_t)row * 1024 + col) = pack8(o0, o1); } }
    }
};
struct EpiRes {
    static constexpr bool PERM = true, AFTER_DRAIN = false;
    const float* X; float* OUT;
    __device__ __forceinline__ void operator()(const f32x4 (&acc)[2][2][4][2], const Unit& u, int wr, int wc, int fr, int fq) const {
        const int row0 = u.pm * BM + wr * 64 + fr, c0 = u.pn * BM + wc * 32 + 8 * fq;
#pragma unroll
        for (int ai = 0; ai < 2; ++ai)
#pragma unroll
            for (int m = 0; m < 4; ++m) { const int row = row0 + ai * HALF + m * 16;
#pragma unroll
                for (int bj = 0; bj < 2; ++bj) { const size_t off = (size_t)row * 1024 + c0 + bj * HALF;
                    const f32x4 x0 = *(const f32x4*)(X + off), x1 = *(const f32x4*)(X + off + 4);
                    *(f32x4*)(OUT + off) = x0 + acc[ai][bj][m][0]; *(f32x4*)(OUT + off + 4) = x1 + acc[ai][bj][m][1]; } }
    }
};
template <class Epi, class Sched, bool ALIGN_EPI = false, bool SP2 = false>
__device__ __forceinline__ void gemm_phase(PG8_LAS unsigned char* lds, const Gemm g, const Sched& S, const Epi& E) {
    const int tid = threadIdx.x, wid = __builtin_amdgcn_readfirstlane(tid >> 6), lane = tid & 63, wr = wid >> 2, wc = wid & 3, fr = lane & 15, fq = lane >> 4;
    const int K = g.K, nt = K / BK;
    unsigned voffA[2], voffB[2];
#pragma unroll
    for (int i = 0; i < 2; ++i) { int R, C; stage_rc(tid * 16 + i * 8192, R, C); const int Rb = Epi::PERM ? ((R & ~31) + perm32(R & 31)) : R;
        voffA[i] = (unsigned)(R * K + C) * 2u; voffB[i] = (unsigned)(Rb * K + C) * 2u; }
    const size_t kstep = (size_t)(BK * 2);
    const size_t hstep = (size_t)HALF * K * 2;
    const size_t tstep = 2 * hstep;
    const unsigned ldsw = (unsigned)wid * 1024u;
    const int aoff = lds_byte(wr * 64 + fr, fq * 8), boff = lds_byte(wc * 32 + fr, fq * 8);
#define PG8_SA(b, h) (((b) * 2 + (h)) * HTB)
#define PG8_SB(b, h) ((4 + (b) * 2 + (h)) * HTB)
#define PG8_STAGE(bufoff, gbase, voff) do { _Pragma("unroll") for (int _i = 0; _i < 2; ++_i) \
        __builtin_amdgcn_global_load_lds((const unsigned*)((const char*)(gbase) + (voff)[_i]), (PG8_LAS unsigned*)(lds + (bufoff) + ldsw + _i * 8192), 16, 0, 0); } while (0)
#define PG8_LDA(dst, b, h) do { _Pragma("unroll") for (int m = 0; m < 4; ++m) _Pragma("unroll") for (int k = 0; k < 2; ++k) dst[m][k] = *(const PG8_LAS bf16x8*)(lds + PG8_SA(b, h) + aoff + m * 2048 + k * 1024); } while (0)
#define PG8_LDB(dst, b, h) do { _Pragma("unroll") for (int n = 0; n < 2; ++n) _Pragma("unroll") for (int k = 0; k < 2; ++k) dst[n][k] = *(const PG8_LAS bf16x8*)(lds + PG8_SB(b, h) + boff + n * 2048 + k * 1024); } while (0)
#define PG8_MMA(ai, bj, At, Bt) do { __builtin_amdgcn_s_setprio(1); _Pragma("unroll") for (int m = 0; m < 4; ++m) _Pragma("unroll") for (int n = 0; n < 2; ++n) _Pragma("unroll") for (int k = 0; k < 2; ++k) \
        acc[ai][bj][m][n] = __builtin_amdgcn_mfma_f32_16x16x32_bf16(Bt[n][k], At[m][k], acc[ai][bj][m][n], 0, 0, 0); __builtin_amdgcn_s_setprio(0); } while (0)
#define PG8_WAIT_V(n) asm volatile("s_waitcnt vmcnt(" #n ")" ::: "memory")
#define PG8_WAIT_L(n) asm volatile("s_waitcnt lgkmcnt(" #n ")" ::: "memory")
#define PG8_BAR __builtin_amdgcn_s_barrier()
#define PG8_SCHED __builtin_amdgcn_sched_barrier(0)
    Unit cur, nxt; int ui = 0;
    if (!S.next(0, cur)) return;
    f32x4 acc[2][2][4][2];
#pragma unroll
    for (int a = 0; a < 2; ++a)
#pragma unroll
        for (int b = 0; b < 2; ++b)
#pragma unroll
            for (int m = 0; m < 4; ++m)
#pragma unroll
                for (int n = 0; n < 2; ++n) acc[a][b][m][n] = (f32x4){0.f, 0.f, 0.f, 0.f};
    bf16x8 At[4][2], B0[2][2], B1[2][2];
    const char* cA = (const char*)g.A + (size_t)cur.pm * tstep; const char* cB = (const char*)g.Bt + (size_t)cur.pn * tstep;
    S.a_ready(cur);
    if constexpr (SP2) {
        PG8_STAGE(PG8_SB(0, 0), cB, voffB); PG8_STAGE(PG8_SB(0, 1), cB + hstep, voffB); PG8_STAGE(PG8_SA(0, 0), cA, voffA); PG8_STAGE(PG8_SA(0, 1), cA + hstep, voffA);
        if (wr == 1) PG8_BAR;
        PG8_WAIT_V(2); PG8_BAR;
        PG8_STAGE(PG8_SB(1, 0), cB + kstep, voffB); PG8_STAGE(PG8_SA(1, 0), cA + kstep, voffA); PG8_STAGE(PG8_SB(1, 1), cB + hstep + kstep, voffB);
        PG8_WAIT_V(6); PG8_BAR;
    } else {
        PG8_STAGE(PG8_SB(0, 0), cB, voffB); PG8_STAGE(PG8_SA(0, 0), cA, voffA); PG8_STAGE(PG8_SB(0, 1), cB + hstep, voffB); PG8_STAGE(PG8_SA(0, 1), cA + hstep, voffA);
        if (wr == 1) PG8_BAR;
        PG8_WAIT_V(4); PG8_BAR;
        PG8_STAGE(PG8_SB(1, 0), cB + kstep, voffB); PG8_STAGE(PG8_SA(1, 0), cA + kstep, voffA); PG8_STAGE(PG8_SB(1, 1), cB + hstep + kstep, voffB);
        PG8_WAIT_V(6); PG8_BAR;
    }
    for (;;) {
        const bool has_next = S.next(ui + 1, nxt);
        const char* nA = has_next ? (const char*)g.A + (size_t)nxt.pm * tstep : cA; const char* nB = has_next ? (const char*)g.Bt + (size_t)nxt.pn * tstep : cB;
        for (int t = 0; t < nt; t += 2) {
            const bool last = (t == nt - 2);
            const char* a1 = cA + (size_t)(t + 1) * kstep;
            const char* a2 = last ? nA : cA + (size_t)(t + 2) * kstep; const char* b2 = last ? nB : cB + (size_t)(t + 2) * kstep;
            const char* a3 = a2 + kstep; const char* b3 = b2 + kstep;
            if (last && has_next) S.a_ready(nxt);
            if constexpr (SP2) {
            PG8_LDB(B0, 0, 0); PG8_LDB(B1, 0, 1); PG8_SCHED; PG8_LDA(At, 0, 0); PG8_STAGE(PG8_SA(1, 1), a1 + hstep, voffA);
            PG8_WAIT_V(8); PG8_WAIT_L(0); PG8_BAR; PG8_MMA(0, 0, At, B0); PG8_MMA(0, 1, At, B1); PG8_BAR; PG8_SCHED;
            PG8_LDA(At, 0, 1); PG8_STAGE(PG8_SB(0, 0), b2, voffB); PG8_STAGE(PG8_SB(0, 1), b2 + hstep, voffB); PG8_STAGE(PG8_SA(0, 0), a2, voffA);
            PG8_WAIT_V(8); PG8_WAIT_L(0); PG8_BAR; PG8_MMA(1, 0, At, B0); PG8_MMA(1, 1, At, B1); PG8_BAR; PG8_SCHED;
            PG8_LDB(B0, 1, 0); PG8_LDB(B1, 1, 1); PG8_SCHED; PG8_LDA(At, 1, 0); PG8_STAGE(PG8_SA(0, 1), a2 + hstep, voffA);
            PG8_WAIT_V(8); PG8_WAIT_L(0); PG8_BAR; PG8_MMA(0, 0, At, B0); PG8_MMA(0, 1, At, B1); PG8_BAR; PG8_SCHED;
            PG8_LDA(At, 1, 1); PG8_STAGE(PG8_SB(1, 0), b3, voffB); PG8_STAGE(PG8_SB(1, 1), b3 + hstep, voffB); PG8_STAGE(PG8_SA(1, 0), a3, voffA);
            PG8_WAIT_V(8); PG8_WAIT_L(0); PG8_BAR; PG8_MMA(1, 0, At, B0); PG8_MMA(1, 1, At, B1); PG8_BAR; PG8_SCHED;
            } else {
            PG8_LDB(B0, 0, 0); PG8_SCHED; PG8_LDA(At, 0, 0); PG8_STAGE(PG8_SA(1, 1), a1 + hstep, voffA);
            PG8_WAIT_L(8); PG8_BAR; PG8_WAIT_L(0); PG8_MMA(0, 0, At, B0); PG8_BAR; PG8_SCHED;
            PG8_LDB(B1, 0, 1); PG8_STAGE(PG8_SB(0, 0), b2, voffB);
            PG8_BAR; PG8_WAIT_L(0); PG8_MMA(0, 1, At, B1); PG8_BAR;
            PG8_LDA(At, 0, 1); PG8_STAGE(PG8_SA(0, 0), a2, voffA);
            PG8_BAR; PG8_WAIT_L(0); PG8_MMA(1, 0, At, B0); PG8_BAR; PG8_SCHED;
            PG8_STAGE(PG8_SB(0, 1), b2 + hstep, voffB);
            PG8_WAIT_V(6); PG8_BAR; PG8_MMA(1, 1, At, B1); PG8_BAR;
            PG8_LDB(B0, 1, 0); PG8_SCHED; PG8_LDA(At, 1, 0); PG8_STAGE(PG8_SA(0, 1), a2 + hstep, voffA);
            PG8_WAIT_L(8); PG8_BAR; PG8_WAIT_L(0); PG8_MMA(0, 0, At, B0); PG8_BAR; PG8_SCHED;
            PG8_LDB(B1, 1, 1); PG8_STAGE(PG8_SB(1, 0), b3, voffB);
            PG8_BAR; PG8_WAIT_L(0); PG8_MMA(0, 1, At, B1); PG8_BAR;
            PG8_LDA(At, 1, 1); PG8_STAGE(PG8_SA(1, 0), a3, voffA);
            PG8_BAR; PG8_WAIT_L(0); PG8_MMA(1, 0, At, B0); PG8_BAR; PG8_SCHED;
            PG8_STAGE(PG8_SB(1, 1), b3 + hstep, voffB);
            PG8_WAIT_V(6); PG8_BAR; PG8_MMA(1, 1, At, B1); PG8_BAR;
            }
        }
        if constexpr (ALIGN_EPI) { if (wr == 0) PG8_BAR; }
        if constexpr (!Epi::AFTER_DRAIN) { E(acc, cur, wr, wc, fr, fq); S.done(cur); }
        if (!has_next) break;
#pragma unroll
        for (int a = 0; a < 2; ++a)
#pragma unroll
            for (int b = 0; b < 2; ++b)
#pragma unroll
                for (int m = 0; m < 4; ++m)
#pragma unroll
                    for (int n = 0; n < 2; ++n) acc[a][b][m][n] = (f32x4){0.f, 0.f, 0.f, 0.f};
        cur = nxt; cA = nA; cB = nB; ++ui;
        if constexpr (ALIGN_EPI) { if (wr == 1) PG8_BAR; }
    }
    PG8_WAIT_V(0);
    if constexpr (!ALIGN_EPI) { if (wr == 0) PG8_BAR; }
    PG8_BAR;
    if constexpr (Epi::AFTER_DRAIN) { E.fused(acc, cur, wr, wc, fr, fq, lds, wid, lane); S.done(cur); }
#undef PG8_SA
#undef PG8_SB
#undef PG8_STAGE
#undef PG8_LDA
#undef PG8_LDB
#undef PG8_MMA
#undef PG8_WAIT_V
#undef PG8_WAIT_L
#undef PG8_BAR
#undef PG8_SCHED
}
}
#define GAS __attribute__((address_space(1)))
#define LAS __attribute__((address_space(3)))
typedef unsigned short bf16;
typedef unsigned v4u __attribute__((ext_vector_type(4)));
typedef float f32x4 __attribute__((ext_vector_type(4)));
typedef short bf16x8 __attribute__((ext_vector_type(8)));
typedef GAS unsigned gu32;
typedef GAS unsigned long long gu64;
#define RLX_AGENT __ATOMIC_RELAXED, __HIP_MEMORY_SCOPE_AGENT
#define LDS_WAIT() asm volatile("s_waitcnt lgkmcnt(0)" ::: "memory")
#define VM_WAIT() asm volatile("s_waitcnt vmcnt(0)" ::: "memory")
__device__ __forceinline__ unsigned long long rt() { return __builtin_amdgcn_s_memrealtime(); }
__device__ __forceinline__ unsigned f2bf(float f) { unsigned u = __builtin_bit_cast(unsigned, f); return (u + 0x7fffu + ((u >> 16) & 1u)) >> 16; }
__device__ __forceinline__ unsigned pk2(float lo, float hi) { return f2bf(lo) | (f2bf(hi) << 16); }

#define XB_TMO      128
#define XB_XCNT(j)  (256  + 64 * (j))
#define XB_XSUB(j)  (1280 + 64 * (j))
#define XB_XGEN(j)  (2304 + 64 * (j))
#define XB_TOP      3328
#define XB_TOPGEN   3392
#define XCD_BAR_WORDS 3456
#define XB_SPIN_CAP (1u << 18)

__device__ __forceinline__ unsigned xb_ld(unsigned* p)              { return __hip_atomic_load(p, __ATOMIC_RELAXED, __HIP_MEMORY_SCOPE_AGENT); }
__device__ __forceinline__ unsigned xb_add(unsigned* p, unsigned v) { return __hip_atomic_fetch_add(p, v, __ATOMIC_RELAXED, __HIP_MEMORY_SCOPE_AGENT); }
__device__ __forceinline__ unsigned xb_xcc_id() { return (unsigned)__builtin_amdgcn_s_getreg((3 << 11) | 20) & 0xFu; }
#define XB_SPIN(cond, bar) do { unsigned _sp = 0; while (cond) { __builtin_amdgcn_s_sleep(1); \
    if ((++_sp & 255u) == 0u) { if (xb_ld(&(bar)[XB_TMO])) break; if (_sp > XB_SPIN_CAP) { atomicAdd(&(bar)[XB_TMO], 1u); break; } } } } while (0)

struct XcdBarrier {
    unsigned* bar; unsigned x;
    volatile LAS unsigned* st;
};

__device__ __forceinline__ XcdBarrier xcd_barrier_post(unsigned* bar, volatile LAS unsigned* st) {
    XcdBarrier b; b.bar = bar; b.x = xb_xcc_id(); b.st = st;
    if (threadIdx.x == 0) (void)xb_add(&bar[XB_XCNT(b.x)], 1u);
    return b;
}
__device__ __forceinline__ void xcd_barrier_complete(unsigned* bar, unsigned x, unsigned& nloc, unsigned& nx) {
    const unsigned G = gridDim.x * gridDim.y * gridDim.z;
    unsigned sum, cnt, mine, sp = 0u;
    for (;;) {
        sum = 0u; cnt = 0u; mine = 0u;
#pragma unroll
        for (unsigned j = 0; j < 16; ++j) { const unsigned c = xb_ld(&bar[XB_XCNT(j)]); sum += c; cnt += (c > 0u) ? 1u : 0u; mine = (j == x) ? c : mine; }
        if (sum == G) break;
        __builtin_amdgcn_s_sleep(1);
        if ((++sp & 255u) == 0u) { if (xb_ld(&bar[XB_TMO])) break; if (sp > XB_SPIN_CAP) { atomicAdd(&bar[XB_TMO], 1u); break; } }
    }
    nloc = mine > 0u ? mine : 1u; nx = cnt > 0u ? cnt : 1u;
}

__device__ __forceinline__ void xcd_barrier(const XcdBarrier& b) {
    asm volatile("s_waitcnt vmcnt(0)" ::: "memory");
    __syncthreads();
    if (threadIdx.x == 0) {
        unsigned* bar = b.bar;
        __builtin_amdgcn_s_waitcnt(0);
        unsigned nloc = b.st[0], nx = b.st[1];
        if (nloc == 0u) { xcd_barrier_complete(bar, b.x, nloc, nx); b.st[0] = nloc; b.st[1] = nx; }
        const unsigned old = xb_add(&bar[XB_XSUB(b.x)], 1u);
        const unsigned gen = old / nloc;
        if (old + 1u == (gen + 1u) * nloc) {
            __builtin_amdgcn_fence(__ATOMIC_RELEASE, "agent");
            asm volatile("s_waitcnt vmcnt(0)" ::: "memory");
            const unsigned og = xb_add(&bar[XB_TOP], 1u);
            const unsigned tg = og / nx;
            if (og + 1u == (tg + 1u) * nx) xb_add(&bar[XB_TOPGEN], 1u);
            else XB_SPIN(xb_ld(&bar[XB_TOPGEN]) == tg, bar);
            __builtin_amdgcn_fence(__ATOMIC_ACQUIRE, "agent");
            xb_add(&bar[XB_XGEN(b.x)], 1u);
            asm volatile("s_waitcnt vmcnt(0)" ::: "memory");
        } else {
            XB_SPIN(xb_ld(&bar[XB_XGEN(b.x)]) == gen, bar);
            __builtin_amdgcn_fence(__ATOMIC_ACQUIRE, "agent");
            asm volatile("s_waitcnt vmcnt(0)" ::: "memory");
        }
    }
    __syncthreads();
}
constexpr int NWAVES = 8;
constexpr int BATCH = 4, T = 4096, D = 1024, M = BATCH * T;
constexpr int RWC = 1792;
constexpr int NG1 = 5376;
constexpr float NORM_EPS = 1e-6f, GN_EPS = 64e-5f;
constexpr float LOG2E = 1.4426950408889634f;
constexpr int N_PHASES = 11;
#ifndef MK_ONE_LAUNCH
#define MK_ONE_LAUNCH 0
#endif
#ifndef SCAN_BLOCKS
#define SCAN_BLOCKS 64
#endif

constexpr size_t MiB = 1u << 20;
constexpr size_t WS_CTL = 0, CTL_ZERO_BYTES = 1 * MiB;
constexpr size_t WS_WIN = 1 * MiB;
constexpr size_t WS_WA = 12 * MiB, WS_WB = 13 * MiB;
constexpr size_t WS_WOUT = 14 * MiB;
constexpr size_t WS_WQ = 16 * MiB;
constexpr size_t WS_CW1K = 20 * MiB, WS_CW1V = 21 * MiB;
constexpr size_t WS_CW2K = 22 * MiB, WS_CW2V = 22 * MiB + 65536;
constexpr size_t WS_SK1 = 22 * MiB + 131072, WS_SK2 = 22 * MiB + 196608;
constexpr size_t WS_BND = 23 * MiB;
constexpr size_t WS_KC = 25 * MiB;
constexpr size_t WS_VCT = 25 * MiB + 262144;
constexpr size_t WS_H = 26 * MiB;
constexpr size_t WS_PRW = 58 * MiB;
constexpr size_t WS_MG = 170 * MiB;
constexpr size_t WS_VST = 234 * MiB, WS_VWT = 238 * MiB;
constexpr size_t WS_END = 256 * MiB;
constexpr size_t DO_PNSA = 0, DO_G = 40 * MiB, DO_GLOG = 56 * MiB;
constexpr int CW_TMO = 0, CW_CODE = 1, CW_NSAQ = 64, CW_BAR = 4096;

constexpr int RING_OFF = 0, RING_BYTES = 131072;
constexpr int LDSCTL_OFF = RING_BYTES, MISC_OFF = LDSCTL_OFF + 320;
constexpr int LDS_BYTES = 147456;
typedef unsigned short u16;
typedef unsigned u32x2 __attribute__((ext_vector_type(2)));
struct Frame {
    LAS unsigned char* lds;
    volatile LAS unsigned* MISC;
    gu32* ctl;
    int tid, lane, wave, vcu, G;
    const float* in[33];
    float* out; unsigned char* ws;
};
__device__ __forceinline__ float wave_sum(float v) {
#pragma unroll
    for (int o = 1; o < 64; o <<= 1) v += __shfl_xor(v, o);
    return v;
}
__device__ __forceinline__ float bf2f(u16 b) { return __uint_as_float((unsigned)b << 16); }
__device__ __forceinline__ float bflo(unsigned w) { return __uint_as_float(w << 16); }
__device__ __forceinline__ float bfhi(unsigned w) { return __uint_as_float(w & 0xffff0000u); }
__device__ __forceinline__ u16 f2b(float f) { return (u16)f2bf(f); }
__device__ __forceinline__ float sigmf(float x) { return 1.0f / (1.0f + __expf(-x)); }
__device__ __forceinline__ f32x4 mfma16(const bf16x8 a, const bf16x8 b, const f32x4 c) { return __builtin_amdgcn_mfma_f32_16x16x32_bf16(a, b, c, 0, 0, 0); }
__device__ __forceinline__ bf16x8 as_bf16x8(const v4u v) { return __builtin_bit_cast(bf16x8, v); }

__device__ __forceinline__ void tr_item(const float* W, int K, int ldw, int sc0, int nblk, int ncols_valid, bf16* WT, int dr0, LAS float* scr, int item, int lane) {
    const int kb = item / nblk, nb = item % nblk, k0 = 64 * kb, n0 = 32 * nb;
#pragma unroll 8
    for (int i = 0; i < 32; ++i) { const int kk = 2 * i + (lane >> 5); const int n = n0 + (lane & 31);
        scr[kk * 33 + (lane & 31)] = (n < ncols_valid) ? W[(size_t)(k0 + kk) * ldw + sc0 + n] : 0.f; }
    LDS_WAIT(); asm volatile("" ::: "memory");
    const int c = lane & 7;
#pragma unroll
    for (int j = 0; j < 4; ++j) { const int n = (lane >> 3) + 8 * j; const LAS float* s = scr + (8 * c) * 33 + n;
        v4u o; o.x = pk2(s[0 * 33], s[1 * 33]); o.y = pk2(s[2 * 33], s[3 * 33]); o.z = pk2(s[4 * 33], s[5 * 33]); o.w = pk2(s[6 * 33], s[7 * 33]);
        *(GAS v4u*)(WT + (size_t)(dr0 + n0 + n) * K + k0 + 8 * c) = o; }
    LDS_WAIT(); asm volatile("" ::: "memory");
}
__device__ __forceinline__ void rms_row_to_bf16(int lane, const float* xrow, const float* gain, bf16* orow) {
    const GAS f32x4* xr = (const GAS f32x4*)xrow + lane; const GAS f32x4* gr = (const GAS f32x4*)gain + lane;
    f32x4 v[4]; float s2 = 0.f;
#pragma unroll
    for (int j = 0; j < 4; ++j) { v[j] = xr[64 * j]; s2 += (v[j].x * v[j].x + v[j].y * v[j].y) + (v[j].z * v[j].z + v[j].w * v[j].w); }
    const float rstd = 1.f / sqrtf(wave_sum(s2) * (1.f / D) + NORM_EPS);
    GAS unsigned long long* o8 = (GAS unsigned long long*)orow + lane;
#pragma unroll
    for (int j = 0; j < 4; ++j) { const f32x4 g = gr[64 * j];
        o8[64 * j] = (unsigned long long)pk2(v[j].x * rstd * g.x, v[j].y * rstd * g.y) | ((unsigned long long)pk2(v[j].z * rstd * g.z, v[j].w * rstd * g.w) << 32); }
}
__device__ __forceinline__ void p0_prologue(const Frame& F) {
    LAS float* scr = (LAS float*)(F.lds + RING_OFF + F.wave * 16384);
    const int gw = F.vcu * NWAVES + F.wave, NGW = F.G * NWAVES;
    unsigned char* ws = F.ws;
    constexpr int I0 = 16 * 96, I1 = 16 * 64, I2 = 16 * 8, I3 = 8 * 32, I4 = 8 * 32, I5 = 16 * 32, I6 = 16 * 64, I7 = 32 * 8, I8 = 32 * 8, I9 = 4 * 2, I10 = 4 * 2;
    constexpr int NITEMS = I0 + I1 + I2 + I3 + I4 + I5 + I6 + I7 + I8 + I9 + I10;
    for (int it = gw; it < NITEMS; it += NGW) {
        int r = it;
        if (r < I0) { tr_item(F.in[2], 1024, 5144, 0, 96, 3072, (bf16*)(ws + WS_WIN), 0, scr, r, F.lane); continue; } r -= I0;
        if (r < I1) { tr_item(F.in[2], 1024, 5144, 3096, 64, 2048, (bf16*)(ws + WS_WIN), 3072, scr, r, F.lane); continue; } r -= I1;
        if (r < I2) { tr_item(F.in[2], 1024, 5144, 3072, 8, 24, (bf16*)(ws + WS_WIN), 5120, scr, r, F.lane); continue; } r -= I2;
        if (r < I3) { tr_item(F.in[24], 512, 1024, 0, 32, 1024, (bf16*)(ws + WS_WA), 0, scr, r, F.lane); continue; } r -= I3;
        if (r < I4) { tr_item(F.in[25], 512, 1024, 0, 32, 1024, (bf16*)(ws + WS_WB), 0, scr, r, F.lane); continue; } r -= I4;
        if (r < I5) { tr_item(F.in[26], 1024, 1024, 0, 32, 1024, (bf16*)(ws + WS_WOUT), 0, scr, r, F.lane); continue; } r -= I5;
        if (r < I6) { tr_item(F.in[28], 1024, 2048, 0, 64, 2048, (bf16*)(ws + WS_WQ), 0, scr, r, F.lane); continue; } r -= I6;
        if (r < I7) { tr_item(F.in[20], 2048, 256, 0, 8, 256, (bf16*)(ws + WS_CW1K), 0, scr, r, F.lane); continue; } r -= I7;
        if (r < I8) { tr_item(F.in[22], 2048, 256, 0, 8, 256, (bf16*)(ws + WS_CW1V), 0, scr, r, F.lane); continue; } r -= I8;
        if (r < I9) { tr_item(F.in[21], 256, 64, 0, 2, 64, (bf16*)(ws + WS_CW2K), 0, scr, r, F.lane); continue; } r -= I9;
        tr_item(F.in[23], 256, 64, 0, 2, 64, (bf16*)(ws + WS_CW2V), 0, scr, r, F.lane);
    }
    { const int gt = F.vcu * (NWAVES * 64) + F.tid, NT = F.G * NWAVES * 64;
      bf16* s1 = (bf16*)(ws + WS_SK1); bf16* s2 = (bf16*)(ws + WS_SK2);
      for (int i = gt; i < 128 * 128; i += NT) { s1[i] = f2b(F.in[29][i]); s2[i] = f2b(F.in[30][i]); } }
    for (int m = gw; m < M; m += NGW) rms_row_to_bf16(F.lane, F.in[0] + (size_t)m * D, F.in[1], (bf16*)(ws + WS_H) + (size_t)m * D);
}
__device__ __forceinline__ void rwkv_prep_tile(const Frame& F, int u) {
    const int tid = F.tid, lane = F.lane, h = F.wave;
    const int R0 = 64 * u, t0 = R0 & (T - 1);
    LAS float* lin = (LAS float*)(F.lds);
    float* PRW = (float*)(F.ws + WS_PRW);
    const float* BND = (const float*)(F.ws + WS_BND);
    bf16* G = (bf16*)((unsigned char*)F.out + DO_G);
    const float* mu = F.in[3];
    const float mu_r = mu[tid], mu_k = mu[512 + tid], mu_v = mu[1024 + tid], mu_l = (tid < 256) ? mu[1536 + tid] : 0.f;
    const float w0c = F.in[4][tid], a0c = F.in[6][tid], kkc = F.in[9][tid], kac = F.in[10][tid];
    const float* w_up = F.in[5]; const float* a_up = F.in[7]; const float* g_up = F.in[8];
    float pr = 0.f, pk = 0.f, pv = 0.f, pl = 0.f;
    if (t0 != 0) { const float* b = BND + (size_t)(u - 1) * RWC; pr = b[tid]; pk = b[512 + tid]; pv = b[1024 + tid]; if (tid < 256) pl = b[1536 + tid]; }
    for (int batch = 0; batch < 4; ++batch) {
        const int Rb = R0 + 16 * batch;
        float xr[16], xk[16], xv[16], xl[16];
#pragma unroll
        for (int j = 0; j < 16; ++j) { const float* p = PRW + (size_t)(Rb + j) * RWC; xr[j] = p[tid]; xk[j] = p[512 + tid]; xv[j] = p[1024 + tid]; xl[j] = (tid < 256) ? p[1536 + tid] : 0.f; }
        VM_WAIT();
#pragma unroll
        for (int j = 0; j < 16; ++j) { float n;
            n = xr[j]; xr[j] = n + (pr - n) * mu_r; pr = n;
            n = xk[j]; xk[j] = n + (pk - n) * mu_k; pk = n;
            n = xv[j]; xv[j] = n + (pv - n) * mu_v; pv = n;
            n = xl[j]; xl[j] = n + (pl - n) * mu_l; pl = n; }
        if (tid < 256) {
#pragma unroll
            for (int j = 0; j < 16; ++j) { const float v = xl[j]; const float f = (tid < 64) ? tanhf(v) : ((tid < 128) ? v : sigmf(v)); lin[tid * 16 + j] = f; }
        }
        __syncthreads();
        float accw[16], acca[16], accg[16];
#pragma unroll
        for (int j = 0; j < 16; ++j) { accw[j] = 0.f; acca[j] = 0.f; accg[j] = 0.f; }
#pragma unroll 2
        for (int jj = 0; jj < 64; ++jj) { const float wv = w_up[jj * 512 + tid], av = a_up[jj * 512 + tid];
            const LAS f32x4* iw = (const LAS f32x4*)(lin + jj * 16); const LAS f32x4* ia = (const LAS f32x4*)(lin + (64 + jj) * 16);
#pragma unroll
            for (int q = 0; q < 4; ++q) { const f32x4 a = iw[q], b = ia[q];
#pragma unroll
                for (int e = 0; e < 4; ++e) { accw[4 * q + e] += a[e] * wv; acca[4 * q + e] += b[e] * av; } } }
#pragma unroll 2
        for (int jj = 0; jj < 128; ++jj) { const float gv = g_up[jj * 512 + tid];
            const LAS f32x4* ig = (const LAS f32x4*)(lin + (128 + jj) * 16);
#pragma unroll
            for (int q = 0; q < 4; ++q) { const f32x4 a = ig[q];
#pragma unroll
                for (int e = 0; e < 4; ++e) accg[4 * q + e] += a[e] * gv; } }
#pragma unroll
        for (int j = 0; j < 16; ++j) { const int row = Rb + j;
            const float z = -(w0c + accw[j]); const float sp = fmaxf(z, 0.f) + log1pf(__expf(-fabsf(z)));
            const float e = __expf(-sp - 0.5f); const float omw = -expm1f(-e);
            const float a = sigmf(a0c + acca[j]);
            const float kkv = xk[j] * kkc, kmod = xk[j] * (1.f + (a - 1.f) * kac);
            const float ss = wave_sum(kkv * kkv); const float kkn = kkv / fmaxf(sqrtf(ss), 1e-12f);
            bf16* rec = (bf16*)(PRW + (size_t)row * RWC) + h * 384;
            rec[lane] = f2b(xr[j]); rec[64 + lane] = f2b(omw); rec[128 + lane] = f2b(kmod); rec[192 + lane] = f2b(xv[j]); rec[256 + lane] = f2b(kkn); rec[320 + lane] = f2b(a);
            G[(size_t)row * 512 + tid] = f2b(accg[j]); }
        __syncthreads();
    }
}
__device__ __forceinline__ void nsa_prep_tile(const Frame& F, int u) {
    const int lane = F.lane, w = F.wave;
    const int R0 = 64 * u, t0 = R0 & (T - 1), b = R0 / T;
    bf16* PNSA = (bf16*)((unsigned char*)F.out + DO_PNSA);
    const float qg = F.in[14][lane] * (0.125f * LOG2E);
    const float kg = (w < 2) ? F.in[16][lane] : F.in[17][lane];
    const int kcol = ((w < 2) ? 768 : 1024) + (w & 1) * 64 + lane;
    for (int tok = 0; tok < 64; ++tok) { bf16* p = PNSA + (size_t)(R0 + tok) * 1280;
        const float q = bf2f(p[w * 64 + lane]); const float ss = wave_sum(q * q) * (1.f / 64.f);
        float k = 0.f; if (w < 4) k = bf2f(p[kcol]);
        const float ks = wave_sum(k * k) * (1.f / 64.f);
        p[w * 64 + lane] = f2b(q * rsqrtf(ss + NORM_EPS) * qg);
        if (w < 4) p[kcol] = f2b(k * rsqrtf(ks + NORM_EPS) * kg); }
    if (w >= 4) {
        const int g = w & 1; const int scol = ((w < 6) ? 896 : 1152) + g * 64;
        bf16* VT = (bf16*)(F.ws + ((w < 6) ? WS_VST : WS_VWT)) + (size_t)((b * 2 + g) * 64) * T + t0 + lane;
        const v4u* src = (const v4u*)(PNSA + (size_t)(R0 + lane) * 1280 + scol);
        v4u v[8];
#pragma unroll
        for (int i = 0; i < 8; ++i) v[i] = src[i];
#pragma unroll
        for (int i = 0; i < 8; ++i) {
            VT[(size_t)(8 * i + 0) * T] = (u16)(v[i].x & 0xffffu); VT[(size_t)(8 * i + 1) * T] = (u16)(v[i].x >> 16);
            VT[(size_t)(8 * i + 2) * T] = (u16)(v[i].y & 0xffffu); VT[(size_t)(8 * i + 3) * T] = (u16)(v[i].y >> 16);
            VT[(size_t)(8 * i + 4) * T] = (u16)(v[i].z & 0xffffu); VT[(size_t)(8 * i + 5) * T] = (u16)(v[i].z >> 16);
            VT[(size_t)(8 * i + 6) * T] = (u16)(v[i].w & 0xffffu); VT[(size_t)(8 * i + 7) * T] = (u16)(v[i].w >> 16); }
    }
}
__device__ __forceinline__ float gelu_tanh(float x) { const float t = 0.7978845608028654f * (x + 0.044715f * x * x * x); return 0.5f * x * (1.f + tanhf(t)); }
__device__ __forceinline__ void compress_unit(const Frame& F, int u) {
    const int lane = F.lane, w = F.wave, r16 = lane & 15, q4 = lane >> 4;
    const int kvsel = u >> 7, b = (u >> 5) & 3, g = (u >> 4) & 1, ntile = u & 15;
    const bf16* X = (const bf16*)((unsigned char*)F.out + DO_PNSA) + (size_t)(b * T) * 1280 + (kvsel ? 640 : 512) + g * 64;
    const float* pos = kvsel ? F.in[19] : F.in[18];
    const bf16* W1t = (const bf16*)(F.ws + (kvsel ? WS_CW1V : WS_CW1K));
    const bf16* W2t = (const bf16*)(F.ws + (kvsel ? WS_CW2V : WS_CW2K));
    LAS bf16* hid = (LAS bf16*)(F.lds);
    LAS float* outb = (LAS float*)(F.lds + 16 * 528);
    int n = 16 * ntile + r16; if (n > 254) n = 254;
    f32x4 acc[2] = {{0.f, 0.f, 0.f, 0.f}, {0.f, 0.f, 0.f, 0.f}};
#pragma unroll 4
    for (int s = 0; s < 64; ++s) { const int lp = s >> 1, d0 = (s & 1) * 32 + 8 * q4;
        const v4u xa = *(const v4u*)(X + (size_t)(16 * n + lp) * 1280 + d0);
        const f32x4 p0 = *(const f32x4*)(pos + lp * 64 + d0), p1 = *(const f32x4*)(pos + lp * 64 + d0 + 4);
        v4u af; af.x = pk2(bflo(xa.x) + p0[0], bfhi(xa.x) + p0[1]); af.y = pk2(bflo(xa.y) + p0[2], bfhi(xa.y) + p0[3]);
        af.z = pk2(bflo(xa.z) + p1[0], bfhi(xa.z) + p1[1]); af.w = pk2(bflo(xa.w) + p1[2], bfhi(xa.w) + p1[3]);
#pragma unroll
        for (int nt = 0; nt < 2; ++nt) { const v4u bfg = *(const v4u*)(W1t + (size_t)(32 * w + 16 * nt + r16) * 2048 + 32 * s + 8 * q4);
            acc[nt] = mfma16(as_bf16x8(af), as_bf16x8(bfg), acc[nt]); } }
#pragma unroll
    for (int nt = 0; nt < 2; ++nt)
#pragma unroll
        for (int r = 0; r < 4; ++r) hid[(4 * q4 + r) * 264 + 32 * w + 16 * nt + r16] = f2b(gelu_tanh(acc[nt][r]));
    __syncthreads();
    if (w < 4) { f32x4 a2 = {0.f, 0.f, 0.f, 0.f};
#pragma unroll
        for (int s = 0; s < 8; ++s) { const v4u af = *(const LAS v4u*)(hid + r16 * 264 + 32 * s + 8 * q4);
            const v4u bfg = *(const v4u*)(W2t + (size_t)(16 * w + r16) * 256 + 32 * s + 8 * q4);
            a2 = mfma16(as_bf16x8(af), as_bf16x8(bfg), a2); }
#pragma unroll
        for (int r = 0; r < 4; ++r) outb[(4 * q4 + r) * 64 + 16 * w + r16] = a2[r]; }
    __syncthreads();
#pragma unroll
    for (int rr = 0; rr < 2; ++rr) { const int row = 2 * w + rr; const int nn = 16 * ntile + row; float val = outb[row * 64 + lane];
        if (kvsel == 0) { const float ss = wave_sum(val * val) * (1.f / 64.f); val = val * rsqrtf(ss + NORM_EPS) * F.in[15][lane];
            ((bf16*)(F.ws + WS_KC))[(size_t)((b * 2 + g) * 256 + nn) * 64 + lane] = (nn < 255) ? f2b(val) : (u16)0; }
        else ((bf16*)(F.ws + WS_VCT))[(size_t)((b * 2 + g) * 64 + lane) * 256 + nn] = (nn < 255) ? f2b(val) : (u16)0; }
    __syncthreads();
}
struct KFr { bf16x8 a0, a1, b0, b1; };
__device__ __forceinline__ KFr load_k(const bf16* Kb, int rstride, int k0, int r16, int q4) {
    const int keyA = k0 + 8 * (r16 >> 2) + (r16 & 3);
    const bf16* pa = Kb + (size_t)keyA * rstride + 8 * q4; const bf16* pb = pa + (size_t)4 * rstride;
    KFr f; f.a0 = as_bf16x8(*(const v4u*)pa); f.a1 = as_bf16x8(*(const v4u*)(pa + 32)); f.b0 = as_bf16x8(*(const v4u*)pb); f.b1 = as_bf16x8(*(const v4u*)(pb + 32)); return f;
}
struct VFr { bf16x8 v[4]; };
__device__ __forceinline__ VFr load_v(const bf16* Vt, int dstride, int k0, int r16, int q4) {
    VFr f;
#pragma unroll
    for (int dt = 0; dt < 4; ++dt) f.v[dt] = as_bf16x8(*(const v4u*)(Vt + (size_t)(16 * dt + r16) * dstride + k0 + 8 * q4));
    return f;
}
__device__ __forceinline__ bf16x8 pack_p(const f32x4 a, const f32x4 b) {
    v4u w; w.x = pg8::cvt_pk_bf16(a[0], a[1]); w.y = pg8::cvt_pk_bf16(a[2], a[3]); w.z = pg8::cvt_pk_bf16(b[0], b[1]); w.w = pg8::cvt_pk_bf16(b[2], b[3]); return as_bf16x8(w);
}
#define NSA_FENCE() asm volatile("s_waitcnt lgkmcnt(0)" ::: "memory")
__device__ __forceinline__ void nsa_wave_unit(const Frame& F, int b, int g, int t0, LAS float* wl) {
    const int lane = F.lane, r16 = lane & 15, q4 = lane >> 4;
    const f32x4 Z4 = {0.f, 0.f, 0.f, 0.f};
    const bf16* PN = (const bf16*)((unsigned char*)F.out + DO_PNSA) + (size_t)(b * T) * 1280;
    const float* GL = (const float*)((unsigned char*)F.out + DO_GLOG) + (size_t)(b * T) * 32;
    LAS float* impT = wl; LAS float* imp2T = wl + 8 * 65; LAS unsigned* selT = (LAS unsigned*)(wl + 16 * 65);
    bf16x8 qf[2][2]; int tq[2];
#pragma unroll
    for (int mt = 0; mt < 2; ++mt) { tq[mt] = t0 + 4 * mt + (r16 >> 2);
#pragma unroll
        for (int dh = 0; dh < 2; ++dh) qf[mt][dh] = as_bf16x8(*(const v4u*)(PN + (size_t)tq[mt] * 1280 + (g * 4 + (r16 & 3)) * 64 + 32 * dh + 8 * q4)); }
    f32x4 Oc[2][4];
#pragma unroll
    for (int mt = 0; mt < 2; ++mt)
#pragma unroll
        for (int dt = 0; dt < 4; ++dt) Oc[mt][dt] = Z4;
    float gate[2][4][3];
#pragma unroll
    for (int mt = 0; mt < 2; ++mt)
#pragma unroll
        for (int r = 0; r < 4; ++r)
#pragma unroll
            for (int br = 0; br < 3; ++br) gate[mt][r][br] = sigmf(GL[(size_t)(t0 + 4 * mt + q4) * 32 + g * 12 + r * 3 + br]);

    const bf16* KC = (const bf16*)(F.ws + WS_KC) + (size_t)((b * 2 + g) * 256) * 64;
    const bf16* VCT = (const bf16*)(F.ws + WS_VCT) + (size_t)((b * 2 + g) * 64) * 256;
    for (int i = lane; i < 16 * 65; i += 64) wl[i] = 0.f;
    const int ncmp = (t0 + 7 >= 31) ? ((t0 + 7 - 31) >> 4) + 1 : 0;
    const int nst = (ncmp + 31) >> 5;
    float inv[2] = {0.f, 0.f};
    {   float ls[2] = {0.f, 0.f};
        for (int st = 0; st < nst; ++st) { const int k0 = 32 * st; const KFr kf = load_k(KC, 64, k0, r16, q4);
#pragma unroll
            for (int mt = 0; mt < 2; ++mt) { f32x4 sA = mfma16(kf.a0, qf[mt][0], Z4); sA = mfma16(kf.a1, qf[mt][1], sA); f32x4 sB = mfma16(kf.b0, qf[mt][0], Z4); sB = mfma16(kf.b1, qf[mt][1], sB);
#pragma unroll
                for (int r = 0; r < 4; ++r) { const int nA = k0 + 8 * q4 + r, nB = nA + 4;
                    ls[mt] += (16 * nA + 31 <= tq[mt]) ? __builtin_amdgcn_exp2f(sA[r]) : 0.f; ls[mt] += (16 * nB + 31 <= tq[mt]) ? __builtin_amdgcn_exp2f(sB[r]) : 0.f; } } }
#pragma unroll
        for (int mt = 0; mt < 2; ++mt) { float l = ls[mt]; l += __shfl_xor(l, 16); l += __shfl_xor(l, 32); inv[mt] = 1.0f / fmaxf(l, 1e-30f); }
    }
    {   f32x4 O[2][4];
#pragma unroll
        for (int mt = 0; mt < 2; ++mt)
#pragma unroll
            for (int dt = 0; dt < 4; ++dt) O[mt][dt] = Z4;
        for (int st = 0; st < nst; ++st) { const int k0 = 32 * st; const KFr kf = load_k(KC, 64, k0, r16, q4); const VFr vf = load_v(VCT, 256, k0, r16, q4);
#pragma unroll
            for (int mt = 0; mt < 2; ++mt) { f32x4 sA = mfma16(kf.a0, qf[mt][0], Z4); sA = mfma16(kf.a1, qf[mt][1], sA); f32x4 sB = mfma16(kf.b0, qf[mt][0], Z4); sB = mfma16(kf.b1, qf[mt][1], sB);
                f32x4 pA, pB;
#pragma unroll
                for (int r = 0; r < 4; ++r) { const int nA = k0 + 8 * q4 + r, nB = nA + 4;
                    pA[r] = (16 * nA + 31 <= tq[mt]) ? __builtin_amdgcn_exp2f(sA[r]) * inv[mt] : 0.f; pB[r] = (16 * nB + 31 <= tq[mt]) ? __builtin_amdgcn_exp2f(sB[r]) * inv[mt] : 0.f; }
                float vA = pA[0] + pA[1] + pA[2] + 0.5f * pA[3], cA = 0.5f * pA[3], vB = pB[0] + pB[1] + pB[2] + 0.5f * pB[3], cB = 0.5f * pB[3];
                vA += __shfl_xor(vA, 1); vA += __shfl_xor(vA, 2); cA += __shfl_xor(cA, 1); cA += __shfl_xor(cA, 2);
                vB += __shfl_xor(vB, 1); vB += __shfl_xor(vB, 2); cB += __shfl_xor(cB, 1); cB += __shfl_xor(cB, 2);
                if ((lane & 3) == 0) { const int tl = 4 * mt + (r16 >> 2), j = (k0 >> 2) + 2 * q4;
                    impT[tl * 65 + j] = vA; imp2T[tl * 65 + j + 1] = cA; impT[tl * 65 + j + 1] = vB; imp2T[tl * 65 + j + 2] = cB; }
                const bf16x8 pf = pack_p(pA, pB);
#pragma unroll
                for (int dt = 0; dt < 4; ++dt) O[mt][dt] = mfma16(pf, vf.v[dt], O[mt][dt]); } }
#pragma unroll
        for (int mt = 0; mt < 2; ++mt)
#pragma unroll
            for (int dt = 0; dt < 4; ++dt)
#pragma unroll
                for (int r = 0; r < 4; ++r) Oc[mt][dt][r] += gate[mt][r][0] * O[mt][dt][r];
    }
    NSA_FENCE();
    const int cur = t0 >> 6;
    unsigned long long uni = 0ull;
    for (int tl = 0; tl < 8; ++tl) {
        unsigned long long mask;
        if (cur < 16) mask = (2ull << cur) - 1ull;
        else {
            const float sc = impT[tl * 65 + lane] + imp2T[tl * 65 + lane];
            const unsigned key = __float_as_uint(fmaxf(sc, 0.f));
            const bool elig = (lane <= cur) && (lane != 0) && (lane != cur) && (lane != cur - 1);
            unsigned prefix = 0u;
            for (int bit = 30; bit >= 0; --bit) { const unsigned cand = prefix | (1u << bit);
                const int cnt = __popcll(__ballot(elig && key >= cand)); if (cnt >= 13) prefix = cand; }
            const unsigned long long gt = __ballot(elig && key > prefix); unsigned long long ties = __ballot(elig && key == prefix);
            int need = 13 - __popcll(gt); unsigned long long keep = 0ull;
            while (need > 0 && ties) { const unsigned long long low = ties & (0ull - ties); keep |= low; ties ^= low; --need; }
            mask = gt | keep | 1ull | (1ull << cur) | (1ull << (cur - 1));
        }
        uni |= mask;
        if (lane == 0) { selT[2 * tl] = (unsigned)mask; selT[2 * tl + 1] = (unsigned)(mask >> 32); }
    }
    NSA_FENCE();
    unsigned long long mk[2];
#pragma unroll
    for (int mt = 0; mt < 2; ++mt) { const int tl = 4 * mt + (r16 >> 2); mk[mt] = (unsigned long long)selT[2 * tl] | ((unsigned long long)selT[2 * tl + 1] << 32); }
    NSA_FENCE();

#pragma unroll 1
    for (int br = 1; br < 3; ++br) {
        const bf16* Kb = PN + (br == 1 ? 768 : 1024) + g * 64;
        const bf16* Vt = (const bf16*)(F.ws + (br == 1 ? WS_VST : WS_VWT)) + (size_t)((b * 2 + g) * 64) * T;
        f32x4 O[2][4]; float ls[2] = {0.f, 0.f};
#pragma unroll
        for (int mt = 0; mt < 2; ++mt)
#pragma unroll
            for (int dt = 0; dt < 4; ++dt) O[mt][dt] = Z4;
        int k0 = 0, kend = 0; unsigned long long rem = uni;
        if (br == 2) { const int lo = t0 - 511; k0 = (lo > 0 ? lo : 0) & ~31; kend = t0 + 8; }
        for (;;) {
            int j = 0;
            if (br == 1) { if (k0 == kend) { if (!rem) break; j = __builtin_ctzll(rem); rem &= rem - 1; k0 = 64 * j; kend = k0 + 64; } else j = k0 >> 6; }
            else { if (k0 >= kend) break; }
            const KFr kf = load_k(Kb, 1280, k0, r16, q4); const VFr vf = load_v(Vt, T, k0, r16, q4);
#pragma unroll
            for (int mt = 0; mt < 2; ++mt) { f32x4 sA = mfma16(kf.a0, qf[mt][0], Z4); sA = mfma16(kf.a1, qf[mt][1], sA); f32x4 sB = mfma16(kf.b0, qf[mt][0], Z4); sB = mfma16(kf.b1, qf[mt][1], sB);
                f32x4 pA, pB; const bool sb = (br == 1) ? (((mk[mt] >> j) & 1ull) != 0ull) : true;
#pragma unroll
                for (int r = 0; r < 4; ++r) { const int kA = k0 + 8 * q4 + r, kB = kA + 4;
                    const bool mA = sb && (kA <= tq[mt]) && (br == 1 || kA + 512 > tq[mt]), mB = sb && (kB <= tq[mt]) && (br == 1 || kB + 512 > tq[mt]);
                    pA[r] = mA ? __builtin_amdgcn_exp2f(sA[r]) : 0.f; pB[r] = mB ? __builtin_amdgcn_exp2f(sB[r]) : 0.f; }
                ls[mt] += (pA[0] + pA[1]) + (pA[2] + pA[3]) + (pB[0] + pB[1]) + (pB[2] + pB[3]);
                const bf16x8 pf = pack_p(pA, pB);
#pragma unroll
                for (int dt = 0; dt < 4; ++dt) O[mt][dt] = mfma16(pf, vf.v[dt], O[mt][dt]); }
            k0 += 32;
        }
#pragma unroll
        for (int mt = 0; mt < 2; ++mt) { float l = ls[mt]; l += __shfl_xor(l, 16); l += __shfl_xor(l, 32); const float il = 1.0f / fmaxf(l, 1e-30f);
#pragma unroll
            for (int r = 0; r < 4; ++r) { const float ilr = __shfl(il, 4 * q4 + r) * (br == 1 ? gate[mt][r][1] : gate[mt][r][2]);
#pragma unroll
                for (int dt = 0; dt < 4; ++dt) Oc[mt][dt][r] += ilr * O[mt][dt][r]; } }
    }
    bf16* YB = (bf16*)(F.ws + WS_H + 16 * MiB) + (size_t)(b * T) * 512;
#pragma unroll
    for (int mt = 0; mt < 2; ++mt)
#pragma unroll
        for (int r = 0; r < 4; ++r)
#pragma unroll
            for (int dt = 0; dt < 4; ++dt) YB[(size_t)(t0 + 4 * mt + q4) * 512 + (g * 4 + r) * 64 + 16 * dt + r16] = f2b(Oc[mt][dt][r]);
}
__device__ __forceinline__ void nsa_phase(const Frame& F) {
    LAS float* wl = (LAS float*)(F.lds + F.wave * 4608);
    for (;;) {
        unsigned c = 0;
        if (F.lane == 0) c = __hip_atomic_fetch_add(F.ctl + CW_NSAQ, 1u, RLX_AGENT);
        c = (unsigned)__builtin_amdgcn_readfirstlane((int)c);
        if (c >= 4096u) break;
        const int b = c & 3, g = (c >> 2) & 1, tqi = 511 - (int)(c >> 3);
        nsa_wave_unit(F, b, g, 8 * tqi, wl);
    }
}
template <int CTRL> __device__ __forceinline__ float dppf(float x) { return __builtin_bit_cast(float, __builtin_amdgcn_update_dpp(0, __builtin_bit_cast(int, x), CTRL, 0xf, 0xf, true)); }
__device__ __forceinline__ float allsum16(float x) { x += dppf<0x128>(x); x += dppf<0x124>(x); x += dppf<0x122>(x); x += dppf<0x121>(x); return x; }
__device__ __forceinline__ f32x4 unpk4(const u32x2 w) { f32x4 r; r[0] = bflo(w.x); r[1] = bfhi(w.x); r[2] = bflo(w.y); r[3] = bfhi(w.y); return r; }
__device__ __forceinline__ void rwkv_scan_block(const Frame& F, int sb) {
    const int tid = F.tid, lane = F.lane, w = F.wave;
    const int bh = sb >> 1, half = sb & 1, b = bh >> 3, h = bh & 7;
    const int lrow = 4 * w + (lane >> 4), kq = lane & 15;
    LAS float* buf = (LAS float*)F.lds;
    LAS float* ybuf = (LAS float*)(F.lds + 98304);
    const unsigned char* recb = F.ws + WS_PRW + (size_t)(b * T) * 7168 + h * 768;
    unsigned char* yb8 = F.ws + WS_PRW + (size_t)(b * T) * 7168 + 6144 + h * 128 + half * 64;
    const int fs = tid >> 4, o4 = (tid & 15) * 4;
    u32x2 st[6];
#define SCAN_LOAD(c) do { _Pragma("unroll") for (int sec = 0; sec < 6; ++sec) st[sec] = *(const u32x2*)(recb + (size_t)(32 * (c) + fs) * 7168 + sec * 128 + o4 * 2); } while (0)
#define SCAN_WRITE(bi) do { LAS float* d = buf + (bi) * 12288 + fs * 384 + o4; const f32x4 r_ = unpk4(st[0]), om_ = unpk4(st[1]), k_ = unpk4(st[2]), v_ = unpk4(st[3]), kk_ = unpk4(st[4]), a_ = unpk4(st[5]); \
        *(LAS f32x4*)(d) = kk_; *(LAS f32x4*)(d + 64) = kk_ * a_; *(LAS f32x4*)(d + 128) = 1.0f - om_; *(LAS f32x4*)(d + 192) = k_; *(LAS f32x4*)(d + 256) = r_; *(LAS f32x4*)(d + 320) = v_; } while (0)
    SCAN_LOAD(0); SCAN_WRITE(0); __syncthreads();
    float S0 = 0.f, S1 = 0.f, S2 = 0.f, S3 = 0.f;
    for (int c = 0; c < T / 32; ++c) {
        if (c + 1 < T / 32) SCAN_LOAD(c + 1);
        const LAS float* cb = buf + (c & 1) * 12288; LAS float* yb = ybuf + (c & 1) * 1024;
#pragma unroll 4
        for (int s = 0; s < 32; ++s) { const LAS float* p = cb + s * 384 + 4 * kq;
            const f32x4 kk4 = *(const LAS f32x4*)(p), ka4 = *(const LAS f32x4*)(p + 64), w4 = *(const LAS f32x4*)(p + 128), k4 = *(const LAS f32x4*)(p + 192), r4 = *(const LAS f32x4*)(p + 256);
            const float vv = cb[s * 384 + 320 + 32 * half + lrow];
            float sa = -((S0 * kk4[0] + S1 * kk4[1]) + (S2 * kk4[2] + S3 * kk4[3])); sa = allsum16(sa);
            S0 = S0 * w4[0] + (sa * ka4[0] + vv * k4[0]); S1 = S1 * w4[1] + (sa * ka4[1] + vv * k4[1]); S2 = S2 * w4[2] + (sa * ka4[2] + vv * k4[2]); S3 = S3 * w4[3] + (sa * ka4[3] + vv * k4[3]);
            float y = (S0 * r4[0] + S1 * r4[1]) + (S2 * r4[2] + S3 * r4[3]); y = allsum16(y);
            if (kq == 0) yb[s * 32 + lrow] = y; }
        if (c + 1 < T / 32) SCAN_WRITE((c + 1) & 1);
        __syncthreads();
        { const int rr = 2 * (tid & 15); const float y0 = yb[fs * 32 + rr], y1 = yb[fs * 32 + rr + 1];
          *(unsigned*)(yb8 + (size_t)(32 * c + fs) * 7168 + rr * 2) = pk2(y0, y1); }
    }
#undef SCAN_LOAD
#undef SCAN_WRITE
    __syncthreads();
}
__device__ __forceinline__ void rwkv_epilogue(const Frame& F) {
    const int lane = F.lane; const int gw = F.vcu * NWAVES + F.wave, NGW = F.G * NWAVES;
    const unsigned char* prw = F.ws + WS_PRW; const bf16* G = (const bf16*)((unsigned char*)F.out + DO_G); bf16* YA = (bf16*)(F.ws + WS_H);
    for (int idx = gw; idx < M * 8; idx += NGW) { const int row = idx >> 3, h = idx & 7, c = h * 64 + lane;
        const bf16* rec = (const bf16*)(prw + (size_t)row * 7168) + h * 384;
        const float y = bf2f(((const bf16*)(prw + (size_t)row * 7168 + 6144))[c]);
        const float mean = wave_sum(y) * (1.f / 64.f); const float d = y - mean; const float var = wave_sum(d * d) * (1.f / 64.f);
        const float yn = d * rsqrtf(var + GN_EPS) * F.in[12][c] + F.in[13][c];
        const float r = bf2f(rec[lane]), k = bf2f(rec[128 + lane]), v = bf2f(rec[192 + lane]);
        const float bon = wave_sum(r * k * F.in[11][c]) * v;
        YA[(size_t)row * 512 + c] = f2b((yn + bon) * bf2f(G[(size_t)row * 512 + c])); }
}
__device__ __forceinline__ unsigned sortable(float x) { const unsigned u = __float_as_uint(x); return (u & 0x80000000u) ? ~u : (u | 0x80000000u); }
__device__ __forceinline__ float unsortable(unsigned k) { const unsigned u = (k & 0x80000000u) ? (k & 0x7fffffffu) : ~k; return __uint_as_float(u); }
#define TK_INSERT(L, key_) do { unsigned k_ = (key_); _Pragma("unroll") for (int s_ = 0; s_ < 16; ++s_) { const unsigned hi_ = L[s_] > k_ ? L[s_] : k_; k_ = L[s_] > k_ ? k_ : L[s_]; L[s_] = hi_; } } while (0)
__device__ __forceinline__ void peer_topk_pass(const Frame& F, int wp, LAS float* sc) {
    const int lane = F.lane, r16 = lane & 15, q4 = lane >> 4;
    const bf16* QRY = (const bf16*)(F.ws + WS_PRW);
    int* EID = (int*)(F.ws + WS_PRW + 64 * MiB); float* EG = (float*)(F.ws + WS_PRW + 72 * MiB);
    const int row = lane & 31, part = lane >> 5;
    unsigned L1[16], L2[16];
#pragma unroll
    for (int half = 0; half < 2; ++half) {
        const bf16* SK = (const bf16*)(F.ws + (half ? WS_SK2 : WS_SK1));
#pragma unroll
        for (int mt = 0; mt < 2; ++mt) { const int rho = 32 * wp + 16 * mt + r16;
            const bf16* qp = QRY + (size_t)(rho >> 3) * 2048 + (rho & 7) * 256 + half * 128 + 8 * q4;
            bf16x8 af[4];
#pragma unroll
            for (int s = 0; s < 4; ++s) af[s] = as_bf16x8(*(const v4u*)(qp + 32 * s));
#pragma unroll
            for (int kt = 0; kt < 8; ++kt) { f32x4 acc = {0.f, 0.f, 0.f, 0.f};
#pragma unroll
                for (int s = 0; s < 4; ++s) acc = mfma16(af[s], as_bf16x8(*(const v4u*)(SK + (size_t)(16 * kt + r16) * 128 + 32 * s + 8 * q4)), acc);
#pragma unroll
                for (int r = 0; r < 4; ++r) { const int rw = 16 * mt + 4 * q4 + r; sc[rw * 128 + ((16 * kt + r16) ^ rw)] = acc[r]; } } }
        NSA_FENCE();
        unsigned Ls[16];
#pragma unroll
        for (int s = 0; s < 16; ++s) Ls[s] = 0u;
#pragma unroll 4
        for (int i = 0; i < 64; ++i) { const int c = 64 * part + i; const float x = sc[row * 128 + (c ^ row)];
            TK_INSERT(Ls, (sortable(x) & ~0x7Fu) | (unsigned)(127 - c)); }
        unsigned Lo[16];
#pragma unroll
        for (int s = 0; s < 16; ++s) Lo[s] = (unsigned)__shfl_xor((int)Ls[s], 32);
#pragma unroll
        for (int s = 0; s < 16; ++s) TK_INSERT(Ls, Lo[s]);
#pragma unroll
        for (int s = 0; s < 16; ++s) { if (half == 0) L1[s] = Ls[s]; else L2[s] = Ls[s]; }
        NSA_FENCE();
    }
    float v1[16], v2[16];
#pragma unroll
    for (int s = 0; s < 16; ++s) { v1[s] = unsortable(L1[s]); v2[s] = unsortable(L2[s]); }
    unsigned C[16];
#pragma unroll
    for (int s = 0; s < 16; ++s) C[s] = 0u;
#pragma unroll
    for (int i = 0; i < 16; ++i)
#pragma unroll
        for (int j = 0; j < 16; ++j) if ((i + 1) * (j + 1) <= 16) { TK_INSERT(C, (sortable(v1[i] + v2[j]) & ~0xFFu) | (unsigned)(255 - (16 * i + j))); }
    LAS unsigned* il = (LAS unsigned*)sc;
    if (part == 0) {
#pragma unroll
        for (int s = 0; s < 16; ++s) { il[row * 33 + s] = 127u - (L1[s] & 127u); il[row * 33 + 16 + s] = 127u - (L2[s] & 127u); }
    }
    NSA_FENCE();
    if (part == 0) { const int rho = 32 * wp + row;
        float val[16], e[16]; float sum = 0.f;
#pragma unroll
        for (int s = 0; s < 16; ++s) val[s] = unsortable(C[s]);
#pragma unroll
        for (int s = 0; s < 16; ++s) { e[s] = __expf(val[s] - val[0]); sum += e[s]; }
        const float is = 1.0f / sum;
#pragma unroll
        for (int s = 0; s < 16; ++s) { const unsigned pos = 255u - (C[s] & 255u); const unsigned i = pos >> 4, j = pos & 15u;
            EID[(size_t)rho * 16 + s] = (int)(il[row * 33 + i] * 128u + il[row * 33 + 16 + j]); EG[(size_t)rho * 16 + s] = e[s] * is; }
    }
    NSA_FENCE();
}
typedef __bf16 bf16x2_t __attribute__((ext_vector_type(2)));
__device__ __forceinline__ float dot2bf(unsigned a, unsigned b, float acc) { return __builtin_amdgcn_fdot2_f32_bf16(__builtin_bit_cast(bf16x2_t, a), __builtin_bit_cast(bf16x2_t, b), acc, false); }
__device__ __forceinline__ void peer_convert_one(const Frame& F, const float* srcf, unsigned char* dstb) {
    const int gt = F.vcu * (NWAVES * 64) + F.tid, NT = F.G * NWAVES * 64;
    const f32x4* src = (const f32x4*)srcf; v4u* dst = (v4u*)dstb;
    for (int i = gt; i < 16384 * 1024 / 8; i += NT) { const f32x4 a = src[2 * i], b = src[2 * i + 1];
        v4u o; o.x = pg8::cvt_pk_bf16(a[0], a[1]); o.y = pg8::cvt_pk_bf16(a[2], a[3]); o.z = pg8::cvt_pk_bf16(b[0], b[1]); o.w = pg8::cvt_pk_bf16(b[2], b[3]); dst[i] = o; }
}
__device__ __forceinline__ void peer_convert_tables(const Frame& F) { peer_convert_one(F, F.in[31], F.ws + WS_MG); peer_convert_one(F, F.in[32], F.ws + WS_MG + 32 * MiB); }
__device__ __forceinline__ void peer_gather(const Frame& F) {
    const int lane = F.lane; const int gw = F.vcu * NWAVES + F.wave, NGW = F.G * NWAVES;
    const bf16* H2 = (const bf16*)(F.ws + WS_H);
    const int* EID = (const int*)(F.ws + WS_PRW + 64 * MiB); const float* EG = (const float*)(F.ws + WS_PRW + 72 * MiB);
    const bf16* Ub = (const bf16*)(F.ws + WS_MG); const bf16* Vb = (const bf16*)(F.ws + WS_MG + 32 * MiB);
    for (int tok = gw; tok < M; tok += NGW) {
        const v4u h0 = *(const v4u*)(H2 + (size_t)tok * D + 8 * lane), h1 = *(const v4u*)(H2 + (size_t)tok * D + 512 + 8 * lane);
        float o[16];
#pragma unroll
        for (int i = 0; i < 16; ++i) o[i] = 0.f;
#pragma unroll 1
        for (int hh = 0; hh < 2; ++hh) {
            const int idv = EID[(size_t)tok * 128 + 64 * hh + lane]; const float gv = EG[(size_t)tok * 128 + 64 * hh + lane];
#pragma unroll 1
            for (int e0 = 0; e0 < 64; e0 += 4) {
                v4u u0[4], u1[4], w0[4], w1[4]; float gt[4], dot[4];
#pragma unroll
                for (int k = 0; k < 4; ++k) { const int id = __builtin_amdgcn_readlane(idv, e0 + k); gt[k] = __builtin_bit_cast(float, __builtin_amdgcn_readlane(__builtin_bit_cast(int, gv), e0 + k));
                    const bf16* ur = Ub + (size_t)id * D + 8 * lane; const bf16* vr = Vb + (size_t)id * D + 8 * lane;
                    u0[k] = *(const v4u*)ur; u1[k] = *(const v4u*)(ur + 512); w0[k] = *(const v4u*)vr; w1[k] = *(const v4u*)(vr + 512); }
#pragma unroll
                for (int k = 0; k < 4; ++k) { float d0 = dot2bf(h0.x, u0[k].x, 0.f), d1 = dot2bf(h0.y, u0[k].y, 0.f); d0 = dot2bf(h0.z, u0[k].z, d0); d1 = dot2bf(h0.w, u0[k].w, d1);
                    d0 = dot2bf(h1.x, u1[k].x, d0); d1 = dot2bf(h1.y, u1[k].y, d1); d0 = dot2bf(h1.z, u1[k].z, d0); d1 = dot2bf(h1.w, u1[k].w, d1); dot[k] = d0 + d1; }
#pragma unroll
                for (int o_ = 1; o_ < 64; o_ <<= 1) {
#pragma unroll
                    for (int k = 0; k < 4; ++k) dot[k] += __shfl_xor(dot[k], o_); }
#pragma unroll
                for (int k = 0; k < 4; ++k) { const float cf = gt[k] * 0.5f * dot[k] * (1.f + erff(dot[k] * 0.70710678118654752f));
                    o[0] += cf * bflo(w0[k].x); o[1] += cf * bfhi(w0[k].x); o[2] += cf * bflo(w0[k].y); o[3] += cf * bfhi(w0[k].y);
                    o[4] += cf * bflo(w0[k].z); o[5] += cf * bfhi(w0[k].z); o[6] += cf * bflo(w0[k].w); o[7] += cf * bfhi(w0[k].w);
                    o[8] += cf * bflo(w1[k].x); o[9] += cf * bfhi(w1[k].x); o[10] += cf * bflo(w1[k].y); o[11] += cf * bfhi(w1[k].y);
                    o[12] += cf * bflo(w1[k].z); o[13] += cf * bfhi(w1[k].z); o[14] += cf * bflo(w1[k].w); o[15] += cf * bfhi(w1[k].w); }
            }
        }
        float* orow = F.out + (size_t)tok * D + 8 * lane;
#pragma unroll
        for (int j = 0; j < 2; ++j) { f32x4* p = (f32x4*)(orow + 512 * j);
            f32x4 a = p[0], b = p[1];
            a[0] += o[8 * j + 0]; a[1] += o[8 * j + 1]; a[2] += o[8 * j + 2]; a[3] += o[8 * j + 3]; b[0] += o[8 * j + 4]; b[1] += o[8 * j + 5]; b[2] += o[8 * j + 6]; b[3] += o[8 * j + 7];
            p[0] = a; p[1] = b; }
    }
}
struct Args { const float* in[33]; float* out; unsigned char* ws; int ph_lo, ph_hi; };
__global__ void __launch_bounds__(NWAVES * 64, 2) mk_fwd(Args args) {
    extern __shared__ __attribute__((aligned(16))) unsigned char lds[];
    Frame F;
    F.lds = (LAS unsigned char*)lds;
    F.MISC = (volatile LAS unsigned*)(F.lds + MISC_OFF);
    F.tid = threadIdx.x; F.lane = F.tid & 63; F.wave = __builtin_amdgcn_readfirstlane(F.tid >> 6);
    F.G = gridDim.x; { const int bx = blockIdx.x; F.vcu = (F.G % 8 == 0) ? (bx % 8) * (F.G / 8) + bx / 8 : bx; }
    unsigned char* ws = args.ws; F.ws = ws; F.out = args.out;
    F.ctl = (gu32*)(ws + WS_CTL);
#pragma unroll
    for (int i = 0; i < 33; ++i) F.in[i] = args.in[i];
    for (int u = F.tid; u < (LDS_BYTES - LDSCTL_OFF) / 4; u += NWAVES * 64) ((LAS unsigned*)(F.lds + LDSCTL_OFF))[u] = 0u;
    __syncthreads();
    const int lo = args.ph_lo, hi = args.ph_hi;
    const bool multi = (hi - lo) > 1;
    XcdBarrier bar; bar.bar = (unsigned*)(F.ctl + CW_BAR); bar.x = 0; bar.st = nullptr;
    if (multi) bar = xcd_barrier_post((unsigned*)(F.ctl + CW_BAR), F.MISC + 8);
#define IN(k) (lo <= (k) && (k) < hi)
#define SEAM(k) do { if (IN(k) && IN((k) + 1)) xcd_barrier(bar); } while (0)

    if (IN(0)) { p0_prologue(F); } SEAM(0);
    if (IN(1)) {
        pg8::Gemm g{(const pg8::bf16_t*)(ws + WS_H), (const pg8::bf16_t*)(ws + WS_WIN), M, NG1, D}; pg8::StaticOrder S; S.init(M, NG1, F.G, (int)blockIdx.x);
        pg8::EpiG1 E{(float*)(ws + WS_PRW), (float*)(ws + WS_BND), (pg8::bf16_t*)((unsigned char*)F.out + DO_PNSA), (pg8::bf16_t*)(ws + WS_MG), (float*)((unsigned char*)F.out + DO_GLOG)};
        pg8::gemm_phase<pg8::EpiG1, pg8::StaticOrder, true, true>(F.lds + RING_OFF, g, S, E);
    } SEAM(1);
    if (IN(2)) {
        for (int u = F.vcu; u < 256; u += F.G) { nsa_prep_tile(F, u); rwkv_prep_tile(F, u); compress_unit(F, u); }
    } SEAM(2);
    if (IN(3)) {
        if ((int)blockIdx.x < SCAN_BLOCKS) { for (int sb = blockIdx.x; sb < 64; sb += SCAN_BLOCKS) rwkv_scan_block(F, sb); }
        else nsa_phase(F);
    } SEAM(3);
    if (IN(4)) { rwkv_epilogue(F); } SEAM(4);
    if (IN(5)) {
        { pg8::Gemm g{(const pg8::bf16_t*)(ws + WS_H), (const pg8::bf16_t*)(ws + WS_WA), M, D, 512}; pg8::StaticOrder S; S.init(M, D, F.G, (int)blockIdx.x);
          pg8::EpiGate1 E{(float*)(ws + WS_PRW), (const pg8::bf16_t*)(ws + WS_MG), 0};
          pg8::gemm_phase<pg8::EpiGate1, pg8::StaticOrder, true, true>(F.lds + RING_OFF, g, S, E); }
        VM_WAIT(); __syncthreads();
        { pg8::Gemm g{(const pg8::bf16_t*)(ws + WS_H + 16 * MiB), (const pg8::bf16_t*)(ws + WS_WB), M, D, 512}; pg8::StaticOrder S; S.init(M, D, F.G, (int)blockIdx.x);
          pg8::EpiGate2 E{(const float*)(ws + WS_PRW), (const pg8::bf16_t*)(ws + WS_MG), 1024, (pg8::bf16_t*)(ws + WS_PRW + 64 * MiB)};
          pg8::gemm_phase<pg8::EpiGate2, pg8::StaticOrder, true, true>(F.lds + RING_OFF, g, S, E); }
    } SEAM(5);
    if (IN(6)) {
        pg8::Gemm g{(const pg8::bf16_t*)(ws + WS_PRW + 64 * MiB), (const pg8::bf16_t*)(ws + WS_WOUT), M, D, D}; pg8::StaticOrder S; S.init(M, D, F.G, (int)blockIdx.x);
        pg8::EpiRes E{F.in[0], F.out};
        pg8::gemm_phase<pg8::EpiRes, pg8::StaticOrder, true, true>(F.lds + RING_OFF, g, S, E);
    } SEAM(6);
    if (IN(7)) { const int gw = F.vcu * NWAVES + F.wave, NGW = F.G * NWAVES;
        for (int m = gw; m < M; m += NGW) rms_row_to_bf16(F.lane, F.out + (size_t)m * D, F.in[27], (bf16*)(ws + WS_H) + (size_t)m * D);
        peer_convert_tables(F);
    } SEAM(7);
    if (IN(8)) {
        pg8::Gemm g{(const pg8::bf16_t*)(ws + WS_H), (const pg8::bf16_t*)(ws + WS_WQ), M, 2048, D}; pg8::StaticOrder S; S.init(M, 2048, F.G, (int)blockIdx.x);
        pg8::EpiBf16<0> E{(pg8::bf16_t*)(ws + WS_PRW), 2048, nullptr, 0, 0, 1.f};
        pg8::gemm_phase<pg8::EpiBf16<0>, pg8::StaticOrder, true, true>(F.lds + RING_OFF, g, S, E);
    } SEAM(8);
    if (IN(9)) { const int gw = F.vcu * NWAVES + F.wave, NGW = F.G * NWAVES; LAS float* sc = (LAS float*)(F.lds + F.wave * 16384);
        for (int wp = gw; wp < M * 8 / 32; wp += NGW) peer_topk_pass(F, wp, sc);
    } SEAM(9);
    if (IN(10)) { peer_gather(F); }
#undef IN
#undef SEAM
}

extern "C" void kernel_launch(void* const* d_in, const int* in_sizes, int n_in, void* d_out, int out_size, void* d_ws, size_t ws_size, hipStream_t stream) {
    static int grid = 0;
    if (grid == 0) {
        if (n_in != 33 || out_size != M * D || ws_size < WS_END) { fprintf(stderr, "kernel_launch: unexpected shapes (n_in %d out %d ws %zu)\n", n_in, out_size, ws_size); grid = -1; return; }
        int dev = 0, cus = 0, per_cu = 0;
        if (hipGetDevice(&dev) != hipSuccess || hipDeviceGetAttribute(&cus, hipDeviceAttributeMultiprocessorCount, dev) != hipSuccess) { grid = -1; return; }
        if (hipFuncSetAttribute((const void*)mk_fwd, hipFuncAttributeMaxDynamicSharedMemorySize, LDS_BYTES) != hipSuccess) { fprintf(stderr, "kernel_launch: hipFuncSetAttribute failed\n"); grid = -1; return; }
        if (hipOccupancyMaxActiveBlocksPerMultiprocessor(&per_cu, (const void*)mk_fwd, NWAVES * 64, LDS_BYTES) != hipSuccess || per_cu < 1)
            fprintf(stderr, "kernel_launch: occupancy query reports %d blocks per CU\n", per_cu);
        (void)hipGetLastError();
        grid = cus;
        if (grid > 256) grid = 256;
    }
    if (grid < 0) return;
    if (hipMemsetAsync((char*)d_ws + WS_CTL, 0, CTL_ZERO_BYTES, stream) != hipSuccess) return;
    Args a{};
    for (int i = 0; i < 33; ++i) a.in[i] = (const float*)d_in[i];
    a.out = (float*)d_out; a.ws = (unsigned char*)d_ws;
#if MK_ONE_LAUNCH
    a.ph_lo = 0; a.ph_hi = N_PHASES;
    hipLaunchKernelGGL(mk_fwd, dim3(grid), dim3(NWAVES * 64), LDS_BYTES, stream, a);
#else
    for (int p = 0; p < N_PHASES; ++p) { a.ph_lo = p; a.ph_hi = p + 1; hipLaunchKernelGGL(mk_fwd, dim3(grid), dim3(NWAVES * 64), LDS_BYTES, stream, a); }
#endif
}
```

```cpp
#include <hip/hip_runtime.h>
#include <cstdio>
#include <cstdint>
#define MK_ONE_LAUNCH 1
#define REP_MASK 0
#define P3REP 1
namespace pg8 {
#define PG8_LAS __attribute__((address_space(3)))
typedef unsigned short bf16_t;
typedef short bf16x8 __attribute__((ext_vector_type(8)));
typedef float f32x4 __attribute__((ext_vector_type(4)));
typedef unsigned u32x4 __attribute__((ext_vector_type(4)));
constexpr int BM = 256, BK = 64, HALF = 128, HTB = HALF * BK * 2  , STAGE_BYTES = 8 * HTB, NXCD = 8, WGM = 8;

__host__ __device__ __forceinline__ int lds_byte(int r, int c) { const int st = (r >> 4) * 2 + (c >> 5), rr = r & 15, cc = c & 31, ob = rr * 64 + cc * 2; return st * 1024 + (ob ^ (((ob >> 9) & 1) << 5)); }
__host__ __device__ __forceinline__ void stage_rc(int b, int& R, int& C) { const int st = b / 1024, sb = b % 1024, swz = sb ^ (((sb >> 9) & 1) << 5); R = (st >> 1) * 16 + swz / 64; C = (st & 1) * 32 + (swz % 64) / 2; }
__host__ __device__ __forceinline__ int perm32(int rho) { const int n = rho >> 4, i = rho & 15; return 8 * (i >> 2) + 4 * n + (i & 3); }

struct Unit { int pm, pn; };
struct Gemm { const bf16_t* A; const bf16_t* Bt; int M, N, K; };

struct StaticOrder {
    int nM, nN, nwg, G, c;
    __host__ __device__ void init(int M, int N, int G_, int c_) { nM = M / BM; nN = N / BM; nwg = nM * nN; G = G_; c = c_; }
    __host__ __device__ bool next(int i, Unit& u) const {
        const long L = (long)i * G + c; if (L >= nwg) return false;
        int wgid = (int)L; { const int q = nwg / NXCD, r = nwg % NXCD, xcd = wgid % NXCD, off = wgid / NXCD; wgid = (xcd < r ? xcd * (q + 1) : r * (q + 1) + (xcd - r) * q) + off; }
        const int nig = WGM * nN, gid = wgid / nig, fm = gid * WGM, gsz = (nM - fm) < WGM ? (nM - fm) : WGM;
        u.pm = fm + ((wgid % nig) % gsz); u.pn = (wgid % nig) / gsz; return true;
    }
    __device__ __forceinline__ void a_ready(const Unit&) const {}
    __device__ __forceinline__ void done(const Unit&) const {}
};

__device__ __forceinline__ unsigned cvt_pk_bf16(float lo, float hi) { unsigned r; asm volatile("v_cvt_pk_bf16_f32 %0, %1, %2" : "=v"(r) : "v"(lo), "v"(hi)); return r; }
typedef float f32x2 __attribute__((ext_vector_type(2)));
__device__ __forceinline__ f32x2 gelu_pk(f32x2 v) {
    const f32x2 av = __builtin_elementwise_abs(v), d = av * 0.2316418882f + 1.0f;
    f32x2 t; t.x = __builtin_amdgcn_rcpf(d.x); t.y = __builtin_amdgcn_rcpf(d.y);
    f32x2 q = t * 0.5307027145f + (-0.7265760135f); q = q * t + 0.7107068705f; q = q * t + (-0.142248368f); q = q * t + 0.127414796f; q = q * t;
    const f32x2 s = (v * v) * (-0.72134752044f);
    f32x2 e; e.x = __builtin_amdgcn_exp2f(s.x); e.y = __builtin_amdgcn_exp2f(s.y);
    const f32x2 m = v * (q * e), r = v - m;
    f32x2 o; o.x = v.x < 0.f ? m.x : r.x; o.y = v.y < 0.f ? m.y : r.y; return o;
}

template <int ACT  > struct EpiBf16 {
    static constexpr bool PERM = true, AFTER_DRAIN = false; static_assert(ACT == 0 || ACT == 1, "EpiBf16: ACT is 0 (none) or 1 (gelu_pk)");
    bf16_t* O; int ldc; const float* bias; int split_cols; size_t split_stride; float scale0;
    __device__ __forceinline__ void operator()(const f32x4 (&acc)[2][2][4][2], const Unit& u, int wr, int wc, int fr, int fq) const {
        const int row0 = u.pm * BM + wr * 64 + fr; int colt = u.pn * BM; bf16_t* base = O;
        float sc = 1.f; if (split_cols) { const int t = colt / split_cols; base += (size_t)t * split_stride; colt -= t * split_cols; if (t == 0) sc = scale0; }
        const int col0 = colt + wc * 32 + 8 * fq, bcol0 = u.pn * BM + wc * 32 + 8 * fq;
        f32x4 bv[2][2];
#pragma unroll
        for (int bj = 0; bj < 2; ++bj)
#pragma unroll
            for (int n = 0; n < 2; ++n) bv[bj][n] = bias ? *(const f32x4*)(bias + bcol0 + bj * HALF + 4 * n) : (f32x4){0.f, 0.f, 0.f, 0.f};
#pragma unroll
        for (int ai = 0; ai < 2; ++ai)
#pragma unroll
            for (int m = 0; m < 4; ++m) { bf16_t* rowp = base + (size_t)(row0 + ai * HALF + m * 16) * ldc + col0;
#pragma unroll
                for (int bj = 0; bj < 2; ++bj) { f32x4 v0 = acc[ai][bj][m][0] + bv[bj][0], v1 = acc[ai][bj][m][1] + bv[bj][1];
                    if (ACT == 1) { f32x2 a = gelu_pk((f32x2){v0[0], v0[1]}), b = gelu_pk((f32x2){v0[2], v0[3]}), c = gelu_pk((f32x2){v1[0], v1[1]}), d = gelu_pk((f32x2){v1[2], v1[3]});
                        v0 = (f32x4){a.x, a.y, b.x, b.y}; v1 = (f32x4){c.x, c.y, d.x, d.y}; }
                    v0 = v0 * sc; v1 = v1 * sc; u32x4 w; w.x = cvt_pk_bf16(v0[0], v0[1]); w.y = cvt_pk_bf16(v0[2], v0[3]); w.z = cvt_pk_bf16(v1[0], v1[1]); w.w = cvt_pk_bf16(v1[2], v1[3]);
                    *(u32x4*)(rowp + bj * HALF) = w; } }
    }
};
__device__ __forceinline__ float bf_lo(unsigned w) { return __uint_as_float(w << 16); }
__device__ __forceinline__ float bf_hi(unsigned w) { return __uint_as_float(w & 0xffff0000u); }
__device__ __forceinline__ float sigm(float x) { return 1.0f / (1.0f + __expf(-x)); }
__device__ __forceinline__ u32x4 pack8(const f32x4 v0, const f32x4 v1) { u32x4 w; w.x = cvt_pk_bf16(v0[0], v0[1]); w.y = cvt_pk_bf16(v0[2], v0[3]); w.z = cvt_pk_bf16(v1[0], v1[1]); w.w = cvt_pk_bf16(v1[2], v1[3]); return w; }

struct EpiG1 {
    static constexpr bool PERM = true, AFTER_DRAIN = false;
    float* PRW; float* BND; bf16_t* PNSA; bf16_t* MG; float* GLOG;
    __device__ __forceinline__ void operator()(const f32x4 (&acc)[2][2][4][2], const Unit& u, int wr, int wc, int fr, int fq) const {
        const int row0 = u.pm * BM + wr * 64 + fr, c0 = wc * 32 + 8 * fq;
#pragma unroll
        for (int ai = 0; ai < 2; ++ai)
#pragma unroll
            for (int m = 0; m < 4; ++m) { const int row = row0 + ai * HALF + m * 16;
#pragma unroll
                for (int bj = 0; bj < 2; ++bj) { const f32x4 v0 = acc[ai][bj][m][0], v1 = acc[ai][bj][m][1]; const int col = c0 + bj * HALF;
                    if (u.pn < 7) { float* p = PRW + (size_t)row * 1792 + u.pn * 256 + col; *(f32x4*)p = v0; *(f32x4*)(p + 4) = v1;
                        if ((row & 63) == 63) { float* q = BND + (size_t)(row >> 6) * 1792 + u.pn * 256 + col; *(f32x4*)q = v0; *(f32x4*)(q + 4) = v1; } }
                    else if (u.pn < 12) { *(u32x4*)(PNSA + (size_t)row * 1280 + (u.pn - 7) * 256 + col) = pack8(v0, v1); }
                    else if (u.pn < 20) { *(u32x4*)(MG + (size_t)row * 2048 + (u.pn - 12) * 256 + col) = pack8(v0, v1); }
                    else { if (col < 32) { float* p = GLOG + (size_t)row * 32 + col; *(f32x4*)p = v0; *(f32x4*)(p + 4) = v1; } }
                } }
    }
};
struct EpiGate1 {
    static constexpr bool PERM = true, AFTER_DRAIN = false;
    float* T1; const bf16_t* MG; int goff;
    __device__ __forceinline__ void operator()(const f32x4 (&acc)[2][2][4][2], const Unit& u, int wr, int wc, int fr, int fq) const {
        const int row0 = u.pm * BM + wr * 64 + fr, c0 = u.pn * BM + wc * 32 + 8 * fq;
#pragma unroll
        for (int ai = 0; ai < 2; ++ai)
#pragma unroll
            for (int m = 0; m < 4; ++m) { const int row = row0 + ai * HALF + m * 16;
#pragma unroll
                for (int bj = 0; bj < 2; ++bj) { const f32x4 v0 = acc[ai][bj][m][0], v1 = acc[ai][bj][m][1]; const int col = c0 + bj * HALF;
                    const u32x4 g = *(const u32x4*)(MG + (size_t)row * 2048 + goff + col);
                    f32x4 o0, o1; o0[0] = sigm(bf_lo(g.x)) * v0[0]; o0[1] = sigm(bf_hi(g.x)) * v0[1]; o0[2] = sigm(bf_lo(g.y)) * v0[2]; o0[3] = sigm(bf_hi(g.y)) * v0[3];
                    o1[0] = sigm(bf_lo(g.z)) * v1[0]; o1[1] = sigm(bf_hi(g.z)) * v1[1]; o1[2] = sigm(bf_lo(g.w)) * v1[2]; o1[3] = sigm(bf_hi(g.w)) * v1[3];
                    float* p = T1 + (size_t)row * 1024 + col; *(f32x4*)p = o0; *(f32x4*)(p + 4) = o1; } }
    }
};
struct EpiGate2 {
    static constexpr bool PERM = true, AFTER_DRAIN = false;
    const float* T1; const bf16_t* MG; int goff; bf16_t* MIX;
    __device__ __forceinline__ void operator()(const f32x4 (&acc)[2][2][4][2], const Unit& u, int wr, int wc, int fr, int fq) const {
        const int row0 = u.pm * BM + wr * 64 + fr, c0 = u.pn * BM + wc * 32 + 8 * fq;
#pragma unroll
        for (int ai = 0; ai < 2; ++ai)
#pragma unroll
            for (int m = 0; m < 4; ++m) { const int row = row0 + ai * HALF + m * 16;
#pragma unroll
                for (int bj = 0; bj < 2; ++bj) { const f32x4 v0 = acc[ai][bj][m][0], v1 = acc[ai][bj][m][1]; const int col = c0 + bj * HALF;
                    const u32x4 g = *(const u32x4*)(MG + (size_t)row * 2048 + goff + col);
                    const float* p = T1 + (size_t)row * 1024 + col; const f32x4 t0 = *(const f32x4*)p, t1 = *(const f32x4*)(p + 4);
                    f32x4 o0, o1; o0[0] = t0[0] + sigm(bf_lo(g.x)) * v0[0]; o0[1] = t0[1] + sigm(bf_hi(g.x)) * v0[1]; o0[2] = t0[2] + sigm(bf_lo(g.y)) * v0[2]; o0[3] = t0[3] + sigm(bf_hi(g.y)) * v0[3];
                    o1[0] = t1[0] + sigm(bf_lo(g.z)) * v1[0]; o1[1] = t1[1] + sigm(bf_hi(g.z)) * v1[1]; o1[2] = t1[2] + sigm(bf_lo(g.w)) * v1[2]; o1[3] = t1[3] + sigm(bf_hi(g.w)) * v1[3];
                    *(u32x4*)(MIX + (size_t)row * 1024 + col) = pack8(o0, o1); } }
    }
};
struct EpiRes {
    static constexpr bool PERM = true, AFTER_DRAIN = false;
    const float* X; float* OUT;
    __device__ __forceinline__ void operator()(const f32x4 (&acc)[2][2][4][2], const Unit& u, int wr, int wc, int fr, int fq) const {
        const int row0 = u.pm * BM + wr * 64 + fr, c0 = u.pn * BM + wc * 32 + 8 * fq;
#pragma unroll
        for (int ai = 0; ai < 2; ++ai)
#pragma unroll
            for (int m = 0; m < 4; ++m) { const int row = row0 + ai * HALF + m * 16;
#pragma unroll
                for (int bj = 0; bj < 2; ++bj) { const size_t off = (size_t)row * 1024 + c0 + bj * HALF;
                    const f32x4 x0 = *(const f32x4*)(X + off), x1 = *(const f32x4*)(X + off + 4);
                    *(f32x4*)(OUT + off) = x0 + acc[ai][bj][m][0]; *(f32x4*)(OUT + off + 4) = x1 + acc[ai][bj][m][1]; } }
    }
};
template <class Epi, class Sched, bool ALIGN_EPI = false, bool SP2 = false>
__device__ __forceinline__ void gemm_phase(PG8_LAS unsigned char* lds, const Gemm g, const Sched& S, const Epi& E) {
    const int tid = threadIdx.x, wid = __builtin_amdgcn_readfirstlane(tid >> 6), lane = tid & 63, wr = wid >> 2, wc = wid & 3, fr = lane & 15, fq = lane >> 4;
    const int K = g.K, nt = K / BK;
    unsigned voffA[2], voffB[2];
#pragma unroll
    for (int i = 0; i < 2; ++i) { int R, C; stage_rc(tid * 16 + i * 8192, R, C); const int Rb = Epi::PERM ? ((R & ~31) + perm32(R & 31)) : R;
        voffA[i] = (unsigned)(R * K + C) * 2u; voffB[i] = (unsigned)(Rb * K + C) * 2u; }
    const size_t kstep = (size_t)(BK * 2);
    const size_t hstep = (size_t)HALF * K * 2;
    const size_t tstep = 2 * hstep;
    const unsigned ldsw = (unsigned)wid * 1024u;
    const int aoff = lds_byte(wr * 64 + fr, fq * 8), boff = lds_byte(wc * 32 + fr, fq * 8);
#define PG8_SA(b, h) (((b) * 2 + (h)) * HTB)
#define PG8_SB(b, h) ((4 + (b) * 2 + (h)) * HTB)
#define PG8_STAGE(bufoff, gbase, voff) do { _Pragma("unroll") for (int _i = 0; _i < 2; ++_i) \
        __builtin_amdgcn_global_load_lds((const unsigned*)((const char*)(gbase) + (voff)[_i]), (PG8_LAS unsigned*)(lds + (bufoff) + ldsw + _i * 8192), 16, 0, 0); } while (0)
#define PG8_LDA(dst, b, h) do { _Pragma("unroll") for (int m = 0; m < 4; ++m) _Pragma("unroll") for (int k = 0; k < 2; ++k) dst[m][k] = *(const PG8_LAS bf16x8*)(lds + PG8_SA(b, h) + aoff + m * 2048 + k * 1024); } while (0)
#define PG8_LDB(dst, b, h) do { _Pragma("unroll") for (int n = 0; n < 2; ++n) _Pragma("unroll") for (int k = 0; k < 2; ++k) dst[n][k] = *(const PG8_LAS bf16x8*)(lds + PG8_SB(b, h) + boff + n * 2048 + k * 1024); } while (0)
#define PG8_MMA(ai, bj, At, Bt) do { __builtin_amdgcn_s_setprio(1); _Pragma("unroll") for (int m = 0; m < 4; ++m) _Pragma("unroll") for (int n = 0; n < 2; ++n) _Pragma("unroll") for (int k = 0; k < 2; ++k) \
        acc[ai][bj][m][n] = __builtin_amdgcn_mfma_f32_16x16x32_bf16(Bt[n][k], At[m][k], acc[ai][bj][m][n], 0, 0, 0); __builtin_amdgcn_s_setprio(0); } while (0)
#define PG8_WAIT_V(n) asm volatile("s_waitcnt vmcnt(" #n ")" ::: "memory")
#define PG8_WAIT_L(n) asm volatile("s_waitcnt lgkmcnt(" #n ")" ::: "memory")
#define PG8_BAR __builtin_amdgcn_s_barrier()
#define PG8_SCHED __builtin_amdgcn_sched_barrier(0)
    Unit cur, nxt; int ui = 0;
    if (!S.next(0, cur)) return;
    f32x4 acc[2][2][4][2];
#pragma unroll
    for (int a = 0; a < 2; ++a)
#pragma unroll
        for (int b = 0; b < 2; ++b)
#pragma unroll
            for (int m = 0; m < 4; ++m)
#pragma unroll
                for (int n = 0; n < 2; ++n) acc[a][b][m][n] = (f32x4){0.f, 0.f, 0.f, 0.f};
    bf16x8 At[4][2], B0[2][2], B1[2][2];
    const char* cA = (const char*)g.A + (size_t)cur.pm * tstep; const char* cB = (const char*)g.Bt + (size_t)cur.pn * tstep;
    S.a_ready(cur);
    if constexpr (SP2) {
        PG8_STAGE(PG8_SB(0, 0), cB, voffB); PG8_STAGE(PG8_SB(0, 1), cB + hstep, voffB); PG8_STAGE(PG8_SA(0, 0), cA, voffA); PG8_STAGE(PG8_SA(0, 1), cA + hstep, voffA);
        if (wr == 1) PG8_BAR;
        PG8_WAIT_V(2); PG8_BAR;
        PG8_STAGE(PG8_SB(1, 0), cB + kstep, voffB); PG8_STAGE(PG8_SA(1, 0), cA + kstep, voffA); PG8_STAGE(PG8_SB(1, 1), cB + hstep + kstep, voffB);
        PG8_WAIT_V(6); PG8_BAR;
    } else {
        PG8_STAGE(PG8_SB(0, 0), cB, voffB); PG8_STAGE(PG8_SA(0, 0), cA, voffA); PG8_STAGE(PG8_SB(0, 1), cB + hstep, voffB); PG8_STAGE(PG8_SA(0, 1), cA + hstep, voffA);
        if (wr == 1) PG8_BAR;
        PG8_WAIT_V(4); PG8_BAR;
        PG8_STAGE(PG8_SB(1, 0), cB + kstep, voffB); PG8_STAGE(PG8_SA(1, 0), cA + kstep, voffA); PG8_STAGE(PG8_SB(1, 1), cB + hstep + kstep, voffB);
        PG8_WAIT_V(6); PG8_BAR;
    }
    for (;;) {
        const bool has_next = S.next(ui + 1, nxt);
        const char* nA = has_next ? (const char*)g.A + (size_t)nxt.pm * tstep : cA; const char* nB = has_next ? (const char*)g.Bt + (size_t)nxt.pn * tstep : cB;
        for (int t = 0; t < nt; t += 2) {
            const bool last = (t == nt - 2);
            const char* a1 = cA + (size_t)(t + 1) * kstep;
            const char* a2 = last ? nA : cA + (size_t)(t + 2) * kstep; const char* b2 = last ? nB : cB + (size_t)(t + 2) * kstep;
            const char* a3 = a2 + kstep; const char* b3 = b2 + kstep;
            if (last && has_next) S.a_ready(nxt);
            if constexpr (SP2) {
            PG8_LDB(B0, 0, 0); PG8_LDB(B1, 0, 1); PG8_SCHED; PG8_LDA(At, 0, 0); PG8_STAGE(PG8_SA(1, 1), a1 + hstep, voffA);
            PG8_WAIT_V(8); PG8_WAIT_L(0); PG8_BAR; PG8_MMA(0, 0, At, B0); PG8_MMA(0, 1, At, B1); PG8_BAR; PG8_SCHED;
            PG8_LDA(At, 0, 1); PG8_STAGE(PG8_SB(0, 0), b2, voffB); PG8_STAGE(PG8_SB(0, 1), b2 + hstep, voffB); PG8_STAGE(PG8_SA(0, 0), a2, voffA);
            PG8_WAIT_V(8); PG8_WAIT_L(0); PG8_BAR; PG8_MMA(1, 0, At, B0); PG8_MMA(1, 1, At, B1); PG8_BAR; PG8_SCHED;
            PG8_LDB(B0, 1, 0); PG8_LDB(B1, 1, 1); PG8_SCHED; PG8_LDA(At, 1, 0); PG8_STAGE(PG8_SA(0, 1), a2 + hstep, voffA);
            PG8_WAIT_V(8); PG8_WAIT_L(0); PG8_BAR; PG8_MMA(0, 0, At, B0); PG8_MMA(0, 1, At, B1); PG8_BAR; PG8_SCHED;
            PG8_LDA(At, 1, 1); PG8_STAGE(PG8_SB(1, 0), b3, voffB); PG8_STAGE(PG8_SB(1, 1), b3 + hstep, voffB); PG8_STAGE(PG8_SA(1, 0), a3, voffA);
            PG8_WAIT_V(8); PG8_WAIT_L(0); PG8_BAR; PG8_MMA(1, 0, At, B0); PG8_MMA(1, 1, At, B1); PG8_BAR; PG8_SCHED;
            } else {
            PG8_LDB(B0, 0, 0); PG8_SCHED; PG8_LDA(At, 0, 0); PG8_STAGE(PG8_SA(1, 1), a1 + hstep, voffA);
            PG8_WAIT_L(8); PG8_BAR; PG8_WAIT_L(0); PG8_MMA(0, 0, At, B0); PG8_BAR; PG8_SCHED;
            PG8_LDB(B1, 0, 1); PG8_STAGE(PG8_SB(0, 0), b2, voffB);
            PG8_BAR; PG8_WAIT_L(0); PG8_MMA(0, 1, At, B1); PG8_BAR;
            PG8_LDA(At, 0, 1); PG8_STAGE(PG8_SA(0, 0), a2, voffA);
            PG8_BAR; PG8_WAIT_L(0); PG8_MMA(1, 0, At, B0); PG8_BAR; PG8_SCHED;
            PG8_STAGE(PG8_SB(0, 1), b2 + hstep, voffB);
            PG8_WAIT_V(6); PG8_BAR; PG8_MMA(1, 1, At, B1); PG8_BAR;
            PG8_LDB(B0, 1, 0); PG8_SCHED; PG8_LDA(At, 1, 0); PG8_STAGE(PG8_SA(0, 1), a2 + hstep, voffA);
            PG8_WAIT_L(8); PG8_BAR; PG8_WAIT_L(0); PG8_MMA(0, 0, At, B0); PG8_BAR; PG8_SCHED;
            PG8_LDB(B1, 1, 1); PG8_STAGE(PG8_SB(1, 0), b3, voffB);
            PG8_BAR; PG8_WAIT_L(0); PG8_MMA(0, 1, At, B1); PG8_BAR;
            PG8_LDA(At, 1, 1); PG8_STAGE(PG8_SA(1, 0), a3, voffA);
            PG8_BAR; PG8_WAIT_L(0); PG8_MMA(1, 0, At, B0); PG8_BAR; PG8_SCHED;
            PG8_STAGE(PG8_SB(1, 1), b3 + hstep, voffB);
            PG8_WAIT_V(6); PG8_BAR; PG8_MMA(1, 1, At, B1); PG8_BAR;
            }
        }
        if constexpr (ALIGN_EPI) { if (wr == 0) PG8_BAR; }
        if constexpr (!Epi::AFTER_DRAIN) { E(acc, cur, wr, wc, fr, fq); S.done(cur); }
        if (!has_next) break;
#pragma unroll
        for (int a = 0; a < 2; ++a)
#pragma unroll
            for (int b = 0; b < 2; ++b)
#pragma unroll
                for (int m = 0; m < 4; ++m)
#pragma unroll
                    for (int n = 0; n < 2; ++n) acc[a][b][m][n] = (f32x4){0.f, 0.f, 0.f, 0.f};
        cur = nxt; cA = nA; cB = nB; ++ui;
        if constexpr (ALIGN_EPI) { if (wr == 1) PG8_BAR; }
    }
    PG8_WAIT_V(0);
    if constexpr (!ALIGN_EPI) { if (wr == 0) PG8_BAR; }
    PG8_BAR;
    if constexpr (Epi::AFTER_DRAIN) { E.fused(acc, cur, wr, wc, fr, fq, lds, wid, lane); S.done(cur); }
#undef PG8_SA
#undef PG8_SB
#undef PG8_STAGE
#undef PG8_LDA
#undef PG8_LDB
#undef PG8_MMA
#undef PG8_WAIT_V
#undef PG8_WAIT_L
#undef PG8_BAR
#undef PG8_SCHED
}
}
#define GAS __attribute__((address_space(1)))
#define LAS __attribute__((address_space(3)))
typedef unsigned short bf16;
typedef unsigned v4u __attribute__((ext_vector_type(4)));
typedef float f32x4 __attribute__((ext_vector_type(4)));
typedef short bf16x8 __attribute__((ext_vector_type(8)));
typedef GAS unsigned gu32;
typedef GAS unsigned long long gu64;
#define RLX_AGENT __ATOMIC_RELAXED, __HIP_MEMORY_SCOPE_AGENT
#define LDS_WAIT() asm volatile("s_waitcnt lgkmcnt(0)" ::: "memory")
#define VM_WAIT() asm volatile("s_waitcnt vmcnt(0)" ::: "memory")
__device__ __forceinline__ unsigned long long rt() { return __builtin_amdgcn_s_memrealtime(); }
__device__ __forceinline__ unsigned f2bf(float f) { unsigned u = __builtin_bit_cast(unsigned, f); return (u + 0x7fffu + ((u >> 16) & 1u)) >> 16; }
__device__ __forceinline__ unsigned pk2(float lo, float hi) { return f2bf(lo) | (f2bf(hi) << 16); }

#define XB_TMO      128
#define XB_XCNT(j)  (256  + 64 * (j))
#define XB_XSUB(j)  (1280 + 64 * (j))
#define XB_XGEN(j)  (2304 + 64 * (j))
#define XB_TOP      3328
#define XB_TOPGEN   3392
#define XCD_BAR_WORDS 3456
#define XB_SPIN_CAP (1u << 18)

__device__ __forceinline__ unsigned xb_ld(unsigned* p)              { return __hip_atomic_load(p, __ATOMIC_RELAXED, __HIP_MEMORY_SCOPE_AGENT); }
__device__ __forceinline__ unsigned xb_add(unsigned* p, unsigned v) { return __hip_atomic_fetch_add(p, v, __ATOMIC_RELAXED, __HIP_MEMORY_SCOPE_AGENT); }
__device__ __forceinline__ unsigned xb_xcc_id() { return (unsigned)__builtin_amdgcn_s_getreg((3 << 11) | 20) & 0xFu; }
#define XB_SPIN(cond, bar) do { unsigned _sp = 0; while (cond) { __builtin_amdgcn_s_sleep(1); \
    if ((++_sp & 255u) == 0u) { if (xb_ld(&(bar)[XB_TMO])) break; if (_sp > XB_SPIN_CAP) { atomicAdd(&(bar)[XB_TMO], 1u); break; } } } } while (0)

struct XcdBarrier {
    unsigned* bar; unsigned x;
    volatile LAS unsigned* st;
};

__device__ __forceinline__ XcdBarrier xcd_barrier_post(unsigned* bar, volatile LAS unsigned* st) {
    XcdBarrier b; b.bar = bar; b.x = xb_xcc_id(); b.st = st;
    if (threadIdx.x == 0) (void)xb_add(&bar[XB_XCNT(b.x)], 1u);
    return b;
}
__device__ __forceinline__ void xcd_barrier_complete(unsigned* bar, unsigned x, unsigned& nloc, unsigned& nx) {
    const unsigned G = gridDim.x * gridDim.y * gridDim.z;
    unsigned sum, cnt, mine, sp = 0u;
    for (;;) {
        sum = 0u; cnt = 0u; mine = 0u;
#pragma unroll
        for (unsigned j = 0; j < 16; ++j) { const unsigned c = xb_ld(&bar[XB_XCNT(j)]); sum += c; cnt += (c > 0u) ? 1u : 0u; mine = (j == x) ? c : mine; }
        if (sum == G) break;
        __builtin_amdgcn_s_sleep(1);
        if ((++sp & 255u) == 0u) { if (xb_ld(&bar[XB_TMO])) break; if (sp > XB_SPIN_CAP) { atomicAdd(&bar[XB_TMO], 1u); break; } }
    }
    nloc = mine > 0u ? mine : 1u; nx = cnt > 0u ? cnt : 1u;
}

__device__ __forceinline__ void xcd_barrier(const XcdBarrier& b) {
    asm volatile("s_waitcnt vmcnt(0)" ::: "memory");
    __syncthreads();
    if (threadIdx.x == 0) {
        unsigned* bar = b.bar;
        __builtin_amdgcn_s_waitcnt(0);
        unsigned nloc = b.st[0], nx = b.st[1];
        if (nloc == 0u) { xcd_barrier_complete(bar, b.x, nloc, nx); b.st[0] = nloc; b.st[1] = nx; }
        const unsigned old = xb_add(&bar[XB_XSUB(b.x)], 1u);
        const unsigned gen = old / nloc;
        if (old + 1u == (gen + 1u) * nloc) {
            __builtin_amdgcn_fence(__ATOMIC_RELEASE, "agent");
            asm volatile("s_waitcnt vmcnt(0)" ::: "memory");
            const unsigned og = xb_add(&bar[XB_TOP], 1u);
            const unsigned tg = og / nx;
            if (og + 1u == (tg + 1u) * nx) xb_add(&bar[XB_TOPGEN], 1u);
            else XB_SPIN(xb_ld(&bar[XB_TOPGEN]) == tg, bar);
            __builtin_amdgcn_fence(__ATOMIC_ACQUIRE, "agent");
            xb_add(&bar[XB_XGEN(b.x)], 1u);
            asm volatile("s_waitcnt vmcnt(0)" ::: "memory");
        } else {
            XB_SPIN(xb_ld(&bar[XB_XGEN(b.x)]) == gen, bar);
            __builtin_amdgcn_fence(__ATOMIC_ACQUIRE, "agent");
            asm volatile("s_waitcnt vmcnt(0)" ::: "memory");
        }
    }
    __syncthreads();
}
constexpr int NWAVES = 8;
constexpr int BATCH = 4, T = 4096, D = 1024, M = BATCH * T;
constexpr int RWC = 1792;
constexpr int NG1 = 5376;
constexpr float NORM_EPS = 1e-6f, GN_EPS = 64e-5f;
constexpr float LOG2E = 1.4426950408889634f;
constexpr int N_PHASES = 11;
#ifndef MK_ONE_LAUNCH
#define MK_ONE_LAUNCH 0
#endif
#ifndef REP_MASK
#define REP_MASK 0
#endif
#ifndef P3REP
#define P3REP 1
#endif
#ifndef SCAN_BLOCKS
#define SCAN_BLOCKS 64
#endif

constexpr size_t MiB = 1u << 20;
constexpr size_t WS_CTL = 0, CTL_ZERO_BYTES = 1 * MiB;
constexpr size_t WS_WIN = 1 * MiB;
constexpr size_t WS_WA = 12 * MiB, WS_WB = 13 * MiB;
constexpr size_t WS_WOUT = 14 * MiB;
constexpr size_t WS_WQ = 16 * MiB;
constexpr size_t WS_CW1K = 20 * MiB, WS_CW1V = 21 * MiB;
constexpr size_t WS_CW2K = 22 * MiB, WS_CW2V = 22 * MiB + 65536;
constexpr size_t WS_SK1 = 22 * MiB + 131072, WS_SK2 = 22 * MiB + 196608;
constexpr size_t WS_BND = 23 * MiB;
constexpr size_t WS_KC = 25 * MiB;
constexpr size_t WS_VCT = 25 * MiB + 262144;
constexpr size_t WS_H = 26 * MiB;
constexpr size_t WS_PRW = 58 * MiB;
constexpr size_t WS_MG = 170 * MiB;
constexpr size_t WS_VST = 234 * MiB, WS_VWT = 238 * MiB;
constexpr size_t WS_END = 256 * MiB;
constexpr size_t DO_PNSA = 0, DO_G = 40 * MiB, DO_GLOG = 56 * MiB;
constexpr int CW_TMO = 0, CW_CODE = 1, CW_NSAQ = 64, CW_BAR = 4096;

constexpr int RING_OFF = 0, RING_BYTES = 131072;
constexpr int LDSCTL_OFF = RING_BYTES, MISC_OFF = LDSCTL_OFF + 320;
constexpr int LDS_BYTES = 147456;
typedef unsigned short u16;
typedef unsigned u32x2 __attribute__((ext_vector_type(2)));
struct Frame {
    LAS unsigned char* lds;
    volatile LAS unsigned* MISC;
    gu32* ctl;
    int tid, lane, wave, vcu, G;
    const float* in[33];
    float* out; unsigned char* ws;
};
__device__ __forceinline__ float wave_sum(float v) {
#pragma unroll
    for (int o = 1; o < 64; o <<= 1) v += __shfl_xor(v, o);
    return v;
}
__device__ __forceinline__ float bf2f(u16 b) { return __uint_as_float((unsigned)b << 16); }
__device__ __forceinline__ float bflo(unsigned w) { return __uint_as_float(w << 16); }
__device__ __forceinline__ float bfhi(unsigned w) { return __uint_as_float(w & 0xffff0000u); }
__device__ __forceinline__ u16 f2b(float f) { return (u16)f2bf(f); }
__device__ __forceinline__ float sigmf(float x) { return 1.0f / (1.0f + __expf(-x)); }
__device__ __forceinline__ f32x4 mfma16(const bf16x8 a, const bf16x8 b, const f32x4 c) { return __builtin_amdgcn_mfma_f32_16x16x32_bf16(a, b, c, 0, 0, 0); }
__device__ __forceinline__ bf16x8 as_bf16x8(const v4u v) { return __builtin_bit_cast(bf16x8, v); }

__device__ __forceinline__ void tr_item(const float* W, int K, int ldw, int sc0, int nblk, int ncols_valid, bf16* WT, int dr0, LAS float* scr, int item, int lane) {
    const int kb = item / nblk, nb = item % nblk, k0 = 64 * kb, n0 = 32 * nb;
#pragma unroll 8
    for (int i = 0; i < 32; ++i) { const int kk = 2 * i + (lane >> 5); const int n = n0 + (lane & 31);
        scr[kk * 33 + (lane & 31)] = (n < ncols_valid) ? W[(size_t)(k0 + kk) * ldw + sc0 + n] : 0.f; }
    LDS_WAIT(); asm volatile("" ::: "memory");
    const int c = lane & 7;
#pragma unroll
    for (int j = 0; j < 4; ++j) { const int n = (lane >> 3) + 8 * j; const LAS float* s = scr + (8 * c) * 33 + n;
        v4u o; o.x = pk2(s[0 * 33], s[1 * 33]); o.y = pk2(s[2 * 33], s[3 * 33]); o.z = pk2(s[4 * 33], s[5 * 33]); o.w = pk2(s[6 * 33], s[7 * 33]);
        *(GAS v4u*)(WT + (size_t)(dr0 + n0 + n) * K + k0 + 8 * c) = o; }
    LDS_WAIT(); asm volatile("" ::: "memory");
}
__device__ __forceinline__ void rms_row_to_bf16(int lane, const float* xrow, const float* gain, bf16* orow) {
    const GAS f32x4* xr = (const GAS f32x4*)xrow + lane; const GAS f32x4* gr = (const GAS f32x4*)gain + lane;
    f32x4 v[4]; float s2 = 0.f;
#pragma unroll
    for (int j = 0; j < 4; ++j) { v[j] = xr[64 * j]; s2 += (v[j].x * v[j].x + v[j].y * v[j].y) + (v[j].z * v[j].z + v[j].w * v[j].w); }
    const float rstd = 1.f / sqrtf(wave_sum(s2) * (1.f / D) + NORM_EPS);
    GAS unsigned long long* o8 = (GAS unsigned long long*)orow + lane;
#pragma unroll
    for (int j = 0; j < 4; ++j) { const f32x4 g = gr[64 * j];
        o8[64 * j] = (unsigned long long)pk2(v[j].x * rstd * g.x, v[j].y * rstd * g.y) | ((unsigned long long)pk2(v[j].z * rstd * g.z, v[j].w * rstd * g.w) << 32); }
}
__device__ __forceinline__ void p0_prologue(const Frame& F) {
    LAS float* scr = (LAS float*)(F.lds + RING_OFF + F.wave * 16384);
    const int gw = F.vcu * NWAVES + F.wave, NGW = F.G * NWAVES;
    unsigned char* ws = F.ws;
    constexpr int I0 = 16 * 96, I1 = 16 * 64, I2 = 16 * 8, I3 = 8 * 32, I4 = 8 * 32, I5 = 16 * 32, I6 = 16 * 64, I7 = 32 * 8, I8 = 32 * 8, I9 = 4 * 2, I10 = 4 * 2;
    constexpr int NITEMS = I0 + I1 + I2 + I3 + I4 + I5 + I6 + I7 + I8 + I9 + I10;
    for (int it = gw; it < NITEMS; it += NGW) {
        int r = it;
        if (r < I0) { tr_item(F.in[2], 1024, 5144, 0, 96, 3072, (bf16*)(ws + WS_WIN), 0, scr, r, F.lane); continue; } r -= I0;
        if (r < I1) { tr_item(F.in[2], 1024, 5144, 3096, 64, 2048, (bf16*)(ws + WS_WIN), 3072, scr, r, F.lane); continue; } r -= I1;
        if (r < I2) { tr_item(F.in[2], 1024, 5144, 3072, 8, 24, (bf16*)(ws + WS_WIN), 5120, scr, r, F.lane); continue; } r -= I2;
        if (r < I3) { tr_item(F.in[24], 512, 1024, 0, 32, 1024, (bf16*)(ws + WS_WA), 0, scr, r, F.lane); continue; } r -= I3;
        if (r < I4) { tr_item(F.in[25], 512, 1024, 0, 32, 1024, (bf16*)(ws + WS_WB), 0, scr, r, F.lane); continue; } r -= I4;
        if (r < I5) { tr_item(F.in[26], 1024, 1024, 0, 32, 1024, (bf16*)(ws + WS_WOUT), 0, scr, r, F.lane); continue; } r -= I5;
        if (r < I6) { tr_item(F.in[28], 1024, 2048, 0, 64, 2048, (bf16*)(ws + WS_WQ), 0, scr, r, F.lane); continue; } r -= I6;
        if (r < I7) { tr_item(F.in[20], 2048, 256, 0, 8, 256, (bf16*)(ws + WS_CW1K), 0, scr, r, F.lane); continue; } r -= I7;
        if (r < I8) { tr_item(F.in[22], 2048, 256, 0, 8, 256, (bf16*)(ws + WS_CW1V), 0, scr, r, F.lane); continue; } r -= I8;
        if (r < I9) { tr_item(F.in[21], 256, 64, 0, 2, 64, (bf16*)(ws + WS_CW2K), 0, scr, r, F.lane); continue; } r -= I9;
        tr_item(F.in[23], 256, 64, 0, 2, 64, (bf16*)(ws + WS_CW2V), 0, scr, r, F.lane);
    }
    { const int gt = F.vcu * (NWAVES * 64) + F.tid, NT = F.G * NWAVES * 64;
      bf16* s1 = (bf16*)(ws + WS_SK1); bf16* s2 = (bf16*)(ws + WS_SK2);
      for (int i = gt; i < 128 * 128; i += NT) { s1[i] = f2b(F.in[29][i]); s2[i] = f2b(F.in[30][i]); } }
    for (int m = gw; m < M; m += NGW) rms_row_to_bf16(F.lane, F.in[0] + (size_t)m * D, F.in[1], (bf16*)(ws + WS_H) + (size_t)m * D);
}
__device__ __forceinline__ void rwkv_prep_tile(const Frame& F, int u) {
    const int tid = F.tid, lane = F.lane, h = F.wave;
    const int R0 = 64 * u, t0 = R0 & (T - 1);
    LAS float* lin = (LAS float*)(F.lds);
    float* PRW = (float*)(F.ws + WS_PRW);
    const float* BND = (const float*)(F.ws + WS_BND);
    bf16* G = (bf16*)((unsigned char*)F.out + DO_G);
    const float* mu = F.in[3];
    const float mu_r = mu[tid], mu_k = mu[512 + tid], mu_v = mu[1024 + tid], mu_l = (tid < 256) ? mu[1536 + tid] : 0.f;
    const float w0c = F.in[4][tid], a0c = F.in[6][tid], kkc = F.in[9][tid], kac = F.in[10][tid];
    const float* w_up = F.in[5]; const float* a_up = F.in[7]; const float* g_up = F.in[8];
    float pr = 0.f, pk = 0.f, pv = 0.f, pl = 0.f;
    if (t0 != 0) { const float* b = BND + (size_t)(u - 1) * RWC; pr = b[tid]; pk = b[512 + tid]; pv = b[1024 + tid]; if (tid < 256) pl = b[1536 + tid]; }
    for (int batch = 0; batch < 4; ++batch) {
        const int Rb = R0 + 16 * batch;
        float xr[16], xk[16], xv[16], xl[16];
#pragma unroll
        for (int j = 0; j < 16; ++j) { const float* p = PRW + (size_t)(Rb + j) * RWC; xr[j] = p[tid]; xk[j] = p[512 + tid]; xv[j] = p[1024 + tid]; xl[j] = (tid < 256) ? p[1536 + tid] : 0.f; }
        VM_WAIT();
#pragma unroll
        for (int j = 0; j < 16; ++j) { float n;
            n = xr[j]; xr[j] = n + (pr - n) * mu_r; pr = n;
            n = xk[j]; xk[j] = n + (pk - n) * mu_k; pk = n;
            n = xv[j]; xv[j] = n + (pv - n) * mu_v; pv = n;
            n = xl[j]; xl[j] = n + (pl - n) * mu_l; pl = n; }
        if (tid < 256) {
#pragma unroll
            for (int j = 0; j < 16; ++j) { const float v = xl[j]; const float f = (tid < 64) ? tanhf(v) : ((tid < 128) ? v : sigmf(v)); lin[tid * 16 + j] = f; }
        }
        __syncthreads();
        float accw[16], acca[16], accg[16];
#pragma unroll
        for (int j = 0; j < 16; ++j) { accw[j] = 0.f; acca[j] = 0.f; accg[j] = 0.f; }
#pragma unroll 2
        for (int jj = 0; jj < 64; ++jj) { const float wv = w_up[jj * 512 + tid], av = a_up[jj * 512 + tid];
            const LAS f32x4* iw = (const LAS f32x4*)(lin + jj * 16); const LAS f32x4* ia = (const LAS f32x4*)(lin + (64 + jj) * 16);
#pragma unroll
            for (int q = 0; q < 4; ++q) { const f32x4 a = iw[q], b = ia[q];
#pragma unroll
                for (int e = 0; e < 4; ++e) { accw[4 * q + e] += a[e] * wv; acca[4 * q + e] += b[e] * av; } } }
#pragma unroll 2
        for (int jj = 0; jj < 128; ++jj) { const float gv = g_up[jj * 512 + tid];
            const LAS f32x4* ig = (const LAS f32x4*)(lin + (128 + jj) * 16);
#pragma unroll
            for (int q = 0; q < 4; ++q) { const f32x4 a = ig[q];
#pragma unroll
                for (int e = 0; e < 4; ++e) accg[4 * q + e] += a[e] * gv; } }
#pragma unroll
        for (int j = 0; j < 16; ++j) { const int row = Rb + j;
            const float z = -(w0c + accw[j]); const float sp = fmaxf(z, 0.f) + log1pf(__expf(-fabsf(z)));
            const float e = __expf(-sp - 0.5f); const float omw = -expm1f(-e);
            const float a = sigmf(a0c + acca[j]);
            const float kkv = xk[j] * kkc, kmod = xk[j] * (1.f + (a - 1.f) * kac);
            const float ss = wave_sum(kkv * kkv); const float kkn = kkv / fmaxf(sqrtf(ss), 1e-12f);
            bf16* rec = (bf16*)(PRW + (size_t)row * RWC) + h * 384;
            rec[lane] = f2b(xr[j]); rec[64 + lane] = f2b(omw); rec[128 + lane] = f2b(kmod); rec[192 + lane] = f2b(xv[j]); rec[256 + lane] = f2b(kkn); rec[320 + lane] = f2b(a);
            G[(size_t)row * 512 + tid] = f2b(accg[j]); }
        __syncthreads();
    }
}
__device__ __forceinline__ void nsa_prep_tile(const Frame& F, int u) {
    const int lane = F.lane, w = F.wave;
    const int R0 = 64 * u, t0 = R0 & (T - 1), b = R0 / T;
    bf16* PNSA = (bf16*)((unsigned char*)F.out + DO_PNSA);
    const float qg = F.in[14][lane] * (0.125f * LOG2E);
    const float kg = (w < 2) ? F.in[16][lane] : F.in[17][lane];
    const int kcol = ((w < 2) ? 768 : 1024) + (w & 1) * 64 + lane;
    for (int tok = 0; tok < 64; ++tok) { bf16* p = PNSA + (size_t)(R0 + tok) * 1280;
        const float q = bf2f(p[w * 64 + lane]); const float ss = wave_sum(q * q) * (1.f / 64.f);
        float k = 0.f; if (w < 4) k = bf2f(p[kcol]);
        const float ks = wave_sum(k * k) * (1.f / 64.f);
        p[w * 64 + lane] = f2b(q * rsqrtf(ss + NORM_EPS) * qg);
        if (w < 4) p[kcol] = f2b(k * rsqrtf(ks + NORM_EPS) * kg); }
    if (w >= 4) {
        const int g = w & 1; const int scol = ((w < 6) ? 896 : 1152) + g * 64;
        bf16* VT = (bf16*)(F.ws + ((w < 6) ? WS_VST : WS_VWT)) + (size_t)((b * 2 + g) * 64) * T + t0 + lane;
        const v4u* src = (const v4u*)(PNSA + (size_t)(R0 + lane) * 1280 + scol);
        v4u v[8];
#pragma unroll
        for (int i = 0; i < 8; ++i) v[i] = src[i];
#pragma unroll
        for (int i = 0; i < 8; ++i) {
            VT[(size_t)(8 * i + 0) * T] = (u16)(v[i].x & 0xffffu); VT[(size_t)(8 * i + 1) * T] = (u16)(v[i].x >> 16);
            VT[(size_t)(8 * i + 2) * T] = (u16)(v[i].y & 0xffffu); VT[(size_t)(8 * i + 3) * T] = (u16)(v[i].y >> 16);
            VT[(size_t)(8 * i + 4) * T] = (u16)(v[i].z & 0xffffu); VT[(size_t)(8 * i + 5) * T] = (u16)(v[i].z >> 16);
            VT[(size_t)(8 * i + 6) * T] = (u16)(v[i].w & 0xffffu); VT[(size_t)(8 * i + 7) * T] = (u16)(v[i].w >> 16); }
    }
}
__device__ __forceinline__ float gelu_tanh(float x) { const float t = 0.7978845608028654f * (x + 0.044715f * x * x * x); return 0.5f * x * (1.f + tanhf(t)); }
__device__ __forceinline__ void compress_unit(const Frame& F, int u) {
    const int lane = F.lane, w = F.wave, r16 = lane & 15, q4 = lane >> 4;
    const int kvsel = u >> 7, b = (u >> 5) & 3, g = (u >> 4) & 1, ntile = u & 15;
    const bf16* X = (const bf16*)((unsigned char*)F.out + DO_PNSA) + (size_t)(b * T) * 1280 + (kvsel ? 640 : 512) + g * 64;
    const float* pos = kvsel ? F.in[19] : F.in[18];
    const bf16* W1t = (const bf16*)(F.ws + (kvsel ? WS_CW1V : WS_CW1K));
    const bf16* W2t = (const bf16*)(F.ws + (kvsel ? WS_CW2V : WS_CW2K));
    LAS bf16* hid = (LAS bf16*)(F.lds);
    LAS float* outb = (LAS float*)(F.lds + 16 * 528);
    int n = 16 * ntile + r16; if (n > 254) n = 254;
    f32x4 acc[2] = {{0.f, 0.f, 0.f, 0.f}, {0.f, 0.f, 0.f, 0.f}};
#pragma unroll 4
    for (int s = 0; s < 64; ++s) { const int lp = s >> 1, d0 = (s & 1) * 32 + 8 * q4;
        const v4u xa = *(const v4u*)(X + (size_t)(16 * n + lp) * 1280 + d0);
        const f32x4 p0 = *(const f32x4*)(pos + lp * 64 + d0), p1 = *(const f32x4*)(pos + lp * 64 + d0 + 4);
        v4u af; af.x = pk2(bflo(xa.x) + p0[0], bfhi(xa.x) + p0[1]); af.y = pk2(bflo(xa.y) + p0[2], bfhi(xa.y) + p0[3]);
        af.z = pk2(bflo(xa.z) + p1[0], bfhi(xa.z) + p1[1]); af.w = pk2(bflo(xa.w) + p1[2], bfhi(xa.w) + p1[3]);
#pragma unroll
        for (int nt = 0; nt < 2; ++nt) { const v4u bfg = *(const v4u*)(W1t + (size_t)(32 * w + 16 * nt + r16) * 2048 + 32 * s + 8 * q4);
            acc[nt] = mfma16(as_bf16x8(af), as_bf16x8(bfg), acc[nt]); } }
#pragma unroll
    for (int nt = 0; nt < 2; ++nt)
#pragma unroll
        for (int r = 0; r < 4; ++r) hid[(4 * q4 + r) * 264 + 32 * w + 16 * nt + r16] = f2b(gelu_tanh(acc[nt][r]));
    __syncthreads();
    if (w < 4) { f32x4 a2 = {0.f, 0.f, 0.f, 0.f};
#pragma unroll
        for (int s = 0; s < 8; ++s) { const v4u af = *(const LAS v4u*)(hid + r16 * 264 + 32 * s + 8 * q4);
            const v4u bfg = *(const v4u*)(W2t + (size_t)(16 * w + r16) * 256 + 32 * s + 8 * q4);
            a2 = mfma16(as_bf16x8(af), as_bf16x8(bfg), a2); }
#pragma unroll
        for (int r = 0; r < 4; ++r) outb[(4 * q4 + r) * 64 + 16 * w + r16] = a2[r]; }
    __syncthreads();
#pragma unroll
    for (int rr = 0; rr < 2; ++rr) { const int row = 2 * w + rr; const int nn = 16 * ntile + row; float val = outb[row * 64 + lane];
        if (kvsel == 0) { const float ss = wave_sum(val * val) * (1.f / 64.f); val = val * rsqrtf(ss + NORM_EPS) * F.in[15][lane];
            ((bf16*)(F.ws + WS_KC))[(size_t)((b * 2 + g) * 256 + nn) * 64 + lane] = (nn < 255) ? f2b(val) : (u16)0; }
        else ((bf16*)(F.ws + WS_VCT))[(size_t)((b * 2 + g) * 64 + lane) * 256 + nn] = (nn < 255) ? f2b(val) : (u16)0; }
    __syncthreads();
}
struct KFr { bf16x8 a0, a1, b0, b1; };
__device__ __forceinline__ KFr load_k(const bf16* Kb, int rstride, int k0, int r16, int q4) {
    const int keyA = k0 + 8 * (r16 >> 2) + (r16 & 3);
    const bf16* pa = Kb + (size_t)keyA * rstride + 8 * q4; const bf16* pb = pa + (size_t)4 * rstride;
    KFr f; f.a0 = as_bf16x8(*(const v4u*)pa); f.a1 = as_bf16x8(*(const v4u*)(pa + 32)); f.b0 = as_bf16x8(*(const v4u*)pb); f.b1 = as_bf16x8(*(const v4u*)(pb + 32)); return f;
}
struct VFr { bf16x8 v[4]; };
__device__ __forceinline__ VFr load_v(const bf16* Vt, int dstride, int k0, int r16, int q4) {
    VFr f;
#pragma unroll
    for (int dt = 0; dt < 4; ++dt) f.v[dt] = as_bf16x8(*(const v4u*)(Vt + (size_t)(16 * dt + r16) * dstride + k0 + 8 * q4));
    return f;
}
__device__ __forceinline__ bf16x8 pack_p(const f32x4 a, const f32x4 b) {
    v4u w; w.x = pg8::cvt_pk_bf16(a[0], a[1]); w.y = pg8::cvt_pk_bf16(a[2], a[3]); w.z = pg8::cvt_pk_bf16(b[0], b[1]); w.w = pg8::cvt_pk_bf16(b[2], b[3]); return as_bf16x8(w);
}
#define NSA_FENCE() asm volatile("s_waitcnt lgkmcnt(0)" ::: "memory")
__device__ __forceinline__ void nsa_wave_unit(const Frame& F, int b, int g, int t0, LAS float* wl) {
    const int lane = F.lane, r16 = lane & 15, q4 = lane >> 4;
    const f32x4 Z4 = {0.f, 0.f, 0.f, 0.f};
    const bf16* PN = (const bf16*)((unsigned char*)F.out + DO_PNSA) + (size_t)(b * T) * 1280;
    const float* GL = (const float*)((unsigned char*)F.out + DO_GLOG) + (size_t)(b * T) * 32;
    LAS float* impT = wl; LAS float* imp2T = wl + 8 * 65; LAS unsigned* selT = (LAS unsigned*)(wl + 16 * 65);
    bf16x8 qf[2][2]; int tq[2];
#pragma unroll
    for (int mt = 0; mt < 2; ++mt) { tq[mt] = t0 + 4 * mt + (r16 >> 2);
#pragma unroll
        for (int dh = 0; dh < 2; ++dh) qf[mt][dh] = as_bf16x8(*(const v4u*)(PN + (size_t)tq[mt] * 1280 + (g * 4 + (r16 & 3)) * 64 + 32 * dh + 8 * q4)); }
    f32x4 Oc[2][4];
#pragma unroll
    for (int mt = 0; mt < 2; ++mt)
#pragma unroll
        for (int dt = 0; dt < 4; ++dt) Oc[mt][dt] = Z4;
    float gate[2][4][3];
#pragma unroll
    for (int mt = 0; mt < 2; ++mt)
#pragma unroll
        for (int r = 0; r < 4; ++r)
#pragma unroll
            for (int br = 0; br < 3; ++br) gate[mt][r][br] = sigmf(GL[(size_t)(t0 + 4 * mt + q4) * 32 + g * 12 + r * 3 + br]);

    const bf16* KC = (const bf16*)(F.ws + WS_KC) + (size_t)((b * 2 + g) * 256) * 64;
    const bf16* VCT = (const bf16*)(F.ws + WS_VCT) + (size_t)((b * 2 + g) * 64) * 256;
    for (int i = lane; i < 16 * 65; i += 64) wl[i] = 0.f;
    const int ncmp = (t0 + 7 >= 31) ? ((t0 + 7 - 31) >> 4) + 1 : 0;
    const int nst = (ncmp + 31) >> 5;
    float inv[2] = {0.f, 0.f};
    {   float ls[2] = {0.f, 0.f};
        for (int st = 0; st < nst; ++st) { const int k0 = 32 * st; const KFr kf = load_k(KC, 64, k0, r16, q4);
#pragma unroll
            for (int mt = 0; mt < 2; ++mt) { f32x4 sA = mfma16(kf.a0, qf[mt][0], Z4); sA = mfma16(kf.a1, qf[mt][1], sA); f32x4 sB = mfma16(kf.b0, qf[mt][0], Z4); sB = mfma16(kf.b1, qf[mt][1], sB);
#pragma unroll
                for (int r = 0; r < 4; ++r) { const int nA = k0 + 8 * q4 + r, nB = nA + 4;
                    ls[mt] += (16 * nA + 31 <= tq[mt]) ? __builtin_amdgcn_exp2f(sA[r]) : 0.f; ls[mt] += (16 * nB + 31 <= tq[mt]) ? __builtin_amdgcn_exp2f(sB[r]) : 0.f; } } }
#pragma unroll
        for (int mt = 0; mt < 2; ++mt) { float l = ls[mt]; l += __shfl_xor(l, 16); l += __shfl_xor(l, 32); inv[mt] = 1.0f / fmaxf(l, 1e-30f); }
    }
    {   f32x4 O[2][4];
#pragma unroll
        for (int mt = 0; mt < 2; ++mt)
#pragma unroll
            for (int dt = 0; dt < 4; ++dt) O[mt][dt] = Z4;
        for (int st = 0; st < nst; ++st) { const int k0 = 32 * st; const KFr kf = load_k(KC, 64, k0, r16, q4); const VFr vf = load_v(VCT, 256, k0, r16, q4);
#pragma unroll
            for (int mt = 0; mt < 2; ++mt) { f32x4 sA = mfma16(kf.a0, qf[mt][0], Z4); sA = mfma16(kf.a1, qf[mt][1], sA); f32x4 sB = mfma16(kf.b0, qf[mt][0], Z4); sB = mfma16(kf.b1, qf[mt][1], sB);
                f32x4 pA, pB;
#pragma unroll
                for (int r = 0; r < 4; ++r) { const int nA = k0 + 8 * q4 + r, nB = nA + 4;
                    pA[r] = (16 * nA + 31 <= tq[mt]) ? __builtin_amdgcn_exp2f(sA[r]) * inv[mt] : 0.f; pB[r] = (16 * nB + 31 <= tq[mt]) ? __builtin_amdgcn_exp2f(sB[r]) * inv[mt] : 0.f; }
                float vA = pA[0] + pA[1] + pA[2] + 0.5f * pA[3], cA = 0.5f * pA[3], vB = pB[0] + pB[1] + pB[2] + 0.5f * pB[3], cB = 0.5f * pB[3];
                vA += __shfl_xor(vA, 1); vA += __shfl_xor(vA, 2); cA += __shfl_xor(cA, 1); cA += __shfl_xor(cA, 2);
                vB += __shfl_xor(vB, 1); vB += __shfl_xor(vB, 2); cB += __shfl_xor(cB, 1); cB += __shfl_xor(cB, 2);
                if ((lane & 3) == 0) { const int tl = 4 * mt + (r16 >> 2), j = (k0 >> 2) + 2 * q4;
                    impT[tl * 65 + j] = vA; imp2T[tl * 65 + j + 1] = cA; impT[tl * 65 + j + 1] = vB; imp2T[tl * 65 + j + 2] = cB; }
                const bf16x8 pf = pack_p(pA, pB);
#pragma unroll
                for (int dt = 0; dt < 4; ++dt) O[mt][dt] = mfma16(pf, vf.v[dt], O[mt][dt]); } }
#pragma unroll
        for (int mt = 0; mt < 2; ++mt)
#pragma unroll
            for (int dt = 0; dt < 4; ++dt)
#pragma unroll
                for (int r = 0; r < 4; ++r) Oc[mt][dt][r] += gate[mt][r][0] * O[mt][dt][r];
    }
    NSA_FENCE();
    const int cur = t0 >> 6;
    unsigned long long uni = 0ull;
    for (int tl = 0; tl < 8; ++tl) {
        unsigned long long mask;
        if (cur < 16) mask = (2ull << cur) - 1ull;
        else {
            const float sc = impT[tl * 65 + lane] + imp2T[tl * 65 + lane];
            const unsigned key = __float_as_uint(fmaxf(sc, 0.f));
            const bool elig = (lane <= cur) && (lane != 0) && (lane != cur) && (lane != cur - 1);
            unsigned prefix = 0u;
            for (int bit = 30; bit >= 0; --bit) { const unsigned cand = prefix | (1u << bit);
                const int cnt = __popcll(__ballot(elig && key >= cand)); if (cnt >= 13) prefix = cand; }
            const unsigned long long gt = __ballot(elig && key > prefix); unsigned long long ties = __ballot(elig && key == prefix);
            int need = 13 - __popcll(gt); unsigned long long keep = 0ull;
            while (need > 0 && ties) { const unsigned long long low = ties & (0ull - ties); keep |= low; ties ^= low; --need; }
            mask = gt | keep | 1ull | (1ull << cur) | (1ull << (cur - 1));
        }
        uni |= mask;
        if (lane == 0) { selT[2 * tl] = (unsigned)mask; selT[2 * tl + 1] = (unsigned)(mask >> 32); }
    }
    NSA_FENCE();
    unsigned long long mk[2];
#pragma unroll
    for (int mt = 0; mt < 2; ++mt) { const int tl = 4 * mt + (r16 >> 2); mk[mt] = (unsigned long long)selT[2 * tl] | ((unsigned long long)selT[2 * tl + 1] << 32); }
    NSA_FENCE();

#pragma unroll 1
    for (int br = 1; br < 3; ++br) {
        const bf16* Kb = PN + (br == 1 ? 768 : 1024) + g * 64;
        const bf16* Vt = (const bf16*)(F.ws + (br == 1 ? WS_VST : WS_VWT)) + (size_t)((b * 2 + g) * 64) * T;
        f32x4 O[2][4]; float ls[2] = {0.f, 0.f};
#pragma unroll
        for (int mt = 0; mt < 2; ++mt)
#pragma unroll
            for (int dt = 0; dt < 4; ++dt) O[mt][dt] = Z4;
        int k0 = 0, kend = 0; unsigned long long rem = uni;
        if (br == 2) { const int lo = t0 - 511; k0 = (lo > 0 ? lo : 0) & ~31; kend = t0 + 8; }
        for (;;) {
            int j = 0;
            if (br == 1) { if (k0 == kend) { if (!rem) break; j = __builtin_ctzll(rem); rem &= rem - 1; k0 = 64 * j; kend = k0 + 64; } else j = k0 >> 6; }
            else { if (k0 >= kend) break; }
            const KFr kf = load_k(Kb, 1280, k0, r16, q4); const VFr vf = load_v(Vt, T, k0, r16, q4);
#pragma unroll
            for (int mt = 0; mt < 2; ++mt) { f32x4 sA = mfma16(kf.a0, qf[mt][0], Z4); sA = mfma16(kf.a1, qf[mt][1], sA); f32x4 sB = mfma16(kf.b0, qf[mt][0], Z4); sB = mfma16(kf.b1, qf[mt][1], sB);
                f32x4 pA, pB; const bool sb = (br == 1) ? (((mk[mt] >> j) & 1ull) != 0ull) : true;
#pragma unroll
                for (int r = 0; r < 4; ++r) { const int kA = k0 + 8 * q4 + r, kB = kA + 4;
                    const bool mA = sb && (kA <= tq[mt]) && (br == 1 || kA + 512 > tq[mt]), mB = sb && (kB <= tq[mt]) && (br == 1 || kB + 512 > tq[mt]);
                    pA[r] = mA ? __builtin_amdgcn_exp2f(sA[r]) : 0.f; pB[r] = mB ? __builtin_amdgcn_exp2f(sB[r]) : 0.f; }
                ls[mt] += (pA[0] + pA[1]) + (pA[2] + pA[3]) + (pB[0] + pB[1]) + (pB[2] + pB[3]);
                const bf16x8 pf = pack_p(pA, pB);
#pragma unroll
                for (int dt = 0; dt < 4; ++dt) O[mt][dt] = mfma16(pf, vf.v[dt], O[mt][dt]); }
            k0 += 32;
        }
#pragma unroll
        for (int mt = 0; mt < 2; ++mt) { float l = ls[mt]; l += __shfl_xor(l, 16); l += __shfl_xor(l, 32); const float il = 1.0f / fmaxf(l, 1e-30f);
#pragma unroll
            for (int r = 0; r < 4; ++r) { const float ilr = __shfl(il, 4 * q4 + r) * (br == 1 ? gate[mt][r][1] : gate[mt][r][2]);
#pragma unroll
                for (int dt = 0; dt < 4; ++dt) Oc[mt][dt][r] += ilr * O[mt][dt][r]; } }
    }
    bf16* YB = (bf16*)(F.ws + WS_H + 16 * MiB) + (size_t)(b * T) * 512;
#pragma unroll
    for (int mt = 0; mt < 2; ++mt)
#pragma unroll
        for (int r = 0; r < 4; ++r)
#pragma unroll
            for (int dt = 0; dt < 4; ++dt) YB[(size_t)(t0 + 4 * mt + q4) * 512 + (g * 4 + r) * 64 + 16 * dt + r16] = f2b(Oc[mt][dt][r]);
}
__device__ __forceinline__ void nsa_phase(const Frame& F, int rep) {
    LAS float* wl = (LAS float*)(F.lds + F.wave * 4608);
    for (;;) {
        unsigned c = 0;
        if (F.lane == 0) c = __hip_atomic_fetch_add(F.ctl + CW_NSAQ + 64 * rep, 1u, RLX_AGENT);
        c = (unsigned)__builtin_amdgcn_readfirstlane((int)c);
        if (c >= 4096u) break;
        const int b = c & 3, g = (c >> 2) & 1, tqi = 511 - (int)(c >> 3);
        nsa_wave_unit(F, b, g, 8 * tqi, wl);
    }
}
template <int CTRL> __device__ __forceinline__ float dppf(float x) { return __builtin_bit_cast(float, __builtin_amdgcn_update_dpp(0, __builtin_bit_cast(int, x), CTRL, 0xf, 0xf, true)); }
__device__ __forceinline__ float allsum16(float x) { x += dppf<0x128>(x); x += dppf<0x124>(x); x += dppf<0x122>(x); x += dppf<0x121>(x); return x; }
__device__ __forceinline__ f32x4 unpk4(const u32x2 w) { f32x4 r; r[0] = bflo(w.x); r[1] = bfhi(w.x); r[2] = bflo(w.y); r[3] = bfhi(w.y); return r; }
__device__ __forceinline__ void rwkv_scan_block(const Frame& F, int sb) {
    const int tid = F.tid, lane = F.lane, w = F.wave;
    const int bh = sb >> 1, half = sb & 1, b = bh >> 3, h = bh & 7;
    const int lrow = 4 * w + (lane >> 4), kq = lane & 15;
    LAS float* buf = (LAS float*)F.lds;
    LAS float* ybuf = (LAS float*)(F.lds + 98304);
    const unsigned char* recb = F.ws + WS_PRW + (size_t)(b * T) * 7168 + h * 768;
    unsigned char* yb8 = F.ws + WS_PRW + (size_t)(b * T) * 7168 + 6144 + h * 128 + half * 64;
    const int fs = tid >> 4, o4 = (tid & 15) * 4;
    u32x2 st[6];
#define SCAN_LOAD(c) do { _Pragma("unroll") for (int sec = 0; sec < 6; ++sec) st[sec] = *(const u32x2*)(recb + (size_t)(32 * (c) + fs) * 7168 + sec * 128 + o4 * 2); } while (0)
#define SCAN_WRITE(bi) do { LAS float* d = buf + (bi) * 12288 + fs * 384 + o4; const f32x4 r_ = unpk4(st[0]), om_ = unpk4(st[1]), k_ = unpk4(st[2]), v_ = unpk4(st[3]), kk_ = unpk4(st[4]), a_ = unpk4(st[5]); \
        *(LAS f32x4*)(d) = kk_; *(LAS f32x4*)(d + 64) = kk_ * a_; *(LAS f32x4*)(d + 128) = 1.0f - om_; *(LAS f32x4*)(d + 192) = k_; *(LAS f32x4*)(d + 256) = r_; *(LAS f32x4*)(d + 320) = v_; } while (0)
    SCAN_LOAD(0); SCAN_WRITE(0); __syncthreads();
    float S0 = 0.f, S1 = 0.f, S2 = 0.f, S3 = 0.f;
    struct StepIn { f32x4 kk, ka, w, k, r; float v; };
#define SCAN_LD(dst, cb_, s_) do { const LAS float* p_ = (cb_) + (s_) * 384 + 4 * kq; dst.kk = *(const LAS f32x4*)(p_); dst.ka = *(const LAS f32x4*)(p_ + 64); dst.w = *(const LAS f32x4*)(p_ + 128); \
        dst.k = *(const LAS f32x4*)(p_ + 192); dst.r = *(const LAS f32x4*)(p_ + 256); dst.v = (cb_)[(s_) * 384 + 320 + 32 * half + lrow]; } while (0)
#define SCAN_STEP(in_, yout) do { float sa_ = (S0 * in_.kk[0] + S1 * in_.kk[1]) + (S2 * in_.kk[2] + S3 * in_.kk[3]); sa_ = allsum16(sa_); \
        S0 = S0 * in_.w[0] + (in_.v * in_.k[0] - sa_ * in_.ka[0]); S1 = S1 * in_.w[1] + (in_.v * in_.k[1] - sa_ * in_.ka[1]); S2 = S2 * in_.w[2] + (in_.v * in_.k[2] - sa_ * in_.ka[2]); S3 = S3 * in_.w[3] + (in_.v * in_.k[3] - sa_ * in_.ka[3]); \
        float y_ = (S0 * in_.r[0] + S1 * in_.r[1]) + (S2 * in_.r[2] + S3 * in_.r[3]); yout = allsum16(y_); } while (0)
    for (int c = 0; c < T / 32; ++c) {
        if (c + 1 < T / 32) SCAN_LOAD(c + 1);
        const LAS float* cb = buf + (c & 1) * 12288; LAS float* yb = ybuf + (c & 1) * 1024;
        StepIn A0, A1, A2, A3, B0, B1, B2, B3;
        SCAN_LD(A0, cb, 0); SCAN_LD(A1, cb, 1); SCAN_LD(A2, cb, 2); SCAN_LD(A3, cb, 3);
#pragma unroll
        for (int g2 = 0; g2 < 4; ++g2) { float y0, y1, y2, y3;
            { const int sb_ = 8 * g2 + 4; SCAN_LD(B0, cb, sb_); SCAN_LD(B1, cb, sb_ + 1); SCAN_LD(B2, cb, sb_ + 2); SCAN_LD(B3, cb, sb_ + 3); }
            SCAN_STEP(A0, y0); SCAN_STEP(A1, y1); SCAN_STEP(A2, y2); SCAN_STEP(A3, y3);
            if (kq == 0) { const int s0_ = 8 * g2; yb[(s0_ + 0) * 32 + lrow] = y0; yb[(s0_ + 1) * 32 + lrow] = y1; yb[(s0_ + 2) * 32 + lrow] = y2; yb[(s0_ + 3) * 32 + lrow] = y3; }
            if (g2 < 3) { const int sa2_ = 8 * g2 + 8; SCAN_LD(A0, cb, sa2_); SCAN_LD(A1, cb, sa2_ + 1); SCAN_LD(A2, cb, sa2_ + 2); SCAN_LD(A3, cb, sa2_ + 3); }
            SCAN_STEP(B0, y0); SCAN_STEP(B1, y1); SCAN_STEP(B2, y2); SCAN_STEP(B3, y3);
            if (kq == 0) { const int s0_ = 8 * g2 + 4; yb[(s0_ + 0) * 32 + lrow] = y0; yb[(s0_ + 1) * 32 + lrow] = y1; yb[(s0_ + 2) * 32 + lrow] = y2; yb[(s0_ + 3) * 32 + lrow] = y3; }
        }
        if (c + 1 < T / 32) SCAN_WRITE((c + 1) & 1);
        __syncthreads();
        { const int rr = 2 * (tid & 15); const float y0 = yb[fs * 32 + rr], y1 = yb[fs * 32 + rr + 1];
          *(unsigned*)(yb8 + (size_t)(32 * c + fs) * 7168 + rr * 2) = pk2(y0, y1); }
    }
#undef SCAN_LD
#undef SCAN_STEP
#undef SCAN_LOAD
#undef SCAN_WRITE
    __syncthreads();
}
__device__ __forceinline__ void rwkv_epilogue(const Frame& F) {
    const int lane = F.lane; const int gw = F.vcu * NWAVES + F.wave, NGW = F.G * NWAVES;
    const unsigned char* prw = F.ws + WS_PRW; const bf16* G = (const bf16*)((unsigned char*)F.out + DO_G); bf16* YA = (bf16*)(F.ws + WS_H);
    for (int idx = gw; idx < M * 8; idx += NGW) { const int row = idx >> 3, h = idx & 7, c = h * 64 + lane;
        const bf16* rec = (const bf16*)(prw + (size_t)row * 7168) + h * 384;
        const float y = bf2f(((const bf16*)(prw + (size_t)row * 7168 + 6144))[c]);
        const float mean = wave_sum(y) * (1.f / 64.f); const float d = y - mean; const float var = wave_sum(d * d) * (1.f / 64.f);
        const float yn = d * rsqrtf(var + GN_EPS) * F.in[12][c] + F.in[13][c];
        const float r = bf2f(rec[lane]), k = bf2f(rec[128 + lane]), v = bf2f(rec[192 + lane]);
        const float bon = wave_sum(r * k * F.in[11][c]) * v;
        YA[(size_t)row * 512 + c] = f2b((yn + bon) * bf2f(G[(size_t)row * 512 + c])); }
}
__device__ __forceinline__ unsigned sortable(float x) { const unsigned u = __float_as_uint(x); return (u & 0x80000000u) ? ~u : (u | 0x80000000u); }
__device__ __forceinline__ float unsortable(unsigned k) { const unsigned u = (k & 0x80000000u) ? (k & 0x7fffffffu) : ~k; return __uint_as_float(u); }
#define TK_INSERT(L, key_) do { unsigned k_ = (key_); _Pragma("unroll") for (int s_ = 0; s_ < 16; ++s_) { const unsigned hi_ = L[s_] > k_ ? L[s_] : k_; k_ = L[s_] > k_ ? k_ : L[s_]; L[s_] = hi_; } } while (0)
__device__ __forceinline__ void peer_topk_pass(const Frame& F, int wp, LAS float* sc) {
    const int lane = F.lane, r16 = lane & 15, q4 = lane >> 4;
    const bf16* QRY = (const bf16*)(F.ws + WS_PRW);
    int* EID = (int*)(F.ws + WS_PRW + 64 * MiB); float* EG = (float*)(F.ws + WS_PRW + 72 * MiB);
    const int row = lane & 31, part = lane >> 5;
    unsigned L1[16], L2[16];
#pragma unroll
    for (int half = 0; half < 2; ++half) {
        const bf16* SK = (const bf16*)(F.ws + (half ? WS_SK2 : WS_SK1));
#pragma unroll
        for (int mt = 0; mt < 2; ++mt) { const int rho = 32 * wp + 16 * mt + r16;
            const bf16* qp = QRY + (size_t)(rho >> 3) * 2048 + (rho & 7) * 256 + half * 128 + 8 * q4;
            bf16x8 af[4];
#pragma unroll
            for (int s = 0; s < 4; ++s) af[s] = as_bf16x8(*(const v4u*)(qp + 32 * s));
#pragma unroll
            for (int kt = 0; kt < 8; ++kt) { f32x4 acc = {0.f, 0.f, 0.f, 0.f};
#pragma unroll
                for (int s = 0; s < 4; ++s) acc = mfma16(af[s], as_bf16x8(*(const v4u*)(SK + (size_t)(16 * kt + r16) * 128 + 32 * s + 8 * q4)), acc);
#pragma unroll
                for (int r = 0; r < 4; ++r) { const int rw = 16 * mt + 4 * q4 + r; sc[rw * 128 + ((16 * kt + r16) ^ rw)] = acc[r]; } } }
        NSA_FENCE();
        unsigned Ls[16];
#pragma unroll
        for (int s = 0; s < 16; ++s) Ls[s] = 0u;
#pragma unroll 4
        for (int i = 0; i < 64; ++i) { const int c = 64 * part + i; const float x = sc[row * 128 + (c ^ row)];
            TK_INSERT(Ls, (sortable(x) & ~0x7Fu) | (unsigned)(127 - c)); }
        unsigned Lo[16];
#pragma unroll
        for (int s = 0; s < 16; ++s) Lo[s] = (unsigned)__shfl_xor((int)Ls[s], 32);
#pragma unroll
        for (int s = 0; s < 16; ++s) TK_INSERT(Ls, Lo[s]);
#pragma unroll
        for (int s = 0; s < 16; ++s) { if (half == 0) L1[s] = Ls[s]; else L2[s] = Ls[s]; }
        NSA_FENCE();
    }
    float v1[16], v2[16];
#pragma unroll
    for (int s = 0; s < 16; ++s) { v1[s] = unsortable(L1[s]); v2[s] = unsortable(L2[s]); }
    unsigned C[16];
#pragma unroll
    for (int s = 0; s < 16; ++s) C[s] = 0u;
#pragma unroll
    for (int i = 0; i < 16; ++i)
#pragma unroll
        for (int j = 0; j < 16; ++j) if ((i + 1) * (j + 1) <= 16) { TK_INSERT(C, (sortable(v1[i] + v2[j]) & ~0xFFu) | (unsigned)(255 - (16 * i + j))); }
    LAS unsigned* il = (LAS unsigned*)sc;
    if (part == 0) {
#pragma unroll
        for (int s = 0; s < 16; ++s) { il[row * 33 + s] = 127u - (L1[s] & 127u); il[row * 33 + 16 + s] = 127u - (L2[s] & 127u); }
    }
    NSA_FENCE();
    if (part == 0) { const int rho = 32 * wp + row;
        float val[16], e[16]; float sum = 0.f;
#pragma unroll
        for (int s = 0; s < 16; ++s) val[s] = unsortable(C[s]);
#pragma unroll
        for (int s = 0; s < 16; ++s) { e[s] = __expf(val[s] - val[0]); sum += e[s]; }
        const float is = 1.0f / sum;
#pragma unroll
        for (int s = 0; s < 16; ++s) { const unsigned pos = 255u - (C[s] & 255u); const unsigned i = pos >> 4, j = pos & 15u;
            EID[(size_t)rho * 16 + s] = (int)(il[row * 33 + i] * 128u + il[row * 33 + 16 + j]); EG[(size_t)rho * 16 + s] = e[s] * is; }
    }
    NSA_FENCE();
}
typedef float f32x2_t __attribute__((ext_vector_type(2)));
constexpr float PEER_SCALE = 256.0f, PEER_ISCALE = 1.0f / 256.0f;
__device__ __forceinline__ void peer_convert_one(const Frame& F, const float* srcf, unsigned char* dstb) {
    const int gt = F.vcu * (NWAVES * 64) + F.tid, NT = F.G * NWAVES * 64;
    const f32x4* src = (const f32x4*)srcf; v4u* dst = (v4u*)dstb;
    for (int i = gt; i < 16384 * 1024 / 16; i += NT) { v4u o;
#pragma unroll
        for (int q = 0; q < 4; ++q) { const f32x4 a = src[4 * i + q] * PEER_SCALE; int w = __builtin_amdgcn_cvt_pk_fp8_f32(a[0], a[1], 0, false); w = __builtin_amdgcn_cvt_pk_fp8_f32(a[2], a[3], w, true); o[q] = (unsigned)w; }
        dst[i] = o; }
}
__device__ __forceinline__ void peer_convert_tables(const Frame& F) { peer_convert_one(F, F.in[31], F.ws + WS_MG); peer_convert_one(F, F.in[32], F.ws + WS_MG + 16 * MiB); }
__device__ __forceinline__ void peer_gather(const Frame& F) {
    const int lane = F.lane; const int gw = F.vcu * NWAVES + F.wave, NGW = F.G * NWAVES;
    const bf16* H2 = (const bf16*)(F.ws + WS_H);
    const int* EID = (const int*)(F.ws + WS_PRW + 64 * MiB); const float* EG = (const float*)(F.ws + WS_PRW + 72 * MiB);
    const unsigned char* U8 = F.ws + WS_MG; const unsigned char* V8 = F.ws + WS_MG + 16 * MiB;
    for (int tok = gw; tok < M; tok += NGW) {
        float h[16], o[16];
        { const v4u h0 = *(const v4u*)(H2 + (size_t)tok * D + 16 * lane), h1 = *(const v4u*)(H2 + (size_t)tok * D + 16 * lane + 8);
#pragma unroll
          for (int q = 0; q < 4; ++q) { h[2 * q] = bflo(h0[q]); h[2 * q + 1] = bfhi(h0[q]); h[8 + 2 * q] = bflo(h1[q]); h[8 + 2 * q + 1] = bfhi(h1[q]); } }
#pragma unroll
        for (int i = 0; i < 16; ++i) o[i] = 0.f;
#pragma unroll 1
        for (int hh = 0; hh < 2; ++hh) {
            const int idv = EID[(size_t)tok * 128 + 64 * hh + lane]; const float gv = EG[(size_t)tok * 128 + 64 * hh + lane] * PEER_ISCALE;
#pragma unroll 1
            for (int e0 = 0; e0 < 64; e0 += 8) {
                v4u uu[8], vv[8]; float gt[8], dot[8];
#pragma unroll
                for (int k = 0; k < 8; ++k) { const int id = __builtin_amdgcn_readlane(idv, e0 + k); gt[k] = __builtin_bit_cast(float, __builtin_amdgcn_readlane(__builtin_bit_cast(int, gv), e0 + k));
                    uu[k] = *(const v4u*)(U8 + (size_t)id * D + 16 * lane); vv[k] = *(const v4u*)(V8 + (size_t)id * D + 16 * lane); }
#pragma unroll
                for (int k = 0; k < 8; ++k) { float d0 = 0.f, d1 = 0.f;
#pragma unroll
                    for (int q = 0; q < 4; ++q) { const f32x2_t lo = __builtin_amdgcn_cvt_pk_f32_fp8((int)uu[k][q], false), hi = __builtin_amdgcn_cvt_pk_f32_fp8((int)uu[k][q], true);
                        d0 += h[4 * q] * lo.x; d1 += h[4 * q + 1] * lo.y; d0 += h[4 * q + 2] * hi.x; d1 += h[4 * q + 3] * hi.y; }
                    dot[k] = d0 + d1; }
#pragma unroll
                for (int o_ = 1; o_ < 64; o_ <<= 1) {
#pragma unroll
                    for (int k = 0; k < 8; ++k) dot[k] += __shfl_xor(dot[k], o_); }
#pragma unroll
                for (int k = 0; k < 8; ++k) { const float dt = dot[k] * PEER_ISCALE; const float cf = gt[k] * 0.5f * dt * (1.f + erff(dt * 0.70710678118654752f));
#pragma unroll
                    for (int q = 0; q < 4; ++q) { const f32x2_t lo = __builtin_amdgcn_cvt_pk_f32_fp8((int)vv[k][q], false), hi = __builtin_amdgcn_cvt_pk_f32_fp8((int)vv[k][q], true);
                        o[4 * q] += cf * lo.x; o[4 * q + 1] += cf * lo.y; o[4 * q + 2] += cf * hi.x; o[4 * q + 3] += cf * hi.y; } }
            }
        }
        f32x4* p = (f32x4*)(F.out + (size_t)tok * D + 16 * lane);
#pragma unroll
        for (int q = 0; q < 4; ++q) { f32x4 a = p[q]; a[0] += o[4 * q]; a[1] += o[4 * q + 1]; a[2] += o[4 * q + 2]; a[3] += o[4 * q + 3]; p[q] = a; }
    }
}
struct Args { const float* in[33]; float* out; unsigned char* ws; int ph_lo, ph_hi; };
__global__ void __launch_bounds__(NWAVES * 64, 2) mk_fwd(Args args) {
    extern __shared__ __attribute__((aligned(16))) unsigned char lds[];
    Frame F;
    F.lds = (LAS unsigned char*)lds;
    F.MISC = (volatile LAS unsigned*)(F.lds + MISC_OFF);
    F.tid = threadIdx.x; F.lane = F.tid & 63; F.wave = __builtin_amdgcn_readfirstlane(F.tid >> 6);
    F.G = gridDim.x; { const int bx = blockIdx.x; F.vcu = (F.G % 8 == 0) ? (bx % 8) * (F.G / 8) + bx / 8 : bx; }
    unsigned char* ws = args.ws; F.ws = ws; F.out = args.out;
    F.ctl = (gu32*)(ws + WS_CTL);
#pragma unroll
    for (int i = 0; i < 33; ++i) F.in[i] = args.in[i];
    for (int u = F.tid; u < (LDS_BYTES - LDSCTL_OFF) / 4; u += NWAVES * 64) ((LAS unsigned*)(F.lds + LDSCTL_OFF))[u] = 0u;
    __syncthreads();
    const int lo = args.ph_lo, hi = args.ph_hi;
    const bool multi = (hi - lo) > 1;
    XcdBarrier bar; bar.bar = (unsigned*)(F.ctl + CW_BAR); bar.x = 0; bar.st = nullptr;
    if (multi) bar = xcd_barrier_post((unsigned*)(F.ctl + CW_BAR), F.MISC + 8);
#define IN(k) (lo <= (k) && (k) < hi)
#define NREP(k) ((((REP_MASK) >> (k)) & 1) + 1)
#define REPBAR() do { if (rep) xcd_barrier(bar); } while (0)
#define SEAM(k) do { if (IN(k) && IN((k) + 1)) xcd_barrier(bar); } while (0)

    if (IN(0)) { for (int rep = 0; rep < NREP(0); ++rep) { REPBAR(); p0_prologue(F); } } SEAM(0);
    if (IN(1)) { for (int rep = 0; rep < NREP(1); ++rep) { REPBAR();
        pg8::Gemm g{(const pg8::bf16_t*)(ws + WS_H), (const pg8::bf16_t*)(ws + WS_WIN), M, NG1, D}; pg8::StaticOrder S; S.init(M, NG1, F.G, (int)blockIdx.x);
        pg8::EpiG1 E{(float*)(ws + WS_PRW), (float*)(ws + WS_BND), (pg8::bf16_t*)((unsigned char*)F.out + DO_PNSA), (pg8::bf16_t*)(ws + WS_MG), (float*)((unsigned char*)F.out + DO_GLOG)};
        pg8::gemm_phase<pg8::EpiG1, pg8::StaticOrder, true, true>(F.lds + RING_OFF, g, S, E);
    } } SEAM(1);
    if (IN(2)) {
        for (int u = F.vcu; u < 256; u += F.G) { nsa_prep_tile(F, u); rwkv_prep_tile(F, u); compress_unit(F, u); }
    } SEAM(2);
    if (IN(3)) { for (int rep = 0; rep < NREP(3); ++rep) { REPBAR();
        if ((int)blockIdx.x < SCAN_BLOCKS) { if (!(rep && P3REP == 3)) for (int sb = blockIdx.x; sb < 64; sb += SCAN_BLOCKS) rwkv_scan_block(F, sb); }
        else { if (!(rep && P3REP == 2)) nsa_phase(F, rep); }
    } } SEAM(3);
    if (IN(4)) { for (int rep = 0; rep < NREP(4); ++rep) { REPBAR(); rwkv_epilogue(F); } } SEAM(4);
    if (IN(5)) { for (int rep = 0; rep < NREP(5); ++rep) { REPBAR();
        { pg8::Gemm g{(const pg8::bf16_t*)(ws + WS_H), (const pg8::bf16_t*)(ws + WS_WA), M, D, 512}; pg8::StaticOrder S; S.init(M, D, F.G, (int)blockIdx.x);
          pg8::EpiGate1 E{(float*)(ws + WS_PRW), (const pg8::bf16_t*)(ws + WS_MG), 0};
          pg8::gemm_phase<pg8::EpiGate1, pg8::StaticOrder, true, true>(F.lds + RING_OFF, g, S, E); }
        VM_WAIT(); __syncthreads();
        { pg8::Gemm g{(const pg8::bf16_t*)(ws + WS_H + 16 * MiB), (const pg8::bf16_t*)(ws + WS_WB), M, D, 512}; pg8::StaticOrder S; S.init(M, D, F.G, (int)blockIdx.x);
          pg8::EpiGate2 E{(const float*)(ws + WS_PRW), (const pg8::bf16_t*)(ws + WS_MG), 1024, (pg8::bf16_t*)(ws + WS_PRW + 64 * MiB)};
          pg8::gemm_phase<pg8::EpiGate2, pg8::StaticOrder, true, true>(F.lds + RING_OFF, g, S, E); }
    } } SEAM(5);
    if (IN(6)) { for (int rep = 0; rep < NREP(6); ++rep) { REPBAR();
        pg8::Gemm g{(const pg8::bf16_t*)(ws + WS_PRW + 64 * MiB), (const pg8::bf16_t*)(ws + WS_WOUT), M, D, D}; pg8::StaticOrder S; S.init(M, D, F.G, (int)blockIdx.x);
        pg8::EpiRes E{F.in[0], F.out};
        pg8::gemm_phase<pg8::EpiRes, pg8::StaticOrder, true, true>(F.lds + RING_OFF, g, S, E);
    } } SEAM(6);
    if (IN(7)) { for (int rep = 0; rep < NREP(7); ++rep) { REPBAR(); const int gw = F.vcu * NWAVES + F.wave, NGW = F.G * NWAVES;
        for (int m = gw; m < M; m += NGW) rms_row_to_bf16(F.lane, F.out + (size_t)m * D, F.in[27], (bf16*)(ws + WS_H) + (size_t)m * D);
        peer_convert_tables(F);
    } } SEAM(7);
    if (IN(8)) { for (int rep = 0; rep < NREP(8); ++rep) { REPBAR();
        pg8::Gemm g{(const pg8::bf16_t*)(ws + WS_H), (const pg8::bf16_t*)(ws + WS_WQ), M, 2048, D}; pg8::StaticOrder S; S.init(M, 2048, F.G, (int)blockIdx.x);
        pg8::EpiBf16<0> E{(pg8::bf16_t*)(ws + WS_PRW), 2048, nullptr, 0, 0, 1.f};
        pg8::gemm_phase<pg8::EpiBf16<0>, pg8::StaticOrder, true, true>(F.lds + RING_OFF, g, S, E);
    } } SEAM(8);
    if (IN(9)) { for (int rep = 0; rep < NREP(9); ++rep) { REPBAR(); const int gw = F.vcu * NWAVES + F.wave, NGW = F.G * NWAVES; LAS float* sc = (LAS float*)(F.lds + F.wave * 16384);
        for (int wp = gw; wp < M * 8 / 32; wp += NGW) peer_topk_pass(F, wp, sc);
    } } SEAM(9);
    if (IN(10)) { peer_gather(F); }
#undef IN
#undef SEAM
}

extern "C" void kernel_launch(void* const* d_in, const int* in_sizes, int n_in, void* d_out, int out_size, void* d_ws, size_t ws_size, hipStream_t stream) {
    static int grid = 0;
    if (grid == 0) {
        if (n_in != 33 || out_size != M * D || ws_size < WS_END) { fprintf(stderr, "kernel_launch: unexpected shapes (n_in %d out %d ws %zu)\n", n_in, out_size, ws_size); grid = -1; return; }
        int dev = 0, cus = 0, per_cu = 0;
        if (hipGetDevice(&dev) != hipSuccess || hipDeviceGetAttribute(&cus, hipDeviceAttributeMultiprocessorCount, dev) != hipSuccess) { grid = -1; return; }
        if (hipFuncSetAttribute((const void*)mk_fwd, hipFuncAttributeMaxDynamicSharedMemorySize, LDS_BYTES) != hipSuccess) { fprintf(stderr, "kernel_launch: hipFuncSetAttribute failed\n"); grid = -1; return; }
        if (hipOccupancyMaxActiveBlocksPerMultiprocessor(&per_cu, (const void*)mk_fwd, NWAVES * 64, LDS_BYTES) != hipSuccess || per_cu < 1)
            fprintf(stderr, "kernel_launch: occupancy query reports %d blocks per CU\n", per_cu);
        (void)hipGetLastError();
        grid = cus;
        if (grid > 256) grid = 256;
    }
    if (grid < 0) return;
    if (hipMemsetAsync((char*)d_ws + WS_CTL, 0, CTL_ZERO_BYTES, stream) != hipSuccess) return;
    Args a{};
    for (int i = 0; i < 33; ++i) a.in[i] = (const float*)d_in[i];
    a.out = (float*)d_out; a.ws = (unsigned char*)d_ws;
#if MK_ONE_LAUNCH
    a.ph_lo = 0; a.ph_hi = N_PHASES;
    hipLaunchKernelGGL(mk_fwd, dim3(grid), dim3(NWAVES * 64), LDS_BYTES, stream, a);
#else
    for (int p = 0; p < N_PHASES; ++p) { a.ph_lo = p; a.ph_hi = p + 1; hipLaunchKernelGGL(mk_fwd, dim3(grid), dim3(NWAVES * 64), LDS_BYTES, stream, a); }
#endif
}
```

```cpp
#include <hip/hip_runtime.h>
#include <cstdio>
#include <cstdint>
#define MK_ONE_LAUNCH 1
#define REP_MASK 0
#define P3REP 1
namespace pg8 {
#define PG8_LAS __attribute__((address_space(3)))
typedef unsigned short bf16_t;
typedef short bf16x8 __attribute__((ext_vector_type(8)));
typedef float f32x4 __attribute__((ext_vector_type(4)));
typedef unsigned u32x4 __attribute__((ext_vector_type(4)));
constexpr int BM = 256, BK = 64, HALF = 128, HTB = HALF * BK * 2  , STAGE_BYTES = 8 * HTB, NXCD = 8, WGM = 8;

__host__ __device__ __forceinline__ int lds_byte(int r, int c) { const int st = (r >> 4) * 2 + (c >> 5), rr = r & 15, cc = c & 31, ob = rr * 64 + cc * 2; return st * 1024 + (ob ^ (((ob >> 9) & 1) << 5)); }
__host__ __device__ __forceinline__ void stage_rc(int b, int& R, int& C) { const int st = b / 1024, sb = b % 1024, swz = sb ^ (((sb >> 9) & 1) << 5); R = (st >> 1) * 16 + swz / 64; C = (st & 1) * 32 + (swz % 64) / 2; }
__host__ __device__ __forceinline__ int perm32(int rho) { const int n = rho >> 4, i = rho & 15; return 8 * (i >> 2) + 4 * n + (i & 3); }

struct Unit { int pm, pn; };
struct Gemm { const bf16_t* A; const bf16_t* Bt; int M, N, K; };

struct StaticOrder {
    int nM, nN, nwg, G, c;
    __host__ __device__ void init(int M, int N, int G_, int c_) { nM = M / BM; nN = N / BM; nwg = nM * nN; G = G_; c = c_; }
    __host__ __device__ bool next(int i, Unit& u) const {
        const long L = (long)i * G + c; if (L >= nwg) return false;
        int wgid = (int)L; { const int q = nwg / NXCD, r = nwg % NXCD, xcd = wgid % NXCD, off = wgid / NXCD; wgid = (xcd < r ? xcd * (q + 1) : r * (q + 1) + (xcd - r) * q) + off; }
        const int nig = WGM * nN, gid = wgid / nig, fm = gid * WGM, gsz = (nM - fm) < WGM ? (nM - fm) : WGM;
        u.pm = fm + ((wgid % nig) % gsz); u.pn = (wgid % nig) / gsz; return true;
    }
    __device__ __forceinline__ void a_ready(const Unit&) const {}
    __device__ __forceinline__ void done(const Unit&) const {}
};

typedef float f32x2c __attribute__((ext_vector_type(2))); typedef __bf16 bf16x2c __attribute__((ext_vector_type(2)));
__device__ __forceinline__ unsigned cvt_pk_bf16(float lo, float hi) { const f32x2c v = {lo, hi}; const bf16x2c b = __builtin_convertvector(v, bf16x2c); return __builtin_bit_cast(unsigned, b); }
typedef float f32x2 __attribute__((ext_vector_type(2)));
__device__ __forceinline__ f32x2 gelu_pk(f32x2 v) {
    const f32x2 av = __builtin_elementwise_abs(v), d = av * 0.2316418882f + 1.0f;
    f32x2 t; t.x = __builtin_amdgcn_rcpf(d.x); t.y = __builtin_amdgcn_rcpf(d.y);
    f32x2 q = t * 0.5307027145f + (-0.7265760135f); q = q * t + 0.7107068705f; q = q * t + (-0.142248368f); q = q * t + 0.127414796f; q = q * t;
    const f32x2 s = (v * v) * (-0.72134752044f);
    f32x2 e; e.x = __builtin_amdgcn_exp2f(s.x); e.y = __builtin_amdgcn_exp2f(s.y);
    const f32x2 m = v * (q * e), r = v - m;
    f32x2 o; o.x = v.x < 0.f ? m.x : r.x; o.y = v.y < 0.f ? m.y : r.y; return o;
}

template <int ACT  > struct EpiBf16 {
    static constexpr bool PERM = true, AFTER_DRAIN = false; static_assert(ACT == 0 || ACT == 1, "EpiBf16: ACT is 0 (none) or 1 (gelu_pk)");
    bf16_t* O; int ldc; const float* bias; int split_cols; size_t split_stride; float scale0;
    __device__ __forceinline__ void operator()(const f32x4 (&acc)[2][2][4][2], const Unit& u, int wr, int wc, int fr, int fq) const {
        const int row0 = u.pm * BM + wr * 64 + fr; int colt = u.pn * BM; bf16_t* base = O;
        float sc = 1.f; if (split_cols) { const int t = colt / split_cols; base += (size_t)t * split_stride; colt -= t * split_cols; if (t == 0) sc = scale0; }
        const int col0 = colt + wc * 32 + 8 * fq, bcol0 = u.pn * BM + wc * 32 + 8 * fq;
        f32x4 bv[2][2];
#pragma unroll
        for (int bj = 0; bj < 2; ++bj)
#pragma unroll
            for (int n = 0; n < 2; ++n) bv[bj][n] = bias ? *(const f32x4*)(bias + bcol0 + bj * HALF + 4 * n) : (f32x4){0.f, 0.f, 0.f, 0.f};
#pragma unroll
        for (int ai = 0; ai < 2; ++ai)
#pragma unroll
            for (int m = 0; m < 4; ++m) { bf16_t* rowp = base + (size_t)(row0 + ai * HALF + m * 16) * ldc + col0;
#pragma unroll
                for (int bj = 0; bj < 2; ++bj) { f32x4 v0 = acc[ai][bj][m][0] + bv[bj][0], v1 = acc[ai][bj][m][1] + bv[bj][1];
                    if (ACT == 1) { f32x2 a = gelu_pk((f32x2){v0[0], v0[1]}), b = gelu_pk((f32x2){v0[2], v0[3]}), c = gelu_pk((f32x2){v1[0], v1[1]}), d = gelu_pk((f32x2){v1[2], v1[3]});
                        v0 = (f32x4){a.x, a.y, b.x, b.y}; v1 = (f32x4){c.x, c.y, d.x, d.y}; }
                    v0 = v0 * sc; v1 = v1 * sc; u32x4 w; w.x = cvt_pk_bf16(v0[0], v0[1]); w.y = cvt_pk_bf16(v0[2], v0[3]); w.z = cvt_pk_bf16(v1[0], v1[1]); w.w = cvt_pk_bf16(v1[2], v1[3]);
                    *(u32x4*)(rowp + bj * HALF) = w; } }
    }
};
__device__ __forceinline__ float bf_lo(unsigned w) { return __uint_as_float(w << 16); }
__device__ __forceinline__ float bf_hi(unsigned w) { return __uint_as_float(w & 0xffff0000u); }
__device__ __forceinline__ float sigm(float x) { return 1.0f / (1.0f + __expf(-x)); }
__device__ __forceinline__ u32x4 pack8(const f32x4 v0, const f32x4 v1) { u32x4 w; w.x = cvt_pk_bf16(v0[0], v0[1]); w.y = cvt_pk_bf16(v0[2], v0[3]); w.z = cvt_pk_bf16(v1[0], v1[1]); w.w = cvt_pk_bf16(v1[2], v1[3]); return w; }

struct EpiG1 {
    static constexpr bool PERM = true, AFTER_DRAIN = false;
    float* PRW; float* BND; bf16_t* PNSA; bf16_t* MG; float* GLOG;
    __device__ __forceinline__ void operator()(const f32x4 (&acc)[2][2][4][2], const Unit& u, int wr, int wc, int fr, int fq) const {
        const int row0 = u.pm * BM + wr * 64 + fr, c0 = wc * 32 + 8 * fq;
#pragma unroll
        for (int ai = 0; ai < 2; ++ai)
#pragma unroll
            for (int m = 0; m < 4; ++m) { const int row = row0 + ai * HALF + m * 16;
#pragma unroll
                for (int bj = 0; bj < 2; ++bj) { const f32x4 v0 = acc[ai][bj][m][0], v1 = acc[ai][bj][m][1]; const int col = c0 + bj * HALF;
                    if (u.pn < 7) { float* p = PRW + (size_t)row * 1792 + u.pn * 256 + col; *(f32x4*)p = v0; *(f32x4*)(p + 4) = v1;
                        if ((row & 63) == 63) { float* q = BND + (size_t)(row >> 6) * 1792 + u.pn * 256 + col; *(f32x4*)q = v0; *(f32x4*)(q + 4) = v1; } }
                    else if (u.pn < 12) { *(u32x4*)(PNSA + (size_t)row * 1280 + (u.pn - 7) * 256 + col) = pack8(v0, v1); }
                    else if (u.pn < 20) { *(u32x4*)(MG + (size_t)row * 2048 + (u.pn - 12) * 256 + col) = pack8(v0, v1); }
                    else { if (col < 32) { float* p = GLOG + (size_t)row * 32 + col; *(f32x4*)p = v0; *(f32x4*)(p + 4) = v1; } }
                } }
    }
};
struct EpiGate1 {
    static constexpr bool PERM = true, AFTER_DRAIN = false;
    float* T1; const bf16_t* MG; int goff;
    __device__ __forceinline__ void operator()(const f32x4 (&acc)[2][2][4][2], const Unit& u, int wr, int wc, int fr, int fq) const {
        const int row0 = u.pm * BM + wr * 64 + fr, c0 = u.pn * BM + wc * 32 + 8 * fq;
#pragma unroll
        for (int ai = 0; ai < 2; ++ai)
#pragma unroll
            for (int m = 0; m < 4; ++m) { const int row = row0 + ai * HALF + m * 16;
#pragma unroll
                for (int bj = 0; bj < 2; ++bj) { const f32x4 v0 = acc[ai][bj][m][0], v1 = acc[ai][bj][m][1]; const int col = c0 + bj * HALF;
                    const u32x4 g = *(const u32x4*)(MG + (size_t)row * 2048 + goff + col);
                    f32x4 o0, o1; o0[0] = sigm(bf_lo(g.x)) * v0[0]; o0[1] = sigm(bf_hi(g.x)) * v0[1]; o0[2] = sigm(bf_lo(g.y)) * v0[2]; o0[3] = sigm(bf_hi(g.y)) * v0[3];
                    o1[0] = sigm(bf_lo(g.z)) * v1[0]; o1[1] = sigm(bf_hi(g.z)) * v1[1]; o1[2] = sigm(bf_lo(g.w)) * v1[2]; o1[3] = sigm(bf_hi(g.w)) * v1[3];
                    float* p = T1 + (size_t)row * 1024 + col; *(f32x4*)p = o0; *(f32x4*)(p + 4) = o1; } }
    }
};
struct EpiGate2 {
    static constexpr bool PERM = true, AFTER_DRAIN = false;
    const float* T1; const bf16_t* MG; int goff; bf16_t* MIX;
    __device__ __forceinline__ void operator()(const f32x4 (&acc)[2][2][4][2], const Unit& u, int wr, int wc, int fr, int fq) const {
        const int row0 = u.pm * BM + wr * 64 + fr, c0 = u.pn * BM + wc * 32 + 8 * fq;
#pragma unroll
        for (int ai = 0; ai < 2; ++ai)
#pragma unroll
            for (int m = 0; m < 4; ++m) { const int row = row0 + ai * HALF + m * 16;
#pragma unroll
                for (int bj = 0; bj < 2; ++bj) { const f32x4 v0 = acc[ai][bj][m][0], v1 = acc[ai][bj][m][1]; const int col = c0 + bj * HALF;
                    const u32x4 g = *(const u32x4*)(MG + (size_t)row * 2048 + goff + col);
                    const float* p = T1 + (size_t)row * 1024 + col; const f32x4 t0 = *(const f32x4*)p, t1 = *(const f32x4*)(p + 4);
                    f32x4 o0, o1; o0[0] = t0[0] + sigm(bf_lo(g.x)) * v0[0]; o0[1] = t0[1] + sigm(bf_hi(g.x)) * v0[1]; o0[2] = t0[2] + sigm(bf_lo(g.y)) * v0[2]; o0[3] = t0[3] + sigm(bf_hi(g.y)) * v0[3];
                    o1[0] = t1[0] + sigm(bf_lo(g.z)) * v1[0]; o1[1] = t1[1] + sigm(bf_hi(g.z)) * v1[1]; o1[2] = t1[2] + sigm(bf_lo(g.w)) * v1[2]; o1[3] = t1[3] + sigm(bf_hi(g.w)) * v1[3];
                    *(u32x4*)(MIX + (size_t)row * 1024 + col) = pack8(o0, o1); } }
    }
};
struct EpiRes {
    static constexpr bool PERM = true, AFTER_DRAIN = false;
    const float* X; float* OUT;
    __device__ __forceinline__ void operator()(const f32x4 (&acc)[2][2][4][2], const Unit& u, int wr, int wc, int fr, int fq) const {
        const int row0 = u.pm * BM + wr * 64 + fr, c0 = u.pn * BM + wc * 32 + 8 * fq;
#pragma unroll
        for (int ai = 0; ai < 2; ++ai)
#pragma unroll
            for (int m = 0; m < 4; ++m) { const int row = row0 + ai * HALF + m * 16;
#pragma unroll
                for (int bj = 0; bj < 2; ++bj) { const size_t off = (size_t)row * 1024 + c0 + bj * HALF;
                    const f32x4 x0 = *(const f32x4*)(X + off), x1 = *(const f32x4*)(X + off + 4);
                    *(f32x4*)(OUT + off) = x0 + acc[ai][bj][m][0]; *(f32x4*)(OUT + off + 4) = x1 + acc[ai][bj][m][1]; } }
    }
};
template <class Epi, class Sched, bool ALIGN_EPI = false, bool SP2 = false>
__device__ __forceinline__ void gemm_phase(PG8_LAS unsigned char* lds, const Gemm g, const Sched& S, const Epi& E) {
    const int tid = threadIdx.x, wid = __builtin_amdgcn_readfirstlane(tid >> 6), lane = tid & 63, wr = wid >> 2, wc = wid & 3, fr = lane & 15, fq = lane >> 4;
    const int K = g.K, nt = K / BK;
    unsigned voffA[2], voffB[2];
#pragma unroll
    for (int i = 0; i < 2; ++i) { int R, C; stage_rc(tid * 16 + i * 8192, R, C); const int Rb = Epi::PERM ? ((R & ~31) + perm32(R & 31)) : R;
        voffA[i] = (unsigned)(R * K + C) * 2u; voffB[i] = (unsigned)(Rb * K + C) * 2u; }
    const size_t kstep = (size_t)(BK * 2);
    const size_t hstep = (size_t)HALF * K * 2;
    const size_t tstep = 2 * hstep;
    const unsigned ldsw = (unsigned)wid * 1024u;
    const int aoff = lds_byte(wr * 64 + fr, fq * 8), boff = lds_byte(wc * 32 + fr, fq * 8);
#define PG8_SA(b, h) (((b) * 2 + (h)) * HTB)
#define PG8_SB(b, h) ((4 + (b) * 2 + (h)) * HTB)
#define PG8_STAGE(bufoff, gbase, voff) do { _Pragma("unroll") for (int _i = 0; _i < 2; ++_i) \
        __builtin_amdgcn_global_load_lds((const unsigned*)((const char*)(gbase) + (voff)[_i]), (PG8_LAS unsigned*)(lds + (bufoff) + ldsw + _i * 8192), 16, 0, 0); } while (0)
#define PG8_LDA(dst, b, h) do { _Pragma("unroll") for (int m = 0; m < 4; ++m) _Pragma("unroll") for (int k = 0; k < 2; ++k) dst[m][k] = *(const PG8_LAS bf16x8*)(lds + PG8_SA(b, h) + aoff + m * 2048 + k * 1024); } while (0)
#define PG8_LDB(dst, b, h) do { _Pragma("unroll") for (int n = 0; n < 2; ++n) _Pragma("unroll") for (int k = 0; k < 2; ++k) dst[n][k] = *(const PG8_LAS bf16x8*)(lds + PG8_SB(b, h) + boff + n * 2048 + k * 1024); } while (0)
#define PG8_MMA(ai, bj, At, Bt) do { __builtin_amdgcn_s_setprio(1); _Pragma("unroll") for (int m = 0; m < 4; ++m) _Pragma("unroll") for (int n = 0; n < 2; ++n) _Pragma("unroll") for (int k = 0; k < 2; ++k) \
        acc[ai][bj][m][n] = __builtin_amdgcn_mfma_f32_16x16x32_bf16(Bt[n][k], At[m][k], acc[ai][bj][m][n], 0, 0, 0); __builtin_amdgcn_s_setprio(0); } while (0)
#define PG8_WAIT_V(n) asm volatile("s_waitcnt vmcnt(" #n ")" ::: "memory")
#define PG8_WAIT_L(n) asm volatile("s_waitcnt lgkmcnt(" #n ")" ::: "memory")
#define PG8_BAR __builtin_amdgcn_s_barrier()
#define PG8_SCHED __builtin_amdgcn_sched_barrier(0)
    Unit cur, nxt; int ui = 0;
    if (!S.next(0, cur)) return;
    f32x4 acc[2][2][4][2];
#pragma unroll
    for (int a = 0; a < 2; ++a)
#pragma unroll
        for (int b = 0; b < 2; ++b)
#pragma unroll
            for (int m = 0; m < 4; ++m)
#pragma unroll
                for (int n = 0; n < 2; ++n) acc[a][b][m][n] = (f32x4){0.f, 0.f, 0.f, 0.f};
    bf16x8 At[4][2], B0[2][2], B1[2][2];
    const char* cA = (const char*)g.A + (size_t)cur.pm * tstep; const char* cB = (const char*)g.Bt + (size_t)cur.pn * tstep;
    S.a_ready(cur);
    if constexpr (SP2) {
        PG8_STAGE(PG8_SB(0, 0), cB, voffB); PG8_STAGE(PG8_SB(0, 1), cB + hstep, voffB); PG8_STAGE(PG8_SA(0, 0), cA, voffA); PG8_STAGE(PG8_SA(0, 1), cA + hstep, voffA);
        if (wr == 1) PG8_BAR;
        PG8_WAIT_V(2); PG8_BAR;
        PG8_STAGE(PG8_SB(1, 0), cB + kstep, voffB); PG8_STAGE(PG8_SA(1, 0), cA + kstep, voffA); PG8_STAGE(PG8_SB(1, 1), cB + hstep + kstep, voffB);
        PG8_WAIT_V(6); PG8_BAR;
    } else {
        PG8_STAGE(PG8_SB(0, 0), cB, voffB); PG8_STAGE(PG8_SA(0, 0), cA, voffA); PG8_STAGE(PG8_SB(0, 1), cB + hstep, voffB); PG8_STAGE(PG8_SA(0, 1), cA + hstep, voffA);
        if (wr == 1) PG8_BAR;
        PG8_WAIT_V(4); PG8_BAR;
        PG8_STAGE(PG8_SB(1, 0), cB + kstep, voffB); PG8_STAGE(PG8_SA(1, 0), cA + kstep, voffA); PG8_STAGE(PG8_SB(1, 1), cB + hstep + kstep, voffB);
        PG8_WAIT_V(6); PG8_BAR;
    }
    for (;;) {
        const bool has_next = S.next(ui + 1, nxt);
        const char* nA = has_next ? (const char*)g.A + (size_t)nxt.pm * tstep : cA; const char* nB = has_next ? (const char*)g.Bt + (size_t)nxt.pn * tstep : cB;
        for (int t = 0; t < nt; t += 2) {
            const bool last = (t == nt - 2);
            const char* a1 = cA + (size_t)(t + 1) * kstep;
            const char* a2 = last ? nA : cA + (size_t)(t + 2) * kstep; const char* b2 = last ? nB : cB + (size_t)(t + 2) * kstep;
            const char* a3 = a2 + kstep; const char* b3 = b2 + kstep;
            if (last && has_next) S.a_ready(nxt);
            if constexpr (SP2) {
            PG8_LDB(B0, 0, 0); PG8_LDB(B1, 0, 1); PG8_SCHED; PG8_LDA(At, 0, 0); PG8_STAGE(PG8_SA(1, 1), a1 + hstep, voffA);
            PG8_WAIT_V(8); PG8_WAIT_L(0); PG8_BAR; PG8_MMA(0, 0, At, B0); PG8_MMA(0, 1, At, B1); PG8_BAR; PG8_SCHED;
            PG8_LDA(At, 0, 1); PG8_STAGE(PG8_SB(0, 0), b2, voffB); PG8_STAGE(PG8_SB(0, 1), b2 + hstep, voffB); PG8_STAGE(PG8_SA(0, 0), a2, voffA);
            PG8_WAIT_V(8); PG8_WAIT_L(0); PG8_BAR; PG8_MMA(1, 0, At, B0); PG8_MMA(1, 1, At, B1); PG8_BAR; PG8_SCHED;
            PG8_LDB(B0, 1, 0); PG8_LDB(B1, 1, 1); PG8_SCHED; PG8_LDA(At, 1, 0); PG8_STAGE(PG8_SA(0, 1), a2 + hstep, voffA);
            PG8_WAIT_V(8); PG8_WAIT_L(0); PG8_BAR; PG8_MMA(0, 0, At, B0); PG8_MMA(0, 1, At, B1); PG8_BAR; PG8_SCHED;
            PG8_LDA(At, 1, 1); PG8_STAGE(PG8_SB(1, 0), b3, voffB); PG8_STAGE(PG8_SB(1, 1), b3 + hstep, voffB); PG8_STAGE(PG8_SA(1, 0), a3, voffA);
            PG8_WAIT_V(8); PG8_WAIT_L(0); PG8_BAR; PG8_MMA(1, 0, At, B0); PG8_MMA(1, 1, At, B1); PG8_BAR; PG8_SCHED;
            } else {
            PG8_LDB(B0, 0, 0); PG8_SCHED; PG8_LDA(At, 0, 0); PG8_STAGE(PG8_SA(1, 1), a1 + hstep, voffA);
            PG8_WAIT_L(8); PG8_BAR; PG8_WAIT_L(0); PG8_MMA(0, 0, At, B0); PG8_BAR; PG8_SCHED;
            PG8_LDB(B1, 0, 1); PG8_STAGE(PG8_SB(0, 0), b2, voffB);
            PG8_BAR; PG8_WAIT_L(0); PG8_MMA(0, 1, At, B1); PG8_BAR;
            PG8_LDA(At, 0, 1); PG8_STAGE(PG8_SA(0, 0), a2, voffA);
            PG8_BAR; PG8_WAIT_L(0); PG8_MMA(1, 0, At, B0); PG8_BAR; PG8_SCHED;
            PG8_STAGE(PG8_SB(0, 1), b2 + hstep, voffB);
            PG8_WAIT_V(6); PG8_BAR; PG8_MMA(1, 1, At, B1); PG8_BAR;
            PG8_LDB(B0, 1, 0); PG8_SCHED; PG8_LDA(At, 1, 0); PG8_STAGE(PG8_SA(0, 1), a2 + hstep, voffA);
            PG8_WAIT_L(8); PG8_BAR; PG8_WAIT_L(0); PG8_MMA(0, 0, At, B0); PG8_BAR; PG8_SCHED;
            PG8_LDB(B1, 1, 1); PG8_STAGE(PG8_SB(1, 0), b3, voffB);
            PG8_BAR; PG8_WAIT_L(0); PG8_MMA(0, 1, At, B1); PG8_BAR;
            PG8_LDA(At, 1, 1); PG8_STAGE(PG8_SA(1, 0), a3, voffA);
            PG8_BAR; PG8_WAIT_L(0); PG8_MMA(1, 0, At, B0); PG8_BAR; PG8_SCHED;
            PG8_STAGE(PG8_SB(1, 1), b3 + hstep, voffB);
            PG8_WAIT_V(6); PG8_BAR; PG8_MMA(1, 1, At, B1); PG8_BAR;
            }
        }
        if constexpr (ALIGN_EPI) { if (wr == 0) PG8_BAR; }
        if constexpr (!Epi::AFTER_DRAIN) { E(acc, cur, wr, wc, fr, fq); S.done(cur); }
        if (!has_next) break;
#pragma unroll
        for (int a = 0; a < 2; ++a)
#pragma unroll
            for (int b = 0; b < 2; ++b)
#pragma unroll
                for (int m = 0; m < 4; ++m)
#pragma unroll
                    for (int n = 0; n < 2; ++n) acc[a][b][m][n] = (f32x4){0.f, 0.f, 0.f, 0.f};
        cur = nxt; cA = nA; cB = nB; ++ui;
        if constexpr (ALIGN_EPI) { if (wr == 1) PG8_BAR; }
    }
    PG8_WAIT_V(0);
    if constexpr (!ALIGN_EPI) { if (wr == 0) PG8_BAR; }
    PG8_BAR;
    if constexpr (Epi::AFTER_DRAIN) { E.fused(acc, cur, wr, wc, fr, fq, lds, wid, lane); S.done(cur); }
#undef PG8_SA
#undef PG8_SB
#undef PG8_STAGE
#undef PG8_LDA
#undef PG8_LDB
#undef PG8_MMA
#undef PG8_WAIT_V
#undef PG8_WAIT_L
#undef PG8_BAR
#undef PG8_SCHED
}
}
#define GAS __attribute__((address_space(1)))
#define LAS __attribute__((address_space(3)))
typedef unsigned short bf16;
typedef unsigned v4u __attribute__((ext_vector_type(4)));
typedef float f32x4 __attribute__((ext_vector_type(4)));
typedef short bf16x8 __attribute__((ext_vector_type(8)));
typedef GAS unsigned gu32;
typedef GAS unsigned long long gu64;
#define RLX_AGENT __ATOMIC_RELAXED, __HIP_MEMORY_SCOPE_AGENT
#define LDS_WAIT() asm volatile("s_waitcnt lgkmcnt(0)" ::: "memory")
#define VM_WAIT() asm volatile("s_waitcnt vmcnt(0)" ::: "memory")
__device__ __forceinline__ unsigned long long rt() { return __builtin_amdgcn_s_memrealtime(); }
__device__ __forceinline__ unsigned f2bf(float f) { unsigned u = __builtin_bit_cast(unsigned, f); return (u + 0x7fffu + ((u >> 16) & 1u)) >> 16; }
__device__ __forceinline__ unsigned pk2(float lo, float hi) { return f2bf(lo) | (f2bf(hi) << 16); }

#define XB_TMO      128
#define XB_XCNT(j)  (256  + 64 * (j))
#define XB_XSUB(j)  (1280 + 64 * (j))
#define XB_XGEN(j)  (2304 + 64 * (j))
#define XB_TOP      3328
#define XB_TOPGEN   3392
#define XCD_BAR_WORDS 3456
#define XB_SPIN_CAP (1u << 18)

__device__ __forceinline__ unsigned xb_ld(unsigned* p)              { return __hip_atomic_load(p, __ATOMIC_RELAXED, __HIP_MEMORY_SCOPE_AGENT); }
__device__ __forceinline__ unsigned xb_add(unsigned* p, unsigned v) { return __hip_atomic_fetch_add(p, v, __ATOMIC_RELAXED, __HIP_MEMORY_SCOPE_AGENT); }
__device__ __forceinline__ unsigned xb_xcc_id() { return (unsigned)__builtin_amdgcn_s_getreg((3 << 11) | 20) & 0xFu; }
#define XB_SPIN(cond, bar) do { unsigned _sp = 0; while (cond) { __builtin_amdgcn_s_sleep(1); \
    if ((++_sp & 255u) == 0u) { if (xb_ld(&(bar)[XB_TMO])) break; if (_sp > XB_SPIN_CAP) { atomicAdd(&(bar)[XB_TMO], 1u); break; } } } } while (0)

struct XcdBarrier {
    unsigned* bar; unsigned x;
    volatile LAS unsigned* st;
};

__device__ __forceinline__ XcdBarrier xcd_barrier_post(unsigned* bar, volatile LAS unsigned* st) {
    XcdBarrier b; b.bar = bar; b.x = xb_xcc_id(); b.st = st;
    if (threadIdx.x == 0) (void)xb_add(&bar[XB_XCNT(b.x)], 1u);
    return b;
}
__device__ __forceinline__ void xcd_barrier_complete(unsigned* bar, unsigned x, unsigned& nloc, unsigned& nx) {
    const unsigned G = gridDim.x * gridDim.y * gridDim.z;
    unsigned sum, cnt, mine, sp = 0u;
    for (;;) {
        sum = 0u; cnt = 0u; mine = 0u;
#pragma unroll
        for (unsigned j = 0; j < 16; ++j) { const unsigned c = xb_ld(&bar[XB_XCNT(j)]); sum += c; cnt += (c > 0u) ? 1u : 0u; mine = (j == x) ? c : mine; }
        if (sum == G) break;
        __builtin_amdgcn_s_sleep(1);
        if ((++sp & 255u) == 0u) { if (xb_ld(&bar[XB_TMO])) break; if (sp > XB_SPIN_CAP) { atomicAdd(&bar[XB_TMO], 1u); break; } }
    }
    nloc = mine > 0u ? mine : 1u; nx = cnt > 0u ? cnt : 1u;
}

__device__ __forceinline__ void xcd_barrier(const XcdBarrier& b) {
    asm volatile("s_waitcnt vmcnt(0)" ::: "memory");
    __syncthreads();
    if (threadIdx.x == 0) {
        unsigned* bar = b.bar;
        __builtin_amdgcn_s_waitcnt(0);
        unsigned nloc = b.st[0], nx = b.st[1];
        if (nloc == 0u) { xcd_barrier_complete(bar, b.x, nloc, nx); b.st[0] = nloc; b.st[1] = nx; }
        const unsigned old = xb_add(&bar[XB_XSUB(b.x)], 1u);
        const unsigned gen = old / nloc;
        if (old + 1u == (gen + 1u) * nloc) {
            __builtin_amdgcn_fence(__ATOMIC_RELEASE, "agent");
            asm volatile("s_waitcnt vmcnt(0)" ::: "memory");
            const unsigned og = xb_add(&bar[XB_TOP], 1u);
            const unsigned tg = og / nx;
            if (og + 1u == (tg + 1u) * nx) xb_add(&bar[XB_TOPGEN], 1u);
            else XB_SPIN(xb_ld(&bar[XB_TOPGEN]) == tg, bar);
            __builtin_amdgcn_fence(__ATOMIC_ACQUIRE, "agent");
            xb_add(&bar[XB_XGEN(b.x)], 1u);
            asm volatile("s_waitcnt vmcnt(0)" ::: "memory");
        } else {
            XB_SPIN(xb_ld(&bar[XB_XGEN(b.x)]) == gen, bar);
            __builtin_amdgcn_fence(__ATOMIC_ACQUIRE, "agent");
            asm volatile("s_waitcnt vmcnt(0)" ::: "memory");
        }
    }
    __syncthreads();
}
constexpr int NWAVES = 8;
constexpr int BATCH = 4, T = 4096, D = 1024, M = BATCH * T;
constexpr int RWC = 1792;
constexpr int NG1 = 5376;
constexpr float NORM_EPS = 1e-6f, GN_EPS = 64e-5f;
constexpr float LOG2E = 1.4426950408889634f;
constexpr int N_PHASES = 11;
#ifndef MK_ONE_LAUNCH
#define MK_ONE_LAUNCH 0
#endif
#ifndef REP_MASK
#define REP_MASK 0
#endif
#ifndef P3REP
#define P3REP 1
#endif
#ifndef SCAN_BLOCKS
#define SCAN_BLOCKS 128
#endif

constexpr size_t MiB = 1u << 20;
constexpr size_t WS_CTL = 0, CTL_ZERO_BYTES = 1 * MiB;
constexpr size_t WS_WIN = 1 * MiB;
constexpr size_t WS_WA = 12 * MiB, WS_WB = 13 * MiB;
constexpr size_t WS_WOUT = 14 * MiB;
constexpr size_t WS_WQ = 16 * MiB;
constexpr size_t WS_CW1K = 20 * MiB, WS_CW1V = 21 * MiB;
constexpr size_t WS_CW2K = 22 * MiB, WS_CW2V = 22 * MiB + 65536;
constexpr size_t WS_SK1 = 22 * MiB + 131072, WS_SK2 = 22 * MiB + 196608;
constexpr size_t WS_BND = 23 * MiB;
constexpr size_t WS_KC = 25 * MiB;
constexpr size_t WS_VCT = 25 * MiB + 262144;
constexpr size_t WS_H = 26 * MiB;
constexpr size_t WS_PRW = 58 * MiB;
constexpr size_t WS_MG = 170 * MiB;
constexpr size_t WS_VST = 234 * MiB, WS_VWT = 238 * MiB;
constexpr size_t WS_END = 256 * MiB;
constexpr size_t DO_PNSA = 0, DO_G = 40 * MiB, DO_GLOG = 56 * MiB;
constexpr int CW_TMO = 0, CW_CODE = 1, CW_NSAQ = 64, CW_BAR = 4096;

constexpr int RING_OFF = 0, RING_BYTES = 131072;
constexpr int LDSCTL_OFF = RING_BYTES, MISC_OFF = LDSCTL_OFF + 320;
constexpr int LDS_BYTES = 147456;
typedef unsigned short u16;
typedef unsigned u32x2 __attribute__((ext_vector_type(2)));
struct Frame {
    LAS unsigned char* lds;
    volatile LAS unsigned* MISC;
    gu32* ctl;
    int tid, lane, wave, vcu, G;
    const float* in[33];
    float* out; unsigned char* ws;
};
__device__ __forceinline__ float wave_sum(float v) {
#pragma unroll
    for (int o = 1; o < 64; o <<= 1) v += __shfl_xor(v, o);
    return v;
}
__device__ __forceinline__ float bf2f(u16 b) { return __uint_as_float((unsigned)b << 16); }
__device__ __forceinline__ float bflo(unsigned w) { return __uint_as_float(w << 16); }
__device__ __forceinline__ float bfhi(unsigned w) { return __uint_as_float(w & 0xffff0000u); }
__device__ __forceinline__ u16 f2b(float f) { return (u16)f2bf(f); }
__device__ __forceinline__ float sigmf(float x) { return 1.0f / (1.0f + __expf(-x)); }
__device__ __forceinline__ f32x4 mfma16(const bf16x8 a, const bf16x8 b, const f32x4 c) { return __builtin_amdgcn_mfma_f32_16x16x32_bf16(a, b, c, 0, 0, 0); }
__device__ __forceinline__ bf16x8 as_bf16x8(const v4u v) { return __builtin_bit_cast(bf16x8, v); }

__device__ __forceinline__ void tr_item(const float* W, int K, int ldw, int sc0, int nblk, int ncols_valid, bf16* WT, int dr0, LAS float* scr, int item, int lane) {
    const int kb = item / nblk, nb = item % nblk, k0 = 64 * kb, n0 = 32 * nb;
#pragma unroll 8
    for (int i = 0; i < 32; ++i) { const int kk = 2 * i + (lane >> 5); const int n = n0 + (lane & 31);
        scr[kk * 33 + (lane & 31)] = (n < ncols_valid) ? W[(size_t)(k0 + kk) * ldw + sc0 + n] : 0.f; }
    LDS_WAIT(); asm volatile("" ::: "memory");
    const int c = lane & 7;
#pragma unroll
    for (int j = 0; j < 4; ++j) { const int n = (lane >> 3) + 8 * j; const LAS float* s = scr + (8 * c) * 33 + n;
        v4u o; o.x = pk2(s[0 * 33], s[1 * 33]); o.y = pk2(s[2 * 33], s[3 * 33]); o.z = pk2(s[4 * 33], s[5 * 33]); o.w = pk2(s[6 * 33], s[7 * 33]);
        *(GAS v4u*)(WT + (size_t)(dr0 + n0 + n) * K + k0 + 8 * c) = o; }
    LDS_WAIT(); asm volatile("" ::: "memory");
}
__device__ __forceinline__ void rms_row_to_bf16(int lane, const float* xrow, const float* gain, bf16* orow) {
    const GAS f32x4* xr = (const GAS f32x4*)xrow + lane; const GAS f32x4* gr = (const GAS f32x4*)gain + lane;
    f32x4 v[4]; float s2 = 0.f;
#pragma unroll
    for (int j = 0; j < 4; ++j) { v[j] = xr[64 * j]; s2 += (v[j].x * v[j].x + v[j].y * v[j].y) + (v[j].z * v[j].z + v[j].w * v[j].w); }
    const float rstd = 1.f / sqrtf(wave_sum(s2) * (1.f / D) + NORM_EPS);
    GAS unsigned long long* o8 = (GAS unsigned long long*)orow + lane;
#pragma unroll
    for (int j = 0; j < 4; ++j) { const f32x4 g = gr[64 * j];
        o8[64 * j] = (unsigned long long)pk2(v[j].x * rstd * g.x, v[j].y * rstd * g.y) | ((unsigned long long)pk2(v[j].z * rstd * g.z, v[j].w * rstd * g.w) << 32); }
}
__device__ __forceinline__ void p0_prologue(const Frame& F) {
    LAS float* scr = (LAS float*)(F.lds + RING_OFF + F.wave * 16384);
    const int gw = F.vcu * NWAVES + F.wave, NGW = F.G * NWAVES;
    unsigned char* ws = F.ws;
    constexpr int I0 = 16 * 96, I1 = 16 * 64, I2 = 16 * 8, I3 = 8 * 32, I4 = 8 * 32, I5 = 16 * 32, I6 = 16 * 64, I7 = 32 * 8, I8 = 32 * 8, I9 = 4 * 2, I10 = 4 * 2;
    constexpr int NITEMS = I0 + I1 + I2 + I3 + I4 + I5 + I6 + I7 + I8 + I9 + I10;
    for (int it = gw; it < NITEMS; it += NGW) {
        int r = it;
        if (r < I0) { tr_item(F.in[2], 1024, 5144, 0, 96, 3072, (bf16*)(ws + WS_WIN), 0, scr, r, F.lane); continue; } r -= I0;
        if (r < I1) { tr_item(F.in[2], 1024, 5144, 3096, 64, 2048, (bf16*)(ws + WS_WIN), 3072, scr, r, F.lane); continue; } r -= I1;
        if (r < I2) { tr_item(F.in[2], 1024, 5144, 3072, 8, 24, (bf16*)(ws + WS_WIN), 5120, scr, r, F.lane); continue; } r -= I2;
        if (r < I3) { tr_item(F.in[24], 512, 1024, 0, 32, 1024, (bf16*)(ws + WS_WA), 0, scr, r, F.lane); continue; } r -= I3;
        if (r < I4) { tr_item(F.in[25], 512, 1024, 0, 32, 1024, (bf16*)(ws + WS_WB), 0, scr, r, F.lane); continue; } r -= I4;
        if (r < I5) { tr_item(F.in[26], 1024, 1024, 0, 32, 1024, (bf16*)(ws + WS_WOUT), 0, scr, r, F.lane); continue; } r -= I5;
        if (r < I6) { tr_item(F.in[28], 1024, 2048, 0, 64, 2048, (bf16*)(ws + WS_WQ), 0, scr, r, F.lane); continue; } r -= I6;
        if (r < I7) { tr_item(F.in[20], 2048, 256, 0, 8, 256, (bf16*)(ws + WS_CW1K), 0, scr, r, F.lane); continue; } r -= I7;
        if (r < I8) { tr_item(F.in[22], 2048, 256, 0, 8, 256, (bf16*)(ws + WS_CW1V), 0, scr, r, F.lane); continue; } r -= I8;
        if (r < I9) { tr_item(F.in[21], 256, 64, 0, 2, 64, (bf16*)(ws + WS_CW2K), 0, scr, r, F.lane); continue; } r -= I9;
        tr_item(F.in[23], 256, 64, 0, 2, 64, (bf16*)(ws + WS_CW2V), 0, scr, r, F.lane);
    }
    { const int gt = F.vcu * (NWAVES * 64) + F.tid, NT = F.G * NWAVES * 64;
      bf16* s1 = (bf16*)(ws + WS_SK1); bf16* s2 = (bf16*)(ws + WS_SK2);
      for (int i = gt; i < 128 * 128; i += NT) { s1[i] = f2b(F.in[29][i]); s2[i] = f2b(F.in[30][i]); } }
    for (int m = gw; m < M; m += NGW) rms_row_to_bf16(F.lane, F.in[0] + (size_t)m * D, F.in[1], (bf16*)(ws + WS_H) + (size_t)m * D);
}
constexpr int REC_BYTES = 12800;
__device__ __forceinline__ void rwkv_prep_tile(const Frame& F, int u) {
    const int tid = F.tid, lane = F.lane, h = F.wave, r16 = lane & 15, q4 = lane >> 4;
    const int R0 = 64 * u, t0 = R0 & (T - 1);
    LAS float* lin = (LAS float*)(F.lds);
    LAS bf16* mats = (LAS bf16*)(F.lds + 16384) + h * 4096;
    LAS float* abl = (LAS float*)(F.lds + 16384 + 65536) + h * 272;
    float* PRW = (float*)(F.ws + WS_PRW);
    const float* BND = (const float*)(F.ws + WS_BND);
    bf16* G = (bf16*)((unsigned char*)F.out + DO_G);
    const float* mu = F.in[3];
    const float mu_r = mu[tid], mu_k = mu[512 + tid], mu_v = mu[1024 + tid], mu_l = (tid < 256) ? mu[1536 + tid] : 0.f;
    const float w0c = F.in[4][tid], a0c = F.in[6][tid], kkc = F.in[9][tid], kac = F.in[10][tid], rkc = F.in[11][tid];
    const float* w_up = F.in[5]; const float* a_up = F.in[7]; const float* g_up = F.in[8];
    float pr = 0.f, pk = 0.f, pv = 0.f, pl = 0.f;
    if (t0 != 0) { const float* b = BND + (size_t)(u - 1) * RWC; pr = b[tid]; pk = b[512 + tid]; pv = b[1024 + tid]; if (tid < 256) pl = b[1536 + tid]; }
    for (int batch = 0; batch < 4; ++batch) {
        const int Rb = R0 + 16 * batch;
        float xr[16], xk[16]; unsigned vtw[8];
        if (tid < 256) { float xl[16];
#pragma unroll
            for (int j = 0; j < 16; ++j) xl[j] = PRW[(size_t)(Rb + j) * RWC + 1536 + tid];
#pragma unroll
            for (int j = 0; j < 16; ++j) { const float n = xl[j]; const float v = n + (pl - n) * mu_l; pl = n; const float f = (tid < 64) ? tanhf(v) : ((tid < 128) ? v : sigmf(v)); lin[tid * 16 + j] = f; } }
        { float xv[16];
#pragma unroll
          for (int j = 0; j < 16; ++j) { const float* p = PRW + (size_t)(Rb + j) * RWC; xr[j] = p[tid]; xk[j] = p[512 + tid]; xv[j] = p[1024 + tid]; }
          VM_WAIT();
#pragma unroll
          for (int j = 0; j < 16; ++j) { float n;
              n = xr[j]; xr[j] = n + (pr - n) * mu_r; pr = n;
              n = xk[j]; xk[j] = n + (pk - n) * mu_k; pk = n;
              n = xv[j]; const unsigned vb = f2bf(n + (pv - n) * mu_v); pv = n;
              if (j & 1) vtw[j >> 1] |= vb << 16; else vtw[j >> 1] = vb; } }
        __syncthreads();
        float accw[16], acca[16], accg[16];
#pragma unroll
        for (int j = 0; j < 16; ++j) accg[j] = 0.f;
#pragma unroll 1
        for (int jj = 0; jj < 128; ++jj) { const float gv = g_up[jj * 512 + tid];
            const LAS f32x4* ig = (const LAS f32x4*)(lin + (128 + jj) * 16);
#pragma unroll
            for (int q = 0; q < 4; ++q) { const f32x4 a = ig[q];
#pragma unroll
                for (int e = 0; e < 4; ++e) accg[4 * q + e] += a[e] * gv; } }
#pragma unroll
        for (int j = 0; j < 16; ++j) G[(size_t)(Rb + j) * 512 + tid] = f2b(accg[j]);
        __builtin_amdgcn_sched_barrier(0);
#pragma unroll
        for (int j = 0; j < 16; ++j) { accw[j] = 0.f; acca[j] = 0.f; }
#pragma unroll 1
        for (int jj = 0; jj < 64; ++jj) { const float wv = w_up[jj * 512 + tid], av = a_up[jj * 512 + tid];
            const LAS f32x4* iw = (const LAS f32x4*)(lin + jj * 16); const LAS f32x4* ia = (const LAS f32x4*)(lin + (64 + jj) * 16);
#pragma unroll
            for (int q = 0; q < 4; ++q) { const f32x4 a = iw[q], b = ia[q];
#pragma unroll
                for (int e = 0; e < 4; ++e) { accw[4 * q + e] += a[e] * wv; acca[4 * q + e] += b[e] * av; } } }
        unsigned char* rec = (unsigned char*)(PRW + (size_t)Rb * RWC) + h * REC_BYTES;
#pragma unroll
        for (int j = 0; j < 16; ++j) {
            const float z = -(w0c + accw[j]); const float sp = fmaxf(z, 0.f) + log1pf(__expf(-fabsf(z)));
            const float e = __expf(-sp - 0.5f); accw[j] = __expf(-e);
            const float a = sigmf(a0c + acca[j]); acca[j] = a;
            const float kkv = xk[j] * kkc; xk[j] = xk[j] * (1.f + (a - 1.f) * kac);
            const float ss = wave_sum(kkv * kkv); accg[j] = kkv / fmaxf(sqrtf(ss), 1e-12f);
            const float bon = wave_sum(xr[j] * xk[j] * rkc);
            if (lane == 0) *(float*)(rec + 12544 + 4 * j) = bon; __builtin_amdgcn_sched_barrier(0); }
        { float g = 1.f; unsigned bhw[8], khw[8];
          LAS bf16* mp = mats + lane;
#pragma unroll
          for (int j = 0; j < 16; ++j) { const float gp = g; g *= accw[j]; const float ig = 1.0f / g;
              const unsigned w1 = pg8::cvt_pk_bf16(accg[j] * gp, xr[j] * g), w2 = pg8::cvt_pk_bf16(accg[j] * acca[j] * ig, xk[j] * ig);
              mp[j * 64] = (u16)(w1 & 0xffffu); mp[1024 + j * 64] = (u16)(w1 >> 16); mp[2048 + j * 64] = (u16)(w2 & 0xffffu); mp[3072 + j * 64] = (u16)(w2 >> 16);
              if (j & 1) { bhw[j >> 1] |= w2 << 16; khw[j >> 1] |= w2 & 0xffff0000u; } else { bhw[j >> 1] = w2 & 0xffffu; khw[j >> 1] = w2 >> 16; } }
          *(float*)(rec + 12288 + 4 * lane) = g;
          v4u* bp = (v4u*)(rec + 4096 + lane * 32); bp[0] = (v4u){bhw[0], bhw[1], bhw[2], bhw[3]}; bp[1] = (v4u){bhw[4], bhw[5], bhw[6], bhw[7]};
          v4u* kp = (v4u*)(rec + 6144 + lane * 32); kp[0] = (v4u){khw[0], khw[1], khw[2], khw[3]}; kp[1] = (v4u){khw[4], khw[5], khw[6], khw[7]};
          v4u* vp = (v4u*)(rec + 8192 + lane * 32); vp[0] = (v4u){vtw[0], vtw[1], vtw[2], vtw[3]}; vp[1] = (v4u){vtw[4], vtw[5], vtw[6], vtw[7]}; }
        LDS_WAIT(); asm volatile("" ::: "memory");
#pragma unroll
        for (int i = 0; i < 2; ++i) { const int pi = lane + 64 * i, s = pi >> 3, ks = (pi >> 2) & 1, qq = pi & 3;
#pragma unroll
            for (int mtx = 0; mtx < 2; ++mtx) { const LAS bf16* src = mats + mtx * 1024 + s * 64 + 32 * ks + 4 * qq;
                const u32x2 lo = *(const LAS u32x2*)src, hi = *(const LAS u32x2*)(src + 16);
                *(v4u*)(rec + mtx * 2048 + pi * 16) = (v4u){lo.x, lo.y, hi.x, hi.y}; } }
        LDS_WAIT(); asm volatile("" ::: "memory");
        { f32x4 Ab = {0.f, 0.f, 0.f, 0.f}, Ak = Ab, Mb = Ab, Mk = Ab;
#pragma unroll
          for (int ks = 0; ks < 2; ++ks) { const int off = r16 * 64 + 32 * ks + 8 * q4;
              const bf16x8 aK = as_bf16x8(*(const LAS v4u*)(mats + off)), aR = as_bf16x8(*(const LAS v4u*)(mats + 1024 + off)), bB = as_bf16x8(*(const LAS v4u*)(mats + 2048 + off)), bK = as_bf16x8(*(const LAS v4u*)(mats + 3072 + off));
              Ab = mfma16(aK, bB, Ab); Ak = mfma16(aK, bK, Ak); Mb = mfma16(aR, bB, Mb); Mk = mfma16(aR, bK, Mk); }
          bf16* rAk = (bf16*)(rec + 10240); bf16* rMb = (bf16*)(rec + 11264); bf16* rMk = (bf16*)(rec + 11776);
#pragma unroll
          for (int r = 0; r < 4; ++r) { const int s = 4 * q4 + r, j = r16; const bool lo = j < s, le = j <= s;
              abl[s * 17 + j] = lo ? Ab[r] : 0.f; rAk[s * 16 + j] = f2b(lo ? Ak[r] : 0.f); rMb[s * 16 + j] = f2b(le ? Mb[r] : 0.f); rMk[s * 16 + j] = f2b(le ? Mk[r] : 0.f); } }
        LDS_WAIT(); asm volatile("" ::: "memory");
        { float Tr[16]; bf16* rT = (bf16*)(rec + 10752);
#pragma unroll
          for (int s = 0; s < 16; ++s) { float t = (r16 == s) ? 1.f : 0.f;
#pragma unroll
              for (int j = 0; j < s; ++j) t -= abl[s * 17 + j] * Tr[j];
              Tr[s] = t; if (lane < 16) rT[s * 16 + r16] = f2b(-t); __builtin_amdgcn_sched_barrier(0); } }
        __syncthreads();
    }
}
__device__ __forceinline__ void nsa_prep_tile(const Frame& F, int u) {
    const int lane = F.lane, w = F.wave;
    const int R0 = 64 * u, t0 = R0 & (T - 1), b = R0 / T;
    bf16* PNSA = (bf16*)((unsigned char*)F.out + DO_PNSA);
    const float qg = F.in[14][lane] * (0.125f * LOG2E);
    const float kg = (w < 2) ? F.in[16][lane] : F.in[17][lane];
    const int kcol = ((w < 2) ? 768 : 1024) + (w & 1) * 64 + lane;
    for (int tok = 0; tok < 64; ++tok) { bf16* p = PNSA + (size_t)(R0 + tok) * 1280;
        const float q = bf2f(p[w * 64 + lane]); const float ss = wave_sum(q * q) * (1.f / 64.f);
        float k = 0.f; if (w < 4) k = bf2f(p[kcol]);
        const float ks = wave_sum(k * k) * (1.f / 64.f);
        p[w * 64 + lane] = f2b(q * rsqrtf(ss + NORM_EPS) * qg);
        if (w < 4) p[kcol] = f2b(k * rsqrtf(ks + NORM_EPS) * kg); }
    if (w >= 4) {
        const int g = w & 1; const int scol = ((w < 6) ? 896 : 1152) + g * 64;
        bf16* VT = (bf16*)(F.ws + ((w < 6) ? WS_VST : WS_VWT)) + (size_t)((b * 2 + g) * 64) * T + t0 + lane;
        const v4u* src = (const v4u*)(PNSA + (size_t)(R0 + lane) * 1280 + scol);
        v4u v[8];
#pragma unroll
        for (int i = 0; i < 8; ++i) v[i] = src[i];
#pragma unroll
        for (int i = 0; i < 8; ++i) {
            VT[(size_t)(8 * i + 0) * T] = (u16)(v[i].x & 0xffffu); VT[(size_t)(8 * i + 1) * T] = (u16)(v[i].x >> 16);
            VT[(size_t)(8 * i + 2) * T] = (u16)(v[i].y & 0xffffu); VT[(size_t)(8 * i + 3) * T] = (u16)(v[i].y >> 16);
            VT[(size_t)(8 * i + 4) * T] = (u16)(v[i].z & 0xffffu); VT[(size_t)(8 * i + 5) * T] = (u16)(v[i].z >> 16);
            VT[(size_t)(8 * i + 6) * T] = (u16)(v[i].w & 0xffffu); VT[(size_t)(8 * i + 7) * T] = (u16)(v[i].w >> 16); }
    }
}
__device__ __forceinline__ float gelu_tanh(float x) { const float t = 0.7978845608028654f * (x + 0.044715f * x * x * x); return 0.5f * x * (1.f + tanhf(t)); }
__device__ __forceinline__ void compress_unit(const Frame& F, int u) {
    const int lane = F.lane, w = F.wave, r16 = lane & 15, q4 = lane >> 4;
    const int kvsel = u >> 7, b = (u >> 5) & 3, g = (u >> 4) & 1, ntile = u & 15;
    const bf16* X = (const bf16*)((unsigned char*)F.out + DO_PNSA) + (size_t)(b * T) * 1280 + (kvsel ? 640 : 512) + g * 64;
    const float* pos = kvsel ? F.in[19] : F.in[18];
    const bf16* W1t = (const bf16*)(F.ws + (kvsel ? WS_CW1V : WS_CW1K));
    const bf16* W2t = (const bf16*)(F.ws + (kvsel ? WS_CW2V : WS_CW2K));
    LAS bf16* hid = (LAS bf16*)(F.lds);
    LAS float* outb = (LAS float*)(F.lds + 16 * 528);
    int n = 16 * ntile + r16; if (n > 254) n = 254;
    f32x4 acc[2] = {{0.f, 0.f, 0.f, 0.f}, {0.f, 0.f, 0.f, 0.f}};
#pragma unroll 4
    for (int s = 0; s < 64; ++s) { const int lp = s >> 1, d0 = (s & 1) * 32 + 8 * q4;
        const v4u xa = *(const v4u*)(X + (size_t)(16 * n + lp) * 1280 + d0);
        const f32x4 p0 = *(const f32x4*)(pos + lp * 64 + d0), p1 = *(const f32x4*)(pos + lp * 64 + d0 + 4);
        v4u af; af.x = pk2(bflo(xa.x) + p0[0], bfhi(xa.x) + p0[1]); af.y = pk2(bflo(xa.y) + p0[2], bfhi(xa.y) + p0[3]);
        af.z = pk2(bflo(xa.z) + p1[0], bfhi(xa.z) + p1[1]); af.w = pk2(bflo(xa.w) + p1[2], bfhi(xa.w) + p1[3]);
#pragma unroll
        for (int nt = 0; nt < 2; ++nt) { const v4u bfg = *(const v4u*)(W1t + (size_t)(32 * w + 16 * nt + r16) * 2048 + 32 * s + 8 * q4);
            acc[nt] = mfma16(as_bf16x8(af), as_bf16x8(bfg), acc[nt]); } }
#pragma unroll
    for (int nt = 0; nt < 2; ++nt)
#pragma unroll
        for (int r = 0; r < 4; ++r) hid[(4 * q4 + r) * 264 + 32 * w + 16 * nt + r16] = f2b(gelu_tanh(acc[nt][r]));
    __syncthreads();
    if (w < 4) { f32x4 a2 = {0.f, 0.f, 0.f, 0.f};
#pragma unroll
        for (int s = 0; s < 8; ++s) { const v4u af = *(const LAS v4u*)(hid + r16 * 264 + 32 * s + 8 * q4);
            const v4u bfg = *(const v4u*)(W2t + (size_t)(16 * w + r16) * 256 + 32 * s + 8 * q4);
            a2 = mfma16(as_bf16x8(af), as_bf16x8(bfg), a2); }
#pragma unroll
        for (int r = 0; r < 4; ++r) outb[(4 * q4 + r) * 64 + 16 * w + r16] = a2[r]; }
    __syncthreads();
#pragma unroll
    for (int rr = 0; rr < 2; ++rr) { const int row = 2 * w + rr; const int nn = 16 * ntile + row; float val = outb[row * 64 + lane];
        if (kvsel == 0) { const float ss = wave_sum(val * val) * (1.f / 64.f); val = val * rsqrtf(ss + NORM_EPS) * F.in[15][lane];
            ((bf16*)(F.ws + WS_KC))[(size_t)((b * 2 + g) * 256 + nn) * 64 + lane] = (nn < 255) ? f2b(val) : (u16)0; }
        else ((bf16*)(F.ws + WS_VCT))[(size_t)((b * 2 + g) * 64 + lane) * 256 + nn] = (nn < 255) ? f2b(val) : (u16)0; }
    __syncthreads();
}
struct KFr { bf16x8 a0, a1, b0, b1; };
__device__ __forceinline__ KFr load_k(const bf16* Kb, int rstride, int k0, int r16, int q4) {
    const int keyA = k0 + 8 * (r16 >> 2) + (r16 & 3);
    const bf16* pa = Kb + (size_t)keyA * rstride + 8 * q4; const bf16* pb = pa + (size_t)4 * rstride;
    KFr f; f.a0 = as_bf16x8(*(const v4u*)pa); f.a1 = as_bf16x8(*(const v4u*)(pa + 32)); f.b0 = as_bf16x8(*(const v4u*)pb); f.b1 = as_bf16x8(*(const v4u*)(pb + 32)); return f;
}
struct VFr { bf16x8 v[4]; };
__device__ __forceinline__ VFr load_v(const bf16* Vt, int dstride, int k0, int r16, int q4) {
    VFr f;
#pragma unroll
    for (int dt = 0; dt < 4; ++dt) f.v[dt] = as_bf16x8(*(const v4u*)(Vt + (size_t)(16 * dt + r16) * dstride + k0 + 8 * q4));
    return f;
}
__device__ __forceinline__ bf16x8 pack_p(const f32x4 a, const f32x4 b) {
    v4u w; w.x = pg8::cvt_pk_bf16(a[0], a[1]); w.y = pg8::cvt_pk_bf16(a[2], a[3]); w.z = pg8::cvt_pk_bf16(b[0], b[1]); w.w = pg8::cvt_pk_bf16(b[2], b[3]); return as_bf16x8(w);
}
#define NSA_FENCE() asm volatile("s_waitcnt lgkmcnt(0)" ::: "memory")
__device__ __forceinline__ void nsa_wave_unit(const Frame& F, int b, int g, int t0, LAS float* wl) {
    const int lane = F.lane, r16 = lane & 15, q4 = lane >> 4;
    const f32x4 Z4 = {0.f, 0.f, 0.f, 0.f};
    const bf16* PN = (const bf16*)((unsigned char*)F.out + DO_PNSA) + (size_t)(b * T) * 1280;
    const float* GL = (const float*)((unsigned char*)F.out + DO_GLOG) + (size_t)(b * T) * 32;
    LAS float* impT = wl; LAS float* imp2T = wl + 8 * 65; LAS unsigned* selT = (LAS unsigned*)(wl + 16 * 65); LAS int* stl = (LAS int*)(wl + 16 * 65 + 16);
    bf16x8 qf[2][2]; int tq[2];
#pragma unroll
    for (int mt = 0; mt < 2; ++mt) { tq[mt] = t0 + 4 * mt + (r16 >> 2);
#pragma unroll
        for (int dh = 0; dh < 2; ++dh) qf[mt][dh] = as_bf16x8(*(const v4u*)(PN + (size_t)tq[mt] * 1280 + (g * 4 + (r16 & 3)) * 64 + 32 * dh + 8 * q4)); }
    f32x4 Oc[2][4];
#pragma unroll
    for (int mt = 0; mt < 2; ++mt)
#pragma unroll
        for (int dt = 0; dt < 4; ++dt) Oc[mt][dt] = Z4;
    float gate[2][4][3];
#pragma unroll
    for (int mt = 0; mt < 2; ++mt)
#pragma unroll
        for (int r = 0; r < 4; ++r)
#pragma unroll
            for (int br = 0; br < 3; ++br) gate[mt][r][br] = sigmf(GL[(size_t)(t0 + 4 * mt + q4) * 32 + g * 12 + r * 3 + br]);

    const bf16* KC = (const bf16*)(F.ws + WS_KC) + (size_t)((b * 2 + g) * 256) * 64;
    const bf16* VCT = (const bf16*)(F.ws + WS_VCT) + (size_t)((b * 2 + g) * 64) * 256;
    for (int i = lane; i < 16 * 65; i += 64) wl[i] = 0.f;
    const int ncmp = (t0 + 7 >= 31) ? ((t0 + 7 - 31) >> 4) + 1 : 0;
    const int nst = (ncmp + 31) >> 5;
    float inv[2] = {0.f, 0.f};
    if (nst > 0) {   float ls[2] = {0.f, 0.f};
        KFr kf = load_k(KC, 64, 0, r16, q4);
        for (int st = 0; st < nst; ++st) { const int k0 = 32 * st; const int k1 = (st + 1 < nst) ? k0 + 32 : k0; const KFr kn = load_k(KC, 64, k1, r16, q4);
#pragma unroll
            for (int mt = 0; mt < 2; ++mt) { f32x4 sA = mfma16(kf.a0, qf[mt][0], Z4); sA = mfma16(kf.a1, qf[mt][1], sA); f32x4 sB = mfma16(kf.b0, qf[mt][0], Z4); sB = mfma16(kf.b1, qf[mt][1], sB);
#pragma unroll
                for (int r = 0; r < 4; ++r) { const int nA = k0 + 8 * q4 + r, nB = nA + 4;
                    ls[mt] += (16 * nA + 31 <= tq[mt]) ? __builtin_amdgcn_exp2f(sA[r]) : 0.f; ls[mt] += (16 * nB + 31 <= tq[mt]) ? __builtin_amdgcn_exp2f(sB[r]) : 0.f; } }
            kf = kn; }
#pragma unroll
        for (int mt = 0; mt < 2; ++mt) { float l = ls[mt]; l += __shfl_xor(l, 16); l += __shfl_xor(l, 32); inv[mt] = 1.0f / fmaxf(l, 1e-30f); }
    }
    if (nst > 0) {   f32x4 O[2][4];
#pragma unroll
        for (int mt = 0; mt < 2; ++mt)
#pragma unroll
            for (int dt = 0; dt < 4; ++dt) O[mt][dt] = Z4;
        KFr kf = load_k(KC, 64, 0, r16, q4); VFr vf = load_v(VCT, 256, 0, r16, q4);
        for (int st = 0; st < nst; ++st) { const int k0 = 32 * st; const int k1 = (st + 1 < nst) ? k0 + 32 : k0; const KFr kn = load_k(KC, 64, k1, r16, q4); const VFr vn = load_v(VCT, 256, k1, r16, q4);
#pragma unroll
            for (int mt = 0; mt < 2; ++mt) { f32x4 sA = mfma16(kf.a0, qf[mt][0], Z4); sA = mfma16(kf.a1, qf[mt][1], sA); f32x4 sB = mfma16(kf.b0, qf[mt][0], Z4); sB = mfma16(kf.b1, qf[mt][1], sB);
                f32x4 pA, pB;
#pragma unroll
                for (int r = 0; r < 4; ++r) { const int nA = k0 + 8 * q4 + r, nB = nA + 4;
                    pA[r] = (16 * nA + 31 <= tq[mt]) ? __builtin_amdgcn_exp2f(sA[r]) * inv[mt] : 0.f; pB[r] = (16 * nB + 31 <= tq[mt]) ? __builtin_amdgcn_exp2f(sB[r]) * inv[mt] : 0.f; }
                float vA = pA[0] + pA[1] + pA[2] + 0.5f * pA[3], cA = 0.5f * pA[3], vB = pB[0] + pB[1] + pB[2] + 0.5f * pB[3], cB = 0.5f * pB[3];
                vA += __shfl_xor(vA, 1); vA += __shfl_xor(vA, 2); cA += __shfl_xor(cA, 1); cA += __shfl_xor(cA, 2);
                vB += __shfl_xor(vB, 1); vB += __shfl_xor(vB, 2); cB += __shfl_xor(cB, 1); cB += __shfl_xor(cB, 2);
                if ((lane & 3) == 0) { const int tl = 4 * mt + (r16 >> 2), j = (k0 >> 2) + 2 * q4;
                    impT[tl * 65 + j] = vA; imp2T[tl * 65 + j + 1] = cA; impT[tl * 65 + j + 1] = vB; imp2T[tl * 65 + j + 2] = cB; }
                const bf16x8 pf = pack_p(pA, pB);
#pragma unroll
                for (int dt = 0; dt < 4; ++dt) O[mt][dt] = mfma16(pf, vf.v[dt], O[mt][dt]); }
            kf = kn; vf = vn; }
#pragma unroll
        for (int mt = 0; mt < 2; ++mt)
#pragma unroll
            for (int dt = 0; dt < 4; ++dt)
#pragma unroll
                for (int r = 0; r < 4; ++r) Oc[mt][dt][r] += gate[mt][r][0] * O[mt][dt][r];
    }
    NSA_FENCE();
    const int cur = t0 >> 6;
    unsigned long long uni = 0ull;
    for (int tl = 0; tl < 8; ++tl) {
        unsigned long long mask;
        if (cur < 16) mask = (2ull << cur) - 1ull;
        else {
            const float sc = impT[tl * 65 + lane] + imp2T[tl * 65 + lane];
            const unsigned key = __float_as_uint(fmaxf(sc, 0.f));
            const bool elig = (lane <= cur) && (lane != 0) && (lane != cur) && (lane != cur - 1);
            unsigned prefix = 0u;
            for (int bit = 30; bit >= 0; --bit) { const unsigned cand = prefix | (1u << bit);
                const int cnt = __popcll(__ballot(elig && key >= cand)); if (cnt >= 13) prefix = cand; }
            const unsigned long long gt = __ballot(elig && key > prefix); unsigned long long ties = __ballot(elig && key == prefix);
            int need = 13 - __popcll(gt); unsigned long long keep = 0ull;
            while (need > 0 && ties) { const unsigned long long low = ties & (0ull - ties); keep |= low; ties ^= low; --need; }
            mask = gt | keep | 1ull | (1ull << cur) | (1ull << (cur - 1));
        }
        uni |= mask;
        if (lane == 0) { selT[2 * tl] = (unsigned)mask; selT[2 * tl + 1] = (unsigned)(mask >> 32); }
    }
    NSA_FENCE();
    unsigned long long mk[2];
#pragma unroll
    for (int mt = 0; mt < 2; ++mt) { const int tl = 4 * mt + (r16 >> 2); mk[mt] = (unsigned long long)selT[2 * tl] | ((unsigned long long)selT[2 * tl + 1] << 32); }
    NSA_FENCE();

#pragma unroll 1
    for (int br = 1; br < 3; ++br) {
        const bf16* Kb = PN + (br == 1 ? 768 : 1024) + g * 64;
        const bf16* Vt = (const bf16*)(F.ws + (br == 1 ? WS_VST : WS_VWT)) + (size_t)((b * 2 + g) * 64) * T;
        f32x4 O[2][4]; float ls[2] = {0.f, 0.f};
#pragma unroll
        for (int mt = 0; mt < 2; ++mt)
#pragma unroll
            for (int dt = 0; dt < 4; ++dt) O[mt][dt] = Z4;
        int nsteps;
        if (br == 1) { nsteps = 2 * __popcll(uni);
            if ((uni >> lane) & 1ull) { const int rk = __popcll(uni & ((1ull << lane) - 1ull)); stl[2 * rk] = 64 * lane; stl[2 * rk + 1] = 64 * lane + 32; } }
        else { const int lo = t0 - 511; const int klo = (lo > 0 ? lo : 0) & ~31; nsteps = ((t0 + 8 - klo) + 31) >> 5; if (lane < nsteps) stl[lane] = klo + 32 * lane; }
        NSA_FENCE();
        KFr kf = load_k(Kb, 1280, __builtin_amdgcn_readfirstlane(stl[0]), r16, q4); VFr vf = load_v(Vt, T, __builtin_amdgcn_readfirstlane(stl[0]), r16, q4);
        for (int i = 0; i < nsteps; ++i) {
            const int k0 = __builtin_amdgcn_readfirstlane(stl[i]); const int k1 = __builtin_amdgcn_readfirstlane(stl[(i + 1 < nsteps) ? i + 1 : i]); const int j = k0 >> 6;
            const KFr kn = load_k(Kb, 1280, k1, r16, q4); const VFr vn = load_v(Vt, T, k1, r16, q4);
#pragma unroll
            for (int mt = 0; mt < 2; ++mt) { f32x4 sA = mfma16(kf.a0, qf[mt][0], Z4); sA = mfma16(kf.a1, qf[mt][1], sA); f32x4 sB = mfma16(kf.b0, qf[mt][0], Z4); sB = mfma16(kf.b1, qf[mt][1], sB);
                f32x4 pA, pB; const bool sb = (br == 1) ? (((mk[mt] >> j) & 1ull) != 0ull) : true;
#pragma unroll
                for (int r = 0; r < 4; ++r) { const int kA = k0 + 8 * q4 + r, kB = kA + 4;
                    const bool mA = sb && (kA <= tq[mt]) && (br == 1 || kA + 512 > tq[mt]), mB = sb && (kB <= tq[mt]) && (br == 1 || kB + 512 > tq[mt]);
                    pA[r] = mA ? __builtin_amdgcn_exp2f(sA[r]) : 0.f; pB[r] = mB ? __builtin_amdgcn_exp2f(sB[r]) : 0.f; }
                ls[mt] += (pA[0] + pA[1]) + (pA[2] + pA[3]) + (pB[0] + pB[1]) + (pB[2] + pB[3]);
                const bf16x8 pf = pack_p(pA, pB);
#pragma unroll
                for (int dt = 0; dt < 4; ++dt) O[mt][dt] = mfma16(pf, vf.v[dt], O[mt][dt]); }
            kf = kn; vf = vn;
        }
        NSA_FENCE();
#pragma unroll
        for (int mt = 0; mt < 2; ++mt) { float l = ls[mt]; l += __shfl_xor(l, 16); l += __shfl_xor(l, 32); const float il = 1.0f / fmaxf(l, 1e-30f);
#pragma unroll
            for (int r = 0; r < 4; ++r) { const float ilr = __shfl(il, 4 * q4 + r) * (br == 1 ? gate[mt][r][1] : gate[mt][r][2]);
#pragma unroll
                for (int dt = 0; dt < 4; ++dt) Oc[mt][dt][r] += ilr * O[mt][dt][r]; } }
    }
    bf16* YB = (bf16*)(F.ws + WS_H + 16 * MiB) + (size_t)(b * T) * 512;
#pragma unroll
    for (int mt = 0; mt < 2; ++mt)
#pragma unroll
        for (int r = 0; r < 4; ++r)
#pragma unroll
            for (int dt = 0; dt < 4; ++dt) YB[(size_t)(t0 + 4 * mt + q4) * 512 + (g * 4 + r) * 64 + 16 * dt + r16] = f2b(Oc[mt][dt][r]);
}
__device__ __forceinline__ void nsa_phase(const Frame& F, int rep) {
    LAS float* wl = (LAS float*)(F.lds + F.wave * 5120);
    for (;;) {
        unsigned c = 0;
        if (F.lane == 0) c = __hip_atomic_fetch_add(F.ctl + CW_NSAQ + 64 * rep, 1u, RLX_AGENT);
        c = (unsigned)__builtin_amdgcn_readfirstlane((int)c);
        if (c >= 4096u) break;
        const int b = c & 3, g = (c >> 2) & 1, tqi = 511 - (int)(c >> 3);
        nsa_wave_unit(F, b, g, 8 * tqi, wl);
    }
}
typedef short bf16x4 __attribute__((ext_vector_type(4)));
__device__ __forceinline__ f32x4 mfma16k16(const bf16x4 a, const bf16x4 b, const f32x4 c) { const bf16x8 a8 = {a[0], a[1], a[2], a[3], 0, 0, 0, 0}, b8 = {b[0], b[1], b[2], b[3], 0, 0, 0, 0}; return __builtin_amdgcn_mfma_f32_16x16x32_bf16(a8, b8, c, 0, 0, 0); }
__device__ __forceinline__ bf16x4 as_bf16x4(const u32x2 v) { return __builtin_bit_cast(bf16x4, v); }
__device__ __forceinline__ bf16x4 pack4(const f32x4 a) { u32x2 w; w.x = pg8::cvt_pk_bf16(a[0], a[1]); w.y = pg8::cvt_pk_bf16(a[2], a[3]); return as_bf16x4(w); }
__device__ __forceinline__ f32x4 unpk4(const u32x2 w) { f32x4 r; r[0] = bflo(w.x); r[1] = bfhi(w.x); r[2] = bflo(w.y); r[3] = bfhi(w.y); return r; }
struct ChunkIn { v4u kt0, kt1, rt0, rt1; u32x2 ak, nt, mb, mk, vt, bh[4], kh[4]; f32x4 gam[4]; };
__device__ __forceinline__ void scan_load(ChunkIn& c, const unsigned char* rec, int vq, int r16, int q4) {
    c.kt0 = *(const v4u*)(rec + (r16 * 64 + q4 * 8) * 2); c.kt1 = *(const v4u*)(rec + (r16 * 64 + 32 + q4 * 8) * 2);
    c.rt0 = *(const v4u*)(rec + 2048 + (r16 * 64 + q4 * 8) * 2); c.rt1 = *(const v4u*)(rec + 2048 + (r16 * 64 + 32 + q4 * 8) * 2);
#pragma unroll
    for (int mt = 0; mt < 4; ++mt) { c.bh[mt] = *(const u32x2*)(rec + 4096 + ((16 * mt + r16) * 16 + 4 * q4) * 2); c.kh[mt] = *(const u32x2*)(rec + 6144 + ((16 * mt + r16) * 16 + 4 * q4) * 2);
        c.gam[mt] = *(const f32x4*)(rec + 12288 + (16 * mt + 4 * q4) * 4); }
    c.vt = *(const u32x2*)(rec + 8192 + ((16 * vq + r16) * 16 + 4 * q4) * 2);
    c.ak = *(const u32x2*)(rec + 10240 + (r16 * 16 + 4 * q4) * 2); c.nt = *(const u32x2*)(rec + 10752 + (r16 * 16 + 4 * q4) * 2);
    c.mb = *(const u32x2*)(rec + 11264 + (r16 * 16 + 4 * q4) * 2); c.mk = *(const u32x2*)(rec + 11776 + (r16 * 16 + 4 * q4) * 2);
}
__device__ __forceinline__ void rwkv_scan_wave(const Frame& F, int bh, int vq) {
    const int lane = F.lane, r16 = lane & 15, q4 = lane >> 4, b = bh >> 3, h = bh & 7;
    const f32x4 Z4 = {0.f, 0.f, 0.f, 0.f};
    const unsigned char* recb = F.ws + WS_PRW + (size_t)(b * T) * 7168 + h * REC_BYTES;
    bf16* Y = (bf16*)(F.ws + WS_H) + (size_t)(b * T) * 512 + h * 64 + 16 * vq + r16;
    f32x4 Zt[4] = {Z4, Z4, Z4, Z4};
    ChunkIn cur, nxt;
    scan_load(cur, recb, vq, r16, q4);
    for (int ch = 0; ch < T / 16; ++ch) {
        scan_load(nxt, recb + (size_t)((ch + 1 < T / 16) ? ch + 1 : ch) * (16 * 7168), vq, r16, q4);
        const bf16x8 zb0 = pack_p(Zt[0], Zt[1]), zb1 = pack_p(Zt[2], Zt[3]);
        f32x4 X = mfma16(as_bf16x8(cur.kt0), zb0, Z4); X = mfma16(as_bf16x8(cur.kt1), zb1, X);
        f32x4 Yc = mfma16(as_bf16x8(cur.rt0), zb0, Z4); Yc = mfma16(as_bf16x8(cur.rt1), zb1, Yc);
        const bf16x4 vt = as_bf16x4(cur.vt);
        const f32x4 W = mfma16k16(as_bf16x4(cur.ak), vt, X);
        const f32x4 U = mfma16k16(as_bf16x4(cur.nt), pack4(W), Z4);
        const bf16x4 ub = pack4(U);
        Yc = mfma16k16(as_bf16x4(cur.mk), vt, Yc); Yc = mfma16k16(as_bf16x4(cur.mb), ub, Yc);
#pragma unroll
        for (int mt = 0; mt < 4; ++mt) { f32x4 acc = mfma16k16(as_bf16x4(cur.kh[mt]), vt, Zt[mt]); acc = mfma16k16(as_bf16x4(cur.bh[mt]), ub, acc); Zt[mt] = acc * cur.gam[mt]; }
#pragma unroll
        for (int r = 0; r < 4; ++r) Y[(size_t)(16 * ch + 4 * q4 + r) * 512] = f2b(Yc[r]);
        cur = nxt;
    }
}
__device__ __forceinline__ void rwkv_epilogue(const Frame& F) {
    const int lane = F.lane; const int gw = F.vcu * NWAVES + F.wave, NGW = F.G * NWAVES;
    const unsigned char* prw = F.ws + WS_PRW; const bf16* G = (const bf16*)((unsigned char*)F.out + DO_G); bf16* YA = (bf16*)(F.ws + WS_H);
    for (int idx = gw; idx < (M / 16) * 8; idx += NGW) { const int bt = idx >> 3, h = idx & 7, c = h * 64 + lane;
        const unsigned char* rec = prw + (size_t)(16 * bt) * 7168 + h * REC_BYTES;
        const v4u* vp = (const v4u*)(rec + 8192 + lane * 32); const v4u v0 = vp[0], v1 = vp[1];
        const float lw = F.in[12][c], lb = F.in[13][c];
        float yv[16], gv[16], bo[16];
#pragma unroll
        for (int s = 0; s < 16; ++s) { const size_t o = (size_t)(16 * bt + s) * 512 + c; yv[s] = bf2f(YA[o]); gv[s] = bf2f(G[o]); bo[s] = *(const float*)(rec + 12544 + 4 * s); }
#pragma unroll
        for (int s = 0; s < 16; ++s) { const unsigned vw = (s < 8) ? v0[s >> 1] : v1[(s - 8) >> 1]; const float vv = (s & 1) ? bfhi(vw) : bflo(vw);
            const float y = yv[s]; const float mean = wave_sum(y) * (1.f / 64.f); const float d = y - mean; const float var = wave_sum(d * d) * (1.f / 64.f);
            const float yn = d * rsqrtf(var + GN_EPS) * lw + lb;
            YA[(size_t)(16 * bt + s) * 512 + c] = f2b((yn + bo[s] * vv) * gv[s]); }
    }
}
__device__ __forceinline__ unsigned sortable(float x) { const unsigned u = __float_as_uint(x); return (u & 0x80000000u) ? ~u : (u | 0x80000000u); }
__device__ __forceinline__ float unsortable(unsigned k) { const unsigned u = (k & 0x80000000u) ? (k & 0x7fffffffu) : ~k; return __uint_as_float(u); }
#define TK_INSERT(L, key_) do { unsigned k_ = (key_); _Pragma("unroll") for (int s_ = 0; s_ < 16; ++s_) { const unsigned hi_ = L[s_] > k_ ? L[s_] : k_; k_ = L[s_] > k_ ? k_ : L[s_]; L[s_] = hi_; } } while (0)
__device__ __forceinline__ void peer_topk_pass(const Frame& F, int wp, LAS float* sc) {
    const int lane = F.lane, r16 = lane & 15, q4 = lane >> 4;
    const bf16* QRY = (const bf16*)(F.ws + WS_PRW);
    int* EID = (int*)(F.ws + WS_PRW + 64 * MiB); float* EG = (float*)(F.ws + WS_PRW + 72 * MiB);
    const int row = lane & 31, part = lane >> 5;
    unsigned L1[16], L2[16];
#pragma unroll
    for (int half = 0; half < 2; ++half) {
        const bf16* SK = (const bf16*)(F.ws + (half ? WS_SK2 : WS_SK1));
#pragma unroll
        for (int mt = 0; mt < 2; ++mt) { const int rho = 32 * wp + 16 * mt + r16;
            const bf16* qp = QRY + (size_t)(rho >> 3) * 2048 + (rho & 7) * 256 + half * 128 + 8 * q4;
            bf16x8 af[4];
#pragma unroll
            for (int s = 0; s < 4; ++s) af[s] = as_bf16x8(*(const v4u*)(qp + 32 * s));
#pragma unroll
            for (int kt = 0; kt < 8; ++kt) { f32x4 acc = {0.f, 0.f, 0.f, 0.f};
#pragma unroll
                for (int s = 0; s < 4; ++s) acc = mfma16(af[s], as_bf16x8(*(const v4u*)(SK + (size_t)(16 * kt + r16) * 128 + 32 * s + 8 * q4)), acc);
#pragma unroll
                for (int r = 0; r < 4; ++r) { const int rw = 16 * mt + 4 * q4 + r; sc[rw * 128 + ((16 * kt + r16) ^ rw)] = acc[r]; } } }
        NSA_FENCE();
        unsigned Ls[16];
#pragma unroll
        for (int s = 0; s < 16; ++s) Ls[s] = 0u;
#pragma unroll 4
        for (int i = 0; i < 64; ++i) { const int c = 64 * part + i; const float x = sc[row * 128 + (c ^ row)];
            TK_INSERT(Ls, (sortable(x) & ~0x7Fu) | (unsigned)(127 - c)); }
        unsigned Lo[16];
#pragma unroll
        for (int s = 0; s < 16; ++s) Lo[s] = (unsigned)__shfl_xor((int)Ls[s], 32);
#pragma unroll
        for (int s = 0; s < 16; ++s) TK_INSERT(Ls, Lo[s]);
#pragma unroll
        for (int s = 0; s < 16; ++s) { if (half == 0) L1[s] = Ls[s]; else L2[s] = Ls[s]; }
        NSA_FENCE();
    }
    float v1[16], v2[16];
#pragma unroll
    for (int s = 0; s < 16; ++s) { v1[s] = unsortable(L1[s]); v2[s] = unsortable(L2[s]); }
    unsigned C[16];
#pragma unroll
    for (int s = 0; s < 16; ++s) C[s] = 0u;
#pragma unroll
    for (int i = 0; i < 16; ++i)
#pragma unroll
        for (int j = 0; j < 16; ++j) if ((i + 1) * (j + 1) <= 16) { TK_INSERT(C, (sortable(v1[i] + v2[j]) & ~0xFFu) | (unsigned)(255 - (16 * i + j))); }
    LAS unsigned* il = (LAS unsigned*)sc;
    if (part == 0) {
#pragma unroll
        for (int s = 0; s < 16; ++s) { il[row * 33 + s] = 127u - (L1[s] & 127u); il[row * 33 + 16 + s] = 127u - (L2[s] & 127u); }
    }
    NSA_FENCE();
    if (part == 0) { const int rho = 32 * wp + row;
        float val[16], e[16]; float sum = 0.f;
#pragma unroll
        for (int s = 0; s < 16; ++s) val[s] = unsortable(C[s]);
#pragma unroll
        for (int s = 0; s < 16; ++s) { e[s] = __expf(val[s] - val[0]); sum += e[s]; }
        const float is = 1.0f / sum;
#pragma unroll
        for (int s = 0; s < 16; ++s) { const unsigned pos = 255u - (C[s] & 255u); const unsigned i = pos >> 4, j = pos & 15u;
            EID[(size_t)rho * 16 + s] = (int)(il[row * 33 + i] * 128u + il[row * 33 + 16 + j]); EG[(size_t)rho * 16 + s] = e[s] * is; }
    }
    NSA_FENCE();
}
typedef float f32x2_t __attribute__((ext_vector_type(2)));
constexpr float PEER_SCALE = 256.0f, PEER_ISCALE = 1.0f / 256.0f;
__device__ __forceinline__ void peer_convert_one(const Frame& F, const float* srcf, unsigned char* dstb) {
    const int gt = F.vcu * (NWAVES * 64) + F.tid, NT = F.G * NWAVES * 64;
    const f32x4* src = (const f32x4*)srcf; v4u* dst = (v4u*)dstb;
    for (int i = gt; i < 16384 * 1024 / 16; i += NT) { v4u o;
#pragma unroll
        for (int q = 0; q < 4; ++q) { const f32x4 a = src[4 * i + q] * PEER_SCALE; int w = __builtin_amdgcn_cvt_pk_fp8_f32(a[0], a[1], 0, false); w = __builtin_amdgcn_cvt_pk_fp8_f32(a[2], a[3], w, true); o[q] = (unsigned)w; }
        dst[i] = o; }
}
__device__ __forceinline__ void peer_convert_tables(const Frame& F) { peer_convert_one(F, F.in[31], F.ws + WS_MG); peer_convert_one(F, F.in[32], F.ws + WS_MG + 16 * MiB); }
__device__ __forceinline__ void peer_gather(const Frame& F) {
    const int lane = F.lane; const int gw = F.vcu * NWAVES + F.wave, NGW = F.G * NWAVES;
    const bf16* H2 = (const bf16*)(F.ws + WS_H);
    const int* EID = (const int*)(F.ws + WS_PRW + 64 * MiB); const float* EG = (const float*)(F.ws + WS_PRW + 72 * MiB);
    const unsigned char* U8 = F.ws + WS_MG; const unsigned char* V8 = F.ws + WS_MG + 16 * MiB;
    for (int tok = gw; tok < M; tok += NGW) {
        float h[16], o[16];
        { const v4u h0 = *(const v4u*)(H2 + (size_t)tok * D + 16 * lane), h1 = *(const v4u*)(H2 + (size_t)tok * D + 16 * lane + 8);
#pragma unroll
          for (int q = 0; q < 4; ++q) { h[2 * q] = bflo(h0[q]); h[2 * q + 1] = bfhi(h0[q]); h[8 + 2 * q] = bflo(h1[q]); h[8 + 2 * q + 1] = bfhi(h1[q]); } }
#pragma unroll
        for (int i = 0; i < 16; ++i) o[i] = 0.f;
#pragma unroll 1
        for (int hh = 0; hh < 2; ++hh) {
            const int idv = EID[(size_t)tok * 128 + 64 * hh + lane]; const float gv = EG[(size_t)tok * 128 + 64 * hh + lane] * PEER_ISCALE;
#pragma unroll 1
            for (int e0 = 0; e0 < 64; e0 += 8) {
                v4u uu[8], vv[8]; float gt[8], dot[8];
#pragma unroll
                for (int k = 0; k < 8; ++k) { const int id = __builtin_amdgcn_readlane(idv, e0 + k); gt[k] = __builtin_bit_cast(float, __builtin_amdgcn_readlane(__builtin_bit_cast(int, gv), e0 + k));
                    uu[k] = *(const v4u*)(U8 + (size_t)id * D + 16 * lane); vv[k] = *(const v4u*)(V8 + (size_t)id * D + 16 * lane); }
#pragma unroll
                for (int k = 0; k < 8; ++k) { float d0 = 0.f, d1 = 0.f;
#pragma unroll
                    for (int q = 0; q < 4; ++q) { const f32x2_t lo = __builtin_amdgcn_cvt_pk_f32_fp8((int)uu[k][q], false), hi = __builtin_amdgcn_cvt_pk_f32_fp8((int)uu[k][q], true);
                        d0 += h[4 * q] * lo.x; d1 += h[4 * q + 1] * lo.y; d0 += h[4 * q + 2] * hi.x; d1 += h[4 * q + 3] * hi.y; }
                    dot[k] = d0 + d1; }
#pragma unroll
                for (int o_ = 1; o_ < 64; o_ <<= 1) {
#pragma unroll
                    for (int k = 0; k < 8; ++k) dot[k] += __shfl_xor(dot[k], o_); }
#pragma unroll
                for (int k = 0; k < 8; ++k) { const float dt = dot[k] * PEER_ISCALE; const float cf = gt[k] * 0.5f * dt * (1.f + erff(dt * 0.70710678118654752f));
#pragma unroll
                    for (int q = 0; q < 4; ++q) { const f32x2_t lo = __builtin_amdgcn_cvt_pk_f32_fp8((int)vv[k][q], false), hi = __builtin_amdgcn_cvt_pk_f32_fp8((int)vv[k][q], true);
                        o[4 * q] += cf * lo.x; o[4 * q + 1] += cf * lo.y; o[4 * q + 2] += cf * hi.x; o[4 * q + 3] += cf * hi.y; } }
            }
        }
        f32x4* p = (f32x4*)(F.out + (size_t)tok * D + 16 * lane);
#pragma unroll
        for (int q = 0; q < 4; ++q) { f32x4 a = p[q]; a[0] += o[4 * q]; a[1] += o[4 * q + 1]; a[2] += o[4 * q + 2]; a[3] += o[4 * q + 3]; p[q] = a; }
    }
}
struct Args { const float* in[33]; float* out; unsigned char* ws; int ph_lo, ph_hi; };
__global__ void __launch_bounds__(NWAVES * 64, 2) mk_fwd(Args args) {
    extern __shared__ __attribute__((aligned(16))) unsigned char lds[];
    Frame F;
    F.lds = (LAS unsigned char*)lds;
    F.MISC = (volatile LAS unsigned*)(F.lds + MISC_OFF);
    F.tid = threadIdx.x; F.lane = F.tid & 63; F.wave = __builtin_amdgcn_readfirstlane(F.tid >> 6);
    F.G = gridDim.x; { const int bx = blockIdx.x; F.vcu = (F.G % 8 == 0) ? (bx % 8) * (F.G / 8) + bx / 8 : bx; }
    unsigned char* ws = args.ws; F.ws = ws; F.out = args.out;
    F.ctl = (gu32*)(ws + WS_CTL);
#pragma unroll
    for (int i = 0; i < 33; ++i) F.in[i] = args.in[i];
    for (int u = F.tid; u < (LDS_BYTES - LDSCTL_OFF) / 4; u += NWAVES * 64) ((LAS unsigned*)(F.lds + LDSCTL_OFF))[u] = 0u;
    __syncthreads();
    const int lo = args.ph_lo, hi = args.ph_hi & 0xff; const int rep = args.ph_hi >> 8;
    const bool multi = (hi - lo) > 1;
    XcdBarrier bar; bar.bar = (unsigned*)(F.ctl + CW_BAR); bar.x = 0; bar.st = nullptr;
    if (multi) bar = xcd_barrier_post((unsigned*)(F.ctl + CW_BAR), F.MISC + 8);
#define IN(k) (lo <= (k) && (k) < hi)
#define NREP(k) ((((repmask) >> (k)) & 1) + 1)
#define REPBAR() do { if (rep) xcd_barrier(bar); } while (0)
#define SEAM(k) do { if (IN(k) && IN((k) + 1)) xcd_barrier(bar); } while (0)

    if (IN(0)) { { p0_prologue(F); } } SEAM(0);
    if (IN(1)) { {
        pg8::Gemm g{(const pg8::bf16_t*)(ws + WS_H), (const pg8::bf16_t*)(ws + WS_WIN), M, NG1, D}; pg8::StaticOrder S; S.init(M, NG1, F.G, (int)blockIdx.x);
        pg8::EpiG1 E{(float*)(ws + WS_PRW), (float*)(ws + WS_BND), (pg8::bf16_t*)((unsigned char*)F.out + DO_PNSA), (pg8::bf16_t*)(ws + WS_MG), (float*)((unsigned char*)F.out + DO_GLOG)};
        pg8::gemm_phase<pg8::EpiG1, pg8::StaticOrder, true, true>(F.lds + RING_OFF, g, S, E);
    } } SEAM(1);
    if (IN(2)) {
        for (int u = F.vcu; u < 256; u += F.G) nsa_prep_tile(F, u);
        for (int u = F.vcu; u < 256; u += F.G) compress_unit(F, u);
        for (int u = F.vcu; u < 256; u += F.G) rwkv_prep_tile(F, u);
    } SEAM(2);
    if (IN(3)) { {
        if ((int)blockIdx.x < 32 && F.wave < 4 && !(rep && P3REP == 3)) rwkv_scan_wave(F, (int)blockIdx.x, F.wave);
        if (!(rep && P3REP == 2)) nsa_phase(F, rep);
    } } SEAM(3);
    if (IN(4)) { { rwkv_epilogue(F); } } SEAM(4);
    if (IN(5)) { {
        { pg8::Gemm g{(const pg8::bf16_t*)(ws + WS_H), (const pg8::bf16_t*)(ws + WS_WA), M, D, 512}; pg8::StaticOrder S; S.init(M, D, F.G, (int)blockIdx.x);
          pg8::EpiGate1 E{(float*)(ws + WS_PRW), (const pg8::bf16_t*)(ws + WS_MG), 0};
          pg8::gemm_phase<pg8::EpiGate1, pg8::StaticOrder, true, true>(F.lds + RING_OFF, g, S, E); }
        VM_WAIT(); __syncthreads();
        { pg8::Gemm g{(const pg8::bf16_t*)(ws + WS_H + 16 * MiB), (const pg8::bf16_t*)(ws + WS_WB), M, D, 512}; pg8::StaticOrder S; S.init(M, D, F.G, (int)blockIdx.x);
          pg8::EpiGate2 E{(const float*)(ws + WS_PRW), (const pg8::bf16_t*)(ws + WS_MG), 1024, (pg8::bf16_t*)(ws + WS_PRW + 64 * MiB)};
          pg8::gemm_phase<pg8::EpiGate2, pg8::StaticOrder, true, true>(F.lds + RING_OFF, g, S, E); }
    } } SEAM(5);
    if (IN(6)) { {
        pg8::Gemm g{(const pg8::bf16_t*)(ws + WS_PRW + 64 * MiB), (const pg8::bf16_t*)(ws + WS_WOUT), M, D, D}; pg8::StaticOrder S; S.init(M, D, F.G, (int)blockIdx.x);
        pg8::EpiRes E{F.in[0], F.out};
        pg8::gemm_phase<pg8::EpiRes, pg8::StaticOrder, true, true>(F.lds + RING_OFF, g, S, E);
    } } SEAM(6);
    if (IN(7)) { { const int gw = F.vcu * NWAVES + F.wave, NGW = F.G * NWAVES;
        for (int m = gw; m < M; m += NGW) rms_row_to_bf16(F.lane, F.out + (size_t)m * D, F.in[27], (bf16*)(ws + WS_H) + (size_t)m * D);
        peer_convert_tables(F);
    } } SEAM(7);
    if (IN(8)) { {
        pg8::Gemm g{(const pg8::bf16_t*)(ws + WS_H), (const pg8::bf16_t*)(ws + WS_WQ), M, 2048, D}; pg8::StaticOrder S; S.init(M, 2048, F.G, (int)blockIdx.x);
        pg8::EpiBf16<0> E{(pg8::bf16_t*)(ws + WS_PRW), 2048, nullptr, 0, 0, 1.f};
        pg8::gemm_phase<pg8::EpiBf16<0>, pg8::StaticOrder, true, true>(F.lds + RING_OFF, g, S, E);
    } } SEAM(8);
    if (IN(9)) { { const int gw = F.vcu * NWAVES + F.wave, NGW = F.G * NWAVES; LAS float* sc = (LAS float*)(F.lds + F.wave * 16384);
        for (int wp = gw; wp < M * 8 / 32; wp += NGW) peer_topk_pass(F, wp, sc);
    } } SEAM(9);
    if (IN(10)) { peer_gather(F); }
#undef IN
#undef SEAM
}

extern "C" void kernel_launch(void* const* d_in, const int* in_sizes, int n_in, void* d_out, int out_size, void* d_ws, size_t ws_size, hipStream_t stream) {
    static int grid = 0;
    if (grid == 0) {
        if (n_in != 33 || out_size != M * D || ws_size < WS_END) { fprintf(stderr, "kernel_launch: unexpected shapes (n_in %d out %d ws %zu)\n", n_in, out_size, ws_size); grid = -1; return; }
        int dev = 0, cus = 0, per_cu = 0;
        if (hipGetDevice(&dev) != hipSuccess || hipDeviceGetAttribute(&cus, hipDeviceAttributeMultiprocessorCount, dev) != hipSuccess) { grid = -1; return; }
        if (hipFuncSetAttribute((const void*)mk_fwd, hipFuncAttributeMaxDynamicSharedMemorySize, LDS_BYTES) != hipSuccess) { fprintf(stderr, "kernel_launch: hipFuncSetAttribute failed\n"); grid = -1; return; }
        if (hipOccupancyMaxActiveBlocksPerMultiprocessor(&per_cu, (const void*)mk_fwd, NWAVES * 64, LDS_BYTES) != hipSuccess || per_cu < 1)
            fprintf(stderr, "kernel_launch: occupancy query reports %d blocks per CU\n", per_cu);
        (void)hipGetLastError();
        grid = cus;
        if (grid > 256) grid = 256;
    }
    if (grid < 0) return;
    if (hipMemsetAsync((char*)d_ws + WS_CTL, 0, CTL_ZERO_BYTES, stream) != hipSuccess) return;
    Args a{};
    for (int i = 0; i < 33; ++i) a.in[i] = (const float*)d_in[i];
    a.out = (float*)d_out; a.ws = (unsigned char*)d_ws;
#if MK_ONE_LAUNCH
    a.ph_lo = 0; a.ph_hi = N_PHASES;
    hipLaunchKernelGGL(mk_fwd, dim3(grid), dim3(NWAVES * 64), LDS_BYTES, stream, a);
#else
    for (int p = 0; p < N_PHASES; ++p) { for (int r = 0; r <= (((REP_MASK) >> p) & 1); ++r) { a.ph_lo = p; a.ph_hi = (p + 1) | (r << 8); hipLaunchKernelGGL(mk_fwd, dim3(grid), dim3(NWAVES * 64), LDS_BYTES, stream, a); } }
#endif
}
```

```cpp
#include <hip/hip_runtime.h>
#include <cstdio>
#include <cstdint>
#define MK_ONE_LAUNCH 1
#define REP_MASK 0
#define P3REP 1
namespace pg8 {
#define PG8_LAS __attribute__((address_space(3)))
typedef unsigned short bf16_t;
typedef short bf16x8 __attribute__((ext_vector_type(8)));
typedef float f32x4 __attribute__((ext_vector_type(4)));
typedef unsigned u32x4 __attribute__((ext_vector_type(4)));
constexpr int BM = 256, BK = 64, HALF = 128, HTB = HALF * BK * 2  , STAGE_BYTES = 8 * HTB, NXCD = 8, WGM = 8;

__host__ __device__ __forceinline__ int lds_byte(int r, int c) { const int st = (r >> 4) * 2 + (c >> 5), rr = r & 15, cc = c & 31, ob = rr * 64 + cc * 2; return st * 1024 + (ob ^ (((ob >> 9) & 1) << 5)); }
__host__ __device__ __forceinline__ void stage_rc(int b, int& R, int& C) { const int st = b / 1024, sb = b % 1024, swz = sb ^ (((sb >> 9) & 1) << 5); R = (st >> 1) * 16 + swz / 64; C = (st & 1) * 32 + (swz % 64) / 2; }
__host__ __device__ __forceinline__ int perm32(int rho) { const int n = rho >> 4, i = rho & 15; return 8 * (i >> 2) + 4 * n + (i & 3); }

struct Unit { int pm, pn; };
struct Gemm { const bf16_t* A; const bf16_t* Bt; int M, N, K; };

struct StaticOrder {
    int nM, nN, nwg, G, c;
    __host__ __device__ void init(int M, int N, int G_, int c_) { nM = M / BM; nN = N / BM; nwg = nM * nN; G = G_; c = c_; }
    __host__ __device__ bool next(int i, Unit& u) const {
        const long L = (long)i * G + c; if (L >= nwg) return false;
        int wgid = (int)L; { const int q = nwg / NXCD, r = nwg % NXCD, xcd = wgid % NXCD, off = wgid / NXCD; wgid = (xcd < r ? xcd * (q + 1) : r * (q + 1) + (xcd - r) * q) + off; }
        const int nig = WGM * nN, gid = wgid / nig, fm = gid * WGM, gsz = (nM - fm) < WGM ? (nM - fm) : WGM;
        u.pm = fm + ((wgid % nig) % gsz); u.pn = (wgid % nig) / gsz; return true;
    }
    __device__ __forceinline__ void a_ready(const Unit&) const {}
    __device__ __forceinline__ void done(const Unit&) const {}
};

typedef float f32x2c __attribute__((ext_vector_type(2))); typedef __bf16 bf16x2c __attribute__((ext_vector_type(2)));
__device__ __forceinline__ unsigned cvt_pk_bf16(float lo, float hi) { const f32x2c v = {lo, hi}; const bf16x2c b = __builtin_convertvector(v, bf16x2c); return __builtin_bit_cast(unsigned, b); }
typedef float f32x2 __attribute__((ext_vector_type(2)));
__device__ __forceinline__ f32x2 gelu_pk(f32x2 v) {
    const f32x2 av = __builtin_elementwise_abs(v), d = av * 0.2316418882f + 1.0f;
    f32x2 t; t.x = __builtin_amdgcn_rcpf(d.x); t.y = __builtin_amdgcn_rcpf(d.y);
    f32x2 q = t * 0.5307027145f + (-0.7265760135f); q = q * t + 0.7107068705f; q = q * t + (-0.142248368f); q = q * t + 0.127414796f; q = q * t;
    const f32x2 s = (v * v) * (-0.72134752044f);
    f32x2 e; e.x = __builtin_amdgcn_exp2f(s.x); e.y = __builtin_amdgcn_exp2f(s.y);
    const f32x2 m = v * (q * e), r = v - m;
    f32x2 o; o.x = v.x < 0.f ? m.x : r.x; o.y = v.y < 0.f ? m.y : r.y; return o;
}

template <int ACT  > struct EpiBf16 {
    static constexpr bool PERM = true, AFTER_DRAIN = false; static_assert(ACT == 0 || ACT == 1, "EpiBf16: ACT is 0 (none) or 1 (gelu_pk)");
    bf16_t* O; int ldc; const float* bias; int split_cols; size_t split_stride; float scale0;
    __device__ __forceinline__ void operator()(const f32x4 (&acc)[2][2][4][2], const Unit& u, int wr, int wc, int fr, int fq) const {
        const int row0 = u.pm * BM + wr * 64 + fr; int colt = u.pn * BM; bf16_t* base = O;
        float sc = 1.f; if (split_cols) { const int t = colt / split_cols; base += (size_t)t * split_stride; colt -= t * split_cols; if (t == 0) sc = scale0; }
        const int col0 = colt + wc * 32 + 8 * fq, bcol0 = u.pn * BM + wc * 32 + 8 * fq;
        f32x4 bv[2][2];
#pragma unroll
        for (int bj = 0; bj < 2; ++bj)
#pragma unroll
            for (int n = 0; n < 2; ++n) bv[bj][n] = bias ? *(const f32x4*)(bias + bcol0 + bj * HALF + 4 * n) : (f32x4){0.f, 0.f, 0.f, 0.f};
#pragma unroll
        for (int ai = 0; ai < 2; ++ai)
#pragma unroll
            for (int m = 0; m < 4; ++m) { bf16_t* rowp = base + (size_t)(row0 + ai * HALF + m * 16) * ldc + col0;
#pragma unroll
                for (int bj = 0; bj < 2; ++bj) { f32x4 v0 = acc[ai][bj][m][0] + bv[bj][0], v1 = acc[ai][bj][m][1] + bv[bj][1];
                    if (ACT == 1) { f32x2 a = gelu_pk((f32x2){v0[0], v0[1]}), b = gelu_pk((f32x2){v0[2], v0[3]}), c = gelu_pk((f32x2){v1[0], v1[1]}), d = gelu_pk((f32x2){v1[2], v1[3]});
                        v0 = (f32x4){a.x, a.y, b.x, b.y}; v1 = (f32x4){c.x, c.y, d.x, d.y}; }
                    v0 = v0 * sc; v1 = v1 * sc; u32x4 w; w.x = cvt_pk_bf16(v0[0], v0[1]); w.y = cvt_pk_bf16(v0[2], v0[3]); w.z = cvt_pk_bf16(v1[0], v1[1]); w.w = cvt_pk_bf16(v1[2], v1[3]);
                    *(u32x4*)(rowp + bj * HALF) = w; } }
    }
};
__device__ __forceinline__ float bf_lo(unsigned w) { return __uint_as_float(w << 16); }
__device__ __forceinline__ float bf_hi(unsigned w) { return __uint_as_float(w & 0xffff0000u); }
__device__ __forceinline__ float sigm(float x) { return 1.0f / (1.0f + __expf(-x)); }
__device__ __forceinline__ u32x4 pack8(const f32x4 v0, const f32x4 v1) { u32x4 w; w.x = cvt_pk_bf16(v0[0], v0[1]); w.y = cvt_pk_bf16(v0[2], v0[3]); w.z = cvt_pk_bf16(v1[0], v1[1]); w.w = cvt_pk_bf16(v1[2], v1[3]); return w; }

struct EpiG1 {
    static constexpr bool PERM = true, AFTER_DRAIN = false;
    float* PRW; float* BND; bf16_t* PNSA; bf16_t* MG; float* GLOG;
    __device__ __forceinline__ void operator()(const f32x4 (&acc)[2][2][4][2], const Unit& u, int wr, int wc, int fr, int fq) const {
        const int row0 = u.pm * BM + wr * 64 + fr, c0 = wc * 32 + 8 * fq;
#pragma unroll
        for (int ai = 0; ai < 2; ++ai)
#pragma unroll
            for (int m = 0; m < 4; ++m) { const int row = row0 + ai * HALF + m * 16;
#pragma unroll
                for (int bj = 0; bj < 2; ++bj) { const f32x4 v0 = acc[ai][bj][m][0], v1 = acc[ai][bj][m][1]; const int col = c0 + bj * HALF;
                    if (u.pn < 7) { float* p = PRW + (size_t)row * 1792 + u.pn * 256 + col; *(f32x4*)p = v0; *(f32x4*)(p + 4) = v1;
                        if ((row & 63) == 63) { float* q = BND + (size_t)(row >> 6) * 1792 + u.pn * 256 + col; *(f32x4*)q = v0; *(f32x4*)(q + 4) = v1; } }
                    else if (u.pn < 12) { *(u32x4*)(PNSA + (size_t)row * 1280 + (u.pn - 7) * 256 + col) = pack8(v0, v1); }
                    else if (u.pn < 20) { *(u32x4*)(MG + (size_t)row * 2048 + (u.pn - 12) * 256 + col) = pack8(v0, v1); }
                    else { if (col < 32) { float* p = GLOG + (size_t)row * 32 + col; *(f32x4*)p = v0; *(f32x4*)(p + 4) = v1; } }
                } }
    }
};
struct EpiGate1 {
    static constexpr bool PERM = true, AFTER_DRAIN = false;
    float* T1; const bf16_t* MG; int goff;
    __device__ __forceinline__ void operator()(const f32x4 (&acc)[2][2][4][2], const Unit& u, int wr, int wc, int fr, int fq) const {
        const int row0 = u.pm * BM + wr * 64 + fr, c0 = u.pn * BM + wc * 32 + 8 * fq;
#pragma unroll
        for (int ai = 0; ai < 2; ++ai)
#pragma unroll
            for (int m = 0; m < 4; ++m) { const int row = row0 + ai * HALF + m * 16;
#pragma unroll
                for (int bj = 0; bj < 2; ++bj) { const f32x4 v0 = acc[ai][bj][m][0], v1 = acc[ai][bj][m][1]; const int col = c0 + bj * HALF;
                    const u32x4 g = *(const u32x4*)(MG + (size_t)row * 2048 + goff + col);
                    f32x4 o0, o1; o0[0] = sigm(bf_lo(g.x)) * v0[0]; o0[1] = sigm(bf_hi(g.x)) * v0[1]; o0[2] = sigm(bf_lo(g.y)) * v0[2]; o0[3] = sigm(bf_hi(g.y)) * v0[3];
                    o1[0] = sigm(bf_lo(g.z)) * v1[0]; o1[1] = sigm(bf_hi(g.z)) * v1[1]; o1[2] = sigm(bf_lo(g.w)) * v1[2]; o1[3] = sigm(bf_hi(g.w)) * v1[3];
                    float* p = T1 + (size_t)row * 1024 + col; *(f32x4*)p = o0; *(f32x4*)(p + 4) = o1; } }
    }
};
struct EpiGate2 {
    static constexpr bool PERM = true, AFTER_DRAIN = false;
    const float* T1; const bf16_t* MG; int goff; bf16_t* MIX;
    __device__ __forceinline__ void operator()(const f32x4 (&acc)[2][2][4][2], const Unit& u, int wr, int wc, int fr, int fq) const {
        const int row0 = u.pm * BM + wr * 64 + fr, c0 = u.pn * BM + wc * 32 + 8 * fq;
#pragma unroll
        for (int ai = 0; ai < 2; ++ai)
#pragma unroll
            for (int m = 0; m < 4; ++m) { const int row = row0 + ai * HALF + m * 16;
#pragma unroll
                for (int bj = 0; bj < 2; ++bj) { const f32x4 v0 = acc[ai][bj][m][0], v1 = acc[ai][bj][m][1]; const int col = c0 + bj * HALF;
                    const u32x4 g = *(const u32x4*)(MG + (size_t)row * 2048 + goff + col);
                    const float* p = T1 + (size_t)row * 1024 + col; const f32x4 t0 = *(const f32x4*)p, t1 = *(const f32x4*)(p + 4);
                    f32x4 o0, o1; o0[0] = t0[0] + sigm(bf_lo(g.x)) * v0[0]; o0[1] = t0[1] + sigm(bf_hi(g.x)) * v0[1]; o0[2] = t0[2] + sigm(bf_lo(g.y)) * v0[2]; o0[3] = t0[3] + sigm(bf_hi(g.y)) * v0[3];
                    o1[0] = t1[0] + sigm(bf_lo(g.z)) * v1[0]; o1[1] = t1[1] + sigm(bf_hi(g.z)) * v1[1]; o1[2] = t1[2] + sigm(bf_lo(g.w)) * v1[2]; o1[3] = t1[3] + sigm(bf_hi(g.w)) * v1[3];
                    *(u32x4*)(MIX + (size_t)row * 1024 + col) = pack8(o0, o1); } }
    }
};
struct EpiRes {
    static constexpr bool PERM = true, AFTER_DRAIN = false;
    const float* X; float* OUT;
    __device__ __forceinline__ void operator()(const f32x4 (&acc)[2][2][4][2], const Unit& u, int wr, int wc, int fr, int fq) const {
        const int row0 = u.pm * BM + wr * 64 + fr, c0 = u.pn * BM + wc * 32 + 8 * fq;
#pragma unroll
        for (int ai = 0; ai < 2; ++ai)
#pragma unroll
            for (int m = 0; m < 4; ++m) { const int row = row0 + ai * HALF + m * 16;
#pragma unroll
                for (int bj = 0; bj < 2; ++bj) { const size_t off = (size_t)row * 1024 + c0 + bj * HALF;
                    const f32x4 x0 = *(const f32x4*)(X + off), x1 = *(const f32x4*)(X + off + 4);
                    *(f32x4*)(OUT + off) = x0 + acc[ai][bj][m][0]; *(f32x4*)(OUT + off + 4) = x1 + acc[ai][bj][m][1]; } }
    }
};
template <class Epi, class Sched, bool ALIGN_EPI = false, bool SP2 = false>
__device__ __forceinline__ void gemm_phase(PG8_LAS unsigned char* lds, const Gemm g, const Sched& S, const Epi& E) {
    const int tid = threadIdx.x, wid = __builtin_amdgcn_readfirstlane(tid >> 6), lane = tid & 63, wr = wid >> 2, wc = wid & 3, fr = lane & 15, fq = lane >> 4;
    const int K = g.K, nt = K / BK;
    unsigned voffA[2], voffB[2];
#pragma unroll
    for (int i = 0; i < 2; ++i) { int R, C; stage_rc(tid * 16 + i * 8192, R, C); const int Rb = Epi::PERM ? ((R & ~31) + perm32(R & 31)) : R;
        voffA[i] = (unsigned)(R * K + C) * 2u; voffB[i] = (unsigned)(Rb * K + C) * 2u; }
    const size_t kstep = (size_t)(BK * 2);
    const size_t hstep = (size_t)HALF * K * 2;
    const size_t tstep = 2 * hstep;
    const unsigned ldsw = (unsigned)wid * 1024u;
    const int aoff = lds_byte(wr * 64 + fr, fq * 8), boff = lds_byte(wc * 32 + fr, fq * 8);
#define PG8_SA(b, h) (((b) * 2 + (h)) * HTB)
#define PG8_SB(b, h) ((4 + (b) * 2 + (h)) * HTB)
#define PG8_STAGE(bufoff, gbase, voff) do { _Pragma("unroll") for (int _i = 0; _i < 2; ++_i) \
        __builtin_amdgcn_global_load_lds((const unsigned*)((const char*)(gbase) + (voff)[_i]), (PG8_LAS unsigned*)(lds + (bufoff) + ldsw + _i * 8192), 16, 0, 0); } while (0)
#define PG8_LDA(dst, b, h) do { _Pragma("unroll") for (int m = 0; m < 4; ++m) _Pragma("unroll") for (int k = 0; k < 2; ++k) dst[m][k] = *(const PG8_LAS bf16x8*)(lds + PG8_SA(b, h) + aoff + m * 2048 + k * 1024); } while (0)
#define PG8_LDB(dst, b, h) do { _Pragma("unroll") for (int n = 0; n < 2; ++n) _Pragma("unroll") for (int k = 0; k < 2; ++k) dst[n][k] = *(const PG8_LAS bf16x8*)(lds + PG8_SB(b, h) + boff + n * 2048 + k * 1024); } while (0)
#define PG8_MMA(ai, bj, At, Bt) do { __builtin_amdgcn_s_setprio(1); _Pragma("unroll") for (int m = 0; m < 4; ++m) _Pragma("unroll") for (int n = 0; n < 2; ++n) _Pragma("unroll") for (int k = 0; k < 2; ++k) \
        acc[ai][bj][m][n] = __builtin_amdgcn_mfma_f32_16x16x32_bf16(Bt[n][k], At[m][k], acc[ai][bj][m][n], 0, 0, 0); __builtin_amdgcn_s_setprio(0); } while (0)
#define PG8_WAIT_V(n) asm volatile("s_waitcnt vmcnt(" #n ")" ::: "memory")
#define PG8_WAIT_L(n) asm volatile("s_waitcnt lgkmcnt(" #n ")" ::: "memory")
#define PG8_BAR __builtin_amdgcn_s_barrier()
#define PG8_SCHED __builtin_amdgcn_sched_barrier(0)
    Unit cur, nxt; int ui = 0;
    if (!S.next(0, cur)) return;
    f32x4 acc[2][2][4][2];
#pragma unroll
    for (int a = 0; a < 2; ++a)
#pragma unroll
        for (int b = 0; b < 2; ++b)
#pragma unroll
            for (int m = 0; m < 4; ++m)
#pragma unroll
                for (int n = 0; n < 2; ++n) acc[a][b][m][n] = (f32x4){0.f, 0.f, 0.f, 0.f};
    bf16x8 At[4][2], B0[2][2], B1[2][2];
    const char* cA = (const char*)g.A + (size_t)cur.pm * tstep; const char* cB = (const char*)g.Bt + (size_t)cur.pn * tstep;
    S.a_ready(cur);
    if constexpr (SP2) {
        PG8_STAGE(PG8_SB(0, 0), cB, voffB); PG8_STAGE(PG8_SB(0, 1), cB + hstep, voffB); PG8_STAGE(PG8_SA(0, 0), cA, voffA); PG8_STAGE(PG8_SA(0, 1), cA + hstep, voffA);
        if (wr == 1) PG8_BAR;
        PG8_WAIT_V(2); PG8_BAR;
        PG8_STAGE(PG8_SB(1, 0), cB + kstep, voffB); PG8_STAGE(PG8_SA(1, 0), cA + kstep, voffA); PG8_STAGE(PG8_SB(1, 1), cB + hstep + kstep, voffB);
        PG8_WAIT_V(6); PG8_BAR;
    } else {
        PG8_STAGE(PG8_SB(0, 0), cB, voffB); PG8_STAGE(PG8_SA(0, 0), cA, voffA); PG8_STAGE(PG8_SB(0, 1), cB + hstep, voffB); PG8_STAGE(PG8_SA(0, 1), cA + hstep, voffA);
        if (wr == 1) PG8_BAR;
        PG8_WAIT_V(4); PG8_BAR;
        PG8_STAGE(PG8_SB(1, 0), cB + kstep, voffB); PG8_STAGE(PG8_SA(1, 0), cA + kstep, voffA); PG8_STAGE(PG8_SB(1, 1), cB + hstep + kstep, voffB);
        PG8_WAIT_V(6); PG8_BAR;
    }
    for (;;) {
        const bool has_next = S.next(ui + 1, nxt);
        const char* nA = has_next ? (const char*)g.A + (size_t)nxt.pm * tstep : cA; const char* nB = has_next ? (const char*)g.Bt + (size_t)nxt.pn * tstep : cB;
        for (int t = 0; t < nt; t += 2) {
            const bool last = (t == nt - 2);
            const char* a1 = cA + (size_t)(t + 1) * kstep;
            const char* a2 = last ? nA : cA + (size_t)(t + 2) * kstep; const char* b2 = last ? nB : cB + (size_t)(t + 2) * kstep;
            const char* a3 = a2 + kstep; const char* b3 = b2 + kstep;
            if (last && has_next) S.a_ready(nxt);
            if constexpr (SP2) {
            PG8_LDB(B0, 0, 0); PG8_LDB(B1, 0, 1); PG8_SCHED; PG8_LDA(At, 0, 0); PG8_STAGE(PG8_SA(1, 1), a1 + hstep, voffA);
            PG8_WAIT_V(8); PG8_WAIT_L(0); PG8_BAR; PG8_MMA(0, 0, At, B0); PG8_MMA(0, 1, At, B1); PG8_BAR; PG8_SCHED;
            PG8_LDA(At, 0, 1); PG8_STAGE(PG8_SB(0, 0), b2, voffB); PG8_STAGE(PG8_SB(0, 1), b2 + hstep, voffB); PG8_STAGE(PG8_SA(0, 0), a2, voffA);
            PG8_WAIT_V(8); PG8_WAIT_L(0); PG8_BAR; PG8_MMA(1, 0, At, B0); PG8_MMA(1, 1, At, B1); PG8_BAR; PG8_SCHED;
            PG8_LDB(B0, 1, 0); PG8_LDB(B1, 1, 1); PG8_SCHED; PG8_LDA(At, 1, 0); PG8_STAGE(PG8_SA(0, 1), a2 + hstep, voffA);
            PG8_WAIT_V(8); PG8_WAIT_L(0); PG8_BAR; PG8_MMA(0, 0, At, B0); PG8_MMA(0, 1, At, B1); PG8_BAR; PG8_SCHED;
            PG8_LDA(At, 1, 1); PG8_STAGE(PG8_SB(1, 0), b3, voffB); PG8_STAGE(PG8_SB(1, 1), b3 + hstep, voffB); PG8_STAGE(PG8_SA(1, 0), a3, voffA);
            PG8_WAIT_V(8); PG8_WAIT_L(0); PG8_BAR; PG8_MMA(1, 0, At, B0); PG8_MMA(1, 1, At, B1); PG8_BAR; PG8_SCHED;
            } else {
            PG8_LDB(B0, 0, 0); PG8_SCHED; PG8_LDA(At, 0, 0); PG8_STAGE(PG8_SA(1, 1), a1 + hstep, voffA);
            PG8_WAIT_L(8); PG8_BAR; PG8_WAIT_L(0); PG8_MMA(0, 0, At, B0); PG8_BAR; PG8_SCHED;
            PG8_LDB(B1, 0, 1); PG8_STAGE(PG8_SB(0, 0), b2, voffB);
            PG8_BAR; PG8_WAIT_L(0); PG8_MMA(0, 1, At, B1); PG8_BAR;
            PG8_LDA(At, 0, 1); PG8_STAGE(PG8_SA(0, 0), a2, voffA);
            PG8_BAR; PG8_WAIT_L(0); PG8_MMA(1, 0, At, B0); PG8_BAR; PG8_SCHED;
            PG8_STAGE(PG8_SB(0, 1), b2 + hstep, voffB);
            PG8_WAIT_V(6); PG8_BAR; PG8_MMA(1, 1, At, B1); PG8_BAR;
            PG8_LDB(B0, 1, 0); PG8_SCHED; PG8_LDA(At, 1, 0); PG8_STAGE(PG8_SA(0, 1), a2 + hstep, voffA);
            PG8_WAIT_L(8); PG8_BAR; PG8_WAIT_L(0); PG8_MMA(0, 0, At, B0); PG8_BAR; PG8_SCHED;
            PG8_LDB(B1, 1, 1); PG8_STAGE(PG8_SB(1, 0), b3, voffB);
            PG8_BAR; PG8_WAIT_L(0); PG8_MMA(0, 1, At, B1); PG8_BAR;
            PG8_LDA(At, 1, 1); PG8_STAGE(PG8_SA(1, 0), a3, voffA);
            PG8_BAR; PG8_WAIT_L(0); PG8_MMA(1, 0, At, B0); PG8_BAR; PG8_SCHED;
            PG8_STAGE(PG8_SB(1, 1), b3 + hstep, voffB);
            PG8_WAIT_V(6); PG8_BAR; PG8_MMA(1, 1, At, B1); PG8_BAR;
            }
        }
        if constexpr (ALIGN_EPI) { if (wr == 0) PG8_BAR; }
        if constexpr (!Epi::AFTER_DRAIN) { E(acc, cur, wr, wc, fr, fq); S.done(cur); }
        if (!has_next) break;
#pragma unroll
        for (int a = 0; a < 2; ++a)
#pragma unroll
            for (int b = 0; b < 2; ++b)
#pragma unroll
                for (int m = 0; m < 4; ++m)
#pragma unroll
                    for (int n = 0; n < 2; ++n) acc[a][b][m][n] = (f32x4){0.f, 0.f, 0.f, 0.f};
        cur = nxt; cA = nA; cB = nB; ++ui;
        if constexpr (ALIGN_EPI) { if (wr == 1) PG8_BAR; }
    }
    PG8_WAIT_V(0);
    if constexpr (!ALIGN_EPI) { if (wr == 0) PG8_BAR; }
    PG8_BAR;
    if constexpr (Epi::AFTER_DRAIN) { E.fused(acc, cur, wr, wc, fr, fq, lds, wid, lane); S.done(cur); }
#undef PG8_SA
#undef PG8_SB
#undef PG8_STAGE
#undef PG8_LDA
#undef PG8_LDB
#undef PG8_MMA
#undef PG8_WAIT_V
#undef PG8_WAIT_L
#undef PG8_BAR
#undef PG8_SCHED
}
}
#define GAS __attribute__((address_space(1)))
#define LAS __attribute__((address_space(3)))
typedef unsigned short bf16;
typedef unsigned v4u __attribute__((ext_vector_type(4)));
typedef float f32x4 __attribute__((ext_vector_type(4)));
typedef short bf16x8 __attribute__((ext_vector_type(8)));
typedef GAS unsigned gu32;
typedef GAS unsigned long long gu64;
#define RLX_AGENT __ATOMIC_RELAXED, __HIP_MEMORY_SCOPE_AGENT
#define LDS_WAIT() asm volatile("s_waitcnt lgkmcnt(0)" ::: "memory")
#define VM_WAIT() asm volatile("s_waitcnt vmcnt(0)" ::: "memory")
__device__ __forceinline__ unsigned long long rt() { return __builtin_amdgcn_s_memrealtime(); }
__device__ __forceinline__ unsigned f2bf(float f) { unsigned u = __builtin_bit_cast(unsigned, f); return (u + 0x7fffu + ((u >> 16) & 1u)) >> 16; }
__device__ __forceinline__ unsigned pk2(float lo, float hi) { return f2bf(lo) | (f2bf(hi) << 16); }

#define XB_TMO      128
#define XB_XCNT(j)  (256  + 64 * (j))
#define XB_XSUB(j)  (1280 + 64 * (j))
#define XB_XGEN(j)  (2304 + 64 * (j))
#define XB_TOP      3328
#define XB_TOPGEN   3392
#define XCD_BAR_WORDS 3456
#define XB_SPIN_CAP (1u << 18)

__device__ __forceinline__ unsigned xb_ld(unsigned* p)              { return __hip_atomic_load(p, __ATOMIC_RELAXED, __HIP_MEMORY_SCOPE_AGENT); }
__device__ __forceinline__ unsigned xb_add(unsigned* p, unsigned v) { return __hip_atomic_fetch_add(p, v, __ATOMIC_RELAXED, __HIP_MEMORY_SCOPE_AGENT); }
__device__ __forceinline__ unsigned xb_xcc_id() { return (unsigned)__builtin_amdgcn_s_getreg((3 << 11) | 20) & 0xFu; }
#define XB_SPIN(cond, bar) do { unsigned _sp = 0; while (cond) { __builtin_amdgcn_s_sleep(1); \
    if ((++_sp & 255u) == 0u) { if (xb_ld(&(bar)[XB_TMO])) break; if (_sp > XB_SPIN_CAP) { atomicAdd(&(bar)[XB_TMO], 1u); break; } } } } while (0)

struct XcdBarrier {
    unsigned* bar; unsigned x;
    volatile LAS unsigned* st;
};

__device__ __forceinline__ XcdBarrier xcd_barrier_post(unsigned* bar, volatile LAS unsigned* st) {
    XcdBarrier b; b.bar = bar; b.x = xb_xcc_id(); b.st = st;
    if (threadIdx.x == 0) (void)xb_add(&bar[XB_XCNT(b.x)], 1u);
    return b;
}
__device__ __forceinline__ void xcd_barrier_complete(unsigned* bar, unsigned x, unsigned& nloc, unsigned& nx) {
    const unsigned G = gridDim.x * gridDim.y * gridDim.z;
    unsigned sum, cnt, mine, sp = 0u;
    for (;;) {
        sum = 0u; cnt = 0u; mine = 0u;
#pragma unroll
        for (unsigned j = 0; j < 16; ++j) { const unsigned c = xb_ld(&bar[XB_XCNT(j)]); sum += c; cnt += (c > 0u) ? 1u : 0u; mine = (j == x) ? c : mine; }
        if (sum == G) break;
        __builtin_amdgcn_s_sleep(1);
        if ((++sp & 255u) == 0u) { if (xb_ld(&bar[XB_TMO])) break; if (sp > XB_SPIN_CAP) { atomicAdd(&bar[XB_TMO], 1u); break; } }
    }
    nloc = mine > 0u ? mine : 1u; nx = cnt > 0u ? cnt : 1u;
}

__device__ __forceinline__ void xcd_barrier(const XcdBarrier& b) {
    asm volatile("s_waitcnt vmcnt(0)" ::: "memory");
    __syncthreads();
    if (threadIdx.x == 0) {
        unsigned* bar = b.bar;
        __builtin_amdgcn_s_waitcnt(0);
        unsigned nloc = b.st[0], nx = b.st[1];
        if (nloc == 0u) { xcd_barrier_complete(bar, b.x, nloc, nx); b.st[0] = nloc; b.st[1] = nx; }
        const unsigned old = xb_add(&bar[XB_XSUB(b.x)], 1u);
        const unsigned gen = old / nloc;
        if (old + 1u == (gen + 1u) * nloc) {
            __builtin_amdgcn_fence(__ATOMIC_RELEASE, "agent");
            asm volatile("s_waitcnt vmcnt(0)" ::: "memory");
            const unsigned og = xb_add(&bar[XB_TOP], 1u);
            const unsigned tg = og / nx;
            if (og + 1u == (tg + 1u) * nx) xb_add(&bar[XB_TOPGEN], 1u);
            else XB_SPIN(xb_ld(&bar[XB_TOPGEN]) == tg, bar);
            __builtin_amdgcn_fence(__ATOMIC_ACQUIRE, "agent");
            xb_add(&bar[XB_XGEN(b.x)], 1u);
            asm volatile("s_waitcnt vmcnt(0)" ::: "memory");
        } else {
            XB_SPIN(xb_ld(&bar[XB_XGEN(b.x)]) == gen, bar);
            __builtin_amdgcn_fence(__ATOMIC_ACQUIRE, "agent");
            asm volatile("s_waitcnt vmcnt(0)" ::: "memory");
        }
    }
    __syncthreads();
}
constexpr int NWAVES = 8;
constexpr int BATCH = 4, T = 4096, D = 1024, M = BATCH * T;
constexpr int RWC = 1792;
constexpr int NG1 = 5376;
constexpr float NORM_EPS = 1e-6f, GN_EPS = 64e-5f;
constexpr float LOG2E = 1.4426950408889634f;
constexpr int N_PHASES = 13;
#ifndef MK_ONE_LAUNCH
#define MK_ONE_LAUNCH 0
#endif
#ifndef REP_MASK
#define REP_MASK 0
#endif
#ifndef P3REP
#define P3REP 1
#endif
#ifndef SCAN_BLOCKS
#define SCAN_BLOCKS 128
#endif

constexpr size_t MiB = 1u << 20;
constexpr size_t WS_CTL = 0, CTL_ZERO_BYTES = 1 * MiB;
constexpr size_t WS_WIN = 1 * MiB;
constexpr size_t WS_WA = 12 * MiB, WS_WB = 13 * MiB;
constexpr size_t WS_WOUT = 14 * MiB;
constexpr size_t WS_WQ = 16 * MiB;
constexpr size_t WS_CW1K = 20 * MiB, WS_CW1V = 21 * MiB;
constexpr size_t WS_CW2K = 22 * MiB, WS_CW2V = 22 * MiB + 65536;
constexpr size_t WS_SK1 = 22 * MiB + 131072, WS_SK2 = 22 * MiB + 196608;
constexpr size_t WS_BND = 23 * MiB;
constexpr size_t WS_KC = 25 * MiB;
constexpr size_t WS_VCT = 25 * MiB + 262144;
constexpr size_t WS_H = 26 * MiB;
constexpr size_t WS_PRW = 58 * MiB;
constexpr size_t WS_MG = 170 * MiB;
constexpr size_t WS_VST = 234 * MiB, WS_VWT = 238 * MiB;
constexpr size_t WS_END = 256 * MiB;
constexpr size_t DO_PNSA = 0, DO_G = 40 * MiB, DO_GLOG = 56 * MiB;
constexpr int CW_TMO = 0, CW_CODE = 1, CW_NSAQ = 64, CW_SCANP = 2048, CW_PEERQ = 4160, CW_BAR = 8192;

constexpr int RING_OFF = 0, RING_BYTES = 131072;
constexpr int LDSCTL_OFF = RING_BYTES, MISC_OFF = LDSCTL_OFF + 320;
constexpr int LDS_BYTES = 147456;
typedef unsigned short u16;
typedef unsigned u32x2 __attribute__((ext_vector_type(2)));
struct Frame {
    LAS unsigned char* lds;
    volatile LAS unsigned* MISC;
    gu32* ctl;
    int tid, lane, wave, vcu, G;
    const float* in[33];
    float* out; unsigned char* ws;
};
__device__ __forceinline__ float wave_sum(float v) {
#pragma unroll
    for (int o = 1; o < 64; o <<= 1) v += __shfl_xor(v, o);
    return v;
}
template <int CTRL> __device__ __forceinline__ float dppf(float x) { return __builtin_bit_cast(float, __builtin_amdgcn_update_dpp(0, __builtin_bit_cast(int, x), CTRL, 0xf, 0xf, true)); }
__device__ __forceinline__ float bf2f(u16 b) { return __uint_as_float((unsigned)b << 16); }
__device__ __forceinline__ float bflo(unsigned w) { return __uint_as_float(w << 16); }
__device__ __forceinline__ float bfhi(unsigned w) { return __uint_as_float(w & 0xffff0000u); }
__device__ __forceinline__ u16 f2b(float f) { return (u16)f2bf(f); }
__device__ __forceinline__ float sigmf(float x) { return 1.0f / (1.0f + __expf(-x)); }
__device__ __forceinline__ f32x4 mfma16(const bf16x8 a, const bf16x8 b, const f32x4 c) { return __builtin_amdgcn_mfma_f32_16x16x32_bf16(a, b, c, 0, 0, 0); }
__device__ __forceinline__ bf16x8 as_bf16x8(const v4u v) { return __builtin_bit_cast(bf16x8, v); }

__device__ __forceinline__ void tr_item(const float* W, int K, int ldw, int sc0, int nblk, int ncols_valid, bf16* WT, int dr0, LAS float* scr, int item, int lane) {
    const int kb = item / nblk, nb = item % nblk, k0 = 64 * kb, n0 = 32 * nb;
#pragma unroll 8
    for (int i = 0; i < 32; ++i) { const int kk = 2 * i + (lane >> 5); const int n = n0 + (lane & 31);
        scr[kk * 33 + (lane & 31)] = (n < ncols_valid) ? W[(size_t)(k0 + kk) * ldw + sc0 + n] : 0.f; }
    LDS_WAIT(); asm volatile("" ::: "memory");
    const int c = lane & 7;
#pragma unroll
    for (int j = 0; j < 4; ++j) { const int n = (lane >> 3) + 8 * j; const LAS float* s = scr + (8 * c) * 33 + n;
        v4u o; o.x = pk2(s[0 * 33], s[1 * 33]); o.y = pk2(s[2 * 33], s[3 * 33]); o.z = pk2(s[4 * 33], s[5 * 33]); o.w = pk2(s[6 * 33], s[7 * 33]);
        *(GAS v4u*)(WT + (size_t)(dr0 + n0 + n) * K + k0 + 8 * c) = o; }
    LDS_WAIT(); asm volatile("" ::: "memory");
}
__device__ __forceinline__ void rms_row_to_bf16(int lane, const float* xrow, const float* gain, bf16* orow) {
    const GAS f32x4* xr = (const GAS f32x4*)xrow + lane; const GAS f32x4* gr = (const GAS f32x4*)gain + lane;
    f32x4 v[4]; float s2 = 0.f;
#pragma unroll
    for (int j = 0; j < 4; ++j) { v[j] = xr[64 * j]; s2 += (v[j].x * v[j].x + v[j].y * v[j].y) + (v[j].z * v[j].z + v[j].w * v[j].w); }
    const float rstd = 1.f / sqrtf(wave_sum(s2) * (1.f / D) + NORM_EPS);
    GAS unsigned long long* o8 = (GAS unsigned long long*)orow + lane;
#pragma unroll
    for (int j = 0; j < 4; ++j) { const f32x4 g = gr[64 * j];
        o8[64 * j] = (unsigned long long)pk2(v[j].x * rstd * g.x, v[j].y * rstd * g.y) | ((unsigned long long)pk2(v[j].z * rstd * g.z, v[j].w * rstd * g.w) << 32); }
}
__device__ __forceinline__ void p0_prologue(const Frame& F) {
    LAS float* scr = (LAS float*)(F.lds + RING_OFF + F.wave * 16384);
    const int gw = F.vcu * NWAVES + F.wave, NGW = F.G * NWAVES;
    unsigned char* ws = F.ws;
    constexpr int I0 = 16 * 96, I1 = 16 * 64, I2 = 16 * 8, I3 = 8 * 32, I4 = 8 * 32, I5 = 16 * 32, I6 = 16 * 64, I7 = 32 * 8, I8 = 32 * 8, I9 = 4 * 2, I10 = 4 * 2;
    constexpr int NITEMS = I0 + I1 + I2 + I3 + I4 + I5 + I6 + I7 + I8 + I9 + I10;
    for (int it = gw; it < NITEMS; it += NGW) {
        int r = it;
        if (r < I0) { tr_item(F.in[2], 1024, 5144, 0, 96, 3072, (bf16*)(ws + WS_WIN), 0, scr, r, F.lane); continue; } r -= I0;
        if (r < I1) { tr_item(F.in[2], 1024, 5144, 3096, 64, 2048, (bf16*)(ws + WS_WIN), 3072, scr, r, F.lane); continue; } r -= I1;
        if (r < I2) { tr_item(F.in[2], 1024, 5144, 3072, 8, 24, (bf16*)(ws + WS_WIN), 5120, scr, r, F.lane); continue; } r -= I2;
        if (r < I3) { tr_item(F.in[24], 512, 1024, 0, 32, 1024, (bf16*)(ws + WS_WA), 0, scr, r, F.lane); continue; } r -= I3;
        if (r < I4) { tr_item(F.in[25], 512, 1024, 0, 32, 1024, (bf16*)(ws + WS_WB), 0, scr, r, F.lane); continue; } r -= I4;
        if (r < I5) { tr_item(F.in[26], 1024, 1024, 0, 32, 1024, (bf16*)(ws + WS_WOUT), 0, scr, r, F.lane); continue; } r -= I5;
        if (r < I6) { tr_item(F.in[28], 1024, 2048, 0, 64, 2048, (bf16*)(ws + WS_WQ), 0, scr, r, F.lane); continue; } r -= I6;
        if (r < I7) { tr_item(F.in[20], 2048, 256, 0, 8, 256, (bf16*)(ws + WS_CW1K), 0, scr, r, F.lane); continue; } r -= I7;
        if (r < I8) { tr_item(F.in[22], 2048, 256, 0, 8, 256, (bf16*)(ws + WS_CW1V), 0, scr, r, F.lane); continue; } r -= I8;
        if (r < I9) { tr_item(F.in[21], 256, 64, 0, 2, 64, (bf16*)(ws + WS_CW2K), 0, scr, r, F.lane); continue; } r -= I9;
        tr_item(F.in[23], 256, 64, 0, 2, 64, (bf16*)(ws + WS_CW2V), 0, scr, r, F.lane);
    }
    { const int gt = F.vcu * (NWAVES * 64) + F.tid, NT = F.G * NWAVES * 64;
      bf16* s1 = (bf16*)(ws + WS_SK1); bf16* s2 = (bf16*)(ws + WS_SK2);
      for (int i = gt; i < 128 * 128; i += NT) { s1[i] = f2b(F.in[29][i]); s2[i] = f2b(F.in[30][i]); } }
    for (int m = gw; m < M; m += NGW) rms_row_to_bf16(F.lane, F.in[0] + (size_t)m * D, F.in[1], (bf16*)(ws + WS_H) + (size_t)m * D);
}
constexpr int REC_BYTES = 12800;
__device__ __forceinline__ void rwkv_prep_tile(const Frame& F, int u) {
    const int tid = F.tid, lane = F.lane, h = F.wave, r16 = lane & 15, q4 = lane >> 4;
    const int R0 = 64 * u, t0 = R0 & (T - 1);
    LAS float* lin = (LAS float*)(F.lds);
    LAS bf16* mats = (LAS bf16*)(F.lds + 16384) + h * 4096;
    LAS float* abl = (LAS float*)(F.lds + 16384 + 65536) + h * 272;
    float* PRW = (float*)(F.ws + WS_PRW);
    const float* BND = (const float*)(F.ws + WS_BND);
    bf16* G = (bf16*)((unsigned char*)F.out + DO_G);
    const float* mu = F.in[3];
    const float mu_r = mu[tid], mu_k = mu[512 + tid], mu_v = mu[1024 + tid], mu_l = (tid < 256) ? mu[1536 + tid] : 0.f;
    const float w0c = F.in[4][tid], a0c = F.in[6][tid], kkc = F.in[9][tid], kac = F.in[10][tid], rkc = F.in[11][tid];
    const float* w_up = F.in[5]; const float* a_up = F.in[7]; const float* g_up = F.in[8];
    float pr = 0.f, pk = 0.f, pv = 0.f, pl = 0.f;
    if (t0 != 0) { const float* b = BND + (size_t)(u - 1) * RWC; pr = b[tid]; pk = b[512 + tid]; pv = b[1024 + tid]; if (tid < 256) pl = b[1536 + tid]; }
    for (int batch = 0; batch < 4; ++batch) {
        const int Rb = R0 + 16 * batch;
        float xr[16], xk[16]; unsigned vtw[8];
        if (tid < 256) { float xl[16];
#pragma unroll
            for (int j = 0; j < 16; ++j) xl[j] = PRW[(size_t)(Rb + j) * RWC + 1536 + tid];
#pragma unroll
            for (int j = 0; j < 16; ++j) { const float n = xl[j]; const float v = n + (pl - n) * mu_l; pl = n; const float f = (tid < 64) ? tanhf(v) : ((tid < 128) ? v : sigmf(v)); lin[tid * 16 + j] = f; } }
        { float xv[16];
#pragma unroll
          for (int j = 0; j < 16; ++j) { const float* p = PRW + (size_t)(Rb + j) * RWC; xr[j] = p[tid]; xk[j] = p[512 + tid]; xv[j] = p[1024 + tid]; }
          VM_WAIT();
#pragma unroll
          for (int j = 0; j < 16; ++j) { float n;
              n = xr[j]; xr[j] = n + (pr - n) * mu_r; pr = n;
              n = xk[j]; xk[j] = n + (pk - n) * mu_k; pk = n;
              n = xv[j]; const unsigned vb = f2bf(n + (pv - n) * mu_v); pv = n;
              if (j & 1) vtw[j >> 1] |= vb << 16; else vtw[j >> 1] = vb; } }
        __syncthreads();
        float accw[16], acca[16], accg[16];
#pragma unroll
        for (int j = 0; j < 16; ++j) accg[j] = 0.f;
#pragma unroll 1
        for (int jj = 0; jj < 128; ++jj) { const float gv = g_up[jj * 512 + tid];
            const LAS f32x4* ig = (const LAS f32x4*)(lin + (128 + jj) * 16);
#pragma unroll
            for (int q = 0; q < 4; ++q) { const f32x4 a = ig[q];
#pragma unroll
                for (int e = 0; e < 4; ++e) accg[4 * q + e] += a[e] * gv; } }
#pragma unroll
        for (int j = 0; j < 16; ++j) G[(size_t)(Rb + j) * 512 + tid] = f2b(accg[j]);
        __builtin_amdgcn_sched_barrier(0);
#pragma unroll
        for (int j = 0; j < 16; ++j) { accw[j] = 0.f; acca[j] = 0.f; }
#pragma unroll 1
        for (int jj = 0; jj < 64; ++jj) { const float wv = w_up[jj * 512 + tid], av = a_up[jj * 512 + tid];
            const LAS f32x4* iw = (const LAS f32x4*)(lin + jj * 16); const LAS f32x4* ia = (const LAS f32x4*)(lin + (64 + jj) * 16);
#pragma unroll
            for (int q = 0; q < 4; ++q) { const f32x4 a = iw[q], b = ia[q];
#pragma unroll
                for (int e = 0; e < 4; ++e) { accw[4 * q + e] += a[e] * wv; acca[4 * q + e] += b[e] * av; } } }
        unsigned char* rec = (unsigned char*)(PRW + (size_t)Rb * RWC) + h * REC_BYTES;
#pragma unroll
        for (int j = 0; j < 16; ++j) {
            const float z = -(w0c + accw[j]); const float sp = fmaxf(z, 0.f) + log1pf(__expf(-fabsf(z)));
            const float e = __expf(-sp - 0.5f); accw[j] = __expf(-e);
            const float a = sigmf(a0c + acca[j]); acca[j] = a;
            const float kkv = xk[j] * kkc; xk[j] = xk[j] * (1.f + (a - 1.f) * kac);
            const float ss = wave_sum(kkv * kkv); accg[j] = kkv / fmaxf(sqrtf(ss), 1e-12f);
            const float bon = wave_sum(xr[j] * xk[j] * rkc);
            if (lane == 0) *(float*)(rec + 12544 + 4 * j) = bon; __builtin_amdgcn_sched_barrier(0); }
        { float g = 1.f; unsigned bhw[8], khw[8];
          LAS bf16* mp = mats + lane;
#pragma unroll
          for (int j = 0; j < 16; ++j) { const float gp = g; g *= accw[j]; const float ig = 1.0f / g;
              const unsigned w1 = pg8::cvt_pk_bf16(accg[j] * gp, xr[j] * g), w2 = pg8::cvt_pk_bf16(accg[j] * acca[j] * ig, xk[j] * ig);
              mp[j * 64] = (u16)(w1 & 0xffffu); mp[1024 + j * 64] = (u16)(w1 >> 16); mp[2048 + j * 64] = (u16)(w2 & 0xffffu); mp[3072 + j * 64] = (u16)(w2 >> 16);
              if (j & 1) { bhw[j >> 1] |= w2 << 16; khw[j >> 1] |= w2 & 0xffff0000u; } else { bhw[j >> 1] = w2 & 0xffffu; khw[j >> 1] = w2 >> 16; } }
          *(float*)(rec + 12288 + 4 * lane) = g;
          v4u* bp = (v4u*)(rec + 4096 + lane * 32); bp[0] = (v4u){bhw[0], bhw[1], bhw[2], bhw[3]}; bp[1] = (v4u){bhw[4], bhw[5], bhw[6], bhw[7]};
          v4u* kp = (v4u*)(rec + 6144 + lane * 32); kp[0] = (v4u){khw[0], khw[1], khw[2], khw[3]}; kp[1] = (v4u){khw[4], khw[5], khw[6], khw[7]};
          v4u* vp = (v4u*)(rec + 8192 + lane * 32); vp[0] = (v4u){vtw[0], vtw[1], vtw[2], vtw[3]}; vp[1] = (v4u){vtw[4], vtw[5], vtw[6], vtw[7]}; }
        LDS_WAIT(); asm volatile("" ::: "memory");
#pragma unroll
        for (int i = 0; i < 2; ++i) { const int pi = lane + 64 * i, s = pi >> 3, ks = (pi >> 2) & 1, qq = pi & 3;
#pragma unroll
            for (int mtx = 0; mtx < 2; ++mtx) { const LAS bf16* src = mats + mtx * 1024 + s * 64 + 32 * ks + 4 * qq;
                const u32x2 lo = *(const LAS u32x2*)src, hi = *(const LAS u32x2*)(src + 16);
                *(v4u*)(rec + mtx * 2048 + pi * 16) = (v4u){lo.x, lo.y, hi.x, hi.y}; } }
        LDS_WAIT(); asm volatile("" ::: "memory");
        { f32x4 Ab = {0.f, 0.f, 0.f, 0.f}, Ak = Ab, Mb = Ab, Mk = Ab;
#pragma unroll
          for (int ks = 0; ks < 2; ++ks) { const int off = r16 * 64 + 32 * ks + 8 * q4;
              const bf16x8 aK = as_bf16x8(*(const LAS v4u*)(mats + off)), aR = as_bf16x8(*(const LAS v4u*)(mats + 1024 + off)), bB = as_bf16x8(*(const LAS v4u*)(mats + 2048 + off)), bK = as_bf16x8(*(const LAS v4u*)(mats + 3072 + off));
              Ab = mfma16(aK, bB, Ab); Ak = mfma16(aK, bK, Ak); Mb = mfma16(aR, bB, Mb); Mk = mfma16(aR, bK, Mk); }
          bf16* rAk = (bf16*)(rec + 10240); bf16* rMb = (bf16*)(rec + 11264); bf16* rMk = (bf16*)(rec + 11776);
#pragma unroll
          for (int r = 0; r < 4; ++r) { const int s = 4 * q4 + r, j = r16; const bool lo = j < s, le = j <= s;
              abl[s * 17 + j] = lo ? Ab[r] : 0.f; rAk[s * 16 + j] = f2b(lo ? Ak[r] : 0.f); rMb[s * 16 + j] = f2b(le ? Mb[r] : 0.f); rMk[s * 16 + j] = f2b(le ? Mk[r] : 0.f); } }
        LDS_WAIT(); asm volatile("" ::: "memory");
        { float Tr[16]; bf16* rT = (bf16*)(rec + 10752);
#pragma unroll
          for (int s = 0; s < 16; ++s) { float t = (r16 == s) ? 1.f : 0.f;
#pragma unroll
              for (int j = 0; j < s; ++j) t -= abl[s * 17 + j] * Tr[j];
              Tr[s] = t; if (lane < 16) rT[s * 16 + r16] = f2b(-t); __builtin_amdgcn_sched_barrier(0); } }
        __syncthreads();
    }
}
__device__ __forceinline__ void nsa_prep_tile(const Frame& F, int u) {
    const int lane = F.lane, w = F.wave;
    const int R0 = 64 * u, t0 = R0 & (T - 1), b = R0 / T;
    bf16* PNSA = (bf16*)((unsigned char*)F.out + DO_PNSA);
    const float qg = F.in[14][lane] * (0.125f * LOG2E);
    const float kg = (w < 2) ? F.in[16][lane] : F.in[17][lane];
    const int kcol = ((w < 2) ? 768 : 1024) + (w & 1) * 64 + lane;
    for (int tok = 0; tok < 64; ++tok) { bf16* p = PNSA + (size_t)(R0 + tok) * 1280;
        const float q = bf2f(p[w * 64 + lane]); const float ss = wave_sum(q * q) * (1.f / 64.f);
        float k = 0.f; if (w < 4) k = bf2f(p[kcol]);
        const float ks = wave_sum(k * k) * (1.f / 64.f);
        p[w * 64 + lane] = f2b(q * rsqrtf(ss + NORM_EPS) * qg);
        if (w < 4) p[kcol] = f2b(k * rsqrtf(ks + NORM_EPS) * kg); }
    if (w >= 4) {
        const int g = w & 1; const int scol = ((w < 6) ? 896 : 1152) + g * 64;
        bf16* VT = (bf16*)(F.ws + ((w < 6) ? WS_VST : WS_VWT)) + (size_t)((b * 2 + g) * 64) * T + (size_t)((t0 + lane) >> 5) * 2048 + ((t0 + lane) & 31);
        const v4u* src = (const v4u*)(PNSA + (size_t)(R0 + lane) * 1280 + scol);
        v4u v[8];
#pragma unroll
        for (int i = 0; i < 8; ++i) v[i] = src[i];
#pragma unroll
        for (int i = 0; i < 8; ++i) {
            VT[(8 * i + 0) * 32] = (u16)(v[i].x & 0xffffu); VT[(8 * i + 1) * 32] = (u16)(v[i].x >> 16);
            VT[(8 * i + 2) * 32] = (u16)(v[i].y & 0xffffu); VT[(8 * i + 3) * 32] = (u16)(v[i].y >> 16);
            VT[(8 * i + 4) * 32] = (u16)(v[i].z & 0xffffu); VT[(8 * i + 5) * 32] = (u16)(v[i].z >> 16);
            VT[(8 * i + 6) * 32] = (u16)(v[i].w & 0xffffu); VT[(8 * i + 7) * 32] = (u16)(v[i].w >> 16); }
    }
}
__device__ __forceinline__ float gelu_tanh(float x) { const float t = 0.7978845608028654f * (x + 0.044715f * x * x * x); return 0.5f * x * (1.f + tanhf(t)); }
__device__ __forceinline__ void compress_unit(const Frame& F, int u) {
    const int lane = F.lane, w = F.wave, r16 = lane & 15, q4 = lane >> 4;
    const int kvsel = u >> 7, b = (u >> 5) & 3, g = (u >> 4) & 1, ntile = u & 15;
    const bf16* X = (const bf16*)((unsigned char*)F.out + DO_PNSA) + (size_t)(b * T) * 1280 + (kvsel ? 640 : 512) + g * 64;
    const float* pos = kvsel ? F.in[19] : F.in[18];
    const bf16* W1t = (const bf16*)(F.ws + (kvsel ? WS_CW1V : WS_CW1K));
    const bf16* W2t = (const bf16*)(F.ws + (kvsel ? WS_CW2V : WS_CW2K));
    LAS bf16* hid = (LAS bf16*)(F.lds);
    LAS float* outb = (LAS float*)(F.lds + 16 * 528);
    int n = 16 * ntile + r16; if (n > 254) n = 254;
    f32x4 acc[2] = {{0.f, 0.f, 0.f, 0.f}, {0.f, 0.f, 0.f, 0.f}};
#pragma unroll 4
    for (int s = 0; s < 64; ++s) { const int lp = s >> 1, d0 = (s & 1) * 32 + 8 * q4;
        const v4u xa = *(const v4u*)(X + (size_t)(16 * n + lp) * 1280 + d0);
        const f32x4 p0 = *(const f32x4*)(pos + lp * 64 + d0), p1 = *(const f32x4*)(pos + lp * 64 + d0 + 4);
        v4u af; af.x = pk2(bflo(xa.x) + p0[0], bfhi(xa.x) + p0[1]); af.y = pk2(bflo(xa.y) + p0[2], bfhi(xa.y) + p0[3]);
        af.z = pk2(bflo(xa.z) + p1[0], bfhi(xa.z) + p1[1]); af.w = pk2(bflo(xa.w) + p1[2], bfhi(xa.w) + p1[3]);
#pragma unroll
        for (int nt = 0; nt < 2; ++nt) { const v4u bfg = *(const v4u*)(W1t + (size_t)(32 * w + 16 * nt + r16) * 2048 + 32 * s + 8 * q4);
            acc[nt] = mfma16(as_bf16x8(af), as_bf16x8(bfg), acc[nt]); } }
#pragma unroll
    for (int nt = 0; nt < 2; ++nt)
#pragma unroll
        for (int r = 0; r < 4; ++r) hid[(4 * q4 + r) * 264 + 32 * w + 16 * nt + r16] = f2b(gelu_tanh(acc[nt][r]));
    __syncthreads();
    if (w < 4) { f32x4 a2 = {0.f, 0.f, 0.f, 0.f};
#pragma unroll
        for (int s = 0; s < 8; ++s) { const v4u af = *(const LAS v4u*)(hid + r16 * 264 + 32 * s + 8 * q4);
            const v4u bfg = *(const v4u*)(W2t + (size_t)(16 * w + r16) * 256 + 32 * s + 8 * q4);
            a2 = mfma16(as_bf16x8(af), as_bf16x8(bfg), a2); }
#pragma unroll
        for (int r = 0; r < 4; ++r) outb[(4 * q4 + r) * 64 + 16 * w + r16] = a2[r]; }
    __syncthreads();
#pragma unroll
    for (int rr = 0; rr < 2; ++rr) { const int row = 2 * w + rr; const int nn = 16 * ntile + row; float val = outb[row * 64 + lane];
        if (kvsel == 0) { const float ss = wave_sum(val * val) * (1.f / 64.f); val = val * rsqrtf(ss + NORM_EPS) * F.in[15][lane];
            ((bf16*)(F.ws + WS_KC))[(size_t)((b * 2 + g) * 256 + nn) * 64 + lane] = (nn < 255) ? f2b(val) : (u16)0; }
        else ((bf16*)(F.ws + WS_VCT))[(size_t)((b * 2 + g) * 64 + lane) * 256 + nn] = (nn < 255) ? f2b(val) : (u16)0; }
    __syncthreads();
}
struct KFr { bf16x8 a0, a1, b0, b1; };
__device__ __forceinline__ KFr load_k(const bf16* Kb, int rstride, int k0, int r16, int q4) {
    const int keyA = k0 + 8 * (r16 >> 2) + (r16 & 3);
    const bf16* pa = Kb + (size_t)keyA * rstride + 8 * q4; const bf16* pb = pa + (size_t)4 * rstride;
    KFr f; f.a0 = as_bf16x8(*(const v4u*)pa); f.a1 = as_bf16x8(*(const v4u*)(pa + 32)); f.b0 = as_bf16x8(*(const v4u*)pb); f.b1 = as_bf16x8(*(const v4u*)(pb + 32)); return f;
}
struct VFr { bf16x8 v[4]; };
__device__ __forceinline__ VFr load_v(const bf16* Vt, int dstride, int k0, int r16, int q4) {
    VFr f;
#pragma unroll
    for (int dt = 0; dt < 4; ++dt) f.v[dt] = as_bf16x8(*(const v4u*)(Vt + (size_t)(16 * dt + r16) * dstride + k0 + 8 * q4));
    return f;
}
__device__ __forceinline__ bf16x8 pack_p(const f32x4 a, const f32x4 b) {
    v4u w; w.x = pg8::cvt_pk_bf16(a[0], a[1]); w.y = pg8::cvt_pk_bf16(a[2], a[3]); w.z = pg8::cvt_pk_bf16(b[0], b[1]); w.w = pg8::cvt_pk_bf16(b[2], b[3]); return as_bf16x8(w);
}
#define NSA_FENCE() asm volatile("s_waitcnt lgkmcnt(0)" ::: "memory")
__device__ __forceinline__ void nsa_wave_unit(const Frame& F, int b, int g, int t0, LAS float* wl) {
    const int lane = F.lane, r16 = lane & 15, q4 = lane >> 4;
    const f32x4 Z4 = {0.f, 0.f, 0.f, 0.f};
    const bf16* PN = (const bf16*)((unsigned char*)F.out + DO_PNSA) + (size_t)(b * T) * 1280;
    const float* GL = (const float*)((unsigned char*)F.out + DO_GLOG) + (size_t)(b * T) * 32;
    LAS float* impT = wl; LAS float* imp2T = wl + 8 * 65; LAS unsigned* selT = (LAS unsigned*)(wl + 16 * 65); LAS int* stl = (LAS int*)(wl + 16 * 65 + 16);
    bf16x8 qf[2][2]; int tq[2];
#pragma unroll
    for (int mt = 0; mt < 2; ++mt) { tq[mt] = t0 + 4 * mt + (r16 >> 2);
#pragma unroll
        for (int dh = 0; dh < 2; ++dh) qf[mt][dh] = as_bf16x8(*(const v4u*)(PN + (size_t)tq[mt] * 1280 + (g * 4 + (r16 & 3)) * 64 + 32 * dh + 8 * q4)); }
    f32x4 Oc[2][4];
#pragma unroll
    for (int mt = 0; mt < 2; ++mt)
#pragma unroll
        for (int dt = 0; dt < 4; ++dt) Oc[mt][dt] = Z4;
#define NSA_GATE(mt_, r_, br_) sigmf(GL[(size_t)(t0 + 4 * (mt_) + q4) * 32 + g * 12 + (r_) * 3 + (br_)])

    const bf16* KC = (const bf16*)(F.ws + WS_KC) + (size_t)((b * 2 + g) * 256) * 64;
    const bf16* VCT = (const bf16*)(F.ws + WS_VCT) + (size_t)((b * 2 + g) * 64) * 256;
    for (int i = lane; i < 16 * 65; i += 64) wl[i] = 0.f;
    const int ncmp = (t0 + 7 >= 31) ? ((t0 + 7 - 31) >> 4) + 1 : 0;
    const int nst = (ncmp + 31) >> 5;
    float inv[2] = {0.f, 0.f};
    if (nst > 0) {   float ls[2] = {0.f, 0.f};
        KFr kf = load_k(KC, 64, 0, r16, q4);
        for (int st = 0; st < nst; ++st) { const int k0 = 32 * st; const int k1 = (st + 1 < nst) ? k0 + 32 : k0; const KFr kn = load_k(KC, 64, k1, r16, q4); const bool cslow = 16 * (k0 + 31) + 31 > t0;
#pragma unroll
            for (int mt = 0; mt < 2; ++mt) { f32x4 sA = mfma16(kf.a0, qf[mt][0], Z4); sA = mfma16(kf.a1, qf[mt][1], sA); f32x4 sB = mfma16(kf.b0, qf[mt][0], Z4); sB = mfma16(kf.b1, qf[mt][1], sB);
#pragma unroll
                for (int r = 0; r < 4; ++r) { const int nA = k0 + 8 * q4 + r, nB = nA + 4;
                    if (cslow) { ls[mt] += (16 * nA + 31 <= tq[mt]) ? __builtin_amdgcn_exp2f(sA[r]) : 0.f; ls[mt] += (16 * nB + 31 <= tq[mt]) ? __builtin_amdgcn_exp2f(sB[r]) : 0.f; }
                    else { ls[mt] += __builtin_amdgcn_exp2f(sA[r]); ls[mt] += __builtin_amdgcn_exp2f(sB[r]); } } }
            kf = kn; }
#pragma unroll
        for (int mt = 0; mt < 2; ++mt) { float l = ls[mt]; l += __shfl_xor(l, 16); l += __shfl_xor(l, 32); inv[mt] = 1.0f / fmaxf(l, 1e-30f); }
    }
    if (nst > 0) {   f32x4 O[2][4];
#pragma unroll
        for (int mt = 0; mt < 2; ++mt)
#pragma unroll
            for (int dt = 0; dt < 4; ++dt) O[mt][dt] = Z4;
        KFr kf = load_k(KC, 64, 0, r16, q4); VFr vf = load_v(VCT, 256, 0, r16, q4);
        for (int st = 0; st < nst; ++st) { const int k0 = 32 * st; const int k1 = (st + 1 < nst) ? k0 + 32 : k0; const KFr kn = load_k(KC, 64, k1, r16, q4); const VFr vn = load_v(VCT, 256, k1, r16, q4); const bool cslow = 16 * (k0 + 31) + 31 > t0;
#pragma unroll
            for (int mt = 0; mt < 2; ++mt) { f32x4 sA = mfma16(kf.a0, qf[mt][0], Z4); sA = mfma16(kf.a1, qf[mt][1], sA); f32x4 sB = mfma16(kf.b0, qf[mt][0], Z4); sB = mfma16(kf.b1, qf[mt][1], sB);
                f32x4 pA, pB;
#pragma unroll
                for (int r = 0; r < 4; ++r) { const int nA = k0 + 8 * q4 + r, nB = nA + 4;
                    if (cslow) { pA[r] = (16 * nA + 31 <= tq[mt]) ? __builtin_amdgcn_exp2f(sA[r]) * inv[mt] : 0.f; pB[r] = (16 * nB + 31 <= tq[mt]) ? __builtin_amdgcn_exp2f(sB[r]) * inv[mt] : 0.f; }
                    else { pA[r] = __builtin_amdgcn_exp2f(sA[r]) * inv[mt]; pB[r] = __builtin_amdgcn_exp2f(sB[r]) * inv[mt]; } }
                float vA = pA[0] + pA[1] + pA[2] + 0.5f * pA[3], cA = 0.5f * pA[3], vB = pB[0] + pB[1] + pB[2] + 0.5f * pB[3], cB = 0.5f * pB[3];
                vA += __shfl_xor(vA, 1); vA += __shfl_xor(vA, 2); cA += __shfl_xor(cA, 1); cA += __shfl_xor(cA, 2);
                vB += __shfl_xor(vB, 1); vB += __shfl_xor(vB, 2); cB += __shfl_xor(cB, 1); cB += __shfl_xor(cB, 2);
                if ((lane & 3) == 0) { const int tl = 4 * mt + (r16 >> 2), j = (k0 >> 2) + 2 * q4;
                    impT[tl * 65 + j] = vA; imp2T[tl * 65 + j + 1] = cA; impT[tl * 65 + j + 1] = vB; imp2T[tl * 65 + j + 2] = cB; }
                const bf16x8 pf = pack_p(pA, pB);
#pragma unroll
                for (int dt = 0; dt < 4; ++dt) O[mt][dt] = mfma16(pf, vf.v[dt], O[mt][dt]); }
            kf = kn; vf = vn; }
#pragma unroll
        for (int mt = 0; mt < 2; ++mt)
#pragma unroll
            for (int dt = 0; dt < 4; ++dt)
#pragma unroll
                for (int r = 0; r < 4; ++r) Oc[mt][dt][r] += NSA_GATE(mt, r, 0) * O[mt][dt][r];
    }
    NSA_FENCE();
    const int cur = t0 >> 6;
    unsigned long long uni = 0ull;
    for (int tl = 0; tl < 8; ++tl) {
        unsigned long long mask;
        if (cur < 16) mask = (2ull << cur) - 1ull;
        else {
            const float sc = impT[tl * 65 + lane] + imp2T[tl * 65 + lane];
            const unsigned key = __float_as_uint(fmaxf(sc, 0.f));
            const bool elig = (lane <= cur) && (lane != 0) && (lane != cur) && (lane != cur - 1);
            unsigned prefix = 0u;
            for (int bit = 30; bit >= 0; --bit) { const unsigned cand = prefix | (1u << bit);
                const int cnt = __popcll(__ballot(elig && key >= cand)); if (cnt >= 13) prefix = cand; }
            const unsigned long long gt = __ballot(elig && key > prefix); unsigned long long ties = __ballot(elig && key == prefix);
            int need = 13 - __popcll(gt); unsigned long long keep = 0ull;
            while (need > 0 && ties) { const unsigned long long low = ties & (0ull - ties); keep |= low; ties ^= low; --need; }
            mask = gt | keep | 1ull | (1ull << cur) | (1ull << (cur - 1));
        }
        uni |= mask;
        if (lane == 0) { selT[2 * tl] = (unsigned)mask; selT[2 * tl + 1] = (unsigned)(mask >> 32); }
    }
    NSA_FENCE();
    unsigned long long mk[2];
#pragma unroll
    for (int mt = 0; mt < 2; ++mt) { const int tl = 4 * mt + (r16 >> 2); mk[mt] = (unsigned long long)selT[2 * tl] | ((unsigned long long)selT[2 * tl + 1] << 32); }
    NSA_FENCE();

#pragma unroll 1
    for (int br = 1; br < 3; ++br) {
        const bf16* Kb = PN + (br == 1 ? 768 : 1024) + g * 64;
        const bf16* Vt = (const bf16*)(F.ws + (br == 1 ? WS_VST : WS_VWT)) + (size_t)((b * 2 + g) * 64) * T;
        f32x4 O[2][4]; float ls[2] = {0.f, 0.f};
#pragma unroll
        for (int mt = 0; mt < 2; ++mt)
#pragma unroll
            for (int dt = 0; dt < 4; ++dt) O[mt][dt] = Z4;
        int nsteps;
        if (br == 1) { nsteps = 2 * __popcll(uni);
            if ((uni >> lane) & 1ull) { const int rk = __popcll(uni & ((1ull << lane) - 1ull)); stl[2 * rk] = 64 * lane; stl[2 * rk + 1] = 64 * lane + 32; } }
        else { const int lo = t0 - 511; const int klo = (lo > 0 ? lo : 0) & ~31; nsteps = ((t0 + 8 - klo) + 31) >> 5; if (lane < nsteps) stl[lane] = klo + 32 * lane; }
        NSA_FENCE();
        KFr kf = load_k(Kb, 1280, __builtin_amdgcn_readfirstlane(stl[0]), r16, q4);
        for (int i = 0; i < nsteps; ++i) {
            const int k0 = __builtin_amdgcn_readfirstlane(stl[i]); const int k1 = __builtin_amdgcn_readfirstlane(stl[(i + 1 < nsteps) ? i + 1 : i]); const int j = k0 >> 6;
            const bool slow = (br == 1) ? (j == cur) : (k0 < t0 - 504 || k0 + 31 > t0);
            const VFr vf = load_v(Vt + (size_t)(k0 >> 5) * 2048, 32, 0, r16, q4); const KFr kn = load_k(Kb, 1280, k1, r16, q4);
#pragma unroll
            for (int mt = 0; mt < 2; ++mt) { f32x4 ci = Z4;
                if (br == 1) { const float bias = (((mk[mt] >> j) & 1ull) != 0ull) ? 0.f : -1e30f; ci = (f32x4){bias, bias, bias, bias}; }
                f32x4 sA = mfma16(kf.a0, qf[mt][0], ci); sA = mfma16(kf.a1, qf[mt][1], sA); f32x4 sB = mfma16(kf.b0, qf[mt][0], ci); sB = mfma16(kf.b1, qf[mt][1], sB);
                f32x4 pA, pB;
                if (slow) {
#pragma unroll
                    for (int r = 0; r < 4; ++r) { const int kA = k0 + 8 * q4 + r, kB = kA + 4;
                        const bool mA = (kA <= tq[mt]) && (br == 1 || kA + 512 > tq[mt]), mB = (kB <= tq[mt]) && (br == 1 || kB + 512 > tq[mt]);
                        pA[r] = mA ? __builtin_amdgcn_exp2f(sA[r]) : 0.f; pB[r] = mB ? __builtin_amdgcn_exp2f(sB[r]) : 0.f; }
                } else {
#pragma unroll
                    for (int r = 0; r < 4; ++r) { pA[r] = __builtin_amdgcn_exp2f(sA[r]); pB[r] = __builtin_amdgcn_exp2f(sB[r]); }
                }
                ls[mt] += (pA[0] + pA[1]) + (pA[2] + pA[3]) + (pB[0] + pB[1]) + (pB[2] + pB[3]);
                const bf16x8 pf = pack_p(pA, pB);
#pragma unroll
                for (int dt = 0; dt < 4; ++dt) O[mt][dt] = mfma16(pf, vf.v[dt], O[mt][dt]); }
            kf = kn;
        }
        NSA_FENCE();
#pragma unroll
        for (int mt = 0; mt < 2; ++mt) { float l = ls[mt]; l += __shfl_xor(l, 16); l += __shfl_xor(l, 32); const float il = 1.0f / fmaxf(l, 1e-30f);
#pragma unroll
            for (int r = 0; r < 4; ++r) { const float ilr = __shfl(il, 4 * q4 + r) * NSA_GATE(mt, r, br);
#pragma unroll
                for (int dt = 0; dt < 4; ++dt) Oc[mt][dt][r] += ilr * O[mt][dt][r]; } }
    }
    bf16* YB = (bf16*)(F.ws + WS_H + 16 * MiB) + (size_t)(b * T) * 512;
#pragma unroll
    for (int mt = 0; mt < 2; ++mt)
#pragma unroll
        for (int r = 0; r < 4; ++r)
#pragma unroll
            for (int dt = 0; dt < 4; ++dt) YB[(size_t)(t0 + 4 * mt + q4) * 512 + (g * 4 + r) * 64 + 16 * dt + r16] = f2b(Oc[mt][dt][r]);
}
__device__ __forceinline__ void nsa_phase(const Frame& F, int rep) {
    LAS float* wl = (LAS float*)(F.lds + F.wave * 5120);
    const int q0 = (int)(xb_xcc_id() & 7u);
    for (int qi = 0; qi < 8; ++qi) { const int q = (q0 + qi) & 7;
        for (;;) {
            unsigned c = 0;
            if (F.lane == 0) c = __hip_atomic_fetch_add(F.ctl + CW_NSAQ + 64 * (8 * rep + q), 1u, RLX_AGENT);
            c = (unsigned)__builtin_amdgcn_readfirstlane((int)c);
            if (c >= 512u) break;
            nsa_wave_unit(F, q >> 1, q & 1, 8 * (511 - (int)c), wl);
        }
    }
}
typedef short bf16x4 __attribute__((ext_vector_type(4)));
__device__ __forceinline__ f32x4 mfma16k16(const bf16x4 a, const bf16x4 b, const f32x4 c) { const bf16x8 a8 = {a[0], a[1], a[2], a[3], 0, 0, 0, 0}, b8 = {b[0], b[1], b[2], b[3], 0, 0, 0, 0}; return __builtin_amdgcn_mfma_f32_16x16x32_bf16(a8, b8, c, 0, 0, 0); }
__device__ __forceinline__ bf16x4 as_bf16x4(const u32x2 v) { return __builtin_bit_cast(bf16x4, v); }
__device__ __forceinline__ bf16x4 pack4(const f32x4 a) { u32x2 w; w.x = pg8::cvt_pk_bf16(a[0], a[1]); w.y = pg8::cvt_pk_bf16(a[2], a[3]); return as_bf16x4(w); }
__device__ __forceinline__ f32x4 unpk4(const u32x2 w) { f32x4 r; r[0] = bflo(w.x); r[1] = bfhi(w.x); r[2] = bflo(w.y); r[3] = bfhi(w.y); return r; }
struct ChunkIn { v4u kt0, kt1, rt0, rt1; u32x2 ak, nt, mb, mk, vt, bh[4], kh[4]; f32x4 gam[4]; };
__device__ __forceinline__ void scan_load(ChunkIn& c, const unsigned char* rec, int vq, int r16, int q4) {
    c.kt0 = *(const v4u*)(rec + (r16 * 64 + q4 * 8) * 2); c.kt1 = *(const v4u*)(rec + (r16 * 64 + 32 + q4 * 8) * 2);
    c.rt0 = *(const v4u*)(rec + 2048 + (r16 * 64 + q4 * 8) * 2); c.rt1 = *(const v4u*)(rec + 2048 + (r16 * 64 + 32 + q4 * 8) * 2);
#pragma unroll
    for (int mt = 0; mt < 4; ++mt) { c.bh[mt] = *(const u32x2*)(rec + 4096 + ((16 * mt + r16) * 16 + 4 * q4) * 2); c.kh[mt] = *(const u32x2*)(rec + 6144 + ((16 * mt + r16) * 16 + 4 * q4) * 2);
        c.gam[mt] = *(const f32x4*)(rec + 12288 + (16 * mt + 4 * q4) * 4); }
    c.vt = *(const u32x2*)(rec + 8192 + ((16 * vq + r16) * 16 + 4 * q4) * 2);
    c.ak = *(const u32x2*)(rec + 10240 + (r16 * 16 + 4 * q4) * 2); c.nt = *(const u32x2*)(rec + 10752 + (r16 * 16 + 4 * q4) * 2);
    c.mb = *(const u32x2*)(rec + 11264 + (r16 * 16 + 4 * q4) * 2); c.mk = *(const u32x2*)(rec + 11776 + (r16 * 16 + 4 * q4) * 2);
}
__device__ __forceinline__ void scan_chunk(const ChunkIn& cur, f32x4 (&Zt)[4], bf16* Y, int ch, int q4) {
    const f32x4 Z4 = {0.f, 0.f, 0.f, 0.f};
    const bf16x8 zb0 = pack_p(Zt[0], Zt[1]), zb1 = pack_p(Zt[2], Zt[3]);
    f32x4 X = mfma16(as_bf16x8(cur.kt0), zb0, Z4); X = mfma16(as_bf16x8(cur.kt1), zb1, X);
    f32x4 Yc = mfma16(as_bf16x8(cur.rt0), zb0, Z4); Yc = mfma16(as_bf16x8(cur.rt1), zb1, Yc);
    const bf16x4 vt = as_bf16x4(cur.vt);
    const f32x4 W = mfma16k16(as_bf16x4(cur.ak), vt, X);
    const f32x4 U = mfma16k16(as_bf16x4(cur.nt), pack4(W), Z4);
    const bf16x4 ub = pack4(U);
    Yc = mfma16k16(as_bf16x4(cur.mk), vt, Yc); Yc = mfma16k16(as_bf16x4(cur.mb), ub, Yc);
#pragma unroll
    for (int mt = 0; mt < 4; ++mt) { f32x4 acc = mfma16k16(as_bf16x4(cur.kh[mt]), vt, Zt[mt]); acc = mfma16k16(as_bf16x4(cur.bh[mt]), ub, acc); Zt[mt] = acc * cur.gam[mt]; }
#pragma unroll
    for (int r = 0; r < 4; ++r) Y[(size_t)(16 * ch + 4 * q4 + r) * 512] = f2b(Yc[r]);
}
__device__ __forceinline__ void rwkv_scan_wave(const Frame& F, int bh, int vq) {
    const int lane = F.lane, r16 = lane & 15, q4 = lane >> 4, b = bh >> 3, h = bh & 7;
    const f32x4 Z4 = {0.f, 0.f, 0.f, 0.f};
    const unsigned char* recb = F.ws + WS_PRW + (size_t)(b * T) * 7168 + h * REC_BYTES;
    bf16* Y = (bf16*)(F.ws + WS_H) + (size_t)(b * T) * 512 + h * 64 + 16 * vq + r16;
    f32x4 Zt[4] = {Z4, Z4, Z4, Z4};
    ChunkIn A, B;
    constexpr size_t CS = 16 * 7168;
    scan_load(A, recb, vq, r16, q4);
    for (int ch = 0; ch < T / 16; ch += 2) {
        if (vq == 0 && lane == 0) __hip_atomic_store(F.ctl + CW_SCANP + 64 * bh, (unsigned)ch, RLX_AGENT);
        scan_load(B, recb + (size_t)(ch + 1) * CS, vq, r16, q4);
        scan_chunk(A, Zt, Y, ch, q4);
        scan_load(A, recb + (size_t)((ch + 2 < T / 16) ? ch + 2 : ch) * CS, vq, r16, q4);
        scan_chunk(B, Zt, Y, ch + 1, q4);
    }
}
__device__ __forceinline__ void rwkv_scan_prefetch(const Frame& F, int bh) {
    const int lane = F.lane, b = bh >> 3, h = bh & 7;
    const unsigned char* recb = F.ws + WS_PRW + (size_t)(b * T) * 7168 + h * REC_BYTES;
    const int o0 = 128 * lane, o1 = 128 * (lane < 35 ? 64 + lane : 98);
    unsigned dmy = 0u, pa[4] = {0u, 0u, 0u, 0u}, pb[4] = {0u, 0u, 0u, 0u};
    for (int c4 = 0; c4 < T / 16; c4 += 4) {
#pragma unroll
        for (int k = 0; k < 4; ++k) { const int ch = c4 + k;
            for (int spin = 0; spin < (1 << 16); ++spin) { const int prog = (int)__hip_atomic_load(F.ctl + CW_SCANP + 64 * bh, RLX_AGENT); if (ch <= prog + 8) break; __builtin_amdgcn_s_sleep(8); }
            const unsigned char* rec = recb + (size_t)ch * (16 * 7168);
            dmy ^= pa[k] ^ pb[k];
            pa[k] = *(const volatile unsigned*)(rec + o0); pb[k] = *(const volatile unsigned*)(rec + o1); }
    }
    dmy ^= pa[0] ^ pb[0] ^ pa[1] ^ pb[1] ^ pa[2] ^ pb[2] ^ pa[3] ^ pb[3];
    if (lane == 0) F.MISC[17] = dmy;
}
__device__ __forceinline__ void rwkv_epilogue(const Frame& F) {
    const int lane = F.lane; const int gw = F.vcu * NWAVES + F.wave, NGW = F.G * NWAVES;
    const unsigned char* prw = F.ws + WS_PRW; const bf16* G = (const bf16*)((unsigned char*)F.out + DO_G); bf16* YA = (bf16*)(F.ws + WS_H);
    for (int idx = gw; idx < (M / 16) * 8; idx += NGW) { const int bt = idx >> 3, h = idx & 7, c = h * 64 + lane;
        const unsigned char* rec = prw + (size_t)(16 * bt) * 7168 + h * REC_BYTES;
        const v4u* vp = (const v4u*)(rec + 8192 + lane * 32); const v4u v0 = vp[0], v1 = vp[1];
        const float lw = F.in[12][c], lb = F.in[13][c];
        float yv[16], gv[16], bo[16];
#pragma unroll
        for (int s = 0; s < 16; ++s) { const size_t o = (size_t)(16 * bt + s) * 512 + c; yv[s] = bf2f(YA[o]); gv[s] = bf2f(G[o]); bo[s] = *(const float*)(rec + 12544 + 4 * s); }
#pragma unroll
        for (int s = 0; s < 16; ++s) { const unsigned vw = (s < 8) ? v0[s >> 1] : v1[(s - 8) >> 1]; const float vv = (s & 1) ? bfhi(vw) : bflo(vw);
            const float y = yv[s]; const float mean = wave_sum(y) * (1.f / 64.f); const float d = y - mean; const float var = wave_sum(d * d) * (1.f / 64.f);
            const float yn = d * rsqrtf(var + GN_EPS) * lw + lb;
            YA[(size_t)(16 * bt + s) * 512 + c] = f2b((yn + bo[s] * vv) * gv[s]); }
    }
}
__device__ __forceinline__ unsigned sortable(float x) { const unsigned u = __float_as_uint(x); return (u & 0x80000000u) ? ~u : (u | 0x80000000u); }
__device__ __forceinline__ float unsortable(unsigned k) { const unsigned u = (k & 0x80000000u) ? (k & 0x7fffffffu) : ~k; return __uint_as_float(u); }
#define TK_INSERT(L, key_) do { unsigned k_ = (key_); _Pragma("unroll") for (int s_ = 0; s_ < 16; ++s_) { const unsigned hi_ = L[s_] > k_ ? L[s_] : k_; k_ = L[s_] > k_ ? k_ : L[s_]; L[s_] = hi_; } } while (0)
__device__ __forceinline__ void peer_topk_pass(const Frame& F, int wp, LAS float* sc) {
    const int lane = F.lane, r16 = lane & 15, q4 = lane >> 4;
    const bf16* QRY = (const bf16*)(F.ws + WS_PRW);
    int* EID = (int*)(F.ws + WS_PRW + 64 * MiB); float* EG = (float*)(F.ws + WS_PRW + 72 * MiB);
    const int row = lane & 31, part = lane >> 5;
    unsigned L1[16], L2[16];
#pragma unroll
    for (int half = 0; half < 2; ++half) {
        const bf16* SK = (const bf16*)(F.ws + (half ? WS_SK2 : WS_SK1));
#pragma unroll
        for (int mt = 0; mt < 2; ++mt) { const int rho = 32 * wp + 16 * mt + r16;
            const bf16* qp = QRY + (size_t)(rho >> 3) * 2048 + (rho & 7) * 256 + half * 128 + 8 * q4;
            bf16x8 af[4];
#pragma unroll
            for (int s = 0; s < 4; ++s) af[s] = as_bf16x8(*(const v4u*)(qp + 32 * s));
#pragma unroll
            for (int kt = 0; kt < 8; ++kt) { f32x4 acc = {0.f, 0.f, 0.f, 0.f};
#pragma unroll
                for (int s = 0; s < 4; ++s) acc = mfma16(af[s], as_bf16x8(*(const v4u*)(SK + (size_t)(16 * kt + r16) * 128 + 32 * s + 8 * q4)), acc);
#pragma unroll
                for (int r = 0; r < 4; ++r) { const int rw = 16 * mt + 4 * q4 + r; sc[rw * 128 + ((16 * kt + r16) ^ rw)] = acc[r]; } } }
        NSA_FENCE();
        unsigned Ls[16];
#pragma unroll
        for (int s = 0; s < 16; ++s) Ls[s] = 0u;
#pragma unroll 4
        for (int i = 0; i < 64; ++i) { const int c = 64 * part + i; const float x = sc[row * 128 + (c ^ row)];
            TK_INSERT(Ls, (sortable(x) & ~0x7Fu) | (unsigned)(127 - c)); }
        unsigned Lo[16];
#pragma unroll
        for (int s = 0; s < 16; ++s) Lo[s] = (unsigned)__shfl_xor((int)Ls[s], 32);
#pragma unroll
        for (int s = 0; s < 16; ++s) TK_INSERT(Ls, Lo[s]);
#pragma unroll
        for (int s = 0; s < 16; ++s) { if (half == 0) L1[s] = Ls[s]; else L2[s] = Ls[s]; }
        NSA_FENCE();
    }
    float v1[16], v2[16];
#pragma unroll
    for (int s = 0; s < 16; ++s) { v1[s] = unsortable(L1[s]); v2[s] = unsortable(L2[s]); }
    unsigned C[16];
#pragma unroll
    for (int s = 0; s < 16; ++s) C[s] = 0u;
#pragma unroll
    for (int i = 0; i < 16; ++i)
#pragma unroll
        for (int j = 0; j < 16; ++j) if ((i + 1) * (j + 1) <= 16) { TK_INSERT(C, (sortable(v1[i] + v2[j]) & ~0xFFu) | (unsigned)(255 - (16 * i + j))); }
    LAS unsigned* il = (LAS unsigned*)sc;
    if (part == 0) {
#pragma unroll
        for (int s = 0; s < 16; ++s) { il[row * 33 + s] = 127u - (L1[s] & 127u); il[row * 33 + 16 + s] = 127u - (L2[s] & 127u); }
    }
    NSA_FENCE();
    if (part == 0) { const int rho = 32 * wp + row;
        float val[16], e[16]; float sum = 0.f;
#pragma unroll
        for (int s = 0; s < 16; ++s) val[s] = unsortable(C[s]);
#pragma unroll
        for (int s = 0; s < 16; ++s) { e[s] = __expf(val[s] - val[0]); sum += e[s]; }
        const float is = 1.0f / sum;
#pragma unroll
        for (int s = 0; s < 16; ++s) { const unsigned pos = 255u - (C[s] & 255u); const unsigned i = pos >> 4, j = pos & 15u;
            EID[(size_t)rho * 16 + s] = (int)(il[row * 33 + i] * 128u + il[row * 33 + 16 + j]); EG[(size_t)rho * 16 + s] = e[s] * is; }
    }
    NSA_FENCE();
}
typedef float f32x2_t __attribute__((ext_vector_type(2)));
constexpr float PEER_SCALE = 256.0f, PEER_ISCALE = 1.0f / 256.0f;
__device__ __forceinline__ void peer_convert_one(const Frame& F, const float* srcf, unsigned char* dstb) {
    const int gt = F.vcu * (NWAVES * 64) + F.tid, NT = F.G * NWAVES * 64;
    const f32x4* src = (const f32x4*)srcf; v4u* dst = (v4u*)dstb;
    for (int i = gt; i < 16384 * 1024 / 16; i += NT) { v4u o;
#pragma unroll
        for (int q = 0; q < 4; ++q) { const f32x4 a = src[4 * i + q] * PEER_SCALE; int w = __builtin_amdgcn_cvt_pk_fp8_f32(a[0], a[1], 0, false); w = __builtin_amdgcn_cvt_pk_fp8_f32(a[2], a[3], w, true); o[q] = (unsigned)w; }
        dst[i] = o; }
}
__device__ __forceinline__ void peer_convert_tables(const Frame& F) { peer_convert_one(F, F.in[31], F.ws + WS_MG); peer_convert_one(F, F.in[32], F.ws + WS_MG + 16 * MiB); }
__device__ __forceinline__ float sum8(float x) { x += dppf<0xB1>(x); x += dppf<0x4E>(x); x += dppf<0x141>(x); return x; }
template <int PHASE> __device__ __forceinline__ void peer_slice_unit(const Frame& F, int s, int tg) {
    const int lane = F.lane, j = lane & 7, gbase = lane & ~7;
    const bf16* H2 = (const bf16*)(F.ws + WS_H);
    const int* EID = (const int*)(F.ws + WS_PRW + 64 * MiB);
    float* PART = (float*)(F.ws + WS_PRW) + (size_t)s * M * 128; const float* CACT = (const float*)(F.ws + WS_PRW + 80 * MiB);
    const unsigned char* TB = F.ws + WS_MG + (PHASE == 0 ? 0 : 16 * MiB) + 128 * s + 16 * j;
#pragma unroll 1
    for (int it = 0; it < 8; ++it) { const int tk = 64 * tg + 8 * it + (lane >> 3);
        int ids[16]; float hv[16], acc[16];
        { const v4u* ip = (const v4u*)(EID + (size_t)tk * 128 + 16 * j);
#pragma unroll
          for (int q = 0; q < 4; ++q) { const v4u w = ip[q]; ids[4 * q] = (int)w.x; ids[4 * q + 1] = (int)w.y; ids[4 * q + 2] = (int)w.z; ids[4 * q + 3] = (int)w.w; } }
        if (PHASE == 0) { const v4u h0 = *(const v4u*)(H2 + (size_t)tk * D + 128 * s + 16 * j), h1 = *(const v4u*)(H2 + (size_t)tk * D + 128 * s + 16 * j + 8);
#pragma unroll
            for (int q = 0; q < 4; ++q) { hv[2 * q] = bflo(h0[q]); hv[2 * q + 1] = bfhi(h0[q]); hv[8 + 2 * q] = bflo(h1[q]); hv[8 + 2 * q + 1] = bfhi(h1[q]); } }
        else { const f32x4* cp = (const f32x4*)(CACT + (size_t)tk * 128 + 16 * j);
#pragma unroll
            for (int q = 0; q < 4; ++q) { const f32x4 c = cp[q]; hv[4 * q] = c[0]; hv[4 * q + 1] = c[1]; hv[4 * q + 2] = c[2]; hv[4 * q + 3] = c[3]; } }
#pragma unroll
        for (int m = 0; m < 16; ++m) acc[m] = 0.f;
#pragma unroll 1
        for (int jj = 0; jj < 8; ++jj) { const int src = (gbase + jj) * 4;
            v4u tv[16];
#pragma unroll
            for (int m = 0; m < 16; ++m) { const int id = __builtin_amdgcn_ds_bpermute(src, ids[m]); tv[m] = *(const v4u*)(TB + (size_t)id * 1024); }
#pragma unroll
            for (int m = 0; m < 16; ++m) {
                float f[16];
#pragma unroll
                for (int q = 0; q < 4; ++q) { const f32x2_t lo = __builtin_amdgcn_cvt_pk_f32_fp8((int)tv[m][q], false), hi = __builtin_amdgcn_cvt_pk_f32_fp8((int)tv[m][q], true); f[4 * q] = lo.x; f[4 * q + 1] = lo.y; f[4 * q + 2] = hi.x; f[4 * q + 3] = hi.y; }
                if (PHASE == 0) { float d0 = 0.f, d1 = 0.f;
#pragma unroll
                    for (int q = 0; q < 8; ++q) { d0 += hv[2 * q] * f[2 * q]; d1 += hv[2 * q + 1] * f[2 * q + 1]; }
                    const float d = sum8(d0 + d1); acc[m] = (j == jj) ? d : acc[m]; }
                else { const float c = __builtin_bit_cast(float, __builtin_amdgcn_ds_bpermute(src, __builtin_bit_cast(int, hv[m])));
#pragma unroll
                    for (int q = 0; q < 16; ++q) acc[q] += c * f[q]; } }
        }
        if (PHASE == 0) { f32x4* pp = (f32x4*)(PART + (size_t)tk * 128 + 16 * j);
#pragma unroll
            for (int q = 0; q < 4; ++q) pp[q] = (f32x4){acc[4 * q], acc[4 * q + 1], acc[4 * q + 2], acc[4 * q + 3]}; }
        else { f32x4* op = (f32x4*)(F.out + (size_t)tk * D + 128 * s + 16 * j);
#pragma unroll
            for (int q = 0; q < 4; ++q) { f32x4 a = op[q]; a[0] += acc[4 * q] * PEER_ISCALE; a[1] += acc[4 * q + 1] * PEER_ISCALE; a[2] += acc[4 * q + 2] * PEER_ISCALE; a[3] += acc[4 * q + 3] * PEER_ISCALE; op[q] = a; } }
    }
}
template <int PHASE> __device__ __forceinline__ void peer_slice_phase(const Frame& F, int rep) {
    const int q0 = (int)(xb_xcc_id() & 7u);
    for (int qi = 0; qi < 8; ++qi) { const int q = (q0 + qi) & 7;
        for (;;) { unsigned c = 0;
            if (F.lane == 0) c = __hip_atomic_fetch_add(F.ctl + CW_PEERQ + 64 * (16 * rep + 8 * PHASE + q), 1u, RLX_AGENT);
            c = (unsigned)__builtin_amdgcn_readfirstlane((int)c);
            if (c >= 256u) break;
            peer_slice_unit<PHASE>(F, q, (int)c); } }
}
__device__ __forceinline__ void peer_act_phase(const Frame& F) {
    const int gt = F.vcu * (NWAVES * 64) + F.tid, NT = F.G * NWAVES * 64;
    const float* PART = (const float*)(F.ws + WS_PRW); const float* EG = (const float*)(F.ws + WS_PRW + 72 * MiB); float* CACT = (float*)(F.ws + WS_PRW + 80 * MiB);
    for (int i = gt; i < M * 128 / 4; i += NT) { f32x4 d = {0.f, 0.f, 0.f, 0.f};
#pragma unroll
        for (int s = 0; s < 8; ++s) d += ((const f32x4*)PART)[(size_t)s * (M * 128 / 4) + i];
        const f32x4 g = ((const f32x4*)EG)[i]; f32x4 c;
#pragma unroll
        for (int e = 0; e < 4; ++e) { const float dt = d[e] * PEER_ISCALE; c[e] = g[e] * 0.5f * dt * (1.f + erff(dt * 0.70710678118654752f)); }
        ((f32x4*)CACT)[i] = c; }
}
struct Args { const float* in[33]; float* out; unsigned char* ws; int ph_lo, ph_hi; };
__global__ void __launch_bounds__(NWAVES * 64, 2) mk_fwd(Args args) {
    extern __shared__ __attribute__((aligned(16))) unsigned char lds[];
    Frame F;
    F.lds = (LAS unsigned char*)lds;
    F.MISC = (volatile LAS unsigned*)(F.lds + MISC_OFF);
    F.tid = threadIdx.x; F.lane = F.tid & 63; F.wave = __builtin_amdgcn_readfirstlane(F.tid >> 6);
    F.G = gridDim.x; { const int bx = blockIdx.x; F.vcu = (F.G % 8 == 0) ? (bx % 8) * (F.G / 8) + bx / 8 : bx; }
    unsigned char* ws = args.ws; F.ws = ws; F.out = args.out;
    F.ctl = (gu32*)(ws + WS_CTL);
#pragma unroll
    for (int i = 0; i < 33; ++i) F.in[i] = args.in[i];
    for (int u = F.tid; u < (LDS_BYTES - LDSCTL_OFF) / 4; u += NWAVES * 64) ((LAS unsigned*)(F.lds + LDSCTL_OFF))[u] = 0u;
    __syncthreads();
    const int lo = args.ph_lo, hi = args.ph_hi & 0xff; const int rep = args.ph_hi >> 8;
    const bool multi = (hi - lo) > 1;
    XcdBarrier bar; bar.bar = (unsigned*)(F.ctl + CW_BAR); bar.x = 0; bar.st = nullptr;
    if (multi) bar = xcd_barrier_post((unsigned*)(F.ctl + CW_BAR), F.MISC + 8);
#define IN(k) (lo <= (k) && (k) < hi)
#define NREP(k) ((((repmask) >> (k)) & 1) + 1)
#define REPBAR() do { if (rep) xcd_barrier(bar); } while (0)
#define SEAM(k) do { if (IN(k) && IN((k) + 1)) xcd_barrier(bar); } while (0)

    if (IN(0)) { { p0_prologue(F); } } SEAM(0);
    if (IN(1)) { {
        pg8::Gemm g{(const pg8::bf16_t*)(ws + WS_H), (const pg8::bf16_t*)(ws + WS_WIN), M, NG1, D}; pg8::StaticOrder S; S.init(M, NG1, F.G, (int)blockIdx.x);
        pg8::EpiG1 E{(float*)(ws + WS_PRW), (float*)(ws + WS_BND), (pg8::bf16_t*)((unsigned char*)F.out + DO_PNSA), (pg8::bf16_t*)(ws + WS_MG), (float*)((unsigned char*)F.out + DO_GLOG)};
        pg8::gemm_phase<pg8::EpiG1, pg8::StaticOrder, true, true>(F.lds + RING_OFF, g, S, E);
    } } SEAM(1);
    if (IN(2)) {
        for (int u = F.vcu; u < 256; u += F.G) nsa_prep_tile(F, u);
        for (int u = F.vcu; u < 256; u += F.G) compress_unit(F, u);
        for (int u = F.vcu; u < 256; u += F.G) rwkv_prep_tile(F, u);
    } SEAM(2);
    if (IN(3)) { {
        if ((int)blockIdx.x < 32 && F.wave < 4 && !(rep && P3REP == 3)) rwkv_scan_wave(F, (int)blockIdx.x, F.wave);
        if ((int)blockIdx.x < 32 && F.wave == 4 && !(rep && P3REP == 3)) rwkv_scan_prefetch(F, (int)blockIdx.x);
        if (!(rep && P3REP == 2)) nsa_phase(F, rep);
    } } SEAM(3);
    if (IN(4)) { { rwkv_epilogue(F); } } SEAM(4);
    if (IN(5)) { {
        { pg8::Gemm g{(const pg8::bf16_t*)(ws + WS_H), (const pg8::bf16_t*)(ws + WS_WA), M, D, 512}; pg8::StaticOrder S; S.init(M, D, F.G, (int)blockIdx.x);
          pg8::EpiGate1 E{(float*)(ws + WS_PRW), (const pg8::bf16_t*)(ws + WS_MG), 0};
          pg8::gemm_phase<pg8::EpiGate1, pg8::StaticOrder, true, true>(F.lds + RING_OFF, g, S, E); }
        VM_WAIT(); __syncthreads();
        { pg8::Gemm g{(const pg8::bf16_t*)(ws + WS_H + 16 * MiB), (const pg8::bf16_t*)(ws + WS_WB), M, D, 512}; pg8::StaticOrder S; S.init(M, D, F.G, (int)blockIdx.x);
          pg8::EpiGate2 E{(const float*)(ws + WS_PRW), (const pg8::bf16_t*)(ws + WS_MG), 1024, (pg8::bf16_t*)(ws + WS_PRW + 64 * MiB)};
          pg8::gemm_phase<pg8::EpiGate2, pg8::StaticOrder, true, true>(F.lds + RING_OFF, g, S, E); }
    } } SEAM(5);
    if (IN(6)) { {
        pg8::Gemm g{(const pg8::bf16_t*)(ws + WS_PRW + 64 * MiB), (const pg8::bf16_t*)(ws + WS_WOUT), M, D, D}; pg8::StaticOrder S; S.init(M, D, F.G, (int)blockIdx.x);
        pg8::EpiRes E{F.in[0], F.out};
        pg8::gemm_phase<pg8::EpiRes, pg8::StaticOrder, true, true>(F.lds + RING_OFF, g, S, E);
    } } SEAM(6);
    if (IN(7)) { { const int gw = F.vcu * NWAVES + F.wave, NGW = F.G * NWAVES;
        for (int m = gw; m < M; m += NGW) rms_row_to_bf16(F.lane, F.out + (size_t)m * D, F.in[27], (bf16*)(ws + WS_H) + (size_t)m * D);
        peer_convert_tables(F);
    } } SEAM(7);
    if (IN(8)) { {
        pg8::Gemm g{(const pg8::bf16_t*)(ws + WS_H), (const pg8::bf16_t*)(ws + WS_WQ), M, 2048, D}; pg8::StaticOrder S; S.init(M, 2048, F.G, (int)blockIdx.x);
        pg8::EpiBf16<0> E{(pg8::bf16_t*)(ws + WS_PRW), 2048, nullptr, 0, 0, 1.f};
        pg8::gemm_phase<pg8::EpiBf16<0>, pg8::StaticOrder, true, true>(F.lds + RING_OFF, g, S, E);
    } } SEAM(8);
    if (IN(9)) { { const int gw = F.vcu * NWAVES + F.wave, NGW = F.G * NWAVES; LAS float* sc = (LAS float*)(F.lds + F.wave * 16384);
        for (int wp = gw; wp < M * 8 / 32; wp += NGW) peer_topk_pass(F, wp, sc);
    } } SEAM(9);
    if (IN(10)) { peer_slice_phase<0>(F, rep); } SEAM(10);
    if (IN(11)) { peer_act_phase(F); } SEAM(11);
    if (IN(12)) { peer_slice_phase<1>(F, rep); }
#undef IN
#undef SEAM
}

extern "C" void kernel_launch(void* const* d_in, const int* in_sizes, int n_in, void* d_out, int out_size, void* d_ws, size_t ws_size, hipStream_t stream) {
    static int grid = 0;
    if (grid == 0) {
        if (n_in != 33 || out_size != M * D || ws_size < WS_END) { fprintf(stderr, "kernel_launch: unexpected shapes (n_in %d out %d ws %zu)\n", n_in, out_size, ws_size); grid = -1; return; }
        int dev = 0, cus = 0, per_cu = 0;
        if (hipGetDevice(&dev) != hipSuccess || hipDeviceGetAttribute(&cus, hipDeviceAttributeMultiprocessorCount, dev) != hipSuccess) { grid = -1; return; }
        if (hipFuncSetAttribute((const void*)mk_fwd, hipFuncAttributeMaxDynamicSharedMemorySize, LDS_BYTES) != hipSuccess) { fprintf(stderr, "kernel_launch: hipFuncSetAttribute failed\n"); grid = -1; return; }
        if (hipOccupancyMaxActiveBlocksPerMultiprocessor(&per_cu, (const void*)mk_fwd, NWAVES * 64, LDS_BYTES) != hipSuccess || per_cu < 1)
            fprintf(stderr, "kernel_launch: occupancy query reports %d blocks per CU\n", per_cu);
        (void)hipGetLastError();
        grid = cus;
        if (grid > 256) grid = 256;
    }
    if (grid < 0) return;
    if (hipMemsetAsync((char*)d_ws + WS_CTL, 0, CTL_ZERO_BYTES, stream) != hipSuccess) return;
    Args a{};
    for (int i = 0; i < 33; ++i) a.in[i] = (const float*)d_in[i];
    a.out = (float*)d_out; a.ws = (unsigned char*)d_ws;
#if MK_ONE_LAUNCH
    a.ph_lo = 0; a.ph_hi = N_PHASES;
    hipLaunchKernelGGL(mk_fwd, dim3(grid), dim3(NWAVES * 64), LDS_BYTES, stream, a);
#else
    for (int p = 0; p < N_PHASES; ++p) { for (int r = 0; r <= (((REP_MASK) >> p) & 1); ++r) { a.ph_lo = p; a.ph_hi = (p + 1) | (r << 8); hipLaunchKernelGGL(mk_fwd, dim3(grid), dim3(NWAVES * 64), LDS_BYTES, stream, a); } }
#endif
}
```

```cpp
#include <hip/hip_runtime.h>
#include <cstdio>
#include <cstdint>
#define MK_ONE_LAUNCH 1
#define REP_MASK 0
#define P3REP 1
#define NSA_SKIP 0
#define DBG_SEL -1
namespace pg8 {
#define PG8_LAS __attribute__((address_space(3)))
typedef unsigned short bf16_t;
typedef short bf16x8 __attribute__((ext_vector_type(8)));
typedef float f32x4 __attribute__((ext_vector_type(4)));
typedef unsigned u32x4 __attribute__((ext_vector_type(4)));
constexpr int BM = 256, BK = 64, HALF = 128, HTB = HALF * BK * 2  , STAGE_BYTES = 8 * HTB, NXCD = 8, WGM = 8;

__host__ __device__ __forceinline__ int lds_byte(int r, int c) { const int st = (r >> 4) * 2 + (c >> 5), rr = r & 15, cc = c & 31, ob = rr * 64 + cc * 2; return st * 1024 + (ob ^ (((ob >> 9) & 1) << 5)); }
__host__ __device__ __forceinline__ void stage_rc(int b, int& R, int& C) { const int st = b / 1024, sb = b % 1024, swz = sb ^ (((sb >> 9) & 1) << 5); R = (st >> 1) * 16 + swz / 64; C = (st & 1) * 32 + (swz % 64) / 2; }
__host__ __device__ __forceinline__ int perm32(int rho) { const int n = rho >> 4, i = rho & 15; return 8 * (i >> 2) + 4 * n + (i & 3); }

struct Unit { int pm, pn; };
struct Gemm { const bf16_t* A; const bf16_t* Bt; int M, N, K; };

struct StaticOrder {
    int nM, nN, nwg, G, c;
    __host__ __device__ void init(int M, int N, int G_, int c_) { nM = M / BM; nN = N / BM; nwg = nM * nN; G = G_; c = c_; }
    __host__ __device__ bool next(int i, Unit& u) const {
        const long L = (long)i * G + c; if (L >= nwg) return false;
        int wgid = (int)L; { const int q = nwg / NXCD, r = nwg % NXCD, xcd = wgid % NXCD, off = wgid / NXCD; wgid = (xcd < r ? xcd * (q + 1) : r * (q + 1) + (xcd - r) * q) + off; }
        const int nig = WGM * nN, gid = wgid / nig, fm = gid * WGM, gsz = (nM - fm) < WGM ? (nM - fm) : WGM;
        u.pm = fm + ((wgid % nig) % gsz); u.pn = (wgid % nig) / gsz; return true;
    }
    __device__ __forceinline__ void a_ready(const Unit&) const {}
    __device__ __forceinline__ void done(const Unit&) const {}
};

typedef float f32x2c __attribute__((ext_vector_type(2))); typedef __bf16 bf16x2c __attribute__((ext_vector_type(2)));
__device__ __forceinline__ unsigned cvt_pk_bf16(float lo, float hi) { const f32x2c v = {lo, hi}; const bf16x2c b = __builtin_convertvector(v, bf16x2c); return __builtin_bit_cast(unsigned, b); }
typedef float f32x2 __attribute__((ext_vector_type(2)));
__device__ __forceinline__ f32x2 gelu_pk(f32x2 v) {
    const f32x2 av = __builtin_elementwise_abs(v), d = av * 0.2316418882f + 1.0f;
    f32x2 t; t.x = __builtin_amdgcn_rcpf(d.x); t.y = __builtin_amdgcn_rcpf(d.y);
    f32x2 q = t * 0.5307027145f + (-0.7265760135f); q = q * t + 0.7107068705f; q = q * t + (-0.142248368f); q = q * t + 0.127414796f; q = q * t;
    const f32x2 s = (v * v) * (-0.72134752044f);
    f32x2 e; e.x = __builtin_amdgcn_exp2f(s.x); e.y = __builtin_amdgcn_exp2f(s.y);
    const f32x2 m = v * (q * e), r = v - m;
    f32x2 o; o.x = v.x < 0.f ? m.x : r.x; o.y = v.y < 0.f ? m.y : r.y; return o;
}

template <int ACT  > struct EpiBf16 {
    static constexpr bool PERM = true, AFTER_DRAIN = false; static_assert(ACT == 0 || ACT == 1, "EpiBf16: ACT is 0 (none) or 1 (gelu_pk)");
    bf16_t* O; int ldc; const float* bias; int split_cols; size_t split_stride; float scale0;
    __device__ __forceinline__ void operator()(const f32x4 (&acc)[2][2][4][2], const Unit& u, int wr, int wc, int fr, int fq) const {
        const int row0 = u.pm * BM + wr * 64 + fr; int colt = u.pn * BM; bf16_t* base = O;
        float sc = 1.f; if (split_cols) { const int t = colt / split_cols; base += (size_t)t * split_stride; colt -= t * split_cols; if (t == 0) sc = scale0; }
        const int col0 = colt + wc * 32 + 8 * fq, bcol0 = u.pn * BM + wc * 32 + 8 * fq;
        f32x4 bv[2][2];
#pragma unroll
        for (int bj = 0; bj < 2; ++bj)
#pragma unroll
            for (int n = 0; n < 2; ++n) bv[bj][n] = bias ? *(const f32x4*)(bias + bcol0 + bj * HALF + 4 * n) : (f32x4){0.f, 0.f, 0.f, 0.f};
#pragma unroll
        for (int ai = 0; ai < 2; ++ai)
#pragma unroll
            for (int m = 0; m < 4; ++m) { bf16_t* rowp = base + (size_t)(row0 + ai * HALF + m * 16) * ldc + col0;
#pragma unroll
                for (int bj = 0; bj < 2; ++bj) { f32x4 v0 = acc[ai][bj][m][0] + bv[bj][0], v1 = acc[ai][bj][m][1] + bv[bj][1];
                    if (ACT == 1) { f32x2 a = gelu_pk((f32x2){v0[0], v0[1]}), b = gelu_pk((f32x2){v0[2], v0[3]}), c = gelu_pk((f32x2){v1[0], v1[1]}), d = gelu_pk((f32x2){v1[2], v1[3]});
                        v0 = (f32x4){a.x, a.y, b.x, b.y}; v1 = (f32x4){c.x, c.y, d.x, d.y}; }
                    v0 = v0 * sc; v1 = v1 * sc; u32x4 w; w.x = cvt_pk_bf16(v0[0], v0[1]); w.y = cvt_pk_bf16(v0[2], v0[3]); w.z = cvt_pk_bf16(v1[0], v1[1]); w.w = cvt_pk_bf16(v1[2], v1[3]);
                    *(u32x4*)(rowp + bj * HALF) = w; } }
    }
};
__device__ __forceinline__ float bf_lo(unsigned w) { return __uint_as_float(w << 16); }
__device__ __forceinline__ float bf_hi(unsigned w) { return __uint_as_float(w & 0xffff0000u); }
__device__ __forceinline__ float sigm(float x) { return 1.0f / (1.0f + __expf(-x)); }
__device__ __forceinline__ u32x4 pack8(const f32x4 v0, const f32x4 v1) { u32x4 w; w.x = cvt_pk_bf16(v0[0], v0[1]); w.y = cvt_pk_bf16(v0[2], v0[3]); w.z = cvt_pk_bf16(v1[0], v1[1]); w.w = cvt_pk_bf16(v1[2], v1[3]); return w; }

struct EpiG1 {
    static constexpr bool PERM = true, AFTER_DRAIN = false;
    float* PRW; float* BND; bf16_t* PNSA; bf16_t* MG; float* GLOG;
    __device__ __forceinline__ void operator()(const f32x4 (&acc)[2][2][4][2], const Unit& u, int wr, int wc, int fr, int fq) const {
        const int row0 = u.pm * BM + wr * 64 + fr, c0 = wc * 32 + 8 * fq;
#pragma unroll
        for (int ai = 0; ai < 2; ++ai)
#pragma unroll
            for (int m = 0; m < 4; ++m) { const int row = row0 + ai * HALF + m * 16;
#pragma unroll
                for (int bj = 0; bj < 2; ++bj) { const f32x4 v0 = acc[ai][bj][m][0], v1 = acc[ai][bj][m][1]; const int col = c0 + bj * HALF;
                    if (u.pn < 7) { float* p = PRW + (size_t)row * 1792 + u.pn * 256 + col; *(f32x4*)p = v0; *(f32x4*)(p + 4) = v1;
                        if ((row & 63) == 63) { float* q = BND + (size_t)(row >> 6) * 1792 + u.pn * 256 + col; *(f32x4*)q = v0; *(f32x4*)(q + 4) = v1; } }
                    else if (u.pn < 12) { *(u32x4*)(PNSA + (size_t)row * 1280 + (u.pn - 7) * 256 + col) = pack8(v0, v1); }
                    else if (u.pn < 20) { *(u32x4*)(MG + (size_t)row * 2048 + (u.pn - 12) * 256 + col) = pack8(v0, v1); }
                    else { if (col < 32) { float* p = GLOG + (size_t)row * 32 + col; *(f32x4*)p = v0; *(f32x4*)(p + 4) = v1; } }
                } }
    }
};
struct EpiGate1 {
    static constexpr bool PERM = true, AFTER_DRAIN = false;
    float* T1; const bf16_t* MG; int goff;
    __device__ __forceinline__ void operator()(const f32x4 (&acc)[2][2][4][2], const Unit& u, int wr, int wc, int fr, int fq) const {
        const int row0 = u.pm * BM + wr * 64 + fr, c0 = u.pn * BM + wc * 32 + 8 * fq;
#pragma unroll
        for (int ai = 0; ai < 2; ++ai)
#pragma unroll
            for (int m = 0; m < 4; ++m) { const int row = row0 + ai * HALF + m * 16;
#pragma unroll
                for (int bj = 0; bj < 2; ++bj) { const f32x4 v0 = acc[ai][bj][m][0], v1 = acc[ai][bj][m][1]; const int col = c0 + bj * HALF;
                    const u32x4 g = *(const u32x4*)(MG + (size_t)row * 2048 + goff + col);
                    f32x4 o0, o1; o0[0] = sigm(bf_lo(g.x)) * v0[0]; o0[1] = sigm(bf_hi(g.x)) * v0[1]; o0[2] = sigm(bf_lo(g.y)) * v0[2]; o0[3] = sigm(bf_hi(g.y)) * v0[3];
                    o1[0] = sigm(bf_lo(g.z)) * v1[0]; o1[1] = sigm(bf_hi(g.z)) * v1[1]; o1[2] = sigm(bf_lo(g.w)) * v1[2]; o1[3] = sigm(bf_hi(g.w)) * v1[3];
                    float* p = T1 + (size_t)row * 1024 + col; *(f32x4*)p = o0; *(f32x4*)(p + 4) = o1; } }
    }
};
struct EpiGate2 {
    static constexpr bool PERM = true, AFTER_DRAIN = false;
    const float* T1; const bf16_t* MG; int goff; bf16_t* MIX;
    __device__ __forceinline__ void operator()(const f32x4 (&acc)[2][2][4][2], const Unit& u, int wr, int wc, int fr, int fq) const {
        const int row0 = u.pm * BM + wr * 64 + fr, c0 = u.pn * BM + wc * 32 + 8 * fq;
#pragma unroll
        for (int ai = 0; ai < 2; ++ai)
#pragma unroll
            for (int m = 0; m < 4; ++m) { const int row = row0 + ai * HALF + m * 16;
#pragma unroll
                for (int bj = 0; bj < 2; ++bj) { const f32x4 v0 = acc[ai][bj][m][0], v1 = acc[ai][bj][m][1]; const int col = c0 + bj * HALF;
                    const u32x4 g = *(const u32x4*)(MG + (size_t)row * 2048 + goff + col);
                    const float* p = T1 + (size_t)row * 1024 + col; const f32x4 t0 = *(const f32x4*)p, t1 = *(const f32x4*)(p + 4);
                    f32x4 o0, o1; o0[0] = t0[0] + sigm(bf_lo(g.x)) * v0[0]; o0[1] = t0[1] + sigm(bf_hi(g.x)) * v0[1]; o0[2] = t0[2] + sigm(bf_lo(g.y)) * v0[2]; o0[3] = t0[3] + sigm(bf_hi(g.y)) * v0[3];
                    o1[0] = t1[0] + sigm(bf_lo(g.z)) * v1[0]; o1[1] = t1[1] + sigm(bf_hi(g.z)) * v1[1]; o1[2] = t1[2] + sigm(bf_lo(g.w)) * v1[2]; o1[3] = t1[3] + sigm(bf_hi(g.w)) * v1[3];
                    *(u32x4*)(MIX + (size_t)row * 1024 + col) = pack8(o0, o1); } }
    }
};
struct EpiRes {
    static constexpr bool PERM = true, AFTER_DRAIN = false;
    const float* X; float* OUT;
    __device__ __forceinline__ void operator()(const f32x4 (&acc)[2][2][4][2], const Unit& u, int wr, int wc, int fr, int fq) const {
        const int row0 = u.pm * BM + wr * 64 + fr, c0 = u.pn * BM + wc * 32 + 8 * fq;
#pragma unroll
        for (int ai = 0; ai < 2; ++ai)
#pragma unroll
            for (int m = 0; m < 4; ++m) { const int row = row0 + ai * HALF + m * 16;
#pragma unroll
                for (int bj = 0; bj < 2; ++bj) { const size_t off = (size_t)row * 1024 + c0 + bj * HALF;
                    const f32x4 x0 = *(const f32x4*)(X + off), x1 = *(const f32x4*)(X + off + 4);
                    *(f32x4*)(OUT + off) = x0 + acc[ai][bj][m][0]; *(f32x4*)(OUT + off + 4) = x1 + acc[ai][bj][m][1]; } }
    }
};
template <class Epi, class Sched, bool ALIGN_EPI = false, bool SP2 = false>
__device__ __forceinline__ void gemm_phase(PG8_LAS unsigned char* lds, const Gemm g, const Sched& S, const Epi& E) {
    const int tid = threadIdx.x, wid = __builtin_amdgcn_readfirstlane(tid >> 6), lane = tid & 63, wr = wid >> 2, wc = wid & 3, fr = lane & 15, fq = lane >> 4;
    const int K = g.K, nt = K / BK;
    unsigned voffA[2], voffB[2];
#pragma unroll
    for (int i = 0; i < 2; ++i) { int R, C; stage_rc(tid * 16 + i * 8192, R, C); const int Rb = Epi::PERM ? ((R & ~31) + perm32(R & 31)) : R;
        voffA[i] = (unsigned)(R * K + C) * 2u; voffB[i] = (unsigned)(Rb * K + C) * 2u; }
    const size_t kstep = (size_t)(BK * 2);
    const size_t hstep = (size_t)HALF * K * 2;
    const size_t tstep = 2 * hstep;
    const unsigned ldsw = (unsigned)wid * 1024u;
    const int aoff = lds_byte(wr * 64 + fr, fq * 8), boff = lds_byte(wc * 32 + fr, fq * 8);
#define PG8_SA(b, h) (((b) * 2 + (h)) * HTB)
#define PG8_SB(b, h) ((4 + (b) * 2 + (h)) * HTB)
#define PG8_STAGE(bufoff, gbase, voff) do { _Pragma("unroll") for (int _i = 0; _i < 2; ++_i) \
        __builtin_amdgcn_global_load_lds((const unsigned*)((const char*)(gbase) + (voff)[_i]), (PG8_LAS unsigned*)(lds + (bufoff) + ldsw + _i * 8192), 16, 0, 0); } while (0)
#define PG8_LDA(dst, b, h) do { _Pragma("unroll") for (int m = 0; m < 4; ++m) _Pragma("unroll") for (int k = 0; k < 2; ++k) dst[m][k] = *(const PG8_LAS bf16x8*)(lds + PG8_SA(b, h) + aoff + m * 2048 + k * 1024); } while (0)
#define PG8_LDB(dst, b, h) do { _Pragma("unroll") for (int n = 0; n < 2; ++n) _Pragma("unroll") for (int k = 0; k < 2; ++k) dst[n][k] = *(const PG8_LAS bf16x8*)(lds + PG8_SB(b, h) + boff + n * 2048 + k * 1024); } while (0)
#define PG8_MMA(ai, bj, At, Bt) do { __builtin_amdgcn_s_setprio(1); _Pragma("unroll") for (int m = 0; m < 4; ++m) _Pragma("unroll") for (int n = 0; n < 2; ++n) _Pragma("unroll") for (int k = 0; k < 2; ++k) \
        acc[ai][bj][m][n] = __builtin_amdgcn_mfma_f32_16x16x32_bf16(Bt[n][k], At[m][k], acc[ai][bj][m][n], 0, 0, 0); __builtin_amdgcn_s_setprio(0); } while (0)
#define PG8_WAIT_V(n) asm volatile("s_waitcnt vmcnt(" #n ")" ::: "memory")
#define PG8_WAIT_L(n) asm volatile("s_waitcnt lgkmcnt(" #n ")" ::: "memory")
#define PG8_BAR __builtin_amdgcn_s_barrier()
#define PG8_SCHED __builtin_amdgcn_sched_barrier(0)
    Unit cur, nxt; int ui = 0;
    if (!S.next(0, cur)) return;
    f32x4 acc[2][2][4][2];
#pragma unroll
    for (int a = 0; a < 2; ++a)
#pragma unroll
        for (int b = 0; b < 2; ++b)
#pragma unroll
            for (int m = 0; m < 4; ++m)
#pragma unroll
                for (int n = 0; n < 2; ++n) acc[a][b][m][n] = (f32x4){0.f, 0.f, 0.f, 0.f};
    bf16x8 At[4][2], B0[2][2], B1[2][2];
    const char* cA = (const char*)g.A + (size_t)cur.pm * tstep; const char* cB = (const char*)g.Bt + (size_t)cur.pn * tstep;
    S.a_ready(cur);
    if constexpr (SP2) {
        PG8_STAGE(PG8_SB(0, 0), cB, voffB); PG8_STAGE(PG8_SB(0, 1), cB + hstep, voffB); PG8_STAGE(PG8_SA(0, 0), cA, voffA); PG8_STAGE(PG8_SA(0, 1), cA + hstep, voffA);
        if (wr == 1) PG8_BAR;
        PG8_WAIT_V(2); PG8_BAR;
        PG8_STAGE(PG8_SB(1, 0), cB + kstep, voffB); PG8_STAGE(PG8_SA(1, 0), cA + kstep, voffA); PG8_STAGE(PG8_SB(1, 1), cB + hstep + kstep, voffB);
        PG8_WAIT_V(6); PG8_BAR;
    } else {
        PG8_STAGE(PG8_SB(0, 0), cB, voffB); PG8_STAGE(PG8_SA(0, 0), cA, voffA); PG8_STAGE(PG8_SB(0, 1), cB + hstep, voffB); PG8_STAGE(PG8_SA(0, 1), cA + hstep, voffA);
        if (wr == 1) PG8_BAR;
        PG8_WAIT_V(4); PG8_BAR;
        PG8_STAGE(PG8_SB(1, 0), cB + kstep, voffB); PG8_STAGE(PG8_SA(1, 0), cA + kstep, voffA); PG8_STAGE(PG8_SB(1, 1), cB + hstep + kstep, voffB);
        PG8_WAIT_V(6); PG8_BAR;
    }
    for (;;) {
        const bool has_next = S.next(ui + 1, nxt);
        const char* nA = has_next ? (const char*)g.A + (size_t)nxt.pm * tstep : cA; const char* nB = has_next ? (const char*)g.Bt + (size_t)nxt.pn * tstep : cB;
        for (int t = 0; t < nt; t += 2) {
            const bool last = (t == nt - 2);
            const char* a1 = cA + (size_t)(t + 1) * kstep;
            const char* a2 = last ? nA : cA + (size_t)(t + 2) * kstep; const char* b2 = last ? nB : cB + (size_t)(t + 2) * kstep;
            const char* a3 = a2 + kstep; const char* b3 = b2 + kstep;
            if (last && has_next) S.a_ready(nxt);
            if constexpr (SP2) {
            PG8_LDB(B0, 0, 0); PG8_LDB(B1, 0, 1); PG8_SCHED; PG8_LDA(At, 0, 0); PG8_STAGE(PG8_SA(1, 1), a1 + hstep, voffA);
            PG8_WAIT_V(8); PG8_WAIT_L(0); PG8_BAR; PG8_MMA(0, 0, At, B0); PG8_MMA(0, 1, At, B1); PG8_BAR; PG8_SCHED;
            PG8_LDA(At, 0, 1); PG8_STAGE(PG8_SB(0, 0), b2, voffB); PG8_STAGE(PG8_SB(0, 1), b2 + hstep, voffB); PG8_STAGE(PG8_SA(0, 0), a2, voffA);
            PG8_WAIT_V(8); PG8_WAIT_L(0); PG8_BAR; PG8_MMA(1, 0, At, B0); PG8_MMA(1, 1, At, B1); PG8_BAR; PG8_SCHED;
            PG8_LDB(B0, 1, 0); PG8_LDB(B1, 1, 1); PG8_SCHED; PG8_LDA(At, 1, 0); PG8_STAGE(PG8_SA(0, 1), a2 + hstep, voffA);
            PG8_WAIT_V(8); PG8_WAIT_L(0); PG8_BAR; PG8_MMA(0, 0, At, B0); PG8_MMA(0, 1, At, B1); PG8_BAR; PG8_SCHED;
            PG8_LDA(At, 1, 1); PG8_STAGE(PG8_SB(1, 0), b3, voffB); PG8_STAGE(PG8_SB(1, 1), b3 + hstep, voffB); PG8_STAGE(PG8_SA(1, 0), a3, voffA);
            PG8_WAIT_V(8); PG8_WAIT_L(0); PG8_BAR; PG8_MMA(1, 0, At, B0); PG8_MMA(1, 1, At, B1); PG8_BAR; PG8_SCHED;
            } else {
            PG8_LDB(B0, 0, 0); PG8_SCHED; PG8_LDA(At, 0, 0); PG8_STAGE(PG8_SA(1, 1), a1 + hstep, voffA);
            PG8_WAIT_L(8); PG8_BAR; PG8_WAIT_L(0); PG8_MMA(0, 0, At, B0); PG8_BAR; PG8_SCHED;
            PG8_LDB(B1, 0, 1); PG8_STAGE(PG8_SB(0, 0), b2, voffB);
            PG8_BAR; PG8_WAIT_L(0); PG8_MMA(0, 1, At, B1); PG8_BAR;
            PG8_LDA(At, 0, 1); PG8_STAGE(PG8_SA(0, 0), a2, voffA);
            PG8_BAR; PG8_WAIT_L(0); PG8_MMA(1, 0, At, B0); PG8_BAR; PG8_SCHED;
            PG8_STAGE(PG8_SB(0, 1), b2 + hstep, voffB);
            PG8_WAIT_V(6); PG8_BAR; PG8_MMA(1, 1, At, B1); PG8_BAR;
            PG8_LDB(B0, 1, 0); PG8_SCHED; PG8_LDA(At, 1, 0); PG8_STAGE(PG8_SA(0, 1), a2 + hstep, voffA);
            PG8_WAIT_L(8); PG8_BAR; PG8_WAIT_L(0); PG8_MMA(0, 0, At, B0); PG8_BAR; PG8_SCHED;
            PG8_LDB(B1, 1, 1); PG8_STAGE(PG8_SB(1, 0), b3, voffB);
            PG8_BAR; PG8_WAIT_L(0); PG8_MMA(0, 1, At, B1); PG8_BAR;
            PG8_LDA(At, 1, 1); PG8_STAGE(PG8_SA(1, 0), a3, voffA);
            PG8_BAR; PG8_WAIT_L(0); PG8_MMA(1, 0, At, B0); PG8_BAR; PG8_SCHED;
            PG8_STAGE(PG8_SB(1, 1), b3 + hstep, voffB);
            PG8_WAIT_V(6); PG8_BAR; PG8_MMA(1, 1, At, B1); PG8_BAR;
            }
        }
        if constexpr (ALIGN_EPI) { if (wr == 0) PG8_BAR; }
        if constexpr (!Epi::AFTER_DRAIN) { E(acc, cur, wr, wc, fr, fq); S.done(cur); }
        if (!has_next) break;
#pragma unroll
        for (int a = 0; a < 2; ++a)
#pragma unroll
            for (int b = 0; b < 2; ++b)
#pragma unroll
                for (int m = 0; m < 4; ++m)
#pragma unroll
                    for (int n = 0; n < 2; ++n) acc[a][b][m][n] = (f32x4){0.f, 0.f, 0.f, 0.f};
        cur = nxt; cA = nA; cB = nB; ++ui;
        if constexpr (ALIGN_EPI) { if (wr == 1) PG8_BAR; }
    }
    PG8_WAIT_V(0);
    if constexpr (!ALIGN_EPI) { if (wr == 0) PG8_BAR; }
    PG8_BAR;
    if constexpr (Epi::AFTER_DRAIN) { E.fused(acc, cur, wr, wc, fr, fq, lds, wid, lane); S.done(cur); }
#undef PG8_SA
#undef PG8_SB
#undef PG8_STAGE
#undef PG8_LDA
#undef PG8_LDB
#undef PG8_MMA
#undef PG8_WAIT_V
#undef PG8_WAIT_L
#undef PG8_BAR
#undef PG8_SCHED
}
}
#define GAS __attribute__((address_space(1)))
#define LAS __attribute__((address_space(3)))
typedef unsigned short bf16;
typedef unsigned v4u __attribute__((ext_vector_type(4)));
typedef float f32x4 __attribute__((ext_vector_type(4)));
typedef short bf16x8 __attribute__((ext_vector_type(8)));
typedef GAS unsigned gu32;
typedef GAS unsigned long long gu64;
#define RLX_AGENT __ATOMIC_RELAXED, __HIP_MEMORY_SCOPE_AGENT
#define LDS_WAIT() asm volatile("s_waitcnt lgkmcnt(0)" ::: "memory")
#define VM_WAIT() asm volatile("s_waitcnt vmcnt(0)" ::: "memory")
__device__ __forceinline__ unsigned long long rt() { return __builtin_amdgcn_s_memrealtime(); }
__device__ __forceinline__ unsigned f2bf(float f) { unsigned u = __builtin_bit_cast(unsigned, f); return (u + 0x7fffu + ((u >> 16) & 1u)) >> 16; }
__device__ __forceinline__ unsigned pk2(float lo, float hi) { return f2bf(lo) | (f2bf(hi) << 16); }

#define XB_TMO      128
#define XB_XCNT(j)  (256  + 64 * (j))
#define XB_XSUB(j)  (1280 + 64 * (j))
#define XB_XGEN(j)  (2304 + 64 * (j))
#define XB_TOP      3328
#define XB_TOPGEN   3392
#define XCD_BAR_WORDS 3456
#define XB_SPIN_CAP (1u << 18)

__device__ __forceinline__ unsigned xb_ld(unsigned* p)              { return __hip_atomic_load(p, __ATOMIC_RELAXED, __HIP_MEMORY_SCOPE_AGENT); }
__device__ __forceinline__ unsigned xb_add(unsigned* p, unsigned v) { return __hip_atomic_fetch_add(p, v, __ATOMIC_RELAXED, __HIP_MEMORY_SCOPE_AGENT); }
__device__ __forceinline__ unsigned xb_xcc_id() { return (unsigned)__builtin_amdgcn_s_getreg((3 << 11) | 20) & 0xFu; }
#define XB_SPIN(cond, bar) do { unsigned _sp = 0; while (cond) { __builtin_amdgcn_s_sleep(1); \
    if ((++_sp & 255u) == 0u) { if (xb_ld(&(bar)[XB_TMO])) break; if (_sp > XB_SPIN_CAP) { atomicAdd(&(bar)[XB_TMO], 1u); break; } } } } while (0)

struct XcdBarrier {
    unsigned* bar; unsigned x;
    volatile LAS unsigned* st;
};

__device__ __forceinline__ XcdBarrier xcd_barrier_post(unsigned* bar, volatile LAS unsigned* st) {
    XcdBarrier b; b.bar = bar; b.x = xb_xcc_id(); b.st = st;
    if (threadIdx.x == 0) (void)xb_add(&bar[XB_XCNT(b.x)], 1u);
    return b;
}
__device__ __forceinline__ void xcd_barrier_complete(unsigned* bar, unsigned x, unsigned& nloc, unsigned& nx) {
    const unsigned G = gridDim.x * gridDim.y * gridDim.z;
    unsigned sum, cnt, mine, sp = 0u;
    for (;;) {
        sum = 0u; cnt = 0u; mine = 0u;
#pragma unroll
        for (unsigned j = 0; j < 16; ++j) { const unsigned c = xb_ld(&bar[XB_XCNT(j)]); sum += c; cnt += (c > 0u) ? 1u : 0u; mine = (j == x) ? c : mine; }
        if (sum == G) break;
        __builtin_amdgcn_s_sleep(1);
        if ((++sp & 255u) == 0u) { if (xb_ld(&bar[XB_TMO])) break; if (sp > XB_SPIN_CAP) { atomicAdd(&bar[XB_TMO], 1u); break; } }
    }
    nloc = mine > 0u ? mine : 1u; nx = cnt > 0u ? cnt : 1u;
}

__device__ __forceinline__ void xcd_barrier(const XcdBarrier& b) {
    asm volatile("s_waitcnt vmcnt(0)" ::: "memory");
    __syncthreads();
    if (threadIdx.x == 0) {
        unsigned* bar = b.bar;
        __builtin_amdgcn_s_waitcnt(0);
        unsigned nloc = b.st[0], nx = b.st[1];
        if (nloc == 0u) { xcd_barrier_complete(bar, b.x, nloc, nx); b.st[0] = nloc; b.st[1] = nx; }
        const unsigned old = xb_add(&bar[XB_XSUB(b.x)], 1u);
        const unsigned gen = old / nloc;
        if (old + 1u == (gen + 1u) * nloc) {
            __builtin_amdgcn_fence(__ATOMIC_RELEASE, "agent");
            asm volatile("s_waitcnt vmcnt(0)" ::: "memory");
            const unsigned og = xb_add(&bar[XB_TOP], 1u);
            const unsigned tg = og / nx;
            if (og + 1u == (tg + 1u) * nx) xb_add(&bar[XB_TOPGEN], 1u);
            else XB_SPIN(xb_ld(&bar[XB_TOPGEN]) == tg, bar);
            __builtin_amdgcn_fence(__ATOMIC_ACQUIRE, "agent");
            xb_add(&bar[XB_XGEN(b.x)], 1u);
            asm volatile("s_waitcnt vmcnt(0)" ::: "memory");
        } else {
            XB_SPIN(xb_ld(&bar[XB_XGEN(b.x)]) == gen, bar);
            __builtin_amdgcn_fence(__ATOMIC_ACQUIRE, "agent");
            asm volatile("s_waitcnt vmcnt(0)" ::: "memory");
        }
    }
    __syncthreads();
}
constexpr int NWAVES = 8;
constexpr int BATCH = 4, T = 4096, D = 1024, M = BATCH * T;
constexpr int RWC = 1792;
constexpr int NG1 = 5376;
constexpr float NORM_EPS = 1e-6f, GN_EPS = 64e-5f;
constexpr float LOG2E = 1.4426950408889634f;
constexpr int N_PHASES = 13;
#ifndef MK_ONE_LAUNCH
#define MK_ONE_LAUNCH 0
#endif
#ifndef REP_MASK
#define REP_MASK 0
#endif
#ifndef DBG_SEL
#define DBG_SEL -1
#endif
#ifndef NSA_SKIP
#define NSA_SKIP 0
#endif
#ifndef P3REP
#define P3REP 1
#endif
#ifndef SCAN_BLOCKS
#define SCAN_BLOCKS 128
#endif

constexpr size_t MiB = 1u << 20;
constexpr size_t WS_CTL = 0, CTL_ZERO_BYTES = 1 * MiB;
constexpr size_t WS_WIN = 1 * MiB;
constexpr size_t WS_WA = 12 * MiB, WS_WB = 13 * MiB;
constexpr size_t WS_WOUT = 14 * MiB;
constexpr size_t WS_WQ = 16 * MiB;
constexpr size_t WS_CW1K = 20 * MiB, WS_CW1V = 21 * MiB;
constexpr size_t WS_CW2K = 22 * MiB, WS_CW2V = 22 * MiB + 65536;
constexpr size_t WS_SK1 = 22 * MiB + 131072, WS_SK2 = 22 * MiB + 196608;
constexpr size_t WS_BND = 23 * MiB;
constexpr size_t WS_KC = 25 * MiB;
constexpr size_t WS_VCT = 25 * MiB + 262144;
constexpr size_t WS_H = 26 * MiB;
constexpr size_t WS_PRW = 58 * MiB;
constexpr size_t WS_MG = 170 * MiB;
constexpr size_t WS_VST = 234 * MiB, WS_VWT = 238 * MiB;
constexpr size_t WS_END = 256 * MiB;
constexpr size_t DO_PNSA = 0, DO_G = 40 * MiB, DO_GLOG = 56 * MiB;
constexpr int CW_TMO = 0, CW_CODE = 1, CW_NSAQ = 64, CW_SCANP = 2048, CW_PEERQ = 4160, CW_BAR = 8192;

constexpr int RING_OFF = 0, RING_BYTES = 131072;
constexpr int LDSCTL_OFF = RING_BYTES, MISC_OFF = LDSCTL_OFF + 320;
constexpr int LDS_BYTES = 147456;
typedef unsigned short u16;
typedef unsigned u32x2 __attribute__((ext_vector_type(2)));
struct Frame {
    LAS unsigned char* lds;
    volatile LAS unsigned* MISC;
    gu32* ctl;
    int tid, lane, wave, vcu, G;
    const float* in[33];
    float* out; unsigned char* ws;
};
__device__ __forceinline__ float wave_sum(float v) {
#pragma unroll
    for (int o = 1; o < 64; o <<= 1) v += __shfl_xor(v, o);
    return v;
}
template <int CTRL> __device__ __forceinline__ float dppf(float x) { return __builtin_bit_cast(float, __builtin_amdgcn_update_dpp(0, __builtin_bit_cast(int, x), CTRL, 0xf, 0xf, true)); }
__device__ __forceinline__ float bf2f(u16 b) { return __uint_as_float((unsigned)b << 16); }
__device__ __forceinline__ float bflo(unsigned w) { return __uint_as_float(w << 16); }
__device__ __forceinline__ float bfhi(unsigned w) { return __uint_as_float(w & 0xffff0000u); }
__device__ __forceinline__ u16 f2b(float f) { return (u16)f2bf(f); }
__device__ __forceinline__ float sigmf(float x) { return 1.0f / (1.0f + __expf(-x)); }
__device__ __forceinline__ f32x4 mfma16(const bf16x8 a, const bf16x8 b, const f32x4 c) { return __builtin_amdgcn_mfma_f32_16x16x32_bf16(a, b, c, 0, 0, 0); }
__device__ __forceinline__ bf16x8 as_bf16x8(const v4u v) { return __builtin_bit_cast(bf16x8, v); }

__device__ __forceinline__ void tr_item(const float* W, int K, int ldw, int sc0, int nblk, int ncols_valid, bf16* WT, int dr0, LAS float* scr, int item, int lane) {
    const int kb = item / nblk, nb = item % nblk, k0 = 64 * kb, n0 = 32 * nb;
#pragma unroll 8
    for (int i = 0; i < 32; ++i) { const int kk = 2 * i + (lane >> 5); const int n = n0 + (lane & 31);
        scr[kk * 33 + (lane & 31)] = (n < ncols_valid) ? W[(size_t)(k0 + kk) * ldw + sc0 + n] : 0.f; }
    LDS_WAIT(); asm volatile("" ::: "memory");
    const int c = lane & 7;
#pragma unroll
    for (int j = 0; j < 4; ++j) { const int n = (lane >> 3) + 8 * j; const LAS float* s = scr + (8 * c) * 33 + n;
        v4u o; o.x = pk2(s[0 * 33], s[1 * 33]); o.y = pk2(s[2 * 33], s[3 * 33]); o.z = pk2(s[4 * 33], s[5 * 33]); o.w = pk2(s[6 * 33], s[7 * 33]);
        *(GAS v4u*)(WT + (size_t)(dr0 + n0 + n) * K + k0 + 8 * c) = o; }
    LDS_WAIT(); asm volatile("" ::: "memory");
}
__device__ __forceinline__ void rms_row_to_bf16(int lane, const float* xrow, const float* gain, bf16* orow) {
    const GAS f32x4* xr = (const GAS f32x4*)xrow + lane; const GAS f32x4* gr = (const GAS f32x4*)gain + lane;
    f32x4 v[4]; float s2 = 0.f;
#pragma unroll
    for (int j = 0; j < 4; ++j) { v[j] = xr[64 * j]; s2 += (v[j].x * v[j].x + v[j].y * v[j].y) + (v[j].z * v[j].z + v[j].w * v[j].w); }
    const float rstd = 1.f / sqrtf(wave_sum(s2) * (1.f / D) + NORM_EPS);
    GAS unsigned long long* o8 = (GAS unsigned long long*)orow + lane;
#pragma unroll
    for (int j = 0; j < 4; ++j) { const f32x4 g = gr[64 * j];
        o8[64 * j] = (unsigned long long)pk2(v[j].x * rstd * g.x, v[j].y * rstd * g.y) | ((unsigned long long)pk2(v[j].z * rstd * g.z, v[j].w * rstd * g.w) << 32); }
}
__device__ __forceinline__ void p0_prologue(const Frame& F) {
    LAS float* scr = (LAS float*)(F.lds + RING_OFF + F.wave * 16384);
    const int gw = F.vcu * NWAVES + F.wave, NGW = F.G * NWAVES;
    unsigned char* ws = F.ws;
    constexpr int I0 = 16 * 96, I1 = 16 * 64, I2 = 16 * 8, I3 = 8 * 32, I4 = 8 * 32, I5 = 16 * 32, I6 = 16 * 64, I7 = 32 * 8, I8 = 32 * 8, I9 = 4 * 2, I10 = 4 * 2;
    constexpr int NITEMS = I0 + I1 + I2 + I3 + I4 + I5 + I6 + I7 + I8 + I9 + I10;
    for (int it = gw; it < NITEMS; it += NGW) {
        int r = it;
        if (r < I0) { tr_item(F.in[2], 1024, 5144, 0, 96, 3072, (bf16*)(ws + WS_WIN), 0, scr, r, F.lane); continue; } r -= I0;
        if (r < I1) { tr_item(F.in[2], 1024, 5144, 3096, 64, 2048, (bf16*)(ws + WS_WIN), 3072, scr, r, F.lane); continue; } r -= I1;
        if (r < I2) { tr_item(F.in[2], 1024, 5144, 3072, 8, 24, (bf16*)(ws + WS_WIN), 5120, scr, r, F.lane); continue; } r -= I2;
        if (r < I3) { tr_item(F.in[24], 512, 1024, 0, 32, 1024, (bf16*)(ws + WS_WA), 0, scr, r, F.lane); continue; } r -= I3;
        if (r < I4) { tr_item(F.in[25], 512, 1024, 0, 32, 1024, (bf16*)(ws + WS_WB), 0, scr, r, F.lane); continue; } r -= I4;
        if (r < I5) { tr_item(F.in[26], 1024, 1024, 0, 32, 1024, (bf16*)(ws + WS_WOUT), 0, scr, r, F.lane); continue; } r -= I5;
        if (r < I6) { tr_item(F.in[28], 1024, 2048, 0, 64, 2048, (bf16*)(ws + WS_WQ), 0, scr, r, F.lane); continue; } r -= I6;
        if (r < I7) { tr_item(F.in[20], 2048, 256, 0, 8, 256, (bf16*)(ws + WS_CW1K), 0, scr, r, F.lane); continue; } r -= I7;
        if (r < I8) { tr_item(F.in[22], 2048, 256, 0, 8, 256, (bf16*)(ws + WS_CW1V), 0, scr, r, F.lane); continue; } r -= I8;
        if (r < I9) { tr_item(F.in[21], 256, 64, 0, 2, 64, (bf16*)(ws + WS_CW2K), 0, scr, r, F.lane); continue; } r -= I9;
        tr_item(F.in[23], 256, 64, 0, 2, 64, (bf16*)(ws + WS_CW2V), 0, scr, r, F.lane);
    }
    { const int gt = F.vcu * (NWAVES * 64) + F.tid, NT = F.G * NWAVES * 64;
      bf16* s1 = (bf16*)(ws + WS_SK1); bf16* s2 = (bf16*)(ws + WS_SK2);
      for (int i = gt; i < 128 * 128; i += NT) { s1[i] = f2b(F.in[29][i]); s2[i] = f2b(F.in[30][i]); } }
    for (int m = gw; m < M; m += NGW) rms_row_to_bf16(F.lane, F.in[0] + (size_t)m * D, F.in[1], (bf16*)(ws + WS_H) + (size_t)m * D);
}
constexpr int REC_BYTES = 12800;
__device__ __forceinline__ void rwkv_prep_tile(const Frame& F, int u) {
    const int tid = F.tid, lane = F.lane, h = F.wave, r16 = lane & 15, q4 = lane >> 4;
    const int R0 = 64 * u, t0 = R0 & (T - 1);
    LAS float* lin = (LAS float*)(F.lds);
    LAS bf16* mats = (LAS bf16*)(F.lds + 16384) + h * 4096;
    LAS float* abl = (LAS float*)(F.lds + 16384 + 65536) + h * 272;
    float* PRW = (float*)(F.ws + WS_PRW);
    const float* BND = (const float*)(F.ws + WS_BND);
    bf16* G = (bf16*)((unsigned char*)F.out + DO_G);
    const float* mu = F.in[3];
    const float mu_r = mu[tid], mu_k = mu[512 + tid], mu_v = mu[1024 + tid], mu_l = (tid < 256) ? mu[1536 + tid] : 0.f;
    const float w0c = F.in[4][tid], a0c = F.in[6][tid], kkc = F.in[9][tid], kac = F.in[10][tid], rkc = F.in[11][tid];
    const float* w_up = F.in[5]; const float* a_up = F.in[7]; const float* g_up = F.in[8];
    float pr = 0.f, pk = 0.f, pv = 0.f, pl = 0.f;
    if (t0 != 0) { const float* b = BND + (size_t)(u - 1) * RWC; pr = b[tid]; pk = b[512 + tid]; pv = b[1024 + tid]; if (tid < 256) pl = b[1536 + tid]; }
    for (int batch = 0; batch < 4; ++batch) {
        const int Rb = R0 + 16 * batch;
        float xr[16], xk[16]; unsigned vtw[8];
        if (tid < 256) { float xl[16];
#pragma unroll
            for (int j = 0; j < 16; ++j) xl[j] = PRW[(size_t)(Rb + j) * RWC + 1536 + tid];
#pragma unroll
            for (int j = 0; j < 16; ++j) { const float n = xl[j]; const float v = n + (pl - n) * mu_l; pl = n; const float f = (tid < 64) ? tanhf(v) : ((tid < 128) ? v : sigmf(v)); lin[tid * 16 + j] = f; } }
        { float xv[16];
#pragma unroll
          for (int j = 0; j < 16; ++j) { const float* p = PRW + (size_t)(Rb + j) * RWC; xr[j] = p[tid]; xk[j] = p[512 + tid]; xv[j] = p[1024 + tid]; }
          VM_WAIT();
#pragma unroll
          for (int j = 0; j < 16; ++j) { float n;
              n = xr[j]; xr[j] = n + (pr - n) * mu_r; pr = n;
              n = xk[j]; xk[j] = n + (pk - n) * mu_k; pk = n;
              n = xv[j]; const unsigned vb = f2bf(n + (pv - n) * mu_v); pv = n;
              if (j & 1) vtw[j >> 1] |= vb << 16; else vtw[j >> 1] = vb; } }
        __syncthreads();
        float accw[16], acca[16], accg[16];
#pragma unroll
        for (int j = 0; j < 16; ++j) accg[j] = 0.f;
#pragma unroll 1
        for (int jj = 0; jj < 128; ++jj) { const float gv = g_up[jj * 512 + tid];
            const LAS f32x4* ig = (const LAS f32x4*)(lin + (128 + jj) * 16);
#pragma unroll
            for (int q = 0; q < 4; ++q) { const f32x4 a = ig[q];
#pragma unroll
                for (int e = 0; e < 4; ++e) accg[4 * q + e] += a[e] * gv; } }
#pragma unroll
        for (int j = 0; j < 16; ++j) G[(size_t)(Rb + j) * 512 + tid] = f2b(accg[j]);
        __builtin_amdgcn_sched_barrier(0);
#pragma unroll
        for (int j = 0; j < 16; ++j) { accw[j] = 0.f; acca[j] = 0.f; }
#pragma unroll 1
        for (int jj = 0; jj < 64; ++jj) { const float wv = w_up[jj * 512 + tid], av = a_up[jj * 512 + tid];
            const LAS f32x4* iw = (const LAS f32x4*)(lin + jj * 16); const LAS f32x4* ia = (const LAS f32x4*)(lin + (64 + jj) * 16);
#pragma unroll
            for (int q = 0; q < 4; ++q) { const f32x4 a = iw[q], b = ia[q];
#pragma unroll
                for (int e = 0; e < 4; ++e) { accw[4 * q + e] += a[e] * wv; acca[4 * q + e] += b[e] * av; } } }
        unsigned char* rec = (unsigned char*)(PRW + (size_t)Rb * RWC) + h * REC_BYTES;
#pragma unroll
        for (int j = 0; j < 16; ++j) {
            const float z = -(w0c + accw[j]); const float sp = fmaxf(z, 0.f) + log1pf(__expf(-fabsf(z)));
            const float e = __expf(-sp - 0.5f); accw[j] = __expf(-e);
            const float a = sigmf(a0c + acca[j]); acca[j] = a;
            const float kkv = xk[j] * kkc; xk[j] = xk[j] * (1.f + (a - 1.f) * kac);
            const float ss = wave_sum(kkv * kkv); accg[j] = kkv / fmaxf(sqrtf(ss), 1e-12f);
            const float bon = wave_sum(xr[j] * xk[j] * rkc);
            if (lane == 0) *(float*)(rec + 12544 + 4 * j) = bon; __builtin_amdgcn_sched_barrier(0); }
        { float g = 1.f; unsigned bhw[8], khw[8];
          LAS bf16* mp = mats + lane;
#pragma unroll
          for (int j = 0; j < 16; ++j) { const float gp = g; g *= accw[j]; const float ig = 1.0f / g;
              const unsigned w1 = pg8::cvt_pk_bf16(accg[j] * gp, xr[j] * g), w2 = pg8::cvt_pk_bf16(accg[j] * acca[j] * ig, xk[j] * ig);
              mp[j * 64] = (u16)(w1 & 0xffffu); mp[1024 + j * 64] = (u16)(w1 >> 16); mp[2048 + j * 64] = (u16)(w2 & 0xffffu); mp[3072 + j * 64] = (u16)(w2 >> 16);
              if (j & 1) { bhw[j >> 1] |= w2 << 16; khw[j >> 1] |= w2 & 0xffff0000u; } else { bhw[j >> 1] = w2 & 0xffffu; khw[j >> 1] = w2 >> 16; } }
          *(float*)(rec + 12288 + 4 * lane) = g;
          v4u* bp = (v4u*)(rec + 4096 + lane * 32); bp[0] = (v4u){bhw[0], bhw[1], bhw[2], bhw[3]}; bp[1] = (v4u){bhw[4], bhw[5], bhw[6], bhw[7]};
          v4u* kp = (v4u*)(rec + 6144 + lane * 32); kp[0] = (v4u){khw[0], khw[1], khw[2], khw[3]}; kp[1] = (v4u){khw[4], khw[5], khw[6], khw[7]};
          v4u* vp = (v4u*)(rec + 8192 + lane * 32); vp[0] = (v4u){vtw[0], vtw[1], vtw[2], vtw[3]}; vp[1] = (v4u){vtw[4], vtw[5], vtw[6], vtw[7]}; }
        LDS_WAIT(); asm volatile("" ::: "memory");
#pragma unroll
        for (int i = 0; i < 2; ++i) { const int pi = lane + 64 * i, s = pi >> 3, ks = (pi >> 2) & 1, qq = pi & 3;
#pragma unroll
            for (int mtx = 0; mtx < 2; ++mtx) { const LAS bf16* src = mats + mtx * 1024 + s * 64 + 32 * ks + 4 * qq;
                const u32x2 lo = *(const LAS u32x2*)src, hi = *(const LAS u32x2*)(src + 16);
                *(v4u*)(rec + mtx * 2048 + pi * 16) = (v4u){lo.x, lo.y, hi.x, hi.y}; } }
        LDS_WAIT(); asm volatile("" ::: "memory");
        { f32x4 Ab = {0.f, 0.f, 0.f, 0.f}, Ak = Ab, Mb = Ab, Mk = Ab;
#pragma unroll
          for (int ks = 0; ks < 2; ++ks) { const int off = r16 * 64 + 32 * ks + 8 * q4;
              const bf16x8 aK = as_bf16x8(*(const LAS v4u*)(mats + off)), aR = as_bf16x8(*(const LAS v4u*)(mats + 1024 + off)), bB = as_bf16x8(*(const LAS v4u*)(mats + 2048 + off)), bK = as_bf16x8(*(const LAS v4u*)(mats + 3072 + off));
              Ab = mfma16(aK, bB, Ab); Ak = mfma16(aK, bK, Ak); Mb = mfma16(aR, bB, Mb); Mk = mfma16(aR, bK, Mk); }
          bf16* rAk = (bf16*)(rec + 10240); bf16* rMb = (bf16*)(rec + 11264); bf16* rMk = (bf16*)(rec + 11776);
#pragma unroll
          for (int r = 0; r < 4; ++r) { const int s = 4 * q4 + r, j = r16; const bool lo = j < s, le = j <= s;
              abl[s * 17 + j] = lo ? Ab[r] : 0.f; rAk[s * 16 + j] = f2b(lo ? Ak[r] : 0.f); rMb[s * 16 + j] = f2b(le ? Mb[r] : 0.f); rMk[s * 16 + j] = f2b(le ? Mk[r] : 0.f); } }
        LDS_WAIT(); asm volatile("" ::: "memory");
        { float Tr[16]; bf16* rT = (bf16*)(rec + 10752);
#pragma unroll
          for (int s = 0; s < 16; ++s) { float t = (r16 == s) ? 1.f : 0.f;
#pragma unroll
              for (int j = 0; j < s; ++j) t -= abl[s * 17 + j] * Tr[j];
              Tr[s] = t; if (lane < 16) rT[s * 16 + r16] = f2b(-t); __builtin_amdgcn_sched_barrier(0); } }
        __syncthreads();
    }
}
__device__ __forceinline__ void nsa_prep_tile(const Frame& F, int u) {
    const int lane = F.lane, w = F.wave;
    const int R0 = 64 * u, t0 = R0 & (T - 1), b = R0 / T;
    bf16* PNSA = (bf16*)((unsigned char*)F.out + DO_PNSA);
    const float qg = F.in[14][lane] * (0.125f * LOG2E);
    const float kg = (w < 2) ? F.in[16][lane] : F.in[17][lane];
    const int kcol = ((w < 2) ? 768 : 1024) + (w & 1) * 64 + lane;
#pragma unroll 1
    for (int tg = 0; tg < 4; ++tg) { float qv[16], kv[16];
#pragma unroll
        for (int i = 0; i < 16; ++i) { const bf16* p = PNSA + (size_t)(R0 + 16 * tg + i) * 1280; qv[i] = bf2f(p[w * 64 + lane]); kv[i] = (w < 4) ? bf2f(p[kcol]) : 0.f; }
#pragma unroll
        for (int i = 0; i < 16; ++i) { bf16* p = PNSA + (size_t)(R0 + 16 * tg + i) * 1280;
            const float ss = wave_sum(qv[i] * qv[i]) * (1.f / 64.f);
            p[w * 64 + lane] = f2b(qv[i] * rsqrtf(ss + NORM_EPS) * qg);
            if (w < 4) { const float ks = wave_sum(kv[i] * kv[i]) * (1.f / 64.f); p[kcol] = f2b(kv[i] * rsqrtf(ks + NORM_EPS) * kg); } } }
    if (w >= 4) {
        const int g = w & 1; const int scol = ((w < 6) ? 896 : 1152) + g * 64;
        bf16* VT = (bf16*)(F.ws + ((w < 6) ? WS_VST : WS_VWT)) + (size_t)((b * 2 + g) * 64) * T + (size_t)((t0 + lane) >> 5) * 2048 + ((t0 + lane) & 31);
        const v4u* src = (const v4u*)(PNSA + (size_t)(R0 + lane) * 1280 + scol);
        v4u v[8];
#pragma unroll
        for (int i = 0; i < 8; ++i) v[i] = src[i];
#pragma unroll
        for (int i = 0; i < 8; ++i) {
            VT[(8 * i + 0) * 32] = (u16)(v[i].x & 0xffffu); VT[(8 * i + 1) * 32] = (u16)(v[i].x >> 16);
            VT[(8 * i + 2) * 32] = (u16)(v[i].y & 0xffffu); VT[(8 * i + 3) * 32] = (u16)(v[i].y >> 16);
            VT[(8 * i + 4) * 32] = (u16)(v[i].z & 0xffffu); VT[(8 * i + 5) * 32] = (u16)(v[i].z >> 16);
            VT[(8 * i + 6) * 32] = (u16)(v[i].w & 0xffffu); VT[(8 * i + 7) * 32] = (u16)(v[i].w >> 16); }
    }
}
__device__ __forceinline__ float gelu_tanh(float x) { const float t = 0.7978845608028654f * (x + 0.044715f * x * x * x); return 0.5f * x * (1.f + tanhf(t)); }
__device__ __forceinline__ void compress_unit(const Frame& F, int u) {
    const int lane = F.lane, w = F.wave, r16 = lane & 15, q4 = lane >> 4;
    const int kvsel = u >> 7, b = (u >> 5) & 3, g = (u >> 4) & 1, ntile = u & 15;
    const bf16* X = (const bf16*)((unsigned char*)F.out + DO_PNSA) + (size_t)(b * T) * 1280 + (kvsel ? 640 : 512) + g * 64;
    const float* pos = kvsel ? F.in[19] : F.in[18];
    const bf16* W1t = (const bf16*)(F.ws + (kvsel ? WS_CW1V : WS_CW1K));
    const bf16* W2t = (const bf16*)(F.ws + (kvsel ? WS_CW2V : WS_CW2K));
    LAS bf16* hid = (LAS bf16*)(F.lds);
    LAS float* outb = (LAS float*)(F.lds + 16 * 528);
    int n = 16 * ntile + r16; if (n > 254) n = 254;
    f32x4 acc[2] = {{0.f, 0.f, 0.f, 0.f}, {0.f, 0.f, 0.f, 0.f}};
#pragma unroll 4
    for (int s = 0; s < 64; ++s) { const int lp = s >> 1, d0 = (s & 1) * 32 + 8 * q4;
        const v4u xa = *(const v4u*)(X + (size_t)(16 * n + lp) * 1280 + d0);
        const f32x4 p0 = *(const f32x4*)(pos + lp * 64 + d0), p1 = *(const f32x4*)(pos + lp * 64 + d0 + 4);
        v4u af; af.x = pk2(bflo(xa.x) + p0[0], bfhi(xa.x) + p0[1]); af.y = pk2(bflo(xa.y) + p0[2], bfhi(xa.y) + p0[3]);
        af.z = pk2(bflo(xa.z) + p1[0], bfhi(xa.z) + p1[1]); af.w = pk2(bflo(xa.w) + p1[2], bfhi(xa.w) + p1[3]);
#pragma unroll
        for (int nt = 0; nt < 2; ++nt) { const v4u bfg = *(const v4u*)(W1t + (size_t)(32 * w + 16 * nt + r16) * 2048 + 32 * s + 8 * q4);
            acc[nt] = mfma16(as_bf16x8(af), as_bf16x8(bfg), acc[nt]); } }
#pragma unroll
    for (int nt = 0; nt < 2; ++nt)
#pragma unroll
        for (int r = 0; r < 4; ++r) hid[(4 * q4 + r) * 264 + 32 * w + 16 * nt + r16] = f2b(gelu_tanh(acc[nt][r]));
    __syncthreads();
    if (w < 4) { f32x4 a2 = {0.f, 0.f, 0.f, 0.f};
#pragma unroll
        for (int s = 0; s < 8; ++s) { const v4u af = *(const LAS v4u*)(hid + r16 * 264 + 32 * s + 8 * q4);
            const v4u bfg = *(const v4u*)(W2t + (size_t)(16 * w + r16) * 256 + 32 * s + 8 * q4);
            a2 = mfma16(as_bf16x8(af), as_bf16x8(bfg), a2); }
#pragma unroll
        for (int r = 0; r < 4; ++r) outb[(4 * q4 + r) * 64 + 16 * w + r16] = a2[r]; }
    __syncthreads();
#pragma unroll
    for (int rr = 0; rr < 2; ++rr) { const int row = 2 * w + rr; const int nn = 16 * ntile + row; float val = outb[row * 64 + lane];
        if (kvsel == 0) { const float ss = wave_sum(val * val) * (1.f / 64.f); val = val * rsqrtf(ss + NORM_EPS) * F.in[15][lane];
            ((bf16*)(F.ws + WS_KC))[(size_t)((b * 2 + g) * 256 + nn) * 64 + lane] = (nn < 255) ? f2b(val) : (u16)0; }
        else ((bf16*)(F.ws + WS_VCT))[(size_t)((b * 2 + g) * 64 + lane) * 256 + nn] = (nn < 255) ? f2b(val) : (u16)0; }
    __syncthreads();
}
__device__ __forceinline__ bf16x8 pack_p(const f32x4 a, const f32x4 b) {
    v4u w; w.x = pg8::cvt_pk_bf16(a[0], a[1]); w.y = pg8::cvt_pk_bf16(a[2], a[3]); w.z = pg8::cvt_pk_bf16(b[0], b[1]); w.w = pg8::cvt_pk_bf16(b[2], b[3]); return as_bf16x8(w);
}
#define NSA_FENCE() asm volatile("s_waitcnt lgkmcnt(0)" ::: "memory")
struct KFr { bf16x8 a0, a1, b0, b1; };
struct VFr { bf16x8 v[4]; };
__device__ __forceinline__ KFr lds_k(const LAS unsigned char* ks, int r16, int q4) {
    const int rA = 8 * (r16 >> 2) + (r16 & 3), rB = rA + 4; const int xA = (rA >> 1) & 7, xB = (rB >> 1) & 7;
    KFr f; f.a0 = as_bf16x8(*(const LAS v4u*)(ks + rA * 128 + ((q4 ^ xA) << 4))); f.a1 = as_bf16x8(*(const LAS v4u*)(ks + rA * 128 + (((4 + q4) ^ xA) << 4)));
    f.b0 = as_bf16x8(*(const LAS v4u*)(ks + rB * 128 + ((q4 ^ xB) << 4))); f.b1 = as_bf16x8(*(const LAS v4u*)(ks + rB * 128 + (((4 + q4) ^ xB) << 4))); return f;
}
__device__ __forceinline__ VFr lds_v(const LAS unsigned char* vs, int r16, int q4) {
    VFr f;
#pragma unroll
    for (int dt = 0; dt < 4; ++dt) { const int d = 16 * dt + r16; f.v[dt] = as_bf16x8(*(const LAS v4u*)(vs + d * 64 + ((q4 ^ ((d >> 2) & 3)) << 4))); }
    return f;
}
struct NsaSrc { const bf16* kb; int krs; const bf16* vb; int vrs; int vtiled; };
__device__ __forceinline__ v4u nsa_stage_load(const NsaSrc& S, int k0, int tid) {
    if (tid < 256) return *(const v4u*)(S.kb + (size_t)(k0 + (tid >> 3)) * S.krs + 8 * (tid & 7));
    const int i = tid - 256, d = i >> 2, c = i & 3;
    return S.vtiled ? *(const v4u*)(S.vb + (size_t)(k0 >> 5) * 2048 + d * 32 + 8 * c) : *(const v4u*)(S.vb + (size_t)d * S.vrs + k0 + 8 * c);
}
__device__ __forceinline__ void nsa_stage_write(LAS unsigned char* lds, int slot, int tid, const v4u v) {
    if (tid < 256) { const int r = tid >> 3, c = tid & 7; *(LAS v4u*)(lds + slot * 4096 + r * 128 + ((c ^ ((r >> 1) & 7)) << 4)) = v; }
    else { const int i = tid - 256, d = i >> 2, c = i & 3; *(LAS v4u*)(lds + 8192 + slot * 4096 + d * 64 + ((c ^ ((d >> 2) & 3)) << 4)) = v; }
}
__device__ __forceinline__ void nsa_block_unit(const Frame& F, int b, int g, int T0, int skip) {
    const int lane = F.lane, tid = F.tid, w = F.wave, r16 = lane & 15, q4 = lane >> 4;
    const int t0 = T0 + 8 * w;
    const f32x4 Z4 = {0.f, 0.f, 0.f, 0.f};
    LAS unsigned char* lds = F.lds;
    LAS float* wl = (LAS float*)(lds + 16384 + w * 5120);
    LAS float* impT = wl; LAS float* imp2T = wl + 8 * 65; LAS unsigned* selT = (LAS unsigned*)(wl + 16 * 65);
    LAS unsigned* bw = (LAS unsigned*)(lds + 57344); LAS int* stl = (LAS int*)(lds + 57344 + 128);
    const bf16* PN = (const bf16*)((unsigned char*)F.out + DO_PNSA) + (size_t)(b * T) * 1280;
    const float* GL = (const float*)((unsigned char*)F.out + DO_GLOG) + (size_t)(b * T) * 32;
    bf16x8 qf[2][2]; int tq[2];
#pragma unroll
    for (int mt = 0; mt < 2; ++mt) { tq[mt] = t0 + 4 * mt + (r16 >> 2);
#pragma unroll
        for (int dh = 0; dh < 2; ++dh) qf[mt][dh] = as_bf16x8(*(const v4u*)(PN + (size_t)tq[mt] * 1280 + (g * 4 + (r16 & 3)) * 64 + 32 * dh + 8 * q4)); }
    f32x4 Oc[2][4];
#pragma unroll
    for (int mt = 0; mt < 2; ++mt)
#pragma unroll
        for (int dt = 0; dt < 4; ++dt) Oc[mt][dt] = Z4;
#define NSA_GATE(mt_, r_, br_) sigmf(GL[(size_t)(t0 + 4 * (mt_) + q4) * 32 + g * 12 + (r_) * 3 + (br_)])
#define NSA_PIPE_BEGIN(S_, n_, K0_OF) { v4u st = nsa_stage_load(S_, K0_OF(0), tid); nsa_stage_write(lds, 0, tid, st); if ((n_) > 1) st = nsa_stage_load(S_, K0_OF(1), tid); __syncthreads(); \
        for (int i = 0; i < (n_); ++i) { const int k0 = K0_OF(i); const LAS unsigned char* ks = lds + (i & 1) * 4096; const LAS unsigned char* vs = lds + 8192 + (i & 1) * 4096;
#define NSA_PIPE_END(S_, n_, K0_OF) if (i + 1 < (n_)) nsa_stage_write(lds, (i + 1) & 1, tid, st); if (i + 2 < (n_)) st = nsa_stage_load(S_, K0_OF(i + 2), tid); __syncthreads(); } }

    for (int i = lane; i < 16 * 65; i += 64) wl[i] = 0.f;
    const NsaSrc SC{(const bf16*)(F.ws + WS_KC) + (size_t)((b * 2 + g) * 256) * 64, 64, (const bf16*)(F.ws + WS_VCT) + (size_t)((b * 2 + g) * 64) * 256, 256, 0};
    const int ncb = (T0 + 63 >= 31) ? ((T0 + 63 - 31) >> 4) + 1 : 0; const int nstB = (skip & 1) ? 0 : ((ncb + 31) >> 5);
    const int ncw = (t0 + 7 >= 31) ? ((t0 + 7 - 31) >> 4) + 1 : 0; const int nstW = (skip & 1) ? 0 : ((ncw + 31) >> 5);
    float inv[2] = {0.f, 0.f};
#define K0_LIN(i_) (32 * (i_))
    if (nstB > 0) { float ls[2] = {0.f, 0.f};
        NSA_PIPE_BEGIN(SC, nstB, K0_LIN)
            if (i < nstW) { const KFr kf = lds_k(ks, r16, q4); const bool cslow = 16 * (k0 + 31) + 31 > t0;
#pragma unroll
                for (int mt = 0; mt < 2; ++mt) { f32x4 sA = mfma16(kf.a0, qf[mt][0], Z4); sA = mfma16(kf.a1, qf[mt][1], sA); f32x4 sB = mfma16(kf.b0, qf[mt][0], Z4); sB = mfma16(kf.b1, qf[mt][1], sB);
#pragma unroll
                    for (int r = 0; r < 4; ++r) { const int nA = k0 + 8 * q4 + r, nB = nA + 4;
                        if (cslow) { ls[mt] += (16 * nA + 31 <= tq[mt]) ? __builtin_amdgcn_exp2f(sA[r]) : 0.f; ls[mt] += (16 * nB + 31 <= tq[mt]) ? __builtin_amdgcn_exp2f(sB[r]) : 0.f; }
                        else { ls[mt] += __builtin_amdgcn_exp2f(sA[r]); ls[mt] += __builtin_amdgcn_exp2f(sB[r]); } } } }
        NSA_PIPE_END(SC, nstB, K0_LIN)
#pragma unroll
        for (int mt = 0; mt < 2; ++mt) { float l = ls[mt]; l += __shfl_xor(l, 16); l += __shfl_xor(l, 32); inv[mt] = 1.0f / fmaxf(l, 1e-30f); }
    }
    if (nstB > 0) { f32x4 O[2][4];
#pragma unroll
        for (int mt = 0; mt < 2; ++mt)
#pragma unroll
            for (int dt = 0; dt < 4; ++dt) O[mt][dt] = Z4;
        NSA_PIPE_BEGIN(SC, nstB, K0_LIN)
            if (i < nstW) { const KFr kf = lds_k(ks, r16, q4); const VFr vf = lds_v(vs, r16, q4); const bool cslow = 16 * (k0 + 31) + 31 > t0;
#pragma unroll
                for (int mt = 0; mt < 2; ++mt) { f32x4 sA = mfma16(kf.a0, qf[mt][0], Z4); sA = mfma16(kf.a1, qf[mt][1], sA); f32x4 sB = mfma16(kf.b0, qf[mt][0], Z4); sB = mfma16(kf.b1, qf[mt][1], sB);
                    f32x4 pA, pB;
#pragma unroll
                    for (int r = 0; r < 4; ++r) { const int nA = k0 + 8 * q4 + r, nB = nA + 4;
                        if (cslow) { pA[r] = (16 * nA + 31 <= tq[mt]) ? __builtin_amdgcn_exp2f(sA[r]) * inv[mt] : 0.f; pB[r] = (16 * nB + 31 <= tq[mt]) ? __builtin_amdgcn_exp2f(sB[r]) * inv[mt] : 0.f; }
                        else { pA[r] = __builtin_amdgcn_exp2f(sA[r]) * inv[mt]; pB[r] = __builtin_amdgcn_exp2f(sB[r]) * inv[mt]; } }
                    float vA = pA[0] + pA[1] + pA[2] + 0.5f * pA[3], cA = 0.5f * pA[3], vB = pB[0] + pB[1] + pB[2] + 0.5f * pB[3], cB = 0.5f * pB[3];
                    vA += __shfl_xor(vA, 1); vA += __shfl_xor(vA, 2); cA += __shfl_xor(cA, 1); cA += __shfl_xor(cA, 2);
                    vB += __shfl_xor(vB, 1); vB += __shfl_xor(vB, 2); cB += __shfl_xor(cB, 1); cB += __shfl_xor(cB, 2);
                    if ((lane & 3) == 0) { const int tl = 4 * mt + (r16 >> 2), j = (k0 >> 2) + 2 * q4;
                        impT[tl * 65 + j] = vA; imp2T[tl * 65 + j + 1] = cA; impT[tl * 65 + j + 1] = vB; imp2T[tl * 65 + j + 2] = cB; }
                    const bf16x8 pf = pack_p(pA, pB);
#pragma unroll
                    for (int dt = 0; dt < 4; ++dt) O[mt][dt] = mfma16(pf, vf.v[dt], O[mt][dt]); } }
        NSA_PIPE_END(SC, nstB, K0_LIN)
#pragma unroll
        for (int mt = 0; mt < 2; ++mt)
#pragma unroll
            for (int r = 0; r < 4; ++r) { const float gt = NSA_GATE(mt, r, 0);
#pragma unroll
                for (int dt = 0; dt < 4; ++dt) Oc[mt][dt][r] += gt * O[mt][dt][r]; }
    }
    NSA_FENCE();
    const int cur = T0 >> 6;
    unsigned long long uni = 0ull;
    for (int tl = 0; tl < 8; ++tl) {
        unsigned long long mask;
        if (cur < 16 || (skip & 2)) mask = (cur < 16) ? ((2ull << cur) - 1ull) : (0xFFFFull | (1ull << cur) | (1ull << (cur - 1)));
        else {
            const float sc = impT[tl * 65 + lane] + imp2T[tl * 65 + lane];
            const unsigned key = __float_as_uint(fmaxf(sc, 0.f));
            const bool elig = (lane <= cur) && (lane != 0) && (lane != cur) && (lane != cur - 1);
            unsigned prefix = 0u;
            for (int bit = 30; bit >= 0; --bit) { const unsigned cand = prefix | (1u << bit);
                const int cnt = __popcll(__ballot(elig && key >= cand)); if (cnt >= 13) prefix = cand; }
            const unsigned long long gt = __ballot(elig && key > prefix); unsigned long long ties = __ballot(elig && key == prefix);
            int need = 13 - __popcll(gt); unsigned long long keep = 0ull;
            while (need > 0 && ties) { const unsigned long long low = ties & (0ull - ties); keep |= low; ties ^= low; --need; }
            mask = gt | keep | 1ull | (1ull << cur) | (1ull << (cur - 1));
        }
        uni |= mask;
        if (lane == 0) { selT[2 * tl] = (unsigned)mask; selT[2 * tl + 1] = (unsigned)(mask >> 32); }
    }
    if (lane == 0) { bw[2 + 2 * w] = (unsigned)uni; bw[3 + 2 * w] = (unsigned)(uni >> 32); }
    NSA_FENCE();
    unsigned long long mk[2];
#pragma unroll
    for (int mt = 0; mt < 2; ++mt) { const int tl = 4 * mt + (r16 >> 2); mk[mt] = (unsigned long long)selT[2 * tl] | ((unsigned long long)selT[2 * tl + 1] << 32); }
    __syncthreads();
    unsigned long long buni = 0ull;
#pragma unroll
    for (int ww = 0; ww < 8; ++ww) buni |= (unsigned long long)bw[2 + 2 * ww] | ((unsigned long long)bw[3 + 2 * ww] << 32);

#define K0_LIST(i_) (__builtin_amdgcn_readfirstlane(stl[(i_)]))
#pragma unroll 1
    for (int br = 1; br < 3; ++br) { if ((skip >> (br + 1)) & 1) continue;
        const NsaSrc SB{PN + (br == 1 ? 768 : 1024) + g * 64, 1280, (const bf16*)(F.ws + (br == 1 ? WS_VST : WS_VWT)) + (size_t)((b * 2 + g) * 64) * T, 0, 1};
        f32x4 O[2][4]; float ls[2] = {0.f, 0.f};
#pragma unroll
        for (int mt = 0; mt < 2; ++mt)
#pragma unroll
            for (int dt = 0; dt < 4; ++dt) O[mt][dt] = Z4;
        int nsteps;
        if (br == 1) { nsteps = 2 * __popcll(buni);
            if (w == 0 && ((buni >> lane) & 1ull)) { const int rk = __popcll(buni & ((1ull << lane) - 1ull)); stl[2 * rk] = 64 * lane; stl[2 * rk + 1] = 64 * lane + 32; } }
        else { const int lo = T0 - 511; const int klo = (lo > 0 ? lo : 0) & ~31; nsteps = ((T0 + 64 - klo) + 31) >> 5; if (w == 0 && lane < nsteps) stl[lane] = klo + 32 * lane; }
        __syncthreads();
        NSA_PIPE_BEGIN(SB, nsteps, K0_LIST)
            const int j = k0 >> 6;
            const bool mine = (br == 1) ? (((uni >> j) & 1ull) != 0ull) : (k0 + 31 >= t0 - 511 && k0 <= t0 + 7);
            if (mine) { const KFr kf = lds_k(ks, r16, q4); const VFr vf = lds_v(vs, r16, q4);
                const bool slow = (br == 1) ? (j == cur) : (k0 < t0 - 504 || k0 + 31 > t0);
#pragma unroll
                for (int mt = 0; mt < 2; ++mt) { f32x4 ci = Z4;
                    if (br == 1) { const float bias = (((mk[mt] >> j) & 1ull) != 0ull) ? 0.f : -1e30f; ci = (f32x4){bias, bias, bias, bias}; }
                    f32x4 sA = mfma16(kf.a0, qf[mt][0], ci); sA = mfma16(kf.a1, qf[mt][1], sA); f32x4 sB = mfma16(kf.b0, qf[mt][0], ci); sB = mfma16(kf.b1, qf[mt][1], sB);
                    f32x4 pA, pB;
                    if (slow) {
#pragma unroll
                        for (int r = 0; r < 4; ++r) { const int kA = k0 + 8 * q4 + r, kB = kA + 4;
                            const bool mA = (kA <= tq[mt]) && (br == 1 || kA + 512 > tq[mt]), mB = (kB <= tq[mt]) && (br == 1 || kB + 512 > tq[mt]);
                            pA[r] = mA ? __builtin_amdgcn_exp2f(sA[r]) : 0.f; pB[r] = mB ? __builtin_amdgcn_exp2f(sB[r]) : 0.f; }
                    } else {
#pragma unroll
                        for (int r = 0; r < 4; ++r) { pA[r] = __builtin_amdgcn_exp2f(sA[r]); pB[r] = __builtin_amdgcn_exp2f(sB[r]); }
                    }
                    ls[mt] += (pA[0] + pA[1]) + (pA[2] + pA[3]) + (pB[0] + pB[1]) + (pB[2] + pB[3]);
                    const bf16x8 pf = pack_p(pA, pB);
#pragma unroll
                    for (int dt = 0; dt < 4; ++dt) O[mt][dt] = mfma16(pf, vf.v[dt], O[mt][dt]); } }
        NSA_PIPE_END(SB, nsteps, K0_LIST)
#pragma unroll
        for (int mt = 0; mt < 2; ++mt) { float l = ls[mt]; l += __shfl_xor(l, 16); l += __shfl_xor(l, 32); const float il = 1.0f / fmaxf(l, 1e-30f);
#pragma unroll
            for (int r = 0; r < 4; ++r) { const float ilr = __shfl(il, 4 * q4 + r) * NSA_GATE(mt, r, br);
#pragma unroll
                for (int dt = 0; dt < 4; ++dt) Oc[mt][dt][r] += ilr * O[mt][dt][r]; } }
    }
    if (!skip) { bf16* YB = (bf16*)(F.ws + WS_H + 16 * MiB) + (size_t)(b * T) * 512;
#pragma unroll
        for (int mt = 0; mt < 2; ++mt)
#pragma unroll
            for (int r = 0; r < 4; ++r)
#pragma unroll
                for (int dt = 0; dt < 4; ++dt) YB[(size_t)(t0 + 4 * mt + q4) * 512 + (g * 4 + r) * 64 + 16 * dt + r16] = f2b(Oc[mt][dt][r]); }
    __syncthreads();
}
__device__ __forceinline__ void nsa_phase(const Frame& F, int rep) {
    LAS unsigned* bw = (LAS unsigned*)(F.lds + 57344);
    const int q0 = (int)(xb_xcc_id() & 7u);
    for (int qi = 0; qi < 8; ++qi) { const int q = (q0 + qi) & 7;
        for (;;) {
            if (F.tid == 0) bw[0] = __hip_atomic_fetch_add(F.ctl + CW_NSAQ + 64 * (8 * rep + q), 1u, RLX_AGENT);
            __syncthreads();
            const unsigned c = bw[0];
            __syncthreads();
            if (c >= 64u) break;
            nsa_block_unit(F, q >> 1, q & 1, 64 * (63 - (int)c), rep ? NSA_SKIP : 0);
        }
    }
}
typedef short bf16x4 __attribute__((ext_vector_type(4)));
__device__ __forceinline__ f32x4 mfma16k16(const bf16x4 a, const bf16x4 b, const f32x4 c) { const bf16x8 a8 = {a[0], a[1], a[2], a[3], 0, 0, 0, 0}, b8 = {b[0], b[1], b[2], b[3], 0, 0, 0, 0}; return __builtin_amdgcn_mfma_f32_16x16x32_bf16(a8, b8, c, 0, 0, 0); }
__device__ __forceinline__ bf16x4 as_bf16x4(const u32x2 v) { return __builtin_bit_cast(bf16x4, v); }
__device__ __forceinline__ bf16x4 pack4(const f32x4 a) { u32x2 w; w.x = pg8::cvt_pk_bf16(a[0], a[1]); w.y = pg8::cvt_pk_bf16(a[2], a[3]); return as_bf16x4(w); }
__device__ __forceinline__ f32x4 unpk4(const u32x2 w) { f32x4 r; r[0] = bflo(w.x); r[1] = bfhi(w.x); r[2] = bflo(w.y); r[3] = bfhi(w.y); return r; }
struct ChunkIn { v4u kt0, kt1, rt0, rt1; u32x2 ak, nt, mb, mk, vt, bh[4], kh[4]; f32x4 gam[4]; };
__device__ __forceinline__ void scan_load(ChunkIn& c, const unsigned char* rec, int vq, int r16, int q4) {
    c.kt0 = *(const v4u*)(rec + (r16 * 64 + q4 * 8) * 2); c.kt1 = *(const v4u*)(rec + (r16 * 64 + 32 + q4 * 8) * 2);
    c.rt0 = *(const v4u*)(rec + 2048 + (r16 * 64 + q4 * 8) * 2); c.rt1 = *(const v4u*)(rec + 2048 + (r16 * 64 + 32 + q4 * 8) * 2);
#pragma unroll
    for (int mt = 0; mt < 4; ++mt) { c.bh[mt] = *(const u32x2*)(rec + 4096 + ((16 * mt + r16) * 16 + 4 * q4) * 2); c.kh[mt] = *(const u32x2*)(rec + 6144 + ((16 * mt + r16) * 16 + 4 * q4) * 2);
        c.gam[mt] = *(const f32x4*)(rec + 12288 + (16 * mt + 4 * q4) * 4); }
    c.vt = *(const u32x2*)(rec + 8192 + ((16 * vq + r16) * 16 + 4 * q4) * 2);
    c.ak = *(const u32x2*)(rec + 10240 + (r16 * 16 + 4 * q4) * 2); c.nt = *(const u32x2*)(rec + 10752 + (r16 * 16 + 4 * q4) * 2);
    c.mb = *(const u32x2*)(rec + 11264 + (r16 * 16 + 4 * q4) * 2); c.mk = *(const u32x2*)(rec + 11776 + (r16 * 16 + 4 * q4) * 2);
}
__device__ __forceinline__ void scan_chunk(const ChunkIn& cur, f32x4 (&Zt)[4], bf16* Y, int ch, int q4) {
    const f32x4 Z4 = {0.f, 0.f, 0.f, 0.f};
    const bf16x8 zb0 = pack_p(Zt[0], Zt[1]), zb1 = pack_p(Zt[2], Zt[3]);
    f32x4 X = mfma16(as_bf16x8(cur.kt0), zb0, Z4); X = mfma16(as_bf16x8(cur.kt1), zb1, X);
    f32x4 Yc = mfma16(as_bf16x8(cur.rt0), zb0, Z4); Yc = mfma16(as_bf16x8(cur.rt1), zb1, Yc);
    const bf16x4 vt = as_bf16x4(cur.vt);
    const f32x4 W = mfma16k16(as_bf16x4(cur.ak), vt, X);
    const f32x4 U = mfma16k16(as_bf16x4(cur.nt), pack4(W), Z4);
    const bf16x4 ub = pack4(U);
    Yc = mfma16k16(as_bf16x4(cur.mk), vt, Yc); Yc = mfma16k16(as_bf16x4(cur.mb), ub, Yc);
#pragma unroll
    for (int mt = 0; mt < 4; ++mt) { f32x4 acc = mfma16k16(as_bf16x4(cur.kh[mt]), vt, Zt[mt]); acc = mfma16k16(as_bf16x4(cur.bh[mt]), ub, acc); Zt[mt] = acc * cur.gam[mt]; }
#pragma unroll
    for (int r = 0; r < 4; ++r) Y[(size_t)(16 * ch + 4 * q4 + r) * 512] = f2b(Yc[r]);
}
__device__ __forceinline__ void rwkv_scan_wave(const Frame& F, int bh, int vq) {
    const int lane = F.lane, r16 = lane & 15, q4 = lane >> 4, b = bh >> 3, h = bh & 7;
    const f32x4 Z4 = {0.f, 0.f, 0.f, 0.f};
    const unsigned char* recb = F.ws + WS_PRW + (size_t)(b * T) * 7168 + h * REC_BYTES;
    bf16* Y = (bf16*)(F.ws + WS_H) + (size_t)(b * T) * 512 + h * 64 + 16 * vq + r16;
    f32x4 Zt[4] = {Z4, Z4, Z4, Z4};
    ChunkIn A, B;
    constexpr size_t CS = 16 * 7168;
    scan_load(A, recb, vq, r16, q4);
    for (int ch = 0; ch < T / 16; ch += 2) {
        if (vq == 0 && lane == 0) __hip_atomic_store(F.ctl + CW_SCANP + 64 * bh, (unsigned)ch, RLX_AGENT);
        scan_load(B, recb + (size_t)(ch + 1) * CS, vq, r16, q4);
        scan_chunk(A, Zt, Y, ch, q4);
        scan_load(A, recb + (size_t)((ch + 2 < T / 16) ? ch + 2 : ch) * CS, vq, r16, q4);
        scan_chunk(B, Zt, Y, ch + 1, q4);
    }
}
__device__ __forceinline__ void rwkv_scan_prefetch(const Frame& F, int bh) {
    const int lane = F.lane, b = bh >> 3, h = bh & 7;
    const unsigned char* recb = F.ws + WS_PRW + (size_t)(b * T) * 7168 + h * REC_BYTES;
    const int o0 = 128 * lane, o1 = 128 * (lane < 35 ? 64 + lane : 98);
    unsigned dmy = 0u, pa[4] = {0u, 0u, 0u, 0u}, pb[4] = {0u, 0u, 0u, 0u};
    for (int c4 = 0; c4 < T / 16; c4 += 4) {
#pragma unroll
        for (int k = 0; k < 4; ++k) { const int ch = c4 + k;
            for (int spin = 0; spin < (1 << 16); ++spin) { const int prog = (int)__hip_atomic_load(F.ctl + CW_SCANP + 64 * bh, RLX_AGENT); if (ch <= prog + 8) break; __builtin_amdgcn_s_sleep(8); }
            const unsigned char* rec = recb + (size_t)ch * (16 * 7168);
            dmy ^= pa[k] ^ pb[k];
            pa[k] = *(const volatile unsigned*)(rec + o0); pb[k] = *(const volatile unsigned*)(rec + o1); }
    }
    dmy ^= pa[0] ^ pb[0] ^ pa[1] ^ pb[1] ^ pa[2] ^ pb[2] ^ pa[3] ^ pb[3];
    if (lane == 0) F.MISC[17] = dmy;
}
__device__ __forceinline__ void rwkv_epilogue(const Frame& F) {
    const int lane = F.lane; const int gw = F.vcu * NWAVES + F.wave, NGW = F.G * NWAVES;
    const unsigned char* prw = F.ws + WS_PRW; const bf16* G = (const bf16*)((unsigned char*)F.out + DO_G); bf16* YA = (bf16*)(F.ws + WS_H);
    for (int idx = gw; idx < (M / 16) * 8; idx += NGW) { const int bt = idx >> 3, h = idx & 7, c = h * 64 + lane;
        const unsigned char* rec = prw + (size_t)(16 * bt) * 7168 + h * REC_BYTES;
        const v4u* vp = (const v4u*)(rec + 8192 + lane * 32); const v4u v0 = vp[0], v1 = vp[1];
        const float lw = F.in[12][c], lb = F.in[13][c];
        float yv[16], gv[16], bo[16];
#pragma unroll
        for (int s = 0; s < 16; ++s) { const size_t o = (size_t)(16 * bt + s) * 512 + c; yv[s] = bf2f(YA[o]); gv[s] = bf2f(G[o]); bo[s] = *(const float*)(rec + 12544 + 4 * s); }
#pragma unroll
        for (int s = 0; s < 16; ++s) { const unsigned vw = (s < 8) ? v0[s >> 1] : v1[(s - 8) >> 1]; const float vv = (s & 1) ? bfhi(vw) : bflo(vw);
            const float y = yv[s]; const float mean = wave_sum(y) * (1.f / 64.f); const float d = y - mean; const float var = wave_sum(d * d) * (1.f / 64.f);
            const float yn = d * rsqrtf(var + GN_EPS) * lw + lb;
            YA[(size_t)(16 * bt + s) * 512 + c] = f2b((yn + bo[s] * vv) * gv[s]); }
    }
}
__device__ __forceinline__ unsigned sortable(float x) { const unsigned u = __float_as_uint(x); return (u & 0x80000000u) ? ~u : (u | 0x80000000u); }
__device__ __forceinline__ float unsortable(unsigned k) { const unsigned u = (k & 0x80000000u) ? (k & 0x7fffffffu) : ~k; return __uint_as_float(u); }
#define TK_INSERT(L, key_) do { unsigned k_ = (key_); _Pragma("unroll") for (int s_ = 0; s_ < 16; ++s_) { const unsigned hi_ = L[s_] > k_ ? L[s_] : k_; k_ = L[s_] > k_ ? k_ : L[s_]; L[s_] = hi_; } } while (0)
__device__ __forceinline__ void peer_topk_pass(const Frame& F, int wp, LAS float* sc) {
    const int lane = F.lane, r16 = lane & 15, q4 = lane >> 4;
    const bf16* QRY = (const bf16*)(F.ws + WS_PRW);
    int* EID = (int*)(F.ws + WS_PRW + 64 * MiB); float* EG = (float*)(F.ws + WS_PRW + 72 * MiB);
    const int row = lane & 31, part = lane >> 5;
    unsigned L1[16], L2[16];
#pragma unroll
    for (int half = 0; half < 2; ++half) {
        const bf16* SK = (const bf16*)(F.ws + (half ? WS_SK2 : WS_SK1));
#pragma unroll
        for (int mt = 0; mt < 2; ++mt) { const int rho = 32 * wp + 16 * mt + r16;
            const bf16* qp = QRY + (size_t)(rho >> 3) * 2048 + (rho & 7) * 256 + half * 128 + 8 * q4;
            bf16x8 af[4];
#pragma unroll
            for (int s = 0; s < 4; ++s) af[s] = as_bf16x8(*(const v4u*)(qp + 32 * s));
#pragma unroll
            for (int kt = 0; kt < 8; ++kt) { f32x4 acc = {0.f, 0.f, 0.f, 0.f};
#pragma unroll
                for (int s = 0; s < 4; ++s) acc = mfma16(af[s], as_bf16x8(*(const v4u*)(SK + (size_t)(16 * kt + r16) * 128 + 32 * s + 8 * q4)), acc);
#pragma unroll
                for (int r = 0; r < 4; ++r) { const int rw = 16 * mt + 4 * q4 + r; sc[rw * 128 + ((16 * kt + r16) ^ rw)] = acc[r]; } } }
        NSA_FENCE();
        unsigned Ls[16];
#pragma unroll
        for (int s = 0; s < 16; ++s) Ls[s] = 0u;
#pragma unroll 4
        for (int i = 0; i < 64; ++i) { const int c = 64 * part + i; const float x = sc[row * 128 + (c ^ row)];
            TK_INSERT(Ls, (sortable(x) & ~0x7Fu) | (unsigned)(127 - c)); }
        unsigned Lo[16];
#pragma unroll
        for (int s = 0; s < 16; ++s) Lo[s] = (unsigned)__shfl_xor((int)Ls[s], 32);
#pragma unroll
        for (int s = 0; s < 16; ++s) TK_INSERT(Ls, Lo[s]);
#pragma unroll
        for (int s = 0; s < 16; ++s) { if (half == 0) L1[s] = Ls[s]; else L2[s] = Ls[s]; }
        NSA_FENCE();
    }
    float v1[16], v2[16];
#pragma unroll
    for (int s = 0; s < 16; ++s) { v1[s] = unsortable(L1[s]); v2[s] = unsortable(L2[s]); }
    unsigned C[16];
#pragma unroll
    for (int s = 0; s < 16; ++s) C[s] = 0u;
#pragma unroll
    for (int i = 0; i < 16; ++i)
#pragma unroll
        for (int j = 0; j < 16; ++j) if ((i + 1) * (j + 1) <= 16) { TK_INSERT(C, (sortable(v1[i] + v2[j]) & ~0xFFu) | (unsigned)(255 - (16 * i + j))); }
    LAS unsigned* il = (LAS unsigned*)sc;
    if (part == 0) {
#pragma unroll
        for (int s = 0; s < 16; ++s) { il[row * 33 + s] = 127u - (L1[s] & 127u); il[row * 33 + 16 + s] = 127u - (L2[s] & 127u); }
    }
    NSA_FENCE();
    if (part == 0) { const int rho = 32 * wp + row;
        float val[16], e[16]; float sum = 0.f;
#pragma unroll
        for (int s = 0; s < 16; ++s) val[s] = unsortable(C[s]);
#pragma unroll
        for (int s = 0; s < 16; ++s) { e[s] = __expf(val[s] - val[0]); sum += e[s]; }
        const float is = 1.0f / sum;
#pragma unroll
        for (int s = 0; s < 16; ++s) { const unsigned pos = 255u - (C[s] & 255u); const unsigned i = pos >> 4, j = pos & 15u;
            EID[(size_t)rho * 16 + s] = (int)(il[row * 33 + i] * 128u + il[row * 33 + 16 + j]); EG[(size_t)rho * 16 + s] = e[s] * is; }
    }
    NSA_FENCE();
}
typedef float f32x2_t __attribute__((ext_vector_type(2)));
constexpr float PEER_SCALE = 256.0f, PEER_ISCALE = 1.0f / 256.0f;
__device__ __forceinline__ void peer_convert_one(const Frame& F, const float* srcf, unsigned char* dstb) {
    const int gt = F.vcu * (NWAVES * 64) + F.tid, NT = F.G * NWAVES * 64;
    const f32x4* src = (const f32x4*)srcf; v4u* dst = (v4u*)dstb;
    for (int i = gt; i < 16384 * 1024 / 16; i += NT) { v4u o;
#pragma unroll
        for (int q = 0; q < 4; ++q) { const f32x4 a = src[4 * i + q] * PEER_SCALE; int w = __builtin_amdgcn_cvt_pk_fp8_f32(a[0], a[1], 0, false); w = __builtin_amdgcn_cvt_pk_fp8_f32(a[2], a[3], w, true); o[q] = (unsigned)w; }
        dst[i] = o; }
}
__device__ __forceinline__ void peer_convert_tables(const Frame& F) { peer_convert_one(F, F.in[31], F.ws + WS_MG); peer_convert_one(F, F.in[32], F.ws + WS_MG + 16 * MiB); }
__device__ __forceinline__ float sum8(float x) { x += dppf<0xB1>(x); x += dppf<0x4E>(x); x += dppf<0x141>(x); return x; }
template <int PHASE> __device__ __forceinline__ void peer_slice_unit(const Frame& F, int s, int tg) {
    const int lane = F.lane, j = lane & 7, gbase = lane & ~7;
    const bf16* H2 = (const bf16*)(F.ws + WS_H);
    const int* EID = (const int*)(F.ws + WS_PRW + 64 * MiB);
    float* PART = (float*)(F.ws + WS_PRW) + (size_t)s * M * 128; const float* CACT = (const float*)(F.ws + WS_PRW + 80 * MiB);
    const unsigned char* TB = F.ws + WS_MG + (PHASE == 0 ? 0 : 16 * MiB) + 128 * s + 16 * j;
#pragma unroll 1
    for (int it = 0; it < 8; ++it) { const int tk = 64 * tg + 8 * it + (lane >> 3);
        int ids[16]; float hv[16], acc[16];
        { const v4u* ip = (const v4u*)(EID + (size_t)tk * 128 + 16 * j);
#pragma unroll
          for (int q = 0; q < 4; ++q) { const v4u w = ip[q]; ids[4 * q] = (int)w.x; ids[4 * q + 1] = (int)w.y; ids[4 * q + 2] = (int)w.z; ids[4 * q + 3] = (int)w.w; } }
        if (PHASE == 0) { const v4u h0 = *(const v4u*)(H2 + (size_t)tk * D + 128 * s + 16 * j), h1 = *(const v4u*)(H2 + (size_t)tk * D + 128 * s + 16 * j + 8);
#pragma unroll
            for (int q = 0; q < 4; ++q) { hv[2 * q] = bflo(h0[q]); hv[2 * q + 1] = bfhi(h0[q]); hv[8 + 2 * q] = bflo(h1[q]); hv[8 + 2 * q + 1] = bfhi(h1[q]); } }
        else { const f32x4* cp = (const f32x4*)(CACT + (size_t)tk * 128 + 16 * j);
#pragma unroll
            for (int q = 0; q < 4; ++q) { const f32x4 c = cp[q]; hv[4 * q] = c[0]; hv[4 * q + 1] = c[1]; hv[4 * q + 2] = c[2]; hv[4 * q + 3] = c[3]; } }
#pragma unroll
        for (int m = 0; m < 16; ++m) acc[m] = 0.f;
#pragma unroll 1
        for (int jj = 0; jj < 8; ++jj) { const int src = (gbase + jj) * 4;
            v4u tv[16];
#pragma unroll
            for (int m = 0; m < 16; ++m) { const int id = __builtin_amdgcn_ds_bpermute(src, ids[m]); tv[m] = *(const v4u*)(TB + (size_t)id * 1024); }
#pragma unroll
            for (int m = 0; m < 16; ++m) {
                float f[16];
#pragma unroll
                for (int q = 0; q < 4; ++q) { const f32x2_t lo = __builtin_amdgcn_cvt_pk_f32_fp8((int)tv[m][q], false), hi = __builtin_amdgcn_cvt_pk_f32_fp8((int)tv[m][q], true); f[4 * q] = lo.x; f[4 * q + 1] = lo.y; f[4 * q + 2] = hi.x; f[4 * q + 3] = hi.y; }
                if (PHASE == 0) { float d0 = 0.f, d1 = 0.f;
#pragma unroll
                    for (int q = 0; q < 8; ++q) { d0 += hv[2 * q] * f[2 * q]; d1 += hv[2 * q + 1] * f[2 * q + 1]; }
                    const float d = sum8(d0 + d1); acc[m] = (j == jj) ? d : acc[m]; }
                else { const float c = __builtin_bit_cast(float, __builtin_amdgcn_ds_bpermute(src, __builtin_bit_cast(int, hv[m])));
#pragma unroll
                    for (int q = 0; q < 16; ++q) acc[q] += c * f[q]; } }
        }
        if (PHASE == 0) { f32x4* pp = (f32x4*)(PART + (size_t)tk * 128 + 16 * j);
#pragma unroll
            for (int q = 0; q < 4; ++q) pp[q] = (f32x4){acc[4 * q], acc[4 * q + 1], acc[4 * q + 2], acc[4 * q + 3]}; }
        else { f32x4* op = (f32x4*)(F.out + (size_t)tk * D + 128 * s + 16 * j);
#pragma unroll
            for (int q = 0; q < 4; ++q) { f32x4 a = op[q]; a[0] += acc[4 * q] * PEER_ISCALE; a[1] += acc[4 * q + 1] * PEER_ISCALE; a[2] += acc[4 * q + 2] * PEER_ISCALE; a[3] += acc[4 * q + 3] * PEER_ISCALE; op[q] = a; } }
    }
}
template <int PHASE> __device__ __forceinline__ void peer_slice_phase(const Frame& F, int rep) {
    const int q0 = (int)(xb_xcc_id() & 7u);
    for (int qi = 0; qi < 8; ++qi) { const int q = (q0 + qi) & 7;
        for (;;) { unsigned c = 0;
            if (F.lane == 0) c = __hip_atomic_fetch_add(F.ctl + CW_PEERQ + 64 * (16 * rep + 8 * PHASE + q), 1u, RLX_AGENT);
            c = (unsigned)__builtin_amdgcn_readfirstlane((int)c);
            if (c >= 256u) break;
            peer_slice_unit<PHASE>(F, q, (int)c); } }
}
__device__ __forceinline__ void peer_act_phase(const Frame& F) {
    const int gt = F.vcu * (NWAVES * 64) + F.tid, NT = F.G * NWAVES * 64;
    const float* PART = (const float*)(F.ws + WS_PRW); const float* EG = (const float*)(F.ws + WS_PRW + 72 * MiB); float* CACT = (float*)(F.ws + WS_PRW + 80 * MiB);
    for (int i = gt; i < M * 128 / 4; i += NT) { f32x4 d = {0.f, 0.f, 0.f, 0.f};
#pragma unroll
        for (int s = 0; s < 8; ++s) d += ((const f32x4*)PART)[(size_t)s * (M * 128 / 4) + i];
        const f32x4 g = ((const f32x4*)EG)[i]; f32x4 c;
#pragma unroll
        for (int e = 0; e < 4; ++e) { const float dt = d[e] * PEER_ISCALE; c[e] = g[e] * 0.5f * dt * (1.f + erff(dt * 0.70710678118654752f)); }
        ((f32x4*)CACT)[i] = c; }
}
struct Args { const float* in[33]; float* out; unsigned char* ws; int ph_lo, ph_hi; };
__global__ void __launch_bounds__(NWAVES * 64, 2) mk_fwd(Args args) {
    extern __shared__ __attribute__((aligned(16))) unsigned char lds[];
    Frame F;
    F.lds = (LAS unsigned char*)lds;
    F.MISC = (volatile LAS unsigned*)(F.lds + MISC_OFF);
    F.tid = threadIdx.x; F.lane = F.tid & 63; F.wave = __builtin_amdgcn_readfirstlane(F.tid >> 6);
    F.G = gridDim.x; { const int bx = blockIdx.x; F.vcu = (F.G % 8 == 0) ? (bx % 8) * (F.G / 8) + bx / 8 : bx; }
    unsigned char* ws = args.ws; F.ws = ws; F.out = args.out;
    F.ctl = (gu32*)(ws + WS_CTL);
#pragma unroll
    for (int i = 0; i < 33; ++i) F.in[i] = args.in[i];
    for (int u = F.tid; u < (LDS_BYTES - LDSCTL_OFF) / 4; u += NWAVES * 64) ((LAS unsigned*)(F.lds + LDSCTL_OFF))[u] = 0u;
    __syncthreads();
    const int lo = args.ph_lo, hi = args.ph_hi & 0xff; const int rep = args.ph_hi >> 8;
    const bool multi = (hi - lo) > 1;
    XcdBarrier bar; bar.bar = (unsigned*)(F.ctl + CW_BAR); bar.x = 0; bar.st = nullptr;
    if (multi) bar = xcd_barrier_post((unsigned*)(F.ctl + CW_BAR), F.MISC + 8);
#define IN(k) (lo <= (k) && (k) < hi)
#define NREP(k) ((((repmask) >> (k)) & 1) + 1)
#define REPBAR() do { if (rep) xcd_barrier(bar); } while (0)
#define SEAM(k) do { if (IN(k) && IN((k) + 1)) xcd_barrier(bar); } while (0)

    if (IN(0)) { { p0_prologue(F); } } SEAM(0);
    if (IN(1)) { {
        pg8::Gemm g{(const pg8::bf16_t*)(ws + WS_H), (const pg8::bf16_t*)(ws + WS_WIN), M, NG1, D}; pg8::StaticOrder S; S.init(M, NG1, F.G, (int)blockIdx.x);
        pg8::EpiG1 E{(float*)(ws + WS_PRW), (float*)(ws + WS_BND), (pg8::bf16_t*)((unsigned char*)F.out + DO_PNSA), (pg8::bf16_t*)(ws + WS_MG), (float*)((unsigned char*)F.out + DO_GLOG)};
        pg8::gemm_phase<pg8::EpiG1, pg8::StaticOrder, true, true>(F.lds + RING_OFF, g, S, E);
    } } SEAM(1);
    if (IN(2)) {
        for (int u = F.vcu; u < 256; u += F.G) nsa_prep_tile(F, u);
        for (int u = F.vcu; u < 256; u += F.G) compress_unit(F, u);
        for (int u = F.vcu; u < 256; u += F.G) rwkv_prep_tile(F, u);
    } SEAM(2);
    if (IN(3)) { {
        if ((int)blockIdx.x < 32 && !(rep && P3REP == 3)) { if (F.wave < 4) rwkv_scan_wave(F, (int)blockIdx.x, F.wave); else if (F.wave == 4) rwkv_scan_prefetch(F, (int)blockIdx.x); __syncthreads(); }
        if (!(rep && P3REP == 2)) nsa_phase(F, rep);
    } } SEAM(3);
    if (IN(4)) { { rwkv_epilogue(F); } } SEAM(4);
    if (IN(5)) { {
        { pg8::Gemm g{(const pg8::bf16_t*)(ws + WS_H), (const pg8::bf16_t*)(ws + WS_WA), M, D, 512}; pg8::StaticOrder S; S.init(M, D, F.G, (int)blockIdx.x);
          pg8::EpiGate1 E{(float*)(ws + WS_PRW), (const pg8::bf16_t*)(ws + WS_MG), 0};
          pg8::gemm_phase<pg8::EpiGate1, pg8::StaticOrder, true, true>(F.lds + RING_OFF, g, S, E); }
        VM_WAIT(); __syncthreads();
        { pg8::Gemm g{(const pg8::bf16_t*)(ws + WS_H + 16 * MiB), (const pg8::bf16_t*)(ws + WS_WB), M, D, 512}; pg8::StaticOrder S; S.init(M, D, F.G, (int)blockIdx.x);
          pg8::EpiGate2 E{(const float*)(ws + WS_PRW), (const pg8::bf16_t*)(ws + WS_MG), 1024, (pg8::bf16_t*)(ws + WS_PRW + 64 * MiB)};
          pg8::gemm_phase<pg8::EpiGate2, pg8::StaticOrder, true, true>(F.lds + RING_OFF, g, S, E); }
    } } SEAM(5);
    if (IN(6)) { {
        pg8::Gemm g{(const pg8::bf16_t*)(ws + WS_PRW + 64 * MiB), (const pg8::bf16_t*)(ws + WS_WOUT), M, D, D}; pg8::StaticOrder S; S.init(M, D, F.G, (int)blockIdx.x);
        pg8::EpiRes E{F.in[0], F.out};
        pg8::gemm_phase<pg8::EpiRes, pg8::StaticOrder, true, true>(F.lds + RING_OFF, g, S, E);
    } } SEAM(6);
    if (IN(7)) { { const int gw = F.vcu * NWAVES + F.wave, NGW = F.G * NWAVES;
        for (int m = gw; m < M; m += NGW) rms_row_to_bf16(F.lane, F.out + (size_t)m * D, F.in[27], (bf16*)(ws + WS_H) + (size_t)m * D);
        peer_convert_tables(F);
    } } SEAM(7);
    if (IN(8)) { {
        pg8::Gemm g{(const pg8::bf16_t*)(ws + WS_H), (const pg8::bf16_t*)(ws + WS_WQ), M, 2048, D}; pg8::StaticOrder S; S.init(M, 2048, F.G, (int)blockIdx.x);
        pg8::EpiBf16<0> E{(pg8::bf16_t*)(ws + WS_PRW), 2048, nullptr, 0, 0, 1.f};
        pg8::gemm_phase<pg8::EpiBf16<0>, pg8::StaticOrder, true, true>(F.lds + RING_OFF, g, S, E);
    } } SEAM(8);
    if (IN(9)) { { const int gw = F.vcu * NWAVES + F.wave, NGW = F.G * NWAVES; LAS float* sc = (LAS float*)(F.lds + F.wave * 16384);
        for (int wp = gw; wp < M * 8 / 32; wp += NGW) peer_topk_pass(F, wp, sc);
    } } SEAM(9);
    if (IN(10)) { peer_slice_phase<0>(F, rep); } SEAM(10);
    if (IN(11)) { peer_act_phase(F); } SEAM(11);
    if (IN(12)) { peer_slice_phase<1>(F, rep); }
    if (DBG_SEL >= 0 && multi) { xcd_barrier(bar); if (blockIdx.x == 0 && F.tid == 0) { const float* dbg = (const float*)(ws + WS_KC + 524288); F.out[0] += (DBG_SEL == 0) ? (0.05f + 0.1f * dbg[0]) : (0.05f + dbg[1] * 1e-7f); } }
#undef IN
#undef SEAM
}

extern "C" void kernel_launch(void* const* d_in, const int* in_sizes, int n_in, void* d_out, int out_size, void* d_ws, size_t ws_size, hipStream_t stream) {
    static int grid = 0;
    if (grid == 0) {
        if (n_in != 33 || out_size != M * D || ws_size < WS_END) { fprintf(stderr, "kernel_launch: unexpected shapes (n_in %d out %d ws %zu)\n", n_in, out_size, ws_size); grid = -1; return; }
        int dev = 0, cus = 0, per_cu = 0;
        if (hipGetDevice(&dev) != hipSuccess || hipDeviceGetAttribute(&cus, hipDeviceAttributeMultiprocessorCount, dev) != hipSuccess) { grid = -1; return; }
        if (hipFuncSetAttribute((const void*)mk_fwd, hipFuncAttributeMaxDynamicSharedMemorySize, LDS_BYTES) != hipSuccess) { fprintf(stderr, "kernel_launch: hipFuncSetAttribute failed\n"); grid = -1; return; }
        if (hipOccupancyMaxActiveBlocksPerMultiprocessor(&per_cu, (const void*)mk_fwd, NWAVES * 64, LDS_BYTES) != hipSuccess || per_cu < 1)
            fprintf(stderr, "kernel_launch: occupancy query reports %d blocks per CU\n", per_cu);
        (void)hipGetLastError();
        grid = cus;
        if (grid > 256) grid = 256;
    }
    if (grid < 0) return;
    if (hipMemsetAsync((char*)d_ws + WS_CTL, 0, CTL_ZERO_BYTES, stream) != hipSuccess) return;
    Args a{};
    for (int i = 0; i < 33; ++i) a.in[i] = (const float*)d_in[i];
    a.out = (float*)d_out; a.ws = (unsigned char*)d_ws;
#if MK_ONE_LAUNCH
    a.ph_lo = 0; a.ph_hi = N_PHASES;
    hipLaunchKernelGGL(mk_fwd, dim3(grid), dim3(NWAVES * 64), LDS_BYTES, stream, a);
#else
    for (int p = 0; p < N_PHASES; ++p) { for (int r = 0; r <= (((REP_MASK) >> p) & 1); ++r) { a.ph_lo = p; a.ph_hi = (p + 1) | (r << 8); hipLaunchKernelGGL(mk_fwd, dim3(grid), dim3(NWAVES * 64), LDS_BYTES, stream, a); } }
#endif
}
```

```cpp
#include <hip/hip_runtime.h>
#include <cstdio>
#include <cstdint>
#define MK_ONE_LAUNCH 1
#define REP_MASK 0
#define P3REP 1
#define NSA_SKIP 0
#define DBG_SEL -1
namespace pg8 {
#define PG8_LAS __attribute__((address_space(3)))
typedef unsigned short bf16_t;
typedef short bf16x8 __attribute__((ext_vector_type(8)));
typedef float f32x4 __attribute__((ext_vector_type(4)));
typedef unsigned u32x4 __attribute__((ext_vector_type(4)));
constexpr int BM = 256, BK = 64, HALF = 128, HTB = HALF * BK * 2  , STAGE_BYTES = 8 * HTB, NXCD = 8, WGM = 8;

__host__ __device__ __forceinline__ int lds_byte(int r, int c) { const int st = (r >> 4) * 2 + (c >> 5), rr = r & 15, cc = c & 31, ob = rr * 64 + cc * 2; return st * 1024 + (ob ^ (((ob >> 9) & 1) << 5)); }
__host__ __device__ __forceinline__ void stage_rc(int b, int& R, int& C) { const int st = b / 1024, sb = b % 1024, swz = sb ^ (((sb >> 9) & 1) << 5); R = (st >> 1) * 16 + swz / 64; C = (st & 1) * 32 + (swz % 64) / 2; }
__host__ __device__ __forceinline__ int perm32(int rho) { const int n = rho >> 4, i = rho & 15; return 8 * (i >> 2) + 4 * n + (i & 3); }

struct Unit { int pm, pn; };
struct Gemm { const bf16_t* A; const bf16_t* Bt; int M, N, K; };

struct StaticOrder {
    int nM, nN, nwg, G, c;
    __host__ __device__ void init(int M, int N, int G_, int c_) { nM = M / BM; nN = N / BM; nwg = nM * nN; G = G_; c = c_; }
    __host__ __device__ bool next(int i, Unit& u) const {
        const long L = (long)i * G + c; if (L >= nwg) return false;
        int wgid = (int)L; { const int q = nwg / NXCD, r = nwg % NXCD, xcd = wgid % NXCD, off = wgid / NXCD; wgid = (xcd < r ? xcd * (q + 1) : r * (q + 1) + (xcd - r) * q) + off; }
        const int nig = WGM * nN, gid = wgid / nig, fm = gid * WGM, gsz = (nM - fm) < WGM ? (nM - fm) : WGM;
        u.pm = fm + ((wgid % nig) % gsz); u.pn = (wgid % nig) / gsz; return true;
    }
    __device__ __forceinline__ void a_ready(const Unit&) const {}
    __device__ __forceinline__ void done(const Unit&) const {}
};

typedef float f32x2c __attribute__((ext_vector_type(2))); typedef __bf16 bf16x2c __attribute__((ext_vector_type(2)));
__device__ __forceinline__ unsigned cvt_pk_bf16(float lo, float hi) { const f32x2c v = {lo, hi}; const bf16x2c b = __builtin_convertvector(v, bf16x2c); return __builtin_bit_cast(unsigned, b); }
typedef float f32x2 __attribute__((ext_vector_type(2)));
__device__ __forceinline__ f32x2 gelu_pk(f32x2 v) {
    const f32x2 av = __builtin_elementwise_abs(v), d = av * 0.2316418882f + 1.0f;
    f32x2 t; t.x = __builtin_amdgcn_rcpf(d.x); t.y = __builtin_amdgcn_rcpf(d.y);
    f32x2 q = t * 0.5307027145f + (-0.7265760135f); q = q * t + 0.7107068705f; q = q * t + (-0.142248368f); q = q * t + 0.127414796f; q = q * t;
    const f32x2 s = (v * v) * (-0.72134752044f);
    f32x2 e; e.x = __builtin_amdgcn_exp2f(s.x); e.y = __builtin_amdgcn_exp2f(s.y);
    const f32x2 m = v * (q * e), r = v - m;
    f32x2 o; o.x = v.x < 0.f ? m.x : r.x; o.y = v.y < 0.f ? m.y : r.y; return o;
}

template <int ACT  > struct EpiBf16 {
    static constexpr bool PERM = true, AFTER_DRAIN = false; static_assert(ACT == 0 || ACT == 1, "EpiBf16: ACT is 0 (none) or 1 (gelu_pk)");
    bf16_t* O; int ldc; const float* bias; int split_cols; size_t split_stride; float scale0;
    __device__ __forceinline__ void operator()(const f32x4 (&acc)[2][2][4][2], const Unit& u, int wr, int wc, int fr, int fq) const {
        const int row0 = u.pm * BM + wr * 64 + fr; int colt = u.pn * BM; bf16_t* base = O;
        float sc = 1.f; if (split_cols) { const int t = colt / split_cols; base += (size_t)t * split_stride; colt -= t * split_cols; if (t == 0) sc = scale0; }
        const int col0 = colt + wc * 32 + 8 * fq, bcol0 = u.pn * BM + wc * 32 + 8 * fq;
        f32x4 bv[2][2];
#pragma unroll
        for (int bj = 0; bj < 2; ++bj)
#pragma unroll
            for (int n = 0; n < 2; ++n) bv[bj][n] = bias ? *(const f32x4*)(bias + bcol0 + bj * HALF + 4 * n) : (f32x4){0.f, 0.f, 0.f, 0.f};
#pragma unroll
        for (int ai = 0; ai < 2; ++ai)
#pragma unroll
            for (int m = 0; m < 4; ++m) { bf16_t* rowp = base + (size_t)(row0 + ai * HALF + m * 16) * ldc + col0;
#pragma unroll
                for (int bj = 0; bj < 2; ++bj) { f32x4 v0 = acc[ai][bj][m][0] + bv[bj][0], v1 = acc[ai][bj][m][1] + bv[bj][1];
                    if (ACT == 1) { f32x2 a = gelu_pk((f32x2){v0[0], v0[1]}), b = gelu_pk((f32x2){v0[2], v0[3]}), c = gelu_pk((f32x2){v1[0], v1[1]}), d = gelu_pk((f32x2){v1[2], v1[3]});
                        v0 = (f32x4){a.x, a.y, b.x, b.y}; v1 = (f32x4){c.x, c.y, d.x, d.y}; }
                    v0 = v0 * sc; v1 = v1 * sc; u32x4 w; w.x = cvt_pk_bf16(v0[0], v0[1]); w.y = cvt_pk_bf16(v0[2], v0[3]); w.z = cvt_pk_bf16(v1[0], v1[1]); w.w = cvt_pk_bf16(v1[2], v1[3]);
                    *(u32x4*)(rowp + bj * HALF) = w; } }
    }
};
__device__ __forceinline__ float bf_lo(unsigned w) { return __uint_as_float(w << 16); }
__device__ __forceinline__ float bf_hi(unsigned w) { return __uint_as_float(w & 0xffff0000u); }
__device__ __forceinline__ float sigm(float x) { return __builtin_amdgcn_rcpf(1.0f + __expf(-x)); }
__device__ __forceinline__ u32x4 pack8(const f32x4 v0, const f32x4 v1) { u32x4 w; w.x = cvt_pk_bf16(v0[0], v0[1]); w.y = cvt_pk_bf16(v0[2], v0[3]); w.z = cvt_pk_bf16(v1[0], v1[1]); w.w = cvt_pk_bf16(v1[2], v1[3]); return w; }

struct EpiG1 {
    static constexpr bool PERM = true, AFTER_DRAIN = false;
    float* PRW; float* BND; bf16_t* PNSA; bf16_t* MG; float* GLOG;
    __device__ __forceinline__ void operator()(const f32x4 (&acc)[2][2][4][2], const Unit& u, int wr, int wc, int fr, int fq) const {
        const int row0 = u.pm * BM + wr * 64 + fr, c0 = wc * 32 + 8 * fq;
#pragma unroll
        for (int ai = 0; ai < 2; ++ai)
#pragma unroll
            for (int m = 0; m < 4; ++m) { const int row = row0 + ai * HALF + m * 16;
#pragma unroll
                for (int bj = 0; bj < 2; ++bj) { const f32x4 v0 = acc[ai][bj][m][0], v1 = acc[ai][bj][m][1]; const int col = c0 + bj * HALF;
                    if (u.pn < 7) { float* p = PRW + (size_t)row * 1792 + u.pn * 256 + col; *(f32x4*)p = v0; *(f32x4*)(p + 4) = v1;
                        if ((row & 63) == 63) { float* q = BND + (size_t)(row >> 6) * 1792 + u.pn * 256 + col; *(f32x4*)q = v0; *(f32x4*)(q + 4) = v1; } }
                    else if (u.pn < 12) { *(u32x4*)(PNSA + (size_t)row * 1280 + (u.pn - 7) * 256 + col) = pack8(v0, v1); }
                    else if (u.pn < 20) { *(u32x4*)(MG + (size_t)row * 2048 + (u.pn - 12) * 256 + col) = pack8(v0, v1); }
                    else { if (col < 32) { float* p = GLOG + (size_t)row * 32 + col; *(f32x4*)p = v0; *(f32x4*)(p + 4) = v1; } }
                } }
    }
};
struct EpiGate1 {
    static constexpr bool PERM = true, AFTER_DRAIN = false;
    float* T1; const bf16_t* MG; int goff;
    __device__ __forceinline__ void operator()(const f32x4 (&acc)[2][2][4][2], const Unit& u, int wr, int wc, int fr, int fq) const {
        const int row0 = u.pm * BM + wr * 64 + fr, c0 = u.pn * BM + wc * 32 + 8 * fq;
#pragma unroll
        for (int ai = 0; ai < 2; ++ai)
#pragma unroll
            for (int m = 0; m < 4; ++m) { const int row = row0 + ai * HALF + m * 16;
#pragma unroll
                for (int bj = 0; bj < 2; ++bj) { const f32x4 v0 = acc[ai][bj][m][0], v1 = acc[ai][bj][m][1]; const int col = c0 + bj * HALF;
                    const u32x4 g = *(const u32x4*)(MG + (size_t)row * 2048 + goff + col);
                    f32x4 o0, o1; o0[0] = sigm(bf_lo(g.x)) * v0[0]; o0[1] = sigm(bf_hi(g.x)) * v0[1]; o0[2] = sigm(bf_lo(g.y)) * v0[2]; o0[3] = sigm(bf_hi(g.y)) * v0[3];
                    o1[0] = sigm(bf_lo(g.z)) * v1[0]; o1[1] = sigm(bf_hi(g.z)) * v1[1]; o1[2] = sigm(bf_lo(g.w)) * v1[2]; o1[3] = sigm(bf_hi(g.w)) * v1[3];
                    float* p = T1 + (size_t)row * 1024 + col; *(f32x4*)p = o0; *(f32x4*)(p + 4) = o1; } }
    }
};
struct EpiGate2 {
    static constexpr bool PERM = true, AFTER_DRAIN = false;
    const float* T1; const bf16_t* MG; int goff; bf16_t* MIX;
    __device__ __forceinline__ void operator()(const f32x4 (&acc)[2][2][4][2], const Unit& u, int wr, int wc, int fr, int fq) const {
        const int row0 = u.pm * BM + wr * 64 + fr, c0 = u.pn * BM + wc * 32 + 8 * fq;
#pragma unroll
        for (int ai = 0; ai < 2; ++ai)
#pragma unroll
            for (int m = 0; m < 4; ++m) { const int row = row0 + ai * HALF + m * 16;
#pragma unroll
                for (int bj = 0; bj < 2; ++bj) { const f32x4 v0 = acc[ai][bj][m][0], v1 = acc[ai][bj][m][1]; const int col = c0 + bj * HALF;
                    const u32x4 g = *(const u32x4*)(MG + (size_t)row * 2048 + goff + col);
                    const float* p = T1 + (size_t)row * 1024 + col; const f32x4 t0 = *(const f32x4*)p, t1 = *(const f32x4*)(p + 4);
                    f32x4 o0, o1; o0[0] = t0[0] + sigm(bf_lo(g.x)) * v0[0]; o0[1] = t0[1] + sigm(bf_hi(g.x)) * v0[1]; o0[2] = t0[2] + sigm(bf_lo(g.y)) * v0[2]; o0[3] = t0[3] + sigm(bf_hi(g.y)) * v0[3];
                    o1[0] = t1[0] + sigm(bf_lo(g.z)) * v1[0]; o1[1] = t1[1] + sigm(bf_hi(g.z)) * v1[1]; o1[2] = t1[2] + sigm(bf_lo(g.w)) * v1[2]; o1[3] = t1[3] + sigm(bf_hi(g.w)) * v1[3];
                    *(u32x4*)(MIX + (size_t)row * 1024 + col) = pack8(o0, o1); } }
    }
};
struct EpiRes {
    static constexpr bool PERM = true, AFTER_DRAIN = false;
    const float* X; float* OUT;
    __device__ __forceinline__ void operator()(const f32x4 (&acc)[2][2][4][2], const Unit& u, int wr, int wc, int fr, int fq) const {
        const int row0 = u.pm * BM + wr * 64 + fr, c0 = u.pn * BM + wc * 32 + 8 * fq;
#pragma unroll
        for (int ai = 0; ai < 2; ++ai)
#pragma unroll
            for (int m = 0; m < 4; ++m) { const int row = row0 + ai * HALF + m * 16;
#pragma unroll
                for (int bj = 0; bj < 2; ++bj) { const size_t off = (size_t)row * 1024 + c0 + bj * HALF;
                    const f32x4 x0 = *(const f32x4*)(X + off), x1 = *(const f32x4*)(X + off + 4);
                    *(f32x4*)(OUT + off) = x0 + acc[ai][bj][m][0]; *(f32x4*)(OUT + off + 4) = x1 + acc[ai][bj][m][1]; } }
    }
};
template <class Epi, class Sched, bool ALIGN_EPI = false, bool SP2 = false>
__device__ __forceinline__ void gemm_phase(PG8_LAS unsigned char* lds, const Gemm g, const Sched& S, const Epi& E) {
    const int tid = threadIdx.x, wid = __builtin_amdgcn_readfirstlane(tid >> 6), lane = tid & 63, wr = wid >> 2, wc = wid & 3, fr = lane & 15, fq = lane >> 4;
    const int K = g.K, nt = K / BK;
    unsigned voffA[2], voffB[2];
#pragma unroll
    for (int i = 0; i < 2; ++i) { int R, C; stage_rc(tid * 16 + i * 8192, R, C); const int Rb = Epi::PERM ? ((R & ~31) + perm32(R & 31)) : R;
        voffA[i] = (unsigned)(R * K + C) * 2u; voffB[i] = (unsigned)(Rb * K + C) * 2u; }
    const size_t kstep = (size_t)(BK * 2);
    const size_t hstep = (size_t)HALF * K * 2;
    const size_t tstep = 2 * hstep;
    const unsigned ldsw = (unsigned)wid * 1024u;
    const int aoff = lds_byte(wr * 64 + fr, fq * 8), boff = lds_byte(wc * 32 + fr, fq * 8);
#define PG8_SA(b, h) (((b) * 2 + (h)) * HTB)
#define PG8_SB(b, h) ((4 + (b) * 2 + (h)) * HTB)
#define PG8_STAGE(bufoff, gbase, voff) do { _Pragma("unroll") for (int _i = 0; _i < 2; ++_i) \
        __builtin_amdgcn_global_load_lds((const unsigned*)((const char*)(gbase) + (voff)[_i]), (PG8_LAS unsigned*)(lds + (bufoff) + ldsw + _i * 8192), 16, 0, 0); } while (0)
#define PG8_LDA(dst, b, h) do { _Pragma("unroll") for (int m = 0; m < 4; ++m) _Pragma("unroll") for (int k = 0; k < 2; ++k) dst[m][k] = *(const PG8_LAS bf16x8*)(lds + PG8_SA(b, h) + aoff + m * 2048 + k * 1024); } while (0)
#define PG8_LDB(dst, b, h) do { _Pragma("unroll") for (int n = 0; n < 2; ++n) _Pragma("unroll") for (int k = 0; k < 2; ++k) dst[n][k] = *(const PG8_LAS bf16x8*)(lds + PG8_SB(b, h) + boff + n * 2048 + k * 1024); } while (0)
#define PG8_MMA(ai, bj, At, Bt) do { __builtin_amdgcn_s_setprio(1); _Pragma("unroll") for (int m = 0; m < 4; ++m) _Pragma("unroll") for (int n = 0; n < 2; ++n) _Pragma("unroll") for (int k = 0; k < 2; ++k) \
        acc[ai][bj][m][n] = __builtin_amdgcn_mfma_f32_16x16x32_bf16(Bt[n][k], At[m][k], acc[ai][bj][m][n], 0, 0, 0); __builtin_amdgcn_s_setprio(0); } while (0)
#define PG8_WAIT_V(n) asm volatile("s_waitcnt vmcnt(" #n ")" ::: "memory")
#define PG8_WAIT_L(n) asm volatile("s_waitcnt lgkmcnt(" #n ")" ::: "memory")
#define PG8_BAR __builtin_amdgcn_s_barrier()
#define PG8_SCHED __builtin_amdgcn_sched_barrier(0)
    Unit cur, nxt; int ui = 0;
    if (!S.next(0, cur)) return;
    f32x4 acc[2][2][4][2];
#pragma unroll
    for (int a = 0; a < 2; ++a)
#pragma unroll
        for (int b = 0; b < 2; ++b)
#pragma unroll
            for (int m = 0; m < 4; ++m)
#pragma unroll
                for (int n = 0; n < 2; ++n) acc[a][b][m][n] = (f32x4){0.f, 0.f, 0.f, 0.f};
    bf16x8 At[4][2], B0[2][2], B1[2][2];
    const char* cA = (const char*)g.A + (size_t)cur.pm * tstep; const char* cB = (const char*)g.Bt + (size_t)cur.pn * tstep;
    S.a_ready(cur);
    if constexpr (SP2) {
        PG8_STAGE(PG8_SB(0, 0), cB, voffB); PG8_STAGE(PG8_SB(0, 1), cB + hstep, voffB); PG8_STAGE(PG8_SA(0, 0), cA, voffA); PG8_STAGE(PG8_SA(0, 1), cA + hstep, voffA);
        if (wr == 1) PG8_BAR;
        PG8_WAIT_V(2); PG8_BAR;
        PG8_STAGE(PG8_SB(1, 0), cB + kstep, voffB); PG8_STAGE(PG8_SA(1, 0), cA + kstep, voffA); PG8_STAGE(PG8_SB(1, 1), cB + hstep + kstep, voffB);
        PG8_WAIT_V(6); PG8_BAR;
    } else {
        PG8_STAGE(PG8_SB(0, 0), cB, voffB); PG8_STAGE(PG8_SA(0, 0), cA, voffA); PG8_STAGE(PG8_SB(0, 1), cB + hstep, voffB); PG8_STAGE(PG8_SA(0, 1), cA + hstep, voffA);
        if (wr == 1) PG8_BAR;
        PG8_WAIT_V(4); PG8_BAR;
        PG8_STAGE(PG8_SB(1, 0), cB + kstep, voffB); PG8_STAGE(PG8_SA(1, 0), cA + kstep, voffA); PG8_STAGE(PG8_SB(1, 1), cB + hstep + kstep, voffB);
        PG8_WAIT_V(6); PG8_BAR;
    }
    for (;;) {
        const bool has_next = S.next(ui + 1, nxt);
        const char* nA = has_next ? (const char*)g.A + (size_t)nxt.pm * tstep : cA; const char* nB = has_next ? (const char*)g.Bt + (size_t)nxt.pn * tstep : cB;
        for (int t = 0; t < nt; t += 2) {
            const bool last = (t == nt - 2);
            const char* a1 = cA + (size_t)(t + 1) * kstep;
            const char* a2 = last ? nA : cA + (size_t)(t + 2) * kstep; const char* b2 = last ? nB : cB + (size_t)(t + 2) * kstep;
            const char* a3 = a2 + kstep; const char* b3 = b2 + kstep;
            if (last && has_next) S.a_ready(nxt);
            if constexpr (SP2) {
            PG8_LDB(B0, 0, 0); PG8_LDB(B1, 0, 1); PG8_SCHED; PG8_LDA(At, 0, 0); PG8_STAGE(PG8_SA(1, 1), a1 + hstep, voffA);
            PG8_WAIT_V(8); PG8_WAIT_L(0); PG8_BAR; PG8_MMA(0, 0, At, B0); PG8_MMA(0, 1, At, B1); PG8_BAR; PG8_SCHED;
            PG8_LDA(At, 0, 1); PG8_STAGE(PG8_SB(0, 0), b2, voffB); PG8_STAGE(PG8_SB(0, 1), b2 + hstep, voffB); PG8_STAGE(PG8_SA(0, 0), a2, voffA);
            PG8_WAIT_V(8); PG8_WAIT_L(0); PG8_BAR; PG8_MMA(1, 0, At, B0); PG8_MMA(1, 1, At, B1); PG8_BAR; PG8_SCHED;
            PG8_LDB(B0, 1, 0); PG8_LDB(B1, 1, 1); PG8_SCHED; PG8_LDA(At, 1, 0); PG8_STAGE(PG8_SA(0, 1), a2 + hstep, voffA);
            PG8_WAIT_V(8); PG8_WAIT_L(0); PG8_BAR; PG8_MMA(0, 0, At, B0); PG8_MMA(0, 1, At, B1); PG8_BAR; PG8_SCHED;
            PG8_LDA(At, 1, 1); PG8_STAGE(PG8_SB(1, 0), b3, voffB); PG8_STAGE(PG8_SB(1, 1), b3 + hstep, voffB); PG8_STAGE(PG8_SA(1, 0), a3, voffA);
            PG8_WAIT_V(8); PG8_WAIT_L(0); PG8_BAR; PG8_MMA(1, 0, At, B0); PG8_MMA(1, 1, At, B1); PG8_BAR; PG8_SCHED;
            } else {
            PG8_LDB(B0, 0, 0); PG8_SCHED; PG8_LDA(At, 0, 0); PG8_STAGE(PG8_SA(1, 1), a1 + hstep, voffA);
            PG8_WAIT_L(8); PG8_BAR; PG8_WAIT_L(0); PG8_MMA(0, 0, At, B0); PG8_BAR; PG8_SCHED;
            PG8_LDB(B1, 0, 1); PG8_STAGE(PG8_SB(0, 0), b2, voffB);
            PG8_BAR; PG8_WAIT_L(0); PG8_MMA(0, 1, At, B1); PG8_BAR;
            PG8_LDA(At, 0, 1); PG8_STAGE(PG8_SA(0, 0), a2, voffA);
            PG8_BAR; PG8_WAIT_L(0); PG8_MMA(1, 0, At, B0); PG8_BAR; PG8_SCHED;
            PG8_STAGE(PG8_SB(0, 1), b2 + hstep, voffB);
            PG8_WAIT_V(6); PG8_BAR; PG8_MMA(1, 1, At, B1); PG8_BAR;
            PG8_LDB(B0, 1, 0); PG8_SCHED; PG8_LDA(At, 1, 0); PG8_STAGE(PG8_SA(0, 1), a2 + hstep, voffA);
            PG8_WAIT_L(8); PG8_BAR; PG8_WAIT_L(0); PG8_MMA(0, 0, At, B0); PG8_BAR; PG8_SCHED;
            PG8_LDB(B1, 1, 1); PG8_STAGE(PG8_SB(1, 0), b3, voffB);
            PG8_BAR; PG8_WAIT_L(0); PG8_MMA(0, 1, At, B1); PG8_BAR;
            PG8_LDA(At, 1, 1); PG8_STAGE(PG8_SA(1, 0), a3, voffA);
            PG8_BAR; PG8_WAIT_L(0); PG8_MMA(1, 0, At, B0); PG8_BAR; PG8_SCHED;
            PG8_STAGE(PG8_SB(1, 1), b3 + hstep, voffB);
            PG8_WAIT_V(6); PG8_BAR; PG8_MMA(1, 1, At, B1); PG8_BAR;
            }
        }
        if constexpr (ALIGN_EPI) { if (wr == 0) PG8_BAR; }
        if constexpr (!Epi::AFTER_DRAIN) { E(acc, cur, wr, wc, fr, fq); S.done(cur); }
        if (!has_next) break;
#pragma unroll
        for (int a = 0; a < 2; ++a)
#pragma unroll
            for (int b = 0; b < 2; ++b)
#pragma unroll
                for (int m = 0; m < 4; ++m)
#pragma unroll
                    for (int n = 0; n < 2; ++n) acc[a][b][m][n] = (f32x4){0.f, 0.f, 0.f, 0.f};
        cur = nxt; cA = nA; cB = nB; ++ui;
        if constexpr (ALIGN_EPI) { if (wr == 1) PG8_BAR; }
    }
    PG8_WAIT_V(0);
    if constexpr (!ALIGN_EPI) { if (wr == 0) PG8_BAR; }
    PG8_BAR;
    if constexpr (Epi::AFTER_DRAIN) { E.fused(acc, cur, wr, wc, fr, fq, lds, wid, lane); S.done(cur); }
#undef PG8_SA
#undef PG8_SB
#undef PG8_STAGE
#undef PG8_LDA
#undef PG8_LDB
#undef PG8_MMA
#undef PG8_WAIT_V
#undef PG8_WAIT_L
#undef PG8_BAR
#undef PG8_SCHED
}
}
#define GAS __attribute__((address_space(1)))
#define LAS __attribute__((address_space(3)))
typedef unsigned short bf16;
typedef unsigned v4u __attribute__((ext_vector_type(4)));
typedef float f32x4 __attribute__((ext_vector_type(4)));
typedef short bf16x8 __attribute__((ext_vector_type(8)));
typedef GAS unsigned gu32;
typedef GAS unsigned long long gu64;
#define RLX_AGENT __ATOMIC_RELAXED, __HIP_MEMORY_SCOPE_AGENT
#define LDS_WAIT() asm volatile("s_waitcnt lgkmcnt(0)" ::: "memory")
#define VM_WAIT() asm volatile("s_waitcnt vmcnt(0)" ::: "memory")
__device__ __forceinline__ unsigned long long rt() { return __builtin_amdgcn_s_memrealtime(); }
__device__ __forceinline__ unsigned f2bf(float f) { unsigned u = __builtin_bit_cast(unsigned, f); return (u + 0x7fffu + ((u >> 16) & 1u)) >> 16; }
__device__ __forceinline__ unsigned pk2(float lo, float hi) { return f2bf(lo) | (f2bf(hi) << 16); }

#define XB_TMO      128
#define XB_XCNT(j)  (256  + 64 * (j))
#define XB_XSUB(j)  (1280 + 64 * (j))
#define XB_XGEN(j)  (2304 + 64 * (j))
#define XB_TOP      3328
#define XB_TOPGEN   3392
#define XCD_BAR_WORDS 3456
#define XB_SPIN_CAP (1u << 18)

__device__ __forceinline__ unsigned xb_ld(unsigned* p)              { return __hip_atomic_load(p, __ATOMIC_RELAXED, __HIP_MEMORY_SCOPE_AGENT); }
__device__ __forceinline__ unsigned xb_add(unsigned* p, unsigned v) { return __hip_atomic_fetch_add(p, v, __ATOMIC_RELAXED, __HIP_MEMORY_SCOPE_AGENT); }
__device__ __forceinline__ unsigned xb_xcc_id() { return (unsigned)__builtin_amdgcn_s_getreg((3 << 11) | 20) & 0xFu; }
#define XB_SPIN(cond, bar) do { unsigned _sp = 0; while (cond) { __builtin_amdgcn_s_sleep(1); \
    if ((++_sp & 255u) == 0u) { if (xb_ld(&(bar)[XB_TMO])) break; if (_sp > XB_SPIN_CAP) { atomicAdd(&(bar)[XB_TMO], 1u); break; } } } } while (0)

struct XcdBarrier {
    unsigned* bar; unsigned x;
    volatile LAS unsigned* st;
};

__device__ __forceinline__ XcdBarrier xcd_barrier_post(unsigned* bar, volatile LAS unsigned* st) {
    XcdBarrier b; b.bar = bar; b.x = xb_xcc_id(); b.st = st;
    if (threadIdx.x == 0) (void)xb_add(&bar[XB_XCNT(b.x)], 1u);
    return b;
}
__device__ __forceinline__ void xcd_barrier_complete(unsigned* bar, unsigned x, unsigned& nloc, unsigned& nx) {
    const unsigned G = gridDim.x * gridDim.y * gridDim.z;
    unsigned sum, cnt, mine, sp = 0u;
    for (;;) {
        sum = 0u; cnt = 0u; mine = 0u;
#pragma unroll
        for (unsigned j = 0; j < 16; ++j) { const unsigned c = xb_ld(&bar[XB_XCNT(j)]); sum += c; cnt += (c > 0u) ? 1u : 0u; mine = (j == x) ? c : mine; }
        if (sum == G) break;
        __builtin_amdgcn_s_sleep(1);
        if ((++sp & 255u) == 0u) { if (xb_ld(&bar[XB_TMO])) break; if (sp > XB_SPIN_CAP) { atomicAdd(&bar[XB_TMO], 1u); break; } }
    }
    nloc = mine > 0u ? mine : 1u; nx = cnt > 0u ? cnt : 1u;
}

__device__ __forceinline__ void xcd_barrier(const XcdBarrier& b) {
    asm volatile("s_waitcnt vmcnt(0)" ::: "memory");
    __syncthreads();
    if (threadIdx.x == 0) {
        unsigned* bar = b.bar;
        __builtin_amdgcn_s_waitcnt(0);
        unsigned nloc = b.st[0], nx = b.st[1];
        if (nloc == 0u) { xcd_barrier_complete(bar, b.x, nloc, nx); b.st[0] = nloc; b.st[1] = nx; }
        const unsigned old = xb_add(&bar[XB_XSUB(b.x)], 1u);
        const unsigned gen = old / nloc;
        if (old + 1u == (gen + 1u) * nloc) {
            __builtin_amdgcn_fence(__ATOMIC_RELEASE, "agent");
            asm volatile("s_waitcnt vmcnt(0)" ::: "memory");
            const unsigned og = xb_add(&bar[XB_TOP], 1u);
            const unsigned tg = og / nx;
            if (og + 1u == (tg + 1u) * nx) xb_add(&bar[XB_TOPGEN], 1u);
            else XB_SPIN(xb_ld(&bar[XB_TOPGEN]) == tg, bar);
            __builtin_amdgcn_fence(__ATOMIC_ACQUIRE, "agent");
            xb_add(&bar[XB_XGEN(b.x)], 1u);
            asm volatile("s_waitcnt vmcnt(0)" ::: "memory");
        } else {
            XB_SPIN(xb_ld(&bar[XB_XGEN(b.x)]) == gen, bar);
            __builtin_amdgcn_fence(__ATOMIC_ACQUIRE, "agent");
            asm volatile("s_waitcnt vmcnt(0)" ::: "memory");
        }
    }
    __syncthreads();
}
constexpr int NWAVES = 8;
constexpr int BATCH = 4, T = 4096, D = 1024, M = BATCH * T;
constexpr int RWC = 1792;
constexpr int NG1 = 5376;
constexpr float NORM_EPS = 1e-6f, GN_EPS = 64e-5f;
constexpr float LOG2E = 1.4426950408889634f;
constexpr int N_PHASES = 13;
#ifndef MK_ONE_LAUNCH
#define MK_ONE_LAUNCH 0
#endif
#ifndef REP_MASK
#define REP_MASK 0
#endif
#ifndef DBG_SEL
#define DBG_SEL -1
#endif
#ifndef NSA_SKIP
#define NSA_SKIP 0
#endif
#ifndef P3REP
#define P3REP 1
#endif
#ifndef SCAN_BLOCKS
#define SCAN_BLOCKS 128
#endif

constexpr size_t MiB = 1u << 20;
constexpr size_t WS_CTL = 0, CTL_ZERO_BYTES = 1 * MiB;
constexpr size_t WS_WIN = 1 * MiB;
constexpr size_t WS_WA = 12 * MiB, WS_WB = 13 * MiB;
constexpr size_t WS_WOUT = 14 * MiB;
constexpr size_t WS_WQ = 16 * MiB;
constexpr size_t WS_CW1K = 20 * MiB, WS_CW1V = 21 * MiB;
constexpr size_t WS_CW2K = 22 * MiB, WS_CW2V = 22 * MiB + 65536;
constexpr size_t WS_SK1 = 22 * MiB + 131072, WS_SK2 = 22 * MiB + 196608;
constexpr size_t WS_BND = 23 * MiB;
constexpr size_t WS_KC = 25 * MiB;
constexpr size_t WS_VCT = 25 * MiB + 262144;
constexpr size_t WS_H = 26 * MiB;
constexpr size_t WS_PRW = 58 * MiB;
constexpr size_t WS_MG = 170 * MiB;
constexpr size_t WS_VST = 234 * MiB, WS_VWT = 238 * MiB;
constexpr size_t WS_END = 256 * MiB;
constexpr size_t DO_PNSA = 0, DO_G = 40 * MiB, DO_GLOG = 56 * MiB;
constexpr int CW_TMO = 0, CW_CODE = 1, CW_NSAQ = 64, CW_SCANP = 2048, CW_PEERQ = 4160, CW_BAR = 8192;

constexpr int RING_OFF = 0, RING_BYTES = 131072;
constexpr int LDSCTL_OFF = RING_BYTES, MISC_OFF = LDSCTL_OFF + 320;
constexpr int LDS_BYTES = 147456;
typedef unsigned short u16;
typedef unsigned u32x2 __attribute__((ext_vector_type(2)));
struct Frame {
    LAS unsigned char* lds;
    volatile LAS unsigned* MISC;
    gu32* ctl;
    int tid, lane, wave, vcu, G;
    const float* in[33];
    float* out; unsigned char* ws;
};
__device__ __forceinline__ float wave_sum(float v) {
#pragma unroll
    for (int o = 1; o < 64; o <<= 1) v += __shfl_xor(v, o);
    return v;
}
template <int CTRL> __device__ __forceinline__ float dppf(float x) { return __builtin_bit_cast(float, __builtin_amdgcn_update_dpp(0, __builtin_bit_cast(int, x), CTRL, 0xf, 0xf, true)); }
__device__ __forceinline__ float bf2f(u16 b) { return __uint_as_float((unsigned)b << 16); }
__device__ __forceinline__ float bflo(unsigned w) { return __uint_as_float(w << 16); }
__device__ __forceinline__ float bfhi(unsigned w) { return __uint_as_float(w & 0xffff0000u); }
__device__ __forceinline__ u16 f2b(float f) { return (u16)pg8::cvt_pk_bf16(f, 0.f); }
#define pk2(lo_, hi_) pg8::cvt_pk_bf16((lo_), (hi_))
__device__ __forceinline__ float sigmf(float x) { return __builtin_amdgcn_rcpf(1.0f + __expf(-x)); }
__device__ __forceinline__ float tanh_fast(float x) { return 1.0f - 2.0f * __builtin_amdgcn_rcpf(1.0f + __expf(2.0f * x)); }
__device__ __forceinline__ f32x4 mfma16(const bf16x8 a, const bf16x8 b, const f32x4 c) { return __builtin_amdgcn_mfma_f32_16x16x32_bf16(a, b, c, 0, 0, 0); }
__device__ __forceinline__ bf16x8 as_bf16x8(const v4u v) { return __builtin_bit_cast(bf16x8, v); }

__device__ __forceinline__ void tr_item(const float* W, int K, int ldw, int sc0, int nblk, int ncols_valid, bf16* WT, int dr0, LAS float* scr, int item, int lane) {
    const int kb = item / nblk, nb = item % nblk, k0 = 64 * kb, n0 = 32 * nb;
#pragma unroll 8
    for (int i = 0; i < 32; ++i) { const int kk = 2 * i + (lane >> 5); const int n = n0 + (lane & 31);
        scr[kk * 33 + (lane & 31)] = (n < ncols_valid) ? W[(size_t)(k0 + kk) * ldw + sc0 + n] : 0.f; }
    LDS_WAIT(); asm volatile("" ::: "memory");
    const int c = lane & 7;
#pragma unroll
    for (int j = 0; j < 4; ++j) { const int n = (lane >> 3) + 8 * j; const LAS float* s = scr + (8 * c) * 33 + n;
        v4u o; o.x = pk2(s[0 * 33], s[1 * 33]); o.y = pk2(s[2 * 33], s[3 * 33]); o.z = pk2(s[4 * 33], s[5 * 33]); o.w = pk2(s[6 * 33], s[7 * 33]);
        *(GAS v4u*)(WT + (size_t)(dr0 + n0 + n) * K + k0 + 8 * c) = o; }
    LDS_WAIT(); asm volatile("" ::: "memory");
}
__device__ __forceinline__ void rms_row_to_bf16(int lane, const float* xrow, const float* gain, bf16* orow) {
    const GAS f32x4* xr = (const GAS f32x4*)xrow + lane; const GAS f32x4* gr = (const GAS f32x4*)gain + lane;
    f32x4 v[4]; float s2 = 0.f;
#pragma unroll
    for (int j = 0; j < 4; ++j) { v[j] = xr[64 * j]; s2 += (v[j].x * v[j].x + v[j].y * v[j].y) + (v[j].z * v[j].z + v[j].w * v[j].w); }
    const float rstd = 1.f / sqrtf(wave_sum(s2) * (1.f / D) + NORM_EPS);
    GAS unsigned long long* o8 = (GAS unsigned long long*)orow + lane;
#pragma unroll
    for (int j = 0; j < 4; ++j) { const f32x4 g = gr[64 * j];
        o8[64 * j] = (unsigned long long)pk2(v[j].x * rstd * g.x, v[j].y * rstd * g.y) | ((unsigned long long)pk2(v[j].z * rstd * g.z, v[j].w * rstd * g.w) << 32); }
}
__device__ __forceinline__ void p0_prologue(const Frame& F) {
    LAS float* scr = (LAS float*)(F.lds + RING_OFF + F.wave * 16384);
    const int gw = F.vcu * NWAVES + F.wave, NGW = F.G * NWAVES;
    unsigned char* ws = F.ws;
    constexpr int I0 = 16 * 96, I1 = 16 * 64, I2 = 16 * 8, I3 = 8 * 32, I4 = 8 * 32, I5 = 16 * 32, I6 = 16 * 64, I7 = 32 * 8, I8 = 32 * 8, I9 = 4 * 2, I10 = 4 * 2;
    constexpr int NITEMS = I0 + I1 + I2 + I3 + I4 + I5 + I6 + I7 + I8 + I9 + I10;
    for (int it = gw; it < NITEMS; it += NGW) {
        int r = it;
        if (r < I0) { tr_item(F.in[2], 1024, 5144, 0, 96, 3072, (bf16*)(ws + WS_WIN), 0, scr, r, F.lane); continue; } r -= I0;
        if (r < I1) { tr_item(F.in[2], 1024, 5144, 3096, 64, 2048, (bf16*)(ws + WS_WIN), 3072, scr, r, F.lane); continue; } r -= I1;
        if (r < I2) { tr_item(F.in[2], 1024, 5144, 3072, 8, 24, (bf16*)(ws + WS_WIN), 5120, scr, r, F.lane); continue; } r -= I2;
        if (r < I3) { tr_item(F.in[24], 512, 1024, 0, 32, 1024, (bf16*)(ws + WS_WA), 0, scr, r, F.lane); continue; } r -= I3;
        if (r < I4) { tr_item(F.in[25], 512, 1024, 0, 32, 1024, (bf16*)(ws + WS_WB), 0, scr, r, F.lane); continue; } r -= I4;
        if (r < I5) { tr_item(F.in[26], 1024, 1024, 0, 32, 1024, (bf16*)(ws + WS_WOUT), 0, scr, r, F.lane); continue; } r -= I5;
        if (r < I6) { tr_item(F.in[28], 1024, 2048, 0, 64, 2048, (bf16*)(ws + WS_WQ), 0, scr, r, F.lane); continue; } r -= I6;
        if (r < I7) { tr_item(F.in[20], 2048, 256, 0, 8, 256, (bf16*)(ws + WS_CW1K), 0, scr, r, F.lane); continue; } r -= I7;
        if (r < I8) { tr_item(F.in[22], 2048, 256, 0, 8, 256, (bf16*)(ws + WS_CW1V), 0, scr, r, F.lane); continue; } r -= I8;
        if (r < I9) { tr_item(F.in[21], 256, 64, 0, 2, 64, (bf16*)(ws + WS_CW2K), 0, scr, r, F.lane); continue; } r -= I9;
        tr_item(F.in[23], 256, 64, 0, 2, 64, (bf16*)(ws + WS_CW2V), 0, scr, r, F.lane);
    }
    { const int gt = F.vcu * (NWAVES * 64) + F.tid, NT = F.G * NWAVES * 64;
      bf16* s1 = (bf16*)(ws + WS_SK1); bf16* s2 = (bf16*)(ws + WS_SK2);
      for (int i = gt; i < 128 * 128; i += NT) { s1[i] = f2b(F.in[29][i]); s2[i] = f2b(F.in[30][i]); } }
    for (int m = gw; m < M; m += NGW) rms_row_to_bf16(F.lane, F.in[0] + (size_t)m * D, F.in[1], (bf16*)(ws + WS_H) + (size_t)m * D);
}
constexpr int REC_BYTES = 12800;
__device__ __forceinline__ void rwkv_prep_tile(const Frame& F, int u) {
    const int tid = F.tid, lane = F.lane, h = F.wave, r16 = lane & 15, q4 = lane >> 4;
    const int R0 = 64 * u, t0 = R0 & (T - 1);
    LAS float* lin = (LAS float*)(F.lds);
    LAS bf16* mats = (LAS bf16*)(F.lds + 16384) + h * 4096;
    LAS float* abl = (LAS float*)(F.lds + 16384 + 65536) + h * 272;
    float* PRW = (float*)(F.ws + WS_PRW);
    const float* BND = (const float*)(F.ws + WS_BND);
    bf16* G = (bf16*)((unsigned char*)F.out + DO_G);
    const float* mu = F.in[3];
    const float mu_r = mu[tid], mu_k = mu[512 + tid], mu_v = mu[1024 + tid], mu_l = (tid < 256) ? mu[1536 + tid] : 0.f;
    const float w0c = F.in[4][tid], a0c = F.in[6][tid], kkc = F.in[9][tid], kac = F.in[10][tid], rkc = F.in[11][tid];
    const float* w_up = F.in[5]; const float* a_up = F.in[7]; const float* g_up = F.in[8];
    float pr = 0.f, pk = 0.f, pv = 0.f, pl = 0.f;
    if (t0 != 0) { const float* b = BND + (size_t)(u - 1) * RWC; pr = b[tid]; pk = b[512 + tid]; pv = b[1024 + tid]; if (tid < 256) pl = b[1536 + tid]; }
    for (int batch = 0; batch < 4; ++batch) {
        const int Rb = R0 + 16 * batch;
        float xr[16], xk[16]; unsigned vtw[8];
        if (tid < 256) { float xl[16];
#pragma unroll
            for (int j = 0; j < 16; ++j) xl[j] = PRW[(size_t)(Rb + j) * RWC + 1536 + tid];
#pragma unroll
            for (int j = 0; j < 16; ++j) { const float n = xl[j]; const float v = n + (pl - n) * mu_l; pl = n; const float f = (tid < 64) ? tanh_fast(v) : ((tid < 128) ? v : sigmf(v)); lin[tid * 16 + j] = f; } }
        { float xv[16];
#pragma unroll
          for (int j = 0; j < 16; ++j) { const float* p = PRW + (size_t)(Rb + j) * RWC; xr[j] = p[tid]; xk[j] = p[512 + tid]; xv[j] = p[1024 + tid]; }
          VM_WAIT();
#pragma unroll
          for (int j = 0; j < 16; ++j) { float n;
              n = xr[j]; xr[j] = n + (pr - n) * mu_r; pr = n;
              n = xk[j]; xk[j] = n + (pk - n) * mu_k; pk = n;
              n = xv[j]; const unsigned vb = f2bf(n + (pv - n) * mu_v); pv = n;
              if (j & 1) vtw[j >> 1] |= vb << 16; else vtw[j >> 1] = vb; } }
        __syncthreads();
        float accw[16], acca[16], accg[16];
#pragma unroll
        for (int j = 0; j < 16; ++j) accg[j] = 0.f;
#pragma unroll 1
        for (int jj = 0; jj < 128; ++jj) { const float gv = g_up[jj * 512 + tid];
            const LAS f32x4* ig = (const LAS f32x4*)(lin + (128 + jj) * 16);
#pragma unroll
            for (int q = 0; q < 4; ++q) { const f32x4 a = ig[q];
#pragma unroll
                for (int e = 0; e < 4; ++e) accg[4 * q + e] += a[e] * gv; } }
#pragma unroll
        for (int j = 0; j < 16; ++j) G[(size_t)(Rb + j) * 512 + tid] = f2b(accg[j]);
        __builtin_amdgcn_sched_barrier(0);
#pragma unroll
        for (int j = 0; j < 16; ++j) { accw[j] = 0.f; acca[j] = 0.f; }
#pragma unroll 1
        for (int jj = 0; jj < 64; ++jj) { const float wv = w_up[jj * 512 + tid], av = a_up[jj * 512 + tid];
            const LAS f32x4* iw = (const LAS f32x4*)(lin + jj * 16); const LAS f32x4* ia = (const LAS f32x4*)(lin + (64 + jj) * 16);
#pragma unroll
            for (int q = 0; q < 4; ++q) { const f32x4 a = iw[q], b = ia[q];
#pragma unroll
                for (int e = 0; e < 4; ++e) { accw[4 * q + e] += a[e] * wv; acca[4 * q + e] += b[e] * av; } } }
        unsigned char* rec = (unsigned char*)(PRW + (size_t)Rb * RWC) + h * REC_BYTES;
#pragma unroll
        for (int j = 0; j < 16; ++j) {
            const float z = -(w0c + accw[j]); const float sp = fmaxf(z, 0.f) + __logf(1.0f + __expf(-fabsf(z)));
            const float e = __expf(-sp - 0.5f); accw[j] = __expf(-e);
            const float a = sigmf(a0c + acca[j]); acca[j] = a;
            const float kkv = xk[j] * kkc; xk[j] = xk[j] * (1.f + (a - 1.f) * kac);
            const float ss = wave_sum(kkv * kkv); accg[j] = kkv * rsqrtf(fmaxf(ss, 1e-24f));
            const float bon = wave_sum(xr[j] * xk[j] * rkc);
            if (lane == 0) *(float*)(rec + 12544 + 4 * j) = bon; __builtin_amdgcn_sched_barrier(0); }
        { float g = 1.f; unsigned bhw[8], khw[8];
          LAS bf16* mp = mats + lane;
#pragma unroll
          for (int j = 0; j < 16; ++j) { const float gp = g; g *= accw[j]; const float ig = __builtin_amdgcn_rcpf(g);
              const unsigned w1 = pg8::cvt_pk_bf16(accg[j] * gp, xr[j] * g), w2 = pg8::cvt_pk_bf16(accg[j] * acca[j] * ig, xk[j] * ig);
              mp[j * 64] = (u16)(w1 & 0xffffu); mp[1024 + j * 64] = (u16)(w1 >> 16); mp[2048 + j * 64] = (u16)(w2 & 0xffffu); mp[3072 + j * 64] = (u16)(w2 >> 16);
              if (j & 1) { bhw[j >> 1] |= w2 << 16; khw[j >> 1] |= w2 & 0xffff0000u; } else { bhw[j >> 1] = w2 & 0xffffu; khw[j >> 1] = w2 >> 16; } }
          *(float*)(rec + 12288 + 4 * lane) = g;
          v4u* bp = (v4u*)(rec + 4096 + lane * 32); bp[0] = (v4u){bhw[0], bhw[1], bhw[2], bhw[3]}; bp[1] = (v4u){bhw[4], bhw[5], bhw[6], bhw[7]};
          v4u* kp = (v4u*)(rec + 6144 + lane * 32); kp[0] = (v4u){khw[0], khw[1], khw[2], khw[3]}; kp[1] = (v4u){khw[4], khw[5], khw[6], khw[7]};
          v4u* vp = (v4u*)(rec + 8192 + lane * 32); vp[0] = (v4u){vtw[0], vtw[1], vtw[2], vtw[3]}; vp[1] = (v4u){vtw[4], vtw[5], vtw[6], vtw[7]}; }
        LDS_WAIT(); asm volatile("" ::: "memory");
#pragma unroll
        for (int i = 0; i < 2; ++i) { const int pi = lane + 64 * i, s = pi >> 3, ks = (pi >> 2) & 1, qq = pi & 3;
#pragma unroll
            for (int mtx = 0; mtx < 2; ++mtx) { const LAS bf16* src = mats + mtx * 1024 + s * 64 + 32 * ks + 4 * qq;
                const u32x2 lo = *(const LAS u32x2*)src, hi = *(const LAS u32x2*)(src + 16);
                *(v4u*)(rec + mtx * 2048 + pi * 16) = (v4u){lo.x, lo.y, hi.x, hi.y}; } }
        LDS_WAIT(); asm volatile("" ::: "memory");
        { f32x4 Ab = {0.f, 0.f, 0.f, 0.f}, Ak = Ab, Mb = Ab, Mk = Ab;
#pragma unroll
          for (int ks = 0; ks < 2; ++ks) { const int off = r16 * 64 + 32 * ks + 8 * q4;
              const bf16x8 aK = as_bf16x8(*(const LAS v4u*)(mats + off)), aR = as_bf16x8(*(const LAS v4u*)(mats + 1024 + off)), bB = as_bf16x8(*(const LAS v4u*)(mats + 2048 + off)), bK = as_bf16x8(*(const LAS v4u*)(mats + 3072 + off));
              Ab = mfma16(aK, bB, Ab); Ak = mfma16(aK, bK, Ak); Mb = mfma16(aR, bB, Mb); Mk = mfma16(aR, bK, Mk); }
          bf16* rAk = (bf16*)(rec + 10240); bf16* rMb = (bf16*)(rec + 11264); bf16* rMk = (bf16*)(rec + 11776);
#pragma unroll
          for (int r = 0; r < 4; ++r) { const int s = 4 * q4 + r, j = r16; const bool lo = j < s, le = j <= s;
              abl[s * 17 + j] = lo ? Ab[r] : 0.f; rAk[s * 16 + j] = f2b(lo ? Ak[r] : 0.f); rMb[s * 16 + j] = f2b(le ? Mb[r] : 0.f); rMk[s * 16 + j] = f2b(le ? Mk[r] : 0.f); } }
        LDS_WAIT(); asm volatile("" ::: "memory");
        { float Tr[16]; bf16* rT = (bf16*)(rec + 10752);
#pragma unroll
          for (int s = 0; s < 16; ++s) { float t = (r16 == s) ? 1.f : 0.f;
#pragma unroll
              for (int j = 0; j < s; ++j) t -= abl[s * 17 + j] * Tr[j];
              Tr[s] = t; if (lane < 16) rT[s * 16 + r16] = f2b(-t); __builtin_amdgcn_sched_barrier(0); } }
        __syncthreads();
    }
}
__device__ __forceinline__ void nsa_prep_tile(const Frame& F, int u) {
    const int lane = F.lane, w = F.wave;
    const int R0 = 64 * u, t0 = R0 & (T - 1), b = R0 / T;
    bf16* PNSA = (bf16*)((unsigned char*)F.out + DO_PNSA);
    const float qg = F.in[14][lane] * (0.125f * LOG2E);
    const float kg = (w < 2) ? F.in[16][lane] : F.in[17][lane];
    const int kcol = ((w < 2) ? 768 : 1024) + (w & 1) * 64 + lane;
#pragma unroll 1
    for (int tg = 0; tg < 4; ++tg) { float qv[16], kv[16];
#pragma unroll
        for (int i = 0; i < 16; ++i) { const bf16* p = PNSA + (size_t)(R0 + 16 * tg + i) * 1280; qv[i] = bf2f(p[w * 64 + lane]); kv[i] = (w < 4) ? bf2f(p[kcol]) : 0.f; }
#pragma unroll
        for (int i = 0; i < 16; ++i) { bf16* p = PNSA + (size_t)(R0 + 16 * tg + i) * 1280;
            const float ss = wave_sum(qv[i] * qv[i]) * (1.f / 64.f);
            p[w * 64 + lane] = f2b(qv[i] * rsqrtf(ss + NORM_EPS) * qg);
            if (w < 4) { const float ks = wave_sum(kv[i] * kv[i]) * (1.f / 64.f); p[kcol] = f2b(kv[i] * rsqrtf(ks + NORM_EPS) * kg); } } }
    if (w >= 4) {
        const int g = w & 1; const int scol = ((w < 6) ? 896 : 1152) + g * 64;
        bf16* VT = (bf16*)(F.ws + ((w < 6) ? WS_VST : WS_VWT)) + (size_t)((b * 2 + g) * 64) * T + (size_t)((t0 + lane) >> 5) * 2048 + ((t0 + lane) & 31);
        const v4u* src = (const v4u*)(PNSA + (size_t)(R0 + lane) * 1280 + scol);
        v4u v[8];
#pragma unroll
        for (int i = 0; i < 8; ++i) v[i] = src[i];
#pragma unroll
        for (int i = 0; i < 8; ++i) {
            VT[(8 * i + 0) * 32] = (u16)(v[i].x & 0xffffu); VT[(8 * i + 1) * 32] = (u16)(v[i].x >> 16);
            VT[(8 * i + 2) * 32] = (u16)(v[i].y & 0xffffu); VT[(8 * i + 3) * 32] = (u16)(v[i].y >> 16);
            VT[(8 * i + 4) * 32] = (u16)(v[i].z & 0xffffu); VT[(8 * i + 5) * 32] = (u16)(v[i].z >> 16);
            VT[(8 * i + 6) * 32] = (u16)(v[i].w & 0xffffu); VT[(8 * i + 7) * 32] = (u16)(v[i].w >> 16); }
    }
}
__device__ __forceinline__ float gelu_tanh(float x) { const float t = 0.7978845608028654f * (x + 0.044715f * x * x * x); return 0.5f * x * (1.f + tanh_fast(t)); }
__device__ __forceinline__ void compress_unit(const Frame& F, int u) {
    const int lane = F.lane, w = F.wave, r16 = lane & 15, q4 = lane >> 4;
    const int kvsel = u >> 7, b = (u >> 5) & 3, g = (u >> 4) & 1, ntile = u & 15;
    const bf16* X = (const bf16*)((unsigned char*)F.out + DO_PNSA) + (size_t)(b * T) * 1280 + (kvsel ? 640 : 512) + g * 64;
    const float* pos = kvsel ? F.in[19] : F.in[18];
    const bf16* W1t = (const bf16*)(F.ws + (kvsel ? WS_CW1V : WS_CW1K));
    const bf16* W2t = (const bf16*)(F.ws + (kvsel ? WS_CW2V : WS_CW2K));
    LAS bf16* hid = (LAS bf16*)(F.lds);
    LAS float* outb = (LAS float*)(F.lds + 16 * 528);
    int n = 16 * ntile + r16; if (n > 254) n = 254;
    f32x4 acc[2] = {{0.f, 0.f, 0.f, 0.f}, {0.f, 0.f, 0.f, 0.f}};
#pragma unroll 4
    for (int s = 0; s < 64; ++s) { const int lp = s >> 1, d0 = (s & 1) * 32 + 8 * q4;
        const v4u xa = *(const v4u*)(X + (size_t)(16 * n + lp) * 1280 + d0);
        const f32x4 p0 = *(const f32x4*)(pos + lp * 64 + d0), p1 = *(const f32x4*)(pos + lp * 64 + d0 + 4);
        v4u af; af.x = pk2(bflo(xa.x) + p0[0], bfhi(xa.x) + p0[1]); af.y = pk2(bflo(xa.y) + p0[2], bfhi(xa.y) + p0[3]);
        af.z = pk2(bflo(xa.z) + p1[0], bfhi(xa.z) + p1[1]); af.w = pk2(bflo(xa.w) + p1[2], bfhi(xa.w) + p1[3]);
#pragma unroll
        for (int nt = 0; nt < 2; ++nt) { const v4u bfg = *(const v4u*)(W1t + (size_t)(32 * w + 16 * nt + r16) * 2048 + 32 * s + 8 * q4);
            acc[nt] = mfma16(as_bf16x8(af), as_bf16x8(bfg), acc[nt]); } }
#pragma unroll
    for (int nt = 0; nt < 2; ++nt)
#pragma unroll
        for (int r = 0; r < 4; ++r) hid[(4 * q4 + r) * 264 + 32 * w + 16 * nt + r16] = f2b(gelu_tanh(acc[nt][r]));
    __syncthreads();
    if (w < 4) { f32x4 a2 = {0.f, 0.f, 0.f, 0.f};
#pragma unroll
        for (int s = 0; s < 8; ++s) { const v4u af = *(const LAS v4u*)(hid + r16 * 264 + 32 * s + 8 * q4);
            const v4u bfg = *(const v4u*)(W2t + (size_t)(16 * w + r16) * 256 + 32 * s + 8 * q4);
            a2 = mfma16(as_bf16x8(af), as_bf16x8(bfg), a2); }
#pragma unroll
        for (int r = 0; r < 4; ++r) outb[(4 * q4 + r) * 64 + 16 * w + r16] = a2[r]; }
    __syncthreads();
#pragma unroll
    for (int rr = 0; rr < 2; ++rr) { const int row = 2 * w + rr; const int nn = 16 * ntile + row; float val = outb[row * 64 + lane];
        if (kvsel == 0) { const float ss = wave_sum(val * val) * (1.f / 64.f); val = val * rsqrtf(ss + NORM_EPS) * F.in[15][lane];
            ((bf16*)(F.ws + WS_KC))[(size_t)((b * 2 + g) * 256 + nn) * 64 + lane] = (nn < 255) ? f2b(val) : (u16)0; }
        else ((bf16*)(F.ws + WS_VCT))[(size_t)((b * 2 + g) * 64 + lane) * 256 + nn] = (nn < 255) ? f2b(val) : (u16)0; }
    __syncthreads();
}
__device__ __forceinline__ bf16x8 pack_p(const f32x4 a, const f32x4 b) {
    v4u w; w.x = pg8::cvt_pk_bf16(a[0], a[1]); w.y = pg8::cvt_pk_bf16(a[2], a[3]); w.z = pg8::cvt_pk_bf16(b[0], b[1]); w.w = pg8::cvt_pk_bf16(b[2], b[3]); return as_bf16x8(w);
}
#define NSA_FENCE() asm volatile("s_waitcnt lgkmcnt(0)" ::: "memory")
struct KFr { bf16x8 a0, a1, b0, b1; };
struct VFr { bf16x8 v[4]; };
__device__ __forceinline__ KFr lds_k(const LAS unsigned char* ks, int r16, int q4) {
    const int rA = 8 * (r16 >> 2) + (r16 & 3), rB = rA + 4; const int xA = (rA >> 1) & 7, xB = (rB >> 1) & 7;
    KFr f; f.a0 = as_bf16x8(*(const LAS v4u*)(ks + rA * 128 + ((q4 ^ xA) << 4))); f.a1 = as_bf16x8(*(const LAS v4u*)(ks + rA * 128 + (((4 + q4) ^ xA) << 4)));
    f.b0 = as_bf16x8(*(const LAS v4u*)(ks + rB * 128 + ((q4 ^ xB) << 4))); f.b1 = as_bf16x8(*(const LAS v4u*)(ks + rB * 128 + (((4 + q4) ^ xB) << 4))); return f;
}
__device__ __forceinline__ VFr lds_v(const LAS unsigned char* vs, int r16, int q4) {
    VFr f;
#pragma unroll
    for (int dt = 0; dt < 4; ++dt) { const int d = 16 * dt + r16; f.v[dt] = as_bf16x8(*(const LAS v4u*)(vs + d * 64 + ((q4 ^ ((d >> 2) & 3)) << 4))); }
    return f;
}
struct NsaSrc { const bf16* kb; int krs; const bf16* vb; int vrs; int vtiled; };
__device__ __forceinline__ v4u nsa_stage_load(const NsaSrc& S, int k0, int tid) {
    if (tid < 256) return *(const v4u*)(S.kb + (size_t)(k0 + (tid >> 3)) * S.krs + 8 * (tid & 7));
    const int i = tid - 256, d = i >> 2, c = i & 3;
    return S.vtiled ? *(const v4u*)(S.vb + (size_t)(k0 >> 5) * 2048 + d * 32 + 8 * c) : *(const v4u*)(S.vb + (size_t)d * S.vrs + k0 + 8 * c);
}
__device__ __forceinline__ void nsa_stage_write(LAS unsigned char* lds, int slot, int tid, const v4u v) {
    if (tid < 256) { const int r = tid >> 3, c = tid & 7; *(LAS v4u*)(lds + slot * 4096 + r * 128 + ((c ^ ((r >> 1) & 7)) << 4)) = v; }
    else { const int i = tid - 256, d = i >> 2, c = i & 3; *(LAS v4u*)(lds + 8192 + slot * 4096 + d * 64 + ((c ^ ((d >> 2) & 3)) << 4)) = v; }
}
__device__ __forceinline__ void nsa_block_unit(const Frame& F, int b, int g, int T0, int skip) {
    const int lane = F.lane, tid = F.tid, w = F.wave, r16 = lane & 15, q4 = lane >> 4;
    const int t0 = T0 + 8 * w;
    const f32x4 Z4 = {0.f, 0.f, 0.f, 0.f};
    LAS unsigned char* lds = F.lds;
    LAS float* wl = (LAS float*)(lds + 16384 + w * 5120);
    LAS float* impT = wl; LAS float* imp2T = wl + 8 * 65; LAS unsigned* selT = (LAS unsigned*)(wl + 16 * 65);
    LAS unsigned* bw = (LAS unsigned*)(lds + 57344); LAS int* stl = (LAS int*)(lds + 57344 + 128);
    const bf16* PN = (const bf16*)((unsigned char*)F.out + DO_PNSA) + (size_t)(b * T) * 1280;
    const float* GL = (const float*)((unsigned char*)F.out + DO_GLOG) + (size_t)(b * T) * 32;
    bf16x8 qf[2][2]; int tq[2];
#pragma unroll
    for (int mt = 0; mt < 2; ++mt) { tq[mt] = t0 + 4 * mt + (r16 >> 2);
#pragma unroll
        for (int dh = 0; dh < 2; ++dh) qf[mt][dh] = as_bf16x8(*(const v4u*)(PN + (size_t)tq[mt] * 1280 + (g * 4 + (r16 & 3)) * 64 + 32 * dh + 8 * q4)); }
    f32x4 Oc[2][4];
#pragma unroll
    for (int mt = 0; mt < 2; ++mt)
#pragma unroll
        for (int dt = 0; dt < 4; ++dt) Oc[mt][dt] = Z4;
#define NSA_GATE(mt_, r_, br_) sigmf(GL[(size_t)(t0 + 4 * (mt_) + q4) * 32 + g * 12 + (r_) * 3 + (br_)])
#define NSA_PIPE_BEGIN(S_, n_, K0_OF) { v4u st = nsa_stage_load(S_, K0_OF(0), tid); nsa_stage_write(lds, 0, tid, st); if ((n_) > 1) st = nsa_stage_load(S_, K0_OF(1), tid); __syncthreads(); \
        for (int i = 0; i < (n_); ++i) { const int k0 = K0_OF(i); const LAS unsigned char* ks = lds + (i & 1) * 4096; const LAS unsigned char* vs = lds + 8192 + (i & 1) * 4096;
#define NSA_PIPE_END(S_, n_, K0_OF) if (i + 1 < (n_)) nsa_stage_write(lds, (i + 1) & 1, tid, st); if (i + 2 < (n_)) st = nsa_stage_load(S_, K0_OF(i + 2), tid); __syncthreads(); } }

    for (int i = lane; i < 16 * 65; i += 64) wl[i] = 0.f;
    const NsaSrc SC{(const bf16*)(F.ws + WS_KC) + (size_t)((b * 2 + g) * 256) * 64, 64, (const bf16*)(F.ws + WS_VCT) + (size_t)((b * 2 + g) * 64) * 256, 256, 0};
    const int ncb = (T0 + 63 >= 31) ? ((T0 + 63 - 31) >> 4) + 1 : 0; const int nstB = (skip & 1) ? 0 : ((ncb + 31) >> 5);
    const int ncw = (t0 + 7 >= 31) ? ((t0 + 7 - 31) >> 4) + 1 : 0; const int nstW = (skip & 1) ? 0 : ((ncw + 31) >> 5);
    float inv[2] = {0.f, 0.f};
#define K0_LIN(i_) (32 * (i_))
    if (nstB > 0) { float ls[2] = {0.f, 0.f};
        NSA_PIPE_BEGIN(SC, nstB, K0_LIN)
            if (i < nstW) { const KFr kf = lds_k(ks, r16, q4); const bool cslow = 16 * (k0 + 31) + 31 > t0;
#pragma unroll
                for (int mt = 0; mt < 2; ++mt) { f32x4 sA = mfma16(kf.a0, qf[mt][0], Z4); sA = mfma16(kf.a1, qf[mt][1], sA); f32x4 sB = mfma16(kf.b0, qf[mt][0], Z4); sB = mfma16(kf.b1, qf[mt][1], sB);
#pragma unroll
                    for (int r = 0; r < 4; ++r) { const int nA = k0 + 8 * q4 + r, nB = nA + 4;
                        if (cslow) { ls[mt] += (16 * nA + 31 <= tq[mt]) ? __builtin_amdgcn_exp2f(sA[r]) : 0.f; ls[mt] += (16 * nB + 31 <= tq[mt]) ? __builtin_amdgcn_exp2f(sB[r]) : 0.f; }
                        else { ls[mt] += __builtin_amdgcn_exp2f(sA[r]); ls[mt] += __builtin_amdgcn_exp2f(sB[r]); } } } }
        NSA_PIPE_END(SC, nstB, K0_LIN)
#pragma unroll
        for (int mt = 0; mt < 2; ++mt) { float l = ls[mt]; l += __shfl_xor(l, 16); l += __shfl_xor(l, 32); inv[mt] = 1.0f / fmaxf(l, 1e-30f); }
    }
    if (nstB > 0) { f32x4 O[2][4];
#pragma unroll
        for (int mt = 0; mt < 2; ++mt)
#pragma unroll
            for (int dt = 0; dt < 4; ++dt) O[mt][dt] = Z4;
        NSA_PIPE_BEGIN(SC, nstB, K0_LIN)
            if (i < nstW) { const KFr kf = lds_k(ks, r16, q4); const VFr vf = lds_v(vs, r16, q4); const bool cslow = 16 * (k0 + 31) + 31 > t0;
#pragma unroll
                for (int mt = 0; mt < 2; ++mt) { f32x4 sA = mfma16(kf.a0, qf[mt][0], Z4); sA = mfma16(kf.a1, qf[mt][1], sA); f32x4 sB = mfma16(kf.b0, qf[mt][0], Z4); sB = mfma16(kf.b1, qf[mt][1], sB);
                    f32x4 pA, pB;
#pragma unroll
                    for (int r = 0; r < 4; ++r) { const int nA = k0 + 8 * q4 + r, nB = nA + 4;
                        if (cslow) { pA[r] = (16 * nA + 31 <= tq[mt]) ? __builtin_amdgcn_exp2f(sA[r]) * inv[mt] : 0.f; pB[r] = (16 * nB + 31 <= tq[mt]) ? __builtin_amdgcn_exp2f(sB[r]) * inv[mt] : 0.f; }
                        else { pA[r] = __builtin_amdgcn_exp2f(sA[r]) * inv[mt]; pB[r] = __builtin_amdgcn_exp2f(sB[r]) * inv[mt]; } }
                    float vA = pA[0] + pA[1] + pA[2] + 0.5f * pA[3], cA = 0.5f * pA[3], vB = pB[0] + pB[1] + pB[2] + 0.5f * pB[3], cB = 0.5f * pB[3];
                    vA += __shfl_xor(vA, 1); vA += __shfl_xor(vA, 2); cA += __shfl_xor(cA, 1); cA += __shfl_xor(cA, 2);
                    vB += __shfl_xor(vB, 1); vB += __shfl_xor(vB, 2); cB += __shfl_xor(cB, 1); cB += __shfl_xor(cB, 2);
                    if ((lane & 3) == 0) { const int tl = 4 * mt + (r16 >> 2), j = (k0 >> 2) + 2 * q4;
                        impT[tl * 65 + j] = vA; imp2T[tl * 65 + j + 1] = cA; impT[tl * 65 + j + 1] = vB; imp2T[tl * 65 + j + 2] = cB; }
                    const bf16x8 pf = pack_p(pA, pB);
#pragma unroll
                    for (int dt = 0; dt < 4; ++dt) O[mt][dt] = mfma16(pf, vf.v[dt], O[mt][dt]); } }
        NSA_PIPE_END(SC, nstB, K0_LIN)
#pragma unroll
        for (int mt = 0; mt < 2; ++mt)
#pragma unroll
            for (int r = 0; r < 4; ++r) { const float gt = NSA_GATE(mt, r, 0);
#pragma unroll
                for (int dt = 0; dt < 4; ++dt) Oc[mt][dt][r] += gt * O[mt][dt][r]; }
    }
    NSA_FENCE();
    const int cur = T0 >> 6;
    unsigned long long uni = 0ull;
    for (int tl = 0; tl < 8; ++tl) {
        unsigned long long mask;
        if (cur < 16 || (skip & 2)) mask = (cur < 16) ? ((2ull << cur) - 1ull) : (0xFFFFull | (1ull << cur) | (1ull << (cur - 1)));
        else {
            const float sc = impT[tl * 65 + lane] + imp2T[tl * 65 + lane];
            const unsigned key = __float_as_uint(fmaxf(sc, 0.f));
            const bool elig = (lane <= cur) && (lane != 0) && (lane != cur) && (lane != cur - 1);
            unsigned prefix = 0u;
            for (int bit = 30; bit >= 0; --bit) { const unsigned cand = prefix | (1u << bit);
                const int cnt = __popcll(__ballot(elig && key >= cand)); if (cnt >= 13) prefix = cand; }
            const unsigned long long gt = __ballot(elig && key > prefix); unsigned long long ties = __ballot(elig && key == prefix);
            int need = 13 - __popcll(gt); unsigned long long keep = 0ull;
            while (need > 0 && ties) { const unsigned long long low = ties & (0ull - ties); keep |= low; ties ^= low; --need; }
            mask = gt | keep | 1ull | (1ull << cur) | (1ull << (cur - 1));
        }
        uni |= mask;
        if (lane == 0) { selT[2 * tl] = (unsigned)mask; selT[2 * tl + 1] = (unsigned)(mask >> 32); }
    }
    if (lane == 0) { bw[2 + 2 * w] = (unsigned)uni; bw[3 + 2 * w] = (unsigned)(uni >> 32); }
    NSA_FENCE();
    unsigned long long mk[2];
#pragma unroll
    for (int mt = 0; mt < 2; ++mt) { const int tl = 4 * mt + (r16 >> 2); mk[mt] = (unsigned long long)selT[2 * tl] | ((unsigned long long)selT[2 * tl + 1] << 32); }
    __syncthreads();
    unsigned long long buni = 0ull;
#pragma unroll
    for (int ww = 0; ww < 8; ++ww) buni |= (unsigned long long)bw[2 + 2 * ww] | ((unsigned long long)bw[3 + 2 * ww] << 32);

#define K0_LIST(i_) (__builtin_amdgcn_readfirstlane(stl[(i_)]))
#pragma unroll 1
    for (int br = 1; br < 3; ++br) { if ((skip >> (br + 1)) & 1) continue;
        const NsaSrc SB{PN + (br == 1 ? 768 : 1024) + g * 64, 1280, (const bf16*)(F.ws + (br == 1 ? WS_VST : WS_VWT)) + (size_t)((b * 2 + g) * 64) * T, 0, 1};
        f32x4 O[2][4]; float ls[2] = {0.f, 0.f};
#pragma unroll
        for (int mt = 0; mt < 2; ++mt)
#pragma unroll
            for (int dt = 0; dt < 4; ++dt) O[mt][dt] = Z4;
        int nsteps;
        if (br == 1) { nsteps = 2 * __popcll(buni);
            if (w == 0 && ((buni >> lane) & 1ull)) { const int rk = __popcll(buni & ((1ull << lane) - 1ull)); stl[2 * rk] = 64 * lane; stl[2 * rk + 1] = 64 * lane + 32; } }
        else { const int lo = T0 - 511; const int klo = (lo > 0 ? lo : 0) & ~31; nsteps = ((T0 + 64 - klo) + 31) >> 5; if (w == 0 && lane < nsteps) stl[lane] = klo + 32 * lane; }
        __syncthreads();
        NSA_PIPE_BEGIN(SB, nsteps, K0_LIST)
            const int j = k0 >> 6;
            const bool mine = (br == 1) ? (((uni >> j) & 1ull) != 0ull) : (k0 + 31 >= t0 - 511 && k0 <= t0 + 7);
            if (mine) { const KFr kf = lds_k(ks, r16, q4); const VFr vf = lds_v(vs, r16, q4);
                const bool slow = (br == 1) ? (j == cur) : (k0 < t0 - 504 || k0 + 31 > t0);
#pragma unroll
                for (int mt = 0; mt < 2; ++mt) { f32x4 ci = Z4;
                    if (br == 1) { const float bias = (((mk[mt] >> j) & 1ull) != 0ull) ? 0.f : -1e30f; ci = (f32x4){bias, bias, bias, bias}; }
                    f32x4 sA = mfma16(kf.a0, qf[mt][0], ci); sA = mfma16(kf.a1, qf[mt][1], sA); f32x4 sB = mfma16(kf.b0, qf[mt][0], ci); sB = mfma16(kf.b1, qf[mt][1], sB);
                    f32x4 pA, pB;
                    if (slow) {
#pragma unroll
                        for (int r = 0; r < 4; ++r) { const int kA = k0 + 8 * q4 + r, kB = kA + 4;
                            const bool mA = (kA <= tq[mt]) && (br == 1 || kA + 512 > tq[mt]), mB = (kB <= tq[mt]) && (br == 1 || kB + 512 > tq[mt]);
                            pA[r] = mA ? __builtin_amdgcn_exp2f(sA[r]) : 0.f; pB[r] = mB ? __builtin_amdgcn_exp2f(sB[r]) : 0.f; }
                    } else {
#pragma unroll
                        for (int r = 0; r < 4; ++r) { pA[r] = __builtin_amdgcn_exp2f(sA[r]); pB[r] = __builtin_amdgcn_exp2f(sB[r]); }
                    }
                    ls[mt] += (pA[0] + pA[1]) + (pA[2] + pA[3]) + (pB[0] + pB[1]) + (pB[2] + pB[3]);
                    const bf16x8 pf = pack_p(pA, pB);
#pragma unroll
                    for (int dt = 0; dt < 4; ++dt) O[mt][dt] = mfma16(pf, vf.v[dt], O[mt][dt]); } }
        NSA_PIPE_END(SB, nsteps, K0_LIST)
#pragma unroll
        for (int mt = 0; mt < 2; ++mt) { float l = ls[mt]; l += __shfl_xor(l, 16); l += __shfl_xor(l, 32); const float il = 1.0f / fmaxf(l, 1e-30f);
#pragma unroll
            for (int r = 0; r < 4; ++r) { const float ilr = __shfl(il, 4 * q4 + r) * NSA_GATE(mt, r, br);
#pragma unroll
                for (int dt = 0; dt < 4; ++dt) Oc[mt][dt][r] += ilr * O[mt][dt][r]; } }
    }
    if (!skip) { bf16* YB = (bf16*)(F.ws + WS_H + 16 * MiB) + (size_t)(b * T) * 512;
#pragma unroll
        for (int mt = 0; mt < 2; ++mt)
#pragma unroll
            for (int r = 0; r < 4; ++r)
#pragma unroll
                for (int dt = 0; dt < 4; ++dt) YB[(size_t)(t0 + 4 * mt + q4) * 512 + (g * 4 + r) * 64 + 16 * dt + r16] = f2b(Oc[mt][dt][r]); }
    __syncthreads();
}
__device__ __forceinline__ void nsa_phase(const Frame& F, int rep) {
    LAS unsigned* bw = (LAS unsigned*)(F.lds + 57344);
    const int q0 = (int)(xb_xcc_id() & 7u);
    for (int qi = 0; qi < 8; ++qi) { const int q = (q0 + qi) & 7;
        for (;;) {
            if (F.tid == 0) bw[0] = __hip_atomic_fetch_add(F.ctl + CW_NSAQ + 64 * (8 * rep + q), 1u, RLX_AGENT);
            __syncthreads();
            const unsigned c = bw[0];
            __syncthreads();
            if (c >= 64u) break;
            nsa_block_unit(F, q >> 1, q & 1, 64 * (63 - (int)c), rep ? NSA_SKIP : 0);
        }
    }
}
typedef short bf16x4 __attribute__((ext_vector_type(4)));
__device__ __forceinline__ f32x4 mfma16k16(const bf16x4 a, const bf16x4 b, const f32x4 c) { const bf16x8 a8 = {a[0], a[1], a[2], a[3], 0, 0, 0, 0}, b8 = {b[0], b[1], b[2], b[3], 0, 0, 0, 0}; return __builtin_amdgcn_mfma_f32_16x16x32_bf16(a8, b8, c, 0, 0, 0); }
__device__ __forceinline__ bf16x4 as_bf16x4(const u32x2 v) { return __builtin_bit_cast(bf16x4, v); }
__device__ __forceinline__ bf16x4 pack4(const f32x4 a) { u32x2 w; w.x = pg8::cvt_pk_bf16(a[0], a[1]); w.y = pg8::cvt_pk_bf16(a[2], a[3]); return as_bf16x4(w); }
__device__ __forceinline__ f32x4 unpk4(const u32x2 w) { f32x4 r; r[0] = bflo(w.x); r[1] = bfhi(w.x); r[2] = bflo(w.y); r[3] = bfhi(w.y); return r; }
struct ChunkIn { v4u kt0, kt1, rt0, rt1; u32x2 ak, nt, mb, mk, vt, bh[4], kh[4]; f32x4 gam[4]; };
__device__ __forceinline__ void scan_load(ChunkIn& c, const unsigned char* rec, int vq, int r16, int q4) {
    c.kt0 = *(const v4u*)(rec + (r16 * 64 + q4 * 8) * 2); c.kt1 = *(const v4u*)(rec + (r16 * 64 + 32 + q4 * 8) * 2);
    c.rt0 = *(const v4u*)(rec + 2048 + (r16 * 64 + q4 * 8) * 2); c.rt1 = *(const v4u*)(rec + 2048 + (r16 * 64 + 32 + q4 * 8) * 2);
#pragma unroll
    for (int mt = 0; mt < 4; ++mt) { c.bh[mt] = *(const u32x2*)(rec + 4096 + ((16 * mt + r16) * 16 + 4 * q4) * 2); c.kh[mt] = *(const u32x2*)(rec + 6144 + ((16 * mt + r16) * 16 + 4 * q4) * 2);
        c.gam[mt] = *(const f32x4*)(rec + 12288 + (16 * mt + 4 * q4) * 4); }
    c.vt = *(const u32x2*)(rec + 8192 + ((16 * vq + r16) * 16 + 4 * q4) * 2);
    c.ak = *(const u32x2*)(rec + 10240 + (r16 * 16 + 4 * q4) * 2); c.nt = *(const u32x2*)(rec + 10752 + (r16 * 16 + 4 * q4) * 2);
    c.mb = *(const u32x2*)(rec + 11264 + (r16 * 16 + 4 * q4) * 2); c.mk = *(const u32x2*)(rec + 11776 + (r16 * 16 + 4 * q4) * 2);
}
__device__ __forceinline__ void scan_chunk(const ChunkIn& cur, f32x4 (&Zt)[4], bf16* Y, int ch, int q4) {
    const f32x4 Z4 = {0.f, 0.f, 0.f, 0.f};
    const bf16x8 zb0 = pack_p(Zt[0], Zt[1]), zb1 = pack_p(Zt[2], Zt[3]);
    f32x4 X = mfma16(as_bf16x8(cur.kt0), zb0, Z4); X = mfma16(as_bf16x8(cur.kt1), zb1, X);
    f32x4 Yc = mfma16(as_bf16x8(cur.rt0), zb0, Z4); Yc = mfma16(as_bf16x8(cur.rt1), zb1, Yc);
    const bf16x4 vt = as_bf16x4(cur.vt);
    const f32x4 W = mfma16k16(as_bf16x4(cur.ak), vt, X);
    const f32x4 U = mfma16k16(as_bf16x4(cur.nt), pack4(W), Z4);
    const bf16x4 ub = pack4(U);
    Yc = mfma16k16(as_bf16x4(cur.mk), vt, Yc); Yc = mfma16k16(as_bf16x4(cur.mb), ub, Yc);
#pragma unroll
    for (int mt = 0; mt < 4; ++mt) { f32x4 acc = mfma16k16(as_bf16x4(cur.kh[mt]), vt, Zt[mt]); acc = mfma16k16(as_bf16x4(cur.bh[mt]), ub, acc); Zt[mt] = acc * cur.gam[mt]; }
#pragma unroll
    for (int r = 0; r < 4; ++r) Y[(size_t)(16 * ch + 4 * q4 + r) * 512] = f2b(Yc[r]);
}
__device__ __forceinline__ void rwkv_scan_wave(const Frame& F, int bh, int vq) {
    const int lane = F.lane, r16 = lane & 15, q4 = lane >> 4, b = bh >> 3, h = bh & 7;
    const f32x4 Z4 = {0.f, 0.f, 0.f, 0.f};
    const unsigned char* recb = F.ws + WS_PRW + (size_t)(b * T) * 7168 + h * REC_BYTES;
    bf16* Y = (bf16*)(F.ws + WS_H) + (size_t)(b * T) * 512 + h * 64 + 16 * vq + r16;
    f32x4 Zt[4] = {Z4, Z4, Z4, Z4};
    ChunkIn A, B;
    constexpr size_t CS = 16 * 7168;
    scan_load(A, recb, vq, r16, q4);
    for (int ch = 0; ch < T / 16; ch += 2) {
        if (vq == 0 && lane == 0) __hip_atomic_store(F.ctl + CW_SCANP + 64 * bh, (unsigned)ch, RLX_AGENT);
        scan_load(B, recb + (size_t)(ch + 1) * CS, vq, r16, q4);
        scan_chunk(A, Zt, Y, ch, q4);
        scan_load(A, recb + (size_t)((ch + 2 < T / 16) ? ch + 2 : ch) * CS, vq, r16, q4);
        scan_chunk(B, Zt, Y, ch + 1, q4);
    }
}
__device__ __forceinline__ void rwkv_scan_prefetch(const Frame& F, int bh) {
    const int lane = F.lane, b = bh >> 3, h = bh & 7;
    const unsigned char* recb = F.ws + WS_PRW + (size_t)(b * T) * 7168 + h * REC_BYTES;
    const int o0 = 128 * lane, o1 = 128 * (lane < 35 ? 64 + lane : 98);
    unsigned dmy = 0u, pa[4] = {0u, 0u, 0u, 0u}, pb[4] = {0u, 0u, 0u, 0u};
    for (int c4 = 0; c4 < T / 16; c4 += 4) {
#pragma unroll
        for (int k = 0; k < 4; ++k) { const int ch = c4 + k;
            for (int spin = 0; spin < (1 << 16); ++spin) { const int prog = (int)__hip_atomic_load(F.ctl + CW_SCANP + 64 * bh, RLX_AGENT); if (ch <= prog + 8) break; __builtin_amdgcn_s_sleep(8); }
            const unsigned char* rec = recb + (size_t)ch * (16 * 7168);
            dmy ^= pa[k] ^ pb[k];
            pa[k] = *(const volatile unsigned*)(rec + o0); pb[k] = *(const volatile unsigned*)(rec + o1); }
    }
    dmy ^= pa[0] ^ pb[0] ^ pa[1] ^ pb[1] ^ pa[2] ^ pb[2] ^ pa[3] ^ pb[3];
    if (lane == 0) F.MISC[17] = dmy;
}
__device__ __forceinline__ void rwkv_epilogue(const Frame& F) {
    const int lane = F.lane; const int gw = F.vcu * NWAVES + F.wave, NGW = F.G * NWAVES;
    const unsigned char* prw = F.ws + WS_PRW; const bf16* G = (const bf16*)((unsigned char*)F.out + DO_G); bf16* YA = (bf16*)(F.ws + WS_H);
    for (int idx = gw; idx < (M / 16) * 8; idx += NGW) { const int bt = idx >> 3, h = idx & 7, c = h * 64 + lane;
        const unsigned char* rec = prw + (size_t)(16 * bt) * 7168 + h * REC_BYTES;
        const v4u* vp = (const v4u*)(rec + 8192 + lane * 32); const v4u v0 = vp[0], v1 = vp[1];
        const float lw = F.in[12][c], lb = F.in[13][c];
        float yv[16], gv[16], bo[16];
#pragma unroll
        for (int s = 0; s < 16; ++s) { const size_t o = (size_t)(16 * bt + s) * 512 + c; yv[s] = bf2f(YA[o]); gv[s] = bf2f(G[o]); bo[s] = *(const float*)(rec + 12544 + 4 * s); }
#pragma unroll
        for (int s = 0; s < 16; ++s) { const unsigned vw = (s < 8) ? v0[s >> 1] : v1[(s - 8) >> 1]; const float vv = (s & 1) ? bfhi(vw) : bflo(vw);
            const float y = yv[s]; const float mean = wave_sum(y) * (1.f / 64.f); const float d = y - mean; const float var = wave_sum(d * d) * (1.f / 64.f);
            const float yn = d * rsqrtf(var + GN_EPS) * lw + lb;
            YA[(size_t)(16 * bt + s) * 512 + c] = f2b((yn + bo[s] * vv) * gv[s]); }
    }
}
__device__ __forceinline__ unsigned sortable(float x) { const unsigned u = __float_as_uint(x); return (u & 0x80000000u) ? ~u : (u | 0x80000000u); }
__device__ __forceinline__ float unsortable(unsigned k) { const unsigned u = (k & 0x80000000u) ? (k & 0x7fffffffu) : ~k; return __uint_as_float(u); }
#define TK_INSERT(L, key_) do { unsigned k_ = (key_); _Pragma("unroll") for (int s_ = 0; s_ < 16; ++s_) { const unsigned hi_ = L[s_] > k_ ? L[s_] : k_; k_ = L[s_] > k_ ? k_ : L[s_]; L[s_] = hi_; } } while (0)
__device__ __forceinline__ void peer_topk_pass(const Frame& F, int wp, LAS float* sc) {
    const int lane = F.lane, r16 = lane & 15, q4 = lane >> 4;
    const bf16* QRY = (const bf16*)(F.ws + WS_PRW);
    int* EID = (int*)(F.ws + WS_PRW + 64 * MiB); float* EG = (float*)(F.ws + WS_PRW + 72 * MiB);
    const int row = lane & 31, part = lane >> 5;
    unsigned L1[16], L2[16];
#pragma unroll
    for (int half = 0; half < 2; ++half) {
        const bf16* SK = (const bf16*)(F.ws + (half ? WS_SK2 : WS_SK1));
#pragma unroll
        for (int mt = 0; mt < 2; ++mt) { const int rho = 32 * wp + 16 * mt + r16;
            const bf16* qp = QRY + (size_t)(rho >> 3) * 2048 + (rho & 7) * 256 + half * 128 + 8 * q4;
            bf16x8 af[4];
#pragma unroll
            for (int s = 0; s < 4; ++s) af[s] = as_bf16x8(*(const v4u*)(qp + 32 * s));
#pragma unroll
            for (int kt = 0; kt < 8; ++kt) { f32x4 acc = {0.f, 0.f, 0.f, 0.f};
#pragma unroll
                for (int s = 0; s < 4; ++s) acc = mfma16(af[s], as_bf16x8(*(const v4u*)(SK + (size_t)(16 * kt + r16) * 128 + 32 * s + 8 * q4)), acc);
#pragma unroll
                for (int r = 0; r < 4; ++r) { const int rw = 16 * mt + 4 * q4 + r; sc[rw * 128 + ((16 * kt + r16) ^ rw)] = acc[r]; } } }
        NSA_FENCE();
        unsigned Ls[16];
#pragma unroll
        for (int s = 0; s < 16; ++s) Ls[s] = 0u;
#pragma unroll 4
        for (int i = 0; i < 64; ++i) { const int c = 64 * part + i; const float x = sc[row * 128 + (c ^ row)];
            TK_INSERT(Ls, (sortable(x) & ~0x7Fu) | (unsigned)(127 - c)); }
        unsigned Lo[16];
#pragma unroll
        for (int s = 0; s < 16; ++s) Lo[s] = (unsigned)__shfl_xor((int)Ls[s], 32);
#pragma unroll
        for (int s = 0; s < 16; ++s) TK_INSERT(Ls, Lo[s]);
#pragma unroll
        for (int s = 0; s < 16; ++s) { if (half == 0) L1[s] = Ls[s]; else L2[s] = Ls[s]; }
        NSA_FENCE();
    }
    float v1[16], v2[16];
#pragma unroll
    for (int s = 0; s < 16; ++s) { v1[s] = unsortable(L1[s]); v2[s] = unsortable(L2[s]); }
    unsigned C[16];
#pragma unroll
    for (int s = 0; s < 16; ++s) C[s] = 0u;
#pragma unroll
    for (int i = 0; i < 16; ++i)
#pragma unroll
        for (int j = 0; j < 16; ++j) if ((i + 1) * (j + 1) <= 16) { TK_INSERT(C, (sortable(v1[i] + v2[j]) & ~0xFFu) | (unsigned)(255 - (16 * i + j))); }
    LAS unsigned* il = (LAS unsigned*)sc;
    if (part == 0) {
#pragma unroll
        for (int s = 0; s < 16; ++s) { il[row * 33 + s] = 127u - (L1[s] & 127u); il[row * 33 + 16 + s] = 127u - (L2[s] & 127u); }
    }
    NSA_FENCE();
    if (part == 0) { const int rho = 32 * wp + row;
        float val[16], e[16]; float sum = 0.f;
#pragma unroll
        for (int s = 0; s < 16; ++s) val[s] = unsortable(C[s]);
#pragma unroll
        for (int s = 0; s < 16; ++s) { e[s] = __expf(val[s] - val[0]); sum += e[s]; }
        const float is = 1.0f / sum;
#pragma unroll
        for (int s = 0; s < 16; ++s) { const unsigned pos = 255u - (C[s] & 255u); const unsigned i = pos >> 4, j = pos & 15u;
            EID[(size_t)rho * 16 + s] = (int)(il[row * 33 + i] * 128u + il[row * 33 + 16 + j]); EG[(size_t)rho * 16 + s] = e[s] * is; }
    }
    NSA_FENCE();
}
typedef float f32x2_t __attribute__((ext_vector_type(2)));
constexpr float PEER_SCALE = 256.0f, PEER_ISCALE = 1.0f / 256.0f;
__device__ __forceinline__ void peer_convert_one(const Frame& F, const float* srcf, unsigned char* dstb) {
    const int gt = F.vcu * (NWAVES * 64) + F.tid, NT = F.G * NWAVES * 64;
    const f32x4* src = (const f32x4*)srcf; v4u* dst = (v4u*)dstb;
    for (int i = gt; i < 16384 * 1024 / 16; i += NT) { v4u o;
#pragma unroll
        for (int q = 0; q < 4; ++q) { const f32x4 a = src[4 * i + q] * PEER_SCALE; int w = __builtin_amdgcn_cvt_pk_fp8_f32(a[0], a[1], 0, false); w = __builtin_amdgcn_cvt_pk_fp8_f32(a[2], a[3], w, true); o[q] = (unsigned)w; }
        dst[i] = o; }
}
constexpr float PEER_SU = 768.0f, PEER_SH = 24.0f;
__device__ __forceinline__ unsigned q8pack(const f32x4 a, float sc) {
    const int q0 = (int)rintf(fminf(fmaxf(a[0] * sc, -127.f), 127.f)), q1 = (int)rintf(fminf(fmaxf(a[1] * sc, -127.f), 127.f)), q2 = (int)rintf(fminf(fmaxf(a[2] * sc, -127.f), 127.f)), q3 = (int)rintf(fminf(fmaxf(a[3] * sc, -127.f), 127.f));
    return (unsigned)(q0 & 255) | ((unsigned)(q1 & 255) << 8) | ((unsigned)(q2 & 255) << 16) | ((unsigned)(q3 & 255) << 24);
}
__device__ __forceinline__ void peer_convert_u8(const Frame& F, const float* srcf, unsigned char* dstb) {
    const int gt = F.vcu * (NWAVES * 64) + F.tid, NT = F.G * NWAVES * 64;
    const f32x4* src = (const f32x4*)srcf; v4u* dst = (v4u*)dstb;
    for (int i = gt; i < 16384 * 1024 / 16; i += NT) { v4u o;
#pragma unroll
        for (int q = 0; q < 4; ++q) o[q] = q8pack(src[4 * i + q], PEER_SU);
        dst[i] = o; }
}
__device__ __forceinline__ void peer_convert_tables(const Frame& F) { peer_convert_u8(F, F.in[31], F.ws + WS_MG); peer_convert_one(F, F.in[32], F.ws + WS_MG + 16 * MiB); }
__device__ __forceinline__ float sum8(float x) { x += dppf<0xB1>(x); x += dppf<0x4E>(x); x += dppf<0x141>(x); return x; }
template <int PHASE> __device__ __forceinline__ void peer_slice_unit(const Frame& F, int s, int tg) {
    const int lane = F.lane, j = lane & 7, gbase = lane & ~7;
    const bf16* H2 = (const bf16*)(F.ws + WS_H);
    const int* EID = (const int*)(F.ws + WS_PRW + 64 * MiB);
    float* PART = (float*)(F.ws + WS_PRW) + (size_t)s * M * 128; const float* CACT = (const float*)(F.ws + WS_PRW + 80 * MiB);
    const unsigned char* TB = F.ws + WS_MG + (PHASE == 0 ? 0 : 16 * MiB) + 128 * s + 16 * j;
#pragma unroll 1
    for (int it = 0; it < 8; ++it) { const int tk = 64 * tg + 8 * it + (lane >> 3);
        int ids[16]; float hv[16], acc[16];
        { const v4u* ip = (const v4u*)(EID + (size_t)tk * 128 + 16 * j);
#pragma unroll
          for (int q = 0; q < 4; ++q) { const v4u w = ip[q]; ids[4 * q] = (int)w.x; ids[4 * q + 1] = (int)w.y; ids[4 * q + 2] = (int)w.z; ids[4 * q + 3] = (int)w.w; } }
        int hq[4] = {0, 0, 0, 0};
        if (PHASE == 0) { const v4u h0 = *(const v4u*)(H2 + (size_t)tk * D + 128 * s + 16 * j), h1 = *(const v4u*)(H2 + (size_t)tk * D + 128 * s + 16 * j + 8);
            hq[0] = (int)q8pack((f32x4){bflo(h0.x), bfhi(h0.x), bflo(h0.y), bfhi(h0.y)}, PEER_SH); hq[1] = (int)q8pack((f32x4){bflo(h0.z), bfhi(h0.z), bflo(h0.w), bfhi(h0.w)}, PEER_SH);
            hq[2] = (int)q8pack((f32x4){bflo(h1.x), bfhi(h1.x), bflo(h1.y), bfhi(h1.y)}, PEER_SH); hq[3] = (int)q8pack((f32x4){bflo(h1.z), bfhi(h1.z), bflo(h1.w), bfhi(h1.w)}, PEER_SH); }
        else { const f32x4* cp = (const f32x4*)(CACT + (size_t)tk * 128 + 16 * j);
#pragma unroll
            for (int q = 0; q < 4; ++q) { const f32x4 c = cp[q]; hv[4 * q] = c[0]; hv[4 * q + 1] = c[1]; hv[4 * q + 2] = c[2]; hv[4 * q + 3] = c[3]; } }
#pragma unroll
        for (int m = 0; m < 16; ++m) acc[m] = 0.f;
#pragma unroll 1
        for (int jj = 0; jj < 8; ++jj) { const int src = (gbase + jj) * 4;
            v4u tv[16];
#pragma unroll
            for (int m = 0; m < 16; ++m) { const int id = __builtin_amdgcn_ds_bpermute(src, ids[m]); tv[m] = *(const v4u*)(TB + (size_t)id * 1024); }
#pragma unroll
            for (int m = 0; m < 16; ++m) {
                if (PHASE == 0) { int di = __builtin_amdgcn_sdot4((int)tv[m].x, hq[0], 0, false); di = __builtin_amdgcn_sdot4((int)tv[m].y, hq[1], di, false); di = __builtin_amdgcn_sdot4((int)tv[m].z, hq[2], di, false); di = __builtin_amdgcn_sdot4((int)tv[m].w, hq[3], di, false);
                    const float d = sum8((float)di); acc[m] = (j == jj) ? d : acc[m]; }
                else {
                    float f[16];
#pragma unroll
                    for (int q = 0; q < 4; ++q) { const f32x2_t lo = __builtin_amdgcn_cvt_pk_f32_fp8((int)tv[m][q], false), hi = __builtin_amdgcn_cvt_pk_f32_fp8((int)tv[m][q], true); f[4 * q] = lo.x; f[4 * q + 1] = lo.y; f[4 * q + 2] = hi.x; f[4 * q + 3] = hi.y; } const float c = __builtin_bit_cast(float, __builtin_amdgcn_ds_bpermute(src, __builtin_bit_cast(int, hv[m])));
#pragma unroll
                    for (int q = 0; q < 16; ++q) acc[q] += c * f[q]; } }
        }
        if (PHASE == 0) { f32x4* pp = (f32x4*)(PART + (size_t)tk * 128 + 16 * j);
#pragma unroll
            for (int q = 0; q < 4; ++q) pp[q] = (f32x4){acc[4 * q], acc[4 * q + 1], acc[4 * q + 2], acc[4 * q + 3]}; }
        else { f32x4* op = (f32x4*)(F.out + (size_t)tk * D + 128 * s + 16 * j);
#pragma unroll
            for (int q = 0; q < 4; ++q) { f32x4 a = op[q]; a[0] += acc[4 * q] * PEER_ISCALE; a[1] += acc[4 * q + 1] * PEER_ISCALE; a[2] += acc[4 * q + 2] * PEER_ISCALE; a[3] += acc[4 * q + 3] * PEER_ISCALE; op[q] = a; } }
    }
}
template <int PHASE> __device__ __forceinline__ void peer_slice_phase(const Frame& F, int rep) {
    const int q0 = (int)(xb_xcc_id() & 7u);
    for (int qi = 0; qi < 8; ++qi) { const int q = (q0 + qi) & 7;
        for (;;) { unsigned c = 0;
            if (F.lane == 0) c = __hip_atomic_fetch_add(F.ctl + CW_PEERQ + 64 * (16 * rep + 8 * PHASE + q), 1u, RLX_AGENT);
            c = (unsigned)__builtin_amdgcn_readfirstlane((int)c);
            if (c >= 256u) break;
            peer_slice_unit<PHASE>(F, q, (int)c); } }
}
__device__ __forceinline__ void peer_act_phase(const Frame& F) {
    const int gt = F.vcu * (NWAVES * 64) + F.tid, NT = F.G * NWAVES * 64;
    const float* PART = (const float*)(F.ws + WS_PRW); const float* EG = (const float*)(F.ws + WS_PRW + 72 * MiB); float* CACT = (float*)(F.ws + WS_PRW + 80 * MiB);
    for (int i = gt; i < M * 128 / 4; i += NT) { f32x4 d = {0.f, 0.f, 0.f, 0.f};
#pragma unroll
        for (int s = 0; s < 8; ++s) d += ((const f32x4*)PART)[(size_t)s * (M * 128 / 4) + i];
        const f32x4 g = ((const f32x4*)EG)[i]; f32x4 c;
#pragma unroll
        for (int e = 0; e < 4; ++e) { const float dt = d[e] * (1.0f / (PEER_SU * PEER_SH)); c[e] = g[e] * 0.5f * dt * (1.f + erff(dt * 0.70710678118654752f)); }
        ((f32x4*)CACT)[i] = c; }
}
struct Args { const float* in[33]; float* out; unsigned char* ws; int ph_lo, ph_hi; };
__global__ void __launch_bounds__(NWAVES * 64, 2) mk_fwd(Args args) {
    extern __shared__ __attribute__((aligned(16))) unsigned char lds[];
    Frame F;
    F.lds = (LAS unsigned char*)lds;
    F.MISC = (volatile LAS unsigned*)(F.lds + MISC_OFF);
    F.tid = threadIdx.x; F.lane = F.tid & 63; F.wave = __builtin_amdgcn_readfirstlane(F.tid >> 6);
    F.G = gridDim.x; { const int bx = blockIdx.x; F.vcu = (F.G % 8 == 0) ? (bx % 8) * (F.G / 8) + bx / 8 : bx; }
    unsigned char* ws = args.ws; F.ws = ws; F.out = args.out;
    F.ctl = (gu32*)(ws + WS_CTL);
#pragma unroll
    for (int i = 0; i < 33; ++i) F.in[i] = args.in[i];
    for (int u = F.tid; u < (LDS_BYTES - LDSCTL_OFF) / 4; u += NWAVES * 64) ((LAS unsigned*)(F.lds + LDSCTL_OFF))[u] = 0u;
    __syncthreads();
    const int lo = args.ph_lo, hi = args.ph_hi & 0xff; const int rep = args.ph_hi >> 8;
    const bool multi = (hi - lo) > 1;
    XcdBarrier bar; bar.bar = (unsigned*)(F.ctl + CW_BAR); bar.x = 0; bar.st = nullptr;
    if (multi) bar = xcd_barrier_post((unsigned*)(F.ctl + CW_BAR), F.MISC + 8);
#define IN(k) (lo <= (k) && (k) < hi)
#define NREP(k) ((((repmask) >> (k)) & 1) + 1)
#define REPBAR() do { if (rep) xcd_barrier(bar); } while (0)
#define SEAM(k) do { if (IN(k) && IN((k) + 1)) xcd_barrier(bar); } while (0)

    if (IN(0)) { { p0_prologue(F); } } SEAM(0);
    if (IN(1)) { {
        pg8::Gemm g{(const pg8::bf16_t*)(ws + WS_H), (const pg8::bf16_t*)(ws + WS_WIN), M, NG1, D}; pg8::StaticOrder S; S.init(M, NG1, F.G, (int)blockIdx.x);
        pg8::EpiG1 E{(float*)(ws + WS_PRW), (float*)(ws + WS_BND), (pg8::bf16_t*)((unsigned char*)F.out + DO_PNSA), (pg8::bf16_t*)(ws + WS_MG), (float*)((unsigned char*)F.out + DO_GLOG)};
        pg8::gemm_phase<pg8::EpiG1, pg8::StaticOrder, true, true>(F.lds + RING_OFF, g, S, E);
    } } SEAM(1);
    if (IN(2)) {
        for (int u = F.vcu; u < 256; u += F.G) nsa_prep_tile(F, u);
        for (int u = F.vcu; u < 256; u += F.G) compress_unit(F, u);
        for (int u = F.vcu; u < 256; u += F.G) rwkv_prep_tile(F, u);
    } SEAM(2);
    if (IN(3)) { {
        if ((int)blockIdx.x < 32 && !(rep && P3REP == 3)) { if (F.wave < 4) rwkv_scan_wave(F, (int)blockIdx.x, F.wave); else if (F.wave == 4) rwkv_scan_prefetch(F, (int)blockIdx.x); __syncthreads(); }
        if (!(rep && P3REP == 2)) nsa_phase(F, rep);
    } } SEAM(3);
    if (IN(4)) { { rwkv_epilogue(F); } } SEAM(4);
    if (IN(5)) { {
        { pg8::Gemm g{(const pg8::bf16_t*)(ws + WS_H), (const pg8::bf16_t*)(ws + WS_WA), M, D, 512}; pg8::StaticOrder S; S.init(M, D, F.G, (int)blockIdx.x);
          pg8::EpiGate1 E{(float*)(ws + WS_PRW), (const pg8::bf16_t*)(ws + WS_MG), 0};
          pg8::gemm_phase<pg8::EpiGate1, pg8::StaticOrder, true, true>(F.lds + RING_OFF, g, S, E); }
        VM_WAIT(); __syncthreads();
        { pg8::Gemm g{(const pg8::bf16_t*)(ws + WS_H + 16 * MiB), (const pg8::bf16_t*)(ws + WS_WB), M, D, 512}; pg8::StaticOrder S; S.init(M, D, F.G, (int)blockIdx.x);
          pg8::EpiGate2 E{(const float*)(ws + WS_PRW), (const pg8::bf16_t*)(ws + WS_MG), 1024, (pg8::bf16_t*)(ws + WS_PRW + 64 * MiB)};
          pg8::gemm_phase<pg8::EpiGate2, pg8::StaticOrder, true, true>(F.lds + RING_OFF, g, S, E); }
    } } SEAM(5);
    if (IN(6)) { {
        pg8::Gemm g{(const pg8::bf16_t*)(ws + WS_PRW + 64 * MiB), (const pg8::bf16_t*)(ws + WS_WOUT), M, D, D}; pg8::StaticOrder S; S.init(M, D, F.G, (int)blockIdx.x);
        pg8::EpiRes E{F.in[0], F.out};
        pg8::gemm_phase<pg8::EpiRes, pg8::StaticOrder, true, true>(F.lds + RING_OFF, g, S, E);
    } } SEAM(6);
    if (IN(7)) { { const int gw = F.vcu * NWAVES + F.wave, NGW = F.G * NWAVES;
        for (int m = gw; m < M; m += NGW) rms_row_to_bf16(F.lane, F.out + (size_t)m * D, F.in[27], (bf16*)(ws + WS_H) + (size_t)m * D);
        peer_convert_tables(F);
    } } SEAM(7);
    if (IN(8)) { {
        pg8::Gemm g{(const pg8::bf16_t*)(ws + WS_H), (const pg8::bf16_t*)(ws + WS_WQ), M, 2048, D}; pg8::StaticOrder S; S.init(M, 2048, F.G, (int)blockIdx.x);
        pg8::EpiBf16<0> E{(pg8::bf16_t*)(ws + WS_PRW), 2048, nullptr, 0, 0, 1.f};
        pg8::gemm_phase<pg8::EpiBf16<0>, pg8::StaticOrder, true, true>(F.lds + RING_OFF, g, S, E);
    } } SEAM(8);
    if (IN(9)) { { const int gw = F.vcu * NWAVES + F.wave, NGW = F.G * NWAVES; LAS float* sc = (LAS float*)(F.lds + F.wave * 16384);
        for (int wp = gw; wp < M * 8 / 32; wp += NGW) peer_topk_pass(F, wp, sc);
    } } SEAM(9);
    if (IN(10)) { peer_slice_phase<0>(F, rep); } SEAM(10);
    if (IN(11)) { peer_act_phase(F); } SEAM(11);
    if (IN(12)) { peer_slice_phase<1>(F, rep); }
    if (DBG_SEL >= 0 && multi) { xcd_barrier(bar); if (blockIdx.x == 0 && F.tid == 0) { const float* dbg = (const float*)(ws + WS_KC + 524288); F.out[0] += (DBG_SEL == 0) ? (0.05f + 0.1f * dbg[0]) : (0.05f + dbg[1] * 1e-7f); } }
#undef IN
#undef SEAM
}

extern "C" void kernel_launch(void* const* d_in, const int* in_sizes, int n_in, void* d_out, int out_size, void* d_ws, size_t ws_size, hipStream_t stream) {
    static int grid = 0;
    if (grid == 0) {
        if (n_in != 33 || out_size != M * D || ws_size < WS_END) { fprintf(stderr, "kernel_launch: unexpected shapes (n_in %d out %d ws %zu)\n", n_in, out_size, ws_size); grid = -1; return; }
        int dev = 0, cus = 0, per_cu = 0;
        if (hipGetDevice(&dev) != hipSuccess || hipDeviceGetAttribute(&cus, hipDeviceAttributeMultiprocessorCount, dev) != hipSuccess) { grid = -1; return; }
        if (hipFuncSetAttribute((const void*)mk_fwd, hipFuncAttributeMaxDynamicSharedMemorySize, LDS_BYTES) != hipSuccess) { fprintf(stderr, "kernel_launch: hipFuncSetAttribute failed\n"); grid = -1; return; }
        if (hipOccupancyMaxActiveBlocksPerMultiprocessor(&per_cu, (const void*)mk_fwd, NWAVES * 64, LDS_BYTES) != hipSuccess || per_cu < 1)
            fprintf(stderr, "kernel_launch: occupancy query reports %d blocks per CU\n", per_cu);
        (void)hipGetLastError();
        grid = cus;
        if (grid > 256) grid = 256;
    }
    if (grid < 0) return;
    if (hipMemsetAsync((char*)d_ws + WS_CTL, 0, CTL_ZERO_BYTES, stream) != hipSuccess) return;
    Args a{};
    for (int i = 0; i < 33; ++i) a.in[i] = (const float*)d_in[i];
    a.out = (float*)d_out; a.ws = (unsigned char*)d_ws;
#if MK_ONE_LAUNCH
    a.ph_lo = 0; a.ph_hi = N_PHASES;
    hipLaunchKernelGGL(mk_fwd, dim3(grid), dim3(NWAVES * 64), LDS_BYTES, stream, a);
#else
    for (int p = 0; p < N_PHASES; ++p) { for (int r = 0; r <= (((REP_MASK) >> p) & 1); ++r) { a.ph_lo = p; a.ph_hi = (p + 1) | (r << 8); hipLaunchKernelGGL(mk_fwd, dim3(grid), dim3(NWAVES * 64), LDS_BYTES, stream, a); } }
#endif
}
```

```cpp
#include <hip/hip_runtime.h>
#include <cstdio>
#include <cstdint>
#define MK_ONE_LAUNCH 1
#define REP_MASK 0
#define P3REP 1
#define NSA_SKIP 0
#define DBG_SEL -1
namespace pg8 {
#define PG8_LAS __attribute__((address_space(3)))
typedef unsigned short bf16_t;
typedef short bf16x8 __attribute__((ext_vector_type(8)));
typedef float f32x4 __attribute__((ext_vector_type(4)));
typedef unsigned u32x4 __attribute__((ext_vector_type(4)));
constexpr int BM = 256, BK = 64, HALF = 128, HTB = HALF * BK * 2  , STAGE_BYTES = 8 * HTB, NXCD = 8, WGM = 8;

__host__ __device__ __forceinline__ int lds_byte(int r, int c) { const int st = (r >> 4) * 2 + (c >> 5), rr = r & 15, cc = c & 31, ob = rr * 64 + cc * 2; return st * 1024 + (ob ^ (((ob >> 9) & 1) << 5)); }
__host__ __device__ __forceinline__ void stage_rc(int b, int& R, int& C) { const int st = b / 1024, sb = b % 1024, swz = sb ^ (((sb >> 9) & 1) << 5); R = (st >> 1) * 16 + swz / 64; C = (st & 1) * 32 + (swz % 64) / 2; }
__host__ __device__ __forceinline__ int perm32(int rho) { const int n = rho >> 4, i = rho & 15; return 8 * (i >> 2) + 4 * n + (i & 3); }

struct Unit { int pm, pn; };
struct Gemm { const bf16_t* A; const bf16_t* Bt; int M, N, K; };

struct StaticOrder {
    int nM, nN, nwg, G, c;
    __host__ __device__ void init(int M, int N, int G_, int c_) { nM = M / BM; nN = N / BM; nwg = nM * nN; G = G_; c = c_; }
    __host__ __device__ bool next(int i, Unit& u) const {
        const long L = (long)i * G + c; if (L >= nwg) return false;
        int wgid = (int)L; { const int q = nwg / NXCD, r = nwg % NXCD, xcd = wgid % NXCD, off = wgid / NXCD; wgid = (xcd < r ? xcd * (q + 1) : r * (q + 1) + (xcd - r) * q) + off; }
        const int nig = WGM * nN, gid = wgid / nig, fm = gid * WGM, gsz = (nM - fm) < WGM ? (nM - fm) : WGM;
        u.pm = fm + ((wgid % nig) % gsz); u.pn = (wgid % nig) / gsz; return true;
    }
    __device__ __forceinline__ void a_ready(const Unit&) const {}
    __device__ __forceinline__ void done(const Unit&) const {}
};

typedef float f32x2c __attribute__((ext_vector_type(2))); typedef __bf16 bf16x2c __attribute__((ext_vector_type(2)));
__device__ __forceinline__ unsigned cvt_pk_bf16(float lo, float hi) { const f32x2c v = {lo, hi}; const bf16x2c b = __builtin_convertvector(v, bf16x2c); return __builtin_bit_cast(unsigned, b); }
typedef float f32x2 __attribute__((ext_vector_type(2)));
__device__ __forceinline__ f32x2 gelu_pk(f32x2 v) {
    const f32x2 av = __builtin_elementwise_abs(v), d = av * 0.2316418882f + 1.0f;
    f32x2 t; t.x = __builtin_amdgcn_rcpf(d.x); t.y = __builtin_amdgcn_rcpf(d.y);
    f32x2 q = t * 0.5307027145f + (-0.7265760135f); q = q * t + 0.7107068705f; q = q * t + (-0.142248368f); q = q * t + 0.127414796f; q = q * t;
    const f32x2 s = (v * v) * (-0.72134752044f);
    f32x2 e; e.x = __builtin_amdgcn_exp2f(s.x); e.y = __builtin_amdgcn_exp2f(s.y);
    const f32x2 m = v * (q * e), r = v - m;
    f32x2 o; o.x = v.x < 0.f ? m.x : r.x; o.y = v.y < 0.f ? m.y : r.y; return o;
}

template <int ACT  > struct EpiBf16 {
    static constexpr bool PERM = true, AFTER_DRAIN = false; static_assert(ACT == 0 || ACT == 1, "EpiBf16: ACT is 0 (none) or 1 (gelu_pk)");
    bf16_t* O; int ldc; const float* bias; int split_cols; size_t split_stride; float scale0;
    __device__ __forceinline__ void operator()(const f32x4 (&acc)[2][2][4][2], const Unit& u, int wr, int wc, int fr, int fq) const {
        const int row0 = u.pm * BM + wr * 64 + fr; int colt = u.pn * BM; bf16_t* base = O;
        float sc = 1.f; if (split_cols) { const int t = colt / split_cols; base += (size_t)t * split_stride; colt -= t * split_cols; if (t == 0) sc = scale0; }
        const int col0 = colt + wc * 32 + 8 * fq, bcol0 = u.pn * BM + wc * 32 + 8 * fq;
        f32x4 bv[2][2];
#pragma unroll
        for (int bj = 0; bj < 2; ++bj)
#pragma unroll
            for (int n = 0; n < 2; ++n) bv[bj][n] = bias ? *(const f32x4*)(bias + bcol0 + bj * HALF + 4 * n) : (f32x4){0.f, 0.f, 0.f, 0.f};
#pragma unroll
        for (int ai = 0; ai < 2; ++ai)
#pragma unroll
            for (int m = 0; m < 4; ++m) { bf16_t* rowp = base + (size_t)(row0 + ai * HALF + m * 16) * ldc + col0;
#pragma unroll
                for (int bj = 0; bj < 2; ++bj) { f32x4 v0 = acc[ai][bj][m][0] + bv[bj][0], v1 = acc[ai][bj][m][1] + bv[bj][1];
                    if (ACT == 1) { f32x2 a = gelu_pk((f32x2){v0[0], v0[1]}), b = gelu_pk((f32x2){v0[2], v0[3]}), c = gelu_pk((f32x2){v1[0], v1[1]}), d = gelu_pk((f32x2){v1[2], v1[3]});
                        v0 = (f32x4){a.x, a.y, b.x, b.y}; v1 = (f32x4){c.x, c.y, d.x, d.y}; }
                    v0 = v0 * sc; v1 = v1 * sc; u32x4 w; w.x = cvt_pk_bf16(v0[0], v0[1]); w.y = cvt_pk_bf16(v0[2], v0[3]); w.z = cvt_pk_bf16(v1[0], v1[1]); w.w = cvt_pk_bf16(v1[2], v1[3]);
                    *(u32x4*)(rowp + bj * HALF) = w; } }
    }
};
__device__ __forceinline__ float bf_lo(unsigned w) { return __uint_as_float(w << 16); }
__device__ __forceinline__ float bf_hi(unsigned w) { return __uint_as_float(w & 0xffff0000u); }
__device__ __forceinline__ float sigm(float x) { return __builtin_amdgcn_rcpf(1.0f + __expf(-x)); }
__device__ __forceinline__ u32x4 pack8(const f32x4 v0, const f32x4 v1) { u32x4 w; w.x = cvt_pk_bf16(v0[0], v0[1]); w.y = cvt_pk_bf16(v0[2], v0[3]); w.z = cvt_pk_bf16(v1[0], v1[1]); w.w = cvt_pk_bf16(v1[2], v1[3]); return w; }

struct EpiG1 {
    static constexpr bool PERM = true, AFTER_DRAIN = false;
    float* PRW; float* BND; bf16_t* PNSA; bf16_t* MG; float* GLOG;
    __device__ __forceinline__ void operator()(const f32x4 (&acc)[2][2][4][2], const Unit& u, int wr, int wc, int fr, int fq) const {
        const int row0 = u.pm * BM + wr * 64 + fr, c0 = wc * 32 + 8 * fq;
#pragma unroll
        for (int ai = 0; ai < 2; ++ai)
#pragma unroll
            for (int m = 0; m < 4; ++m) { const int row = row0 + ai * HALF + m * 16;
#pragma unroll
                for (int bj = 0; bj < 2; ++bj) { const f32x4 v0 = acc[ai][bj][m][0], v1 = acc[ai][bj][m][1]; const int col = c0 + bj * HALF;
                    if (u.pn < 7) { float* p = PRW + (size_t)row * 1792 + u.pn * 256 + col; *(f32x4*)p = v0; *(f32x4*)(p + 4) = v1;
                        if ((row & 63) == 63) { float* q = BND + (size_t)(row >> 6) * 1792 + u.pn * 256 + col; *(f32x4*)q = v0; *(f32x4*)(q + 4) = v1; } }
                    else if (u.pn < 12) { *(u32x4*)(PNSA + (size_t)row * 1280 + (u.pn - 7) * 256 + col) = pack8(v0, v1); }
                    else if (u.pn < 20) { *(u32x4*)(MG + (size_t)row * 2048 + (u.pn - 12) * 256 + col) = pack8(v0, v1); }
                    else { if (col < 32) { float* p = GLOG + (size_t)row * 32 + col; *(f32x4*)p = v0; *(f32x4*)(p + 4) = v1; } }
                } }
    }
};
struct EpiGate1 {
    static constexpr bool PERM = true, AFTER_DRAIN = false;
    float* T1; const bf16_t* MG; int goff;
    __device__ __forceinline__ void operator()(const f32x4 (&acc)[2][2][4][2], const Unit& u, int wr, int wc, int fr, int fq) const {
        const int row0 = u.pm * BM + wr * 64 + fr, c0 = u.pn * BM + wc * 32 + 8 * fq;
#pragma unroll
        for (int ai = 0; ai < 2; ++ai)
#pragma unroll
            for (int m = 0; m < 4; ++m) { const int row = row0 + ai * HALF + m * 16;
#pragma unroll
                for (int bj = 0; bj < 2; ++bj) { const f32x4 v0 = acc[ai][bj][m][0], v1 = acc[ai][bj][m][1]; const int col = c0 + bj * HALF;
                    const u32x4 g = *(const u32x4*)(MG + (size_t)row * 2048 + goff + col);
                    f32x4 o0, o1; o0[0] = sigm(bf_lo(g.x)) * v0[0]; o0[1] = sigm(bf_hi(g.x)) * v0[1]; o0[2] = sigm(bf_lo(g.y)) * v0[2]; o0[3] = sigm(bf_hi(g.y)) * v0[3];
                    o1[0] = sigm(bf_lo(g.z)) * v1[0]; o1[1] = sigm(bf_hi(g.z)) * v1[1]; o1[2] = sigm(bf_lo(g.w)) * v1[2]; o1[3] = sigm(bf_hi(g.w)) * v1[3];
                    float* p = T1 + (size_t)row * 1024 + col; *(f32x4*)p = o0; *(f32x4*)(p + 4) = o1; } }
    }
};
struct EpiGate2 {
    static constexpr bool PERM = true, AFTER_DRAIN = false;
    const float* T1; const bf16_t* MG; int goff; bf16_t* MIX;
    __device__ __forceinline__ void operator()(const f32x4 (&acc)[2][2][4][2], const Unit& u, int wr, int wc, int fr, int fq) const {
        const int row0 = u.pm * BM + wr * 64 + fr, c0 = u.pn * BM + wc * 32 + 8 * fq;
#pragma unroll
        for (int ai = 0; ai < 2; ++ai)
#pragma unroll
            for (int m = 0; m < 4; ++m) { const int row = row0 + ai * HALF + m * 16;
#pragma unroll
                for (int bj = 0; bj < 2; ++bj) { const f32x4 v0 = acc[ai][bj][m][0], v1 = acc[ai][bj][m][1]; const int col = c0 + bj * HALF;
                    const u32x4 g = *(const u32x4*)(MG + (size_t)row * 2048 + goff + col);
                    const float* p = T1 + (size_t)row * 1024 + col; const f32x4 t0 = *(const f32x4*)p, t1 = *(const f32x4*)(p + 4);
                    f32x4 o0, o1; o0[0] = t0[0] + sigm(bf_lo(g.x)) * v0[0]; o0[1] = t0[1] + sigm(bf_hi(g.x)) * v0[1]; o0[2] = t0[2] + sigm(bf_lo(g.y)) * v0[2]; o0[3] = t0[3] + sigm(bf_hi(g.y)) * v0[3];
                    o1[0] = t1[0] + sigm(bf_lo(g.z)) * v1[0]; o1[1] = t1[1] + sigm(bf_hi(g.z)) * v1[1]; o1[2] = t1[2] + sigm(bf_lo(g.w)) * v1[2]; o1[3] = t1[3] + sigm(bf_hi(g.w)) * v1[3];
                    *(u32x4*)(MIX + (size_t)row * 1024 + col) = pack8(o0, o1); } }
    }
};
struct EpiRes {
    static constexpr bool PERM = true, AFTER_DRAIN = false;
    const float* X; float* OUT;
    __device__ __forceinline__ void operator()(const f32x4 (&acc)[2][2][4][2], const Unit& u, int wr, int wc, int fr, int fq) const {
        const int row0 = u.pm * BM + wr * 64 + fr, c0 = u.pn * BM + wc * 32 + 8 * fq;
#pragma unroll
        for (int ai = 0; ai < 2; ++ai)
#pragma unroll
            for (int m = 0; m < 4; ++m) { const int row = row0 + ai * HALF + m * 16;
#pragma unroll
                for (int bj = 0; bj < 2; ++bj) { const size_t off = (size_t)row * 1024 + c0 + bj * HALF;
                    const f32x4 x0 = *(const f32x4*)(X + off), x1 = *(const f32x4*)(X + off + 4);
                    *(f32x4*)(OUT + off) = x0 + acc[ai][bj][m][0]; *(f32x4*)(OUT + off + 4) = x1 + acc[ai][bj][m][1]; } }
    }
};
template <class Epi, class Sched, bool ALIGN_EPI = false, bool SP2 = false>
__device__ __forceinline__ void gemm_phase(PG8_LAS unsigned char* lds, const Gemm g, const Sched& S, const Epi& E) {
    const int tid = threadIdx.x, wid = __builtin_amdgcn_readfirstlane(tid >> 6), lane = tid & 63, wr = wid >> 2, wc = wid & 3, fr = lane & 15, fq = lane >> 4;
    const int K = g.K, nt = K / BK;
    unsigned voffA[2], voffB[2];
#pragma unroll
    for (int i = 0; i < 2; ++i) { int R, C; stage_rc(tid * 16 + i * 8192, R, C); const int Rb = Epi::PERM ? ((R & ~31) + perm32(R & 31)) : R;
        voffA[i] = (unsigned)(R * K + C) * 2u; voffB[i] = (unsigned)(Rb * K + C) * 2u; }
    const size_t kstep = (size_t)(BK * 2);
    const size_t hstep = (size_t)HALF * K * 2;
    const size_t tstep = 2 * hstep;
    const unsigned ldsw = (unsigned)wid * 1024u;
    const int aoff = lds_byte(wr * 64 + fr, fq * 8), boff = lds_byte(wc * 32 + fr, fq * 8);
#define PG8_SA(b, h) (((b) * 2 + (h)) * HTB)
#define PG8_SB(b, h) ((4 + (b) * 2 + (h)) * HTB)
#define PG8_STAGE(bufoff, gbase, voff) do { _Pragma("unroll") for (int _i = 0; _i < 2; ++_i) \
        __builtin_amdgcn_global_load_lds((const unsigned*)((const char*)(gbase) + (voff)[_i]), (PG8_LAS unsigned*)(lds + (bufoff) + ldsw + _i * 8192), 16, 0, 0); } while (0)
#define PG8_LDA(dst, b, h) do { _Pragma("unroll") for (int m = 0; m < 4; ++m) _Pragma("unroll") for (int k = 0; k < 2; ++k) dst[m][k] = *(const PG8_LAS bf16x8*)(lds + PG8_SA(b, h) + aoff + m * 2048 + k * 1024); } while (0)
#define PG8_LDB(dst, b, h) do { _Pragma("unroll") for (int n = 0; n < 2; ++n) _Pragma("unroll") for (int k = 0; k < 2; ++k) dst[n][k] = *(const PG8_LAS bf16x8*)(lds + PG8_SB(b, h) + boff + n * 2048 + k * 1024); } while (0)
#define PG8_MMA(ai, bj, At, Bt) do { __builtin_amdgcn_s_setprio(1); _Pragma("unroll") for (int m = 0; m < 4; ++m) _Pragma("unroll") for (int n = 0; n < 2; ++n) _Pragma("unroll") for (int k = 0; k < 2; ++k) \
        acc[ai][bj][m][n] = __builtin_amdgcn_mfma_f32_16x16x32_bf16(Bt[n][k], At[m][k], acc[ai][bj][m][n], 0, 0, 0); __builtin_amdgcn_s_setprio(0); } while (0)
#define PG8_WAIT_V(n) asm volatile("s_waitcnt vmcnt(" #n ")" ::: "memory")
#define PG8_WAIT_L(n) asm volatile("s_waitcnt lgkmcnt(" #n ")" ::: "memory")
#define PG8_BAR __builtin_amdgcn_s_barrier()
#define PG8_SCHED __builtin_amdgcn_sched_barrier(0)
    Unit cur, nxt; int ui = 0;
    if (!S.next(0, cur)) return;
    f32x4 acc[2][2][4][2];
#pragma unroll
    for (int a = 0; a < 2; ++a)
#pragma unroll
        for (int b = 0; b < 2; ++b)
#pragma unroll
            for (int m = 0; m < 4; ++m)
#pragma unroll
                for (int n = 0; n < 2; ++n) acc[a][b][m][n] = (f32x4){0.f, 0.f, 0.f, 0.f};
    bf16x8 At[4][2], B0[2][2], B1[2][2];
    const char* cA = (const char*)g.A + (size_t)cur.pm * tstep; const char* cB = (const char*)g.Bt + (size_t)cur.pn * tstep;
    S.a_ready(cur);
    if constexpr (SP2) {
        PG8_STAGE(PG8_SB(0, 0), cB, voffB); PG8_STAGE(PG8_SB(0, 1), cB + hstep, voffB); PG8_STAGE(PG8_SA(0, 0), cA, voffA); PG8_STAGE(PG8_SA(0, 1), cA + hstep, voffA);
        if (wr == 1) PG8_BAR;
        PG8_WAIT_V(2); PG8_BAR;
        PG8_STAGE(PG8_SB(1, 0), cB + kstep, voffB); PG8_STAGE(PG8_SA(1, 0), cA + kstep, voffA); PG8_STAGE(PG8_SB(1, 1), cB + hstep + kstep, voffB);
        PG8_WAIT_V(6); PG8_BAR;
    } else {
        PG8_STAGE(PG8_SB(0, 0), cB, voffB); PG8_STAGE(PG8_SA(0, 0), cA, voffA); PG8_STAGE(PG8_SB(0, 1), cB + hstep, voffB); PG8_STAGE(PG8_SA(0, 1), cA + hstep, voffA);
        if (wr == 1) PG8_BAR;
        PG8_WAIT_V(4); PG8_BAR;
        PG8_STAGE(PG8_SB(1, 0), cB + kstep, voffB); PG8_STAGE(PG8_SA(1, 0), cA + kstep, voffA); PG8_STAGE(PG8_SB(1, 1), cB + hstep + kstep, voffB);
        PG8_WAIT_V(6); PG8_BAR;
    }
    for (;;) {
        const bool has_next = S.next(ui + 1, nxt);
        const char* nA = has_next ? (const char*)g.A + (size_t)nxt.pm * tstep : cA; const char* nB = has_next ? (const char*)g.Bt + (size_t)nxt.pn * tstep : cB;
        for (int t = 0; t < nt; t += 2) {
            const bool last = (t == nt - 2);
            const char* a1 = cA + (size_t)(t + 1) * kstep;
            const char* a2 = last ? nA : cA + (size_t)(t + 2) * kstep; const char* b2 = last ? nB : cB + (size_t)(t + 2) * kstep;
            const char* a3 = a2 + kstep; const char* b3 = b2 + kstep;
            if (last && has_next) S.a_ready(nxt);
            if constexpr (SP2) {
            PG8_LDB(B0, 0, 0); PG8_LDB(B1, 0, 1); PG8_SCHED; PG8_LDA(At, 0, 0); PG8_STAGE(PG8_SA(1, 1), a1 + hstep, voffA);
            PG8_WAIT_V(8); PG8_WAIT_L(0); PG8_BAR; PG8_MMA(0, 0, At, B0); PG8_MMA(0, 1, At, B1); PG8_BAR; PG8_SCHED;
            PG8_LDA(At, 0, 1); PG8_STAGE(PG8_SB(0, 0), b2, voffB); PG8_STAGE(PG8_SB(0, 1), b2 + hstep, voffB); PG8_STAGE(PG8_SA(0, 0), a2, voffA);
            PG8_WAIT_V(8); PG8_WAIT_L(0); PG8_BAR; PG8_MMA(1, 0, At, B0); PG8_MMA(1, 1, At, B1); PG8_BAR; PG8_SCHED;
            PG8_LDB(B0, 1, 0); PG8_LDB(B1, 1, 1); PG8_SCHED; PG8_LDA(At, 1, 0); PG8_STAGE(PG8_SA(0, 1), a2 + hstep, voffA);
            PG8_WAIT_V(8); PG8_WAIT_L(0); PG8_BAR; PG8_MMA(0, 0, At, B0); PG8_MMA(0, 1, At, B1); PG8_BAR; PG8_SCHED;
            PG8_LDA(At, 1, 1); PG8_STAGE(PG8_SB(1, 0), b3, voffB); PG8_STAGE(PG8_SB(1, 1), b3 + hstep, voffB); PG8_STAGE(PG8_SA(1, 0), a3, voffA);
            PG8_WAIT_V(8); PG8_WAIT_L(0); PG8_BAR; PG8_MMA(1, 0, At, B0); PG8_MMA(1, 1, At, B1); PG8_BAR; PG8_SCHED;
            } else {
            PG8_LDB(B0, 0, 0); PG8_SCHED; PG8_LDA(At, 0, 0); PG8_STAGE(PG8_SA(1, 1), a1 + hstep, voffA);
            PG8_WAIT_L(8); PG8_BAR; PG8_WAIT_L(0); PG8_MMA(0, 0, At, B0); PG8_BAR; PG8_SCHED;
            PG8_LDB(B1, 0, 1); PG8_STAGE(PG8_SB(0, 0), b2, voffB);
            PG8_BAR; PG8_WAIT_L(0); PG8_MMA(0, 1, At, B1); PG8_BAR;
            PG8_LDA(At, 0, 1); PG8_STAGE(PG8_SA(0, 0), a2, voffA);
            PG8_BAR; PG8_WAIT_L(0); PG8_MMA(1, 0, At, B0); PG8_BAR; PG8_SCHED;
            PG8_STAGE(PG8_SB(0, 1), b2 + hstep, voffB);
            PG8_WAIT_V(6); PG8_BAR; PG8_MMA(1, 1, At, B1); PG8_BAR;
            PG8_LDB(B0, 1, 0); PG8_SCHED; PG8_LDA(At, 1, 0); PG8_STAGE(PG8_SA(0, 1), a2 + hstep, voffA);
            PG8_WAIT_L(8); PG8_BAR; PG8_WAIT_L(0); PG8_MMA(0, 0, At, B0); PG8_BAR; PG8_SCHED;
            PG8_LDB(B1, 1, 1); PG8_STAGE(PG8_SB(1, 0), b3, voffB);
            PG8_BAR; PG8_WAIT_L(0); PG8_MMA(0, 1, At, B1); PG8_BAR;
            PG8_LDA(At, 1, 1); PG8_STAGE(PG8_SA(1, 0), a3, voffA);
            PG8_BAR; PG8_WAIT_L(0); PG8_MMA(1, 0, At, B0); PG8_BAR; PG8_SCHED;
            PG8_STAGE(PG8_SB(1, 1), b3 + hstep, voffB);
            PG8_WAIT_V(6); PG8_BAR; PG8_MMA(1, 1, At, B1); PG8_BAR;
            }
        }
        if constexpr (ALIGN_EPI) { if (wr == 0) PG8_BAR; }
        if constexpr (!Epi::AFTER_DRAIN) { E(acc, cur, wr, wc, fr, fq); S.done(cur); }
        if (!has_next) break;
#pragma unroll
        for (int a = 0; a < 2; ++a)
#pragma unroll
            for (int b = 0; b < 2; ++b)
#pragma unroll
                for (int m = 0; m < 4; ++m)
#pragma unroll
                    for (int n = 0; n < 2; ++n) acc[a][b][m][n] = (f32x4){0.f, 0.f, 0.f, 0.f};
        cur = nxt; cA = nA; cB = nB; ++ui;
        if constexpr (ALIGN_EPI) { if (wr == 1) PG8_BAR; }
    }
    PG8_WAIT_V(0);
    if constexpr (!ALIGN_EPI) { if (wr == 0) PG8_BAR; }
    PG8_BAR;
    if constexpr (Epi::AFTER_DRAIN) { E.fused(acc, cur, wr, wc, fr, fq, lds, wid, lane); S.done(cur); }
#undef PG8_SA
#undef PG8_SB
#undef PG8_STAGE
#undef PG8_LDA
#undef PG8_LDB
#undef PG8_MMA
#undef PG8_WAIT_V
#undef PG8_WAIT_L
#undef PG8_BAR
#undef PG8_SCHED
}
}
#define GAS __attribute__((address_space(1)))
#define LAS __attribute__((address_space(3)))
typedef unsigned short bf16;
typedef unsigned v4u __attribute__((ext_vector_type(4)));
typedef float f32x4 __attribute__((ext_vector_type(4)));
typedef short bf16x8 __attribute__((ext_vector_type(8)));
typedef GAS unsigned gu32;
typedef GAS unsigned long long gu64;
#define RLX_AGENT __ATOMIC_RELAXED, __HIP_MEMORY_SCOPE_AGENT
#define LDS_WAIT() asm volatile("s_waitcnt lgkmcnt(0)" ::: "memory")
#define VM_WAIT() asm volatile("s_waitcnt vmcnt(0)" ::: "memory")
__device__ __forceinline__ unsigned long long rt() { return __builtin_amdgcn_s_memrealtime(); }
__device__ __forceinline__ unsigned f2bf(float f) { unsigned u = __builtin_bit_cast(unsigned, f); return (u + 0x7fffu + ((u >> 16) & 1u)) >> 16; }
__device__ __forceinline__ unsigned pk2(float lo, float hi) { return f2bf(lo) | (f2bf(hi) << 16); }

#define XB_TMO      128
#define XB_XCNT(j)  (256  + 64 * (j))
#define XB_XSUB(j)  (1280 + 64 * (j))
#define XB_XGEN(j)  (2304 + 64 * (j))
#define XB_TOP      3328
#define XB_TOPGEN   3392
#define XCD_BAR_WORDS 3456
#define XB_SPIN_CAP (1u << 18)

__device__ __forceinline__ unsigned xb_ld(unsigned* p)              { return __hip_atomic_load(p, __ATOMIC_RELAXED, __HIP_MEMORY_SCOPE_AGENT); }
__device__ __forceinline__ unsigned xb_add(unsigned* p, unsigned v) { return __hip_atomic_fetch_add(p, v, __ATOMIC_RELAXED, __HIP_MEMORY_SCOPE_AGENT); }
__device__ __forceinline__ unsigned xb_xcc_id() { return (unsigned)__builtin_amdgcn_s_getreg((3 << 11) | 20) & 0xFu; }
#define XB_SPIN(cond, bar) do { unsigned _sp = 0; while (cond) { __builtin_amdgcn_s_sleep(1); \
    if ((++_sp & 255u) == 0u) { if (xb_ld(&(bar)[XB_TMO])) break; if (_sp > XB_SPIN_CAP) { atomicAdd(&(bar)[XB_TMO], 1u); break; } } } } while (0)

struct XcdBarrier {
    unsigned* bar; unsigned x;
    volatile LAS unsigned* st;
};

__device__ __forceinline__ XcdBarrier xcd_barrier_post(unsigned* bar, volatile LAS unsigned* st) {
    XcdBarrier b; b.bar = bar; b.x = xb_xcc_id(); b.st = st;
    if (threadIdx.x == 0) (void)xb_add(&bar[XB_XCNT(b.x)], 1u);
    return b;
}
__device__ __forceinline__ void xcd_barrier_complete(unsigned* bar, unsigned x, unsigned& nloc, unsigned& nx) {
    const unsigned G = gridDim.x * gridDim.y * gridDim.z;
    unsigned sum, cnt, mine, sp = 0u;
    for (;;) {
        sum = 0u; cnt = 0u; mine = 0u;
#pragma unroll
        for (unsigned j = 0; j < 16; ++j) { const unsigned c = xb_ld(&bar[XB_XCNT(j)]); sum += c; cnt += (c > 0u) ? 1u : 0u; mine = (j == x) ? c : mine; }
        if (sum == G) break;
        __builtin_amdgcn_s_sleep(1);
        if ((++sp & 255u) == 0u) { if (xb_ld(&bar[XB_TMO])) break; if (sp > XB_SPIN_CAP) { atomicAdd(&bar[XB_TMO], 1u); break; } }
    }
    nloc = mine > 0u ? mine : 1u; nx = cnt > 0u ? cnt : 1u;
}

__device__ __forceinline__ void xcd_barrier(const XcdBarrier& b) {
    asm volatile("s_waitcnt vmcnt(0)" ::: "memory");
    __syncthreads();
    if (threadIdx.x == 0) {
        unsigned* bar = b.bar;
        __builtin_amdgcn_s_waitcnt(0);
        unsigned nloc = b.st[0], nx = b.st[1];
        if (nloc == 0u) { xcd_barrier_complete(bar, b.x, nloc, nx); b.st[0] = nloc; b.st[1] = nx; }
        const unsigned old = xb_add(&bar[XB_XSUB(b.x)], 1u);
        const unsigned gen = old / nloc;
        if (old + 1u == (gen + 1u) * nloc) {
            __builtin_amdgcn_fence(__ATOMIC_RELEASE, "agent");
            asm volatile("s_waitcnt vmcnt(0)" ::: "memory");
            const unsigned og = xb_add(&bar[XB_TOP], 1u);
            const unsigned tg = og / nx;
            if (og + 1u == (tg + 1u) * nx) xb_add(&bar[XB_TOPGEN], 1u);
            else XB_SPIN(xb_ld(&bar[XB_TOPGEN]) == tg, bar);
            __builtin_amdgcn_fence(__ATOMIC_ACQUIRE, "agent");
            xb_add(&bar[XB_XGEN(b.x)], 1u);
            asm volatile("s_waitcnt vmcnt(0)" ::: "memory");
        } else {
            XB_SPIN(xb_ld(&bar[XB_XGEN(b.x)]) == gen, bar);
            __builtin_amdgcn_fence(__ATOMIC_ACQUIRE, "agent");
            asm volatile("s_waitcnt vmcnt(0)" ::: "memory");
        }
    }
    __syncthreads();
}
constexpr int NWAVES = 8;
constexpr int BATCH = 4, T = 4096, D = 1024, M = BATCH * T;
constexpr int RWC = 1792;
constexpr int NG1 = 5376;
constexpr float NORM_EPS = 1e-6f, GN_EPS = 64e-5f;
constexpr float LOG2E = 1.4426950408889634f;
constexpr int N_PHASES = 13;
#ifndef MK_ONE_LAUNCH
#define MK_ONE_LAUNCH 0
#endif
#ifndef REP_MASK
#define REP_MASK 0
#endif
#ifndef DBG_SEL
#define DBG_SEL -1
#endif
#ifndef NSA_SKIP
#define NSA_SKIP 0
#endif
#ifndef P3REP
#define P3REP 1
#endif
#ifndef SCAN_BLOCKS
#define SCAN_BLOCKS 128
#endif

constexpr size_t MiB = 1u << 20;
constexpr size_t WS_CTL = 0, CTL_ZERO_BYTES = 1 * MiB;
constexpr size_t WS_WIN = 1 * MiB;
constexpr size_t WS_WA = 12 * MiB, WS_WB = 13 * MiB;
constexpr size_t WS_WOUT = 14 * MiB;
constexpr size_t WS_WQ = 16 * MiB;
constexpr size_t WS_CW1K = 20 * MiB, WS_CW1V = 21 * MiB;
constexpr size_t WS_CW2K = 22 * MiB, WS_CW2V = 22 * MiB + 65536;
constexpr size_t WS_SK1 = 22 * MiB + 131072, WS_SK2 = 22 * MiB + 196608;
constexpr size_t WS_WUT = 22 * MiB + 262144, WS_AUT = WS_WUT + 65536, WS_GUT = WS_WUT + 131072;
constexpr size_t WS_BND = 23 * MiB;
constexpr size_t WS_KC = 25 * MiB;
constexpr size_t WS_VCT = 25 * MiB + 262144;
constexpr size_t WS_H = 26 * MiB;
constexpr size_t WS_PRW = 58 * MiB;
constexpr size_t WS_MG = 170 * MiB;
constexpr size_t WS_VST = 234 * MiB, WS_VWT = 238 * MiB;
constexpr size_t WS_END = 256 * MiB;
constexpr size_t DO_PNSA = 0, DO_G = 40 * MiB, DO_GLOG = 56 * MiB;
constexpr int CW_TMO = 0, CW_CODE = 1, CW_NSAQ = 64, CW_SCANP = 2048, CW_PEERQ = 4160, CW_BAR = 8192;

constexpr int RING_OFF = 0, RING_BYTES = 131072;
constexpr int LDSCTL_OFF = RING_BYTES, MISC_OFF = LDSCTL_OFF + 320;
constexpr int LDS_BYTES = 147456;
typedef unsigned short u16;
typedef unsigned u32x2 __attribute__((ext_vector_type(2)));
struct Frame {
    LAS unsigned char* lds;
    volatile LAS unsigned* MISC;
    gu32* ctl;
    int tid, lane, wave, vcu, G;
    const float* in[33];
    float* out; unsigned char* ws;
};
__device__ __forceinline__ float wave_sum(float v) {
#pragma unroll
    for (int o = 1; o < 64; o <<= 1) v += __shfl_xor(v, o);
    return v;
}
template <int CTRL> __device__ __forceinline__ float dppf(float x) { return __builtin_bit_cast(float, __builtin_amdgcn_update_dpp(0, __builtin_bit_cast(int, x), CTRL, 0xf, 0xf, true)); }
__device__ __forceinline__ float bf2f(u16 b) { return __uint_as_float((unsigned)b << 16); }
__device__ __forceinline__ float bflo(unsigned w) { return __uint_as_float(w << 16); }
__device__ __forceinline__ float bfhi(unsigned w) { return __uint_as_float(w & 0xffff0000u); }
__device__ __forceinline__ u16 f2b(float f) { return (u16)pg8::cvt_pk_bf16(f, 0.f); }
#define pk2(lo_, hi_) pg8::cvt_pk_bf16((lo_), (hi_))
__device__ __forceinline__ float sigmf(float x) { return __builtin_amdgcn_rcpf(1.0f + __expf(-x)); }
__device__ __forceinline__ float tanh_fast(float x) { return 1.0f - 2.0f * __builtin_amdgcn_rcpf(1.0f + __expf(2.0f * x)); }
__device__ __forceinline__ f32x4 mfma16(const bf16x8 a, const bf16x8 b, const f32x4 c) { return __builtin_amdgcn_mfma_f32_16x16x32_bf16(a, b, c, 0, 0, 0); }
__device__ __forceinline__ bf16x8 as_bf16x8(const v4u v) { return __builtin_bit_cast(bf16x8, v); }

__device__ __forceinline__ void tr_item(const float* W, int K, int ldw, int sc0, int nblk, int ncols_valid, bf16* WT, int dr0, LAS float* scr, int item, int lane) {
    const int kb = item / nblk, nb = item % nblk, k0 = 64 * kb, n0 = 32 * nb;
#pragma unroll 8
    for (int i = 0; i < 32; ++i) { const int kk = 2 * i + (lane >> 5); const int n = n0 + (lane & 31);
        scr[kk * 33 + (lane & 31)] = (n < ncols_valid) ? W[(size_t)(k0 + kk) * ldw + sc0 + n] : 0.f; }
    LDS_WAIT(); asm volatile("" ::: "memory");
    const int c = lane & 7;
#pragma unroll
    for (int j = 0; j < 4; ++j) { const int n = (lane >> 3) + 8 * j; const LAS float* s = scr + (8 * c) * 33 + n;
        v4u o; o.x = pk2(s[0 * 33], s[1 * 33]); o.y = pk2(s[2 * 33], s[3 * 33]); o.z = pk2(s[4 * 33], s[5 * 33]); o.w = pk2(s[6 * 33], s[7 * 33]);
        *(GAS v4u*)(WT + (size_t)(dr0 + n0 + n) * K + k0 + 8 * c) = o; }
    LDS_WAIT(); asm volatile("" ::: "memory");
}
__device__ __forceinline__ void rms_row_to_bf16(int lane, const float* xrow, const float* gain, bf16* orow) {
    const GAS f32x4* xr = (const GAS f32x4*)xrow + lane; const GAS f32x4* gr = (const GAS f32x4*)gain + lane;
    f32x4 v[4]; float s2 = 0.f;
#pragma unroll
    for (int j = 0; j < 4; ++j) { v[j] = xr[64 * j]; s2 += (v[j].x * v[j].x + v[j].y * v[j].y) + (v[j].z * v[j].z + v[j].w * v[j].w); }
    const float rstd = 1.f / sqrtf(wave_sum(s2) * (1.f / D) + NORM_EPS);
    GAS unsigned long long* o8 = (GAS unsigned long long*)orow + lane;
#pragma unroll
    for (int j = 0; j < 4; ++j) { const f32x4 g = gr[64 * j];
        o8[64 * j] = (unsigned long long)pk2(v[j].x * rstd * g.x, v[j].y * rstd * g.y) | ((unsigned long long)pk2(v[j].z * rstd * g.z, v[j].w * rstd * g.w) << 32); }
}
__device__ __forceinline__ void p0_prologue(const Frame& F) {
    LAS float* scr = (LAS float*)(F.lds + RING_OFF + F.wave * 16384);
    const int gw = F.vcu * NWAVES + F.wave, NGW = F.G * NWAVES;
    unsigned char* ws = F.ws;
    constexpr int I0 = 16 * 96, I1 = 16 * 64, I2 = 16 * 8, I3 = 8 * 32, I4 = 8 * 32, I5 = 16 * 32, I6 = 16 * 64, I7 = 32 * 8, I8 = 32 * 8, I9 = 4 * 2, I10 = 4 * 2, I11 = 16, I12 = 16, I13 = 32;
    constexpr int NITEMS = I0 + I1 + I2 + I3 + I4 + I5 + I6 + I7 + I8 + I9 + I10 + I11 + I12 + I13;
    for (int it = gw; it < NITEMS; it += NGW) {
        int r = it;
        if (r < I0) { tr_item(F.in[2], 1024, 5144, 0, 96, 3072, (bf16*)(ws + WS_WIN), 0, scr, r, F.lane); continue; } r -= I0;
        if (r < I1) { tr_item(F.in[2], 1024, 5144, 3096, 64, 2048, (bf16*)(ws + WS_WIN), 3072, scr, r, F.lane); continue; } r -= I1;
        if (r < I2) { tr_item(F.in[2], 1024, 5144, 3072, 8, 24, (bf16*)(ws + WS_WIN), 5120, scr, r, F.lane); continue; } r -= I2;
        if (r < I3) { tr_item(F.in[24], 512, 1024, 0, 32, 1024, (bf16*)(ws + WS_WA), 0, scr, r, F.lane); continue; } r -= I3;
        if (r < I4) { tr_item(F.in[25], 512, 1024, 0, 32, 1024, (bf16*)(ws + WS_WB), 0, scr, r, F.lane); continue; } r -= I4;
        if (r < I5) { tr_item(F.in[26], 1024, 1024, 0, 32, 1024, (bf16*)(ws + WS_WOUT), 0, scr, r, F.lane); continue; } r -= I5;
        if (r < I6) { tr_item(F.in[28], 1024, 2048, 0, 64, 2048, (bf16*)(ws + WS_WQ), 0, scr, r, F.lane); continue; } r -= I6;
        if (r < I7) { tr_item(F.in[20], 2048, 256, 0, 8, 256, (bf16*)(ws + WS_CW1K), 0, scr, r, F.lane); continue; } r -= I7;
        if (r < I8) { tr_item(F.in[22], 2048, 256, 0, 8, 256, (bf16*)(ws + WS_CW1V), 0, scr, r, F.lane); continue; } r -= I8;
        if (r < I9) { tr_item(F.in[21], 256, 64, 0, 2, 64, (bf16*)(ws + WS_CW2K), 0, scr, r, F.lane); continue; } r -= I9;
        if (r < I10) { tr_item(F.in[23], 256, 64, 0, 2, 64, (bf16*)(ws + WS_CW2V), 0, scr, r, F.lane); continue; } r -= I10;
        if (r < I11) { tr_item(F.in[5], 64, 512, 0, 16, 512, (bf16*)(ws + WS_WUT), 0, scr, r, F.lane); continue; } r -= I11;
        if (r < I12) { tr_item(F.in[7], 64, 512, 0, 16, 512, (bf16*)(ws + WS_AUT), 0, scr, r, F.lane); continue; } r -= I12;
        tr_item(F.in[8], 128, 512, 0, 16, 512, (bf16*)(ws + WS_GUT), 0, scr, r, F.lane);
    }
    { const int gt = F.vcu * (NWAVES * 64) + F.tid, NT = F.G * NWAVES * 64;
      bf16* s1 = (bf16*)(ws + WS_SK1); bf16* s2 = (bf16*)(ws + WS_SK2);
      for (int i = gt; i < 128 * 128; i += NT) { s1[i] = f2b(F.in[29][i]); s2[i] = f2b(F.in[30][i]); } }
    for (int m = gw; m < M; m += NGW) rms_row_to_bf16(F.lane, F.in[0] + (size_t)m * D, F.in[1], (bf16*)(ws + WS_H) + (size_t)m * D);
}
constexpr int REC_BYTES = 12800;
__device__ __forceinline__ void rwkv_prep_tile(const Frame& F, int u) {
    const int tid = F.tid, lane = F.lane, h = F.wave, r16 = lane & 15, q4 = lane >> 4;
    const int R0 = 64 * u, t0 = R0 & (T - 1);
    LAS bf16* linb = (LAS bf16*)(F.lds);
    LAS bf16* mats = (LAS bf16*)(F.lds + 16384) + h * 4096;
    LAS float* abl = (LAS float*)(F.lds + 16384 + 65536) + h * 272;
    float* PRW = (float*)(F.ws + WS_PRW);
    const float* BND = (const float*)(F.ws + WS_BND);
    bf16* G = (bf16*)((unsigned char*)F.out + DO_G);
    const float* mu = F.in[3];
    const float mu_r = mu[tid], mu_k = mu[512 + tid], mu_v = mu[1024 + tid], mu_l = (tid < 256) ? mu[1536 + tid] : 0.f;
    const float w0c = F.in[4][tid], a0c = F.in[6][tid], kkc = F.in[9][tid], kac = F.in[10][tid], rkc = F.in[11][tid];
    const float* w_up = F.in[5]; const float* a_up = F.in[7]; const float* g_up = F.in[8];
    float pr = 0.f, pk = 0.f, pv = 0.f, pl = 0.f;
    if (t0 != 0) { const float* b = BND + (size_t)(u - 1) * RWC; pr = b[tid]; pk = b[512 + tid]; pv = b[1024 + tid]; if (tid < 256) pl = b[1536 + tid]; }
    for (int batch = 0; batch < 4; ++batch) {
        const int Rb = R0 + 16 * batch;
        if (DBG_SEL == 30 && batch == 0 && blockIdx.x == 0 && tid == 0) F.MISC[20] = (unsigned)__builtin_amdgcn_s_memrealtime();
        float xr[16], xk[16]; unsigned vtw[8];
        if (tid < 256) { float xl[16];
#pragma unroll
            for (int j = 0; j < 16; ++j) xl[j] = PRW[(size_t)(Rb + j) * RWC + 1536 + tid];
#pragma unroll
            for (int j = 0; j < 16; ++j) { const float n = xl[j]; const float v = n + (pl - n) * mu_l; pl = n; const float f = (tid < 64) ? tanh_fast(v) : ((tid < 128) ? v : sigmf(v)); linb[j * 256 + tid] = f2b(f); } }
        { float xv[16];
#pragma unroll
          for (int j = 0; j < 16; ++j) { const float* p = PRW + (size_t)(Rb + j) * RWC; xr[j] = p[tid]; xk[j] = p[512 + tid]; xv[j] = p[1024 + tid]; }
          VM_WAIT();
#pragma unroll
          for (int j = 0; j < 16; ++j) { float n;
              n = xr[j]; xr[j] = n + (pr - n) * mu_r; pr = n;
              n = xk[j]; xk[j] = n + (pk - n) * mu_k; pk = n;
              n = xv[j]; const unsigned vb = f2bf(n + (pv - n) * mu_v); pv = n;
              if (j & 1) vtw[j >> 1] |= vb << 16; else vtw[j >> 1] = vb; } }
        __syncthreads();
        if ((DBG_SEL == 30 || DBG_SEL == 31) && batch == 0 && blockIdx.x == 0 && tid == 0) F.MISC[20 + (DBG_SEL == 30)] = (unsigned)__builtin_amdgcn_s_memrealtime();
        float accw[16], acca[16], accg[16];
        { const bf16* WUT = (const bf16*)(F.ws + WS_WUT); const bf16* AUT = (const bf16*)(F.ws + WS_AUT); const bf16* GUT = (const bf16*)(F.ws + WS_GUT);
          const f32x4 Z4 = {0.f, 0.f, 0.f, 0.f};
          bf16x8 af[8];
#pragma unroll
          for (int ks = 0; ks < 8; ++ks) af[ks] = as_bf16x8(*(const LAS v4u*)(linb + r16 * 256 + 32 * ks + 8 * q4));
          LAS float* ow = (LAS float*)mats;
#pragma unroll
          for (int nt = 0; nt < 4; ++nt) { const int col = 64 * h + 16 * nt + r16;
              f32x4 cw = Z4, ca = Z4, cg = Z4;
#pragma unroll
              for (int ks = 0; ks < 2; ++ks) { cw = mfma16(af[ks], as_bf16x8(*(const v4u*)(WUT + (size_t)col * 64 + 32 * ks + 8 * q4)), cw); ca = mfma16(af[2 + ks], as_bf16x8(*(const v4u*)(AUT + (size_t)col * 64 + 32 * ks + 8 * q4)), ca); }
#pragma unroll
              for (int ks = 0; ks < 4; ++ks) cg = mfma16(af[4 + ks], as_bf16x8(*(const v4u*)(GUT + (size_t)col * 128 + 32 * ks + 8 * q4)), cg);
#pragma unroll
              for (int r = 0; r < 4; ++r) { const int tok = 4 * q4 + r; ow[tok * 64 + 16 * nt + r16] = cw[r]; ow[1024 + tok * 64 + 16 * nt + r16] = ca[r]; G[(size_t)(Rb + tok) * 512 + col] = f2b(cg[r]); } }
          LDS_WAIT(); asm volatile("" ::: "memory");
#pragma unroll
          for (int j = 0; j < 16; ++j) { accw[j] = ow[j * 64 + lane]; acca[j] = ow[1024 + j * 64 + lane]; }
          LDS_WAIT(); asm volatile("" ::: "memory"); }
        if ((DBG_SEL == 31 || DBG_SEL == 32) && batch == 0 && blockIdx.x == 0 && tid == 0) F.MISC[20 + (DBG_SEL == 31)] = (unsigned)__builtin_amdgcn_s_memrealtime();
        unsigned char* rec = (unsigned char*)(PRW + (size_t)Rb * RWC) + h * REC_BYTES;
#pragma unroll
        for (int j = 0; j < 16; ++j) {
            const float z = -(w0c + accw[j]); const float sp = fmaxf(z, 0.f) + __logf(1.0f + __expf(-fabsf(z)));
            const float e = __expf(-sp - 0.5f); accw[j] = __expf(-e);
            const float a = sigmf(a0c + acca[j]); acca[j] = a;
            const float kkv = xk[j] * kkc; xk[j] = xk[j] * (1.f + (a - 1.f) * kac);
            const float ss = wave_sum(kkv * kkv); accg[j] = kkv * rsqrtf(fmaxf(ss, 1e-24f));
            const float bon = wave_sum(xr[j] * xk[j] * rkc);
            if (lane == 0) *(float*)(rec + 12544 + 4 * j) = bon; __builtin_amdgcn_sched_barrier(0); }
        { float g = 1.f; unsigned bhw[8], khw[8];
          LAS bf16* mp = mats + lane;
#pragma unroll
          for (int j = 0; j < 16; ++j) { const float gp = g; g *= accw[j]; const float ig = __builtin_amdgcn_rcpf(g);
              const unsigned w1 = pg8::cvt_pk_bf16(accg[j] * gp, xr[j] * g), w2 = pg8::cvt_pk_bf16(accg[j] * acca[j] * ig, xk[j] * ig);
              mp[j * 64] = (u16)(w1 & 0xffffu); mp[1024 + j * 64] = (u16)(w1 >> 16); mp[2048 + j * 64] = (u16)(w2 & 0xffffu); mp[3072 + j * 64] = (u16)(w2 >> 16);
              if (j & 1) { bhw[j >> 1] |= w2 << 16; khw[j >> 1] |= w2 & 0xffff0000u; } else { bhw[j >> 1] = w2 & 0xffffu; khw[j >> 1] = w2 >> 16; } }
          *(float*)(rec + 12288 + 4 * lane) = g;
          v4u* bp = (v4u*)(rec + 4096 + lane * 32); bp[0] = (v4u){bhw[0], bhw[1], bhw[2], bhw[3]}; bp[1] = (v4u){bhw[4], bhw[5], bhw[6], bhw[7]};
          v4u* kp = (v4u*)(rec + 6144 + lane * 32); kp[0] = (v4u){khw[0], khw[1], khw[2], khw[3]}; kp[1] = (v4u){khw[4], khw[5], khw[6], khw[7]};
          v4u* vp = (v4u*)(rec + 8192 + lane * 32); vp[0] = (v4u){vtw[0], vtw[1], vtw[2], vtw[3]}; vp[1] = (v4u){vtw[4], vtw[5], vtw[6], vtw[7]}; }
        LDS_WAIT(); asm volatile("" ::: "memory");
#pragma unroll
        for (int i = 0; i < 2; ++i) { const int pi = lane + 64 * i, s = pi >> 3, ks = (pi >> 2) & 1, qq = pi & 3;
#pragma unroll
            for (int mtx = 0; mtx < 2; ++mtx) { const LAS bf16* src = mats + mtx * 1024 + s * 64 + 32 * ks + 4 * qq;
                const u32x2 lo = *(const LAS u32x2*)src, hi = *(const LAS u32x2*)(src + 16);
                *(v4u*)(rec + mtx * 2048 + pi * 16) = (v4u){lo.x, lo.y, hi.x, hi.y}; } }
        LDS_WAIT(); asm volatile("" ::: "memory");
        { f32x4 Ab = {0.f, 0.f, 0.f, 0.f}, Ak = Ab, Mb = Ab, Mk = Ab;
#pragma unroll
          for (int ks = 0; ks < 2; ++ks) { const int off = r16 * 64 + 32 * ks + 8 * q4;
              const bf16x8 aK = as_bf16x8(*(const LAS v4u*)(mats + off)), aR = as_bf16x8(*(const LAS v4u*)(mats + 1024 + off)), bB = as_bf16x8(*(const LAS v4u*)(mats + 2048 + off)), bK = as_bf16x8(*(const LAS v4u*)(mats + 3072 + off));
              Ab = mfma16(aK, bB, Ab); Ak = mfma16(aK, bK, Ak); Mb = mfma16(aR, bB, Mb); Mk = mfma16(aR, bK, Mk); }
          bf16* rAk = (bf16*)(rec + 10240); bf16* rMb = (bf16*)(rec + 11264); bf16* rMk = (bf16*)(rec + 11776);
#pragma unroll
          for (int r = 0; r < 4; ++r) { const int s = 4 * q4 + r, j = r16; const bool lo = j < s, le = j <= s;
              abl[s * 17 + j] = lo ? Ab[r] : 0.f; rAk[s * 16 + j] = f2b(lo ? Ak[r] : 0.f); rMb[s * 16 + j] = f2b(le ? Mb[r] : 0.f); rMk[s * 16 + j] = f2b(le ? Mk[r] : 0.f); } }
        LDS_WAIT(); asm volatile("" ::: "memory");
        { float Tr[16]; bf16* rT = (bf16*)(rec + 10752);
#pragma unroll
          for (int s = 0; s < 16; ++s) { float t = (r16 == s) ? 1.f : 0.f;
#pragma unroll
              for (int j = 0; j < s; ++j) t -= abl[s * 17 + j] * Tr[j];
              Tr[s] = t; if (lane < 16) rT[s * 16 + r16] = f2b(-t); __builtin_amdgcn_sched_barrier(0); } }
        __syncthreads();
        if (DBG_SEL == 32 && batch == 0 && blockIdx.x == 0 && tid == 0) F.MISC[21] = (unsigned)__builtin_amdgcn_s_memrealtime();
    }
}
__device__ __forceinline__ void nsa_prep_tile(const Frame& F, int u) {
    const int lane = F.lane, w = F.wave;
    const int R0 = 64 * u, t0 = R0 & (T - 1), b = R0 / T;
    bf16* PNSA = (bf16*)((unsigned char*)F.out + DO_PNSA);
    const float qg = F.in[14][lane] * (0.125f * LOG2E);
    const float kg = (w < 2) ? F.in[16][lane] : F.in[17][lane];
    const int kcol = ((w < 2) ? 768 : 1024) + (w & 1) * 64 + lane;
#pragma unroll 1
    for (int tg = 0; tg < 4; ++tg) { float qv[16], kv[16];
#pragma unroll
        for (int i = 0; i < 16; ++i) { const bf16* p = PNSA + (size_t)(R0 + 16 * tg + i) * 1280; qv[i] = bf2f(p[w * 64 + lane]); kv[i] = (w < 4) ? bf2f(p[kcol]) : 0.f; }
#pragma unroll
        for (int i = 0; i < 16; ++i) { bf16* p = PNSA + (size_t)(R0 + 16 * tg + i) * 1280;
            const float ss = wave_sum(qv[i] * qv[i]) * (1.f / 64.f);
            p[w * 64 + lane] = f2b(qv[i] * rsqrtf(ss + NORM_EPS) * qg);
            if (w < 4) { const float ks = wave_sum(kv[i] * kv[i]) * (1.f / 64.f); p[kcol] = f2b(kv[i] * rsqrtf(ks + NORM_EPS) * kg); } } }
    if (w >= 4) {
        const int g = w & 1; const int scol = ((w < 6) ? 896 : 1152) + g * 64;
        bf16* VT = (bf16*)(F.ws + ((w < 6) ? WS_VST : WS_VWT)) + (size_t)((b * 2 + g) * 64) * T + (size_t)((t0 + lane) >> 5) * 2048 + ((t0 + lane) & 31);
        const v4u* src = (const v4u*)(PNSA + (size_t)(R0 + lane) * 1280 + scol);
        v4u v[8];
#pragma unroll
        for (int i = 0; i < 8; ++i) v[i] = src[i];
#pragma unroll
        for (int i = 0; i < 8; ++i) {
            VT[(8 * i + 0) * 32] = (u16)(v[i].x & 0xffffu); VT[(8 * i + 1) * 32] = (u16)(v[i].x >> 16);
            VT[(8 * i + 2) * 32] = (u16)(v[i].y & 0xffffu); VT[(8 * i + 3) * 32] = (u16)(v[i].y >> 16);
            VT[(8 * i + 4) * 32] = (u16)(v[i].z & 0xffffu); VT[(8 * i + 5) * 32] = (u16)(v[i].z >> 16);
            VT[(8 * i + 6) * 32] = (u16)(v[i].w & 0xffffu); VT[(8 * i + 7) * 32] = (u16)(v[i].w >> 16); }
    }
}
__device__ __forceinline__ float gelu_tanh(float x) { const float t = 0.7978845608028654f * (x + 0.044715f * x * x * x); return 0.5f * x * (1.f + tanh_fast(t)); }
__device__ __forceinline__ void compress_unit(const Frame& F, int u) {
    const int lane = F.lane, w = F.wave, r16 = lane & 15, q4 = lane >> 4;
    const int kvsel = u >> 7, b = (u >> 5) & 3, g = (u >> 4) & 1, ntile = u & 15;
    const bf16* X = (const bf16*)((unsigned char*)F.out + DO_PNSA) + (size_t)(b * T) * 1280 + (kvsel ? 640 : 512) + g * 64;
    const float* pos = kvsel ? F.in[19] : F.in[18];
    const bf16* W1t = (const bf16*)(F.ws + (kvsel ? WS_CW1V : WS_CW1K));
    const bf16* W2t = (const bf16*)(F.ws + (kvsel ? WS_CW2V : WS_CW2K));
    LAS bf16* hid = (LAS bf16*)(F.lds);
    LAS float* outb = (LAS float*)(F.lds + 16 * 528);
    int n = 16 * ntile + r16; if (n > 254) n = 254;
    f32x4 acc[2] = {{0.f, 0.f, 0.f, 0.f}, {0.f, 0.f, 0.f, 0.f}};
#pragma unroll 4
    for (int s = 0; s < 64; ++s) { const int lp = s >> 1, d0 = (s & 1) * 32 + 8 * q4;
        const v4u xa = *(const v4u*)(X + (size_t)(16 * n + lp) * 1280 + d0);
        const f32x4 p0 = *(const f32x4*)(pos + lp * 64 + d0), p1 = *(const f32x4*)(pos + lp * 64 + d0 + 4);
        v4u af; af.x = pk2(bflo(xa.x) + p0[0], bfhi(xa.x) + p0[1]); af.y = pk2(bflo(xa.y) + p0[2], bfhi(xa.y) + p0[3]);
        af.z = pk2(bflo(xa.z) + p1[0], bfhi(xa.z) + p1[1]); af.w = pk2(bflo(xa.w) + p1[2], bfhi(xa.w) + p1[3]);
#pragma unroll
        for (int nt = 0; nt < 2; ++nt) { const v4u bfg = *(const v4u*)(W1t + (size_t)(32 * w + 16 * nt + r16) * 2048 + 32 * s + 8 * q4);
            acc[nt] = mfma16(as_bf16x8(af), as_bf16x8(bfg), acc[nt]); } }
#pragma unroll
    for (int nt = 0; nt < 2; ++nt)
#pragma unroll
        for (int r = 0; r < 4; ++r) hid[(4 * q4 + r) * 264 + 32 * w + 16 * nt + r16] = f2b(gelu_tanh(acc[nt][r]));
    __syncthreads();
    if (w < 4) { f32x4 a2 = {0.f, 0.f, 0.f, 0.f};
#pragma unroll
        for (int s = 0; s < 8; ++s) { const v4u af = *(const LAS v4u*)(hid + r16 * 264 + 32 * s + 8 * q4);
            const v4u bfg = *(const v4u*)(W2t + (size_t)(16 * w + r16) * 256 + 32 * s + 8 * q4);
            a2 = mfma16(as_bf16x8(af), as_bf16x8(bfg), a2); }
#pragma unroll
        for (int r = 0; r < 4; ++r) outb[(4 * q4 + r) * 64 + 16 * w + r16] = a2[r]; }
    __syncthreads();
#pragma unroll
    for (int rr = 0; rr < 2; ++rr) { const int row = 2 * w + rr; const int nn = 16 * ntile + row; float val = outb[row * 64 + lane];
        if (kvsel == 0) { const float ss = wave_sum(val * val) * (1.f / 64.f); val = val * rsqrtf(ss + NORM_EPS) * F.in[15][lane];
            ((bf16*)(F.ws + WS_KC))[(size_t)((b * 2 + g) * 256 + nn) * 64 + lane] = (nn < 255) ? f2b(val) : (u16)0; }
        else ((bf16*)(F.ws + WS_VCT))[(size_t)((b * 2 + g) * 64 + lane) * 256 + nn] = (nn < 255) ? f2b(val) : (u16)0; }
    __syncthreads();
}
__device__ __forceinline__ bf16x8 pack_p(const f32x4 a, const f32x4 b) {
    v4u w; w.x = pg8::cvt_pk_bf16(a[0], a[1]); w.y = pg8::cvt_pk_bf16(a[2], a[3]); w.z = pg8::cvt_pk_bf16(b[0], b[1]); w.w = pg8::cvt_pk_bf16(b[2], b[3]); return as_bf16x8(w);
}
#define NSA_FENCE() asm volatile("s_waitcnt lgkmcnt(0)" ::: "memory")
struct KFr { bf16x8 a0, a1, b0, b1; };
struct VFr { bf16x8 v[4]; };
__device__ __forceinline__ KFr lds_k(const LAS unsigned char* ks, int r16, int q4) {
    const int rA = 8 * (r16 >> 2) + (r16 & 3), rB = rA + 4; const int xA = (rA >> 1) & 7, xB = (rB >> 1) & 7;
    KFr f; f.a0 = as_bf16x8(*(const LAS v4u*)(ks + rA * 128 + ((q4 ^ xA) << 4))); f.a1 = as_bf16x8(*(const LAS v4u*)(ks + rA * 128 + (((4 + q4) ^ xA) << 4)));
    f.b0 = as_bf16x8(*(const LAS v4u*)(ks + rB * 128 + ((q4 ^ xB) << 4))); f.b1 = as_bf16x8(*(const LAS v4u*)(ks + rB * 128 + (((4 + q4) ^ xB) << 4))); return f;
}
__device__ __forceinline__ VFr lds_v(const LAS unsigned char* vs, int r16, int q4) {
    VFr f;
#pragma unroll
    for (int dt = 0; dt < 4; ++dt) { const int d = 16 * dt + r16; f.v[dt] = as_bf16x8(*(const LAS v4u*)(vs + d * 64 + ((q4 ^ ((d >> 2) & 3)) << 4))); }
    return f;
}
struct NsaSrc { const bf16* kb; int krs; const bf16* vb; int vrs; int vtiled; };
__device__ __forceinline__ v4u nsa_stage_load(const NsaSrc& S, int k0, int tid) {
    if (tid < 256) return *(const v4u*)(S.kb + (size_t)(k0 + (tid >> 3)) * S.krs + 8 * (tid & 7));
    const int i = tid - 256, d = i >> 2, c = i & 3;
    return S.vtiled ? *(const v4u*)(S.vb + (size_t)(k0 >> 5) * 2048 + d * 32 + 8 * c) : *(const v4u*)(S.vb + (size_t)d * S.vrs + k0 + 8 * c);
}
__device__ __forceinline__ void nsa_stage_write(LAS unsigned char* lds, int slot, int tid, const v4u v) {
    if (tid < 256) { const int r = tid >> 3, c = tid & 7; *(LAS v4u*)(lds + slot * 4096 + r * 128 + ((c ^ ((r >> 1) & 7)) << 4)) = v; }
    else { const int i = tid - 256, d = i >> 2, c = i & 3; *(LAS v4u*)(lds + 8192 + slot * 4096 + d * 64 + ((c ^ ((d >> 2) & 3)) << 4)) = v; }
}
__device__ __forceinline__ void nsa_block_unit(const Frame& F, int b, int g, int T0, int skip) {
    const int lane = F.lane, tid = F.tid, w = F.wave, r16 = lane & 15, q4 = lane >> 4;
    const int t0 = T0 + 8 * w;
    const f32x4 Z4 = {0.f, 0.f, 0.f, 0.f};
    LAS unsigned char* lds = F.lds;
    LAS float* wl = (LAS float*)(lds + 16384 + w * 5120);
    LAS float* impT = wl; LAS float* imp2T = wl + 8 * 65; LAS unsigned* selT = (LAS unsigned*)(wl + 16 * 65);
    LAS unsigned* bw = (LAS unsigned*)(lds + 57344); LAS int* stl = (LAS int*)(lds + 57344 + 128);
    const bf16* PN = (const bf16*)((unsigned char*)F.out + DO_PNSA) + (size_t)(b * T) * 1280;
    const float* GL = (const float*)((unsigned char*)F.out + DO_GLOG) + (size_t)(b * T) * 32;
    bf16x8 qf[2][2]; int tq[2];
#pragma unroll
    for (int mt = 0; mt < 2; ++mt) { tq[mt] = t0 + 4 * mt + (r16 >> 2);
#pragma unroll
        for (int dh = 0; dh < 2; ++dh) qf[mt][dh] = as_bf16x8(*(const v4u*)(PN + (size_t)tq[mt] * 1280 + (g * 4 + (r16 & 3)) * 64 + 32 * dh + 8 * q4)); }
    f32x4 Oc[2][4];
#pragma unroll
    for (int mt = 0; mt < 2; ++mt)
#pragma unroll
        for (int dt = 0; dt < 4; ++dt) Oc[mt][dt] = Z4;
#define NSA_GATE(mt_, r_, br_) sigmf(GL[(size_t)(t0 + 4 * (mt_) + q4) * 32 + g * 12 + (r_) * 3 + (br_)])
#define NSA_PIPE_BEGIN(S_, n_, K0_OF) { v4u st = nsa_stage_load(S_, K0_OF(0), tid); nsa_stage_write(lds, 0, tid, st); if ((n_) > 1) st = nsa_stage_load(S_, K0_OF(1), tid); __syncthreads(); \
        for (int i = 0; i < (n_); ++i) { const int k0 = K0_OF(i); const LAS unsigned char* ks = lds + (i & 1) * 4096; const LAS unsigned char* vs = lds + 8192 + (i & 1) * 4096;
#define NSA_PIPE_END(S_, n_, K0_OF) if (i + 1 < (n_)) nsa_stage_write(lds, (i + 1) & 1, tid, st); if (i + 2 < (n_)) st = nsa_stage_load(S_, K0_OF(i + 2), tid); __syncthreads(); } }

    for (int i = lane; i < 16 * 65; i += 64) wl[i] = 0.f;
    const NsaSrc SC{(const bf16*)(F.ws + WS_KC) + (size_t)((b * 2 + g) * 256) * 64, 64, (const bf16*)(F.ws + WS_VCT) + (size_t)((b * 2 + g) * 64) * 256, 256, 0};
    const int ncb = (T0 + 63 >= 31) ? ((T0 + 63 - 31) >> 4) + 1 : 0; const int nstB = (skip & 1) ? 0 : ((ncb + 31) >> 5);
    const int ncw = (t0 + 7 >= 31) ? ((t0 + 7 - 31) >> 4) + 1 : 0; const int nstW = (skip & 1) ? 0 : ((ncw + 31) >> 5);
    float inv[2] = {0.f, 0.f};
#define K0_LIN(i_) (32 * (i_))
    if (nstB > 0) { float ls[2] = {0.f, 0.f};
        NSA_PIPE_BEGIN(SC, nstB, K0_LIN)
            if (i < nstW) { const KFr kf = lds_k(ks, r16, q4); const bool cslow = 16 * (k0 + 31) + 31 > t0;
#pragma unroll
                for (int mt = 0; mt < 2; ++mt) { f32x4 sA = mfma16(kf.a0, qf[mt][0], Z4); sA = mfma16(kf.a1, qf[mt][1], sA); f32x4 sB = mfma16(kf.b0, qf[mt][0], Z4); sB = mfma16(kf.b1, qf[mt][1], sB);
#pragma unroll
                    for (int r = 0; r < 4; ++r) { const int nA = k0 + 8 * q4 + r, nB = nA + 4;
                        if (cslow) { ls[mt] += (16 * nA + 31 <= tq[mt]) ? __builtin_amdgcn_exp2f(sA[r]) : 0.f; ls[mt] += (16 * nB + 31 <= tq[mt]) ? __builtin_amdgcn_exp2f(sB[r]) : 0.f; }
                        else { ls[mt] += __builtin_amdgcn_exp2f(sA[r]); ls[mt] += __builtin_amdgcn_exp2f(sB[r]); } } } }
        NSA_PIPE_END(SC, nstB, K0_LIN)
#pragma unroll
        for (int mt = 0; mt < 2; ++mt) { float l = ls[mt]; l += __shfl_xor(l, 16); l += __shfl_xor(l, 32); inv[mt] = 1.0f / fmaxf(l, 1e-30f); }
    }
    if (nstB > 0) { f32x4 O[2][4];
#pragma unroll
        for (int mt = 0; mt < 2; ++mt)
#pragma unroll
            for (int dt = 0; dt < 4; ++dt) O[mt][dt] = Z4;
        NSA_PIPE_BEGIN(SC, nstB, K0_LIN)
            if (i < nstW) { const KFr kf = lds_k(ks, r16, q4); const VFr vf = lds_v(vs, r16, q4); const bool cslow = 16 * (k0 + 31) + 31 > t0;
#pragma unroll
                for (int mt = 0; mt < 2; ++mt) { f32x4 sA = mfma16(kf.a0, qf[mt][0], Z4); sA = mfma16(kf.a1, qf[mt][1], sA); f32x4 sB = mfma16(kf.b0, qf[mt][0], Z4); sB = mfma16(kf.b1, qf[mt][1], sB);
                    f32x4 pA, pB;
#pragma unroll
                    for (int r = 0; r < 4; ++r) { const int nA = k0 + 8 * q4 + r, nB = nA + 4;
                        if (cslow) { pA[r] = (16 * nA + 31 <= tq[mt]) ? __builtin_amdgcn_exp2f(sA[r]) * inv[mt] : 0.f; pB[r] = (16 * nB + 31 <= tq[mt]) ? __builtin_amdgcn_exp2f(sB[r]) * inv[mt] : 0.f; }
                        else { pA[r] = __builtin_amdgcn_exp2f(sA[r]) * inv[mt]; pB[r] = __builtin_amdgcn_exp2f(sB[r]) * inv[mt]; } }
                    float vA = pA[0] + pA[1] + pA[2] + 0.5f * pA[3], cA = 0.5f * pA[3], vB = pB[0] + pB[1] + pB[2] + 0.5f * pB[3], cB = 0.5f * pB[3];
                    vA += __shfl_xor(vA, 1); vA += __shfl_xor(vA, 2); cA += __shfl_xor(cA, 1); cA += __shfl_xor(cA, 2);
                    vB += __shfl_xor(vB, 1); vB += __shfl_xor(vB, 2); cB += __shfl_xor(cB, 1); cB += __shfl_xor(cB, 2);
                    if ((lane & 3) == 0) { const int tl = 4 * mt + (r16 >> 2), j = (k0 >> 2) + 2 * q4;
                        impT[tl * 65 + j] = vA; imp2T[tl * 65 + j + 1] = cA; impT[tl * 65 + j + 1] = vB; imp2T[tl * 65 + j + 2] = cB; }
                    const bf16x8 pf = pack_p(pA, pB);
#pragma unroll
                    for (int dt = 0; dt < 4; ++dt) O[mt][dt] = mfma16(pf, vf.v[dt], O[mt][dt]); } }
        NSA_PIPE_END(SC, nstB, K0_LIN)
#pragma unroll
        for (int mt = 0; mt < 2; ++mt)
#pragma unroll
            for (int r = 0; r < 4; ++r) { const float gt = NSA_GATE(mt, r, 0);
#pragma unroll
                for (int dt = 0; dt < 4; ++dt) Oc[mt][dt][r] += gt * O[mt][dt][r]; }
    }
    NSA_FENCE();
    const int cur = T0 >> 6;
    unsigned long long uni = 0ull;
    for (int tl = 0; tl < 8; ++tl) {
        unsigned long long mask;
        if (cur < 16 || (skip & 2)) mask = (cur < 16) ? ((2ull << cur) - 1ull) : (0xFFFFull | (1ull << cur) | (1ull << (cur - 1)));
        else {
            const float sc = impT[tl * 65 + lane] + imp2T[tl * 65 + lane];
            const unsigned key = __float_as_uint(fmaxf(sc, 0.f));
            const bool elig = (lane <= cur) && (lane != 0) && (lane != cur) && (lane != cur - 1);
            unsigned prefix = 0u;
            for (int bit = 30; bit >= 0; --bit) { const unsigned cand = prefix | (1u << bit);
                const int cnt = __popcll(__ballot(elig && key >= cand)); if (cnt >= 13) prefix = cand; }
            const unsigned long long gt = __ballot(elig && key > prefix); unsigned long long ties = __ballot(elig && key == prefix);
            int need = 13 - __popcll(gt); unsigned long long keep = 0ull;
            while (need > 0 && ties) { const unsigned long long low = ties & (0ull - ties); keep |= low; ties ^= low; --need; }
            mask = gt | keep | 1ull | (1ull << cur) | (1ull << (cur - 1));
        }
        uni |= mask;
        if (lane == 0) { selT[2 * tl] = (unsigned)mask; selT[2 * tl + 1] = (unsigned)(mask >> 32); }
    }
    if (lane == 0) { bw[2 + 2 * w] = (unsigned)uni; bw[3 + 2 * w] = (unsigned)(uni >> 32); }
    NSA_FENCE();
    unsigned long long mk[2];
#pragma unroll
    for (int mt = 0; mt < 2; ++mt) { const int tl = 4 * mt + (r16 >> 2); mk[mt] = (unsigned long long)selT[2 * tl] | ((unsigned long long)selT[2 * tl + 1] << 32); }
    __syncthreads();
    unsigned long long buni = 0ull;
#pragma unroll
    for (int ww = 0; ww < 8; ++ww) buni |= (unsigned long long)bw[2 + 2 * ww] | ((unsigned long long)bw[3 + 2 * ww] << 32);

#define K0_LIST(i_) (__builtin_amdgcn_readfirstlane(stl[(i_)]))
#pragma unroll 1
    for (int br = 1; br < 3; ++br) { if ((skip >> (br + 1)) & 1) continue;
        const NsaSrc SB{PN + (br == 1 ? 768 : 1024) + g * 64, 1280, (const bf16*)(F.ws + (br == 1 ? WS_VST : WS_VWT)) + (size_t)((b * 2 + g) * 64) * T, 0, 1};
        f32x4 O[2][4]; float ls[2] = {0.f, 0.f};
#pragma unroll
        for (int mt = 0; mt < 2; ++mt)
#pragma unroll
            for (int dt = 0; dt < 4; ++dt) O[mt][dt] = Z4;
        int nsteps;
        if (br == 1) { nsteps = 2 * __popcll(buni);
            if (w == 0 && ((buni >> lane) & 1ull)) { const int rk = __popcll(buni & ((1ull << lane) - 1ull)); stl[2 * rk] = 64 * lane; stl[2 * rk + 1] = 64 * lane + 32; } }
        else { const int lo = T0 - 511; const int klo = (lo > 0 ? lo : 0) & ~31; nsteps = ((T0 + 64 - klo) + 31) >> 5; if (w == 0 && lane < nsteps) stl[lane] = klo + 32 * lane; }
        __syncthreads();
        NSA_PIPE_BEGIN(SB, nsteps, K0_LIST)
            const int j = k0 >> 6;
            const bool mine = (br == 1) ? (((uni >> j) & 1ull) != 0ull) : (k0 + 31 >= t0 - 511 && k0 <= t0 + 7);
            if (mine) { const KFr kf = lds_k(ks, r16, q4); const VFr vf = lds_v(vs, r16, q4);
                const bool slow = (br == 1) ? (j == cur) : (k0 < t0 - 504 || k0 + 31 > t0);
#pragma unroll
                for (int mt = 0; mt < 2; ++mt) { f32x4 ci = Z4;
                    if (br == 1) { const float bias = (((mk[mt] >> j) & 1ull) != 0ull) ? 0.f : -1e30f; ci = (f32x4){bias, bias, bias, bias}; }
                    f32x4 sA = mfma16(kf.a0, qf[mt][0], ci); sA = mfma16(kf.a1, qf[mt][1], sA); f32x4 sB = mfma16(kf.b0, qf[mt][0], ci); sB = mfma16(kf.b1, qf[mt][1], sB);
                    f32x4 pA, pB;
                    if (slow) {
#pragma unroll
                        for (int r = 0; r < 4; ++r) { const int kA = k0 + 8 * q4 + r, kB = kA + 4;
                            const bool mA = (kA <= tq[mt]) && (br == 1 || kA + 512 > tq[mt]), mB = (kB <= tq[mt]) && (br == 1 || kB + 512 > tq[mt]);
                            pA[r] = mA ? __builtin_amdgcn_exp2f(sA[r]) : 0.f; pB[r] = mB ? __builtin_amdgcn_exp2f(sB[r]) : 0.f; }
                    } else {
#pragma unroll
                        for (int r = 0; r < 4; ++r) { pA[r] = __builtin_amdgcn_exp2f(sA[r]); pB[r] = __builtin_amdgcn_exp2f(sB[r]); }
                    }
                    ls[mt] += (pA[0] + pA[1]) + (pA[2] + pA[3]) + (pB[0] + pB[1]) + (pB[2] + pB[3]);
                    const bf16x8 pf = pack_p(pA, pB);
#pragma unroll
                    for (int dt = 0; dt < 4; ++dt) O[mt][dt] = mfma16(pf, vf.v[dt], O[mt][dt]); } }
        NSA_PIPE_END(SB, nsteps, K0_LIST)
#pragma unroll
        for (int mt = 0; mt < 2; ++mt) { float l = ls[mt]; l += __shfl_xor(l, 16); l += __shfl_xor(l, 32); const float il = 1.0f / fmaxf(l, 1e-30f);
#pragma unroll
            for (int r = 0; r < 4; ++r) { const float ilr = __shfl(il, 4 * q4 + r) * NSA_GATE(mt, r, br);
#pragma unroll
                for (int dt = 0; dt < 4; ++dt) Oc[mt][dt][r] += ilr * O[mt][dt][r]; } }
    }
    if (!skip) { bf16* YB = (bf16*)(F.ws + WS_H + 16 * MiB) + (size_t)(b * T) * 512;
#pragma unroll
        for (int mt = 0; mt < 2; ++mt)
#pragma unroll
            for (int r = 0; r < 4; ++r)
#pragma unroll
                for (int dt = 0; dt < 4; ++dt) YB[(size_t)(t0 + 4 * mt + q4) * 512 + (g * 4 + r) * 64 + 16 * dt + r16] = f2b(Oc[mt][dt][r]); }
    __syncthreads();
}
__device__ __forceinline__ void nsa_phase(const Frame& F, int rep) {
    LAS unsigned* bw = (LAS unsigned*)(F.lds + 57344);
    const int q0 = (int)(xb_xcc_id() & 7u);
    for (int qi = 0; qi < 8; ++qi) { const int q = (q0 + qi) & 7;
        for (;;) {
            if (F.tid == 0) bw[0] = __hip_atomic_fetch_add(F.ctl + CW_NSAQ + 64 * (8 * rep + q), 1u, RLX_AGENT);
            __syncthreads();
            const unsigned c = bw[0];
            __syncthreads();
            if (c >= 64u) break;
            nsa_block_unit(F, q >> 1, q & 1, 64 * (63 - (int)c), rep ? NSA_SKIP : 0);
        }
    }
}
typedef short bf16x4 __attribute__((ext_vector_type(4)));
__device__ __forceinline__ f32x4 mfma16k16(const bf16x4 a, const bf16x4 b, const f32x4 c) { const bf16x8 a8 = {a[0], a[1], a[2], a[3], 0, 0, 0, 0}, b8 = {b[0], b[1], b[2], b[3], 0, 0, 0, 0}; return __builtin_amdgcn_mfma_f32_16x16x32_bf16(a8, b8, c, 0, 0, 0); }
__device__ __forceinline__ bf16x4 as_bf16x4(const u32x2 v) { return __builtin_bit_cast(bf16x4, v); }
__device__ __forceinline__ bf16x4 pack4(const f32x4 a) { u32x2 w; w.x = pg8::cvt_pk_bf16(a[0], a[1]); w.y = pg8::cvt_pk_bf16(a[2], a[3]); return as_bf16x4(w); }
__device__ __forceinline__ f32x4 unpk4(const u32x2 w) { f32x4 r; r[0] = bflo(w.x); r[1] = bfhi(w.x); r[2] = bflo(w.y); r[3] = bfhi(w.y); return r; }
struct ChunkIn { v4u kt0, kt1, rt0, rt1; u32x2 ak, nt, mb, mk, vt, bh[4], kh[4]; f32x4 gam[4]; };
__device__ __forceinline__ void scan_load(ChunkIn& c, const unsigned char* rec, int vq, int r16, int q4) {
    c.kt0 = *(const v4u*)(rec + (r16 * 64 + q4 * 8) * 2); c.kt1 = *(const v4u*)(rec + (r16 * 64 + 32 + q4 * 8) * 2);
    c.rt0 = *(const v4u*)(rec + 2048 + (r16 * 64 + q4 * 8) * 2); c.rt1 = *(const v4u*)(rec + 2048 + (r16 * 64 + 32 + q4 * 8) * 2);
#pragma unroll
    for (int mt = 0; mt < 4; ++mt) { c.bh[mt] = *(const u32x2*)(rec + 4096 + ((16 * mt + r16) * 16 + 4 * q4) * 2); c.kh[mt] = *(const u32x2*)(rec + 6144 + ((16 * mt + r16) * 16 + 4 * q4) * 2);
        c.gam[mt] = *(const f32x4*)(rec + 12288 + (16 * mt + 4 * q4) * 4); }
    c.vt = *(const u32x2*)(rec + 8192 + ((16 * vq + r16) * 16 + 4 * q4) * 2);
    c.ak = *(const u32x2*)(rec + 10240 + (r16 * 16 + 4 * q4) * 2); c.nt = *(const u32x2*)(rec + 10752 + (r16 * 16 + 4 * q4) * 2);
    c.mb = *(const u32x2*)(rec + 11264 + (r16 * 16 + 4 * q4) * 2); c.mk = *(const u32x2*)(rec + 11776 + (r16 * 16 + 4 * q4) * 2);
}
__device__ __forceinline__ void scan_chunk(const ChunkIn& cur, f32x4 (&Zt)[4], bf16* Y, int ch, int q4) {
    const f32x4 Z4 = {0.f, 0.f, 0.f, 0.f};
    const bf16x8 zb0 = pack_p(Zt[0], Zt[1]), zb1 = pack_p(Zt[2], Zt[3]);
    f32x4 X = mfma16(as_bf16x8(cur.kt0), zb0, Z4); X = mfma16(as_bf16x8(cur.kt1), zb1, X);
    f32x4 Yc = mfma16(as_bf16x8(cur.rt0), zb0, Z4); Yc = mfma16(as_bf16x8(cur.rt1), zb1, Yc);
    const bf16x4 vt = as_bf16x4(cur.vt);
    const f32x4 W = mfma16k16(as_bf16x4(cur.ak), vt, X);
    const f32x4 U = mfma16k16(as_bf16x4(cur.nt), pack4(W), Z4);
    const bf16x4 ub = pack4(U);
    Yc = mfma16k16(as_bf16x4(cur.mk), vt, Yc); Yc = mfma16k16(as_bf16x4(cur.mb), ub, Yc);
#pragma unroll
    for (int mt = 0; mt < 4; ++mt) { f32x4 acc = mfma16k16(as_bf16x4(cur.kh[mt]), vt, Zt[mt]); acc = mfma16k16(as_bf16x4(cur.bh[mt]), ub, acc); Zt[mt] = acc * cur.gam[mt]; }
#pragma unroll
    for (int r = 0; r < 4; ++r) Y[(size_t)(16 * ch + 4 * q4 + r) * 512] = f2b(Yc[r]);
}
__device__ __forceinline__ void rwkv_scan_wave(const Frame& F, int bh, int vq) {
    const int lane = F.lane, r16 = lane & 15, q4 = lane >> 4, b = bh >> 3, h = bh & 7;
    const f32x4 Z4 = {0.f, 0.f, 0.f, 0.f};
    const unsigned char* recb = F.ws + WS_PRW + (size_t)(b * T) * 7168 + h * REC_BYTES;
    bf16* Y = (bf16*)(F.ws + WS_H) + (size_t)(b * T) * 512 + h * 64 + 16 * vq + r16;
    f32x4 Zt[4] = {Z4, Z4, Z4, Z4};
    ChunkIn A, B;
    constexpr size_t CS = 16 * 7168;
    scan_load(A, recb, vq, r16, q4);
    for (int ch = 0; ch < T / 16; ch += 2) {
        if (vq == 0 && lane == 0) __hip_atomic_store(F.ctl + CW_SCANP + 64 * bh, (unsigned)ch, RLX_AGENT);
        scan_load(B, recb + (size_t)(ch + 1) * CS, vq, r16, q4);
        scan_chunk(A, Zt, Y, ch, q4);
        scan_load(A, recb + (size_t)((ch + 2 < T / 16) ? ch + 2 : ch) * CS, vq, r16, q4);
        scan_chunk(B, Zt, Y, ch + 1, q4);
    }
}
__device__ __forceinline__ void rwkv_scan_prefetch(const Frame& F, int bh) {
    const int lane = F.lane, b = bh >> 3, h = bh & 7;
    const unsigned char* recb = F.ws + WS_PRW + (size_t)(b * T) * 7168 + h * REC_BYTES;
    const int o0 = 128 * lane, o1 = 128 * (lane < 35 ? 64 + lane : 98);
    unsigned dmy = 0u, pa[4] = {0u, 0u, 0u, 0u}, pb[4] = {0u, 0u, 0u, 0u};
    for (int c4 = 0; c4 < T / 16; c4 += 4) {
#pragma unroll
        for (int k = 0; k < 4; ++k) { const int ch = c4 + k;
            for (int spin = 0; spin < (1 << 16); ++spin) { const int prog = (int)__hip_atomic_load(F.ctl + CW_SCANP + 64 * bh, RLX_AGENT); if (ch <= prog + 8) break; __builtin_amdgcn_s_sleep(8); }
            const unsigned char* rec = recb + (size_t)ch * (16 * 7168);
            dmy ^= pa[k] ^ pb[k];
            pa[k] = *(const volatile unsigned*)(rec + o0); pb[k] = *(const volatile unsigned*)(rec + o1); }
    }
    dmy ^= pa[0] ^ pb[0] ^ pa[1] ^ pb[1] ^ pa[2] ^ pb[2] ^ pa[3] ^ pb[3];
    if (lane == 0) F.MISC[17] = dmy;
}
__device__ __forceinline__ void rwkv_epilogue(const Frame& F) {
    const int lane = F.lane; const int gw = F.vcu * NWAVES + F.wave, NGW = F.G * NWAVES;
    const unsigned char* prw = F.ws + WS_PRW; const bf16* G = (const bf16*)((unsigned char*)F.out + DO_G); bf16* YA = (bf16*)(F.ws + WS_H);
    for (int idx = gw; idx < (M / 16) * 8; idx += NGW) { const int bt = idx >> 3, h = idx & 7, c = h * 64 + lane;
        const unsigned char* rec = prw + (size_t)(16 * bt) * 7168 + h * REC_BYTES;
        const v4u* vp = (const v4u*)(rec + 8192 + lane * 32); const v4u v0 = vp[0], v1 = vp[1];
        const float lw = F.in[12][c], lb = F.in[13][c];
        float yv[16], gv[16], bo[16];
#pragma unroll
        for (int s = 0; s < 16; ++s) { const size_t o = (size_t)(16 * bt + s) * 512 + c; yv[s] = bf2f(YA[o]); gv[s] = bf2f(G[o]); bo[s] = *(const float*)(rec + 12544 + 4 * s); }
#pragma unroll
        for (int s = 0; s < 16; ++s) { const unsigned vw = (s < 8) ? v0[s >> 1] : v1[(s - 8) >> 1]; const float vv = (s & 1) ? bfhi(vw) : bflo(vw);
            const float y = yv[s]; const float mean = wave_sum(y) * (1.f / 64.f); const float d = y - mean; const float var = wave_sum(d * d) * (1.f / 64.f);
            const float yn = d * rsqrtf(var + GN_EPS) * lw + lb;
            YA[(size_t)(16 * bt + s) * 512 + c] = f2b((yn + bo[s] * vv) * gv[s]); }
    }
}
__device__ __forceinline__ unsigned sortable(float x) { const unsigned u = __float_as_uint(x); return (u & 0x80000000u) ? ~u : (u | 0x80000000u); }
__device__ __forceinline__ float unsortable(unsigned k) { const unsigned u = (k & 0x80000000u) ? (k & 0x7fffffffu) : ~k; return __uint_as_float(u); }
#define TK_INSERT(L, key_) do { unsigned k_ = (key_); _Pragma("unroll") for (int s_ = 0; s_ < 16; ++s_) { const unsigned hi_ = L[s_] > k_ ? L[s_] : k_; k_ = L[s_] > k_ ? k_ : L[s_]; L[s_] = hi_; } } while (0)
__device__ __forceinline__ void peer_topk_pass(const Frame& F, int wp, LAS float* sc) {
    const int lane = F.lane, r16 = lane & 15, q4 = lane >> 4;
    const bf16* QRY = (const bf16*)(F.ws + WS_PRW);
    int* EID = (int*)(F.ws + WS_PRW + 64 * MiB); float* EG = (float*)(F.ws + WS_PRW + 72 * MiB);
    const int row = lane & 31, part = lane >> 5;
    unsigned L1[16], L2[16];
#pragma unroll
    for (int half = 0; half < 2; ++half) {
        const bf16* SK = (const bf16*)(F.ws + (half ? WS_SK2 : WS_SK1));
#pragma unroll
        for (int mt = 0; mt < 2; ++mt) { const int rho = 32 * wp + 16 * mt + r16;
            const bf16* qp = QRY + (size_t)(rho >> 3) * 2048 + (rho & 7) * 256 + half * 128 + 8 * q4;
            bf16x8 af[4];
#pragma unroll
            for (int s = 0; s < 4; ++s) af[s] = as_bf16x8(*(const v4u*)(qp + 32 * s));
#pragma unroll
            for (int kt = 0; kt < 8; ++kt) { f32x4 acc = {0.f, 0.f, 0.f, 0.f};
#pragma unroll
                for (int s = 0; s < 4; ++s) acc = mfma16(af[s], as_bf16x8(*(const v4u*)(SK + (size_t)(16 * kt + r16) * 128 + 32 * s + 8 * q4)), acc);
#pragma unroll
                for (int r = 0; r < 4; ++r) { const int rw = 16 * mt + 4 * q4 + r; sc[rw * 128 + ((16 * kt + r16) ^ rw)] = acc[r]; } } }
        NSA_FENCE();
        unsigned Ls[16];
#pragma unroll
        for (int s = 0; s < 16; ++s) Ls[s] = 0u;
#pragma unroll 4
        for (int i = 0; i < 64; ++i) { const int c = 64 * part + i; const float x = sc[row * 128 + (c ^ row)];
            TK_INSERT(Ls, (sortable(x) & ~0x7Fu) | (unsigned)(127 - c)); }
        unsigned Lo[16];
#pragma unroll
        for (int s = 0; s < 16; ++s) Lo[s] = (unsigned)__shfl_xor((int)Ls[s], 32);
#pragma unroll
        for (int s = 0; s < 16; ++s) TK_INSERT(Ls, Lo[s]);
#pragma unroll
        for (int s = 0; s < 16; ++s) { if (half == 0) L1[s] = Ls[s]; else L2[s] = Ls[s]; }
        NSA_FENCE();
    }
    float v1[16], v2[16];
#pragma unroll
    for (int s = 0; s < 16; ++s) { v1[s] = unsortable(L1[s]); v2[s] = unsortable(L2[s]); }
    unsigned C[16];
#pragma unroll
    for (int s = 0; s < 16; ++s) C[s] = 0u;
#pragma unroll
    for (int i = 0; i < 16; ++i)
#pragma unroll
        for (int j = 0; j < 16; ++j) if ((i + 1) * (j + 1) <= 16) { TK_INSERT(C, (sortable(v1[i] + v2[j]) & ~0xFFu) | (unsigned)(255 - (16 * i + j))); }
    LAS unsigned* il = (LAS unsigned*)sc;
    if (part == 0) {
#pragma unroll
        for (int s = 0; s < 16; ++s) { il[row * 33 + s] = 127u - (L1[s] & 127u); il[row * 33 + 16 + s] = 127u - (L2[s] & 127u); }
    }
    NSA_FENCE();
    if (part == 0) { const int rho = 32 * wp + row;
        float val[16], e[16]; float sum = 0.f;
#pragma unroll
        for (int s = 0; s < 16; ++s) val[s] = unsortable(C[s]);
#pragma unroll
        for (int s = 0; s < 16; ++s) { e[s] = __expf(val[s] - val[0]); sum += e[s]; }
        const float is = 1.0f / sum;
#pragma unroll
        for (int s = 0; s < 16; ++s) { const unsigned pos = 255u - (C[s] & 255u); const unsigned i = pos >> 4, j = pos & 15u;
            EID[(size_t)rho * 16 + s] = (int)(il[row * 33 + i] * 128u + il[row * 33 + 16 + j]); EG[(size_t)rho * 16 + s] = e[s] * is; }
    }
    NSA_FENCE();
}
typedef float f32x2_t __attribute__((ext_vector_type(2)));
constexpr float PEER_SCALE = 256.0f, PEER_ISCALE = 1.0f / 256.0f;
__device__ __forceinline__ void peer_convert_one(const Frame& F, const float* srcf, unsigned char* dstb) {
    const int gt = F.vcu * (NWAVES * 64) + F.tid, NT = F.G * NWAVES * 64;
    const f32x4* src = (const f32x4*)srcf; v4u* dst = (v4u*)dstb;
    for (int i = gt; i < 16384 * 1024 / 16; i += NT) { v4u o;
#pragma unroll
        for (int q = 0; q < 4; ++q) { const f32x4 a = src[4 * i + q] * PEER_SCALE; int w = __builtin_amdgcn_cvt_pk_fp8_f32(a[0], a[1], 0, false); w = __builtin_amdgcn_cvt_pk_fp8_f32(a[2], a[3], w, true); o[q] = (unsigned)w; }
        dst[i] = o; }
}
constexpr float PEER_SU = 768.0f, PEER_SH = 24.0f;
__device__ __forceinline__ unsigned q8pack(const f32x4 a, float sc) {
    const int q0 = (int)rintf(fminf(fmaxf(a[0] * sc, -127.f), 127.f)), q1 = (int)rintf(fminf(fmaxf(a[1] * sc, -127.f), 127.f)), q2 = (int)rintf(fminf(fmaxf(a[2] * sc, -127.f), 127.f)), q3 = (int)rintf(fminf(fmaxf(a[3] * sc, -127.f), 127.f));
    return (unsigned)(q0 & 255) | ((unsigned)(q1 & 255) << 8) | ((unsigned)(q2 & 255) << 16) | ((unsigned)(q3 & 255) << 24);
}
__device__ __forceinline__ void peer_convert_u8(const Frame& F, const float* srcf, unsigned char* dstb) {
    const int gt = F.vcu * (NWAVES * 64) + F.tid, NT = F.G * NWAVES * 64;
    const f32x4* src = (const f32x4*)srcf; v4u* dst = (v4u*)dstb;
    for (int i = gt; i < 16384 * 1024 / 16; i += NT) { v4u o;
#pragma unroll
        for (int q = 0; q < 4; ++q) o[q] = q8pack(src[4 * i + q], PEER_SU);
        dst[i] = o; }
}
__device__ __forceinline__ void peer_convert_tables(const Frame& F) { peer_convert_u8(F, F.in[31], F.ws + WS_MG); peer_convert_one(F, F.in[32], F.ws + WS_MG + 16 * MiB); }
__device__ __forceinline__ float sum8(float x) { x += dppf<0xB1>(x); x += dppf<0x4E>(x); x += dppf<0x141>(x); return x; }
template <int PHASE> __device__ __forceinline__ void peer_slice_unit(const Frame& F, int s, int tg) {
    const int lane = F.lane, j = lane & 7, gbase = lane & ~7;
    const bf16* H2 = (const bf16*)(F.ws + WS_H);
    const int* EID = (const int*)(F.ws + WS_PRW + 64 * MiB);
    float* PART = (float*)(F.ws + WS_PRW) + (size_t)s * M * 128; const float* CACT = (const float*)(F.ws + WS_PRW + 80 * MiB);
    const unsigned char* TB = F.ws + WS_MG + (PHASE == 0 ? 0 : 16 * MiB) + 128 * s + 16 * j;
#pragma unroll 1
    for (int it = 0; it < 8; ++it) { const int tk = 64 * tg + 8 * it + (lane >> 3);
        int ids[16]; float hv[16], acc[16];
        { const v4u* ip = (const v4u*)(EID + (size_t)tk * 128 + 16 * j);
#pragma unroll
          for (int q = 0; q < 4; ++q) { const v4u w = ip[q]; ids[4 * q] = (int)w.x; ids[4 * q + 1] = (int)w.y; ids[4 * q + 2] = (int)w.z; ids[4 * q + 3] = (int)w.w; } }
        int hq[4] = {0, 0, 0, 0};
        if (PHASE == 0) { const v4u h0 = *(const v4u*)(H2 + (size_t)tk * D + 128 * s + 16 * j), h1 = *(const v4u*)(H2 + (size_t)tk * D + 128 * s + 16 * j + 8);
            hq[0] = (int)q8pack((f32x4){bflo(h0.x), bfhi(h0.x), bflo(h0.y), bfhi(h0.y)}, PEER_SH); hq[1] = (int)q8pack((f32x4){bflo(h0.z), bfhi(h0.z), bflo(h0.w), bfhi(h0.w)}, PEER_SH);
            hq[2] = (int)q8pack((f32x4){bflo(h1.x), bfhi(h1.x), bflo(h1.y), bfhi(h1.y)}, PEER_SH); hq[3] = (int)q8pack((f32x4){bflo(h1.z), bfhi(h1.z), bflo(h1.w), bfhi(h1.w)}, PEER_SH); }
        else { const f32x4* cp = (const f32x4*)(CACT + (size_t)tk * 128 + 16 * j);
#pragma unroll
            for (int q = 0; q < 4; ++q) { const f32x4 c = cp[q]; hv[4 * q] = c[0]; hv[4 * q + 1] = c[1]; hv[4 * q + 2] = c[2]; hv[4 * q + 3] = c[3]; } }
#pragma unroll
        for (int m = 0; m < 16; ++m) acc[m] = 0.f;
#pragma unroll 1
        for (int jj = 0; jj < 8; ++jj) { const int src = (gbase + jj) * 4;
            v4u tv[16];
#pragma unroll
            for (int m = 0; m < 16; ++m) { const int id = __builtin_amdgcn_ds_bpermute(src, ids[m]); tv[m] = *(const v4u*)(TB + (size_t)id * 1024); }
#pragma unroll
            for (int m = 0; m < 16; ++m) {
                if (PHASE == 0) { int di = __builtin_amdgcn_sdot4((int)tv[m].x, hq[0], 0, false); di = __builtin_amdgcn_sdot4((int)tv[m].y, hq[1], di, false); di = __builtin_amdgcn_sdot4((int)tv[m].z, hq[2], di, false); di = __builtin_amdgcn_sdot4((int)tv[m].w, hq[3], di, false);
                    const float d = sum8((float)di); acc[m] = (j == jj) ? d : acc[m]; }
                else {
                    float f[16];
#pragma unroll
                    for (int q = 0; q < 4; ++q) { const f32x2_t lo = __builtin_amdgcn_cvt_pk_f32_fp8((int)tv[m][q], false), hi = __builtin_amdgcn_cvt_pk_f32_fp8((int)tv[m][q], true); f[4 * q] = lo.x; f[4 * q + 1] = lo.y; f[4 * q + 2] = hi.x; f[4 * q + 3] = hi.y; } const float c = __builtin_bit_cast(float, __builtin_amdgcn_ds_bpermute(src, __builtin_bit_cast(int, hv[m])));
#pragma unroll
                    for (int q = 0; q < 16; ++q) acc[q] += c * f[q]; } }
        }
        if (PHASE == 0) { f32x4* pp = (f32x4*)(PART + (size_t)tk * 128 + 16 * j);
#pragma unroll
            for (int q = 0; q < 4; ++q) pp[q] = (f32x4){acc[4 * q], acc[4 * q + 1], acc[4 * q + 2], acc[4 * q + 3]}; }
        else { f32x4* op = (f32x4*)(F.out + (size_t)tk * D + 128 * s + 16 * j);
#pragma unroll
            for (int q = 0; q < 4; ++q) { f32x4 a = op[q]; a[0] += acc[4 * q] * PEER_ISCALE; a[1] += acc[4 * q + 1] * PEER_ISCALE; a[2] += acc[4 * q + 2] * PEER_ISCALE; a[3] += acc[4 * q + 3] * PEER_ISCALE; op[q] = a; } }
    }
}
template <int PHASE> __device__ __forceinline__ void peer_slice_phase(const Frame& F, int rep) {
    const int q0 = (int)(xb_xcc_id() & 7u);
    for (int qi = 0; qi < 8; ++qi) { const int q = (q0 + qi) & 7;
        for (;;) { unsigned c = 0;
            if (F.lane == 0) c = __hip_atomic_fetch_add(F.ctl + CW_PEERQ + 64 * (16 * rep + 8 * PHASE + q), 1u, RLX_AGENT);
            c = (unsigned)__builtin_amdgcn_readfirstlane((int)c);
            if (c >= 256u) break;
            peer_slice_unit<PHASE>(F, q, (int)c); } }
}
__device__ __forceinline__ void peer_act_phase(const Frame& F) {
    const int gt = F.vcu * (NWAVES * 64) + F.tid, NT = F.G * NWAVES * 64;
    const float* PART = (const float*)(F.ws + WS_PRW); const float* EG = (const float*)(F.ws + WS_PRW + 72 * MiB); float* CACT = (float*)(F.ws + WS_PRW + 80 * MiB);
    for (int i = gt; i < M * 128 / 4; i += NT) { f32x4 d = {0.f, 0.f, 0.f, 0.f};
#pragma unroll
        for (int s = 0; s < 8; ++s) d += ((const f32x4*)PART)[(size_t)s * (M * 128 / 4) + i];
        const f32x4 g = ((const f32x4*)EG)[i]; f32x4 c;
#pragma unroll
        for (int e = 0; e < 4; ++e) { const float dt = d[e] * (1.0f / (PEER_SU * PEER_SH)); c[e] = g[e] * 0.5f * dt * (1.f + erff(dt * 0.70710678118654752f)); }
        ((f32x4*)CACT)[i] = c; }
}
struct Args { const float* in[33]; float* out; unsigned char* ws; int ph_lo, ph_hi; };
__global__ void __launch_bounds__(NWAVES * 64, 2) mk_fwd(Args args) {
    extern __shared__ __attribute__((aligned(16))) unsigned char lds[];
    Frame F;
    F.lds = (LAS unsigned char*)lds;
    F.MISC = (volatile LAS unsigned*)(F.lds + MISC_OFF);
    F.tid = threadIdx.x; F.lane = F.tid & 63; F.wave = __builtin_amdgcn_readfirstlane(F.tid >> 6);
    F.G = gridDim.x; { const int bx = blockIdx.x; F.vcu = (F.G % 8 == 0) ? (bx % 8) * (F.G / 8) + bx / 8 : bx; }
    unsigned char* ws = args.ws; F.ws = ws; F.out = args.out;
    F.ctl = (gu32*)(ws + WS_CTL);
#pragma unroll
    for (int i = 0; i < 33; ++i) F.in[i] = args.in[i];
    for (int u = F.tid; u < (LDS_BYTES - LDSCTL_OFF) / 4; u += NWAVES * 64) ((LAS unsigned*)(F.lds + LDSCTL_OFF))[u] = 0u;
    __syncthreads();
    const int lo = args.ph_lo, hi = args.ph_hi & 0xff; const int rep = args.ph_hi >> 8;
    const bool multi = (hi - lo) > 1;
    XcdBarrier bar; bar.bar = (unsigned*)(F.ctl + CW_BAR); bar.x = 0; bar.st = nullptr;
    if (multi) bar = xcd_barrier_post((unsigned*)(F.ctl + CW_BAR), F.MISC + 8);
#define IN(k) (lo <= (k) && (k) < hi)
#define NREP(k) ((((repmask) >> (k)) & 1) + 1)
#define REPBAR() do { if (rep) xcd_barrier(bar); } while (0)
#define SEAM(k) do { if (DBG_SEL == (k) && blockIdx.x == 0 && F.tid == 0) dbg_t1 = __builtin_amdgcn_s_memrealtime(); if (IN(k) && IN((k) + 1)) xcd_barrier(bar); if ((DBG_SEL == (k) + 1 || (DBG_SEL == 20 && (k) == 1)) && blockIdx.x == 0 && F.tid == 0) dbg_t0 = __builtin_amdgcn_s_memrealtime(); } while (0)
    unsigned long long dbg_t0 = 0ull, dbg_t1 = 0ull;

    if (IN(0)) { { p0_prologue(F); } } SEAM(0);
    if (IN(1)) { {
        pg8::Gemm g{(const pg8::bf16_t*)(ws + WS_H), (const pg8::bf16_t*)(ws + WS_WIN), M, NG1, D}; pg8::StaticOrder S; S.init(M, NG1, F.G, (int)blockIdx.x);
        pg8::EpiG1 E{(float*)(ws + WS_PRW), (float*)(ws + WS_BND), (pg8::bf16_t*)((unsigned char*)F.out + DO_PNSA), (pg8::bf16_t*)(ws + WS_MG), (float*)((unsigned char*)F.out + DO_GLOG)};
        pg8::gemm_phase<pg8::EpiG1, pg8::StaticOrder, true, true>(F.lds + RING_OFF, g, S, E);
    } } SEAM(1);
    if (IN(2)) {
        for (int u = F.vcu; u < 256; u += F.G) nsa_prep_tile(F, u);
        if (DBG_SEL == 20 && blockIdx.x == 0 && F.tid == 0) dbg_t1 = __builtin_amdgcn_s_memrealtime();
        if (DBG_SEL == 21 && blockIdx.x == 0 && F.tid == 0) dbg_t0 = __builtin_amdgcn_s_memrealtime();
        for (int u = F.vcu; u < 256; u += F.G) compress_unit(F, u);
        if (DBG_SEL == 21 && blockIdx.x == 0 && F.tid == 0) dbg_t1 = __builtin_amdgcn_s_memrealtime();
        for (int u = F.vcu; u < 256; u += F.G) rwkv_prep_tile(F, u);
    } SEAM(2);
    if (IN(3)) { {
        if ((int)blockIdx.x < 32 && !(rep && P3REP == 3)) { if (F.wave < 4) rwkv_scan_wave(F, (int)blockIdx.x, F.wave); else if (F.wave == 4) rwkv_scan_prefetch(F, (int)blockIdx.x); __syncthreads(); }
        if (!(rep && P3REP == 2)) nsa_phase(F, rep);
    } } SEAM(3);
    if (IN(4)) { { rwkv_epilogue(F); } } SEAM(4);
    if (IN(5)) { {
        { pg8::Gemm g{(const pg8::bf16_t*)(ws + WS_H), (const pg8::bf16_t*)(ws + WS_WA), M, D, 512}; pg8::StaticOrder S; S.init(M, D, F.G, (int)blockIdx.x);
          pg8::EpiGate1 E{(float*)(ws + WS_PRW), (const pg8::bf16_t*)(ws + WS_MG), 0};
          pg8::gemm_phase<pg8::EpiGate1, pg8::StaticOrder, true, true>(F.lds + RING_OFF, g, S, E); }
        VM_WAIT(); __syncthreads();
        { pg8::Gemm g{(const pg8::bf16_t*)(ws + WS_H + 16 * MiB), (const pg8::bf16_t*)(ws + WS_WB), M, D, 512}; pg8::StaticOrder S; S.init(M, D, F.G, (int)blockIdx.x);
          pg8::EpiGate2 E{(const float*)(ws + WS_PRW), (const pg8::bf16_t*)(ws + WS_MG), 1024, (pg8::bf16_t*)(ws + WS_PRW + 64 * MiB)};
          pg8::gemm_phase<pg8::EpiGate2, pg8::StaticOrder, true, true>(F.lds + RING_OFF, g, S, E); }
    } } SEAM(5);
    if (IN(6)) { {
        pg8::Gemm g{(const pg8::bf16_t*)(ws + WS_PRW + 64 * MiB), (const pg8::bf16_t*)(ws + WS_WOUT), M, D, D}; pg8::StaticOrder S; S.init(M, D, F.G, (int)blockIdx.x);
        pg8::EpiRes E{F.in[0], F.out};
        pg8::gemm_phase<pg8::EpiRes, pg8::StaticOrder, true, true>(F.lds + RING_OFF, g, S, E);
    } } SEAM(6);
    if (IN(7)) { { const int gw = F.vcu * NWAVES + F.wave, NGW = F.G * NWAVES;
        for (int m = gw; m < M; m += NGW) rms_row_to_bf16(F.lane, F.out + (size_t)m * D, F.in[27], (bf16*)(ws + WS_H) + (size_t)m * D);
        peer_convert_tables(F);
    } } SEAM(7);
    if (IN(8)) { {
        pg8::Gemm g{(const pg8::bf16_t*)(ws + WS_H), (const pg8::bf16_t*)(ws + WS_WQ), M, 2048, D}; pg8::StaticOrder S; S.init(M, 2048, F.G, (int)blockIdx.x);
        pg8::EpiBf16<0> E{(pg8::bf16_t*)(ws + WS_PRW), 2048, nullptr, 0, 0, 1.f};
        pg8::gemm_phase<pg8::EpiBf16<0>, pg8::StaticOrder, true, true>(F.lds + RING_OFF, g, S, E);
    } } SEAM(8);
    if (IN(9)) { { const int gw = F.vcu * NWAVES + F.wave, NGW = F.G * NWAVES; LAS float* sc = (LAS float*)(F.lds + F.wave * 16384);
        for (int wp = gw; wp < M * 8 / 32; wp += NGW) peer_topk_pass(F, wp, sc);
    } } SEAM(9);
    if (IN(10)) { peer_slice_phase<0>(F, rep); } SEAM(10);
    if (IN(11)) { peer_act_phase(F); } SEAM(11);
    if (IN(12)) { peer_slice_phase<1>(F, rep); }
    if (DBG_SEL >= 0 && multi) { if (DBG_SEL == 12 && blockIdx.x == 0 && F.tid == 0) dbg_t1 = __builtin_amdgcn_s_memrealtime(); xcd_barrier(bar); if (blockIdx.x == 0 && F.tid == 0) F.out[0] += (DBG_SEL >= 30) ? (0.05f + (float)(F.MISC[21] - F.MISC[20]) * 0.01f * 1e-3f) : (0.05f + (float)(dbg_t1 - dbg_t0) * 0.01f * 2e-4f); }
#undef IN
#undef SEAM
}

extern "C" void kernel_launch(void* const* d_in, const int* in_sizes, int n_in, void* d_out, int out_size, void* d_ws, size_t ws_size, hipStream_t stream) {
    static int grid = 0;
    if (grid == 0) {
        if (n_in != 33 || out_size != M * D || ws_size < WS_END) { fprintf(stderr, "kernel_launch: unexpected shapes (n_in %d out %d ws %zu)\n", n_in, out_size, ws_size); grid = -1; return; }
        int dev = 0, cus = 0, per_cu = 0;
        if (hipGetDevice(&dev) != hipSuccess || hipDeviceGetAttribute(&cus, hipDeviceAttributeMultiprocessorCount, dev) != hipSuccess) { grid = -1; return; }
        if (hipFuncSetAttribute((const void*)mk_fwd, hipFuncAttributeMaxDynamicSharedMemorySize, LDS_BYTES) != hipSuccess) { fprintf(stderr, "kernel_launch: hipFuncSetAttribute failed\n"); grid = -1; return; }
        if (hipOccupancyMaxActiveBlocksPerMultiprocessor(&per_cu, (const void*)mk_fwd, NWAVES * 64, LDS_BYTES) != hipSuccess || per_cu < 1)
            fprintf(stderr, "kernel_launch: occupancy query reports %d blocks per CU\n", per_cu);
        (void)hipGetLastError();
        grid = cus;
        if (grid > 256) grid = 256;
    }
    if (grid < 0) return;
    if (hipMemsetAsync((char*)d_ws + WS_CTL, 0, CTL_ZERO_BYTES, stream) != hipSuccess) return;
    Args a{};
    for (int i = 0; i < 33; ++i) a.in[i] = (const float*)d_in[i];
    a.out = (float*)d_out; a.ws = (unsigned char*)d_ws;
#if MK_ONE_LAUNCH
    a.ph_lo = 0; a.ph_hi = N_PHASES;
    hipLaunchKernelGGL(mk_fwd, dim3(grid), dim3(NWAVES * 64), LDS_BYTES, stream, a);
#else
    for (int p = 0; p < N_PHASES; ++p) { for (int r = 0; r <= (((REP_MASK) >> p) & 1); ++r) { a.ph_lo = p; a.ph_hi = (p + 1) | (r << 8); hipLaunchKernelGGL(mk_fwd, dim3(grid), dim3(NWAVES * 64), LDS_BYTES, stream, a); } }
#endif
}
```

```cpp
#include <hip/hip_runtime.h>
#include <cstdio>
#include <cstdint>
#define MK_ONE_LAUNCH 1
#define REP_MASK 0
#define P3REP 1
#define NSA_SKIP 0
#define DBG_SEL -1
namespace pg8 {
#define PG8_LAS __attribute__((address_space(3)))
typedef unsigned short bf16_t;
typedef short bf16x8 __attribute__((ext_vector_type(8)));
typedef float f32x4 __attribute__((ext_vector_type(4)));
typedef unsigned u32x4 __attribute__((ext_vector_type(4)));
constexpr int BM = 256, BK = 64, HALF = 128, HTB = HALF * BK * 2  , STAGE_BYTES = 8 * HTB, NXCD = 8, WGM = 8;

__host__ __device__ __forceinline__ int lds_byte(int r, int c) { const int st = (r >> 4) * 2 + (c >> 5), rr = r & 15, cc = c & 31, ob = rr * 64 + cc * 2; return st * 1024 + (ob ^ (((ob >> 9) & 1) << 5)); }
__host__ __device__ __forceinline__ void stage_rc(int b, int& R, int& C) { const int st = b / 1024, sb = b % 1024, swz = sb ^ (((sb >> 9) & 1) << 5); R = (st >> 1) * 16 + swz / 64; C = (st & 1) * 32 + (swz % 64) / 2; }
__host__ __device__ __forceinline__ int perm32(int rho) { const int n = rho >> 4, i = rho & 15; return 8 * (i >> 2) + 4 * n + (i & 3); }

struct Unit { int pm, pn; };
struct Gemm { const bf16_t* A; const bf16_t* Bt; int M, N, K; };

struct StaticOrder {
    int nM, nN, nwg, G, c;
    __host__ __device__ void init(int M, int N, int G_, int c_) { nM = M / BM; nN = N / BM; nwg = nM * nN; G = G_; c = c_; }
    __host__ __device__ bool next(int i, Unit& u) const {
        const long L = (long)i * G + c; if (L >= nwg) return false;
        int wgid = (int)L; { const int q = nwg / NXCD, r = nwg % NXCD, xcd = wgid % NXCD, off = wgid / NXCD; wgid = (xcd < r ? xcd * (q + 1) : r * (q + 1) + (xcd - r) * q) + off; }
        const int nig = WGM * nN, gid = wgid / nig, fm = gid * WGM, gsz = (nM - fm) < WGM ? (nM - fm) : WGM;
        u.pm = fm + ((wgid % nig) % gsz); u.pn = (wgid % nig) / gsz; return true;
    }
    __device__ __forceinline__ void a_ready(const Unit&) const {}
    __device__ __forceinline__ void done(const Unit&) const {}
};

typedef float f32x2c __attribute__((ext_vector_type(2))); typedef __bf16 bf16x2c __attribute__((ext_vector_type(2)));
__device__ __forceinline__ unsigned cvt_pk_bf16(float lo, float hi) { const f32x2c v = {lo, hi}; const bf16x2c b = __builtin_convertvector(v, bf16x2c); return __builtin_bit_cast(unsigned, b); }
typedef float f32x2 __attribute__((ext_vector_type(2)));
__device__ __forceinline__ f32x2 gelu_pk(f32x2 v) {
    const f32x2 av = __builtin_elementwise_abs(v), d = av * 0.2316418882f + 1.0f;
    f32x2 t; t.x = __builtin_amdgcn_rcpf(d.x); t.y = __builtin_amdgcn_rcpf(d.y);
    f32x2 q = t * 0.5307027145f + (-0.7265760135f); q = q * t + 0.7107068705f; q = q * t + (-0.142248368f); q = q * t + 0.127414796f; q = q * t;
    const f32x2 s = (v * v) * (-0.72134752044f);
    f32x2 e; e.x = __builtin_amdgcn_exp2f(s.x); e.y = __builtin_amdgcn_exp2f(s.y);
    const f32x2 m = v * (q * e), r = v - m;
    f32x2 o; o.x = v.x < 0.f ? m.x : r.x; o.y = v.y < 0.f ? m.y : r.y; return o;
}

template <int ACT  > struct EpiBf16 {
    static constexpr bool PERM = true, AFTER_DRAIN = false; static_assert(ACT == 0 || ACT == 1, "EpiBf16: ACT is 0 (none) or 1 (gelu_pk)");
    bf16_t* O; int ldc; const float* bias; int split_cols; size_t split_stride; float scale0;
    __device__ __forceinline__ void operator()(const f32x4 (&acc)[2][2][4][2], const Unit& u, int wr, int wc, int fr, int fq) const {
        const int row0 = u.pm * BM + wr * 64 + fr; int colt = u.pn * BM; bf16_t* base = O;
        float sc = 1.f; if (split_cols) { const int t = colt / split_cols; base += (size_t)t * split_stride; colt -= t * split_cols; if (t == 0) sc = scale0; }
        const int col0 = colt + wc * 32 + 8 * fq, bcol0 = u.pn * BM + wc * 32 + 8 * fq;
        f32x4 bv[2][2];
#pragma unroll
        for (int bj = 0; bj < 2; ++bj)
#pragma unroll
            for (int n = 0; n < 2; ++n) bv[bj][n] = bias ? *(const f32x4*)(bias + bcol0 + bj * HALF + 4 * n) : (f32x4){0.f, 0.f, 0.f, 0.f};
#pragma unroll
        for (int ai = 0; ai < 2; ++ai)
#pragma unroll
            for (int m = 0; m < 4; ++m) { bf16_t* rowp = base + (size_t)(row0 + ai * HALF + m * 16) * ldc + col0;
#pragma unroll
                for (int bj = 0; bj < 2; ++bj) { f32x4 v0 = acc[ai][bj][m][0] + bv[bj][0], v1 = acc[ai][bj][m][1] + bv[bj][1];
                    if (ACT == 1) { f32x2 a = gelu_pk((f32x2){v0[0], v0[1]}), b = gelu_pk((f32x2){v0[2], v0[3]}), c = gelu_pk((f32x2){v1[0], v1[1]}), d = gelu_pk((f32x2){v1[2], v1[3]});
                        v0 = (f32x4){a.x, a.y, b.x, b.y}; v1 = (f32x4){c.x, c.y, d.x, d.y}; }
                    v0 = v0 * sc; v1 = v1 * sc; u32x4 w; w.x = cvt_pk_bf16(v0[0], v0[1]); w.y = cvt_pk_bf16(v0[2], v0[3]); w.z = cvt_pk_bf16(v1[0], v1[1]); w.w = cvt_pk_bf16(v1[2], v1[3]);
                    *(u32x4*)(rowp + bj * HALF) = w; } }
    }
};
__device__ __forceinline__ float bf_lo(unsigned w) { return __uint_as_float(w << 16); }
__device__ __forceinline__ float bf_hi(unsigned w) { return __uint_as_float(w & 0xffff0000u); }
__device__ __forceinline__ float sigm(float x) { return __builtin_amdgcn_rcpf(1.0f + __expf(-x)); }
__device__ __forceinline__ u32x4 pack8(const f32x4 v0, const f32x4 v1) { u32x4 w; w.x = cvt_pk_bf16(v0[0], v0[1]); w.y = cvt_pk_bf16(v0[2], v0[3]); w.z = cvt_pk_bf16(v1[0], v1[1]); w.w = cvt_pk_bf16(v1[2], v1[3]); return w; }

struct EpiG1 {
    static constexpr bool PERM = true, AFTER_DRAIN = false;
    float* PRW; float* BND; bf16_t* PNSA; bf16_t* MG; float* GLOG;
    __device__ __forceinline__ void operator()(const f32x4 (&acc)[2][2][4][2], const Unit& u, int wr, int wc, int fr, int fq) const {
        const int row0 = u.pm * BM + wr * 64 + fr, c0 = wc * 32 + 8 * fq;
#pragma unroll
        for (int ai = 0; ai < 2; ++ai)
#pragma unroll
            for (int m = 0; m < 4; ++m) { const int row = row0 + ai * HALF + m * 16;
#pragma unroll
                for (int bj = 0; bj < 2; ++bj) { const f32x4 v0 = acc[ai][bj][m][0], v1 = acc[ai][bj][m][1]; const int col = c0 + bj * HALF;
                    if (u.pn < 7) { float* p = PRW + (size_t)row * 1792 + u.pn * 256 + col; *(f32x4*)p = v0; *(f32x4*)(p + 4) = v1;
                        if ((row & 63) == 63) { float* q = BND + (size_t)(row >> 6) * 1792 + u.pn * 256 + col; *(f32x4*)q = v0; *(f32x4*)(q + 4) = v1; } }
                    else if (u.pn < 12) { *(u32x4*)(PNSA + (size_t)row * 1280 + (u.pn - 7) * 256 + col) = pack8(v0, v1); }
                    else if (u.pn < 20) { *(u32x4*)(MG + (size_t)row * 2048 + (u.pn - 12) * 256 + col) = pack8(v0, v1); }
                    else { if (col < 32) { float* p = GLOG + (size_t)row * 32 + col; *(f32x4*)p = v0; *(f32x4*)(p + 4) = v1; } }
                } }
    }
};
struct EpiGate1 {
    static constexpr bool PERM = true, AFTER_DRAIN = false;
    float* T1; const bf16_t* MG; int goff;
    __device__ __forceinline__ void operator()(const f32x4 (&acc)[2][2][4][2], const Unit& u, int wr, int wc, int fr, int fq) const {
        const int row0 = u.pm * BM + wr * 64 + fr, c0 = u.pn * BM + wc * 32 + 8 * fq;
#pragma unroll
        for (int ai = 0; ai < 2; ++ai)
#pragma unroll
            for (int m = 0; m < 4; ++m) { const int row = row0 + ai * HALF + m * 16;
#pragma unroll
                for (int bj = 0; bj < 2; ++bj) { const f32x4 v0 = acc[ai][bj][m][0], v1 = acc[ai][bj][m][1]; const int col = c0 + bj * HALF;
                    const u32x4 g = *(const u32x4*)(MG + (size_t)row * 2048 + goff + col);
                    f32x4 o0, o1; o0[0] = sigm(bf_lo(g.x)) * v0[0]; o0[1] = sigm(bf_hi(g.x)) * v0[1]; o0[2] = sigm(bf_lo(g.y)) * v0[2]; o0[3] = sigm(bf_hi(g.y)) * v0[3];
                    o1[0] = sigm(bf_lo(g.z)) * v1[0]; o1[1] = sigm(bf_hi(g.z)) * v1[1]; o1[2] = sigm(bf_lo(g.w)) * v1[2]; o1[3] = sigm(bf_hi(g.w)) * v1[3];
                    float* p = T1 + (size_t)row * 1024 + col; *(f32x4*)p = o0; *(f32x4*)(p + 4) = o1; } }
    }
};
struct EpiGate2 {
    static constexpr bool PERM = true, AFTER_DRAIN = false;
    const float* T1; const bf16_t* MG; int goff; bf16_t* MIX;
    __device__ __forceinline__ void operator()(const f32x4 (&acc)[2][2][4][2], const Unit& u, int wr, int wc, int fr, int fq) const {
        const int row0 = u.pm * BM + wr * 64 + fr, c0 = u.pn * BM + wc * 32 + 8 * fq;
#pragma unroll
        for (int ai = 0; ai < 2; ++ai)
#pragma unroll
            for (int m = 0; m < 4; ++m) { const int row = row0 + ai * HALF + m * 16;
#pragma unroll
                for (int bj = 0; bj < 2; ++bj) { const f32x4 v0 = acc[ai][bj][m][0], v1 = acc[ai][bj][m][1]; const int col = c0 + bj * HALF;
                    const u32x4 g = *(const u32x4*)(MG + (size_t)row * 2048 + goff + col);
                    const float* p = T1 + (size_t)row * 1024 + col; const f32x4 t0 = *(const f32x4*)p, t1 = *(const f32x4*)(p + 4);
                    f32x4 o0, o1; o0[0] = t0[0] + sigm(bf_lo(g.x)) * v0[0]; o0[1] = t0[1] + sigm(bf_hi(g.x)) * v0[1]; o0[2] = t0[2] + sigm(bf_lo(g.y)) * v0[2]; o0[3] = t0[3] + sigm(bf_hi(g.y)) * v0[3];
                    o1[0] = t1[0] + sigm(bf_lo(g.z)) * v1[0]; o1[1] = t1[1] + sigm(bf_hi(g.z)) * v1[1]; o1[2] = t1[2] + sigm(bf_lo(g.w)) * v1[2]; o1[3] = t1[3] + sigm(bf_hi(g.w)) * v1[3];
                    *(u32x4*)(MIX + (size_t)row * 1024 + col) = pack8(o0, o1); } }
    }
};
struct EpiRes {
    static constexpr bool PERM = true, AFTER_DRAIN = false;
    const float* X; float* OUT;
    __device__ __forceinline__ void operator()(const f32x4 (&acc)[2][2][4][2], const Unit& u, int wr, int wc, int fr, int fq) const {
        const int row0 = u.pm * BM + wr * 64 + fr, c0 = u.pn * BM + wc * 32 + 8 * fq;
#pragma unroll
        for (int ai = 0; ai < 2; ++ai)
#pragma unroll
            for (int m = 0; m < 4; ++m) { const int row = row0 + ai * HALF + m * 16;
#pragma unroll
                for (int bj = 0; bj < 2; ++bj) { const size_t off = (size_t)row * 1024 + c0 + bj * HALF;
                    const f32x4 x0 = *(const f32x4*)(X + off), x1 = *(const f32x4*)(X + off + 4);
                    *(f32x4*)(OUT + off) = x0 + acc[ai][bj][m][0]; *(f32x4*)(OUT + off + 4) = x1 + acc[ai][bj][m][1]; } }
    }
};
template <class Epi, class Sched, bool ALIGN_EPI = false, bool SP2 = false>
__device__ __forceinline__ void gemm_phase(PG8_LAS unsigned char* lds, const Gemm g, const Sched& S, const Epi& E) {
    const int tid = threadIdx.x, wid = __builtin_amdgcn_readfirstlane(tid >> 6), lane = tid & 63, wr = wid >> 2, wc = wid & 3, fr = lane & 15, fq = lane >> 4;
    const int K = g.K, nt = K / BK;
    unsigned voffA[2], voffB[2];
#pragma unroll
    for (int i = 0; i < 2; ++i) { int R, C; stage_rc(tid * 16 + i * 8192, R, C); const int Rb = Epi::PERM ? ((R & ~31) + perm32(R & 31)) : R;
        voffA[i] = (unsigned)(R * K + C) * 2u; voffB[i] = (unsigned)(Rb * K + C) * 2u; }
    const size_t kstep = (size_t)(BK * 2);
    const size_t hstep = (size_t)HALF * K * 2;
    const size_t tstep = 2 * hstep;
    const unsigned ldsw = (unsigned)wid * 1024u;
    const int aoff = lds_byte(wr * 64 + fr, fq * 8), boff = lds_byte(wc * 32 + fr, fq * 8);
#define PG8_SA(b, h) (((b) * 2 + (h)) * HTB)
#define PG8_SB(b, h) ((4 + (b) * 2 + (h)) * HTB)
#define PG8_STAGE(bufoff, gbase, voff) do { _Pragma("unroll") for (int _i = 0; _i < 2; ++_i) \
        __builtin_amdgcn_global_load_lds((const unsigned*)((const char*)(gbase) + (voff)[_i]), (PG8_LAS unsigned*)(lds + (bufoff) + ldsw + _i * 8192), 16, 0, 0); } while (0)
#define PG8_LDA(dst, b, h) do { _Pragma("unroll") for (int m = 0; m < 4; ++m) _Pragma("unroll") for (int k = 0; k < 2; ++k) dst[m][k] = *(const PG8_LAS bf16x8*)(lds + PG8_SA(b, h) + aoff + m * 2048 + k * 1024); } while (0)
#define PG8_LDB(dst, b, h) do { _Pragma("unroll") for (int n = 0; n < 2; ++n) _Pragma("unroll") for (int k = 0; k < 2; ++k) dst[n][k] = *(const PG8_LAS bf16x8*)(lds + PG8_SB(b, h) + boff + n * 2048 + k * 1024); } while (0)
#define PG8_MMA(ai, bj, At, Bt) do { __builtin_amdgcn_s_setprio(1); _Pragma("unroll") for (int m = 0; m < 4; ++m) _Pragma("unroll") for (int n = 0; n < 2; ++n) _Pragma("unroll") for (int k = 0; k < 2; ++k) \
        acc[ai][bj][m][n] = __builtin_amdgcn_mfma_f32_16x16x32_bf16(Bt[n][k], At[m][k], acc[ai][bj][m][n], 0, 0, 0); __builtin_amdgcn_s_setprio(0); } while (0)
#define PG8_WAIT_V(n) asm volatile("s_waitcnt vmcnt(" #n ")" ::: "memory")
#define PG8_WAIT_L(n) asm volatile("s_waitcnt lgkmcnt(" #n ")" ::: "memory")
#define PG8_BAR __builtin_amdgcn_s_barrier()
#define PG8_SCHED __builtin_amdgcn_sched_barrier(0)
    Unit cur, nxt; int ui = 0;
    if (!S.next(0, cur)) return;
    f32x4 acc[2][2][4][2];
#pragma unroll
    for (int a = 0; a < 2; ++a)
#pragma unroll
        for (int b = 0; b < 2; ++b)
#pragma unroll
            for (int m = 0; m < 4; ++m)
#pragma unroll
                for (int n = 0; n < 2; ++n) acc[a][b][m][n] = (f32x4){0.f, 0.f, 0.f, 0.f};
    bf16x8 At[4][2], B0[2][2], B1[2][2];
    const char* cA = (const char*)g.A + (size_t)cur.pm * tstep; const char* cB = (const char*)g.Bt + (size_t)cur.pn * tstep;
    S.a_ready(cur);
    if constexpr (SP2) {
        PG8_STAGE(PG8_SB(0, 0), cB, voffB); PG8_STAGE(PG8_SB(0, 1), cB + hstep, voffB); PG8_STAGE(PG8_SA(0, 0), cA, voffA); PG8_STAGE(PG8_SA(0, 1), cA + hstep, voffA);
        if (wr == 1) PG8_BAR;
        PG8_WAIT_V(2); PG8_BAR;
        PG8_STAGE(PG8_SB(1, 0), cB + kstep, voffB); PG8_STAGE(PG8_SA(1, 0), cA + kstep, voffA); PG8_STAGE(PG8_SB(1, 1), cB + hstep + kstep, voffB);
        PG8_WAIT_V(6); PG8_BAR;
    } else {
        PG8_STAGE(PG8_SB(0, 0), cB, voffB); PG8_STAGE(PG8_SA(0, 0), cA, voffA); PG8_STAGE(PG8_SB(0, 1), cB + hstep, voffB); PG8_STAGE(PG8_SA(0, 1), cA + hstep, voffA);
        if (wr == 1) PG8_BAR;
        PG8_WAIT_V(4); PG8_BAR;
        PG8_STAGE(PG8_SB(1, 0), cB + kstep, voffB); PG8_STAGE(PG8_SA(1, 0), cA + kstep, voffA); PG8_STAGE(PG8_SB(1, 1), cB + hstep + kstep, voffB);
        PG8_WAIT_V(6); PG8_BAR;
    }
    for (;;) {
        const bool has_next = S.next(ui + 1, nxt);
        const char* nA = has_next ? (const char*)g.A + (size_t)nxt.pm * tstep : cA; const char* nB = has_next ? (const char*)g.Bt + (size_t)nxt.pn * tstep : cB;
        for (int t = 0; t < nt; t += 2) {
            const bool last = (t == nt - 2);
            const char* a1 = cA + (size_t)(t + 1) * kstep;
            const char* a2 = last ? nA : cA + (size_t)(t + 2) * kstep; const char* b2 = last ? nB : cB + (size_t)(t + 2) * kstep;
            const char* a3 = a2 + kstep; const char* b3 = b2 + kstep;
            if (last && has_next) S.a_ready(nxt);
            if constexpr (SP2) {
            PG8_LDB(B0, 0, 0); PG8_LDB(B1, 0, 1); PG8_SCHED; PG8_LDA(At, 0, 0); PG8_STAGE(PG8_SA(1, 1), a1 + hstep, voffA);
            PG8_WAIT_V(8); PG8_WAIT_L(0); PG8_BAR; PG8_MMA(0, 0, At, B0); PG8_MMA(0, 1, At, B1); PG8_BAR; PG8_SCHED;
            PG8_LDA(At, 0, 1); PG8_STAGE(PG8_SB(0, 0), b2, voffB); PG8_STAGE(PG8_SB(0, 1), b2 + hstep, voffB); PG8_STAGE(PG8_SA(0, 0), a2, voffA);
            PG8_WAIT_V(8); PG8_WAIT_L(0); PG8_BAR; PG8_MMA(1, 0, At, B0); PG8_MMA(1, 1, At, B1); PG8_BAR; PG8_SCHED;
            PG8_LDB(B0, 1, 0); PG8_LDB(B1, 1, 1); PG8_SCHED; PG8_LDA(At, 1, 0); PG8_STAGE(PG8_SA(0, 1), a2 + hstep, voffA);
            PG8_WAIT_V(8); PG8_WAIT_L(0); PG8_BAR; PG8_MMA(0, 0, At, B0); PG8_MMA(0, 1, At, B1); PG8_BAR; PG8_SCHED;
            PG8_LDA(At, 1, 1); PG8_STAGE(PG8_SB(1, 0), b3, voffB); PG8_STAGE(PG8_SB(1, 1), b3 + hstep, voffB); PG8_STAGE(PG8_SA(1, 0), a3, voffA);
            PG8_WAIT_V(8); PG8_WAIT_L(0); PG8_BAR; PG8_MMA(1, 0, At, B0); PG8_MMA(1, 1, At, B1); PG8_BAR; PG8_SCHED;
            } else {
            PG8_LDB(B0, 0, 0); PG8_SCHED; PG8_LDA(At, 0, 0); PG8_STAGE(PG8_SA(1, 1), a1 + hstep, voffA);
            PG8_WAIT_L(8); PG8_BAR; PG8_WAIT_L(0); PG8_MMA(0, 0, At, B0); PG8_BAR; PG8_SCHED;
            PG8_LDB(B1, 0, 1); PG8_STAGE(PG8_SB(0, 0), b2, voffB);
            PG8_BAR; PG8_WAIT_L(0); PG8_MMA(0, 1, At, B1); PG8_BAR;
            PG8_LDA(At, 0, 1); PG8_STAGE(PG8_SA(0, 0), a2, voffA);
            PG8_BAR; PG8_WAIT_L(0); PG8_MMA(1, 0, At, B0); PG8_BAR; PG8_SCHED;
            PG8_STAGE(PG8_SB(0, 1), b2 + hstep, voffB);
            PG8_WAIT_V(6); PG8_BAR; PG8_MMA(1, 1, At, B1); PG8_BAR;
            PG8_LDB(B0, 1, 0); PG8_SCHED; PG8_LDA(At, 1, 0); PG8_STAGE(PG8_SA(0, 1), a2 + hstep, voffA);
            PG8_WAIT_L(8); PG8_BAR; PG8_WAIT_L(0); PG8_MMA(0, 0, At, B0); PG8_BAR; PG8_SCHED;
            PG8_LDB(B1, 1, 1); PG8_STAGE(PG8_SB(1, 0), b3, voffB);
            PG8_BAR; PG8_WAIT_L(0); PG8_MMA(0, 1, At, B1); PG8_BAR;
            PG8_LDA(At, 1, 1); PG8_STAGE(PG8_SA(1, 0), a3, voffA);
            PG8_BAR; PG8_WAIT_L(0); PG8_MMA(1, 0, At, B0); PG8_BAR; PG8_SCHED;
            PG8_STAGE(PG8_SB(1, 1), b3 + hstep, voffB);
            PG8_WAIT_V(6); PG8_BAR; PG8_MMA(1, 1, At, B1); PG8_BAR;
            }
        }
        if constexpr (ALIGN_EPI) { if (wr == 0) PG8_BAR; }
        if constexpr (!Epi::AFTER_DRAIN) { E(acc, cur, wr, wc, fr, fq); S.done(cur); }
        if (!has_next) break;
#pragma unroll
        for (int a = 0; a < 2; ++a)
#pragma unroll
            for (int b = 0; b < 2; ++b)
#pragma unroll
                for (int m = 0; m < 4; ++m)
#pragma unroll
                    for (int n = 0; n < 2; ++n) acc[a][b][m][n] = (f32x4){0.f, 0.f, 0.f, 0.f};
        cur = nxt; cA = nA; cB = nB; ++ui;
        if constexpr (ALIGN_EPI) { if (wr == 1) PG8_BAR; }
    }
    PG8_WAIT_V(0);
    if constexpr (!ALIGN_EPI) { if (wr == 0) PG8_BAR; }
    PG8_BAR;
    if constexpr (Epi::AFTER_DRAIN) { E.fused(acc, cur, wr, wc, fr, fq, lds, wid, lane); S.done(cur); }
#undef PG8_SA
#undef PG8_SB
#undef PG8_STAGE
#undef PG8_LDA
#undef PG8_LDB
#undef PG8_MMA
#undef PG8_WAIT_V
#undef PG8_WAIT_L
#undef PG8_BAR
#undef PG8_SCHED
}
}
#define GAS __attribute__((address_space(1)))
#define LAS __attribute__((address_space(3)))
typedef unsigned short bf16;
typedef unsigned v4u __attribute__((ext_vector_type(4)));
typedef float f32x4 __attribute__((ext_vector_type(4)));
typedef short bf16x8 __attribute__((ext_vector_type(8)));
typedef GAS unsigned gu32;
typedef GAS unsigned long long gu64;
#define RLX_AGENT __ATOMIC_RELAXED, __HIP_MEMORY_SCOPE_AGENT
#define LDS_WAIT() asm volatile("s_waitcnt lgkmcnt(0)" ::: "memory")
#define VM_WAIT() asm volatile("s_waitcnt vmcnt(0)" ::: "memory")
__device__ __forceinline__ unsigned long long rt() { return __builtin_amdgcn_s_memrealtime(); }
__device__ __forceinline__ unsigned f2bf(float f) { unsigned u = __builtin_bit_cast(unsigned, f); return (u + 0x7fffu + ((u >> 16) & 1u)) >> 16; }
__device__ __forceinline__ unsigned pk2(float lo, float hi) { return f2bf(lo) | (f2bf(hi) << 16); }

#define XB_TMO      128
#define XB_XCNT(j)  (256  + 64 * (j))
#define XB_XSUB(j)  (1280 + 64 * (j))
#define XB_XGEN(j)  (2304 + 64 * (j))
#define XB_TOP      3328
#define XB_TOPGEN   3392
#define XCD_BAR_WORDS 3456
#define XB_SPIN_CAP (1u << 18)

__device__ __forceinline__ unsigned xb_ld(unsigned* p)              { return __hip_atomic_load(p, __ATOMIC_RELAXED, __HIP_MEMORY_SCOPE_AGENT); }
__device__ __forceinline__ unsigned xb_add(unsigned* p, unsigned v) { return __hip_atomic_fetch_add(p, v, __ATOMIC_RELAXED, __HIP_MEMORY_SCOPE_AGENT); }
__device__ __forceinline__ unsigned xb_xcc_id() { return (unsigned)__builtin_amdgcn_s_getreg((3 << 11) | 20) & 0xFu; }
#define XB_SPIN(cond, bar) do { unsigned _sp = 0; while (cond) { __builtin_amdgcn_s_sleep(1); \
    if ((++_sp & 255u) == 0u) { if (xb_ld(&(bar)[XB_TMO])) break; if (_sp > XB_SPIN_CAP) { atomicAdd(&(bar)[XB_TMO], 1u); break; } } } } while (0)

struct XcdBarrier {
    unsigned* bar; unsigned x;
    volatile LAS unsigned* st;
};

__device__ __forceinline__ XcdBarrier xcd_barrier_post(unsigned* bar, volatile LAS unsigned* st) {
    XcdBarrier b; b.bar = bar; b.x = xb_xcc_id(); b.st = st;
    if (threadIdx.x == 0) (void)xb_add(&bar[XB_XCNT(b.x)], 1u);
    return b;
}
__device__ __forceinline__ void xcd_barrier_complete(unsigned* bar, unsigned x, unsigned& nloc, unsigned& nx) {
    const unsigned G = gridDim.x * gridDim.y * gridDim.z;
    unsigned sum, cnt, mine, sp = 0u;
    for (;;) {
        sum = 0u; cnt = 0u; mine = 0u;
#pragma unroll
        for (unsigned j = 0; j < 16; ++j) { const unsigned c = xb_ld(&bar[XB_XCNT(j)]); sum += c; cnt += (c > 0u) ? 1u : 0u; mine = (j == x) ? c : mine; }
        if (sum == G) break;
        __builtin_amdgcn_s_sleep(1);
        if ((++sp & 255u) == 0u) { if (xb_ld(&bar[XB_TMO])) break; if (sp > XB_SPIN_CAP) { atomicAdd(&bar[XB_TMO], 1u); break; } }
    }
    nloc = mine > 0u ? mine : 1u; nx = cnt > 0u ? cnt : 1u;
}

__device__ __forceinline__ void xcd_barrier(const XcdBarrier& b) {
    asm volatile("s_waitcnt vmcnt(0)" ::: "memory");
    __syncthreads();
    if (threadIdx.x == 0) {
        unsigned* bar = b.bar;
        __builtin_amdgcn_s_waitcnt(0);
        unsigned nloc = b.st[0], nx = b.st[1];
        if (nloc == 0u) { xcd_barrier_complete(bar, b.x, nloc, nx); b.st[0] = nloc; b.st[1] = nx; }
        const unsigned old = xb_add(&bar[XB_XSUB(b.x)], 1u);
        const unsigned gen = old / nloc;
        if (old + 1u == (gen + 1u) * nloc) {
            __builtin_amdgcn_fence(__ATOMIC_RELEASE, "agent");
            asm volatile("s_waitcnt vmcnt(0)" ::: "memory");
            const unsigned og = xb_add(&bar[XB_TOP], 1u);
            const unsigned tg = og / nx;
            if (og + 1u == (tg + 1u) * nx) xb_add(&bar[XB_TOPGEN], 1u);
            else XB_SPIN(xb_ld(&bar[XB_TOPGEN]) == tg, bar);
            __builtin_amdgcn_fence(__ATOMIC_ACQUIRE, "agent");
            xb_add(&bar[XB_XGEN(b.x)], 1u);
            asm volatile("s_waitcnt vmcnt(0)" ::: "memory");
        } else {
            XB_SPIN(xb_ld(&bar[XB_XGEN(b.x)]) == gen, bar);
            __builtin_amdgcn_fence(__ATOMIC_ACQUIRE, "agent");
            asm volatile("s_waitcnt vmcnt(0)" ::: "memory");
        }
    }
    __syncthreads();
}
constexpr int NWAVES = 8;
constexpr int BATCH = 4, T = 4096, D = 1024, M = BATCH * T;
constexpr int RWC = 1792;
constexpr int NG1 = 5376;
constexpr float NORM_EPS = 1e-6f, GN_EPS = 64e-5f;
constexpr float LOG2E = 1.4426950408889634f;
constexpr int N_PHASES = 13;
#ifndef MK_ONE_LAUNCH
#define MK_ONE_LAUNCH 0
#endif
#ifndef REP_MASK
#define REP_MASK 0
#endif
#ifndef DBG_SEL
#define DBG_SEL -1
#endif
#ifndef NSA_SKIP
#define NSA_SKIP 0
#endif
#ifndef P3REP
#define P3REP 1
#endif
#ifndef SCAN_BLOCKS
#define SCAN_BLOCKS 128
#endif

constexpr size_t MiB = 1u << 20;
constexpr size_t WS_CTL = 0, CTL_ZERO_BYTES = 1 * MiB;
constexpr size_t WS_WIN = 1 * MiB;
constexpr size_t WS_WA = 12 * MiB, WS_WB = 13 * MiB;
constexpr size_t WS_WOUT = 14 * MiB;
constexpr size_t WS_WQ = 16 * MiB;
constexpr size_t WS_CW1K = 20 * MiB, WS_CW1V = 21 * MiB;
constexpr size_t WS_CW2K = 22 * MiB, WS_CW2V = 22 * MiB + 65536;
constexpr size_t WS_SK1 = 22 * MiB + 131072, WS_SK2 = 22 * MiB + 196608;
constexpr size_t WS_WUT = 22 * MiB + 262144, WS_AUT = WS_WUT + 65536, WS_GUT = WS_WUT + 131072;
constexpr size_t WS_BND = 23 * MiB;
constexpr size_t WS_KC = 25 * MiB;
constexpr size_t WS_VCT = 25 * MiB + 262144;
constexpr size_t WS_H = 26 * MiB;
constexpr size_t WS_PRW = 58 * MiB;
constexpr size_t WS_MG = 170 * MiB;
constexpr size_t WS_VST = 234 * MiB, WS_VWT = 238 * MiB;
constexpr size_t WS_END = 256 * MiB;
constexpr size_t DO_PNSA = 0, DO_G = 40 * MiB, DO_GLOG = 56 * MiB;
constexpr int CW_TMO = 0, CW_CODE = 1, CW_NSAQ = 64, CW_SCANP = 2048, CW_PEERQ = 4160, CW_BAR = 8192;

constexpr int RING_OFF = 0, RING_BYTES = 131072;
constexpr int LDSCTL_OFF = RING_BYTES, MISC_OFF = LDSCTL_OFF + 320;
constexpr int LDS_BYTES = 147456;
typedef unsigned short u16;
typedef unsigned u32x2 __attribute__((ext_vector_type(2)));
struct Frame {
    LAS unsigned char* lds;
    volatile LAS unsigned* MISC;
    gu32* ctl;
    int tid, lane, wave, vcu, G;
    const float* in[33];
    float* out; unsigned char* ws;
};
__device__ __forceinline__ float wave_sum(float v) {
#pragma unroll
    for (int o = 1; o < 64; o <<= 1) v += __shfl_xor(v, o);
    return v;
}
template <int CTRL> __device__ __forceinline__ float dppf(float x) { return __builtin_bit_cast(float, __builtin_amdgcn_update_dpp(0, __builtin_bit_cast(int, x), CTRL, 0xf, 0xf, true)); }
__device__ __forceinline__ float bf2f(u16 b) { return __uint_as_float((unsigned)b << 16); }
__device__ __forceinline__ float bflo(unsigned w) { return __uint_as_float(w << 16); }
__device__ __forceinline__ float bfhi(unsigned w) { return __uint_as_float(w & 0xffff0000u); }
__device__ __forceinline__ u16 f2b(float f) { return (u16)pg8::cvt_pk_bf16(f, 0.f); }
#define pk2(lo_, hi_) pg8::cvt_pk_bf16((lo_), (hi_))
__device__ __forceinline__ float sigmf(float x) { return __builtin_amdgcn_rcpf(1.0f + __expf(-x)); }
__device__ __forceinline__ float tanh_fast(float x) { return 1.0f - 2.0f * __builtin_amdgcn_rcpf(1.0f + __expf(2.0f * x)); }
__device__ __forceinline__ f32x4 mfma16(const bf16x8 a, const bf16x8 b, const f32x4 c) { return __builtin_amdgcn_mfma_f32_16x16x32_bf16(a, b, c, 0, 0, 0); }
__device__ __forceinline__ bf16x8 as_bf16x8(const v4u v) { return __builtin_bit_cast(bf16x8, v); }

__device__ __forceinline__ void tr_item(const float* W, int K, int ldw, int sc0, int nblk, int ncols_valid, bf16* WT, int dr0, LAS float* scr, int item, int lane) {
    const int kb = item / nblk, nb = item % nblk, k0 = 64 * kb, n0 = 32 * nb;
#pragma unroll 8
    for (int i = 0; i < 32; ++i) { const int kk = 2 * i + (lane >> 5); const int n = n0 + (lane & 31); const int nc = (n < ncols_valid) ? n : 0;
        const float v = W[(size_t)(k0 + kk) * ldw + sc0 + nc]; scr[kk * 33 + (lane & 31)] = (n < ncols_valid) ? v : 0.f; }
    LDS_WAIT(); asm volatile("" ::: "memory");
    const int c = lane & 7;
#pragma unroll
    for (int j = 0; j < 4; ++j) { const int n = (lane >> 3) + 8 * j; const LAS float* s = scr + (8 * c) * 33 + n;
        v4u o; o.x = pk2(s[0 * 33], s[1 * 33]); o.y = pk2(s[2 * 33], s[3 * 33]); o.z = pk2(s[4 * 33], s[5 * 33]); o.w = pk2(s[6 * 33], s[7 * 33]);
        *(GAS v4u*)(WT + (size_t)(dr0 + n0 + n) * K + k0 + 8 * c) = o; }
    LDS_WAIT(); asm volatile("" ::: "memory");
}
__device__ __forceinline__ void rms_row_to_bf16(int lane, const float* xrow, const float* gain, bf16* orow) {
    const GAS f32x4* xr = (const GAS f32x4*)xrow + lane; const GAS f32x4* gr = (const GAS f32x4*)gain + lane;
    f32x4 v[4]; float s2 = 0.f;
#pragma unroll
    for (int j = 0; j < 4; ++j) { v[j] = xr[64 * j]; s2 += (v[j].x * v[j].x + v[j].y * v[j].y) + (v[j].z * v[j].z + v[j].w * v[j].w); }
    const float rstd = 1.f / sqrtf(wave_sum(s2) * (1.f / D) + NORM_EPS);
    GAS unsigned long long* o8 = (GAS unsigned long long*)orow + lane;
#pragma unroll
    for (int j = 0; j < 4; ++j) { const f32x4 g = gr[64 * j];
        o8[64 * j] = (unsigned long long)pk2(v[j].x * rstd * g.x, v[j].y * rstd * g.y) | ((unsigned long long)pk2(v[j].z * rstd * g.z, v[j].w * rstd * g.w) << 32); }
}
__device__ __forceinline__ void p0_prologue(const Frame& F) {
    LAS float* scr = (LAS float*)(F.lds + RING_OFF + F.wave * 16384);
    const int gw = F.vcu * NWAVES + F.wave, NGW = F.G * NWAVES;
    unsigned char* ws = F.ws;
    constexpr int I0 = 16 * 96, I1 = 16 * 64, I2 = 16 * 8, I3 = 8 * 32, I4 = 8 * 32, I5 = 16 * 32, I6 = 16 * 64, I7 = 32 * 8, I8 = 32 * 8, I9 = 4 * 2, I10 = 4 * 2, I11 = 16, I12 = 16, I13 = 32;
    constexpr int NITEMS = I0 + I1 + I2 + I3 + I4 + I5 + I6 + I7 + I8 + I9 + I10 + I11 + I12 + I13;
    for (int it = gw; it < NITEMS; it += NGW) {
        int r = it;
        if (r < I0) { tr_item(F.in[2], 1024, 5144, 0, 96, 3072, (bf16*)(ws + WS_WIN), 0, scr, r, F.lane); continue; } r -= I0;
        if (r < I1) { tr_item(F.in[2], 1024, 5144, 3096, 64, 2048, (bf16*)(ws + WS_WIN), 3072, scr, r, F.lane); continue; } r -= I1;
        if (r < I2) { tr_item(F.in[2], 1024, 5144, 3072, 8, 24, (bf16*)(ws + WS_WIN), 5120, scr, r, F.lane); continue; } r -= I2;
        if (r < I3) { tr_item(F.in[24], 512, 1024, 0, 32, 1024, (bf16*)(ws + WS_WA), 0, scr, r, F.lane); continue; } r -= I3;
        if (r < I4) { tr_item(F.in[25], 512, 1024, 0, 32, 1024, (bf16*)(ws + WS_WB), 0, scr, r, F.lane); continue; } r -= I4;
        if (r < I5) { tr_item(F.in[26], 1024, 1024, 0, 32, 1024, (bf16*)(ws + WS_WOUT), 0, scr, r, F.lane); continue; } r -= I5;
        if (r < I6) { tr_item(F.in[28], 1024, 2048, 0, 64, 2048, (bf16*)(ws + WS_WQ), 0, scr, r, F.lane); continue; } r -= I6;
        if (r < I7) { tr_item(F.in[20], 2048, 256, 0, 8, 256, (bf16*)(ws + WS_CW1K), 0, scr, r, F.lane); continue; } r -= I7;
        if (r < I8) { tr_item(F.in[22], 2048, 256, 0, 8, 256, (bf16*)(ws + WS_CW1V), 0, scr, r, F.lane); continue; } r -= I8;
        if (r < I9) { tr_item(F.in[21], 256, 64, 0, 2, 64, (bf16*)(ws + WS_CW2K), 0, scr, r, F.lane); continue; } r -= I9;
        if (r < I10) { tr_item(F.in[23], 256, 64, 0, 2, 64, (bf16*)(ws + WS_CW2V), 0, scr, r, F.lane); continue; } r -= I10;
        if (r < I11) { tr_item(F.in[5], 64, 512, 0, 16, 512, (bf16*)(ws + WS_WUT), 0, scr, r, F.lane); continue; } r -= I11;
        if (r < I12) { tr_item(F.in[7], 64, 512, 0, 16, 512, (bf16*)(ws + WS_AUT), 0, scr, r, F.lane); continue; } r -= I12;
        tr_item(F.in[8], 128, 512, 0, 16, 512, (bf16*)(ws + WS_GUT), 0, scr, r, F.lane);
    }
    { const int gt = F.vcu * (NWAVES * 64) + F.tid, NT = F.G * NWAVES * 64;
      bf16* s1 = (bf16*)(ws + WS_SK1); bf16* s2 = (bf16*)(ws + WS_SK2);
      for (int i = gt; i < 128 * 128; i += NT) { s1[i] = f2b(F.in[29][i]); s2[i] = f2b(F.in[30][i]); } }
    for (int m = gw; m < M; m += NGW) rms_row_to_bf16(F.lane, F.in[0] + (size_t)m * D, F.in[1], (bf16*)(ws + WS_H) + (size_t)m * D);
}
constexpr int REC_BYTES = 12800;
__device__ __forceinline__ void rwkv_prep_tile(const Frame& F, int u) {
    const int tid = F.tid, lane = F.lane, h = F.wave, r16 = lane & 15, q4 = lane >> 4;
    const int R0 = 64 * u, t0 = R0 & (T - 1);
    LAS bf16* linb = (LAS bf16*)(F.lds);
    LAS bf16* mats = (LAS bf16*)(F.lds + 16384) + h * 4096;
    LAS float* abl = (LAS float*)(F.lds + 16384 + 65536) + h * 272;
    float* PRW = (float*)(F.ws + WS_PRW);
    const float* BND = (const float*)(F.ws + WS_BND);
    bf16* G = (bf16*)((unsigned char*)F.out + DO_G);
    const float* mu = F.in[3];
    const float mu_r = mu[tid], mu_k = mu[512 + tid], mu_v = mu[1024 + tid], mu_l = (tid < 256) ? mu[1536 + tid] : 0.f;
    const float w0c = F.in[4][tid], a0c = F.in[6][tid], kkc = F.in[9][tid], kac = F.in[10][tid], rkc = F.in[11][tid];
    const float* w_up = F.in[5]; const float* a_up = F.in[7]; const float* g_up = F.in[8];
    float pr = 0.f, pk = 0.f, pv = 0.f, pl = 0.f;
    if (t0 != 0) { const float* b = BND + (size_t)(u - 1) * RWC; pr = b[tid]; pk = b[512 + tid]; pv = b[1024 + tid]; if (tid < 256) pl = b[1536 + tid]; }
    for (int batch = 0; batch < 4; ++batch) {
        const int Rb = R0 + 16 * batch;
        if (DBG_SEL == 30 && batch == 0 && blockIdx.x == 0 && tid == 0) F.MISC[20] = (unsigned)__builtin_amdgcn_s_memrealtime();
        float xr[16], xk[16]; unsigned vtw[8];
        if (tid < 256) { float xl[16];
#pragma unroll
            for (int j = 0; j < 16; ++j) xl[j] = PRW[(size_t)(Rb + j) * RWC + 1536 + tid];
#pragma unroll
            for (int j = 0; j < 16; ++j) { const float n = xl[j]; const float v = n + (pl - n) * mu_l; pl = n; const float f = (tid < 64) ? tanh_fast(v) : ((tid < 128) ? v : sigmf(v)); linb[j * 256 + tid] = f2b(f); } }
        { float xv[16];
#pragma unroll
          for (int j = 0; j < 16; ++j) { const float* p = PRW + (size_t)(Rb + j) * RWC; xr[j] = p[tid]; xk[j] = p[512 + tid]; xv[j] = p[1024 + tid]; }
          VM_WAIT();
#pragma unroll
          for (int j = 0; j < 16; ++j) { float n;
              n = xr[j]; xr[j] = n + (pr - n) * mu_r; pr = n;
              n = xk[j]; xk[j] = n + (pk - n) * mu_k; pk = n;
              n = xv[j]; const unsigned vb = f2bf(n + (pv - n) * mu_v); pv = n;
              if (j & 1) vtw[j >> 1] |= vb << 16; else vtw[j >> 1] = vb; } }
        __syncthreads();
        if ((DBG_SEL == 30 || DBG_SEL == 31) && batch == 0 && blockIdx.x == 0 && tid == 0) F.MISC[20 + (DBG_SEL == 30)] = (unsigned)__builtin_amdgcn_s_memrealtime();
        float accw[16], acca[16], accg[16];
        { const bf16* WUT = (const bf16*)(F.ws + WS_WUT); const bf16* AUT = (const bf16*)(F.ws + WS_AUT); const bf16* GUT = (const bf16*)(F.ws + WS_GUT);
          const f32x4 Z4 = {0.f, 0.f, 0.f, 0.f};
          bf16x8 af[8];
#pragma unroll
          for (int ks = 0; ks < 8; ++ks) af[ks] = as_bf16x8(*(const LAS v4u*)(linb + r16 * 256 + 32 * ks + 8 * q4));
          LAS float* ow = (LAS float*)mats;
#pragma unroll
          for (int nt = 0; nt < 4; ++nt) { const int col = 64 * h + 16 * nt + r16;
              f32x4 cw = Z4, ca = Z4, cg = Z4;
#pragma unroll
              for (int ks = 0; ks < 2; ++ks) { cw = mfma16(af[ks], as_bf16x8(*(const v4u*)(WUT + (size_t)col * 64 + 32 * ks + 8 * q4)), cw); ca = mfma16(af[2 + ks], as_bf16x8(*(const v4u*)(AUT + (size_t)col * 64 + 32 * ks + 8 * q4)), ca); }
#pragma unroll
              for (int ks = 0; ks < 4; ++ks) cg = mfma16(af[4 + ks], as_bf16x8(*(const v4u*)(GUT + (size_t)col * 128 + 32 * ks + 8 * q4)), cg);
#pragma unroll
              for (int r = 0; r < 4; ++r) { const int tok = 4 * q4 + r; ow[tok * 64 + 16 * nt + r16] = cw[r]; ow[1024 + tok * 64 + 16 * nt + r16] = ca[r]; G[(size_t)(Rb + tok) * 512 + col] = f2b(cg[r]); } }
          LDS_WAIT(); asm volatile("" ::: "memory");
#pragma unroll
          for (int j = 0; j < 16; ++j) { accw[j] = ow[j * 64 + lane]; acca[j] = ow[1024 + j * 64 + lane]; }
          LDS_WAIT(); asm volatile("" ::: "memory"); }
        if ((DBG_SEL == 31 || DBG_SEL == 32) && batch == 0 && blockIdx.x == 0 && tid == 0) F.MISC[20 + (DBG_SEL == 31)] = (unsigned)__builtin_amdgcn_s_memrealtime();
        unsigned char* rec = (unsigned char*)(PRW + (size_t)Rb * RWC) + h * REC_BYTES;
#pragma unroll
        for (int j = 0; j < 16; ++j) {
            const float z = -(w0c + accw[j]); const float sp = fmaxf(z, 0.f) + __logf(1.0f + __expf(-fabsf(z)));
            const float e = __expf(-sp - 0.5f); accw[j] = __expf(-e);
            const float a = sigmf(a0c + acca[j]); acca[j] = a;
            const float kkv = xk[j] * kkc; xk[j] = xk[j] * (1.f + (a - 1.f) * kac);
            const float ss = wave_sum(kkv * kkv); accg[j] = kkv * rsqrtf(fmaxf(ss, 1e-24f));
            const float bon = wave_sum(xr[j] * xk[j] * rkc);
            if (lane == 0) *(float*)(rec + 12544 + 4 * j) = bon; __builtin_amdgcn_sched_barrier(0); }
        { float g = 1.f; unsigned bhw[8], khw[8];
          LAS bf16* mp = mats + lane;
#pragma unroll
          for (int j = 0; j < 16; ++j) { const float gp = g; g *= accw[j]; const float ig = __builtin_amdgcn_rcpf(g);
              const unsigned w1 = pg8::cvt_pk_bf16(accg[j] * gp, xr[j] * g), w2 = pg8::cvt_pk_bf16(accg[j] * acca[j] * ig, xk[j] * ig);
              mp[j * 64] = (u16)(w1 & 0xffffu); mp[1024 + j * 64] = (u16)(w1 >> 16); mp[2048 + j * 64] = (u16)(w2 & 0xffffu); mp[3072 + j * 64] = (u16)(w2 >> 16);
              if (j & 1) { bhw[j >> 1] |= w2 << 16; khw[j >> 1] |= w2 & 0xffff0000u; } else { bhw[j >> 1] = w2 & 0xffffu; khw[j >> 1] = w2 >> 16; } }
          *(float*)(rec + 12288 + 4 * lane) = g;
          v4u* bp = (v4u*)(rec + 4096 + lane * 32); bp[0] = (v4u){bhw[0], bhw[1], bhw[2], bhw[3]}; bp[1] = (v4u){bhw[4], bhw[5], bhw[6], bhw[7]};
          v4u* kp = (v4u*)(rec + 6144 + lane * 32); kp[0] = (v4u){khw[0], khw[1], khw[2], khw[3]}; kp[1] = (v4u){khw[4], khw[5], khw[6], khw[7]};
          v4u* vp = (v4u*)(rec + 8192 + lane * 32); vp[0] = (v4u){vtw[0], vtw[1], vtw[2], vtw[3]}; vp[1] = (v4u){vtw[4], vtw[5], vtw[6], vtw[7]}; }
        LDS_WAIT(); asm volatile("" ::: "memory");
#pragma unroll
        for (int i = 0; i < 2; ++i) { const int pi = lane + 64 * i, s = pi >> 3, ks = (pi >> 2) & 1, qq = pi & 3;
#pragma unroll
            for (int mtx = 0; mtx < 2; ++mtx) { const LAS bf16* src = mats + mtx * 1024 + s * 64 + 32 * ks + 4 * qq;
                const u32x2 lo = *(const LAS u32x2*)src, hi = *(const LAS u32x2*)(src + 16);
                *(v4u*)(rec + mtx * 2048 + pi * 16) = (v4u){lo.x, lo.y, hi.x, hi.y}; } }
        LDS_WAIT(); asm volatile("" ::: "memory");
        { f32x4 Ab = {0.f, 0.f, 0.f, 0.f}, Ak = Ab, Mb = Ab, Mk = Ab;
#pragma unroll
          for (int ks = 0; ks < 2; ++ks) { const int off = r16 * 64 + 32 * ks + 8 * q4;
              const bf16x8 aK = as_bf16x8(*(const LAS v4u*)(mats + off)), aR = as_bf16x8(*(const LAS v4u*)(mats + 1024 + off)), bB = as_bf16x8(*(const LAS v4u*)(mats + 2048 + off)), bK = as_bf16x8(*(const LAS v4u*)(mats + 3072 + off));
              Ab = mfma16(aK, bB, Ab); Ak = mfma16(aK, bK, Ak); Mb = mfma16(aR, bB, Mb); Mk = mfma16(aR, bK, Mk); }
          bf16* rAk = (bf16*)(rec + 10240); bf16* rMb = (bf16*)(rec + 11264); bf16* rMk = (bf16*)(rec + 11776);
#pragma unroll
          for (int r = 0; r < 4; ++r) { const int s = 4 * q4 + r, j = r16; const bool lo = j < s, le = j <= s;
              abl[s * 17 + j] = lo ? Ab[r] : 0.f; rAk[s * 16 + j] = f2b(lo ? Ak[r] : 0.f); rMb[s * 16 + j] = f2b(le ? Mb[r] : 0.f); rMk[s * 16 + j] = f2b(le ? Mk[r] : 0.f); } }
        LDS_WAIT(); asm volatile("" ::: "memory");
        { float Tr[16]; bf16* rT = (bf16*)(rec + 10752);
#pragma unroll
          for (int s = 0; s < 16; ++s) { float t = (r16 == s) ? 1.f : 0.f;
#pragma unroll
              for (int j = 0; j < s; ++j) t -= abl[s * 17 + j] * Tr[j];
              Tr[s] = t; if (lane < 16) rT[s * 16 + r16] = f2b(-t); __builtin_amdgcn_sched_barrier(0); } }
        __syncthreads();
        if (DBG_SEL == 32 && batch == 0 && blockIdx.x == 0 && tid == 0) F.MISC[21] = (unsigned)__builtin_amdgcn_s_memrealtime();
    }
}
__device__ __forceinline__ void nsa_prep_tile(const Frame& F, int u) {
    const int lane = F.lane, w = F.wave;
    const int R0 = 64 * u, t0 = R0 & (T - 1), b = R0 / T;
    bf16* PNSA = (bf16*)((unsigned char*)F.out + DO_PNSA);
    const float qg = F.in[14][lane] * (0.125f * LOG2E);
    const float kg = (w < 2) ? F.in[16][lane] : F.in[17][lane];
    const int kcol = ((w < 2) ? 768 : 1024) + (w & 1) * 64 + lane;
#pragma unroll 1
    for (int tg = 0; tg < 4; ++tg) { float qv[16], kv[16];
#pragma unroll
        for (int i = 0; i < 16; ++i) { const bf16* p = PNSA + (size_t)(R0 + 16 * tg + i) * 1280; qv[i] = bf2f(p[w * 64 + lane]); kv[i] = (w < 4) ? bf2f(p[kcol]) : 0.f; }
#pragma unroll
        for (int i = 0; i < 16; ++i) { bf16* p = PNSA + (size_t)(R0 + 16 * tg + i) * 1280;
            const float ss = wave_sum(qv[i] * qv[i]) * (1.f / 64.f);
            p[w * 64 + lane] = f2b(qv[i] * rsqrtf(ss + NORM_EPS) * qg);
            if (w < 4) { const float ks = wave_sum(kv[i] * kv[i]) * (1.f / 64.f); p[kcol] = f2b(kv[i] * rsqrtf(ks + NORM_EPS) * kg); } } }
    if (w >= 4) {
        const int g = w & 1; const int scol = ((w < 6) ? 896 : 1152) + g * 64;
        bf16* VT = (bf16*)(F.ws + ((w < 6) ? WS_VST : WS_VWT)) + (size_t)((b * 2 + g) * 64) * T + (size_t)((t0 + lane) >> 5) * 2048 + ((t0 + lane) & 31);
        const v4u* src = (const v4u*)(PNSA + (size_t)(R0 + lane) * 1280 + scol);
        v4u v[8];
#pragma unroll
        for (int i = 0; i < 8; ++i) v[i] = src[i];
#pragma unroll
        for (int i = 0; i < 8; ++i) {
            VT[(8 * i + 0) * 32] = (u16)(v[i].x & 0xffffu); VT[(8 * i + 1) * 32] = (u16)(v[i].x >> 16);
            VT[(8 * i + 2) * 32] = (u16)(v[i].y & 0xffffu); VT[(8 * i + 3) * 32] = (u16)(v[i].y >> 16);
            VT[(8 * i + 4) * 32] = (u16)(v[i].z & 0xffffu); VT[(8 * i + 5) * 32] = (u16)(v[i].z >> 16);
            VT[(8 * i + 6) * 32] = (u16)(v[i].w & 0xffffu); VT[(8 * i + 7) * 32] = (u16)(v[i].w >> 16); }
    }
}
__device__ __forceinline__ float gelu_tanh(float x) { const float t = 0.7978845608028654f * (x + 0.044715f * x * x * x); return 0.5f * x * (1.f + tanh_fast(t)); }
__device__ __forceinline__ void compress_unit(const Frame& F, int u) {
    const int lane = F.lane, w = F.wave, r16 = lane & 15, q4 = lane >> 4;
    const int kvsel = u >> 7, b = (u >> 5) & 3, g = (u >> 4) & 1, ntile = u & 15;
    const bf16* X = (const bf16*)((unsigned char*)F.out + DO_PNSA) + (size_t)(b * T) * 1280 + (kvsel ? 640 : 512) + g * 64;
    const float* pos = kvsel ? F.in[19] : F.in[18];
    const bf16* W1t = (const bf16*)(F.ws + (kvsel ? WS_CW1V : WS_CW1K));
    const bf16* W2t = (const bf16*)(F.ws + (kvsel ? WS_CW2V : WS_CW2K));
    LAS bf16* hid = (LAS bf16*)(F.lds);
    LAS float* outb = (LAS float*)(F.lds + 16 * 528);
    int n = 16 * ntile + r16; if (n > 254) n = 254;
    f32x4 acc[2] = {{0.f, 0.f, 0.f, 0.f}, {0.f, 0.f, 0.f, 0.f}};
#pragma unroll 4
    for (int s = 0; s < 64; ++s) { const int lp = s >> 1, d0 = (s & 1) * 32 + 8 * q4;
        const v4u xa = *(const v4u*)(X + (size_t)(16 * n + lp) * 1280 + d0);
        const f32x4 p0 = *(const f32x4*)(pos + lp * 64 + d0), p1 = *(const f32x4*)(pos + lp * 64 + d0 + 4);
        v4u af; af.x = pk2(bflo(xa.x) + p0[0], bfhi(xa.x) + p0[1]); af.y = pk2(bflo(xa.y) + p0[2], bfhi(xa.y) + p0[3]);
        af.z = pk2(bflo(xa.z) + p1[0], bfhi(xa.z) + p1[1]); af.w = pk2(bflo(xa.w) + p1[2], bfhi(xa.w) + p1[3]);
#pragma unroll
        for (int nt = 0; nt < 2; ++nt) { const v4u bfg = *(const v4u*)(W1t + (size_t)(32 * w + 16 * nt + r16) * 2048 + 32 * s + 8 * q4);
            acc[nt] = mfma16(as_bf16x8(af), as_bf16x8(bfg), acc[nt]); } }
#pragma unroll
    for (int nt = 0; nt < 2; ++nt)
#pragma unroll
        for (int r = 0; r < 4; ++r) hid[(4 * q4 + r) * 264 + 32 * w + 16 * nt + r16] = f2b(gelu_tanh(acc[nt][r]));
    __syncthreads();
    if (w < 4) { f32x4 a2 = {0.f, 0.f, 0.f, 0.f};
#pragma unroll
        for (int s = 0; s < 8; ++s) { const v4u af = *(const LAS v4u*)(hid + r16 * 264 + 32 * s + 8 * q4);
            const v4u bfg = *(const v4u*)(W2t + (size_t)(16 * w + r16) * 256 + 32 * s + 8 * q4);
            a2 = mfma16(as_bf16x8(af), as_bf16x8(bfg), a2); }
#pragma unroll
        for (int r = 0; r < 4; ++r) outb[(4 * q4 + r) * 64 + 16 * w + r16] = a2[r]; }
    __syncthreads();
#pragma unroll
    for (int rr = 0; rr < 2; ++rr) { const int row = 2 * w + rr; const int nn = 16 * ntile + row; float val = outb[row * 64 + lane];
        if (kvsel == 0) { const float ss = wave_sum(val * val) * (1.f / 64.f); val = val * rsqrtf(ss + NORM_EPS) * F.in[15][lane];
            ((bf16*)(F.ws + WS_KC))[(size_t)((b * 2 + g) * 256 + nn) * 64 + lane] = (nn < 255) ? f2b(val) : (u16)0; }
        else ((bf16*)(F.ws + WS_VCT))[(size_t)((b * 2 + g) * 64 + lane) * 256 + nn] = (nn < 255) ? f2b(val) : (u16)0; }
    __syncthreads();
}
__device__ __forceinline__ bf16x8 pack_p(const f32x4 a, const f32x4 b) {
    v4u w; w.x = pg8::cvt_pk_bf16(a[0], a[1]); w.y = pg8::cvt_pk_bf16(a[2], a[3]); w.z = pg8::cvt_pk_bf16(b[0], b[1]); w.w = pg8::cvt_pk_bf16(b[2], b[3]); return as_bf16x8(w);
}
#define NSA_FENCE() asm volatile("s_waitcnt lgkmcnt(0)" ::: "memory")
struct KFr { bf16x8 a0, a1, b0, b1; };
struct VFr { bf16x8 v[4]; };
__device__ __forceinline__ KFr lds_k(const LAS unsigned char* ks, int r16, int q4) {
    const int rA = 8 * (r16 >> 2) + (r16 & 3), rB = rA + 4; const int xA = (rA >> 1) & 7, xB = (rB >> 1) & 7;
    KFr f; f.a0 = as_bf16x8(*(const LAS v4u*)(ks + rA * 128 + ((q4 ^ xA) << 4))); f.a1 = as_bf16x8(*(const LAS v4u*)(ks + rA * 128 + (((4 + q4) ^ xA) << 4)));
    f.b0 = as_bf16x8(*(const LAS v4u*)(ks + rB * 128 + ((q4 ^ xB) << 4))); f.b1 = as_bf16x8(*(const LAS v4u*)(ks + rB * 128 + (((4 + q4) ^ xB) << 4))); return f;
}
__device__ __forceinline__ VFr lds_v(const LAS unsigned char* vs, int r16, int q4) {
    VFr f;
#pragma unroll
    for (int dt = 0; dt < 4; ++dt) { const int d = 16 * dt + r16; f.v[dt] = as_bf16x8(*(const LAS v4u*)(vs + d * 64 + ((q4 ^ ((d >> 2) & 3)) << 4))); }
    return f;
}
struct NsaSrc { const bf16* kb; int krs; const bf16* vb; int vrs; int vtiled; };
__device__ __forceinline__ v4u nsa_stage_load(const NsaSrc& S, int k0, int tid) {
    if (tid < 256) return *(const v4u*)(S.kb + (size_t)(k0 + (tid >> 3)) * S.krs + 8 * (tid & 7));
    const int i = tid - 256, d = i >> 2, c = i & 3;
    return S.vtiled ? *(const v4u*)(S.vb + (size_t)(k0 >> 5) * 2048 + d * 32 + 8 * c) : *(const v4u*)(S.vb + (size_t)d * S.vrs + k0 + 8 * c);
}
__device__ __forceinline__ void nsa_stage_write(LAS unsigned char* lds, int slot, int tid, const v4u v) {
    if (tid < 256) { const int r = tid >> 3, c = tid & 7; *(LAS v4u*)(lds + slot * 4096 + r * 128 + ((c ^ ((r >> 1) & 7)) << 4)) = v; }
    else { const int i = tid - 256, d = i >> 2, c = i & 3; *(LAS v4u*)(lds + 8192 + slot * 4096 + d * 64 + ((c ^ ((d >> 2) & 3)) << 4)) = v; }
}
__device__ __forceinline__ void nsa_block_unit(const Frame& F, int b, int g, int T0, int skip) {
    const int lane = F.lane, tid = F.tid, w = F.wave, r16 = lane & 15, q4 = lane >> 4;
    const int t0 = T0 + 8 * w;
    const f32x4 Z4 = {0.f, 0.f, 0.f, 0.f};
    LAS unsigned char* lds = F.lds;
    LAS float* wl = (LAS float*)(lds + 16384 + w * 5120);
    LAS float* impT = wl; LAS float* imp2T = wl + 8 * 65; LAS unsigned* selT = (LAS unsigned*)(wl + 16 * 65);
    LAS unsigned* bw = (LAS unsigned*)(lds + 57344); LAS int* stl = (LAS int*)(lds + 57344 + 128);
    const bf16* PN = (const bf16*)((unsigned char*)F.out + DO_PNSA) + (size_t)(b * T) * 1280;
    const float* GL = (const float*)((unsigned char*)F.out + DO_GLOG) + (size_t)(b * T) * 32;
    bf16x8 qf[2][2]; int tq[2];
#pragma unroll
    for (int mt = 0; mt < 2; ++mt) { tq[mt] = t0 + 4 * mt + (r16 >> 2);
#pragma unroll
        for (int dh = 0; dh < 2; ++dh) qf[mt][dh] = as_bf16x8(*(const v4u*)(PN + (size_t)tq[mt] * 1280 + (g * 4 + (r16 & 3)) * 64 + 32 * dh + 8 * q4)); }
    f32x4 Oc[2][4];
#pragma unroll
    for (int mt = 0; mt < 2; ++mt)
#pragma unroll
        for (int dt = 0; dt < 4; ++dt) Oc[mt][dt] = Z4;
#define NSA_GATE(mt_, r_, br_) sigmf(GL[(size_t)(t0 + 4 * (mt_) + q4) * 32 + g * 12 + (r_) * 3 + (br_)])
#define NSA_PIPE_BEGIN(S_, n_, K0_OF) { v4u st = nsa_stage_load(S_, K0_OF(0), tid); nsa_stage_write(lds, 0, tid, st); if ((n_) > 1) st = nsa_stage_load(S_, K0_OF(1), tid); __syncthreads(); \
        for (int i = 0; i < (n_); ++i) { const int k0 = K0_OF(i); const LAS unsigned char* ks = lds + (i & 1) * 4096; const LAS unsigned char* vs = lds + 8192 + (i & 1) * 4096;
#define NSA_PIPE_END(S_, n_, K0_OF) if (i + 1 < (n_)) nsa_stage_write(lds, (i + 1) & 1, tid, st); if (i + 2 < (n_)) st = nsa_stage_load(S_, K0_OF(i + 2), tid); __syncthreads(); } }

    for (int i = lane; i < 16 * 65; i += 64) wl[i] = 0.f;
    const NsaSrc SC{(const bf16*)(F.ws + WS_KC) + (size_t)((b * 2 + g) * 256) * 64, 64, (const bf16*)(F.ws + WS_VCT) + (size_t)((b * 2 + g) * 64) * 256, 256, 0};
    const int ncb = (T0 + 63 >= 31) ? ((T0 + 63 - 31) >> 4) + 1 : 0; const int nstB = (skip & 1) ? 0 : ((ncb + 31) >> 5);
    const int ncw = (t0 + 7 >= 31) ? ((t0 + 7 - 31) >> 4) + 1 : 0; const int nstW = (skip & 1) ? 0 : ((ncw + 31) >> 5);
    float inv[2] = {0.f, 0.f};
#define K0_LIN(i_) (32 * (i_))
    if (nstB > 0) { float ls[2] = {0.f, 0.f};
        NSA_PIPE_BEGIN(SC, nstB, K0_LIN)
            if (i < nstW) { const KFr kf = lds_k(ks, r16, q4); const bool cslow = 16 * (k0 + 31) + 31 > t0;
#pragma unroll
                for (int mt = 0; mt < 2; ++mt) { f32x4 sA = mfma16(kf.a0, qf[mt][0], Z4); sA = mfma16(kf.a1, qf[mt][1], sA); f32x4 sB = mfma16(kf.b0, qf[mt][0], Z4); sB = mfma16(kf.b1, qf[mt][1], sB);
#pragma unroll
                    for (int r = 0; r < 4; ++r) { const int nA = k0 + 8 * q4 + r, nB = nA + 4;
                        if (cslow) { ls[mt] += (16 * nA + 31 <= tq[mt]) ? __builtin_amdgcn_exp2f(sA[r]) : 0.f; ls[mt] += (16 * nB + 31 <= tq[mt]) ? __builtin_amdgcn_exp2f(sB[r]) : 0.f; }
                        else { ls[mt] += __builtin_amdgcn_exp2f(sA[r]); ls[mt] += __builtin_amdgcn_exp2f(sB[r]); } } } }
        NSA_PIPE_END(SC, nstB, K0_LIN)
#pragma unroll
        for (int mt = 0; mt < 2; ++mt) { float l = ls[mt]; l += __shfl_xor(l, 16); l += __shfl_xor(l, 32); inv[mt] = 1.0f / fmaxf(l, 1e-30f); }
    }
    if (nstB > 0) { f32x4 O[2][4];
#pragma unroll
        for (int mt = 0; mt < 2; ++mt)
#pragma unroll
            for (int dt = 0; dt < 4; ++dt) O[mt][dt] = Z4;
        NSA_PIPE_BEGIN(SC, nstB, K0_LIN)
            if (i < nstW) { const KFr kf = lds_k(ks, r16, q4); const VFr vf = lds_v(vs, r16, q4); const bool cslow = 16 * (k0 + 31) + 31 > t0;
#pragma unroll
                for (int mt = 0; mt < 2; ++mt) { f32x4 sA = mfma16(kf.a0, qf[mt][0], Z4); sA = mfma16(kf.a1, qf[mt][1], sA); f32x4 sB = mfma16(kf.b0, qf[mt][0], Z4); sB = mfma16(kf.b1, qf[mt][1], sB);
                    f32x4 pA, pB;
#pragma unroll
                    for (int r = 0; r < 4; ++r) { const int nA = k0 + 8 * q4 + r, nB = nA + 4;
                        if (cslow) { pA[r] = (16 * nA + 31 <= tq[mt]) ? __builtin_amdgcn_exp2f(sA[r]) * inv[mt] : 0.f; pB[r] = (16 * nB + 31 <= tq[mt]) ? __builtin_amdgcn_exp2f(sB[r]) * inv[mt] : 0.f; }
                        else { pA[r] = __builtin_amdgcn_exp2f(sA[r]) * inv[mt]; pB[r] = __builtin_amdgcn_exp2f(sB[r]) * inv[mt]; } }
                    float vA = pA[0] + pA[1] + pA[2] + 0.5f * pA[3], cA = 0.5f * pA[3], vB = pB[0] + pB[1] + pB[2] + 0.5f * pB[3], cB = 0.5f * pB[3];
                    vA += __shfl_xor(vA, 1); vA += __shfl_xor(vA, 2); cA += __shfl_xor(cA, 1); cA += __shfl_xor(cA, 2);
                    vB += __shfl_xor(vB, 1); vB += __shfl_xor(vB, 2); cB += __shfl_xor(cB, 1); cB += __shfl_xor(cB, 2);
                    if ((lane & 3) == 0) { const int tl = 4 * mt + (r16 >> 2), j = (k0 >> 2) + 2 * q4;
                        impT[tl * 65 + j] = vA; imp2T[tl * 65 + j + 1] = cA; impT[tl * 65 + j + 1] = vB; imp2T[tl * 65 + j + 2] = cB; }
                    const bf16x8 pf = pack_p(pA, pB);
#pragma unroll
                    for (int dt = 0; dt < 4; ++dt) O[mt][dt] = mfma16(pf, vf.v[dt], O[mt][dt]); } }
        NSA_PIPE_END(SC, nstB, K0_LIN)
#pragma unroll
        for (int mt = 0; mt < 2; ++mt)
#pragma unroll
            for (int r = 0; r < 4; ++r) { const float gt = NSA_GATE(mt, r, 0);
#pragma unroll
                for (int dt = 0; dt < 4; ++dt) Oc[mt][dt][r] += gt * O[mt][dt][r]; }
    }
    NSA_FENCE();
    const int cur = T0 >> 6;
    unsigned long long uni = 0ull;
    for (int tl = 0; tl < 8; ++tl) {
        unsigned long long mask;
        if (cur < 16 || (skip & 2)) mask = (cur < 16) ? ((2ull << cur) - 1ull) : (0xFFFFull | (1ull << cur) | (1ull << (cur - 1)));
        else {
            const float sc = impT[tl * 65 + lane] + imp2T[tl * 65 + lane];
            const unsigned key = __float_as_uint(fmaxf(sc, 0.f));
            const bool elig = (lane <= cur) && (lane != 0) && (lane != cur) && (lane != cur - 1);
            unsigned prefix = 0u;
            for (int bit = 30; bit >= 0; --bit) { const unsigned cand = prefix | (1u << bit);
                const int cnt = __popcll(__ballot(elig && key >= cand)); if (cnt >= 13) prefix = cand; }
            const unsigned long long gt = __ballot(elig && key > prefix); unsigned long long ties = __ballot(elig && key == prefix);
            int need = 13 - __popcll(gt); unsigned long long keep = 0ull;
            while (need > 0 && ties) { const unsigned long long low = ties & (0ull - ties); keep |= low; ties ^= low; --need; }
            mask = gt | keep | 1ull | (1ull << cur) | (1ull << (cur - 1));
        }
        uni |= mask;
        if (lane == 0) { selT[2 * tl] = (unsigned)mask; selT[2 * tl + 1] = (unsigned)(mask >> 32); }
    }
    if (lane == 0) { bw[2 + 2 * w] = (unsigned)uni; bw[3 + 2 * w] = (unsigned)(uni >> 32); }
    NSA_FENCE();
    unsigned long long mk[2];
#pragma unroll
    for (int mt = 0; mt < 2; ++mt) { const int tl = 4 * mt + (r16 >> 2); mk[mt] = (unsigned long long)selT[2 * tl] | ((unsigned long long)selT[2 * tl + 1] << 32); }
    __syncthreads();
    unsigned long long buni = 0ull;
#pragma unroll
    for (int ww = 0; ww < 8; ++ww) buni |= (unsigned long long)bw[2 + 2 * ww] | ((unsigned long long)bw[3 + 2 * ww] << 32);

#define K0_LIST(i_) (__builtin_amdgcn_readfirstlane(stl[(i_)]))
#pragma unroll 1
    for (int br = 1; br < 3; ++br) { if ((skip >> (br + 1)) & 1) continue;
        const NsaSrc SB{PN + (br == 1 ? 768 : 1024) + g * 64, 1280, (const bf16*)(F.ws + (br == 1 ? WS_VST : WS_VWT)) + (size_t)((b * 2 + g) * 64) * T, 0, 1};
        f32x4 O[2][4]; float ls[2] = {0.f, 0.f};
#pragma unroll
        for (int mt = 0; mt < 2; ++mt)
#pragma unroll
            for (int dt = 0; dt < 4; ++dt) O[mt][dt] = Z4;
        int nsteps;
        if (br == 1) { nsteps = 2 * __popcll(buni);
            if (w == 0 && ((buni >> lane) & 1ull)) { const int rk = __popcll(buni & ((1ull << lane) - 1ull)); stl[2 * rk] = 64 * lane; stl[2 * rk + 1] = 64 * lane + 32; } }
        else { const int lo = T0 - 511; const int klo = (lo > 0 ? lo : 0) & ~31; nsteps = ((T0 + 64 - klo) + 31) >> 5; if (w == 0 && lane < nsteps) stl[lane] = klo + 32 * lane; }
        __syncthreads();
        NSA_PIPE_BEGIN(SB, nsteps, K0_LIST)
            const int j = k0 >> 6;
            const bool mine = (br == 1) ? (((uni >> j) & 1ull) != 0ull) : (k0 + 31 >= t0 - 511 && k0 <= t0 + 7);
            if (mine) { const KFr kf = lds_k(ks, r16, q4); const VFr vf = lds_v(vs, r16, q4);
                const bool slow = (br == 1) ? (j == cur) : (k0 < t0 - 504 || k0 + 31 > t0);
#pragma unroll
                for (int mt = 0; mt < 2; ++mt) { f32x4 ci = Z4;
                    if (br == 1) { const float bias = (((mk[mt] >> j) & 1ull) != 0ull) ? 0.f : -1e30f; ci = (f32x4){bias, bias, bias, bias}; }
                    f32x4 sA = mfma16(kf.a0, qf[mt][0], ci); sA = mfma16(kf.a1, qf[mt][1], sA); f32x4 sB = mfma16(kf.b0, qf[mt][0], ci); sB = mfma16(kf.b1, qf[mt][1], sB);
                    f32x4 pA, pB;
                    if (slow) {
#pragma unroll
                        for (int r = 0; r < 4; ++r) { const int kA = k0 + 8 * q4 + r, kB = kA + 4;
                            const bool mA = (kA <= tq[mt]) && (br == 1 || kA + 512 > tq[mt]), mB = (kB <= tq[mt]) && (br == 1 || kB + 512 > tq[mt]);
                            pA[r] = mA ? __builtin_amdgcn_exp2f(sA[r]) : 0.f; pB[r] = mB ? __builtin_amdgcn_exp2f(sB[r]) : 0.f; }
                    } else {
#pragma unroll
                        for (int r = 0; r < 4; ++r) { pA[r] = __builtin_amdgcn_exp2f(sA[r]); pB[r] = __builtin_amdgcn_exp2f(sB[r]); }
                    }
                    ls[mt] += (pA[0] + pA[1]) + (pA[2] + pA[3]) + (pB[0] + pB[1]) + (pB[2] + pB[3]);
                    const bf16x8 pf = pack_p(pA, pB);
#pragma unroll
                    for (int dt = 0; dt < 4; ++dt) O[mt][dt] = mfma16(pf, vf.v[dt], O[mt][dt]); } }
        NSA_PIPE_END(SB, nsteps, K0_LIST)
#pragma unroll
        for (int mt = 0; mt < 2; ++mt) { float l = ls[mt]; l += __shfl_xor(l, 16); l += __shfl_xor(l, 32); const float il = 1.0f / fmaxf(l, 1e-30f);
#pragma unroll
            for (int r = 0; r < 4; ++r) { const float ilr = __shfl(il, 4 * q4 + r) * NSA_GATE(mt, r, br);
#pragma unroll
                for (int dt = 0; dt < 4; ++dt) Oc[mt][dt][r] += ilr * O[mt][dt][r]; } }
    }
    if (!skip) { bf16* YB = (bf16*)(F.ws + WS_H + 16 * MiB) + (size_t)(b * T) * 512;
#pragma unroll
        for (int mt = 0; mt < 2; ++mt)
#pragma unroll
            for (int r = 0; r < 4; ++r)
#pragma unroll
                for (int dt = 0; dt < 4; ++dt) YB[(size_t)(t0 + 4 * mt + q4) * 512 + (g * 4 + r) * 64 + 16 * dt + r16] = f2b(Oc[mt][dt][r]); }
    __syncthreads();
}
__device__ __forceinline__ void nsa_phase(const Frame& F, int rep) {
    LAS unsigned* bw = (LAS unsigned*)(F.lds + 57344);
    const int q0 = (int)(xb_xcc_id() & 7u);
    for (int qi = 0; qi < 8; ++qi) { const int q = (q0 + qi) & 7;
        for (;;) {
            if (F.tid == 0) bw[0] = __hip_atomic_fetch_add(F.ctl + CW_NSAQ + 64 * (8 * rep + q), 1u, RLX_AGENT);
            __syncthreads();
            const unsigned c = bw[0];
            __syncthreads();
            if (c >= 64u) break;
            nsa_block_unit(F, q >> 1, q & 1, 64 * (63 - (int)c), rep ? NSA_SKIP : 0);
        }
    }
}
typedef short bf16x4 __attribute__((ext_vector_type(4)));
__device__ __forceinline__ f32x4 mfma16k16(const bf16x4 a, const bf16x4 b, const f32x4 c) { const bf16x8 a8 = {a[0], a[1], a[2], a[3], 0, 0, 0, 0}, b8 = {b[0], b[1], b[2], b[3], 0, 0, 0, 0}; return __builtin_amdgcn_mfma_f32_16x16x32_bf16(a8, b8, c, 0, 0, 0); }
__device__ __forceinline__ bf16x4 as_bf16x4(const u32x2 v) { return __builtin_bit_cast(bf16x4, v); }
__device__ __forceinline__ bf16x4 pack4(const f32x4 a) { u32x2 w; w.x = pg8::cvt_pk_bf16(a[0], a[1]); w.y = pg8::cvt_pk_bf16(a[2], a[3]); return as_bf16x4(w); }
__device__ __forceinline__ f32x4 unpk4(const u32x2 w) { f32x4 r; r[0] = bflo(w.x); r[1] = bfhi(w.x); r[2] = bflo(w.y); r[3] = bfhi(w.y); return r; }
struct ChunkIn { v4u kt0, kt1, rt0, rt1; u32x2 ak, nt, mb, mk, vt, bh[4], kh[4]; f32x4 gam[4]; };
__device__ __forceinline__ void scan_load(ChunkIn& c, const unsigned char* rec, int vq, int r16, int q4) {
    c.kt0 = *(const v4u*)(rec + (r16 * 64 + q4 * 8) * 2); c.kt1 = *(const v4u*)(rec + (r16 * 64 + 32 + q4 * 8) * 2);
    c.rt0 = *(const v4u*)(rec + 2048 + (r16 * 64 + q4 * 8) * 2); c.rt1 = *(const v4u*)(rec + 2048 + (r16 * 64 + 32 + q4 * 8) * 2);
#pragma unroll
    for (int mt = 0; mt < 4; ++mt) { c.bh[mt] = *(const u32x2*)(rec + 4096 + ((16 * mt + r16) * 16 + 4 * q4) * 2); c.kh[mt] = *(const u32x2*)(rec + 6144 + ((16 * mt + r16) * 16 + 4 * q4) * 2);
        c.gam[mt] = *(const f32x4*)(rec + 12288 + (16 * mt + 4 * q4) * 4); }
    c.vt = *(const u32x2*)(rec + 8192 + ((16 * vq + r16) * 16 + 4 * q4) * 2);
    c.ak = *(const u32x2*)(rec + 10240 + (r16 * 16 + 4 * q4) * 2); c.nt = *(const u32x2*)(rec + 10752 + (r16 * 16 + 4 * q4) * 2);
    c.mb = *(const u32x2*)(rec + 11264 + (r16 * 16 + 4 * q4) * 2); c.mk = *(const u32x2*)(rec + 11776 + (r16 * 16 + 4 * q4) * 2);
}
__device__ __forceinline__ void scan_chunk(const ChunkIn& cur, f32x4 (&Zt)[4], bf16* Y, int ch, int q4) {
    const f32x4 Z4 = {0.f, 0.f, 0.f, 0.f};
    const bf16x8 zb0 = pack_p(Zt[0], Zt[1]), zb1 = pack_p(Zt[2], Zt[3]);
    f32x4 X = mfma16(as_bf16x8(cur.kt0), zb0, Z4); X = mfma16(as_bf16x8(cur.kt1), zb1, X);
    f32x4 Yc = mfma16(as_bf16x8(cur.rt0), zb0, Z4); Yc = mfma16(as_bf16x8(cur.rt1), zb1, Yc);
    const bf16x4 vt = as_bf16x4(cur.vt);
    const f32x4 W = mfma16k16(as_bf16x4(cur.ak), vt, X);
    const f32x4 U = mfma16k16(as_bf16x4(cur.nt), pack4(W), Z4);
    const bf16x4 ub = pack4(U);
    Yc = mfma16k16(as_bf16x4(cur.mk), vt, Yc); Yc = mfma16k16(as_bf16x4(cur.mb), ub, Yc);
#pragma unroll
    for (int mt = 0; mt < 4; ++mt) { f32x4 acc = mfma16k16(as_bf16x4(cur.kh[mt]), vt, Zt[mt]); acc = mfma16k16(as_bf16x4(cur.bh[mt]), ub, acc); Zt[mt] = acc * cur.gam[mt]; }
#pragma unroll
    for (int r = 0; r < 4; ++r) Y[(size_t)(16 * ch + 4 * q4 + r) * 512] = f2b(Yc[r]);
}
__device__ __forceinline__ void rwkv_scan_wave(const Frame& F, int bh, int vq) {
    const int lane = F.lane, r16 = lane & 15, q4 = lane >> 4, b = bh >> 3, h = bh & 7;
    const f32x4 Z4 = {0.f, 0.f, 0.f, 0.f};
    const unsigned char* recb = F.ws + WS_PRW + (size_t)(b * T) * 7168 + h * REC_BYTES;
    bf16* Y = (bf16*)(F.ws + WS_H) + (size_t)(b * T) * 512 + h * 64 + 16 * vq + r16;
    f32x4 Zt[4] = {Z4, Z4, Z4, Z4};
    ChunkIn A, B;
    constexpr size_t CS = 16 * 7168;
    scan_load(A, recb, vq, r16, q4);
    for (int ch = 0; ch < T / 16; ch += 2) {
        if (vq == 0 && lane == 0) __hip_atomic_store(F.ctl + CW_SCANP + 64 * bh, (unsigned)ch, RLX_AGENT);
        scan_load(B, recb + (size_t)(ch + 1) * CS, vq, r16, q4);
        scan_chunk(A, Zt, Y, ch, q4);
        scan_load(A, recb + (size_t)((ch + 2 < T / 16) ? ch + 2 : ch) * CS, vq, r16, q4);
        scan_chunk(B, Zt, Y, ch + 1, q4);
    }
}
__device__ __forceinline__ void rwkv_scan_prefetch(const Frame& F, int bh) {
    const int lane = F.lane, b = bh >> 3, h = bh & 7;
    const unsigned char* recb = F.ws + WS_PRW + (size_t)(b * T) * 7168 + h * REC_BYTES;
    const int o0 = 128 * lane, o1 = 128 * (lane < 35 ? 64 + lane : 98);
    unsigned dmy = 0u, pa[4] = {0u, 0u, 0u, 0u}, pb[4] = {0u, 0u, 0u, 0u};
    for (int c4 = 0; c4 < T / 16; c4 += 4) {
#pragma unroll
        for (int k = 0; k < 4; ++k) { const int ch = c4 + k;
            for (int spin = 0; spin < (1 << 16); ++spin) { const int prog = (int)__hip_atomic_load(F.ctl + CW_SCANP + 64 * bh, RLX_AGENT); if (ch <= prog + 8) break; __builtin_amdgcn_s_sleep(8); }
            const unsigned char* rec = recb + (size_t)ch * (16 * 7168);
            dmy ^= pa[k] ^ pb[k];
            pa[k] = *(const volatile unsigned*)(rec + o0); pb[k] = *(const volatile unsigned*)(rec + o1); }
    }
    dmy ^= pa[0] ^ pb[0] ^ pa[1] ^ pb[1] ^ pa[2] ^ pb[2] ^ pa[3] ^ pb[3];
    if (lane == 0) F.MISC[17] = dmy;
}
__device__ __forceinline__ void rwkv_epilogue(const Frame& F) {
    const int lane = F.lane; const int gw = F.vcu * NWAVES + F.wave, NGW = F.G * NWAVES;
    const unsigned char* prw = F.ws + WS_PRW; const bf16* G = (const bf16*)((unsigned char*)F.out + DO_G); bf16* YA = (bf16*)(F.ws + WS_H);
    for (int idx = gw; idx < (M / 16) * 8; idx += NGW) { const int bt = idx >> 3, h = idx & 7, c = h * 64 + lane;
        const unsigned char* rec = prw + (size_t)(16 * bt) * 7168 + h * REC_BYTES;
        const v4u* vp = (const v4u*)(rec + 8192 + lane * 32); const v4u v0 = vp[0], v1 = vp[1];
        const float lw = F.in[12][c], lb = F.in[13][c];
        float yv[16], gv[16], bo[16];
#pragma unroll
        for (int s = 0; s < 16; ++s) { const size_t o = (size_t)(16 * bt + s) * 512 + c; yv[s] = bf2f(YA[o]); gv[s] = bf2f(G[o]); bo[s] = *(const float*)(rec + 12544 + 4 * s); }
#pragma unroll
        for (int s = 0; s < 16; ++s) { const unsigned vw = (s < 8) ? v0[s >> 1] : v1[(s - 8) >> 1]; const float vv = (s & 1) ? bfhi(vw) : bflo(vw);
            const float y = yv[s]; const float mean = wave_sum(y) * (1.f / 64.f); const float d = y - mean; const float var = wave_sum(d * d) * (1.f / 64.f);
            const float yn = d * rsqrtf(var + GN_EPS) * lw + lb;
            YA[(size_t)(16 * bt + s) * 512 + c] = f2b((yn + bo[s] * vv) * gv[s]); }
    }
}
__device__ __forceinline__ unsigned sortable(float x) { const unsigned u = __float_as_uint(x); return (u & 0x80000000u) ? ~u : (u | 0x80000000u); }
__device__ __forceinline__ float unsortable(unsigned k) { const unsigned u = (k & 0x80000000u) ? (k & 0x7fffffffu) : ~k; return __uint_as_float(u); }
#define TK_INSERT(L, key_) do { unsigned k_ = (key_); _Pragma("unroll") for (int s_ = 0; s_ < 16; ++s_) { const unsigned hi_ = L[s_] > k_ ? L[s_] : k_; k_ = L[s_] > k_ ? k_ : L[s_]; L[s_] = hi_; } } while (0)
__device__ __forceinline__ void peer_topk_pass(const Frame& F, int wp, LAS float* sc) {
    const int lane = F.lane, r16 = lane & 15, q4 = lane >> 4;
    const bf16* QRY = (const bf16*)(F.ws + WS_PRW);
    int* EID = (int*)(F.ws + WS_PRW + 64 * MiB); float* EG = (float*)(F.ws + WS_PRW + 72 * MiB);
    const int row = lane & 31, part = lane >> 5;
    unsigned L1[16], L2[16];
#pragma unroll
    for (int half = 0; half < 2; ++half) {
        const bf16* SK = (const bf16*)(F.ws + (half ? WS_SK2 : WS_SK1));
        bf16x8 af[2][4];
#pragma unroll
        for (int mt = 0; mt < 2; ++mt) { const int rho = 32 * wp + 16 * mt + r16; const bf16* qp = QRY + (size_t)(rho >> 3) * 2048 + (rho & 7) * 256 + half * 128 + 8 * q4;
#pragma unroll
            for (int s = 0; s < 4; ++s) af[mt][s] = as_bf16x8(*(const v4u*)(qp + 32 * s)); }
#pragma unroll
        for (int kg = 0; kg < 2; ++kg) { bf16x8 kb[4][4];
#pragma unroll
            for (int k4 = 0; k4 < 4; ++k4)
#pragma unroll
                for (int s = 0; s < 4; ++s) kb[k4][s] = as_bf16x8(*(const v4u*)(SK + (size_t)(16 * (4 * kg + k4) + r16) * 128 + 32 * s + 8 * q4));
#pragma unroll
          for (int mt = 0; mt < 2; ++mt) {
#pragma unroll
            for (int k4 = 0; k4 < 4; ++k4) { const int kt = 4 * kg + k4; f32x4 acc = {0.f, 0.f, 0.f, 0.f};
#pragma unroll
                for (int s = 0; s < 4; ++s) acc = mfma16(af[mt][s], kb[k4][s], acc);
#pragma unroll
                for (int r = 0; r < 4; ++r) { const int rw = 16 * mt + 4 * q4 + r; sc[rw * 128 + ((16 * kt + r16) ^ rw)] = acc[r]; } } } }
        NSA_FENCE();
        unsigned Ls[16];
#pragma unroll
        for (int s = 0; s < 16; ++s) Ls[s] = 0u;
#pragma unroll 4
        for (int i = 0; i < 64; ++i) { const int c = 64 * part + i; const float x = sc[row * 128 + (c ^ row)];
            TK_INSERT(Ls, (sortable(x) & ~0x7Fu) | (unsigned)(127 - c)); }
        unsigned Lo[16];
#pragma unroll
        for (int s = 0; s < 16; ++s) Lo[s] = (unsigned)__shfl_xor((int)Ls[s], 32);
#pragma unroll
        for (int s = 0; s < 16; ++s) TK_INSERT(Ls, Lo[s]);
#pragma unroll
        for (int s = 0; s < 16; ++s) { if (half == 0) L1[s] = Ls[s]; else L2[s] = Ls[s]; }
        NSA_FENCE();
    }
    float v1[16], v2[16];
#pragma unroll
    for (int s = 0; s < 16; ++s) { v1[s] = unsortable(L1[s]); v2[s] = unsortable(L2[s]); }
    unsigned C[16];
#pragma unroll
    for (int s = 0; s < 16; ++s) C[s] = 0u;
#pragma unroll
    for (int i = 0; i < 16; ++i)
#pragma unroll
        for (int j = 0; j < 16; ++j) if ((i + 1) * (j + 1) <= 16) { TK_INSERT(C, (sortable(v1[i] + v2[j]) & ~0xFFu) | (unsigned)(255 - (16 * i + j))); }
    LAS unsigned* il = (LAS unsigned*)sc;
    if (part == 0) {
#pragma unroll
        for (int s = 0; s < 16; ++s) { il[row * 33 + s] = 127u - (L1[s] & 127u); il[row * 33 + 16 + s] = 127u - (L2[s] & 127u); }
    }
    NSA_FENCE();
    if (part == 0) { const int rho = 32 * wp + row;
        float val[16], e[16]; float sum = 0.f;
#pragma unroll
        for (int s = 0; s < 16; ++s) val[s] = unsortable(C[s]);
#pragma unroll
        for (int s = 0; s < 16; ++s) { e[s] = __expf(val[s] - val[0]); sum += e[s]; }
        const float is = 1.0f / sum;
#pragma unroll
        for (int s = 0; s < 16; ++s) { const unsigned pos = 255u - (C[s] & 255u); const unsigned i = pos >> 4, j = pos & 15u;
            EID[(size_t)rho * 16 + s] = (int)(il[row * 33 + i] * 128u + il[row * 33 + 16 + j]); EG[(size_t)rho * 16 + s] = e[s] * is; }
    }
    NSA_FENCE();
}
typedef float f32x2_t __attribute__((ext_vector_type(2)));
constexpr float PEER_SCALE = 256.0f, PEER_ISCALE = 1.0f / 256.0f;
__device__ __forceinline__ void peer_convert_one(const Frame& F, const float* srcf, unsigned char* dstb) {
    const int gt = F.vcu * (NWAVES * 64) + F.tid, NT = F.G * NWAVES * 64;
    const f32x4* src = (const f32x4*)srcf; v4u* dst = (v4u*)dstb;
    for (int i = gt; i < 16384 * 1024 / 16; i += NT) { v4u o;
#pragma unroll
        for (int q = 0; q < 4; ++q) { const f32x4 a = src[4 * i + q] * PEER_SCALE; int w = __builtin_amdgcn_cvt_pk_fp8_f32(a[0], a[1], 0, false); w = __builtin_amdgcn_cvt_pk_fp8_f32(a[2], a[3], w, true); o[q] = (unsigned)w; }
        dst[i] = o; }
}
constexpr float PEER_SU = 768.0f, PEER_SH = 24.0f;
__device__ __forceinline__ unsigned q8pack(const f32x4 a, float sc) {
    const int q0 = (int)rintf(fminf(fmaxf(a[0] * sc, -127.f), 127.f)), q1 = (int)rintf(fminf(fmaxf(a[1] * sc, -127.f), 127.f)), q2 = (int)rintf(fminf(fmaxf(a[2] * sc, -127.f), 127.f)), q3 = (int)rintf(fminf(fmaxf(a[3] * sc, -127.f), 127.f));
    return (unsigned)(q0 & 255) | ((unsigned)(q1 & 255) << 8) | ((unsigned)(q2 & 255) << 16) | ((unsigned)(q3 & 255) << 24);
}
__device__ __forceinline__ void peer_convert_u8(const Frame& F, const float* srcf, unsigned char* dstb) {
    const int gt = F.vcu * (NWAVES * 64) + F.tid, NT = F.G * NWAVES * 64;
    const f32x4* src = (const f32x4*)srcf; v4u* dst = (v4u*)dstb;
    for (int i = gt; i < 16384 * 1024 / 16; i += NT) { v4u o;
#pragma unroll
        for (int q = 0; q < 4; ++q) o[q] = q8pack(src[4 * i + q], PEER_SU);
        dst[i] = o; }
}
__device__ __forceinline__ void peer_convert_tables(const Frame& F) { peer_convert_u8(F, F.in[31], F.ws + WS_MG); peer_convert_one(F, F.in[32], F.ws + WS_MG + 16 * MiB); }
__device__ __forceinline__ float sum8(float x) { x += dppf<0xB1>(x); x += dppf<0x4E>(x); x += dppf<0x141>(x); return x; }
template <int PHASE> __device__ __forceinline__ void peer_slice_unit(const Frame& F, int s, int tg) {
    const int lane = F.lane, j = lane & 7, gbase = lane & ~7;
    const bf16* H2 = (const bf16*)(F.ws + WS_H);
    const int* EID = (const int*)(F.ws + WS_PRW + 64 * MiB);
    float* PART = (float*)(F.ws + WS_PRW) + (size_t)s * M * 128; const float* CACT = (const float*)(F.ws + WS_PRW + 80 * MiB);
    const unsigned char* TB = F.ws + WS_MG + (PHASE == 0 ? 0 : 16 * MiB) + 128 * s + 16 * j;
#pragma unroll 1
    for (int it = 0; it < 8; ++it) { const int tk = 64 * tg + 8 * it + (lane >> 3);
        int ids[16]; float hv[16], acc[16];
        { const v4u* ip = (const v4u*)(EID + (size_t)tk * 128 + 16 * j);
#pragma unroll
          for (int q = 0; q < 4; ++q) { const v4u w = ip[q]; ids[4 * q] = (int)w.x; ids[4 * q + 1] = (int)w.y; ids[4 * q + 2] = (int)w.z; ids[4 * q + 3] = (int)w.w; } }
        int hq[4] = {0, 0, 0, 0};
        if (PHASE == 0) { const v4u h0 = *(const v4u*)(H2 + (size_t)tk * D + 128 * s + 16 * j), h1 = *(const v4u*)(H2 + (size_t)tk * D + 128 * s + 16 * j + 8);
            hq[0] = (int)q8pack((f32x4){bflo(h0.x), bfhi(h0.x), bflo(h0.y), bfhi(h0.y)}, PEER_SH); hq[1] = (int)q8pack((f32x4){bflo(h0.z), bfhi(h0.z), bflo(h0.w), bfhi(h0.w)}, PEER_SH);
            hq[2] = (int)q8pack((f32x4){bflo(h1.x), bfhi(h1.x), bflo(h1.y), bfhi(h1.y)}, PEER_SH); hq[3] = (int)q8pack((f32x4){bflo(h1.z), bfhi(h1.z), bflo(h1.w), bfhi(h1.w)}, PEER_SH); }
        else { const f32x4* cp = (const f32x4*)(CACT + (size_t)tk * 128 + 16 * j);
#pragma unroll
            for (int q = 0; q < 4; ++q) { const f32x4 c = cp[q]; hv[4 * q] = c[0]; hv[4 * q + 1] = c[1]; hv[4 * q + 2] = c[2]; hv[4 * q + 3] = c[3]; } }
#pragma unroll
        for (int m = 0; m < 16; ++m) acc[m] = 0.f;
#pragma unroll 1
        for (int jj = 0; jj < 8; ++jj) { const int src = (gbase + jj) * 4;
            v4u tv[16];
#pragma unroll
            for (int m = 0; m < 16; ++m) { const int id = __builtin_amdgcn_ds_bpermute(src, ids[m]); tv[m] = *(const v4u*)(TB + (size_t)id * 1024); }
#pragma unroll
            for (int m = 0; m < 16; ++m) {
                if (PHASE == 0) { int di = __builtin_amdgcn_sdot4((int)tv[m].x, hq[0], 0, false); di = __builtin_amdgcn_sdot4((int)tv[m].y, hq[1], di, false); di = __builtin_amdgcn_sdot4((int)tv[m].z, hq[2], di, false); di = __builtin_amdgcn_sdot4((int)tv[m].w, hq[3], di, false);
                    const float d = sum8((float)di); acc[m] = (j == jj) ? d : acc[m]; }
                else {
                    float f[16];
#pragma unroll
                    for (int q = 0; q < 4; ++q) { const f32x2_t lo = __builtin_amdgcn_cvt_pk_f32_fp8((int)tv[m][q], false), hi = __builtin_amdgcn_cvt_pk_f32_fp8((int)tv[m][q], true); f[4 * q] = lo.x; f[4 * q + 1] = lo.y; f[4 * q + 2] = hi.x; f[4 * q + 3] = hi.y; } const float c = __builtin_bit_cast(float, __builtin_amdgcn_ds_bpermute(src, __builtin_bit_cast(int, hv[m])));
#pragma unroll
                    for (int q = 0; q < 16; ++q) acc[q] += c * f[q]; } }
        }
        if (PHASE == 0) { f32x4* pp = (f32x4*)(PART + (size_t)tk * 128 + 16 * j);
#pragma unroll
            for (int q = 0; q < 4; ++q) pp[q] = (f32x4){acc[4 * q], acc[4 * q + 1], acc[4 * q + 2], acc[4 * q + 3]}; }
        else { f32x4* op = (f32x4*)(F.out + (size_t)tk * D + 128 * s + 16 * j);
#pragma unroll
            for (int q = 0; q < 4; ++q) { f32x4 a = op[q]; a[0] += acc[4 * q] * PEER_ISCALE; a[1] += acc[4 * q + 1] * PEER_ISCALE; a[2] += acc[4 * q + 2] * PEER_ISCALE; a[3] += acc[4 * q + 3] * PEER_ISCALE; op[q] = a; } }
    }
}
template <int PHASE> __device__ __forceinline__ void peer_slice_phase(const Frame& F, int rep) {
    const int q0 = (int)(xb_xcc_id() & 7u);
    for (int qi = 0; qi < 8; ++qi) { const int q = (q0 + qi) & 7;
        for (;;) { unsigned c = 0;
            if (F.lane == 0) c = __hip_atomic_fetch_add(F.ctl + CW_PEERQ + 64 * (16 * rep + 8 * PHASE + q), 1u, RLX_AGENT);
            c = (unsigned)__builtin_amdgcn_readfirstlane((int)c);
            if (c >= 256u) break;
            peer_slice_unit<PHASE>(F, q, (int)c); } }
}
__device__ __forceinline__ void peer_act_phase(const Frame& F) {
    const int gt = F.vcu * (NWAVES * 64) + F.tid, NT = F.G * NWAVES * 64;
    const float* PART = (const float*)(F.ws + WS_PRW); const float* EG = (const float*)(F.ws + WS_PRW + 72 * MiB); float* CACT = (float*)(F.ws + WS_PRW + 80 * MiB);
    for (int i = gt; i < M * 128 / 4; i += NT) { f32x4 d = {0.f, 0.f, 0.f, 0.f};
#pragma unroll
        for (int s = 0; s < 8; ++s) d += ((const f32x4*)PART)[(size_t)s * (M * 128 / 4) + i];
        const f32x4 g = ((const f32x4*)EG)[i]; f32x4 c;
#pragma unroll
        for (int e = 0; e < 4; ++e) { const float dt = d[e] * (1.0f / (PEER_SU * PEER_SH)); c[e] = g[e] * 0.5f * dt * (1.f + erff(dt * 0.70710678118654752f)); }
        ((f32x4*)CACT)[i] = c; }
}
struct Args { const float* in[33]; float* out; unsigned char* ws; int ph_lo, ph_hi; };
__global__ void __launch_bounds__(NWAVES * 64, 2) mk_fwd(Args args) {
    extern __shared__ __attribute__((aligned(16))) unsigned char lds[];
    Frame F;
    F.lds = (LAS unsigned char*)lds;
    F.MISC = (volatile LAS unsigned*)(F.lds + MISC_OFF);
    F.tid = threadIdx.x; F.lane = F.tid & 63; F.wave = __builtin_amdgcn_readfirstlane(F.tid >> 6);
    F.G = gridDim.x; { const int bx = blockIdx.x; F.vcu = (F.G % 8 == 0) ? (bx % 8) * (F.G / 8) + bx / 8 : bx; }
    unsigned char* ws = args.ws; F.ws = ws; F.out = args.out;
    F.ctl = (gu32*)(ws + WS_CTL);
#pragma unroll
    for (int i = 0; i < 33; ++i) F.in[i] = args.in[i];
    for (int u = F.tid; u < (LDS_BYTES - LDSCTL_OFF) / 4; u += NWAVES * 64) ((LAS unsigned*)(F.lds + LDSCTL_OFF))[u] = 0u;
    __syncthreads();
    const int lo = args.ph_lo, hi = args.ph_hi & 0xff; const int rep = args.ph_hi >> 8;
    const bool multi = (hi - lo) > 1;
    XcdBarrier bar; bar.bar = (unsigned*)(F.ctl + CW_BAR); bar.x = 0; bar.st = nullptr;
    if (multi) bar = xcd_barrier_post((unsigned*)(F.ctl + CW_BAR), F.MISC + 8);
#define IN(k) (lo <= (k) && (k) < hi)
#define NREP(k) ((((repmask) >> (k)) & 1) + 1)
#define REPBAR() do { if (rep) xcd_barrier(bar); } while (0)
#define SEAM(k) do { if (DBG_SEL == (k) && blockIdx.x == 0 && F.tid == 0) dbg_t1 = __builtin_amdgcn_s_memrealtime(); if (IN(k) && IN((k) + 1)) xcd_barrier(bar); if ((DBG_SEL == (k) + 1 || (DBG_SEL == 20 && (k) == 1)) && blockIdx.x == 0 && F.tid == 0) dbg_t0 = __builtin_amdgcn_s_memrealtime(); } while (0)
    unsigned long long dbg_t0 = 0ull, dbg_t1 = 0ull;

    if (IN(0)) { { p0_prologue(F); } } SEAM(0);
    if (IN(1)) { {
        pg8::Gemm g{(const pg8::bf16_t*)(ws + WS_H), (const pg8::bf16_t*)(ws + WS_WIN), M, NG1, D}; pg8::StaticOrder S; S.init(M, NG1, F.G, (int)blockIdx.x);
        pg8::EpiG1 E{(float*)(ws + WS_PRW), (float*)(ws + WS_BND), (pg8::bf16_t*)((unsigned char*)F.out + DO_PNSA), (pg8::bf16_t*)(ws + WS_MG), (float*)((unsigned char*)F.out + DO_GLOG)};
        pg8::gemm_phase<pg8::EpiG1, pg8::StaticOrder, true, true>(F.lds + RING_OFF, g, S, E);
    } } SEAM(1);
    if (IN(2)) {
        for (int u = F.vcu; u < 256; u += F.G) nsa_prep_tile(F, u);
        if (DBG_SEL == 20 && blockIdx.x == 0 && F.tid == 0) dbg_t1 = __builtin_amdgcn_s_memrealtime();
        if (DBG_SEL == 21 && blockIdx.x == 0 && F.tid == 0) dbg_t0 = __builtin_amdgcn_s_memrealtime();
        for (int u = F.vcu; u < 256; u += F.G) compress_unit(F, u);
        if (DBG_SEL == 21 && blockIdx.x == 0 && F.tid == 0) dbg_t1 = __builtin_amdgcn_s_memrealtime();
        for (int u = F.vcu; u < 256; u += F.G) rwkv_prep_tile(F, u);
    } SEAM(2);
    if (IN(3)) { {
        if ((int)blockIdx.x < 32 && !(rep && P3REP == 3)) { if (F.wave < 4) rwkv_scan_wave(F, (int)blockIdx.x, F.wave); else if (F.wave == 4) rwkv_scan_prefetch(F, (int)blockIdx.x); __syncthreads(); }
        if (!(rep && P3REP == 2)) nsa_phase(F, rep);
    } } SEAM(3);
    if (IN(4)) { { rwkv_epilogue(F); } } SEAM(4);
    if (IN(5)) { {
        { pg8::Gemm g{(const pg8::bf16_t*)(ws + WS_H), (const pg8::bf16_t*)(ws + WS_WA), M, D, 512}; pg8::StaticOrder S; S.init(M, D, F.G, (int)blockIdx.x);
          pg8::EpiGate1 E{(float*)(ws + WS_PRW), (const pg8::bf16_t*)(ws + WS_MG), 0};
          pg8::gemm_phase<pg8::EpiGate1, pg8::StaticOrder, true, true>(F.lds + RING_OFF, g, S, E); }
        VM_WAIT(); __syncthreads();
        { pg8::Gemm g{(const pg8::bf16_t*)(ws + WS_H + 16 * MiB), (const pg8::bf16_t*)(ws + WS_WB), M, D, 512}; pg8::StaticOrder S; S.init(M, D, F.G, (int)blockIdx.x);
          pg8::EpiGate2 E{(const float*)(ws + WS_PRW), (const pg8::bf16_t*)(ws + WS_MG), 1024, (pg8::bf16_t*)(ws + WS_PRW + 64 * MiB)};
          pg8::gemm_phase<pg8::EpiGate2, pg8::StaticOrder, true, true>(F.lds + RING_OFF, g, S, E); }
    } } SEAM(5);
    if (IN(6)) { {
        pg8::Gemm g{(const pg8::bf16_t*)(ws + WS_PRW + 64 * MiB), (const pg8::bf16_t*)(ws + WS_WOUT), M, D, D}; pg8::StaticOrder S; S.init(M, D, F.G, (int)blockIdx.x);
        pg8::EpiRes E{F.in[0], F.out};
        pg8::gemm_phase<pg8::EpiRes, pg8::StaticOrder, true, true>(F.lds + RING_OFF, g, S, E);
    } } SEAM(6);
    if (IN(7)) { { const int gw = F.vcu * NWAVES + F.wave, NGW = F.G * NWAVES;
        for (int m = gw; m < M; m += NGW) rms_row_to_bf16(F.lane, F.out + (size_t)m * D, F.in[27], (bf16*)(ws + WS_H) + (size_t)m * D);
        peer_convert_tables(F);
    } } SEAM(7);
    if (IN(8)) { {
        pg8::Gemm g{(const pg8::bf16_t*)(ws + WS_H), (const pg8::bf16_t*)(ws + WS_WQ), M, 2048, D}; pg8::StaticOrder S; S.init(M, 2048, F.G, (int)blockIdx.x);
        pg8::EpiBf16<0> E{(pg8::bf16_t*)(ws + WS_PRW), 2048, nullptr, 0, 0, 1.f};
        pg8::gemm_phase<pg8::EpiBf16<0>, pg8::StaticOrder, true, true>(F.lds + RING_OFF, g, S, E);
    } } SEAM(8);
    if (IN(9)) { { const int gw = F.vcu * NWAVES + F.wave, NGW = F.G * NWAVES; LAS float* sc = (LAS float*)(F.lds + F.wave * 16384);
        for (int wp = gw; wp < M * 8 / 32; wp += NGW) peer_topk_pass(F, wp, sc);
    } } SEAM(9);
    if (IN(10)) { peer_slice_phase<0>(F, rep); } SEAM(10);
    if (IN(11)) { peer_act_phase(F); } SEAM(11);
    if (IN(12)) { peer_slice_phase<1>(F, rep); }
    if (DBG_SEL >= 0 && multi) { if (DBG_SEL == 12 && blockIdx.x == 0 && F.tid == 0) dbg_t1 = __builtin_amdgcn_s_memrealtime(); xcd_barrier(bar); if (blockIdx.x == 0 && F.tid == 0) F.out[0] += (DBG_SEL >= 30) ? (0.05f + (float)(F.MISC[21] - F.MISC[20]) * 0.01f * 1e-3f) : (0.05f + (float)(dbg_t1 - dbg_t0) * 0.01f * 2e-4f); }
#undef IN
#undef SEAM
}

extern "C" void kernel_launch(void* const* d_in, const int* in_sizes, int n_in, void* d_out, int out_size, void* d_ws, size_t ws_size, hipStream_t stream) {
    static int grid = 0;
    if (grid == 0) {
        if (n_in != 33 || out_size != M * D || ws_size < WS_END) { fprintf(stderr, "kernel_launch: unexpected shapes (n_in %d out %d ws %zu)\n", n_in, out_size, ws_size); grid = -1; return; }
        int dev = 0, cus = 0, per_cu = 0;
        if (hipGetDevice(&dev) != hipSuccess || hipDeviceGetAttribute(&cus, hipDeviceAttributeMultiprocessorCount, dev) != hipSuccess) { grid = -1; return; }
        if (hipFuncSetAttribute((const void*)mk_fwd, hipFuncAttributeMaxDynamicSharedMemorySize, LDS_BYTES) != hipSuccess) { fprintf(stderr, "kernel_launch: hipFuncSetAttribute failed\n"); grid = -1; return; }
        if (hipOccupancyMaxActiveBlocksPerMultiprocessor(&per_cu, (const void*)mk_fwd, NWAVES * 64, LDS_BYTES) != hipSuccess || per_cu < 1)
            fprintf(stderr, "kernel_launch: occupancy query reports %d blocks per CU\n", per_cu);
        (void)hipGetLastError();
        grid = cus;
        if (grid > 256) grid = 256;
    }
    if (grid < 0) return;
    if (hipMemsetAsync((char*)d_ws + WS_CTL, 0, CTL_ZERO_BYTES, stream) != hipSuccess) return;
    Args a{};
    for (int i = 0; i < 33; ++i) a.in[i] = (const float*)d_in[i];
    a.out = (float*)d_out; a.ws = (unsigned char*)d_ws;
#if MK_ONE_LAUNCH
    a.ph_lo = 0; a.ph_hi = N_PHASES;
    hipLaunchKernelGGL(mk_fwd, dim3(grid), dim3(NWAVES * 64), LDS_BYTES, stream, a);
#else
    for (int p = 0; p < N_PHASES; ++p) { for (int r = 0; r <= (((REP_MASK) >> p) & 1); ++r) { a.ph_lo = p; a.ph_hi = (p + 1) | (r << 8); hipLaunchKernelGGL(mk_fwd, dim3(grid), dim3(NWAVES * 64), LDS_BYTES, stream, a); } }
#endif
}
```

```cpp
#include <hip/hip_runtime.h>
#include <cstdio>
#include <cstdint>
#define MK_ONE_LAUNCH 1
#define REP_MASK 0
#define P3REP 1
#define NSA_SKIP 0
#define DBG_SEL -1
namespace pg8 {
#define PG8_LAS __attribute__((address_space(3)))
typedef unsigned short bf16_t;
typedef short bf16x8 __attribute__((ext_vector_type(8)));
typedef float f32x4 __attribute__((ext_vector_type(4)));
typedef unsigned u32x4 __attribute__((ext_vector_type(4)));
constexpr int BM = 256, BK = 64, HALF = 128, HTB = HALF * BK * 2  , STAGE_BYTES = 8 * HTB, NXCD = 8, WGM = 8;

__host__ __device__ __forceinline__ int lds_byte(int r, int c) { const int st = (r >> 4) * 2 + (c >> 5), rr = r & 15, cc = c & 31, ob = rr * 64 + cc * 2; return st * 1024 + (ob ^ (((ob >> 9) & 1) << 5)); }
__host__ __device__ __forceinline__ void stage_rc(int b, int& R, int& C) { const int st = b / 1024, sb = b % 1024, swz = sb ^ (((sb >> 9) & 1) << 5); R = (st >> 1) * 16 + swz / 64; C = (st & 1) * 32 + (swz % 64) / 2; }
__host__ __device__ __forceinline__ int perm32(int rho) { const int n = rho >> 4, i = rho & 15; return 8 * (i >> 2) + 4 * n + (i & 3); }

struct Unit { int pm, pn; int seg = 0; };
struct Gemm { const bf16_t* A; const bf16_t* Bt; int M, N, K; const bf16_t* A2 = nullptr; const bf16_t* Bt2 = nullptr; };

struct StaticOrder {
    int nM, nN, nwg, G, c;
    __host__ __device__ void init(int M, int N, int G_, int c_) { nM = M / BM; nN = N / BM; nwg = nM * nN; G = G_; c = c_; }
    __host__ __device__ bool next(int i, Unit& u) const {
        const long L = (long)i * G + c; if (L >= nwg) return false;
        int wgid = (int)L; { const int q = nwg / NXCD, r = nwg % NXCD, xcd = wgid % NXCD, off = wgid / NXCD; wgid = (xcd < r ? xcd * (q + 1) : r * (q + 1) + (xcd - r) * q) + off; }
        const int nig = WGM * nN, gid = wgid / nig, fm = gid * WGM, gsz = (nM - fm) < WGM ? (nM - fm) : WGM;
        u.pm = fm + ((wgid % nig) % gsz); u.pn = (wgid % nig) / gsz; return true;
    }
    __device__ __forceinline__ void a_ready(const Unit&) const {}
    __device__ __forceinline__ void done(const Unit&) const {}
};


struct StaticOrder2 {
    StaticOrder base;
    __host__ __device__ void init(int M, int N, int G_, int c_) { base.init(M, N, G_, c_); }
    __host__ __device__ bool next(int i, Unit& u) const { const bool ok = base.next(i >> 1, u); u.seg = i & 1; return ok; }
    __device__ __forceinline__ void a_ready(const Unit&) const {}
    __device__ __forceinline__ void done(const Unit&) const {}
};
typedef float f32x2c __attribute__((ext_vector_type(2))); typedef __bf16 bf16x2c __attribute__((ext_vector_type(2)));
__device__ __forceinline__ unsigned cvt_pk_bf16(float lo, float hi) { const f32x2c v = {lo, hi}; const bf16x2c b = __builtin_convertvector(v, bf16x2c); return __builtin_bit_cast(unsigned, b); }
typedef float f32x2 __attribute__((ext_vector_type(2)));
__device__ __forceinline__ f32x2 gelu_pk(f32x2 v) {
    const f32x2 av = __builtin_elementwise_abs(v), d = av * 0.2316418882f + 1.0f;
    f32x2 t; t.x = __builtin_amdgcn_rcpf(d.x); t.y = __builtin_amdgcn_rcpf(d.y);
    f32x2 q = t * 0.5307027145f + (-0.7265760135f); q = q * t + 0.7107068705f; q = q * t + (-0.142248368f); q = q * t + 0.127414796f; q = q * t;
    const f32x2 s = (v * v) * (-0.72134752044f);
    f32x2 e; e.x = __builtin_amdgcn_exp2f(s.x); e.y = __builtin_amdgcn_exp2f(s.y);
    const f32x2 m = v * (q * e), r = v - m;
    f32x2 o; o.x = v.x < 0.f ? m.x : r.x; o.y = v.y < 0.f ? m.y : r.y; return o;
}

template <int ACT  > struct EpiBf16 {
    static constexpr bool PERM = true, AFTER_DRAIN = false, KEEP_ACC = false; static_assert(ACT == 0 || ACT == 1, "EpiBf16: ACT is 0 (none) or 1 (gelu_pk)");
    bf16_t* O; int ldc; const float* bias; int split_cols; size_t split_stride; float scale0;
    __device__ __forceinline__ void operator()(const f32x4 (&acc)[2][2][4][2], const Unit& u, int wr, int wc, int fr, int fq) const {
        const int row0 = u.pm * BM + wr * 64 + fr; int colt = u.pn * BM; bf16_t* base = O;
        float sc = 1.f; if (split_cols) { const int t = colt / split_cols; base += (size_t)t * split_stride; colt -= t * split_cols; if (t == 0) sc = scale0; }
        const int col0 = colt + wc * 32 + 8 * fq, bcol0 = u.pn * BM + wc * 32 + 8 * fq;
        f32x4 bv[2][2];
#pragma unroll
        for (int bj = 0; bj < 2; ++bj)
#pragma unroll
            for (int n = 0; n < 2; ++n) bv[bj][n] = bias ? *(const f32x4*)(bias + bcol0 + bj * HALF + 4 * n) : (f32x4){0.f, 0.f, 0.f, 0.f};
#pragma unroll
        for (int ai = 0; ai < 2; ++ai)
#pragma unroll
            for (int m = 0; m < 4; ++m) { bf16_t* rowp = base + (size_t)(row0 + ai * HALF + m * 16) * ldc + col0;
#pragma unroll
                for (int bj = 0; bj < 2; ++bj) { f32x4 v0 = acc[ai][bj][m][0] + bv[bj][0], v1 = acc[ai][bj][m][1] + bv[bj][1];
                    if (ACT == 1) { f32x2 a = gelu_pk((f32x2){v0[0], v0[1]}), b = gelu_pk((f32x2){v0[2], v0[3]}), c = gelu_pk((f32x2){v1[0], v1[1]}), d = gelu_pk((f32x2){v1[2], v1[3]});
                        v0 = (f32x4){a.x, a.y, b.x, b.y}; v1 = (f32x4){c.x, c.y, d.x, d.y}; }
                    v0 = v0 * sc; v1 = v1 * sc; u32x4 w; w.x = cvt_pk_bf16(v0[0], v0[1]); w.y = cvt_pk_bf16(v0[2], v0[3]); w.z = cvt_pk_bf16(v1[0], v1[1]); w.w = cvt_pk_bf16(v1[2], v1[3]);
                    *(u32x4*)(rowp + bj * HALF) = w; } }
    }
};
__device__ __forceinline__ float bf_lo(unsigned w) { return __uint_as_float(w << 16); }
__device__ __forceinline__ float bf_hi(unsigned w) { return __uint_as_float(w & 0xffff0000u); }
__device__ __forceinline__ float sigm(float x) { return __builtin_amdgcn_rcpf(1.0f + __expf(-x)); }
__device__ __forceinline__ u32x4 pack8(const f32x4 v0, const f32x4 v1) { u32x4 w; w.x = cvt_pk_bf16(v0[0], v0[1]); w.y = cvt_pk_bf16(v0[2], v0[3]); w.z = cvt_pk_bf16(v1[0], v1[1]); w.w = cvt_pk_bf16(v1[2], v1[3]); return w; }

struct EpiG1 {
    static constexpr bool PERM = true, AFTER_DRAIN = false, KEEP_ACC = false;
    float* PRW; float* BND; bf16_t* PNSA; bf16_t* MG; float* GLOG;
    __device__ __forceinline__ void operator()(const f32x4 (&acc)[2][2][4][2], const Unit& u, int wr, int wc, int fr, int fq) const {
        const int row0 = u.pm * BM + wr * 64 + fr, c0 = wc * 32 + 8 * fq;
#pragma unroll
        for (int ai = 0; ai < 2; ++ai)
#pragma unroll
            for (int m = 0; m < 4; ++m) { const int row = row0 + ai * HALF + m * 16;
#pragma unroll
                for (int bj = 0; bj < 2; ++bj) { const f32x4 v0 = acc[ai][bj][m][0], v1 = acc[ai][bj][m][1]; const int col = c0 + bj * HALF;
                    if (u.pn < 7) { float* p = PRW + (size_t)row * 1792 + u.pn * 256 + col; *(f32x4*)p = v0; *(f32x4*)(p + 4) = v1;
                        if ((row & 63) == 63) { float* q = BND + (size_t)(row >> 6) * 1792 + u.pn * 256 + col; *(f32x4*)q = v0; *(f32x4*)(q + 4) = v1; } }
                    else if (u.pn < 12) { *(u32x4*)(PNSA + (size_t)row * 1280 + (u.pn - 7) * 256 + col) = pack8(v0, v1); }
                    else if (u.pn < 20) { *(u32x4*)(MG + (size_t)row * 2048 + (u.pn - 12) * 256 + col) = pack8(v0, v1); }
                    else { if (col < 32) { float* p = GLOG + (size_t)row * 32 + col; *(f32x4*)p = v0; *(f32x4*)(p + 4) = v1; } }
                } }
    }
};
struct EpiGate1 {
    static constexpr bool PERM = true, AFTER_DRAIN = false, KEEP_ACC = false;
    float* T1; const bf16_t* MG; int goff;
    __device__ __forceinline__ void operator()(const f32x4 (&acc)[2][2][4][2], const Unit& u, int wr, int wc, int fr, int fq) const {
        const int row0 = u.pm * BM + wr * 64 + fr, c0 = u.pn * BM + wc * 32 + 8 * fq;
#pragma unroll
        for (int ai = 0; ai < 2; ++ai)
#pragma unroll
            for (int m = 0; m < 4; ++m) { const int row = row0 + ai * HALF + m * 16;
#pragma unroll
                for (int bj = 0; bj < 2; ++bj) { const f32x4 v0 = acc[ai][bj][m][0], v1 = acc[ai][bj][m][1]; const int col = c0 + bj * HALF;
                    const u32x4 g = *(const u32x4*)(MG + (size_t)row * 2048 + goff + col);
                    f32x4 o0, o1; o0[0] = sigm(bf_lo(g.x)) * v0[0]; o0[1] = sigm(bf_hi(g.x)) * v0[1]; o0[2] = sigm(bf_lo(g.y)) * v0[2]; o0[3] = sigm(bf_hi(g.y)) * v0[3];
                    o1[0] = sigm(bf_lo(g.z)) * v1[0]; o1[1] = sigm(bf_hi(g.z)) * v1[1]; o1[2] = sigm(bf_lo(g.w)) * v1[2]; o1[3] = sigm(bf_hi(g.w)) * v1[3];
                    float* p = T1 + (size_t)row * 1024 + col; *(f32x4*)p = o0; *(f32x4*)(p + 4) = o1; } }
    }
};
struct EpiGate2 {
    static constexpr bool PERM = true, AFTER_DRAIN = false, KEEP_ACC = false;
    const float* T1; const bf16_t* MG; int goff; bf16_t* MIX;
    __device__ __forceinline__ void operator()(const f32x4 (&acc)[2][2][4][2], const Unit& u, int wr, int wc, int fr, int fq) const {
        const int row0 = u.pm * BM + wr * 64 + fr, c0 = u.pn * BM + wc * 32 + 8 * fq;
#pragma unroll
        for (int ai = 0; ai < 2; ++ai)
#pragma unroll
            for (int m = 0; m < 4; ++m) { const int row = row0 + ai * HALF + m * 16;
#pragma unroll
                for (int bj = 0; bj < 2; ++bj) { const f32x4 v0 = acc[ai][bj][m][0], v1 = acc[ai][bj][m][1]; const int col = c0 + bj * HALF;
                    const u32x4 g = *(const u32x4*)(MG + (size_t)row * 2048 + goff + col);
                    const float* p = T1 + (size_t)row * 1024 + col; const f32x4 t0 = *(const f32x4*)p, t1 = *(const f32x4*)(p + 4);
                    f32x4 o0, o1; o0[0] = t0[0] + sigm(bf_lo(g.x)) * v0[0]; o0[1] = t0[1] + sigm(bf_hi(g.x)) * v0[1]; o0[2] = t0[2] + sigm(bf_lo(g.y)) * v0[2]; o0[3] = t0[3] + sigm(bf_hi(g.y)) * v0[3];
                    o1[0] = t1[0] + sigm(bf_lo(g.z)) * v1[0]; o1[1] = t1[1] + sigm(bf_hi(g.z)) * v1[1]; o1[2] = t1[2] + sigm(bf_lo(g.w)) * v1[2]; o1[3] = t1[3] + sigm(bf_hi(g.w)) * v1[3];
                    *(u32x4*)(MIX + (size_t)row * 1024 + col) = pack8(o0, o1); } }
    }
};
struct EpiRes {
    static constexpr bool PERM = true, AFTER_DRAIN = false, KEEP_ACC = false;
    const float* X; float* OUT;
    __device__ __forceinline__ void operator()(const f32x4 (&acc)[2][2][4][2], const Unit& u, int wr, int wc, int fr, int fq) const {
        const int row0 = u.pm * BM + wr * 64 + fr, c0 = u.pn * BM + wc * 32 + 8 * fq;
#pragma unroll
        for (int ai = 0; ai < 2; ++ai)
#pragma unroll
            for (int m = 0; m < 4; ++m) { const int row = row0 + ai * HALF + m * 16;
#pragma unroll
                for (int bj = 0; bj < 2; ++bj) { const size_t off = (size_t)row * 1024 + c0 + bj * HALF;
                    const f32x4 x0 = *(const f32x4*)(X + off), x1 = *(const f32x4*)(X + off + 4);
                    *(f32x4*)(OUT + off) = x0 + acc[ai][bj][m][0]; *(f32x4*)(OUT + off + 4) = x1 + acc[ai][bj][m][1]; } }
    }
};
struct EpiMerge {
    static constexpr bool PERM = true, AFTER_DRAIN = false, KEEP_ACC = true;
    const bf16_t* MG; bf16_t* MIX;
    __device__ __forceinline__ void operator()(f32x4 (&acc)[2][2][4][2], const Unit& u, int wr, int wc, int fr, int fq) const {
        const int row0 = u.pm * BM + wr * 64 + fr, c0 = u.pn * BM + wc * 32 + 8 * fq;
#pragma unroll
        for (int ai = 0; ai < 2; ++ai)
#pragma unroll
            for (int m = 0; m < 4; ++m) { const int row = row0 + ai * HALF + m * 16;
#pragma unroll
                for (int bj = 0; bj < 2; ++bj) { const int col = c0 + bj * HALF;
                    const u32x4 gb = *(const u32x4*)(MG + (size_t)row * 2048 + 1024 + col);
                    const float eb[8] = {__expf(-bf_lo(gb.x)), __expf(-bf_hi(gb.x)), __expf(-bf_lo(gb.y)), __expf(-bf_hi(gb.y)), __expf(-bf_lo(gb.z)), __expf(-bf_hi(gb.z)), __expf(-bf_lo(gb.w)), __expf(-bf_hi(gb.w))};
                    if (u.seg == 0) { const u32x4 ga = *(const u32x4*)(MG + (size_t)row * 2048 + col);
                        const float ea[8] = {__expf(-bf_lo(ga.x)), __expf(-bf_hi(ga.x)), __expf(-bf_lo(ga.y)), __expf(-bf_hi(ga.y)), __expf(-bf_lo(ga.z)), __expf(-bf_hi(ga.z)), __expf(-bf_lo(ga.w)), __expf(-bf_hi(ga.w))};
#pragma unroll
                        for (int e = 0; e < 4; ++e) { acc[ai][bj][m][0][e] *= (1.0f + eb[e]) * __builtin_amdgcn_rcpf(1.0f + ea[e]); acc[ai][bj][m][1][e] *= (1.0f + eb[4 + e]) * __builtin_amdgcn_rcpf(1.0f + ea[4 + e]); } }
                    else { f32x4 o0, o1;
#pragma unroll
                        for (int e = 0; e < 4; ++e) { o0[e] = acc[ai][bj][m][0][e] * __builtin_amdgcn_rcpf(1.0f + eb[e]); o1[e] = acc[ai][bj][m][1][e] * __builtin_amdgcn_rcpf(1.0f + eb[4 + e]); }
                        *(u32x4*)(MIX + (size_t)row * 1024 + col) = pack8(o0, o1); } } }
    }
};
template <class Epi, class Sched, bool ALIGN_EPI = false, bool SP2 = false>
__device__ __forceinline__ void gemm_phase(PG8_LAS unsigned char* lds, const Gemm g, const Sched& S, const Epi& E) {
    const int tid = threadIdx.x, wid = __builtin_amdgcn_readfirstlane(tid >> 6), lane = tid & 63, wr = wid >> 2, wc = wid & 3, fr = lane & 15, fq = lane >> 4;
    const int K = g.K, nt = K / BK;
    unsigned voffA[2], voffB[2];
#pragma unroll
    for (int i = 0; i < 2; ++i) { int R, C; stage_rc(tid * 16 + i * 8192, R, C); const int Rb = Epi::PERM ? ((R & ~31) + perm32(R & 31)) : R;
        voffA[i] = (unsigned)(R * K + C) * 2u; voffB[i] = (unsigned)(Rb * K + C) * 2u; }
    const size_t kstep = (size_t)(BK * 2);
    const size_t hstep = (size_t)HALF * K * 2;
    const size_t tstep = 2 * hstep;
    const unsigned ldsw = (unsigned)wid * 1024u;
    const int aoff = lds_byte(wr * 64 + fr, fq * 8), boff = lds_byte(wc * 32 + fr, fq * 8);
#define PG8_SA(b, h) (((b) * 2 + (h)) * HTB)
#define PG8_SB(b, h) ((4 + (b) * 2 + (h)) * HTB)
#define PG8_STAGE(bufoff, gbase, voff) do { _Pragma("unroll") for (int _i = 0; _i < 2; ++_i) \
        __builtin_amdgcn_global_load_lds((const unsigned*)((const char*)(gbase) + (voff)[_i]), (PG8_LAS unsigned*)(lds + (bufoff) + ldsw + _i * 8192), 16, 0, 0); } while (0)
#define PG8_LDA(dst, b, h) do { _Pragma("unroll") for (int m = 0; m < 4; ++m) _Pragma("unroll") for (int k = 0; k < 2; ++k) dst[m][k] = *(const PG8_LAS bf16x8*)(lds + PG8_SA(b, h) + aoff + m * 2048 + k * 1024); } while (0)
#define PG8_LDB(dst, b, h) do { _Pragma("unroll") for (int n = 0; n < 2; ++n) _Pragma("unroll") for (int k = 0; k < 2; ++k) dst[n][k] = *(const PG8_LAS bf16x8*)(lds + PG8_SB(b, h) + boff + n * 2048 + k * 1024); } while (0)
#define PG8_MMA(ai, bj, At, Bt) do { __builtin_amdgcn_s_setprio(1); _Pragma("unroll") for (int m = 0; m < 4; ++m) _Pragma("unroll") for (int n = 0; n < 2; ++n) _Pragma("unroll") for (int k = 0; k < 2; ++k) \
        acc[ai][bj][m][n] = __builtin_amdgcn_mfma_f32_16x16x32_bf16(Bt[n][k], At[m][k], acc[ai][bj][m][n], 0, 0, 0); __builtin_amdgcn_s_setprio(0); } while (0)
#define PG8_WAIT_V(n) asm volatile("s_waitcnt vmcnt(" #n ")" ::: "memory")
#define PG8_WAIT_L(n) asm volatile("s_waitcnt lgkmcnt(" #n ")" ::: "memory")
#define PG8_BAR __builtin_amdgcn_s_barrier()
#define PG8_SCHED __builtin_amdgcn_sched_barrier(0)
    Unit cur, nxt; int ui = 0;
    if (!S.next(0, cur)) return;
    f32x4 acc[2][2][4][2];
#pragma unroll
    for (int a = 0; a < 2; ++a)
#pragma unroll
        for (int b = 0; b < 2; ++b)
#pragma unroll
            for (int m = 0; m < 4; ++m)
#pragma unroll
                for (int n = 0; n < 2; ++n) acc[a][b][m][n] = (f32x4){0.f, 0.f, 0.f, 0.f};
    bf16x8 At[4][2], B0[2][2], B1[2][2];
    const char* cA = (const char*)(cur.seg ? g.A2 : g.A) + (size_t)cur.pm * tstep; const char* cB = (const char*)(cur.seg ? g.Bt2 : g.Bt) + (size_t)cur.pn * tstep;
    S.a_ready(cur);
    if constexpr (SP2) {
        PG8_STAGE(PG8_SB(0, 0), cB, voffB); PG8_STAGE(PG8_SB(0, 1), cB + hstep, voffB); PG8_STAGE(PG8_SA(0, 0), cA, voffA); PG8_STAGE(PG8_SA(0, 1), cA + hstep, voffA);
        if (wr == 1) PG8_BAR;
        PG8_WAIT_V(2); PG8_BAR;
        PG8_STAGE(PG8_SB(1, 0), cB + kstep, voffB); PG8_STAGE(PG8_SA(1, 0), cA + kstep, voffA); PG8_STAGE(PG8_SB(1, 1), cB + hstep + kstep, voffB);
        PG8_WAIT_V(6); PG8_BAR;
    } else {
        PG8_STAGE(PG8_SB(0, 0), cB, voffB); PG8_STAGE(PG8_SA(0, 0), cA, voffA); PG8_STAGE(PG8_SB(0, 1), cB + hstep, voffB); PG8_STAGE(PG8_SA(0, 1), cA + hstep, voffA);
        if (wr == 1) PG8_BAR;
        PG8_WAIT_V(4); PG8_BAR;
        PG8_STAGE(PG8_SB(1, 0), cB + kstep, voffB); PG8_STAGE(PG8_SA(1, 0), cA + kstep, voffA); PG8_STAGE(PG8_SB(1, 1), cB + hstep + kstep, voffB);
        PG8_WAIT_V(6); PG8_BAR;
    }
    for (;;) {
        const bool has_next = S.next(ui + 1, nxt);
        const char* nA = has_next ? (const char*)(nxt.seg ? g.A2 : g.A) + (size_t)nxt.pm * tstep : cA; const char* nB = has_next ? (const char*)(nxt.seg ? g.Bt2 : g.Bt) + (size_t)nxt.pn * tstep : cB;
        for (int t = 0; t < nt; t += 2) {
            const bool last = (t == nt - 2);
            const char* a1 = cA + (size_t)(t + 1) * kstep;
            const char* a2 = last ? nA : cA + (size_t)(t + 2) * kstep; const char* b2 = last ? nB : cB + (size_t)(t + 2) * kstep;
            const char* a3 = a2 + kstep; const char* b3 = b2 + kstep;
            if (last && has_next) S.a_ready(nxt);
            if constexpr (SP2) {
            PG8_LDB(B0, 0, 0); PG8_LDB(B1, 0, 1); PG8_SCHED; PG8_LDA(At, 0, 0); PG8_STAGE(PG8_SA(1, 1), a1 + hstep, voffA);
            PG8_WAIT_V(8); PG8_WAIT_L(0); PG8_BAR; PG8_MMA(0, 0, At, B0); PG8_MMA(0, 1, At, B1); PG8_BAR; PG8_SCHED;
            PG8_LDA(At, 0, 1); PG8_STAGE(PG8_SB(0, 0), b2, voffB); PG8_STAGE(PG8_SB(0, 1), b2 + hstep, voffB); PG8_STAGE(PG8_SA(0, 0), a2, voffA);
            PG8_WAIT_V(8); PG8_WAIT_L(0); PG8_BAR; PG8_MMA(1, 0, At, B0); PG8_MMA(1, 1, At, B1); PG8_BAR; PG8_SCHED;
            PG8_LDB(B0, 1, 0); PG8_LDB(B1, 1, 1); PG8_SCHED; PG8_LDA(At, 1, 0); PG8_STAGE(PG8_SA(0, 1), a2 + hstep, voffA);
            PG8_WAIT_V(8); PG8_WAIT_L(0); PG8_BAR; PG8_MMA(0, 0, At, B0); PG8_MMA(0, 1, At, B1); PG8_BAR; PG8_SCHED;
            PG8_LDA(At, 1, 1); PG8_STAGE(PG8_SB(1, 0), b3, voffB); PG8_STAGE(PG8_SB(1, 1), b3 + hstep, voffB); PG8_STAGE(PG8_SA(1, 0), a3, voffA);
            PG8_WAIT_V(8); PG8_WAIT_L(0); PG8_BAR; PG8_MMA(1, 0, At, B0); PG8_MMA(1, 1, At, B1); PG8_BAR; PG8_SCHED;
            } else {
            PG8_LDB(B0, 0, 0); PG8_SCHED; PG8_LDA(At, 0, 0); PG8_STAGE(PG8_SA(1, 1), a1 + hstep, voffA);
            PG8_WAIT_L(8); PG8_BAR; PG8_WAIT_L(0); PG8_MMA(0, 0, At, B0); PG8_BAR; PG8_SCHED;
            PG8_LDB(B1, 0, 1); PG8_STAGE(PG8_SB(0, 0), b2, voffB);
            PG8_BAR; PG8_WAIT_L(0); PG8_MMA(0, 1, At, B1); PG8_BAR;
            PG8_LDA(At, 0, 1); PG8_STAGE(PG8_SA(0, 0), a2, voffA);
            PG8_BAR; PG8_WAIT_L(0); PG8_MMA(1, 0, At, B0); PG8_BAR; PG8_SCHED;
            PG8_STAGE(PG8_SB(0, 1), b2 + hstep, voffB);
            PG8_WAIT_V(6); PG8_BAR; PG8_MMA(1, 1, At, B1); PG8_BAR;
            PG8_LDB(B0, 1, 0); PG8_SCHED; PG8_LDA(At, 1, 0); PG8_STAGE(PG8_SA(0, 1), a2 + hstep, voffA);
            PG8_WAIT_L(8); PG8_BAR; PG8_WAIT_L(0); PG8_MMA(0, 0, At, B0); PG8_BAR; PG8_SCHED;
            PG8_LDB(B1, 1, 1); PG8_STAGE(PG8_SB(1, 0), b3, voffB);
            PG8_BAR; PG8_WAIT_L(0); PG8_MMA(0, 1, At, B1); PG8_BAR;
            PG8_LDA(At, 1, 1); PG8_STAGE(PG8_SA(1, 0), a3, voffA);
            PG8_BAR; PG8_WAIT_L(0); PG8_MMA(1, 0, At, B0); PG8_BAR; PG8_SCHED;
            PG8_STAGE(PG8_SB(1, 1), b3 + hstep, voffB);
            PG8_WAIT_V(6); PG8_BAR; PG8_MMA(1, 1, At, B1); PG8_BAR;
            }
        }
        if constexpr (ALIGN_EPI) { if (wr == 0) PG8_BAR; }
        if constexpr (!Epi::AFTER_DRAIN) { E(acc, cur, wr, wc, fr, fq); S.done(cur); }
        if (!has_next) break;
        if (!(Epi::KEEP_ACC && cur.seg == 0))
#pragma unroll
        for (int a = 0; a < 2; ++a)
#pragma unroll
            for (int b = 0; b < 2; ++b)
#pragma unroll
                for (int m = 0; m < 4; ++m)
#pragma unroll
                    for (int n = 0; n < 2; ++n) acc[a][b][m][n] = (f32x4){0.f, 0.f, 0.f, 0.f};
        cur = nxt; cA = nA; cB = nB; ++ui;
        if constexpr (ALIGN_EPI) { if (wr == 1) PG8_BAR; }
    }
    PG8_WAIT_V(0);
    if constexpr (!ALIGN_EPI) { if (wr == 0) PG8_BAR; }
    PG8_BAR;
    if constexpr (Epi::AFTER_DRAIN) { E.fused(acc, cur, wr, wc, fr, fq, lds, wid, lane); S.done(cur); }
#undef PG8_SA
#undef PG8_SB
#undef PG8_STAGE
#undef PG8_LDA
#undef PG8_LDB
#undef PG8_MMA
#undef PG8_WAIT_V
#undef PG8_WAIT_L
#undef PG8_BAR
#undef PG8_SCHED
}
}
#define GAS __attribute__((address_space(1)))
#define LAS __attribute__((address_space(3)))
typedef unsigned short bf16;
typedef unsigned v4u __attribute__((ext_vector_type(4)));
typedef float f32x4 __attribute__((ext_vector_type(4)));
typedef short bf16x8 __attribute__((ext_vector_type(8)));
typedef GAS unsigned gu32;
typedef GAS unsigned long long gu64;
#define RLX_AGENT __ATOMIC_RELAXED, __HIP_MEMORY_SCOPE_AGENT
#define LDS_WAIT() asm volatile("s_waitcnt lgkmcnt(0)" ::: "memory")
#define VM_WAIT() asm volatile("s_waitcnt vmcnt(0)" ::: "memory")
__device__ __forceinline__ unsigned long long rt() { return __builtin_amdgcn_s_memrealtime(); }
__device__ __forceinline__ unsigned f2bf(float f) { unsigned u = __builtin_bit_cast(unsigned, f); return (u + 0x7fffu + ((u >> 16) & 1u)) >> 16; }
__device__ __forceinline__ unsigned pk2(float lo, float hi) { return f2bf(lo) | (f2bf(hi) << 16); }

#define XB_TMO      128
#define XB_XCNT(j)  (256  + 64 * (j))
#define XB_XSUB(j)  (1280 + 64 * (j))
#define XB_XGEN(j)  (2304 + 64 * (j))
#define XB_TOP      3328
#define XB_TOPGEN   3392
#define XCD_BAR_WORDS 3456
#define XB_SPIN_CAP (1u << 18)

__device__ __forceinline__ unsigned xb_ld(unsigned* p)              { return __hip_atomic_load(p, __ATOMIC_RELAXED, __HIP_MEMORY_SCOPE_AGENT); }
__device__ __forceinline__ unsigned xb_add(unsigned* p, unsigned v) { return __hip_atomic_fetch_add(p, v, __ATOMIC_RELAXED, __HIP_MEMORY_SCOPE_AGENT); }
__device__ __forceinline__ unsigned xb_xcc_id() { return (unsigned)__builtin_amdgcn_s_getreg((3 << 11) | 20) & 0xFu; }
#define XB_SPIN(cond, bar) do { unsigned _sp = 0; while (cond) { __builtin_amdgcn_s_sleep(1); \
    if ((++_sp & 255u) == 0u) { if (xb_ld(&(bar)[XB_TMO])) break; if (_sp > XB_SPIN_CAP) { atomicAdd(&(bar)[XB_TMO], 1u); break; } } } } while (0)

struct XcdBarrier {
    unsigned* bar; unsigned x;
    volatile LAS unsigned* st;
};

__device__ __forceinline__ XcdBarrier xcd_barrier_post(unsigned* bar, volatile LAS unsigned* st) {
    XcdBarrier b; b.bar = bar; b.x = xb_xcc_id(); b.st = st;
    if (threadIdx.x == 0) (void)xb_add(&bar[XB_XCNT(b.x)], 1u);
    return b;
}
__device__ __forceinline__ void xcd_barrier_complete(unsigned* bar, unsigned x, unsigned& nloc, unsigned& nx) {
    const unsigned G = gridDim.x * gridDim.y * gridDim.z;
    unsigned sum, cnt, mine, sp = 0u;
    for (;;) {
        sum = 0u; cnt = 0u; mine = 0u;
#pragma unroll
        for (unsigned j = 0; j < 16; ++j) { const unsigned c = xb_ld(&bar[XB_XCNT(j)]); sum += c; cnt += (c > 0u) ? 1u : 0u; mine = (j == x) ? c : mine; }
        if (sum == G) break;
        __builtin_amdgcn_s_sleep(1);
        if ((++sp & 255u) == 0u) { if (xb_ld(&bar[XB_TMO])) break; if (sp > XB_SPIN_CAP) { atomicAdd(&bar[XB_TMO], 1u); break; } }
    }
    nloc = mine > 0u ? mine : 1u; nx = cnt > 0u ? cnt : 1u;
}

__device__ __forceinline__ void xcd_barrier(const XcdBarrier& b) {
    asm volatile("s_waitcnt vmcnt(0)" ::: "memory");
    __syncthreads();
    if (threadIdx.x == 0) {
        unsigned* bar = b.bar;
        __builtin_amdgcn_s_waitcnt(0);
        unsigned nloc = b.st[0], nx = b.st[1];
        if (nloc == 0u) { xcd_barrier_complete(bar, b.x, nloc, nx); b.st[0] = nloc; b.st[1] = nx; }
        const unsigned old = xb_add(&bar[XB_XSUB(b.x)], 1u);
        const unsigned gen = old / nloc;
        if (old + 1u == (gen + 1u) * nloc) {
            __builtin_amdgcn_fence(__ATOMIC_RELEASE, "agent");
            asm volatile("s_waitcnt vmcnt(0)" ::: "memory");
            const unsigned og = xb_add(&bar[XB_TOP], 1u);
            const unsigned tg = og / nx;
            if (og + 1u == (tg + 1u) * nx) xb_add(&bar[XB_TOPGEN], 1u);
            else XB_SPIN(xb_ld(&bar[XB_TOPGEN]) == tg, bar);
            __builtin_amdgcn_fence(__ATOMIC_ACQUIRE, "agent");
            xb_add(&bar[XB_XGEN(b.x)], 1u);
            asm volatile("s_waitcnt vmcnt(0)" ::: "memory");
        } else {
            XB_SPIN(xb_ld(&bar[XB_XGEN(b.x)]) == gen, bar);
            __builtin_amdgcn_fence(__ATOMIC_ACQUIRE, "agent");
            asm volatile("s_waitcnt vmcnt(0)" ::: "memory");
        }
    }
    __syncthreads();
}
constexpr int NWAVES = 8;
constexpr int BATCH = 4, T = 4096, D = 1024, M = BATCH * T;
constexpr int RWC = 1792;
constexpr int NG1 = 5376;
constexpr float NORM_EPS = 1e-6f, GN_EPS = 64e-5f;
constexpr float LOG2E = 1.4426950408889634f;
constexpr int N_PHASES = 13;
#ifndef MK_ONE_LAUNCH
#define MK_ONE_LAUNCH 0
#endif
#ifndef REP_MASK
#define REP_MASK 0
#endif
#ifndef DBG_SEL
#define DBG_SEL -1
#endif
#ifndef NSA_SKIP
#define NSA_SKIP 0
#endif
#ifndef P3REP
#define P3REP 1
#endif
#ifndef SCAN_BLOCKS
#define SCAN_BLOCKS 128
#endif

constexpr size_t MiB = 1u << 20;
constexpr size_t WS_CTL = 0, CTL_ZERO_BYTES = 1 * MiB;
constexpr size_t WS_WIN = 1 * MiB;
constexpr size_t WS_WA = 12 * MiB, WS_WB = 13 * MiB;
constexpr size_t WS_WOUT = 14 * MiB;
constexpr size_t WS_WQ = 16 * MiB;
constexpr size_t WS_CW1K = 20 * MiB, WS_CW1V = 21 * MiB;
constexpr size_t WS_CW2K = 22 * MiB, WS_CW2V = 22 * MiB + 65536;
constexpr size_t WS_SK1 = 22 * MiB + 131072, WS_SK2 = 22 * MiB + 196608;
constexpr size_t WS_WUT = 22 * MiB + 262144, WS_AUT = WS_WUT + 65536, WS_GUT = WS_WUT + 131072;
constexpr size_t WS_BND = 23 * MiB;
constexpr size_t WS_KC = 25 * MiB;
constexpr size_t WS_VCT = 25 * MiB + 262144;
constexpr size_t WS_H = 26 * MiB;
constexpr size_t WS_PRW = 58 * MiB;
constexpr size_t WS_MG = 170 * MiB;
constexpr size_t WS_VST = 234 * MiB, WS_VWT = 238 * MiB;
constexpr size_t WS_END = 256 * MiB;
constexpr size_t DO_PNSA = 0, DO_G = 40 * MiB, DO_GLOG = 56 * MiB;
constexpr int CW_TMO = 0, CW_CODE = 1, CW_NSAQ = 64, CW_SCANP = 2048, CW_PEERQ = 4160, CW_BAR = 8192;

constexpr int RING_OFF = 0, RING_BYTES = 131072;
constexpr int LDSCTL_OFF = RING_BYTES, MISC_OFF = LDSCTL_OFF + 320;
constexpr int LDS_BYTES = 147456;
typedef unsigned short u16;
typedef unsigned u32x2 __attribute__((ext_vector_type(2)));
struct Frame {
    LAS unsigned char* lds;
    volatile LAS unsigned* MISC;
    gu32* ctl;
    int tid, lane, wave, vcu, G;
    const float* in[33];
    float* out; unsigned char* ws;
};
__device__ __forceinline__ float wave_sum(float v) {
#pragma unroll
    for (int o = 1; o < 64; o <<= 1) v += __shfl_xor(v, o);
    return v;
}
template <int CTRL> __device__ __forceinline__ float dppf(float x) { return __builtin_bit_cast(float, __builtin_amdgcn_update_dpp(0, __builtin_bit_cast(int, x), CTRL, 0xf, 0xf, true)); }
__device__ __forceinline__ float bf2f(u16 b) { return __uint_as_float((unsigned)b << 16); }
__device__ __forceinline__ float bflo(unsigned w) { return __uint_as_float(w << 16); }
__device__ __forceinline__ float bfhi(unsigned w) { return __uint_as_float(w & 0xffff0000u); }
__device__ __forceinline__ u16 f2b(float f) { return (u16)pg8::cvt_pk_bf16(f, 0.f); }
#define pk2(lo_, hi_) pg8::cvt_pk_bf16((lo_), (hi_))
__device__ __forceinline__ float sigmf(float x) { return __builtin_amdgcn_rcpf(1.0f + __expf(-x)); }
__device__ __forceinline__ float tanh_fast(float x) { return 1.0f - 2.0f * __builtin_amdgcn_rcpf(1.0f + __expf(2.0f * x)); }
__device__ __forceinline__ f32x4 mfma16(const bf16x8 a, const bf16x8 b, const f32x4 c) { return __builtin_amdgcn_mfma_f32_16x16x32_bf16(a, b, c, 0, 0, 0); }
__device__ __forceinline__ bf16x8 as_bf16x8(const v4u v) { return __builtin_bit_cast(bf16x8, v); }

__device__ __forceinline__ void tr_item(const float* W, int K, int ldw, int sc0, int nblk, int ncols_valid, bf16* WT, int dr0, LAS float* scr, int item, int lane) {
    const int kb = item / nblk, nb = item % nblk, k0 = 64 * kb, n0 = 32 * nb;
#pragma unroll 8
    for (int i = 0; i < 32; ++i) { const int kk = 2 * i + (lane >> 5); const int n = n0 + (lane & 31); const int nc = (n < ncols_valid) ? n : 0;
        const float v = W[(size_t)(k0 + kk) * ldw + sc0 + nc]; scr[kk * 33 + (lane & 31)] = (n < ncols_valid) ? v : 0.f; }
    LDS_WAIT(); asm volatile("" ::: "memory");
    const int c = lane & 7;
#pragma unroll
    for (int j = 0; j < 4; ++j) { const int n = (lane >> 3) + 8 * j; const LAS float* s = scr + (8 * c) * 33 + n;
        v4u o; o.x = pk2(s[0 * 33], s[1 * 33]); o.y = pk2(s[2 * 33], s[3 * 33]); o.z = pk2(s[4 * 33], s[5 * 33]); o.w = pk2(s[6 * 33], s[7 * 33]);
        *(GAS v4u*)(WT + (size_t)(dr0 + n0 + n) * K + k0 + 8 * c) = o; }
    LDS_WAIT(); asm volatile("" ::: "memory");
}
__device__ __forceinline__ void rms_row_to_bf16(int lane, const float* xrow, const float* gain, bf16* orow) {
    const GAS f32x4* xr = (const GAS f32x4*)xrow + lane; const GAS f32x4* gr = (const GAS f32x4*)gain + lane;
    f32x4 v[4]; float s2 = 0.f;
#pragma unroll
    for (int j = 0; j < 4; ++j) { v[j] = xr[64 * j]; s2 += (v[j].x * v[j].x + v[j].y * v[j].y) + (v[j].z * v[j].z + v[j].w * v[j].w); }
    const float rstd = 1.f / sqrtf(wave_sum(s2) * (1.f / D) + NORM_EPS);
    GAS unsigned long long* o8 = (GAS unsigned long long*)orow + lane;
#pragma unroll
    for (int j = 0; j < 4; ++j) { const f32x4 g = gr[64 * j];
        o8[64 * j] = (unsigned long long)pk2(v[j].x * rstd * g.x, v[j].y * rstd * g.y) | ((unsigned long long)pk2(v[j].z * rstd * g.z, v[j].w * rstd * g.w) << 32); }
}
__device__ __forceinline__ void p0_prologue(const Frame& F) {
    LAS float* scr = (LAS float*)(F.lds + RING_OFF + F.wave * 16384);
    const int gw = F.vcu * NWAVES + F.wave, NGW = F.G * NWAVES;
    unsigned char* ws = F.ws;
    constexpr int I0 = 16 * 96, I1 = 16 * 64, I2 = 16 * 8, I3 = 8 * 32, I4 = 8 * 32, I5 = 16 * 32, I6 = 16 * 64, I7 = 32 * 8, I8 = 32 * 8, I9 = 4 * 2, I10 = 4 * 2, I11 = 16, I12 = 16, I13 = 32;
    constexpr int NITEMS = I0 + I1 + I2 + I3 + I4 + I5 + I6 + I7 + I8 + I9 + I10 + I11 + I12 + I13;
    for (int it = gw; it < NITEMS; it += NGW) {
        int r = it;
        if (r < I0) { tr_item(F.in[2], 1024, 5144, 0, 96, 3072, (bf16*)(ws + WS_WIN), 0, scr, r, F.lane); continue; } r -= I0;
        if (r < I1) { tr_item(F.in[2], 1024, 5144, 3096, 64, 2048, (bf16*)(ws + WS_WIN), 3072, scr, r, F.lane); continue; } r -= I1;
        if (r < I2) { tr_item(F.in[2], 1024, 5144, 3072, 8, 24, (bf16*)(ws + WS_WIN), 5120, scr, r, F.lane); continue; } r -= I2;
        if (r < I3) { tr_item(F.in[24], 512, 1024, 0, 32, 1024, (bf16*)(ws + WS_WA), 0, scr, r, F.lane); continue; } r -= I3;
        if (r < I4) { tr_item(F.in[25], 512, 1024, 0, 32, 1024, (bf16*)(ws + WS_WB), 0, scr, r, F.lane); continue; } r -= I4;
        if (r < I5) { tr_item(F.in[26], 1024, 1024, 0, 32, 1024, (bf16*)(ws + WS_WOUT), 0, scr, r, F.lane); continue; } r -= I5;
        if (r < I6) { tr_item(F.in[28], 1024, 2048, 0, 64, 2048, (bf16*)(ws + WS_WQ), 0, scr, r, F.lane); continue; } r -= I6;
        if (r < I7) { tr_item(F.in[20], 2048, 256, 0, 8, 256, (bf16*)(ws + WS_CW1K), 0, scr, r, F.lane); continue; } r -= I7;
        if (r < I8) { tr_item(F.in[22], 2048, 256, 0, 8, 256, (bf16*)(ws + WS_CW1V), 0, scr, r, F.lane); continue; } r -= I8;
        if (r < I9) { tr_item(F.in[21], 256, 64, 0, 2, 64, (bf16*)(ws + WS_CW2K), 0, scr, r, F.lane); continue; } r -= I9;
        if (r < I10) { tr_item(F.in[23], 256, 64, 0, 2, 64, (bf16*)(ws + WS_CW2V), 0, scr, r, F.lane); continue; } r -= I10;
        if (r < I11) { tr_item(F.in[5], 64, 512, 0, 16, 512, (bf16*)(ws + WS_WUT), 0, scr, r, F.lane); continue; } r -= I11;
        if (r < I12) { tr_item(F.in[7], 64, 512, 0, 16, 512, (bf16*)(ws + WS_AUT), 0, scr, r, F.lane); continue; } r -= I12;
        tr_item(F.in[8], 128, 512, 0, 16, 512, (bf16*)(ws + WS_GUT), 0, scr, r, F.lane);
    }
    { const int gt = F.vcu * (NWAVES * 64) + F.tid, NT = F.G * NWAVES * 64;
      bf16* s1 = (bf16*)(ws + WS_SK1); bf16* s2 = (bf16*)(ws + WS_SK2);
      for (int i = gt; i < 128 * 128; i += NT) { s1[i] = f2b(F.in[29][i]); s2[i] = f2b(F.in[30][i]); } }
    for (int m = gw; m < M; m += NGW) rms_row_to_bf16(F.lane, F.in[0] + (size_t)m * D, F.in[1], (bf16*)(ws + WS_H) + (size_t)m * D);
}
constexpr int REC_BYTES = 12800;
__device__ __forceinline__ void rwkv_prep_tile(const Frame& F, int u) {
    const int tid = F.tid, lane = F.lane, h = F.wave, r16 = lane & 15, q4 = lane >> 4;
    const int R0 = 64 * u, t0 = R0 & (T - 1);
    LAS bf16* linb = (LAS bf16*)(F.lds);
    LAS bf16* mats = (LAS bf16*)(F.lds + 16384) + h * 4096;
    LAS float* abl = (LAS float*)(F.lds + 16384 + 65536) + h * 272;
    float* PRW = (float*)(F.ws + WS_PRW);
    const float* BND = (const float*)(F.ws + WS_BND);
    bf16* G = (bf16*)((unsigned char*)F.out + DO_G);
    const float* mu = F.in[3];
    const float mu_r = mu[tid], mu_k = mu[512 + tid], mu_v = mu[1024 + tid], mu_l = (tid < 256) ? mu[1536 + tid] : 0.f;
    const float w0c = F.in[4][tid], a0c = F.in[6][tid], kkc = F.in[9][tid], kac = F.in[10][tid], rkc = F.in[11][tid];
    const float* w_up = F.in[5]; const float* a_up = F.in[7]; const float* g_up = F.in[8];
    float pr = 0.f, pk = 0.f, pv = 0.f, pl = 0.f;
    if (t0 != 0) { const float* b = BND + (size_t)(u - 1) * RWC; pr = b[tid]; pk = b[512 + tid]; pv = b[1024 + tid]; if (tid < 256) pl = b[1536 + tid]; }
    for (int batch = 0; batch < 4; ++batch) {
        const int Rb = R0 + 16 * batch;
        if (DBG_SEL == 30 && batch == 0 && blockIdx.x == 0 && tid == 0) F.MISC[20] = (unsigned)__builtin_amdgcn_s_memrealtime();
        float xr[16], xk[16]; unsigned vtw[8];
        if (tid < 256) { float xl[16];
#pragma unroll
            for (int j = 0; j < 16; ++j) xl[j] = PRW[(size_t)(Rb + j) * RWC + 1536 + tid];
#pragma unroll
            for (int j = 0; j < 16; ++j) { const float n = xl[j]; const float v = n + (pl - n) * mu_l; pl = n; const float f = (tid < 64) ? tanh_fast(v) : ((tid < 128) ? v : sigmf(v)); linb[j * 256 + tid] = f2b(f); } }
        { float xv[16];
#pragma unroll
          for (int j = 0; j < 16; ++j) { const float* p = PRW + (size_t)(Rb + j) * RWC; xr[j] = p[tid]; xk[j] = p[512 + tid]; xv[j] = p[1024 + tid]; }
          VM_WAIT();
#pragma unroll
          for (int j = 0; j < 16; ++j) { float n;
              n = xr[j]; xr[j] = n + (pr - n) * mu_r; pr = n;
              n = xk[j]; xk[j] = n + (pk - n) * mu_k; pk = n;
              n = xv[j]; const unsigned vb = f2bf(n + (pv - n) * mu_v); pv = n;
              if (j & 1) vtw[j >> 1] |= vb << 16; else vtw[j >> 1] = vb; } }
        __syncthreads();
        if ((DBG_SEL == 30 || DBG_SEL == 31) && batch == 0 && blockIdx.x == 0 && tid == 0) F.MISC[20 + (DBG_SEL == 30)] = (unsigned)__builtin_amdgcn_s_memrealtime();
        float accw[16], acca[16], accg[16];
        { const bf16* WUT = (const bf16*)(F.ws + WS_WUT); const bf16* AUT = (const bf16*)(F.ws + WS_AUT); const bf16* GUT = (const bf16*)(F.ws + WS_GUT);
          const f32x4 Z4 = {0.f, 0.f, 0.f, 0.f};
          bf16x8 af[8];
#pragma unroll
          for (int ks = 0; ks < 8; ++ks) af[ks] = as_bf16x8(*(const LAS v4u*)(linb + r16 * 256 + 32 * ks + 8 * q4));
          LAS float* ow = (LAS float*)mats;
#pragma unroll
          for (int nt = 0; nt < 4; ++nt) { const int col = 64 * h + 16 * nt + r16;
              f32x4 cw = Z4, ca = Z4, cg = Z4;
#pragma unroll
              for (int ks = 0; ks < 2; ++ks) { cw = mfma16(af[ks], as_bf16x8(*(const v4u*)(WUT + (size_t)col * 64 + 32 * ks + 8 * q4)), cw); ca = mfma16(af[2 + ks], as_bf16x8(*(const v4u*)(AUT + (size_t)col * 64 + 32 * ks + 8 * q4)), ca); }
#pragma unroll
              for (int ks = 0; ks < 4; ++ks) cg = mfma16(af[4 + ks], as_bf16x8(*(const v4u*)(GUT + (size_t)col * 128 + 32 * ks + 8 * q4)), cg);
#pragma unroll
              for (int r = 0; r < 4; ++r) { const int tok = 4 * q4 + r; ow[tok * 64 + 16 * nt + r16] = cw[r]; ow[1024 + tok * 64 + 16 * nt + r16] = ca[r]; G[(size_t)(Rb + tok) * 512 + col] = f2b(cg[r]); } }
          LDS_WAIT(); asm volatile("" ::: "memory");
#pragma unroll
          for (int j = 0; j < 16; ++j) { accw[j] = ow[j * 64 + lane]; acca[j] = ow[1024 + j * 64 + lane]; }
          LDS_WAIT(); asm volatile("" ::: "memory"); }
        if ((DBG_SEL == 31 || DBG_SEL == 32) && batch == 0 && blockIdx.x == 0 && tid == 0) F.MISC[20 + (DBG_SEL == 31)] = (unsigned)__builtin_amdgcn_s_memrealtime();
        unsigned char* rec = (unsigned char*)(PRW + (size_t)Rb * RWC) + h * REC_BYTES;
#pragma unroll
        for (int j = 0; j < 16; ++j) {
            const float z = -(w0c + accw[j]); const float sp = fmaxf(z, 0.f) + __logf(1.0f + __expf(-fabsf(z)));
            const float e = __expf(-sp - 0.5f); accw[j] = __expf(-e);
            const float a = sigmf(a0c + acca[j]); acca[j] = a;
            const float kkv = xk[j] * kkc; xk[j] = xk[j] * (1.f + (a - 1.f) * kac);
            const float ss = wave_sum(kkv * kkv); accg[j] = kkv * rsqrtf(fmaxf(ss, 1e-24f));
            const float bon = wave_sum(xr[j] * xk[j] * rkc);
            if (lane == 0) *(float*)(rec + 12544 + 4 * j) = bon; __builtin_amdgcn_sched_barrier(0); }
        { float g = 1.f; unsigned bhw[8], khw[8];
          LAS bf16* mp = mats + lane;
#pragma unroll
          for (int j = 0; j < 16; ++j) { const float gp = g; g *= accw[j]; const float ig = __builtin_amdgcn_rcpf(g);
              const unsigned w1 = pg8::cvt_pk_bf16(accg[j] * gp, xr[j] * g), w2 = pg8::cvt_pk_bf16(accg[j] * acca[j] * ig, xk[j] * ig);
              mp[j * 64] = (u16)(w1 & 0xffffu); mp[1024 + j * 64] = (u16)(w1 >> 16); mp[2048 + j * 64] = (u16)(w2 & 0xffffu); mp[3072 + j * 64] = (u16)(w2 >> 16);
              if (j & 1) { bhw[j >> 1] |= w2 << 16; khw[j >> 1] |= w2 & 0xffff0000u; } else { bhw[j >> 1] = w2 & 0xffffu; khw[j >> 1] = w2 >> 16; } }
          *(float*)(rec + 12288 + 4 * lane) = g;
          v4u* bp = (v4u*)(rec + 4096 + lane * 32); bp[0] = (v4u){bhw[0], bhw[1], bhw[2], bhw[3]}; bp[1] = (v4u){bhw[4], bhw[5], bhw[6], bhw[7]};
          v4u* kp = (v4u*)(rec + 6144 + lane * 32); kp[0] = (v4u){khw[0], khw[1], khw[2], khw[3]}; kp[1] = (v4u){khw[4], khw[5], khw[6], khw[7]};
          v4u* vp = (v4u*)(rec + 8192 + lane * 32); vp[0] = (v4u){vtw[0], vtw[1], vtw[2], vtw[3]}; vp[1] = (v4u){vtw[4], vtw[5], vtw[6], vtw[7]}; }
        LDS_WAIT(); asm volatile("" ::: "memory");
#pragma unroll
        for (int i = 0; i < 2; ++i) { const int pi = lane + 64 * i, s = pi >> 3, ks = (pi >> 2) & 1, qq = pi & 3;
#pragma unroll
            for (int mtx = 0; mtx < 2; ++mtx) { const LAS bf16* src = mats + mtx * 1024 + s * 64 + 32 * ks + 4 * qq;
                const u32x2 lo = *(const LAS u32x2*)src, hi = *(const LAS u32x2*)(src + 16);
                *(v4u*)(rec + mtx * 2048 + pi * 16) = (v4u){lo.x, lo.y, hi.x, hi.y}; } }
        LDS_WAIT(); asm volatile("" ::: "memory");
        { f32x4 Ab = {0.f, 0.f, 0.f, 0.f}, Ak = Ab, Mb = Ab, Mk = Ab;
#pragma unroll
          for (int ks = 0; ks < 2; ++ks) { const int off = r16 * 64 + 32 * ks + 8 * q4;
              const bf16x8 aK = as_bf16x8(*(const LAS v4u*)(mats + off)), aR = as_bf16x8(*(const LAS v4u*)(mats + 1024 + off)), bB = as_bf16x8(*(const LAS v4u*)(mats + 2048 + off)), bK = as_bf16x8(*(const LAS v4u*)(mats + 3072 + off));
              Ab = mfma16(aK, bB, Ab); Ak = mfma16(aK, bK, Ak); Mb = mfma16(aR, bB, Mb); Mk = mfma16(aR, bK, Mk); }
          bf16* rAk = (bf16*)(rec + 10240); bf16* rMb = (bf16*)(rec + 11264); bf16* rMk = (bf16*)(rec + 11776);
#pragma unroll
          for (int r = 0; r < 4; ++r) { const int s = 4 * q4 + r, j = r16; const bool lo = j < s, le = j <= s;
              abl[s * 17 + j] = lo ? Ab[r] : 0.f; rAk[s * 16 + j] = f2b(lo ? Ak[r] : 0.f); rMb[s * 16 + j] = f2b(le ? Mb[r] : 0.f); rMk[s * 16 + j] = f2b(le ? Mk[r] : 0.f); } }
        LDS_WAIT(); asm volatile("" ::: "memory");
        { float Tr[16]; bf16* rT = (bf16*)(rec + 10752);
#pragma unroll
          for (int s = 0; s < 16; ++s) { float t = (r16 == s) ? 1.f : 0.f;
#pragma unroll
              for (int j = 0; j < s; ++j) t -= abl[s * 17 + j] * Tr[j];
              Tr[s] = t; if (lane < 16) rT[s * 16 + r16] = f2b(-t); __builtin_amdgcn_sched_barrier(0); } }
        __syncthreads();
        if (DBG_SEL == 32 && batch == 0 && blockIdx.x == 0 && tid == 0) F.MISC[21] = (unsigned)__builtin_amdgcn_s_memrealtime();
    }
}
__device__ __forceinline__ void nsa_prep_tile(const Frame& F, int u) {
    const int lane = F.lane, w = F.wave;
    const int R0 = 64 * u, t0 = R0 & (T - 1), b = R0 / T;
    bf16* PNSA = (bf16*)((unsigned char*)F.out + DO_PNSA);
    const float qg = F.in[14][lane] * (0.125f * LOG2E);
    const float kg = (w < 2) ? F.in[16][lane] : F.in[17][lane];
    const int kcol = ((w < 2) ? 768 : 1024) + (w & 1) * 64 + lane;
#pragma unroll 1
    for (int tg = 0; tg < 4; ++tg) { float qv[16], kv[16];
#pragma unroll
        for (int i = 0; i < 16; ++i) { const bf16* p = PNSA + (size_t)(R0 + 16 * tg + i) * 1280; qv[i] = bf2f(p[w * 64 + lane]); kv[i] = (w < 4) ? bf2f(p[kcol]) : 0.f; }
#pragma unroll
        for (int i = 0; i < 16; ++i) { bf16* p = PNSA + (size_t)(R0 + 16 * tg + i) * 1280;
            const float ss = wave_sum(qv[i] * qv[i]) * (1.f / 64.f);
            p[w * 64 + lane] = f2b(qv[i] * rsqrtf(ss + NORM_EPS) * qg);
            if (w < 4) { const float ks = wave_sum(kv[i] * kv[i]) * (1.f / 64.f); p[kcol] = f2b(kv[i] * rsqrtf(ks + NORM_EPS) * kg); } } }
    if (w >= 4) {
        const int g = w & 1; const int scol = ((w < 6) ? 896 : 1152) + g * 64;
        bf16* VT = (bf16*)(F.ws + ((w < 6) ? WS_VST : WS_VWT)) + (size_t)((b * 2 + g) * 64) * T + (size_t)((t0 + lane) >> 5) * 2048 + ((t0 + lane) & 31);
        const v4u* src = (const v4u*)(PNSA + (size_t)(R0 + lane) * 1280 + scol);
        v4u v[8];
#pragma unroll
        for (int i = 0; i < 8; ++i) v[i] = src[i];
#pragma unroll
        for (int i = 0; i < 8; ++i) {
            VT[(8 * i + 0) * 32] = (u16)(v[i].x & 0xffffu); VT[(8 * i + 1) * 32] = (u16)(v[i].x >> 16);
            VT[(8 * i + 2) * 32] = (u16)(v[i].y & 0xffffu); VT[(8 * i + 3) * 32] = (u16)(v[i].y >> 16);
            VT[(8 * i + 4) * 32] = (u16)(v[i].z & 0xffffu); VT[(8 * i + 5) * 32] = (u16)(v[i].z >> 16);
            VT[(8 * i + 6) * 32] = (u16)(v[i].w & 0xffffu); VT[(8 * i + 7) * 32] = (u16)(v[i].w >> 16); }
    }
}
__device__ __forceinline__ float gelu_tanh(float x) { const float t = 0.7978845608028654f * (x + 0.044715f * x * x * x); return 0.5f * x * (1.f + tanh_fast(t)); }
__device__ __forceinline__ void compress_unit(const Frame& F, int u) {
    const int lane = F.lane, w = F.wave, r16 = lane & 15, q4 = lane >> 4;
    const int kvsel = u >> 7, b = (u >> 5) & 3, g = (u >> 4) & 1, ntile = u & 15;
    const bf16* X = (const bf16*)((unsigned char*)F.out + DO_PNSA) + (size_t)(b * T) * 1280 + (kvsel ? 640 : 512) + g * 64;
    const float* pos = kvsel ? F.in[19] : F.in[18];
    const bf16* W1t = (const bf16*)(F.ws + (kvsel ? WS_CW1V : WS_CW1K));
    const bf16* W2t = (const bf16*)(F.ws + (kvsel ? WS_CW2V : WS_CW2K));
    LAS bf16* hid = (LAS bf16*)(F.lds);
    LAS float* outb = (LAS float*)(F.lds + 16 * 528);
    int n = 16 * ntile + r16; if (n > 254) n = 254;
    f32x4 acc[2] = {{0.f, 0.f, 0.f, 0.f}, {0.f, 0.f, 0.f, 0.f}};
#pragma unroll 4
    for (int s = 0; s < 64; ++s) { const int lp = s >> 1, d0 = (s & 1) * 32 + 8 * q4;
        const v4u xa = *(const v4u*)(X + (size_t)(16 * n + lp) * 1280 + d0);
        const f32x4 p0 = *(const f32x4*)(pos + lp * 64 + d0), p1 = *(const f32x4*)(pos + lp * 64 + d0 + 4);
        v4u af; af.x = pk2(bflo(xa.x) + p0[0], bfhi(xa.x) + p0[1]); af.y = pk2(bflo(xa.y) + p0[2], bfhi(xa.y) + p0[3]);
        af.z = pk2(bflo(xa.z) + p1[0], bfhi(xa.z) + p1[1]); af.w = pk2(bflo(xa.w) + p1[2], bfhi(xa.w) + p1[3]);
#pragma unroll
        for (int nt = 0; nt < 2; ++nt) { const v4u bfg = *(const v4u*)(W1t + (size_t)(32 * w + 16 * nt + r16) * 2048 + 32 * s + 8 * q4);
            acc[nt] = mfma16(as_bf16x8(af), as_bf16x8(bfg), acc[nt]); } }
#pragma unroll
    for (int nt = 0; nt < 2; ++nt)
#pragma unroll
        for (int r = 0; r < 4; ++r) hid[(4 * q4 + r) * 264 + 32 * w + 16 * nt + r16] = f2b(gelu_tanh(acc[nt][r]));
    __syncthreads();
    if (w < 4) { f32x4 a2 = {0.f, 0.f, 0.f, 0.f};
#pragma unroll
        for (int s = 0; s < 8; ++s) { const v4u af = *(const LAS v4u*)(hid + r16 * 264 + 32 * s + 8 * q4);
            const v4u bfg = *(const v4u*)(W2t + (size_t)(16 * w + r16) * 256 + 32 * s + 8 * q4);
            a2 = mfma16(as_bf16x8(af), as_bf16x8(bfg), a2); }
#pragma unroll
        for (int r = 0; r < 4; ++r) outb[(4 * q4 + r) * 64 + 16 * w + r16] = a2[r]; }
    __syncthreads();
#pragma unroll
    for (int rr = 0; rr < 2; ++rr) { const int row = 2 * w + rr; const int nn = 16 * ntile + row; float val = outb[row * 64 + lane];
        if (kvsel == 0) { const float ss = wave_sum(val * val) * (1.f / 64.f); val = val * rsqrtf(ss + NORM_EPS) * F.in[15][lane];
            ((bf16*)(F.ws + WS_KC))[(size_t)((b * 2 + g) * 256 + nn) * 64 + lane] = (nn < 255) ? f2b(val) : (u16)0; }
        else ((bf16*)(F.ws + WS_VCT))[(size_t)((b * 2 + g) * 64 + lane) * 256 + nn] = (nn < 255) ? f2b(val) : (u16)0; }
    __syncthreads();
}
__device__ __forceinline__ bf16x8 pack_p(const f32x4 a, const f32x4 b) {
    v4u w; w.x = pg8::cvt_pk_bf16(a[0], a[1]); w.y = pg8::cvt_pk_bf16(a[2], a[3]); w.z = pg8::cvt_pk_bf16(b[0], b[1]); w.w = pg8::cvt_pk_bf16(b[2], b[3]); return as_bf16x8(w);
}
#define NSA_FENCE() asm volatile("s_waitcnt lgkmcnt(0)" ::: "memory")
struct KFr { bf16x8 a0, a1, b0, b1; };
struct VFr { bf16x8 v[4]; };
__device__ __forceinline__ KFr lds_k(const LAS unsigned char* ks, int r16, int q4) {
    const int rA = 8 * (r16 >> 2) + (r16 & 3), rB = rA + 4; const int xA = (rA >> 1) & 7, xB = (rB >> 1) & 7;
    KFr f; f.a0 = as_bf16x8(*(const LAS v4u*)(ks + rA * 128 + ((q4 ^ xA) << 4))); f.a1 = as_bf16x8(*(const LAS v4u*)(ks + rA * 128 + (((4 + q4) ^ xA) << 4)));
    f.b0 = as_bf16x8(*(const LAS v4u*)(ks + rB * 128 + ((q4 ^ xB) << 4))); f.b1 = as_bf16x8(*(const LAS v4u*)(ks + rB * 128 + (((4 + q4) ^ xB) << 4))); return f;
}
__device__ __forceinline__ VFr lds_v(const LAS unsigned char* vs, int r16, int q4) {
    VFr f;
#pragma unroll
    for (int dt = 0; dt < 4; ++dt) { const int d = 16 * dt + r16; f.v[dt] = as_bf16x8(*(const LAS v4u*)(vs + d * 64 + ((q4 ^ ((d >> 2) & 3)) << 4))); }
    return f;
}
struct NsaSrc { const bf16* kb; int krs; const bf16* vb; int vrs; int vtiled; };
__device__ __forceinline__ v4u nsa_stage_load(const NsaSrc& S, int k0, int tid) {
    if (tid < 256) return *(const v4u*)(S.kb + (size_t)(k0 + (tid >> 3)) * S.krs + 8 * (tid & 7));
    const int i = tid - 256, d = i >> 2, c = i & 3;
    return S.vtiled ? *(const v4u*)(S.vb + (size_t)(k0 >> 5) * 2048 + d * 32 + 8 * c) : *(const v4u*)(S.vb + (size_t)d * S.vrs + k0 + 8 * c);
}
__device__ __forceinline__ void nsa_stage_write(LAS unsigned char* lds, int slot, int tid, const v4u v) {
    if (tid < 256) { const int r = tid >> 3, c = tid & 7; *(LAS v4u*)(lds + slot * 4096 + r * 128 + ((c ^ ((r >> 1) & 7)) << 4)) = v; }
    else { const int i = tid - 256, d = i >> 2, c = i & 3; *(LAS v4u*)(lds + 8192 + slot * 4096 + d * 64 + ((c ^ ((d >> 2) & 3)) << 4)) = v; }
}
__device__ __forceinline__ void nsa_block_unit(const Frame& F, int b, int g, int T0, int skip) {
    const int lane = F.lane, tid = F.tid, w = F.wave, r16 = lane & 15, q4 = lane >> 4;
    const int t0 = T0 + 8 * w;
    const f32x4 Z4 = {0.f, 0.f, 0.f, 0.f};
    LAS unsigned char* lds = F.lds;
    LAS float* wl = (LAS float*)(lds + 16384 + w * 5120);
    LAS float* impT = wl; LAS float* imp2T = wl + 8 * 65; LAS unsigned* selT = (LAS unsigned*)(wl + 16 * 65);
    LAS unsigned* bw = (LAS unsigned*)(lds + 57344); LAS int* stl = (LAS int*)(lds + 57344 + 128);
    const bf16* PN = (const bf16*)((unsigned char*)F.out + DO_PNSA) + (size_t)(b * T) * 1280;
    const float* GL = (const float*)((unsigned char*)F.out + DO_GLOG) + (size_t)(b * T) * 32;
    bf16x8 qf[2][2]; int tq[2];
#pragma unroll
    for (int mt = 0; mt < 2; ++mt) { tq[mt] = t0 + 4 * mt + (r16 >> 2);
#pragma unroll
        for (int dh = 0; dh < 2; ++dh) qf[mt][dh] = as_bf16x8(*(const v4u*)(PN + (size_t)tq[mt] * 1280 + (g * 4 + (r16 & 3)) * 64 + 32 * dh + 8 * q4)); }
    f32x4 Oc[2][4];
#pragma unroll
    for (int mt = 0; mt < 2; ++mt)
#pragma unroll
        for (int dt = 0; dt < 4; ++dt) Oc[mt][dt] = Z4;
#define NSA_GATE(mt_, r_, br_) sigmf(GL[(size_t)(t0 + 4 * (mt_) + q4) * 32 + g * 12 + (r_) * 3 + (br_)])
#define NSA_PIPE_BEGIN(S_, n_, K0_OF) { v4u st = nsa_stage_load(S_, K0_OF(0), tid); nsa_stage_write(lds, 0, tid, st); if ((n_) > 1) st = nsa_stage_load(S_, K0_OF(1), tid); __syncthreads(); \
        for (int i = 0; i < (n_); ++i) { const int k0 = K0_OF(i); const LAS unsigned char* ks = lds + (i & 1) * 4096; const LAS unsigned char* vs = lds + 8192 + (i & 1) * 4096;
#define NSA_PIPE_END(S_, n_, K0_OF) if (i + 1 < (n_)) nsa_stage_write(lds, (i + 1) & 1, tid, st); if (i + 2 < (n_)) st = nsa_stage_load(S_, K0_OF(i + 2), tid); __syncthreads(); } }

    for (int i = lane; i < 16 * 65; i += 64) wl[i] = 0.f;
    const NsaSrc SC{(const bf16*)(F.ws + WS_KC) + (size_t)((b * 2 + g) * 256) * 64, 64, (const bf16*)(F.ws + WS_VCT) + (size_t)((b * 2 + g) * 64) * 256, 256, 0};
    const int ncb = (T0 + 63 >= 31) ? ((T0 + 63 - 31) >> 4) + 1 : 0; const int nstB = (skip & 1) ? 0 : ((ncb + 31) >> 5);
    const int ncw = (t0 + 7 >= 31) ? ((t0 + 7 - 31) >> 4) + 1 : 0; const int nstW = (skip & 1) ? 0 : ((ncw + 31) >> 5);
    float inv[2] = {0.f, 0.f};
#define K0_LIN(i_) (32 * (i_))
    if (nstB > 0) { float ls[2] = {0.f, 0.f};
        NSA_PIPE_BEGIN(SC, nstB, K0_LIN)
            if (i < nstW) { const KFr kf = lds_k(ks, r16, q4); const bool cslow = 16 * (k0 + 31) + 31 > t0;
#pragma unroll
                for (int mt = 0; mt < 2; ++mt) { f32x4 sA = mfma16(kf.a0, qf[mt][0], Z4); sA = mfma16(kf.a1, qf[mt][1], sA); f32x4 sB = mfma16(kf.b0, qf[mt][0], Z4); sB = mfma16(kf.b1, qf[mt][1], sB);
#pragma unroll
                    for (int r = 0; r < 4; ++r) { const int nA = k0 + 8 * q4 + r, nB = nA + 4;
                        if (cslow) { ls[mt] += (16 * nA + 31 <= tq[mt]) ? __builtin_amdgcn_exp2f(sA[r]) : 0.f; ls[mt] += (16 * nB + 31 <= tq[mt]) ? __builtin_amdgcn_exp2f(sB[r]) : 0.f; }
                        else { ls[mt] += __builtin_amdgcn_exp2f(sA[r]); ls[mt] += __builtin_amdgcn_exp2f(sB[r]); } } } }
        NSA_PIPE_END(SC, nstB, K0_LIN)
#pragma unroll
        for (int mt = 0; mt < 2; ++mt) { float l = ls[mt]; l += __shfl_xor(l, 16); l += __shfl_xor(l, 32); inv[mt] = 1.0f / fmaxf(l, 1e-30f); }
    }
    if (nstB > 0) { f32x4 O[2][4];
#pragma unroll
        for (int mt = 0; mt < 2; ++mt)
#pragma unroll
            for (int dt = 0; dt < 4; ++dt) O[mt][dt] = Z4;
        NSA_PIPE_BEGIN(SC, nstB, K0_LIN)
            if (i < nstW) { const KFr kf = lds_k(ks, r16, q4); const VFr vf = lds_v(vs, r16, q4); const bool cslow = 16 * (k0 + 31) + 31 > t0;
#pragma unroll
                for (int mt = 0; mt < 2; ++mt) { f32x4 sA = mfma16(kf.a0, qf[mt][0], Z4); sA = mfma16(kf.a1, qf[mt][1], sA); f32x4 sB = mfma16(kf.b0, qf[mt][0], Z4); sB = mfma16(kf.b1, qf[mt][1], sB);
                    f32x4 pA, pB;
#pragma unroll
                    for (int r = 0; r < 4; ++r) { const int nA = k0 + 8 * q4 + r, nB = nA + 4;
                        if (cslow) { pA[r] = (16 * nA + 31 <= tq[mt]) ? __builtin_amdgcn_exp2f(sA[r]) * inv[mt] : 0.f; pB[r] = (16 * nB + 31 <= tq[mt]) ? __builtin_amdgcn_exp2f(sB[r]) * inv[mt] : 0.f; }
                        else { pA[r] = __builtin_amdgcn_exp2f(sA[r]) * inv[mt]; pB[r] = __builtin_amdgcn_exp2f(sB[r]) * inv[mt]; } }
                    float vA = pA[0] + pA[1] + pA[2] + 0.5f * pA[3], cA = 0.5f * pA[3], vB = pB[0] + pB[1] + pB[2] + 0.5f * pB[3], cB = 0.5f * pB[3];
                    vA += __shfl_xor(vA, 1); vA += __shfl_xor(vA, 2); cA += __shfl_xor(cA, 1); cA += __shfl_xor(cA, 2);
                    vB += __shfl_xor(vB, 1); vB += __shfl_xor(vB, 2); cB += __shfl_xor(cB, 1); cB += __shfl_xor(cB, 2);
                    if ((lane & 3) == 0) { const int tl = 4 * mt + (r16 >> 2), j = (k0 >> 2) + 2 * q4;
                        impT[tl * 65 + j] = vA; imp2T[tl * 65 + j + 1] = cA; impT[tl * 65 + j + 1] = vB; imp2T[tl * 65 + j + 2] = cB; }
                    const bf16x8 pf = pack_p(pA, pB);
#pragma unroll
                    for (int dt = 0; dt < 4; ++dt) O[mt][dt] = mfma16(pf, vf.v[dt], O[mt][dt]); } }
        NSA_PIPE_END(SC, nstB, K0_LIN)
#pragma unroll
        for (int mt = 0; mt < 2; ++mt)
#pragma unroll
            for (int r = 0; r < 4; ++r) { const float gt = NSA_GATE(mt, r, 0);
#pragma unroll
                for (int dt = 0; dt < 4; ++dt) Oc[mt][dt][r] += gt * O[mt][dt][r]; }
    }
    NSA_FENCE();
    const int cur = T0 >> 6;
    unsigned long long uni = 0ull;
    for (int tl = 0; tl < 8; ++tl) {
        unsigned long long mask;
        if (cur < 16 || (skip & 2)) mask = (cur < 16) ? ((2ull << cur) - 1ull) : (0xFFFFull | (1ull << cur) | (1ull << (cur - 1)));
        else {
            const float sc = impT[tl * 65 + lane] + imp2T[tl * 65 + lane];
            const unsigned key = __float_as_uint(fmaxf(sc, 0.f));
            const bool elig = (lane <= cur) && (lane != 0) && (lane != cur) && (lane != cur - 1);
            unsigned prefix = 0u;
            for (int bit = 30; bit >= 0; --bit) { const unsigned cand = prefix | (1u << bit);
                const int cnt = __popcll(__ballot(elig && key >= cand)); if (cnt >= 13) prefix = cand; }
            const unsigned long long gt = __ballot(elig && key > prefix); unsigned long long ties = __ballot(elig && key == prefix);
            int need = 13 - __popcll(gt); unsigned long long keep = 0ull;
            while (need > 0 && ties) { const unsigned long long low = ties & (0ull - ties); keep |= low; ties ^= low; --need; }
            mask = gt | keep | 1ull | (1ull << cur) | (1ull << (cur - 1));
        }
        uni |= mask;
        if (lane == 0) { selT[2 * tl] = (unsigned)mask; selT[2 * tl + 1] = (unsigned)(mask >> 32); }
    }
    if (lane == 0) { bw[2 + 2 * w] = (unsigned)uni; bw[3 + 2 * w] = (unsigned)(uni >> 32); }
    NSA_FENCE();
    unsigned long long mk[2];
#pragma unroll
    for (int mt = 0; mt < 2; ++mt) { const int tl = 4 * mt + (r16 >> 2); mk[mt] = (unsigned long long)selT[2 * tl] | ((unsigned long long)selT[2 * tl + 1] << 32); }
    __syncthreads();
    unsigned long long buni = 0ull;
#pragma unroll
    for (int ww = 0; ww < 8; ++ww) buni |= (unsigned long long)bw[2 + 2 * ww] | ((unsigned long long)bw[3 + 2 * ww] << 32);

#define K0_LIST(i_) (__builtin_amdgcn_readfirstlane(stl[(i_)]))
#pragma unroll 1
    for (int br = 1; br < 3; ++br) { if ((skip >> (br + 1)) & 1) continue;
        const NsaSrc SB{PN + (br == 1 ? 768 : 1024) + g * 64, 1280, (const bf16*)(F.ws + (br == 1 ? WS_VST : WS_VWT)) + (size_t)((b * 2 + g) * 64) * T, 0, 1};
        f32x4 O[2][4]; float ls[2] = {0.f, 0.f};
#pragma unroll
        for (int mt = 0; mt < 2; ++mt)
#pragma unroll
            for (int dt = 0; dt < 4; ++dt) O[mt][dt] = Z4;
        int nsteps;
        if (br == 1) { nsteps = 2 * __popcll(buni);
            if (w == 0 && ((buni >> lane) & 1ull)) { const int rk = __popcll(buni & ((1ull << lane) - 1ull)); stl[2 * rk] = 64 * lane; stl[2 * rk + 1] = 64 * lane + 32; } }
        else { const int lo = T0 - 511; const int klo = (lo > 0 ? lo : 0) & ~31; nsteps = ((T0 + 64 - klo) + 31) >> 5; if (w == 0 && lane < nsteps) stl[lane] = klo + 32 * lane; }
        __syncthreads();
        NSA_PIPE_BEGIN(SB, nsteps, K0_LIST)
            const int j = k0 >> 6;
            const bool mine = (br == 1) ? (((uni >> j) & 1ull) != 0ull) : (k0 + 31 >= t0 - 511 && k0 <= t0 + 7);
            if (mine) { const KFr kf = lds_k(ks, r16, q4); const VFr vf = lds_v(vs, r16, q4);
                const bool slow = (br == 1) ? (j == cur) : (k0 < t0 - 504 || k0 + 31 > t0);
#pragma unroll
                for (int mt = 0; mt < 2; ++mt) { f32x4 ci = Z4;
                    if (br == 1) { const float bias = (((mk[mt] >> j) & 1ull) != 0ull) ? 0.f : -1e30f; ci = (f32x4){bias, bias, bias, bias}; }
                    f32x4 sA = mfma16(kf.a0, qf[mt][0], ci); sA = mfma16(kf.a1, qf[mt][1], sA); f32x4 sB = mfma16(kf.b0, qf[mt][0], ci); sB = mfma16(kf.b1, qf[mt][1], sB);
                    f32x4 pA, pB;
                    if (slow) {
#pragma unroll
                        for (int r = 0; r < 4; ++r) { const int kA = k0 + 8 * q4 + r, kB = kA + 4;
                            const bool mA = (kA <= tq[mt]) && (br == 1 || kA + 512 > tq[mt]), mB = (kB <= tq[mt]) && (br == 1 || kB + 512 > tq[mt]);
                            pA[r] = mA ? __builtin_amdgcn_exp2f(sA[r]) : 0.f; pB[r] = mB ? __builtin_amdgcn_exp2f(sB[r]) : 0.f; }
                    } else {
#pragma unroll
                        for (int r = 0; r < 4; ++r) { pA[r] = __builtin_amdgcn_exp2f(sA[r]); pB[r] = __builtin_amdgcn_exp2f(sB[r]); }
                    }
                    ls[mt] += (pA[0] + pA[1]) + (pA[2] + pA[3]) + (pB[0] + pB[1]) + (pB[2] + pB[3]);
                    const bf16x8 pf = pack_p(pA, pB);
#pragma unroll
                    for (int dt = 0; dt < 4; ++dt) O[mt][dt] = mfma16(pf, vf.v[dt], O[mt][dt]); } }
        NSA_PIPE_END(SB, nsteps, K0_LIST)
#pragma unroll
        for (int mt = 0; mt < 2; ++mt) { float l = ls[mt]; l += __shfl_xor(l, 16); l += __shfl_xor(l, 32); const float il = 1.0f / fmaxf(l, 1e-30f);
#pragma unroll
            for (int r = 0; r < 4; ++r) { const float ilr = __shfl(il, 4 * q4 + r) * NSA_GATE(mt, r, br);
#pragma unroll
                for (int dt = 0; dt < 4; ++dt) Oc[mt][dt][r] += ilr * O[mt][dt][r]; } }
    }
    if (!skip) { bf16* YB = (bf16*)(F.ws + WS_H + 16 * MiB) + (size_t)(b * T) * 512;
#pragma unroll
        for (int mt = 0; mt < 2; ++mt)
#pragma unroll
            for (int r = 0; r < 4; ++r)
#pragma unroll
                for (int dt = 0; dt < 4; ++dt) YB[(size_t)(t0 + 4 * mt + q4) * 512 + (g * 4 + r) * 64 + 16 * dt + r16] = f2b(Oc[mt][dt][r]); }
    __syncthreads();
}
__device__ __forceinline__ void nsa_phase(const Frame& F, int rep) {
    LAS unsigned* bw = (LAS unsigned*)(F.lds + 57344);
    const int q0 = (int)(xb_xcc_id() & 7u);
    for (int qi = 0; qi < 8; ++qi) { const int q = (q0 + qi) & 7;
        for (;;) {
            if (F.tid == 0) bw[0] = __hip_atomic_fetch_add(F.ctl + CW_NSAQ + 64 * (8 * rep + q), 1u, RLX_AGENT);
            __syncthreads();
            const unsigned c = bw[0];
            __syncthreads();
            if (c >= 64u) break;
            nsa_block_unit(F, q >> 1, q & 1, 64 * (63 - (int)c), rep ? NSA_SKIP : 0);
        }
    }
}
typedef short bf16x4 __attribute__((ext_vector_type(4)));
__device__ __forceinline__ f32x4 mfma16k16(const bf16x4 a, const bf16x4 b, const f32x4 c) { const bf16x8 a8 = {a[0], a[1], a[2], a[3], 0, 0, 0, 0}, b8 = {b[0], b[1], b[2], b[3], 0, 0, 0, 0}; return __builtin_amdgcn_mfma_f32_16x16x32_bf16(a8, b8, c, 0, 0, 0); }
__device__ __forceinline__ bf16x4 as_bf16x4(const u32x2 v) { return __builtin_bit_cast(bf16x4, v); }
__device__ __forceinline__ bf16x4 pack4(const f32x4 a) { u32x2 w; w.x = pg8::cvt_pk_bf16(a[0], a[1]); w.y = pg8::cvt_pk_bf16(a[2], a[3]); return as_bf16x4(w); }
__device__ __forceinline__ f32x4 unpk4(const u32x2 w) { f32x4 r; r[0] = bflo(w.x); r[1] = bfhi(w.x); r[2] = bflo(w.y); r[3] = bfhi(w.y); return r; }
struct ChunkIn { v4u kt0, kt1, rt0, rt1; u32x2 ak, nt, mb, mk, vt, bh[4], kh[4]; f32x4 gam[4]; };
__device__ __forceinline__ void scan_load(ChunkIn& c, const unsigned char* rec, int vq, int r16, int q4) {
    c.kt0 = *(const v4u*)(rec + (r16 * 64 + q4 * 8) * 2); c.kt1 = *(const v4u*)(rec + (r16 * 64 + 32 + q4 * 8) * 2);
    c.rt0 = *(const v4u*)(rec + 2048 + (r16 * 64 + q4 * 8) * 2); c.rt1 = *(const v4u*)(rec + 2048 + (r16 * 64 + 32 + q4 * 8) * 2);
#pragma unroll
    for (int mt = 0; mt < 4; ++mt) { c.bh[mt] = *(const u32x2*)(rec + 4096 + ((16 * mt + r16) * 16 + 4 * q4) * 2); c.kh[mt] = *(const u32x2*)(rec + 6144 + ((16 * mt + r16) * 16 + 4 * q4) * 2);
        c.gam[mt] = *(const f32x4*)(rec + 12288 + (16 * mt + 4 * q4) * 4); }
    c.vt = *(const u32x2*)(rec + 8192 + ((16 * vq + r16) * 16 + 4 * q4) * 2);
    c.ak = *(const u32x2*)(rec + 10240 + (r16 * 16 + 4 * q4) * 2); c.nt = *(const u32x2*)(rec + 10752 + (r16 * 16 + 4 * q4) * 2);
    c.mb = *(const u32x2*)(rec + 11264 + (r16 * 16 + 4 * q4) * 2); c.mk = *(const u32x2*)(rec + 11776 + (r16 * 16 + 4 * q4) * 2);
}
__device__ __forceinline__ void scan_chunk(const ChunkIn& cur, f32x4 (&Zt)[4], bf16* Y, int ch, int q4) {
    const f32x4 Z4 = {0.f, 0.f, 0.f, 0.f};
    const bf16x8 zb0 = pack_p(Zt[0], Zt[1]), zb1 = pack_p(Zt[2], Zt[3]);
    f32x4 X = mfma16(as_bf16x8(cur.kt0), zb0, Z4); X = mfma16(as_bf16x8(cur.kt1), zb1, X);
    f32x4 Yc = mfma16(as_bf16x8(cur.rt0), zb0, Z4); Yc = mfma16(as_bf16x8(cur.rt1), zb1, Yc);
    const bf16x4 vt = as_bf16x4(cur.vt);
    const f32x4 W = mfma16k16(as_bf16x4(cur.ak), vt, X);
    const f32x4 U = mfma16k16(as_bf16x4(cur.nt), pack4(W), Z4);
    const bf16x4 ub = pack4(U);
    Yc = mfma16k16(as_bf16x4(cur.mk), vt, Yc); Yc = mfma16k16(as_bf16x4(cur.mb), ub, Yc);
#pragma unroll
    for (int mt = 0; mt < 4; ++mt) { f32x4 acc = mfma16k16(as_bf16x4(cur.kh[mt]), vt, Zt[mt]); acc = mfma16k16(as_bf16x4(cur.bh[mt]), ub, acc); Zt[mt] = acc * cur.gam[mt]; }
#pragma unroll
    for (int r = 0; r < 4; ++r) Y[(size_t)(16 * ch + 4 * q4 + r) * 512] = f2b(Yc[r]);
}
__device__ __forceinline__ void rwkv_scan_wave(const Frame& F, int bh, int vq) {
    const int lane = F.lane, r16 = lane & 15, q4 = lane >> 4, b = bh >> 3, h = bh & 7;
    const f32x4 Z4 = {0.f, 0.f, 0.f, 0.f};
    const unsigned char* recb = F.ws + WS_PRW + (size_t)(b * T) * 7168 + h * REC_BYTES;
    bf16* Y = (bf16*)(F.ws + WS_H) + (size_t)(b * T) * 512 + h * 64 + 16 * vq + r16;
    f32x4 Zt[4] = {Z4, Z4, Z4, Z4};
    ChunkIn A, B;
    constexpr size_t CS = 16 * 7168;
    scan_load(A, recb, vq, r16, q4);
    for (int ch = 0; ch < T / 16; ch += 2) {
        if (vq == 0 && lane == 0) __hip_atomic_store(F.ctl + CW_SCANP + 64 * bh, (unsigned)ch, RLX_AGENT);
        scan_load(B, recb + (size_t)(ch + 1) * CS, vq, r16, q4);
        scan_chunk(A, Zt, Y, ch, q4);
        scan_load(A, recb + (size_t)((ch + 2 < T / 16) ? ch + 2 : ch) * CS, vq, r16, q4);
        scan_chunk(B, Zt, Y, ch + 1, q4);
    }
}
__device__ __forceinline__ void rwkv_scan_prefetch(const Frame& F, int bh) {
    const int lane = F.lane, b = bh >> 3, h = bh & 7;
    const unsigned char* recb = F.ws + WS_PRW + (size_t)(b * T) * 7168 + h * REC_BYTES;
    const int o0 = 128 * lane, o1 = 128 * (lane < 35 ? 64 + lane : 98);
    unsigned dmy = 0u, pa[4] = {0u, 0u, 0u, 0u}, pb[4] = {0u, 0u, 0u, 0u};
    for (int c4 = 0; c4 < T / 16; c4 += 4) {
#pragma unroll
        for (int k = 0; k < 4; ++k) { const int ch = c4 + k;
            for (int spin = 0; spin < (1 << 16); ++spin) { const int prog = (int)__hip_atomic_load(F.ctl + CW_SCANP + 64 * bh, RLX_AGENT); if (ch <= prog + 8) break; __builtin_amdgcn_s_sleep(8); }
            const unsigned char* rec = recb + (size_t)ch * (16 * 7168);
            dmy ^= pa[k] ^ pb[k];
            pa[k] = *(const volatile unsigned*)(rec + o0); pb[k] = *(const volatile unsigned*)(rec + o1); }
    }
    dmy ^= pa[0] ^ pb[0] ^ pa[1] ^ pb[1] ^ pa[2] ^ pb[2] ^ pa[3] ^ pb[3];
    if (lane == 0) F.MISC[17] = dmy;
}
__device__ __forceinline__ void rwkv_epilogue(const Frame& F) {
    const int lane = F.lane; const int gw = F.vcu * NWAVES + F.wave, NGW = F.G * NWAVES;
    const unsigned char* prw = F.ws + WS_PRW; const bf16* G = (const bf16*)((unsigned char*)F.out + DO_G); bf16* YA = (bf16*)(F.ws + WS_H);
    for (int idx = gw; idx < (M / 16) * 8; idx += NGW) { const int bt = idx >> 3, h = idx & 7, c = h * 64 + lane;
        const unsigned char* rec = prw + (size_t)(16 * bt) * 7168 + h * REC_BYTES;
        const v4u* vp = (const v4u*)(rec + 8192 + lane * 32); const v4u v0 = vp[0], v1 = vp[1];
        const float lw = F.in[12][c], lb = F.in[13][c];
        float yv[16], gv[16], bo[16];
#pragma unroll
        for (int s = 0; s < 16; ++s) { const size_t o = (size_t)(16 * bt + s) * 512 + c; yv[s] = bf2f(YA[o]); gv[s] = bf2f(G[o]); bo[s] = *(const float*)(rec + 12544 + 4 * s); }
#pragma unroll
        for (int s = 0; s < 16; ++s) { const unsigned vw = (s < 8) ? v0[s >> 1] : v1[(s - 8) >> 1]; const float vv = (s & 1) ? bfhi(vw) : bflo(vw);
            const float y = yv[s]; const float mean = wave_sum(y) * (1.f / 64.f); const float d = y - mean; const float var = wave_sum(d * d) * (1.f / 64.f);
            const float yn = d * rsqrtf(var + GN_EPS) * lw + lb;
            YA[(size_t)(16 * bt + s) * 512 + c] = f2b((yn + bo[s] * vv) * gv[s]); }
    }
}
__device__ __forceinline__ unsigned sortable(float x) { const unsigned u = __float_as_uint(x); return (u & 0x80000000u) ? ~u : (u | 0x80000000u); }
__device__ __forceinline__ float unsortable(unsigned k) { const unsigned u = (k & 0x80000000u) ? (k & 0x7fffffffu) : ~k; return __uint_as_float(u); }
#define TK_INSERT(L, key_) do { unsigned k_ = (key_); _Pragma("unroll") for (int s_ = 0; s_ < 16; ++s_) { const unsigned hi_ = L[s_] > k_ ? L[s_] : k_; k_ = L[s_] > k_ ? k_ : L[s_]; L[s_] = hi_; } } while (0)
__device__ __forceinline__ void peer_topk_pass(const Frame& F, int wp, LAS float* sc) {
    const int lane = F.lane, r16 = lane & 15, q4 = lane >> 4;
    const bf16* QRY = (const bf16*)(F.ws + WS_PRW);
    int* EID = (int*)(F.ws + WS_PRW + 64 * MiB); float* EG = (float*)(F.ws + WS_PRW + 72 * MiB);
    const int row = lane & 31, part = lane >> 5;
    unsigned L1[16], L2[16];
#pragma unroll
    for (int half = 0; half < 2; ++half) {
        const bf16* SK = (const bf16*)(F.ws + (half ? WS_SK2 : WS_SK1));
        bf16x8 af[2][4];
#pragma unroll
        for (int mt = 0; mt < 2; ++mt) { const int rho = 32 * wp + 16 * mt + r16; const bf16* qp = QRY + (size_t)(rho >> 3) * 2048 + (rho & 7) * 256 + half * 128 + 8 * q4;
#pragma unroll
            for (int s = 0; s < 4; ++s) af[mt][s] = as_bf16x8(*(const v4u*)(qp + 32 * s)); }
#pragma unroll
        for (int kg = 0; kg < 2; ++kg) { bf16x8 kb[4][4];
#pragma unroll
            for (int k4 = 0; k4 < 4; ++k4)
#pragma unroll
                for (int s = 0; s < 4; ++s) kb[k4][s] = as_bf16x8(*(const v4u*)(SK + (size_t)(16 * (4 * kg + k4) + r16) * 128 + 32 * s + 8 * q4));
#pragma unroll
          for (int mt = 0; mt < 2; ++mt) {
#pragma unroll
            for (int k4 = 0; k4 < 4; ++k4) { const int kt = 4 * kg + k4; f32x4 acc = {0.f, 0.f, 0.f, 0.f};
#pragma unroll
                for (int s = 0; s < 4; ++s) acc = mfma16(af[mt][s], kb[k4][s], acc);
#pragma unroll
                for (int r = 0; r < 4; ++r) { const int rw = 16 * mt + 4 * q4 + r; sc[rw * 128 + ((16 * kt + r16) ^ rw)] = acc[r]; } } } }
        NSA_FENCE();
        unsigned Ls[16];
#pragma unroll
        for (int s = 0; s < 16; ++s) Ls[s] = 0u;
#pragma unroll 4
        for (int i = 0; i < 64; ++i) { const int c = 64 * part + i; const float x = sc[row * 128 + (c ^ row)];
            TK_INSERT(Ls, (sortable(x) & ~0x7Fu) | (unsigned)(127 - c)); }
        unsigned Lo[16];
#pragma unroll
        for (int s = 0; s < 16; ++s) Lo[s] = (unsigned)__shfl_xor((int)Ls[s], 32);
#pragma unroll
        for (int s = 0; s < 16; ++s) TK_INSERT(Ls, Lo[s]);
#pragma unroll
        for (int s = 0; s < 16; ++s) { if (half == 0) L1[s] = Ls[s]; else L2[s] = Ls[s]; }
        NSA_FENCE();
    }
    float v1[16], v2[16];
#pragma unroll
    for (int s = 0; s < 16; ++s) { v1[s] = unsortable(L1[s]); v2[s] = unsortable(L2[s]); }
    unsigned C[16];
#pragma unroll
    for (int s = 0; s < 16; ++s) C[s] = 0u;
#pragma unroll
    for (int i = 0; i < 16; ++i)
#pragma unroll
        for (int j = 0; j < 16; ++j) if ((i + 1) * (j + 1) <= 16) { TK_INSERT(C, (sortable(v1[i] + v2[j]) & ~0xFFu) | (unsigned)(255 - (16 * i + j))); }
    LAS unsigned* il = (LAS unsigned*)sc;
    if (part == 0) {
#pragma unroll
        for (int s = 0; s < 16; ++s) { il[row * 33 + s] = 127u - (L1[s] & 127u); il[row * 33 + 16 + s] = 127u - (L2[s] & 127u); }
    }
    NSA_FENCE();
    if (part == 0) { const int rho = 32 * wp + row;
        float val[16], e[16]; float sum = 0.f;
#pragma unroll
        for (int s = 0; s < 16; ++s) val[s] = unsortable(C[s]);
#pragma unroll
        for (int s = 0; s < 16; ++s) { e[s] = __expf(val[s] - val[0]); sum += e[s]; }
        const float is = 1.0f / sum;
#pragma unroll
        for (int s = 0; s < 16; ++s) { const unsigned pos = 255u - (C[s] & 255u); const unsigned i = pos >> 4, j = pos & 15u;
            EID[(size_t)rho * 16 + s] = (int)(il[row * 33 + i] * 128u + il[row * 33 + 16 + j]); EG[(size_t)rho * 16 + s] = e[s] * is; }
    }
    NSA_FENCE();
}
typedef float f32x2_t __attribute__((ext_vector_type(2)));
constexpr float PEER_SCALE = 256.0f, PEER_ISCALE = 1.0f / 256.0f;
__device__ __forceinline__ void peer_convert_one(const Frame& F, const float* srcf, unsigned char* dstb) {
    const int gt = F.vcu * (NWAVES * 64) + F.tid, NT = F.G * NWAVES * 64;
    const f32x4* src = (const f32x4*)srcf; v4u* dst = (v4u*)dstb;
    for (int i = gt; i < 16384 * 1024 / 16; i += NT) { v4u o;
#pragma unroll
        for (int q = 0; q < 4; ++q) { const f32x4 a = src[4 * i + q] * PEER_SCALE; int w = __builtin_amdgcn_cvt_pk_fp8_f32(a[0], a[1], 0, false); w = __builtin_amdgcn_cvt_pk_fp8_f32(a[2], a[3], w, true); o[q] = (unsigned)w; }
        dst[i] = o; }
}
constexpr float PEER_SU = 768.0f, PEER_SH = 24.0f;
__device__ __forceinline__ unsigned q8pack(const f32x4 a, float sc) {
    const int q0 = (int)rintf(fminf(fmaxf(a[0] * sc, -127.f), 127.f)), q1 = (int)rintf(fminf(fmaxf(a[1] * sc, -127.f), 127.f)), q2 = (int)rintf(fminf(fmaxf(a[2] * sc, -127.f), 127.f)), q3 = (int)rintf(fminf(fmaxf(a[3] * sc, -127.f), 127.f));
    return (unsigned)(q0 & 255) | ((unsigned)(q1 & 255) << 8) | ((unsigned)(q2 & 255) << 16) | ((unsigned)(q3 & 255) << 24);
}
__device__ __forceinline__ void peer_convert_u8(const Frame& F, const float* srcf, unsigned char* dstb) {
    const int gt = F.vcu * (NWAVES * 64) + F.tid, NT = F.G * NWAVES * 64;
    const f32x4* src = (const f32x4*)srcf; v4u* dst = (v4u*)dstb;
    for (int i = gt; i < 16384 * 1024 / 16; i += NT) { v4u o;
#pragma unroll
        for (int q = 0; q < 4; ++q) o[q] = q8pack(src[4 * i + q], PEER_SU);
        dst[i] = o; }
}
__device__ __forceinline__ void peer_convert_tables(const Frame& F) { peer_convert_u8(F, F.in[31], F.ws + WS_MG); peer_convert_one(F, F.in[32], F.ws + WS_MG + 16 * MiB); }
__device__ __forceinline__ float sum8(float x) { x += dppf<0xB1>(x); x += dppf<0x4E>(x); x += dppf<0x141>(x); return x; }
template <int PHASE> __device__ __forceinline__ void peer_slice_unit(const Frame& F, int s, int tg) {
    const int lane = F.lane, j = lane & 7, gbase = lane & ~7;
    const bf16* H2 = (const bf16*)(F.ws + WS_H);
    const int* EID = (const int*)(F.ws + WS_PRW + 64 * MiB);
    float* PART = (float*)(F.ws + WS_PRW) + (size_t)s * M * 128; const float* CACT = (const float*)(F.ws + WS_PRW + 80 * MiB);
    const unsigned char* TB = F.ws + WS_MG + (PHASE == 0 ? 0 : 16 * MiB) + 128 * s + 16 * j;
#pragma unroll 1
    for (int it = 0; it < 8; ++it) { const int tk = 64 * tg + 8 * it + (lane >> 3);
        int ids[16]; float hv[16], acc[16];
        { const v4u* ip = (const v4u*)(EID + (size_t)tk * 128 + 16 * j);
#pragma unroll
          for (int q = 0; q < 4; ++q) { const v4u w = ip[q]; ids[4 * q] = (int)w.x; ids[4 * q + 1] = (int)w.y; ids[4 * q + 2] = (int)w.z; ids[4 * q + 3] = (int)w.w; } }
        int hq[4] = {0, 0, 0, 0};
        if (PHASE == 0) { const v4u h0 = *(const v4u*)(H2 + (size_t)tk * D + 128 * s + 16 * j), h1 = *(const v4u*)(H2 + (size_t)tk * D + 128 * s + 16 * j + 8);
            hq[0] = (int)q8pack((f32x4){bflo(h0.x), bfhi(h0.x), bflo(h0.y), bfhi(h0.y)}, PEER_SH); hq[1] = (int)q8pack((f32x4){bflo(h0.z), bfhi(h0.z), bflo(h0.w), bfhi(h0.w)}, PEER_SH);
            hq[2] = (int)q8pack((f32x4){bflo(h1.x), bfhi(h1.x), bflo(h1.y), bfhi(h1.y)}, PEER_SH); hq[3] = (int)q8pack((f32x4){bflo(h1.z), bfhi(h1.z), bflo(h1.w), bfhi(h1.w)}, PEER_SH); }
        else { const f32x4* cp = (const f32x4*)(CACT + (size_t)tk * 128 + 16 * j);
#pragma unroll
            for (int q = 0; q < 4; ++q) { const f32x4 c = cp[q]; hv[4 * q] = c[0]; hv[4 * q + 1] = c[1]; hv[4 * q + 2] = c[2]; hv[4 * q + 3] = c[3]; } }
#pragma unroll
        for (int m = 0; m < 16; ++m) acc[m] = 0.f;
        v4u tn[16];
        if (PHASE == 0) {
#pragma unroll
            for (int m = 0; m < 16; ++m) { const int id = __builtin_amdgcn_ds_bpermute(gbase * 4, ids[m]); tn[m] = *(const v4u*)(TB + (size_t)id * 1024); } }
#pragma unroll 1
        for (int jj = 0; jj < 8; ++jj) { const int src = (gbase + jj) * 4;
            v4u tv[16];
            if (PHASE == 0) { const int srcn = (gbase + ((jj + 1 < 8) ? jj + 1 : jj)) * 4;
#pragma unroll
                for (int m = 0; m < 16; ++m) tv[m] = tn[m];
#pragma unroll
                for (int m = 0; m < 16; ++m) { const int id = __builtin_amdgcn_ds_bpermute(srcn, ids[m]); tn[m] = *(const v4u*)(TB + (size_t)id * 1024); } }
            else {
#pragma unroll
                for (int m = 0; m < 16; ++m) { const int id = __builtin_amdgcn_ds_bpermute(src, ids[m]); tv[m] = *(const v4u*)(TB + (size_t)id * 1024); } }
#pragma unroll
            for (int m = 0; m < 16; ++m) {
                if (PHASE == 0) { int di = __builtin_amdgcn_sdot4((int)tv[m].x, hq[0], 0, false); di = __builtin_amdgcn_sdot4((int)tv[m].y, hq[1], di, false); di = __builtin_amdgcn_sdot4((int)tv[m].z, hq[2], di, false); di = __builtin_amdgcn_sdot4((int)tv[m].w, hq[3], di, false);
                    const float d = sum8((float)di); acc[m] = (j == jj) ? d : acc[m]; }
                else {
                    float f[16];
#pragma unroll
                    for (int q = 0; q < 4; ++q) { const f32x2_t lo = __builtin_amdgcn_cvt_pk_f32_fp8((int)tv[m][q], false), hi = __builtin_amdgcn_cvt_pk_f32_fp8((int)tv[m][q], true); f[4 * q] = lo.x; f[4 * q + 1] = lo.y; f[4 * q + 2] = hi.x; f[4 * q + 3] = hi.y; } const float c = __builtin_bit_cast(float, __builtin_amdgcn_ds_bpermute(src, __builtin_bit_cast(int, hv[m])));
#pragma unroll
                    for (int q = 0; q < 16; ++q) acc[q] += c * f[q]; } }
        }
        if (PHASE == 0) { f32x4* pp = (f32x4*)(PART + (size_t)tk * 128 + 16 * j);
#pragma unroll
            for (int q = 0; q < 4; ++q) pp[q] = (f32x4){acc[4 * q], acc[4 * q + 1], acc[4 * q + 2], acc[4 * q + 3]}; }
        else { f32x4* op = (f32x4*)(F.out + (size_t)tk * D + 128 * s + 16 * j);
#pragma unroll
            for (int q = 0; q < 4; ++q) { f32x4 a = op[q]; a[0] += acc[4 * q] * PEER_ISCALE; a[1] += acc[4 * q + 1] * PEER_ISCALE; a[2] += acc[4 * q + 2] * PEER_ISCALE; a[3] += acc[4 * q + 3] * PEER_ISCALE; op[q] = a; } }
    }
}
template <int PHASE> __device__ __forceinline__ void peer_slice_phase(const Frame& F, int rep) {
    const int q0 = (int)(xb_xcc_id() & 7u);
    for (int qi = 0; qi < 8; ++qi) { const int q = (q0 + qi) & 7;
        for (;;) { unsigned c = 0;
            if (F.lane == 0) c = __hip_atomic_fetch_add(F.ctl + CW_PEERQ + 64 * (16 * rep + 8 * PHASE + q), 1u, RLX_AGENT);
            c = (unsigned)__builtin_amdgcn_readfirstlane((int)c);
            if (c >= 256u) break;
            peer_slice_unit<PHASE>(F, q, (int)c); } }
}
__device__ __forceinline__ void peer_act_phase(const Frame& F) {
    const int gt = F.vcu * (NWAVES * 64) + F.tid, NT = F.G * NWAVES * 64;
    const float* PART = (const float*)(F.ws + WS_PRW); const float* EG = (const float*)(F.ws + WS_PRW + 72 * MiB); float* CACT = (float*)(F.ws + WS_PRW + 80 * MiB);
    for (int i = gt; i < M * 128 / 4; i += NT) { f32x4 d = {0.f, 0.f, 0.f, 0.f};
#pragma unroll
        for (int s = 0; s < 8; ++s) d += ((const f32x4*)PART)[(size_t)s * (M * 128 / 4) + i];
        const f32x4 g = ((const f32x4*)EG)[i]; f32x4 c;
#pragma unroll
        for (int e = 0; e < 4; ++e) { const float dt = d[e] * (1.0f / (PEER_SU * PEER_SH)); c[e] = g[e] * 0.5f * dt * (1.f + erff(dt * 0.70710678118654752f)); }
        ((f32x4*)CACT)[i] = c; }
}
struct Args { const float* in[33]; float* out; unsigned char* ws; int ph_lo, ph_hi; };
__global__ void __launch_bounds__(NWAVES * 64, 2) mk_fwd(Args args) {
    extern __shared__ __attribute__((aligned(16))) unsigned char lds[];
    Frame F;
    F.lds = (LAS unsigned char*)lds;
    F.MISC = (volatile LAS unsigned*)(F.lds + MISC_OFF);
    F.tid = threadIdx.x; F.lane = F.tid & 63; F.wave = __builtin_amdgcn_readfirstlane(F.tid >> 6);
    F.G = gridDim.x; { const int bx = blockIdx.x; F.vcu = (F.G % 8 == 0) ? (bx % 8) * (F.G / 8) + bx / 8 : bx; }
    unsigned char* ws = args.ws; F.ws = ws; F.out = args.out;
    F.ctl = (gu32*)(ws + WS_CTL);
#pragma unroll
    for (int i = 0; i < 33; ++i) F.in[i] = args.in[i];
    for (int u = F.tid; u < (LDS_BYTES - LDSCTL_OFF) / 4; u += NWAVES * 64) ((LAS unsigned*)(F.lds + LDSCTL_OFF))[u] = 0u;
    __syncthreads();
    const int lo = args.ph_lo, hi = args.ph_hi & 0xff; const int rep = args.ph_hi >> 8;
    const bool multi = (hi - lo) > 1;
    XcdBarrier bar; bar.bar = (unsigned*)(F.ctl + CW_BAR); bar.x = 0; bar.st = nullptr;
    if (multi) bar = xcd_barrier_post((unsigned*)(F.ctl + CW_BAR), F.MISC + 8);
#define IN(k) (lo <= (k) && (k) < hi)
#define NREP(k) ((((repmask) >> (k)) & 1) + 1)
#define REPBAR() do { if (rep) xcd_barrier(bar); } while (0)
#define SEAM(k) do { if (DBG_SEL == (k) && blockIdx.x == 0 && F.tid == 0) dbg_t1 = __builtin_amdgcn_s_memrealtime(); if (IN(k) && IN((k) + 1)) xcd_barrier(bar); if ((DBG_SEL == (k) + 1 || (DBG_SEL == 20 && (k) == 1)) && blockIdx.x == 0 && F.tid == 0) dbg_t0 = __builtin_amdgcn_s_memrealtime(); } while (0)
    unsigned long long dbg_t0 = 0ull, dbg_t1 = 0ull;

    if (IN(0)) { { p0_prologue(F); } } SEAM(0);
    if (IN(1)) { {
        pg8::Gemm g{(const pg8::bf16_t*)(ws + WS_H), (const pg8::bf16_t*)(ws + WS_WIN), M, NG1, D}; pg8::StaticOrder S; S.init(M, NG1, F.G, (int)blockIdx.x);
        pg8::EpiG1 E{(float*)(ws + WS_PRW), (float*)(ws + WS_BND), (pg8::bf16_t*)((unsigned char*)F.out + DO_PNSA), (pg8::bf16_t*)(ws + WS_MG), (float*)((unsigned char*)F.out + DO_GLOG)};
        pg8::gemm_phase<pg8::EpiG1, pg8::StaticOrder, true, true>(F.lds + RING_OFF, g, S, E);
    } } SEAM(1);
    if (IN(2)) {
        for (int u = F.vcu; u < 256; u += F.G) nsa_prep_tile(F, u);
        if (DBG_SEL == 20 && blockIdx.x == 0 && F.tid == 0) dbg_t1 = __builtin_amdgcn_s_memrealtime();
        if (DBG_SEL == 21 && blockIdx.x == 0 && F.tid == 0) dbg_t0 = __builtin_amdgcn_s_memrealtime();
        for (int u = F.vcu; u < 256; u += F.G) compress_unit(F, u);
        if (DBG_SEL == 21 && blockIdx.x == 0 && F.tid == 0) dbg_t1 = __builtin_amdgcn_s_memrealtime();
        for (int u = F.vcu; u < 256; u += F.G) rwkv_prep_tile(F, u);
    } SEAM(2);
    if (IN(3)) { {
        if ((int)blockIdx.x < 32 && !(rep && P3REP == 3)) { if (F.wave < 4) rwkv_scan_wave(F, (int)blockIdx.x, F.wave); else if (F.wave == 4) rwkv_scan_prefetch(F, (int)blockIdx.x); __syncthreads(); }
        if (!(rep && P3REP == 2)) nsa_phase(F, rep);
    } } SEAM(3);
    if (IN(4)) { { rwkv_epilogue(F); } } SEAM(4);
    if (IN(5)) { {
        { pg8::Gemm g{(const pg8::bf16_t*)(ws + WS_H), (const pg8::bf16_t*)(ws + WS_WA), M, D, 512, (const pg8::bf16_t*)(ws + WS_H + 16 * MiB), (const pg8::bf16_t*)(ws + WS_WB)}; pg8::StaticOrder2 S; S.init(M, D, F.G, (int)blockIdx.x);
          pg8::EpiMerge E{(const pg8::bf16_t*)(ws + WS_MG), (pg8::bf16_t*)(ws + WS_PRW + 64 * MiB)};
          pg8::gemm_phase<pg8::EpiMerge, pg8::StaticOrder2, true, true>(F.lds + RING_OFF, g, S, E); }
    } } SEAM(5);
    if (IN(6)) { {
        pg8::Gemm g{(const pg8::bf16_t*)(ws + WS_PRW + 64 * MiB), (const pg8::bf16_t*)(ws + WS_WOUT), M, D, D}; pg8::StaticOrder S; S.init(M, D, F.G, (int)blockIdx.x);
        pg8::EpiRes E{F.in[0], F.out};
        pg8::gemm_phase<pg8::EpiRes, pg8::StaticOrder, true, true>(F.lds + RING_OFF, g, S, E);
    } } SEAM(6);
    if (IN(7)) { { const int gw = F.vcu * NWAVES + F.wave, NGW = F.G * NWAVES;
        for (int m = gw; m < M; m += NGW) rms_row_to_bf16(F.lane, F.out + (size_t)m * D, F.in[27], (bf16*)(ws + WS_H) + (size_t)m * D);
        peer_convert_tables(F);
    } } SEAM(7);
    if (IN(8)) { {
        pg8::Gemm g{(const pg8::bf16_t*)(ws + WS_H), (const pg8::bf16_t*)(ws + WS_WQ), M, 2048, D}; pg8::StaticOrder S; S.init(M, 2048, F.G, (int)blockIdx.x);
        pg8::EpiBf16<0> E{(pg8::bf16_t*)(ws + WS_PRW), 2048, nullptr, 0, 0, 1.f};
        pg8::gemm_phase<pg8::EpiBf16<0>, pg8::StaticOrder, true, true>(F.lds + RING_OFF, g, S, E);
    } } SEAM(8);
    if (IN(9)) { { const int gw = F.vcu * NWAVES + F.wave, NGW = F.G * NWAVES; LAS float* sc = (LAS float*)(F.lds + F.wave * 16384);
        for (int wp = gw; wp < M * 8 / 32; wp += NGW) peer_topk_pass(F, wp, sc);
    } } SEAM(9);
    if (IN(10)) { peer_slice_phase<0>(F, rep); } SEAM(10);
    if (IN(11)) { peer_act_phase(F); } SEAM(11);
    if (IN(12)) { peer_slice_phase<1>(F, rep); }
    if (DBG_SEL >= 0 && multi) { if (DBG_SEL == 12 && blockIdx.x == 0 && F.tid == 0) dbg_t1 = __builtin_amdgcn_s_memrealtime(); xcd_barrier(bar); if (blockIdx.x == 0 && F.tid == 0) F.out[0] += (DBG_SEL >= 30) ? (0.05f + (float)(F.MISC[21] - F.MISC[20]) * 0.01f * 1e-3f) : (0.05f + (float)(dbg_t1 - dbg_t0) * 0.01f * 2e-4f); }
#undef IN
#undef SEAM
}

extern "C" void kernel_launch(void* const* d_in, const int* in_sizes, int n_in, void* d_out, int out_size, void* d_ws, size_t ws_size, hipStream_t stream) {
    static int grid = 0;
    if (grid == 0) {
        if (n_in != 33 || out_size != M * D || ws_size < WS_END) { fprintf(stderr, "kernel_launch: unexpected shapes (n_in %d out %d ws %zu)\n", n_in, out_size, ws_size); grid = -1; return; }
        int dev = 0, cus = 0, per_cu = 0;
        if (hipGetDevice(&dev) != hipSuccess || hipDeviceGetAttribute(&cus, hipDeviceAttributeMultiprocessorCount, dev) != hipSuccess) { grid = -1; return; }
        if (hipFuncSetAttribute((const void*)mk_fwd, hipFuncAttributeMaxDynamicSharedMemorySize, LDS_BYTES) != hipSuccess) { fprintf(stderr, "kernel_launch: hipFuncSetAttribute failed\n"); grid = -1; return; }
        if (hipOccupancyMaxActiveBlocksPerMultiprocessor(&per_cu, (const void*)mk_fwd, NWAVES * 64, LDS_BYTES) != hipSuccess || per_cu < 1)
            fprintf(stderr, "kernel_launch: occupancy query reports %d blocks per CU\n", per_cu);
        (void)hipGetLastError();
        grid = cus;
        if (grid > 256) grid = 256;
    }
    if (grid < 0) return;
    if (hipMemsetAsync((char*)d_ws + WS_CTL, 0, CTL_ZERO_BYTES, stream) != hipSuccess) return;
    Args a{};
    for (int i = 0; i < 33; ++i) a.in[i] = (const float*)d_in[i];
    a.out = (float*)d_out; a.ws = (unsigned char*)d_ws;
#if MK_ONE_LAUNCH
    a.ph_lo = 0; a.ph_hi = N_PHASES;
    hipLaunchKernelGGL(mk_fwd, dim3(grid), dim3(NWAVES * 64), LDS_BYTES, stream, a);
#else
    for (int p = 0; p < N_PHASES; ++p) { for (int r = 0; r <= (((REP_MASK) >> p) & 1); ++r) { a.ph_lo = p; a.ph_hi = (p + 1) | (r << 8); hipLaunchKernelGGL(mk_fwd, dim3(grid), dim3(NWAVES * 64), LDS_BYTES, stream, a); } }
#endif
}
```

```cpp
#include <hip/hip_runtime.h>
#include <cstdio>
#include <cstdint>
#define MK_ONE_LAUNCH 1
#define REP_MASK 0
#define P3REP 1
#define NSA_SKIP 0
#define DBG_SEL -1
namespace pg8 {
#define PG8_LAS __attribute__((address_space(3)))
typedef unsigned short bf16_t;
typedef short bf16x8 __attribute__((ext_vector_type(8)));
typedef float f32x4 __attribute__((ext_vector_type(4)));
typedef unsigned u32x4 __attribute__((ext_vector_type(4)));
constexpr int BM = 256, BK = 64, HALF = 128, HTB = HALF * BK * 2  , STAGE_BYTES = 8 * HTB, NXCD = 8, WGM = 8;

__host__ __device__ __forceinline__ int lds_byte(int r, int c) { const int st = (r >> 4) * 2 + (c >> 5), rr = r & 15, cc = c & 31, ob = rr * 64 + cc * 2; return st * 1024 + (ob ^ (((ob >> 9) & 1) << 5)); }
__host__ __device__ __forceinline__ void stage_rc(int b, int& R, int& C) { const int st = b / 1024, sb = b % 1024, swz = sb ^ (((sb >> 9) & 1) << 5); R = (st >> 1) * 16 + swz / 64; C = (st & 1) * 32 + (swz % 64) / 2; }
__host__ __device__ __forceinline__ int perm32(int rho) { const int n = rho >> 4, i = rho & 15; return 8 * (i >> 2) + 4 * n + (i & 3); }

struct Unit { int pm, pn; int seg = 0; };
struct Gemm { const bf16_t* A; const bf16_t* Bt; int M, N, K; const bf16_t* A2 = nullptr; const bf16_t* Bt2 = nullptr; };

struct StaticOrder {
    int nM, nN, nwg, G, c;
    __host__ __device__ void init(int M, int N, int G_, int c_) { nM = M / BM; nN = N / BM; nwg = nM * nN; G = G_; c = c_; }
    __host__ __device__ bool next(int i, Unit& u) const {
        const long L = (long)i * G + c; if (L >= nwg) return false;
        int wgid = (int)L; { const int q = nwg / NXCD, r = nwg % NXCD, xcd = wgid % NXCD, off = wgid / NXCD; wgid = (xcd < r ? xcd * (q + 1) : r * (q + 1) + (xcd - r) * q) + off; }
        const int nig = WGM * nN, gid = wgid / nig, fm = gid * WGM, gsz = (nM - fm) < WGM ? (nM - fm) : WGM;
        u.pm = fm + ((wgid % nig) % gsz); u.pn = (wgid % nig) / gsz; return true;
    }
    __device__ __forceinline__ void a_ready(const Unit&) const {}
    __device__ __forceinline__ void done(const Unit&) const {}
};


struct StaticOrder2 {
    StaticOrder base;
    __host__ __device__ void init(int M, int N, int G_, int c_) { base.init(M, N, G_, c_); }
    __host__ __device__ bool next(int i, Unit& u) const { const bool ok = base.next(i >> 1, u); u.seg = i & 1; return ok; }
    __device__ __forceinline__ void a_ready(const Unit&) const {}
    __device__ __forceinline__ void done(const Unit&) const {}
};
typedef float f32x2c __attribute__((ext_vector_type(2))); typedef __bf16 bf16x2c __attribute__((ext_vector_type(2)));
__device__ __forceinline__ unsigned cvt_pk_bf16(float lo, float hi) { const f32x2c v = {lo, hi}; const bf16x2c b = __builtin_convertvector(v, bf16x2c); return __builtin_bit_cast(unsigned, b); }
typedef float f32x2 __attribute__((ext_vector_type(2)));
__device__ __forceinline__ f32x2 gelu_pk(f32x2 v) {
    const f32x2 av = __builtin_elementwise_abs(v), d = av * 0.2316418882f + 1.0f;
    f32x2 t; t.x = __builtin_amdgcn_rcpf(d.x); t.y = __builtin_amdgcn_rcpf(d.y);
    f32x2 q = t * 0.5307027145f + (-0.7265760135f); q = q * t + 0.7107068705f; q = q * t + (-0.142248368f); q = q * t + 0.127414796f; q = q * t;
    const f32x2 s = (v * v) * (-0.72134752044f);
    f32x2 e; e.x = __builtin_amdgcn_exp2f(s.x); e.y = __builtin_amdgcn_exp2f(s.y);
    const f32x2 m = v * (q * e), r = v - m;
    f32x2 o; o.x = v.x < 0.f ? m.x : r.x; o.y = v.y < 0.f ? m.y : r.y; return o;
}

template <int ACT  > struct EpiBf16 {
    static constexpr bool PERM = true, AFTER_DRAIN = false, KEEP_ACC = false; static_assert(ACT == 0 || ACT == 1, "EpiBf16: ACT is 0 (none) or 1 (gelu_pk)");
    bf16_t* O; int ldc; const float* bias; int split_cols; size_t split_stride; float scale0;
    __device__ __forceinline__ void operator()(const f32x4 (&acc)[2][2][4][2], const Unit& u, int wr, int wc, int fr, int fq) const {
        const int row0 = u.pm * BM + wr * 64 + fr; int colt = u.pn * BM; bf16_t* base = O;
        float sc = 1.f; if (split_cols) { const int t = colt / split_cols; base += (size_t)t * split_stride; colt -= t * split_cols; if (t == 0) sc = scale0; }
        const int col0 = colt + wc * 32 + 8 * fq, bcol0 = u.pn * BM + wc * 32 + 8 * fq;
        f32x4 bv[2][2];
#pragma unroll
        for (int bj = 0; bj < 2; ++bj)
#pragma unroll
            for (int n = 0; n < 2; ++n) bv[bj][n] = bias ? *(const f32x4*)(bias + bcol0 + bj * HALF + 4 * n) : (f32x4){0.f, 0.f, 0.f, 0.f};
#pragma unroll
        for (int ai = 0; ai < 2; ++ai)
#pragma unroll
            for (int m = 0; m < 4; ++m) { bf16_t* rowp = base + (size_t)(row0 + ai * HALF + m * 16) * ldc + col0;
#pragma unroll
                for (int bj = 0; bj < 2; ++bj) { f32x4 v0 = acc[ai][bj][m][0] + bv[bj][0], v1 = acc[ai][bj][m][1] + bv[bj][1];
                    if (ACT == 1) { f32x2 a = gelu_pk((f32x2){v0[0], v0[1]}), b = gelu_pk((f32x2){v0[2], v0[3]}), c = gelu_pk((f32x2){v1[0], v1[1]}), d = gelu_pk((f32x2){v1[2], v1[3]});
                        v0 = (f32x4){a.x, a.y, b.x, b.y}; v1 = (f32x4){c.x, c.y, d.x, d.y}; }
                    v0 = v0 * sc; v1 = v1 * sc; u32x4 w; w.x = cvt_pk_bf16(v0[0], v0[1]); w.y = cvt_pk_bf16(v0[2], v0[3]); w.z = cvt_pk_bf16(v1[0], v1[1]); w.w = cvt_pk_bf16(v1[2], v1[3]);
                    *(u32x4*)(rowp + bj * HALF) = w; } }
    }
};
__device__ __forceinline__ float bf_lo(unsigned w) { return __uint_as_float(w << 16); }
__device__ __forceinline__ float bf_hi(unsigned w) { return __uint_as_float(w & 0xffff0000u); }
__device__ __forceinline__ float sigm(float x) { return __builtin_amdgcn_rcpf(1.0f + __expf(-x)); }
__device__ __forceinline__ u32x4 pack8(const f32x4 v0, const f32x4 v1) { u32x4 w; w.x = cvt_pk_bf16(v0[0], v0[1]); w.y = cvt_pk_bf16(v0[2], v0[3]); w.z = cvt_pk_bf16(v1[0], v1[1]); w.w = cvt_pk_bf16(v1[2], v1[3]); return w; }

struct EpiG1 {
    static constexpr bool PERM = true, AFTER_DRAIN = false, KEEP_ACC = false;
    float* PRW; float* BND; bf16_t* PNSA; bf16_t* MG; float* GLOG;
    __device__ __forceinline__ void operator()(const f32x4 (&acc)[2][2][4][2], const Unit& u, int wr, int wc, int fr, int fq) const {
        const int row0 = u.pm * BM + wr * 64 + fr, c0 = wc * 32 + 8 * fq;
#pragma unroll
        for (int ai = 0; ai < 2; ++ai)
#pragma unroll
            for (int m = 0; m < 4; ++m) { const int row = row0 + ai * HALF + m * 16;
#pragma unroll
                for (int bj = 0; bj < 2; ++bj) { const f32x4 v0 = acc[ai][bj][m][0], v1 = acc[ai][bj][m][1]; const int col = c0 + bj * HALF;
                    if (u.pn < 7) { float* p = PRW + (size_t)row * 1792 + u.pn * 256 + col; *(f32x4*)p = v0; *(f32x4*)(p + 4) = v1;
                        if ((row & 63) == 63) { float* q = BND + (size_t)(row >> 6) * 1792 + u.pn * 256 + col; *(f32x4*)q = v0; *(f32x4*)(q + 4) = v1; } }
                    else if (u.pn < 12) { *(u32x4*)(PNSA + (size_t)row * 1280 + (u.pn - 7) * 256 + col) = pack8(v0, v1); }
                    else if (u.pn < 20) { *(u32x4*)(MG + (size_t)row * 2048 + (u.pn - 12) * 256 + col) = pack8(v0, v1); }
                    else { if (col < 32) { float* p = GLOG + (size_t)row * 32 + col; *(f32x4*)p = v0; *(f32x4*)(p + 4) = v1; } }
                } }
    }
};
struct EpiGate1 {
    static constexpr bool PERM = true, AFTER_DRAIN = false, KEEP_ACC = false;
    float* T1; const bf16_t* MG; int goff;
    __device__ __forceinline__ void operator()(const f32x4 (&acc)[2][2][4][2], const Unit& u, int wr, int wc, int fr, int fq) const {
        const int row0 = u.pm * BM + wr * 64 + fr, c0 = u.pn * BM + wc * 32 + 8 * fq;
#pragma unroll
        for (int ai = 0; ai < 2; ++ai)
#pragma unroll
            for (int m = 0; m < 4; ++m) { const int row = row0 + ai * HALF + m * 16;
#pragma unroll
                for (int bj = 0; bj < 2; ++bj) { const f32x4 v0 = acc[ai][bj][m][0], v1 = acc[ai][bj][m][1]; const int col = c0 + bj * HALF;
                    const u32x4 g = *(const u32x4*)(MG + (size_t)row * 2048 + goff + col);
                    f32x4 o0, o1; o0[0] = sigm(bf_lo(g.x)) * v0[0]; o0[1] = sigm(bf_hi(g.x)) * v0[1]; o0[2] = sigm(bf_lo(g.y)) * v0[2]; o0[3] = sigm(bf_hi(g.y)) * v0[3];
                    o1[0] = sigm(bf_lo(g.z)) * v1[0]; o1[1] = sigm(bf_hi(g.z)) * v1[1]; o1[2] = sigm(bf_lo(g.w)) * v1[2]; o1[3] = sigm(bf_hi(g.w)) * v1[3];
                    float* p = T1 + (size_t)row * 1024 + col; *(f32x4*)p = o0; *(f32x4*)(p + 4) = o1; } }
    }
};
struct EpiGate2 {
    static constexpr bool PERM = true, AFTER_DRAIN = false, KEEP_ACC = false;
    const float* T1; const bf16_t* MG; int goff; bf16_t* MIX;
    __device__ __forceinline__ void operator()(const f32x4 (&acc)[2][2][4][2], const Unit& u, int wr, int wc, int fr, int fq) const {
        const int row0 = u.pm * BM + wr * 64 + fr, c0 = u.pn * BM + wc * 32 + 8 * fq;
#pragma unroll
        for (int ai = 0; ai < 2; ++ai)
#pragma unroll
            for (int m = 0; m < 4; ++m) { const int row = row0 + ai * HALF + m * 16;
#pragma unroll
                for (int bj = 0; bj < 2; ++bj) { const f32x4 v0 = acc[ai][bj][m][0], v1 = acc[ai][bj][m][1]; const int col = c0 + bj * HALF;
                    const u32x4 g = *(const u32x4*)(MG + (size_t)row * 2048 + goff + col);
                    const float* p = T1 + (size_t)row * 1024 + col; const f32x4 t0 = *(const f32x4*)p, t1 = *(const f32x4*)(p + 4);
                    f32x4 o0, o1; o0[0] = t0[0] + sigm(bf_lo(g.x)) * v0[0]; o0[1] = t0[1] + sigm(bf_hi(g.x)) * v0[1]; o0[2] = t0[2] + sigm(bf_lo(g.y)) * v0[2]; o0[3] = t0[3] + sigm(bf_hi(g.y)) * v0[3];
                    o1[0] = t1[0] + sigm(bf_lo(g.z)) * v1[0]; o1[1] = t1[1] + sigm(bf_hi(g.z)) * v1[1]; o1[2] = t1[2] + sigm(bf_lo(g.w)) * v1[2]; o1[3] = t1[3] + sigm(bf_hi(g.w)) * v1[3];
                    *(u32x4*)(MIX + (size_t)row * 1024 + col) = pack8(o0, o1); } }
    }
};
struct EpiRes {
    static constexpr bool PERM = true, AFTER_DRAIN = false, KEEP_ACC = false;
    const float* X; float* OUT;
    __device__ __forceinline__ void operator()(const f32x4 (&acc)[2][2][4][2], const Unit& u, int wr, int wc, int fr, int fq) const {
        const int row0 = u.pm * BM + wr * 64 + fr, c0 = u.pn * BM + wc * 32 + 8 * fq;
#pragma unroll
        for (int ai = 0; ai < 2; ++ai)
#pragma unroll
            for (int m = 0; m < 4; ++m) { const int row = row0 + ai * HALF + m * 16;
#pragma unroll
                for (int bj = 0; bj < 2; ++bj) { const size_t off = (size_t)row * 1024 + c0 + bj * HALF;
                    const f32x4 x0 = *(const f32x4*)(X + off), x1 = *(const f32x4*)(X + off + 4);
                    *(f32x4*)(OUT + off) = x0 + acc[ai][bj][m][0]; *(f32x4*)(OUT + off + 4) = x1 + acc[ai][bj][m][1]; } }
    }
};
struct EpiMerge {
    static constexpr bool PERM = true, AFTER_DRAIN = false, KEEP_ACC = true;
    const bf16_t* MG; bf16_t* MIX;
    __device__ __forceinline__ void operator()(f32x4 (&acc)[2][2][4][2], const Unit& u, int wr, int wc, int fr, int fq) const {
        const int row0 = u.pm * BM + wr * 64 + fr, c0 = u.pn * BM + wc * 32 + 8 * fq;
#pragma unroll
        for (int ai = 0; ai < 2; ++ai)
#pragma unroll
            for (int m = 0; m < 4; ++m) { const int row = row0 + ai * HALF + m * 16;
#pragma unroll
                for (int bj = 0; bj < 2; ++bj) { const int col = c0 + bj * HALF;
                    const u32x4 gb = *(const u32x4*)(MG + (size_t)row * 2048 + 1024 + col);
                    const float eb[8] = {__expf(-bf_lo(gb.x)), __expf(-bf_hi(gb.x)), __expf(-bf_lo(gb.y)), __expf(-bf_hi(gb.y)), __expf(-bf_lo(gb.z)), __expf(-bf_hi(gb.z)), __expf(-bf_lo(gb.w)), __expf(-bf_hi(gb.w))};
                    if (u.seg == 0) { const u32x4 ga = *(const u32x4*)(MG + (size_t)row * 2048 + col);
                        const float ea[8] = {__expf(-bf_lo(ga.x)), __expf(-bf_hi(ga.x)), __expf(-bf_lo(ga.y)), __expf(-bf_hi(ga.y)), __expf(-bf_lo(ga.z)), __expf(-bf_hi(ga.z)), __expf(-bf_lo(ga.w)), __expf(-bf_hi(ga.w))};
#pragma unroll
                        for (int e = 0; e < 4; ++e) { acc[ai][bj][m][0][e] *= (1.0f + eb[e]) * __builtin_amdgcn_rcpf(1.0f + ea[e]); acc[ai][bj][m][1][e] *= (1.0f + eb[4 + e]) * __builtin_amdgcn_rcpf(1.0f + ea[4 + e]); } }
                    else { f32x4 o0, o1;
#pragma unroll
                        for (int e = 0; e < 4; ++e) { o0[e] = acc[ai][bj][m][0][e] * __builtin_amdgcn_rcpf(1.0f + eb[e]); o1[e] = acc[ai][bj][m][1][e] * __builtin_amdgcn_rcpf(1.0f + eb[4 + e]); }
                        *(u32x4*)(MIX + (size_t)row * 1024 + col) = pack8(o0, o1); } } }
    }
};
template <class Epi, class Sched, bool ALIGN_EPI = false, bool SP2 = false>
__device__ __forceinline__ void gemm_phase(PG8_LAS unsigned char* lds, const Gemm g, const Sched& S, const Epi& E) {
    const int tid = threadIdx.x, wid = __builtin_amdgcn_readfirstlane(tid >> 6), lane = tid & 63, wr = wid >> 2, wc = wid & 3, fr = lane & 15, fq = lane >> 4;
    const int K = g.K, nt = K / BK;
    unsigned voffA[2], voffB[2];
#pragma unroll
    for (int i = 0; i < 2; ++i) { int R, C; stage_rc(tid * 16 + i * 8192, R, C); const int Rb = Epi::PERM ? ((R & ~31) + perm32(R & 31)) : R;
        voffA[i] = (unsigned)(R * K + C) * 2u; voffB[i] = (unsigned)(Rb * K + C) * 2u; }
    const size_t kstep = (size_t)(BK * 2);
    const size_t hstep = (size_t)HALF * K * 2;
    const size_t tstep = 2 * hstep;
    const unsigned ldsw = (unsigned)wid * 1024u;
    const int aoff = lds_byte(wr * 64 + fr, fq * 8), boff = lds_byte(wc * 32 + fr, fq * 8);
#define PG8_SA(b, h) (((b) * 2 + (h)) * HTB)
#define PG8_SB(b, h) ((4 + (b) * 2 + (h)) * HTB)
#define PG8_STAGE(bufoff, gbase, voff) do { _Pragma("unroll") for (int _i = 0; _i < 2; ++_i) \
        __builtin_amdgcn_global_load_lds((const unsigned*)((const char*)(gbase) + (voff)[_i]), (PG8_LAS unsigned*)(lds + (bufoff) + ldsw + _i * 8192), 16, 0, 0); } while (0)
#define PG8_LDA(dst, b, h) do { _Pragma("unroll") for (int m = 0; m < 4; ++m) _Pragma("unroll") for (int k = 0; k < 2; ++k) dst[m][k] = *(const PG8_LAS bf16x8*)(lds + PG8_SA(b, h) + aoff + m * 2048 + k * 1024); } while (0)
#define PG8_LDB(dst, b, h) do { _Pragma("unroll") for (int n = 0; n < 2; ++n) _Pragma("unroll") for (int k = 0; k < 2; ++k) dst[n][k] = *(const PG8_LAS bf16x8*)(lds + PG8_SB(b, h) + boff + n * 2048 + k * 1024); } while (0)
#define PG8_MMA(ai, bj, At, Bt) do { __builtin_amdgcn_s_setprio(1); _Pragma("unroll") for (int m = 0; m < 4; ++m) _Pragma("unroll") for (int n = 0; n < 2; ++n) _Pragma("unroll") for (int k = 0; k < 2; ++k) \
        acc[ai][bj][m][n] = __builtin_amdgcn_mfma_f32_16x16x32_bf16(Bt[n][k], At[m][k], acc[ai][bj][m][n], 0, 0, 0); __builtin_amdgcn_s_setprio(0); } while (0)
#define PG8_WAIT_V(n) asm volatile("s_waitcnt vmcnt(" #n ")" ::: "memory")
#define PG8_WAIT_L(n) asm volatile("s_waitcnt lgkmcnt(" #n ")" ::: "memory")
#define PG8_BAR __builtin_amdgcn_s_barrier()
#define PG8_SCHED __builtin_amdgcn_sched_barrier(0)
    Unit cur, nxt; int ui = 0;
    if (!S.next(0, cur)) return;
    f32x4 acc[2][2][4][2];
#pragma unroll
    for (int a = 0; a < 2; ++a)
#pragma unroll
        for (int b = 0; b < 2; ++b)
#pragma unroll
            for (int m = 0; m < 4; ++m)
#pragma unroll
                for (int n = 0; n < 2; ++n) acc[a][b][m][n] = (f32x4){0.f, 0.f, 0.f, 0.f};
    bf16x8 At[4][2], B0[2][2], B1[2][2];
    const char* cA = (const char*)(cur.seg ? g.A2 : g.A) + (size_t)cur.pm * tstep; const char* cB = (const char*)(cur.seg ? g.Bt2 : g.Bt) + (size_t)cur.pn * tstep;
    S.a_ready(cur);
    if constexpr (SP2) {
        PG8_STAGE(PG8_SB(0, 0), cB, voffB); PG8_STAGE(PG8_SB(0, 1), cB + hstep, voffB); PG8_STAGE(PG8_SA(0, 0), cA, voffA); PG8_STAGE(PG8_SA(0, 1), cA + hstep, voffA);
        if (wr == 1) PG8_BAR;
        PG8_WAIT_V(2); PG8_BAR;
        PG8_STAGE(PG8_SB(1, 0), cB + kstep, voffB); PG8_STAGE(PG8_SA(1, 0), cA + kstep, voffA); PG8_STAGE(PG8_SB(1, 1), cB + hstep + kstep, voffB);
        PG8_WAIT_V(6); PG8_BAR;
    } else {
        PG8_STAGE(PG8_SB(0, 0), cB, voffB); PG8_STAGE(PG8_SA(0, 0), cA, voffA); PG8_STAGE(PG8_SB(0, 1), cB + hstep, voffB); PG8_STAGE(PG8_SA(0, 1), cA + hstep, voffA);
        if (wr == 1) PG8_BAR;
        PG8_WAIT_V(4); PG8_BAR;
        PG8_STAGE(PG8_SB(1, 0), cB + kstep, voffB); PG8_STAGE(PG8_SA(1, 0), cA + kstep, voffA); PG8_STAGE(PG8_SB(1, 1), cB + hstep + kstep, voffB);
        PG8_WAIT_V(6); PG8_BAR;
    }
    for (;;) {
        const bool has_next = S.next(ui + 1, nxt);
        const char* nA = has_next ? (const char*)(nxt.seg ? g.A2 : g.A) + (size_t)nxt.pm * tstep : cA; const char* nB = has_next ? (const char*)(nxt.seg ? g.Bt2 : g.Bt) + (size_t)nxt.pn * tstep : cB;
        for (int t = 0; t < nt; t += 2) {
            const bool last = (t == nt - 2);
            const char* a1 = cA + (size_t)(t + 1) * kstep;
            const char* a2 = last ? nA : cA + (size_t)(t + 2) * kstep; const char* b2 = last ? nB : cB + (size_t)(t + 2) * kstep;
            const char* a3 = a2 + kstep; const char* b3 = b2 + kstep;
            if (last && has_next) S.a_ready(nxt);
            if constexpr (SP2) {
            PG8_LDB(B0, 0, 0); PG8_LDB(B1, 0, 1); PG8_SCHED; PG8_LDA(At, 0, 0); PG8_STAGE(PG8_SA(1, 1), a1 + hstep, voffA);
            PG8_WAIT_V(8); PG8_WAIT_L(0); PG8_BAR; PG8_MMA(0, 0, At, B0); PG8_MMA(0, 1, At, B1); PG8_BAR; PG8_SCHED;
            PG8_LDA(At, 0, 1); PG8_STAGE(PG8_SB(0, 0), b2, voffB); PG8_STAGE(PG8_SB(0, 1), b2 + hstep, voffB); PG8_STAGE(PG8_SA(0, 0), a2, voffA);
            PG8_WAIT_V(8); PG8_WAIT_L(0); PG8_BAR; PG8_MMA(1, 0, At, B0); PG8_MMA(1, 1, At, B1); PG8_BAR; PG8_SCHED;
            PG8_LDB(B0, 1, 0); PG8_LDB(B1, 1, 1); PG8_SCHED; PG8_LDA(At, 1, 0); PG8_STAGE(PG8_SA(0, 1), a2 + hstep, voffA);
            PG8_WAIT_V(8); PG8_WAIT_L(0); PG8_BAR; PG8_MMA(0, 0, At, B0); PG8_MMA(0, 1, At, B1); PG8_BAR; PG8_SCHED;
            PG8_LDA(At, 1, 1); PG8_STAGE(PG8_SB(1, 0), b3, voffB); PG8_STAGE(PG8_SB(1, 1), b3 + hstep, voffB); PG8_STAGE(PG8_SA(1, 0), a3, voffA);
            PG8_WAIT_V(8); PG8_WAIT_L(0); PG8_BAR; PG8_MMA(1, 0, At, B0); PG8_MMA(1, 1, At, B1); PG8_BAR; PG8_SCHED;
            } else {
            PG8_LDB(B0, 0, 0); PG8_SCHED; PG8_LDA(At, 0, 0); PG8_STAGE(PG8_SA(1, 1), a1 + hstep, voffA);
            PG8_WAIT_L(8); PG8_BAR; PG8_WAIT_L(0); PG8_MMA(0, 0, At, B0); PG8_BAR; PG8_SCHED;
            PG8_LDB(B1, 0, 1); PG8_STAGE(PG8_SB(0, 0), b2, voffB);
            PG8_BAR; PG8_WAIT_L(0); PG8_MMA(0, 1, At, B1); PG8_BAR;
            PG8_LDA(At, 0, 1); PG8_STAGE(PG8_SA(0, 0), a2, voffA);
            PG8_BAR; PG8_WAIT_L(0); PG8_MMA(1, 0, At, B0); PG8_BAR; PG8_SCHED;
            PG8_STAGE(PG8_SB(0, 1), b2 + hstep, voffB);
            PG8_WAIT_V(6); PG8_BAR; PG8_MMA(1, 1, At, B1); PG8_BAR;
            PG8_LDB(B0, 1, 0); PG8_SCHED; PG8_LDA(At, 1, 0); PG8_STAGE(PG8_SA(0, 1), a2 + hstep, voffA);
            PG8_WAIT_L(8); PG8_BAR; PG8_WAIT_L(0); PG8_MMA(0, 0, At, B0); PG8_BAR; PG8_SCHED;
            PG8_LDB(B1, 1, 1); PG8_STAGE(PG8_SB(1, 0), b3, voffB);
            PG8_BAR; PG8_WAIT_L(0); PG8_MMA(0, 1, At, B1); PG8_BAR;
            PG8_LDA(At, 1, 1); PG8_STAGE(PG8_SA(1, 0), a3, voffA);
            PG8_BAR; PG8_WAIT_L(0); PG8_MMA(1, 0, At, B0); PG8_BAR; PG8_SCHED;
            PG8_STAGE(PG8_SB(1, 1), b3 + hstep, voffB);
            PG8_WAIT_V(6); PG8_BAR; PG8_MMA(1, 1, At, B1); PG8_BAR;
            }
        }
        if constexpr (ALIGN_EPI) { if (wr == 0) PG8_BAR; }
        if constexpr (!Epi::AFTER_DRAIN) { E(acc, cur, wr, wc, fr, fq); S.done(cur); }
        if (!has_next) break;
        if (!(Epi::KEEP_ACC && cur.seg == 0))
#pragma unroll
        for (int a = 0; a < 2; ++a)
#pragma unroll
            for (int b = 0; b < 2; ++b)
#pragma unroll
                for (int m = 0; m < 4; ++m)
#pragma unroll
                    for (int n = 0; n < 2; ++n) acc[a][b][m][n] = (f32x4){0.f, 0.f, 0.f, 0.f};
        cur = nxt; cA = nA; cB = nB; ++ui;
        if constexpr (ALIGN_EPI) { if (wr == 1) PG8_BAR; }
    }
    PG8_WAIT_V(0);
    if constexpr (!ALIGN_EPI) { if (wr == 0) PG8_BAR; }
    PG8_BAR;
    if constexpr (Epi::AFTER_DRAIN) { E.fused(acc, cur, wr, wc, fr, fq, lds, wid, lane); S.done(cur); }
#undef PG8_SA
#undef PG8_SB
#undef PG8_STAGE
#undef PG8_LDA
#undef PG8_LDB
#undef PG8_MMA
#undef PG8_WAIT_V
#undef PG8_WAIT_L
#undef PG8_BAR
#undef PG8_SCHED
}
}
#define GAS __attribute__((address_space(1)))
#define LAS __attribute__((address_space(3)))
typedef unsigned short bf16;
typedef unsigned v4u __attribute__((ext_vector_type(4)));
typedef float f32x4 __attribute__((ext_vector_type(4)));
typedef short bf16x8 __attribute__((ext_vector_type(8)));
typedef GAS unsigned gu32;
typedef GAS unsigned long long gu64;
#define RLX_AGENT __ATOMIC_RELAXED, __HIP_MEMORY_SCOPE_AGENT
#define LDS_WAIT() asm volatile("s_waitcnt lgkmcnt(0)" ::: "memory")
#define VM_WAIT() asm volatile("s_waitcnt vmcnt(0)" ::: "memory")
__device__ __forceinline__ unsigned long long rt() { return __builtin_amdgcn_s_memrealtime(); }
__device__ __forceinline__ unsigned f2bf(float f) { unsigned u = __builtin_bit_cast(unsigned, f); return (u + 0x7fffu + ((u >> 16) & 1u)) >> 16; }
__device__ __forceinline__ unsigned pk2(float lo, float hi) { return f2bf(lo) | (f2bf(hi) << 16); }

#define XB_TMO      128
#define XB_XCNT(j)  (256  + 64 * (j))
#define XB_XSUB(j)  (1280 + 64 * (j))
#define XB_XGEN(j)  (2304 + 64 * (j))
#define XB_TOP      3328
#define XB_TOPGEN   3392
#define XCD_BAR_WORDS 3456
#define XB_SPIN_CAP (1u << 18)

__device__ __forceinline__ unsigned xb_ld(unsigned* p)              { return __hip_atomic_load(p, __ATOMIC_RELAXED, __HIP_MEMORY_SCOPE_AGENT); }
__device__ __forceinline__ unsigned xb_add(unsigned* p, unsigned v) { return __hip_atomic_fetch_add(p, v, __ATOMIC_RELAXED, __HIP_MEMORY_SCOPE_AGENT); }
__device__ __forceinline__ unsigned xb_xcc_id() { return (unsigned)__builtin_amdgcn_s_getreg((3 << 11) | 20) & 0xFu; }
#define XB_SPIN(cond, bar) do { unsigned _sp = 0; while (cond) { __builtin_amdgcn_s_sleep(1); \
    if ((++_sp & 255u) == 0u) { if (xb_ld(&(bar)[XB_TMO])) break; if (_sp > XB_SPIN_CAP) { atomicAdd(&(bar)[XB_TMO], 1u); break; } } } } while (0)

struct XcdBarrier {
    unsigned* bar; unsigned x;
    volatile LAS unsigned* st;
};

__device__ __forceinline__ XcdBarrier xcd_barrier_post(unsigned* bar, volatile LAS unsigned* st) {
    XcdBarrier b; b.bar = bar; b.x = xb_xcc_id(); b.st = st;
    if (threadIdx.x == 0) (void)xb_add(&bar[XB_XCNT(b.x)], 1u);
    return b;
}
__device__ __forceinline__ void xcd_barrier_complete(unsigned* bar, unsigned x, unsigned& nloc, unsigned& nx) {
    const unsigned G = gridDim.x * gridDim.y * gridDim.z;
    unsigned sum, cnt, mine, sp = 0u;
    for (;;) {
        sum = 0u; cnt = 0u; mine = 0u;
#pragma unroll
        for (unsigned j = 0; j < 16; ++j) { const unsigned c = xb_ld(&bar[XB_XCNT(j)]); sum += c; cnt += (c > 0u) ? 1u : 0u; mine = (j == x) ? c : mine; }
        if (sum == G) break;
        __builtin_amdgcn_s_sleep(1);
        if ((++sp & 255u) == 0u) { if (xb_ld(&bar[XB_TMO])) break; if (sp > XB_SPIN_CAP) { atomicAdd(&bar[XB_TMO], 1u); break; } }
    }
    nloc = mine > 0u ? mine : 1u; nx = cnt > 0u ? cnt : 1u;
}

__device__ __forceinline__ void xcd_barrier(const XcdBarrier& b) {
    asm volatile("s_waitcnt vmcnt(0)" ::: "memory");
    __syncthreads();
    if (threadIdx.x == 0) {
        unsigned* bar = b.bar;
        __builtin_amdgcn_s_waitcnt(0);
        unsigned nloc = b.st[0], nx = b.st[1];
        if (nloc == 0u) { xcd_barrier_complete(bar, b.x, nloc, nx); b.st[0] = nloc; b.st[1] = nx; }
        const unsigned old = xb_add(&bar[XB_XSUB(b.x)], 1u);
        const unsigned gen = old / nloc;
        if (old + 1u == (gen + 1u) * nloc) {
            __builtin_amdgcn_fence(__ATOMIC_RELEASE, "agent");
            asm volatile("s_waitcnt vmcnt(0)" ::: "memory");
            const unsigned og = xb_add(&bar[XB_TOP], 1u);
            const unsigned tg = og / nx;
            if (og + 1u == (tg + 1u) * nx) xb_add(&bar[XB_TOPGEN], 1u);
            else XB_SPIN(xb_ld(&bar[XB_TOPGEN]) == tg, bar);
            __builtin_amdgcn_fence(__ATOMIC_ACQUIRE, "agent");
            xb_add(&bar[XB_XGEN(b.x)], 1u);
            asm volatile("s_waitcnt vmcnt(0)" ::: "memory");
        } else {
            XB_SPIN(xb_ld(&bar[XB_XGEN(b.x)]) == gen, bar);
            __builtin_amdgcn_fence(__ATOMIC_ACQUIRE, "agent");
            asm volatile("s_waitcnt vmcnt(0)" ::: "memory");
        }
    }
    __syncthreads();
}
constexpr int NWAVES = 8;
constexpr int BATCH = 4, T = 4096, D = 1024, M = BATCH * T;
constexpr int RWC = 1792;
constexpr int NG1 = 5376;
constexpr float NORM_EPS = 1e-6f, GN_EPS = 64e-5f;
constexpr float LOG2E = 1.4426950408889634f;
constexpr int N_PHASES = 13;
#ifndef MK_ONE_LAUNCH
#define MK_ONE_LAUNCH 0
#endif
#ifndef REP_MASK
#define REP_MASK 0
#endif
#ifndef DBG_SCALE
#define DBG_SCALE 4e-4f
#endif
#ifndef DBG_SEL
#define DBG_SEL -1
#endif
#ifndef NSA_SKIP
#define NSA_SKIP 0
#endif
#ifndef P3REP
#define P3REP 1
#endif
#ifndef SCAN_BLOCKS
#define SCAN_BLOCKS 128
#endif

constexpr size_t MiB = 1u << 20;
constexpr size_t WS_CTL = 0, CTL_ZERO_BYTES = 1 * MiB;
constexpr size_t WS_WIN = 1 * MiB;
constexpr size_t WS_WA = 12 * MiB, WS_WB = 13 * MiB;
constexpr size_t WS_WOUT = 14 * MiB;
constexpr size_t WS_WQ = 16 * MiB;
constexpr size_t WS_CW1K = 20 * MiB, WS_CW1V = 21 * MiB;
constexpr size_t WS_CW2K = 22 * MiB, WS_CW2V = 22 * MiB + 65536;
constexpr size_t WS_SK1 = 22 * MiB + 131072, WS_SK2 = 22 * MiB + 196608;
constexpr size_t WS_WUT = 22 * MiB + 262144, WS_AUT = WS_WUT + 65536, WS_GUT = WS_WUT + 131072;
constexpr size_t WS_BND = 23 * MiB;
constexpr size_t WS_KC = 25 * MiB;
constexpr size_t WS_VCT = 25 * MiB + 262144;
constexpr size_t WS_H = 26 * MiB;
constexpr size_t WS_PRW = 58 * MiB;
constexpr size_t WS_MG = 170 * MiB;
constexpr size_t WS_VST = 234 * MiB, WS_VWT = 238 * MiB;
constexpr size_t WS_END = 256 * MiB;
constexpr size_t DO_PNSA = 0, DO_G = 40 * MiB, DO_GLOG = 56 * MiB;
constexpr int CW_TMO = 0, CW_CODE = 1, CW_NSAQ = 64, CW_SCANP = 2048, CW_PEERQ = 4160, CW_BAR = 8192;

constexpr int RING_OFF = 0, RING_BYTES = 131072;
constexpr int LDSCTL_OFF = RING_BYTES, MISC_OFF = LDSCTL_OFF + 320;
constexpr int LDS_BYTES = 147456;
typedef unsigned short u16;
typedef unsigned u32x2 __attribute__((ext_vector_type(2)));
struct Frame {
    LAS unsigned char* lds;
    volatile LAS unsigned* MISC;
    gu32* ctl;
    int tid, lane, wave, vcu, G;
    const float* in[33];
    float* out; unsigned char* ws;
};
__device__ __forceinline__ float wave_sum(float v) {
#pragma unroll
    for (int o = 1; o < 64; o <<= 1) v += __shfl_xor(v, o);
    return v;
}
template <int CTRL> __device__ __forceinline__ float dppf(float x) { return __builtin_bit_cast(float, __builtin_amdgcn_update_dpp(0, __builtin_bit_cast(int, x), CTRL, 0xf, 0xf, true)); }
__device__ __forceinline__ float bf2f(u16 b) { return __uint_as_float((unsigned)b << 16); }
__device__ __forceinline__ float bflo(unsigned w) { return __uint_as_float(w << 16); }
__device__ __forceinline__ float bfhi(unsigned w) { return __uint_as_float(w & 0xffff0000u); }
__device__ __forceinline__ u16 f2b(float f) { return (u16)pg8::cvt_pk_bf16(f, 0.f); }
#define pk2(lo_, hi_) pg8::cvt_pk_bf16((lo_), (hi_))
__device__ __forceinline__ float sigmf(float x) { return __builtin_amdgcn_rcpf(1.0f + __expf(-x)); }
__device__ __forceinline__ float tanh_fast(float x) { return 1.0f - 2.0f * __builtin_amdgcn_rcpf(1.0f + __expf(2.0f * x)); }
__device__ __forceinline__ f32x4 mfma16(const bf16x8 a, const bf16x8 b, const f32x4 c) { return __builtin_amdgcn_mfma_f32_16x16x32_bf16(a, b, c, 0, 0, 0); }
__device__ __forceinline__ bf16x8 as_bf16x8(const v4u v) { return __builtin_bit_cast(bf16x8, v); }
typedef short bf16x4 __attribute__((ext_vector_type(4)));
__device__ __forceinline__ f32x4 mfma16k16(const bf16x4 a, const bf16x4 b, const f32x4 c) { const bf16x8 a8 = {a[0], a[1], a[2], a[3], 0, 0, 0, 0}, b8 = {b[0], b[1], b[2], b[3], 0, 0, 0, 0}; return __builtin_amdgcn_mfma_f32_16x16x32_bf16(a8, b8, c, 0, 0, 0); }
__device__ __forceinline__ bf16x4 as_bf16x4(const u32x2 v) { return __builtin_bit_cast(bf16x4, v); }
__device__ __forceinline__ bf16x4 pack4(const f32x4 a) { u32x2 w; w.x = pg8::cvt_pk_bf16(a[0], a[1]); w.y = pg8::cvt_pk_bf16(a[2], a[3]); return as_bf16x4(w); }

__device__ __forceinline__ void tr_item(const float* W, int K, int ldw, int sc0, int nblk, int ncols_valid, bf16* WT, int dr0, LAS float* scr, int item, int lane) {
    const int kb = item / nblk, nb = item % nblk, k0 = 64 * kb, n0 = 32 * nb;
#pragma unroll 8
    for (int i = 0; i < 32; ++i) { const int kk = 2 * i + (lane >> 5); const int n = n0 + (lane & 31); const int nc = (n < ncols_valid) ? n : 0;
        const float v = W[(size_t)(k0 + kk) * ldw + sc0 + nc]; scr[kk * 33 + (lane & 31)] = (n < ncols_valid) ? v : 0.f; }
    LDS_WAIT(); asm volatile("" ::: "memory");
    const int c = lane & 7;
#pragma unroll
    for (int j = 0; j < 4; ++j) { const int n = (lane >> 3) + 8 * j; const LAS float* s = scr + (8 * c) * 33 + n;
        v4u o; o.x = pk2(s[0 * 33], s[1 * 33]); o.y = pk2(s[2 * 33], s[3 * 33]); o.z = pk2(s[4 * 33], s[5 * 33]); o.w = pk2(s[6 * 33], s[7 * 33]);
        *(GAS v4u*)(WT + (size_t)(dr0 + n0 + n) * K + k0 + 8 * c) = o; }
    LDS_WAIT(); asm volatile("" ::: "memory");
}
__device__ __forceinline__ void rms_row_to_bf16(int lane, const float* xrow, const float* gain, bf16* orow) {
    const GAS f32x4* xr = (const GAS f32x4*)xrow + lane; const GAS f32x4* gr = (const GAS f32x4*)gain + lane;
    f32x4 v[4]; float s2 = 0.f;
#pragma unroll
    for (int j = 0; j < 4; ++j) { v[j] = xr[64 * j]; s2 += (v[j].x * v[j].x + v[j].y * v[j].y) + (v[j].z * v[j].z + v[j].w * v[j].w); }
    const float rstd = 1.f / sqrtf(wave_sum(s2) * (1.f / D) + NORM_EPS);
    GAS unsigned long long* o8 = (GAS unsigned long long*)orow + lane;
#pragma unroll
    for (int j = 0; j < 4; ++j) { const f32x4 g = gr[64 * j];
        o8[64 * j] = (unsigned long long)pk2(v[j].x * rstd * g.x, v[j].y * rstd * g.y) | ((unsigned long long)pk2(v[j].z * rstd * g.z, v[j].w * rstd * g.w) << 32); }
}
__device__ __forceinline__ void p0_prologue(const Frame& F) {
    LAS float* scr = (LAS float*)(F.lds + RING_OFF + F.wave * 16384);
    const int gw = F.vcu * NWAVES + F.wave, NGW = F.G * NWAVES;
    unsigned char* ws = F.ws;
    constexpr int I0 = 16 * 96, I1 = 16 * 64, I2 = 16 * 8, I3 = 8 * 32, I4 = 8 * 32, I5 = 16 * 32, I6 = 16 * 64, I7 = 32 * 8, I8 = 32 * 8, I9 = 4 * 2, I10 = 4 * 2, I11 = 16, I12 = 16, I13 = 32;
    constexpr int NITEMS = I0 + I1 + I2 + I3 + I4 + I5 + I6 + I7 + I8 + I9 + I10 + I11 + I12 + I13;
    for (int it = gw; it < NITEMS; it += NGW) {
        int r = it;
        if (r < I0) { tr_item(F.in[2], 1024, 5144, 0, 96, 3072, (bf16*)(ws + WS_WIN), 0, scr, r, F.lane); continue; } r -= I0;
        if (r < I1) { tr_item(F.in[2], 1024, 5144, 3096, 64, 2048, (bf16*)(ws + WS_WIN), 3072, scr, r, F.lane); continue; } r -= I1;
        if (r < I2) { tr_item(F.in[2], 1024, 5144, 3072, 8, 24, (bf16*)(ws + WS_WIN), 5120, scr, r, F.lane); continue; } r -= I2;
        if (r < I3) { tr_item(F.in[24], 512, 1024, 0, 32, 1024, (bf16*)(ws + WS_WA), 0, scr, r, F.lane); continue; } r -= I3;
        if (r < I4) { tr_item(F.in[25], 512, 1024, 0, 32, 1024, (bf16*)(ws + WS_WB), 0, scr, r, F.lane); continue; } r -= I4;
        if (r < I5) { tr_item(F.in[26], 1024, 1024, 0, 32, 1024, (bf16*)(ws + WS_WOUT), 0, scr, r, F.lane); continue; } r -= I5;
        if (r < I6) { tr_item(F.in[28], 1024, 2048, 0, 64, 2048, (bf16*)(ws + WS_WQ), 0, scr, r, F.lane); continue; } r -= I6;
        if (r < I7) { tr_item(F.in[20], 2048, 256, 0, 8, 256, (bf16*)(ws + WS_CW1K), 0, scr, r, F.lane); continue; } r -= I7;
        if (r < I8) { tr_item(F.in[22], 2048, 256, 0, 8, 256, (bf16*)(ws + WS_CW1V), 0, scr, r, F.lane); continue; } r -= I8;
        if (r < I9) { tr_item(F.in[21], 256, 64, 0, 2, 64, (bf16*)(ws + WS_CW2K), 0, scr, r, F.lane); continue; } r -= I9;
        if (r < I10) { tr_item(F.in[23], 256, 64, 0, 2, 64, (bf16*)(ws + WS_CW2V), 0, scr, r, F.lane); continue; } r -= I10;
        if (r < I11) { tr_item(F.in[5], 64, 512, 0, 16, 512, (bf16*)(ws + WS_WUT), 0, scr, r, F.lane); continue; } r -= I11;
        if (r < I12) { tr_item(F.in[7], 64, 512, 0, 16, 512, (bf16*)(ws + WS_AUT), 0, scr, r, F.lane); continue; } r -= I12;
        tr_item(F.in[8], 128, 512, 0, 16, 512, (bf16*)(ws + WS_GUT), 0, scr, r, F.lane);
    }
    { const int gt = F.vcu * (NWAVES * 64) + F.tid, NT = F.G * NWAVES * 64;
      bf16* s1 = (bf16*)(ws + WS_SK1); bf16* s2 = (bf16*)(ws + WS_SK2);
      for (int i = gt; i < 128 * 128; i += NT) { s1[i] = f2b(F.in[29][i]); s2[i] = f2b(F.in[30][i]); } }
    for (int m = gw; m < M; m += NGW) rms_row_to_bf16(F.lane, F.in[0] + (size_t)m * D, F.in[1], (bf16*)(ws + WS_H) + (size_t)m * D);
}
constexpr int REC_BYTES = 13696;
constexpr int RO_KT = 0, RO_RT = 2048, RO_BH = 4096, RO_KH = 6144, RO_VT = 8192, RO_UV = 10240, RO_MB = 12288, RO_MK = 12800, RO_GAM = 13312, RO_BON = 13568;
__device__ __forceinline__ void rwkv_prep_tile(const Frame& F, int u) {
    const int tid = F.tid, lane = F.lane, h = F.wave, r16 = lane & 15, q4 = lane >> 4;
    const int R0 = 64 * u, t0 = R0 & (T - 1);
    LAS bf16* linb = (LAS bf16*)(F.lds);
    LAS bf16* mats = (LAS bf16*)(F.lds + 16384) + h * 4096;
    LAS float* abl = (LAS float*)(F.lds + 16384 + 65536) + h * 272;
    LAS bf16* ktT = (LAS bf16*)(F.lds + 16384 + 65536 + 8704) + h * 1024;
    LAS bf16* vtT = (LAS bf16*)(F.lds + 16384 + 65536 + 8704 + 16384) + h * 1024;
    float* PRW = (float*)(F.ws + WS_PRW);
    const float* BND = (const float*)(F.ws + WS_BND);
    bf16* G = (bf16*)((unsigned char*)F.out + DO_G);
    const float* mu = F.in[3];
    const float mu_r = mu[tid], mu_k = mu[512 + tid], mu_v = mu[1024 + tid], mu_l = (tid < 256) ? mu[1536 + tid] : 0.f;
    const float w0c = F.in[4][tid], a0c = F.in[6][tid], kkc = F.in[9][tid], kac = F.in[10][tid], rkc = F.in[11][tid];
    const float* w_up = F.in[5]; const float* a_up = F.in[7]; const float* g_up = F.in[8];
    float pr = 0.f, pk = 0.f, pv = 0.f, pl = 0.f;
    if (t0 != 0) { const float* b = BND + (size_t)(u - 1) * RWC; pr = b[tid]; pk = b[512 + tid]; pv = b[1024 + tid]; if (tid < 256) pl = b[1536 + tid]; }
    for (int batch = 0; batch < 4; ++batch) {
        const int Rb = R0 + 16 * batch;
        if (DBG_SEL == 30 && batch == 0 && blockIdx.x == 0 && tid == 0) F.MISC[20] = (unsigned)__builtin_amdgcn_s_memrealtime();
        float xr[16], xk[16]; unsigned vtw[8];
        if (tid < 256) { float xl[16];
#pragma unroll
            for (int j = 0; j < 16; ++j) xl[j] = PRW[(size_t)(Rb + j) * RWC + 1536 + tid];
#pragma unroll
            for (int j = 0; j < 16; ++j) { const float n = xl[j]; const float v = n + (pl - n) * mu_l; pl = n; const float f = (tid < 64) ? tanh_fast(v) : ((tid < 128) ? v : sigmf(v)); linb[j * 256 + tid] = f2b(f); } }
        { float xv[16];
#pragma unroll
          for (int j = 0; j < 16; ++j) { const float* p = PRW + (size_t)(Rb + j) * RWC; xr[j] = p[tid]; xk[j] = p[512 + tid]; xv[j] = p[1024 + tid]; }
          VM_WAIT();
#pragma unroll
          for (int j = 0; j < 16; ++j) { float n;
              n = xr[j]; xr[j] = n + (pr - n) * mu_r; pr = n;
              n = xk[j]; xk[j] = n + (pk - n) * mu_k; pk = n;
              n = xv[j]; const unsigned vb = f2bf(n + (pv - n) * mu_v); pv = n;
              if (j & 1) vtw[j >> 1] |= vb << 16; else vtw[j >> 1] = vb; } }
        __syncthreads();
        { unsigned char* rec0 = (unsigned char*)(PRW + (size_t)Rb * RWC) + h * REC_BYTES;
          v4u* vp = (v4u*)(rec0 + RO_VT + lane * 32); vp[0] = (v4u){vtw[0], vtw[1], vtw[2], vtw[3]}; vp[1] = (v4u){vtw[4], vtw[5], vtw[6], vtw[7]};
          LAS v4u* vl = (LAS v4u*)(vtT + lane * 16); vl[0] = (v4u){vtw[0], vtw[1], vtw[2], vtw[3]}; vl[1] = (v4u){vtw[4], vtw[5], vtw[6], vtw[7]}; }
        if ((DBG_SEL == 30 || DBG_SEL == 31) && batch == 0 && blockIdx.x == 0 && tid == 0) F.MISC[20 + (DBG_SEL == 30)] = (unsigned)__builtin_amdgcn_s_memrealtime();
        float accw[16], acca[16];
        { const bf16* WUT = (const bf16*)(F.ws + WS_WUT); const bf16* AUT = (const bf16*)(F.ws + WS_AUT); const bf16* GUT = (const bf16*)(F.ws + WS_GUT);
          const f32x4 Z4 = {0.f, 0.f, 0.f, 0.f};
          bf16x8 af[8];
#pragma unroll
          for (int ks = 0; ks < 8; ++ks) af[ks] = as_bf16x8(*(const LAS v4u*)(linb + r16 * 256 + 32 * ks + 8 * q4));
          LAS float* ow = (LAS float*)mats;
#pragma unroll
          for (int nt = 0; nt < 4; ++nt) { const int col = 64 * h + 16 * nt + r16;
              f32x4 cw = Z4, ca = Z4, cg = Z4;
#pragma unroll
              for (int ks = 0; ks < 2; ++ks) { cw = mfma16(af[ks], as_bf16x8(*(const v4u*)(WUT + (size_t)col * 64 + 32 * ks + 8 * q4)), cw); ca = mfma16(af[2 + ks], as_bf16x8(*(const v4u*)(AUT + (size_t)col * 64 + 32 * ks + 8 * q4)), ca); }
#pragma unroll
              for (int ks = 0; ks < 4; ++ks) cg = mfma16(af[4 + ks], as_bf16x8(*(const v4u*)(GUT + (size_t)col * 128 + 32 * ks + 8 * q4)), cg);
#pragma unroll
              for (int r = 0; r < 4; ++r) { const int tok = 4 * q4 + r; ow[tok * 64 + 16 * nt + r16] = cw[r]; ow[1024 + tok * 64 + 16 * nt + r16] = ca[r]; G[(size_t)(Rb + tok) * 512 + col] = f2b(cg[r]); } }
          LDS_WAIT(); asm volatile("" ::: "memory");
#pragma unroll
          for (int j = 0; j < 16; ++j) { accw[j] = ow[j * 64 + lane]; acca[j] = ow[1024 + j * 64 + lane]; }
          LDS_WAIT(); asm volatile("" ::: "memory"); }
        if ((DBG_SEL == 31 || DBG_SEL == 32) && batch == 0 && blockIdx.x == 0 && tid == 0) F.MISC[20 + (DBG_SEL == 31)] = (unsigned)__builtin_amdgcn_s_memrealtime();
        unsigned char* rec = (unsigned char*)(PRW + (size_t)Rb * RWC) + h * REC_BYTES;
        { float g = 1.f;
          LAS bf16* mp = mats + lane; bf16* rBh = (bf16*)(rec + RO_BH) + lane * 16; bf16* rKh = (bf16*)(rec + RO_KH) + lane * 16;
#pragma unroll
          for (int j = 0; j < 16; ++j) {
              const float z = -(w0c + accw[j]); const float sp = fmaxf(z, 0.f) + __logf(1.0f + __expf(-fabsf(z)));
              const float wj = __expf(-__expf(-sp - 0.5f));
              const float a = sigmf(a0c + acca[j]);
              const float kkv = xk[j] * kkc; const float kmod = xk[j] * (1.f + (a - 1.f) * kac);
              const float ss = wave_sum(kkv * kkv); const float kkn = kkv * rsqrtf(fmaxf(ss, 1e-24f));
              const float bon = wave_sum(xr[j] * kmod * rkc);
              if (lane == 0) *(float*)(rec + RO_BON + 4 * j) = bon;
              const float gp = g; g *= wj; const float ig = __builtin_amdgcn_rcpf(g);
              const unsigned w1 = pg8::cvt_pk_bf16(kkn * gp, xr[j] * g), w2 = pg8::cvt_pk_bf16(kkn * a * ig, kmod * ig);
              mp[j * 64] = (u16)(w1 & 0xffffu); mp[1024 + j * 64] = (u16)(w1 >> 16); mp[2048 + j * 64] = (u16)(w2 & 0xffffu); mp[3072 + j * 64] = (u16)(w2 >> 16);
              ktT[lane * 16 + j] = (u16)(w1 & 0xffffu);
              rBh[j] = (u16)(w2 & 0xffffu); rKh[j] = (u16)(w2 >> 16);
              __builtin_amdgcn_sched_barrier(0); }
          *(float*)(rec + RO_GAM + 4 * lane) = g;
          }
        LDS_WAIT(); asm volatile("" ::: "memory");
#pragma unroll
        for (int i = 0; i < 2; ++i) { const int pi = lane + 64 * i, s = pi >> 3, ks = (pi >> 2) & 1, qq = pi & 3;
            const LAS bf16* src = mats + 1024 + s * 64 + 32 * ks + 4 * qq;
            const u32x2 lo = *(const LAS u32x2*)src, hi = *(const LAS u32x2*)(src + 16);
            *(v4u*)(rec + RO_RT + pi * 16) = (v4u){lo.x, lo.y, hi.x, hi.y}; }
        LDS_WAIT(); asm volatile("" ::: "memory");
        { f32x4 Ab = {0.f, 0.f, 0.f, 0.f}, Ak = Ab, Mb = Ab, Mk = Ab;
#pragma unroll
          for (int ks = 0; ks < 2; ++ks) { const int off = r16 * 64 + 32 * ks + 8 * q4;
              const bf16x8 aK = as_bf16x8(*(const LAS v4u*)(mats + off)), aR = as_bf16x8(*(const LAS v4u*)(mats + 1024 + off)), bB = as_bf16x8(*(const LAS v4u*)(mats + 2048 + off)), bK = as_bf16x8(*(const LAS v4u*)(mats + 3072 + off));
              Ab = mfma16(aK, bB, Ab); Ak = mfma16(aK, bK, Ak); Mb = mfma16(aR, bB, Mb); Mk = mfma16(aR, bK, Mk); }
          LDS_WAIT(); asm volatile("" ::: "memory");
          bf16* rMb = (bf16*)(rec + RO_MB); bf16* rMk = (bf16*)(rec + RO_MK);
          LAS bf16* akl = mats + 3072;
#pragma unroll
          for (int r = 0; r < 4; ++r) { const int s = 4 * q4 + r, j = r16; const bool lo = j < s, le = j <= s;
              abl[s * 17 + j] = lo ? Ab[r] : 0.f; akl[s * 16 + j] = f2b(lo ? Ak[r] : 0.f); rMb[s * 16 + j] = f2b(le ? Mb[r] : 0.f); rMk[s * 16 + j] = f2b(le ? Mk[r] : 0.f); }
          }
        LDS_WAIT(); asm volatile("" ::: "memory");
        { float Tr[16]; LAS bf16* ntl = mats + 3072 + 256;
#pragma unroll
          for (int s = 0; s < 16; ++s) { float t = (r16 == s) ? 1.f : 0.f;
#pragma unroll
              for (int j = 0; j < s; ++j) t -= abl[s * 17 + j] * Tr[j];
              Tr[s] = t; if (lane < 16) ntl[s * 16 + r16] = f2b(-t); __builtin_amdgcn_sched_barrier(0); } }
        LDS_WAIT(); asm volatile("" ::: "memory");
        { const f32x4 Z4 = {0.f, 0.f, 0.f, 0.f};
          const bf16x4 ntf = as_bf16x4(*(const LAS u32x2*)(mats + 3072 + 256 + r16 * 16 + 4 * q4)), akf = as_bf16x4(*(const LAS u32x2*)(mats + 3072 + r16 * 16 + 4 * q4));
          bf16* rKt = (bf16*)(rec + RO_KT);
#pragma unroll
          for (int nt = 0; nt < 4; ++nt) {
              const bf16x4 ktf = as_bf16x4(*(const LAS u32x2*)(ktT + (16 * nt + r16) * 16 + 4 * q4)), vtf = as_bf16x4(*(const LAS u32x2*)(vtT + (16 * nt + r16) * 16 + 4 * q4));
              const f32x4 kp = mfma16k16(ntf, ktf, Z4);
              const f32x4 akv = mfma16k16(akf, vtf, Z4);
              const f32x4 uv = mfma16k16(ntf, pack4(akv), Z4);
              const int pos = (nt >> 1) * 32 + (r16 >> 2) * 8 + (nt & 1) * 4 + (r16 & 3);
#pragma unroll
              for (int r = 0; r < 4; ++r) rKt[(4 * q4 + r) * 64 + pos] = f2b(kp[r]);
              *(u32x2*)(rec + RO_UV + ((16 * nt + r16) * 16 + 4 * q4) * 2) = __builtin_bit_cast(u32x2, pack4(uv)); } }
        LDS_WAIT(); asm volatile("" ::: "memory");
        __syncthreads();
        if (DBG_SEL == 32 && batch == 0 && blockIdx.x == 0 && tid == 0) F.MISC[21] = (unsigned)__builtin_amdgcn_s_memrealtime();
    }
}
__device__ __forceinline__ void nsa_prep_tile(const Frame& F, int u) {
    const int lane = F.lane, w = F.wave;
    const int R0 = 64 * u, t0 = R0 & (T - 1), b = R0 / T;
    bf16* PNSA = (bf16*)((unsigned char*)F.out + DO_PNSA);
    const float qg = F.in[14][lane] * (0.125f * LOG2E);
    const float kg = (w < 2) ? F.in[16][lane] : F.in[17][lane];
    const int kcol = ((w < 2) ? 768 : 1024) + (w & 1) * 64 + lane;
#pragma unroll 1
    for (int tg = 0; tg < 4; ++tg) { float qv[16], kv[16];
#pragma unroll
        for (int i = 0; i < 16; ++i) { const bf16* p = PNSA + (size_t)(R0 + 16 * tg + i) * 1280; qv[i] = bf2f(p[w * 64 + lane]); kv[i] = (w < 4) ? bf2f(p[kcol]) : 0.f; }
#pragma unroll
        for (int i = 0; i < 16; ++i) { bf16* p = PNSA + (size_t)(R0 + 16 * tg + i) * 1280;
            const float ss = wave_sum(qv[i] * qv[i]) * (1.f / 64.f);
            p[w * 64 + lane] = f2b(qv[i] * rsqrtf(ss + NORM_EPS) * qg);
            if (w < 4) { const float ks = wave_sum(kv[i] * kv[i]) * (1.f / 64.f); p[kcol] = f2b(kv[i] * rsqrtf(ks + NORM_EPS) * kg); } } }
    if (w >= 4) {
        const int g = w & 1; const int scol = ((w < 6) ? 896 : 1152) + g * 64;
        bf16* VT = (bf16*)(F.ws + ((w < 6) ? WS_VST : WS_VWT)) + (size_t)((b * 2 + g) * 64) * T + (size_t)((t0 + lane) >> 5) * 2048 + ((t0 + lane) & 31);
        const v4u* src = (const v4u*)(PNSA + (size_t)(R0 + lane) * 1280 + scol);
        v4u v[8];
#pragma unroll
        for (int i = 0; i < 8; ++i) v[i] = src[i];
#pragma unroll
        for (int i = 0; i < 8; ++i) {
            VT[(8 * i + 0) * 32] = (u16)(v[i].x & 0xffffu); VT[(8 * i + 1) * 32] = (u16)(v[i].x >> 16);
            VT[(8 * i + 2) * 32] = (u16)(v[i].y & 0xffffu); VT[(8 * i + 3) * 32] = (u16)(v[i].y >> 16);
            VT[(8 * i + 4) * 32] = (u16)(v[i].z & 0xffffu); VT[(8 * i + 5) * 32] = (u16)(v[i].z >> 16);
            VT[(8 * i + 6) * 32] = (u16)(v[i].w & 0xffffu); VT[(8 * i + 7) * 32] = (u16)(v[i].w >> 16); }
    }
}
__device__ __forceinline__ float gelu_tanh(float x) { const float t = 0.7978845608028654f * (x + 0.044715f * x * x * x); return 0.5f * x * (1.f + tanh_fast(t)); }
__device__ __forceinline__ void compress_unit(const Frame& F, int u) {
    const int lane = F.lane, w = F.wave, r16 = lane & 15, q4 = lane >> 4;
    const int kvsel = u >> 7, b = (u >> 5) & 3, g = (u >> 4) & 1, ntile = u & 15;
    const bf16* X = (const bf16*)((unsigned char*)F.out + DO_PNSA) + (size_t)(b * T) * 1280 + (kvsel ? 640 : 512) + g * 64;
    const float* pos = kvsel ? F.in[19] : F.in[18];
    const bf16* W1t = (const bf16*)(F.ws + (kvsel ? WS_CW1V : WS_CW1K));
    const bf16* W2t = (const bf16*)(F.ws + (kvsel ? WS_CW2V : WS_CW2K));
    LAS bf16* hid = (LAS bf16*)(F.lds);
    LAS float* outb = (LAS float*)(F.lds + 16 * 528);
    int n = 16 * ntile + r16; if (n > 254) n = 254;
    f32x4 acc[2] = {{0.f, 0.f, 0.f, 0.f}, {0.f, 0.f, 0.f, 0.f}};
#pragma unroll 4
    for (int s = 0; s < 64; ++s) { const int lp = s >> 1, d0 = (s & 1) * 32 + 8 * q4;
        const v4u xa = *(const v4u*)(X + (size_t)(16 * n + lp) * 1280 + d0);
        const f32x4 p0 = *(const f32x4*)(pos + lp * 64 + d0), p1 = *(const f32x4*)(pos + lp * 64 + d0 + 4);
        v4u af; af.x = pk2(bflo(xa.x) + p0[0], bfhi(xa.x) + p0[1]); af.y = pk2(bflo(xa.y) + p0[2], bfhi(xa.y) + p0[3]);
        af.z = pk2(bflo(xa.z) + p1[0], bfhi(xa.z) + p1[1]); af.w = pk2(bflo(xa.w) + p1[2], bfhi(xa.w) + p1[3]);
#pragma unroll
        for (int nt = 0; nt < 2; ++nt) { const v4u bfg = *(const v4u*)(W1t + (size_t)(32 * w + 16 * nt + r16) * 2048 + 32 * s + 8 * q4);
            acc[nt] = mfma16(as_bf16x8(af), as_bf16x8(bfg), acc[nt]); } }
#pragma unroll
    for (int nt = 0; nt < 2; ++nt)
#pragma unroll
        for (int r = 0; r < 4; ++r) hid[(4 * q4 + r) * 264 + 32 * w + 16 * nt + r16] = f2b(gelu_tanh(acc[nt][r]));
    __syncthreads();
    if (w < 4) { f32x4 a2 = {0.f, 0.f, 0.f, 0.f};
#pragma unroll
        for (int s = 0; s < 8; ++s) { const v4u af = *(const LAS v4u*)(hid + r16 * 264 + 32 * s + 8 * q4);
            const v4u bfg = *(const v4u*)(W2t + (size_t)(16 * w + r16) * 256 + 32 * s + 8 * q4);
            a2 = mfma16(as_bf16x8(af), as_bf16x8(bfg), a2); }
#pragma unroll
        for (int r = 0; r < 4; ++r) outb[(4 * q4 + r) * 64 + 16 * w + r16] = a2[r]; }
    __syncthreads();
#pragma unroll
    for (int rr = 0; rr < 2; ++rr) { const int row = 2 * w + rr; const int nn = 16 * ntile + row; float val = outb[row * 64 + lane];
        if (kvsel == 0) { const float ss = wave_sum(val * val) * (1.f / 64.f); val = val * rsqrtf(ss + NORM_EPS) * F.in[15][lane];
            ((bf16*)(F.ws + WS_KC))[(size_t)((b * 2 + g) * 256 + nn) * 64 + lane] = (nn < 255) ? f2b(val) : (u16)0; }
        else ((bf16*)(F.ws + WS_VCT))[(size_t)((b * 2 + g) * 64 + lane) * 256 + nn] = (nn < 255) ? f2b(val) : (u16)0; }
    __syncthreads();
}
__device__ __forceinline__ bf16x8 pack_p(const f32x4 a, const f32x4 b) {
    v4u w; w.x = pg8::cvt_pk_bf16(a[0], a[1]); w.y = pg8::cvt_pk_bf16(a[2], a[3]); w.z = pg8::cvt_pk_bf16(b[0], b[1]); w.w = pg8::cvt_pk_bf16(b[2], b[3]); return as_bf16x8(w);
}
#define NSA_FENCE() asm volatile("s_waitcnt lgkmcnt(0)" ::: "memory")
struct KFr { bf16x8 a0, a1, b0, b1; };
struct VFr { bf16x8 v[4]; };
__device__ __forceinline__ KFr lds_k(const LAS unsigned char* ks, int r16, int q4) {
    const int rA = 8 * (r16 >> 2) + (r16 & 3), rB = rA + 4; const int xA = (rA >> 1) & 7, xB = (rB >> 1) & 7;
    KFr f; f.a0 = as_bf16x8(*(const LAS v4u*)(ks + rA * 128 + ((q4 ^ xA) << 4))); f.a1 = as_bf16x8(*(const LAS v4u*)(ks + rA * 128 + (((4 + q4) ^ xA) << 4)));
    f.b0 = as_bf16x8(*(const LAS v4u*)(ks + rB * 128 + ((q4 ^ xB) << 4))); f.b1 = as_bf16x8(*(const LAS v4u*)(ks + rB * 128 + (((4 + q4) ^ xB) << 4))); return f;
}
__device__ __forceinline__ VFr lds_v(const LAS unsigned char* vs, int r16, int q4) {
    VFr f;
#pragma unroll
    for (int dt = 0; dt < 4; ++dt) { const int d = 16 * dt + r16; f.v[dt] = as_bf16x8(*(const LAS v4u*)(vs + d * 64 + ((q4 ^ ((d >> 2) & 3)) << 4))); }
    return f;
}
struct NsaSrc { const bf16* kb; int krs; const bf16* vb; int vrs; int vtiled; };
__device__ __forceinline__ v4u nsa_stage_load(const NsaSrc& S, int k0, int tid) {
    if (tid < 256) return *(const v4u*)(S.kb + (size_t)(k0 + (tid >> 3)) * S.krs + 8 * (tid & 7));
    const int i = tid - 256, d = i >> 2, c = i & 3;
    return S.vtiled ? *(const v4u*)(S.vb + (size_t)(k0 >> 5) * 2048 + d * 32 + 8 * c) : *(const v4u*)(S.vb + (size_t)d * S.vrs + k0 + 8 * c);
}
__device__ __forceinline__ void nsa_stage_write(LAS unsigned char* lds, int slot, int tid, const v4u v) {
    if (tid < 256) { const int r = tid >> 3, c = tid & 7; *(LAS v4u*)(lds + slot * 4096 + r * 128 + ((c ^ ((r >> 1) & 7)) << 4)) = v; }
    else { const int i = tid - 256, d = i >> 2, c = i & 3; *(LAS v4u*)(lds + 8192 + slot * 4096 + d * 64 + ((c ^ ((d >> 2) & 3)) << 4)) = v; }
}
__device__ __forceinline__ void nsa_block_unit(const Frame& F, int b, int g, int T0, int skip) {
    const int lane = F.lane, tid = F.tid, w = F.wave, r16 = lane & 15, q4 = lane >> 4;
    const int t0 = T0 + 8 * w;
    const f32x4 Z4 = {0.f, 0.f, 0.f, 0.f};
    LAS unsigned char* lds = F.lds;
    LAS float* wl = (LAS float*)(lds + 16384 + w * 5120);
    LAS float* impT = wl; LAS float* imp2T = wl + 8 * 65; LAS unsigned* selT = (LAS unsigned*)(wl + 16 * 65);
    LAS unsigned* bw = (LAS unsigned*)(lds + 57344); LAS int* stl = (LAS int*)(lds + 57344 + 128);
    const bf16* PN = (const bf16*)((unsigned char*)F.out + DO_PNSA) + (size_t)(b * T) * 1280;
    const float* GL = (const float*)((unsigned char*)F.out + DO_GLOG) + (size_t)(b * T) * 32;
    bf16x8 qf[2][2]; int tq[2];
#pragma unroll
    for (int mt = 0; mt < 2; ++mt) { tq[mt] = t0 + 4 * mt + (r16 >> 2);
#pragma unroll
        for (int dh = 0; dh < 2; ++dh) qf[mt][dh] = as_bf16x8(*(const v4u*)(PN + (size_t)tq[mt] * 1280 + (g * 4 + (r16 & 3)) * 64 + 32 * dh + 8 * q4)); }
    f32x4 Oc[2][4];
#pragma unroll
    for (int mt = 0; mt < 2; ++mt)
#pragma unroll
        for (int dt = 0; dt < 4; ++dt) Oc[mt][dt] = Z4;
#define NSA_GATE(mt_, r_, br_) sigmf(GL[(size_t)(t0 + 4 * (mt_) + q4) * 32 + g * 12 + (r_) * 3 + (br_)])
#define NSA_PIPE_BEGIN(S_, n_, K0_OF) { v4u st = nsa_stage_load(S_, K0_OF(0), tid); nsa_stage_write(lds, 0, tid, st); if ((n_) > 1) st = nsa_stage_load(S_, K0_OF(1), tid); __syncthreads(); \
        for (int i = 0; i < (n_); ++i) { const int k0 = K0_OF(i); const LAS unsigned char* ks = lds + (i & 1) * 4096; const LAS unsigned char* vs = lds + 8192 + (i & 1) * 4096;
#define NSA_PIPE_END(S_, n_, K0_OF) if (i + 1 < (n_)) nsa_stage_write(lds, (i + 1) & 1, tid, st); if (i + 2 < (n_)) st = nsa_stage_load(S_, K0_OF(i + 2), tid); __syncthreads(); } }

    for (int i = lane; i < 16 * 65; i += 64) wl[i] = 0.f;
    const NsaSrc SC{(const bf16*)(F.ws + WS_KC) + (size_t)((b * 2 + g) * 256) * 64, 64, (const bf16*)(F.ws + WS_VCT) + (size_t)((b * 2 + g) * 64) * 256, 256, 0};
    const int ncb = (T0 + 63 >= 31) ? ((T0 + 63 - 31) >> 4) + 1 : 0; const int nstB = (skip & 1) ? 0 : ((ncb + 31) >> 5);
    const int ncw = (t0 + 7 >= 31) ? ((t0 + 7 - 31) >> 4) + 1 : 0; const int nstW = (skip & 1) ? 0 : ((ncw + 31) >> 5);
    float inv[2] = {0.f, 0.f};
#define K0_LIN(i_) (32 * (i_))
    if (nstB > 0) { float ls[2] = {0.f, 0.f};
        NSA_PIPE_BEGIN(SC, nstB, K0_LIN)
            if (i < nstW) { const KFr kf = lds_k(ks, r16, q4); const bool cslow = 16 * (k0 + 31) + 31 > t0;
#pragma unroll
                for (int mt = 0; mt < 2; ++mt) { f32x4 sA = mfma16(kf.a0, qf[mt][0], Z4); sA = mfma16(kf.a1, qf[mt][1], sA); f32x4 sB = mfma16(kf.b0, qf[mt][0], Z4); sB = mfma16(kf.b1, qf[mt][1], sB);
#pragma unroll
                    for (int r = 0; r < 4; ++r) { const int nA = k0 + 8 * q4 + r, nB = nA + 4;
                        if (cslow) { ls[mt] += (16 * nA + 31 <= tq[mt]) ? __builtin_amdgcn_exp2f(sA[r]) : 0.f; ls[mt] += (16 * nB + 31 <= tq[mt]) ? __builtin_amdgcn_exp2f(sB[r]) : 0.f; }
                        else { ls[mt] += __builtin_amdgcn_exp2f(sA[r]); ls[mt] += __builtin_amdgcn_exp2f(sB[r]); } } } }
        NSA_PIPE_END(SC, nstB, K0_LIN)
#pragma unroll
        for (int mt = 0; mt < 2; ++mt) { float l = ls[mt]; l += __shfl_xor(l, 16); l += __shfl_xor(l, 32); inv[mt] = 1.0f / fmaxf(l, 1e-30f); }
    }
    if (nstB > 0) { f32x4 O[2][4];
#pragma unroll
        for (int mt = 0; mt < 2; ++mt)
#pragma unroll
            for (int dt = 0; dt < 4; ++dt) O[mt][dt] = Z4;
        NSA_PIPE_BEGIN(SC, nstB, K0_LIN)
            if (i < nstW) { const KFr kf = lds_k(ks, r16, q4); const VFr vf = lds_v(vs, r16, q4); const bool cslow = 16 * (k0 + 31) + 31 > t0;
#pragma unroll
                for (int mt = 0; mt < 2; ++mt) { f32x4 sA = mfma16(kf.a0, qf[mt][0], Z4); sA = mfma16(kf.a1, qf[mt][1], sA); f32x4 sB = mfma16(kf.b0, qf[mt][0], Z4); sB = mfma16(kf.b1, qf[mt][1], sB);
                    f32x4 pA, pB;
#pragma unroll
                    for (int r = 0; r < 4; ++r) { const int nA = k0 + 8 * q4 + r, nB = nA + 4;
                        if (cslow) { pA[r] = (16 * nA + 31 <= tq[mt]) ? __builtin_amdgcn_exp2f(sA[r]) * inv[mt] : 0.f; pB[r] = (16 * nB + 31 <= tq[mt]) ? __builtin_amdgcn_exp2f(sB[r]) * inv[mt] : 0.f; }
                        else { pA[r] = __builtin_amdgcn_exp2f(sA[r]) * inv[mt]; pB[r] = __builtin_amdgcn_exp2f(sB[r]) * inv[mt]; } }
                    float vA = pA[0] + pA[1] + pA[2] + 0.5f * pA[3], cA = 0.5f * pA[3], vB = pB[0] + pB[1] + pB[2] + 0.5f * pB[3], cB = 0.5f * pB[3];
                    vA += __shfl_xor(vA, 1); vA += __shfl_xor(vA, 2); cA += __shfl_xor(cA, 1); cA += __shfl_xor(cA, 2);
                    vB += __shfl_xor(vB, 1); vB += __shfl_xor(vB, 2); cB += __shfl_xor(cB, 1); cB += __shfl_xor(cB, 2);
                    if ((lane & 3) == 0) { const int tl = 4 * mt + (r16 >> 2), j = (k0 >> 2) + 2 * q4;
                        impT[tl * 65 + j] = vA; imp2T[tl * 65 + j + 1] = cA; impT[tl * 65 + j + 1] = vB; imp2T[tl * 65 + j + 2] = cB; }
                    const bf16x8 pf = pack_p(pA, pB);
#pragma unroll
                    for (int dt = 0; dt < 4; ++dt) O[mt][dt] = mfma16(pf, vf.v[dt], O[mt][dt]); } }
        NSA_PIPE_END(SC, nstB, K0_LIN)
#pragma unroll
        for (int mt = 0; mt < 2; ++mt)
#pragma unroll
            for (int r = 0; r < 4; ++r) { const float gt = NSA_GATE(mt, r, 0);
#pragma unroll
                for (int dt = 0; dt < 4; ++dt) Oc[mt][dt][r] += gt * O[mt][dt][r]; }
    }
    NSA_FENCE();
    const int cur = T0 >> 6;
    unsigned long long uni = 0ull;
    for (int tl = 0; tl < 8; ++tl) {
        unsigned long long mask;
        if (cur < 16 || (skip & 2)) mask = (cur < 16) ? ((2ull << cur) - 1ull) : (0xFFFFull | (1ull << cur) | (1ull << (cur - 1)));
        else {
            const float sc = impT[tl * 65 + lane] + imp2T[tl * 65 + lane];
            const unsigned key = __float_as_uint(fmaxf(sc, 0.f));
            const bool elig = (lane <= cur) && (lane != 0) && (lane != cur) && (lane != cur - 1);
            unsigned prefix = 0u;
            for (int bit = 30; bit >= 0; --bit) { const unsigned cand = prefix | (1u << bit);
                const int cnt = __popcll(__ballot(elig && key >= cand)); if (cnt >= 13) prefix = cand; }
            const unsigned long long gt = __ballot(elig && key > prefix); unsigned long long ties = __ballot(elig && key == prefix);
            int need = 13 - __popcll(gt); unsigned long long keep = 0ull;
            while (need > 0 && ties) { const unsigned long long low = ties & (0ull - ties); keep |= low; ties ^= low; --need; }
            mask = gt | keep | 1ull | (1ull << cur) | (1ull << (cur - 1));
        }
        uni |= mask;
        if (lane == 0) { selT[2 * tl] = (unsigned)mask; selT[2 * tl + 1] = (unsigned)(mask >> 32); }
    }
    if (lane == 0) { bw[2 + 2 * w] = (unsigned)uni; bw[3 + 2 * w] = (unsigned)(uni >> 32); }
    NSA_FENCE();
    unsigned long long mk[2];
#pragma unroll
    for (int mt = 0; mt < 2; ++mt) { const int tl = 4 * mt + (r16 >> 2); mk[mt] = (unsigned long long)selT[2 * tl] | ((unsigned long long)selT[2 * tl + 1] << 32); }
    __syncthreads();
    unsigned long long buni = 0ull;
#pragma unroll
    for (int ww = 0; ww < 8; ++ww) buni |= (unsigned long long)bw[2 + 2 * ww] | ((unsigned long long)bw[3 + 2 * ww] << 32);

#define K0_LIST(i_) (__builtin_amdgcn_readfirstlane(stl[(i_)]))
#pragma unroll 1
    for (int br = 1; br < 3; ++br) { if ((skip >> (br + 1)) & 1) continue;
        const NsaSrc SB{PN + (br == 1 ? 768 : 1024) + g * 64, 1280, (const bf16*)(F.ws + (br == 1 ? WS_VST : WS_VWT)) + (size_t)((b * 2 + g) * 64) * T, 0, 1};
        f32x4 O[2][4]; float ls[2] = {0.f, 0.f};
#pragma unroll
        for (int mt = 0; mt < 2; ++mt)
#pragma unroll
            for (int dt = 0; dt < 4; ++dt) O[mt][dt] = Z4;
        int nsteps;
        if (br == 1) { nsteps = 2 * __popcll(buni);
            if (w == 0 && ((buni >> lane) & 1ull)) { const int rk = __popcll(buni & ((1ull << lane) - 1ull)); stl[2 * rk] = 64 * lane; stl[2 * rk + 1] = 64 * lane + 32; } }
        else { const int lo = T0 - 511; const int klo = (lo > 0 ? lo : 0) & ~31; nsteps = ((T0 + 64 - klo) + 31) >> 5; if (w == 0 && lane < nsteps) stl[lane] = klo + 32 * lane; }
        __syncthreads();
        NSA_PIPE_BEGIN(SB, nsteps, K0_LIST)
            const int j = k0 >> 6;
            const bool mine = (br == 1) ? (((uni >> j) & 1ull) != 0ull) : (k0 + 31 >= t0 - 511 && k0 <= t0 + 7);
            if (mine) { const KFr kf = lds_k(ks, r16, q4); const VFr vf = lds_v(vs, r16, q4);
                const bool slow = (br == 1) ? (j == cur) : (k0 < t0 - 504 || k0 + 31 > t0);
#pragma unroll
                for (int mt = 0; mt < 2; ++mt) { f32x4 ci = Z4;
                    if (br == 1) { const float bias = (((mk[mt] >> j) & 1ull) != 0ull) ? 0.f : -1e30f; ci = (f32x4){bias, bias, bias, bias}; }
                    f32x4 sA = mfma16(kf.a0, qf[mt][0], ci); sA = mfma16(kf.a1, qf[mt][1], sA); f32x4 sB = mfma16(kf.b0, qf[mt][0], ci); sB = mfma16(kf.b1, qf[mt][1], sB);
                    f32x4 pA, pB;
                    if (slow) {
#pragma unroll
                        for (int r = 0; r < 4; ++r) { const int kA = k0 + 8 * q4 + r, kB = kA + 4;
                            const bool mA = (kA <= tq[mt]) && (br == 1 || kA + 512 > tq[mt]), mB = (kB <= tq[mt]) && (br == 1 || kB + 512 > tq[mt]);
                            pA[r] = mA ? __builtin_amdgcn_exp2f(sA[r]) : 0.f; pB[r] = mB ? __builtin_amdgcn_exp2f(sB[r]) : 0.f; }
                    } else {
#pragma unroll
                        for (int r = 0; r < 4; ++r) { pA[r] = __builtin_amdgcn_exp2f(sA[r]); pB[r] = __builtin_amdgcn_exp2f(sB[r]); }
                    }
                    ls[mt] += (pA[0] + pA[1]) + (pA[2] + pA[3]) + (pB[0] + pB[1]) + (pB[2] + pB[3]);
                    const bf16x8 pf = pack_p(pA, pB);
#pragma unroll
                    for (int dt = 0; dt < 4; ++dt) O[mt][dt] = mfma16(pf, vf.v[dt], O[mt][dt]); } }
        NSA_PIPE_END(SB, nsteps, K0_LIST)
#pragma unroll
        for (int mt = 0; mt < 2; ++mt) { float l = ls[mt]; l += __shfl_xor(l, 16); l += __shfl_xor(l, 32); const float il = 1.0f / fmaxf(l, 1e-30f);
#pragma unroll
            for (int r = 0; r < 4; ++r) { const float ilr = __shfl(il, 4 * q4 + r) * NSA_GATE(mt, r, br);
#pragma unroll
                for (int dt = 0; dt < 4; ++dt) Oc[mt][dt][r] += ilr * O[mt][dt][r]; } }
    }
    if (!skip) { bf16* YB = (bf16*)(F.ws + WS_H + 16 * MiB) + (size_t)(b * T) * 512;
#pragma unroll
        for (int mt = 0; mt < 2; ++mt)
#pragma unroll
            for (int r = 0; r < 4; ++r)
#pragma unroll
                for (int dt = 0; dt < 4; ++dt) YB[(size_t)(t0 + 4 * mt + q4) * 512 + (g * 4 + r) * 64 + 16 * dt + r16] = f2b(Oc[mt][dt][r]); }
    __syncthreads();
}
__device__ __forceinline__ void nsa_phase(const Frame& F, int rep) {
    LAS unsigned* bw = (LAS unsigned*)(F.lds + 57344);
    const int q0 = (int)(xb_xcc_id() & 7u);
    for (int qi = 0; qi < 8; ++qi) { const int q = (q0 + qi) & 7;
        for (;;) {
            if (F.tid == 0) bw[0] = __hip_atomic_fetch_add(F.ctl + CW_NSAQ + 64 * (8 * rep + q), 1u, RLX_AGENT);
            __syncthreads();
            const unsigned c = bw[0];
            __syncthreads();
            if (c >= 64u) break;
            nsa_block_unit(F, q >> 1, q & 1, 64 * (63 - (int)c), rep ? NSA_SKIP : 0);
        }
    }
}
__device__ __forceinline__ f32x4 unpk4(const u32x2 w) { f32x4 r; r[0] = bflo(w.x); r[1] = bfhi(w.x); r[2] = bflo(w.y); r[3] = bfhi(w.y); return r; }
struct ChunkIn { v4u kt0, kt1, rt0, rt1; u32x2 uv, mb, mk, vt, bh[4], kh[4]; f32x4 gam[4]; };
__device__ __forceinline__ void scan_load(ChunkIn& c, const unsigned char* rec, int vq, int r16, int q4) {
    c.kt0 = *(const v4u*)(rec + (r16 * 64 + q4 * 8) * 2); c.kt1 = *(const v4u*)(rec + (r16 * 64 + 32 + q4 * 8) * 2);
    c.rt0 = *(const v4u*)(rec + RO_RT + (r16 * 64 + q4 * 8) * 2); c.rt1 = *(const v4u*)(rec + RO_RT + (r16 * 64 + 32 + q4 * 8) * 2);
#pragma unroll
    for (int mt = 0; mt < 4; ++mt) { c.bh[mt] = *(const u32x2*)(rec + RO_BH + ((16 * mt + r16) * 16 + 4 * q4) * 2); c.kh[mt] = *(const u32x2*)(rec + RO_KH + ((16 * mt + r16) * 16 + 4 * q4) * 2);
        c.gam[mt] = *(const f32x4*)(rec + RO_GAM + (16 * mt + 4 * q4) * 4); }
    c.vt = *(const u32x2*)(rec + RO_VT + ((16 * vq + r16) * 16 + 4 * q4) * 2); c.uv = *(const u32x2*)(rec + RO_UV + ((16 * vq + r16) * 16 + 4 * q4) * 2);
    c.mb = *(const u32x2*)(rec + RO_MB + (r16 * 16 + 4 * q4) * 2); c.mk = *(const u32x2*)(rec + RO_MK + (r16 * 16 + 4 * q4) * 2);
}
__device__ __forceinline__ void scan_chunk(const ChunkIn& cur, f32x4 (&Zt)[4], bf16* Y, int ch, int q4) {
    const f32x4 Z4 = {0.f, 0.f, 0.f, 0.f};
    const bf16x8 zb0 = pack_p(Zt[0], Zt[1]), zb1 = pack_p(Zt[2], Zt[3]);
    f32x4 U = mfma16(as_bf16x8(cur.kt0), zb0, unpk4(cur.uv)); U = mfma16(as_bf16x8(cur.kt1), zb1, U);
    f32x4 Yc = mfma16(as_bf16x8(cur.rt0), zb0, Z4); Yc = mfma16(as_bf16x8(cur.rt1), zb1, Yc);
    const bf16x4 vt = as_bf16x4(cur.vt);
    const bf16x4 ub = pack4(U);
    Yc = mfma16k16(as_bf16x4(cur.mk), vt, Yc); Yc = mfma16k16(as_bf16x4(cur.mb), ub, Yc);
#pragma unroll
    for (int mt = 0; mt < 4; ++mt) { f32x4 acc = mfma16k16(as_bf16x4(cur.kh[mt]), vt, Zt[mt]); acc = mfma16k16(as_bf16x4(cur.bh[mt]), ub, acc); Zt[mt] = acc * cur.gam[mt]; }
#pragma unroll
    for (int r = 0; r < 4; ++r) Y[(size_t)(16 * ch + 4 * q4 + r) * 512] = f2b(Yc[r]);
}
constexpr int SR_SLOTS = 8, SR_SLOT_BYTES = 13824, SR_PIECES = REC_BYTES / 16 / 4;
__device__ __forceinline__ void scan_lds_load(ChunkIn& c, const LAS unsigned char* rec, int vq, int r16, int q4) {
    c.kt0 = *(const LAS v4u*)(rec + (r16 * 64 + q4 * 8) * 2); c.kt1 = *(const LAS v4u*)(rec + (r16 * 64 + 32 + q4 * 8) * 2);
    c.rt0 = *(const LAS v4u*)(rec + RO_RT + (r16 * 64 + q4 * 8) * 2); c.rt1 = *(const LAS v4u*)(rec + RO_RT + (r16 * 64 + 32 + q4 * 8) * 2);
#pragma unroll
    for (int mt = 0; mt < 4; ++mt) { c.bh[mt] = *(const LAS u32x2*)(rec + RO_BH + ((16 * mt + r16) * 16 + 4 * q4) * 2); c.kh[mt] = *(const LAS u32x2*)(rec + RO_KH + ((16 * mt + r16) * 16 + 4 * q4) * 2);
        c.gam[mt] = *(const LAS f32x4*)(rec + RO_GAM + (16 * mt + 4 * q4) * 4); }
    c.vt = *(const LAS u32x2*)(rec + RO_VT + ((16 * vq + r16) * 16 + 4 * q4) * 2); c.uv = *(const LAS u32x2*)(rec + RO_UV + ((16 * vq + r16) * 16 + 4 * q4) * 2);
    c.mb = *(const LAS u32x2*)(rec + RO_MB + (r16 * 16 + 4 * q4) * 2); c.mk = *(const LAS u32x2*)(rec + RO_MK + (r16 * 16 + 4 * q4) * 2);
}
__device__ __forceinline__ void sr_wait_ge(volatile LAS unsigned* w, unsigned want) {
    for (unsigned spin = 0; spin < (1u << 22); ++spin) { if (*w >= want) break; __builtin_amdgcn_s_sleep(1); }
}
__device__ __forceinline__ void rwkv_scan_wave(const Frame& F, int bh, int vq) {
    const int lane = F.lane, r16 = lane & 15, q4 = lane >> 4, b = bh >> 3, h = bh & 7;
    const f32x4 Z4 = {0.f, 0.f, 0.f, 0.f};
    bf16* Y = (bf16*)(F.ws + WS_H) + (size_t)(b * T) * 512 + h * 64 + 16 * vq + r16;
    volatile LAS unsigned* filled = F.MISC + 32; volatile LAS unsigned* freed = F.MISC + 48;
    f32x4 Zt[4] = {Z4, Z4, Z4, Z4};
    ChunkIn A, B;
#define SR_TAKE(dst, ch_) do { const int sl_ = (ch_) & (SR_SLOTS - 1); sr_wait_ge(filled + sl_, 4u * (unsigned)(((ch_) >> 3) + 1)); asm volatile("" ::: "memory"); \
        scan_lds_load(dst, F.lds + sl_ * SR_SLOT_BYTES, vq, r16, q4); asm volatile("s_waitcnt lgkmcnt(0)" ::: "memory"); \
        if (lane == 0) __hip_atomic_fetch_add((LAS unsigned*)(freed + sl_), 1u, __ATOMIC_RELAXED, __HIP_MEMORY_SCOPE_WORKGROUP); } while (0)
    SR_TAKE(A, 0);
    for (int ch = 0; ch < T / 16; ch += 2) {
        SR_TAKE(B, ch + 1);
        scan_chunk(A, Zt, Y, ch, q4);
        if (ch + 2 < T / 16) SR_TAKE(A, ch + 2);
        scan_chunk(B, Zt, Y, ch + 1, q4);
    }
#undef SR_TAKE
}
__device__ __forceinline__ void rwkv_scan_loader(const Frame& F, int bh, int lw) {
    const int lane = F.lane, b = bh >> 3, h = bh & 7;
    const unsigned char* recb = F.ws + WS_PRW + (size_t)(b * T) * 7168 + h * REC_BYTES + (size_t)(SR_PIECES * lw) * 16;
    volatile LAS unsigned* filled = F.MISC + 32; volatile LAS unsigned* freed = F.MISC + 48;
    constexpr size_t CS = 16 * 7168;
    v4u pc[4][4];
#define SL_ISSUE(k_, ch_) do { const unsigned char* r_ = recb + (size_t)(ch_) * CS; _Pragma("unroll") for (int i_ = 0; i_ < 4; ++i_) { const int p_ = lane + 64 * i_; pc[k_][i_] = *(const v4u*)(r_ + 16 * (p_ < SR_PIECES ? p_ : 0)); } } while (0)
#define SL_COMMIT(k_, ch_) do { const int sl_ = (ch_) & (SR_SLOTS - 1); sr_wait_ge(freed + sl_, 4u * (unsigned)((ch_) >> 3)); asm volatile("" ::: "memory"); \
        LAS unsigned char* d_ = F.lds + sl_ * SR_SLOT_BYTES + (SR_PIECES * lw) * 16; _Pragma("unroll") for (int i_ = 0; i_ < 4; ++i_) { const int p_ = lane + 64 * i_; if (p_ < SR_PIECES) *(LAS v4u*)(d_ + 16 * p_) = pc[k_][i_]; } \
        asm volatile("s_waitcnt lgkmcnt(0)" ::: "memory"); if (lane == 0) __hip_atomic_fetch_add((LAS unsigned*)(filled + sl_), 1u, __ATOMIC_RELAXED, __HIP_MEMORY_SCOPE_WORKGROUP); } while (0)
    SL_ISSUE(0, 0); SL_ISSUE(1, 1); SL_ISSUE(2, 2); SL_ISSUE(3, 3);
    for (int c4 = 0; c4 < T / 16; c4 += 4) {
#pragma unroll
        for (int k = 0; k < 4; ++k) { const int ch = c4 + k;
            SL_COMMIT(k, ch);
            if (ch + 4 < T / 16) SL_ISSUE(k, ch + 4); }
    }
#undef SL_ISSUE
#undef SL_COMMIT
}
__device__ __forceinline__ void rwkv_epilogue(const Frame& F) {
    const int lane = F.lane; const int gw = F.vcu * NWAVES + F.wave, NGW = F.G * NWAVES;
    const unsigned char* prw = F.ws + WS_PRW; const bf16* G = (const bf16*)((unsigned char*)F.out + DO_G); bf16* YA = (bf16*)(F.ws + WS_H);
    for (int idx = gw; idx < (M / 16) * 8; idx += NGW) { const int bt = idx >> 3, h = idx & 7, c = h * 64 + lane;
        const unsigned char* rec = prw + (size_t)(16 * bt) * 7168 + h * REC_BYTES;
        const v4u* vp = (const v4u*)(rec + RO_VT + lane * 32); const v4u v0 = vp[0], v1 = vp[1];
        const float lw = F.in[12][c], lb = F.in[13][c];
        float yv[16], gv[16], bo[16];
#pragma unroll
        for (int s = 0; s < 16; ++s) { const size_t o = (size_t)(16 * bt + s) * 512 + c; yv[s] = bf2f(YA[o]); gv[s] = bf2f(G[o]); bo[s] = *(const float*)(rec + RO_BON + 4 * s); }
#pragma unroll
        for (int s = 0; s < 16; ++s) { const unsigned vw = (s < 8) ? v0[s >> 1] : v1[(s - 8) >> 1]; const float vv = (s & 1) ? bfhi(vw) : bflo(vw);
            const float y = yv[s]; const float mean = wave_sum(y) * (1.f / 64.f); const float d = y - mean; const float var = wave_sum(d * d) * (1.f / 64.f);
            const float yn = d * rsqrtf(var + GN_EPS) * lw + lb;
            YA[(size_t)(16 * bt + s) * 512 + c] = f2b((yn + bo[s] * vv) * gv[s]); }
    }
}
__device__ __forceinline__ unsigned sortable(float x) { const unsigned u = __float_as_uint(x); return (u & 0x80000000u) ? ~u : (u | 0x80000000u); }
__device__ __forceinline__ float unsortable(unsigned k) { const unsigned u = (k & 0x80000000u) ? (k & 0x7fffffffu) : ~k; return __uint_as_float(u); }
#define TK_INSERT(L, key_) do { unsigned k_ = (key_); _Pragma("unroll") for (int s_ = 0; s_ < 16; ++s_) { const unsigned hi_ = L[s_] > k_ ? L[s_] : k_; k_ = L[s_] > k_ ? k_ : L[s_]; L[s_] = hi_; } } while (0)
__device__ __forceinline__ void peer_topk_pass(const Frame& F, int wp, LAS float* sc) {
    const int lane = F.lane, r16 = lane & 15, q4 = lane >> 4;
    const bf16* QRY = (const bf16*)(F.ws + WS_PRW);
    int* EID = (int*)(F.ws + WS_PRW + 64 * MiB); float* EG = (float*)(F.ws + WS_PRW + 72 * MiB);
    const int row = lane & 31, part = lane >> 5;
    unsigned L1[16], L2[16];
#pragma unroll
    for (int half = 0; half < 2; ++half) {
        const bf16* SK = (const bf16*)(F.ws + (half ? WS_SK2 : WS_SK1));
        bf16x8 af[2][4];
#pragma unroll
        for (int mt = 0; mt < 2; ++mt) { const int rho = 32 * wp + 16 * mt + r16; const bf16* qp = QRY + (size_t)(rho >> 3) * 2048 + (rho & 7) * 256 + half * 128 + 8 * q4;
#pragma unroll
            for (int s = 0; s < 4; ++s) af[mt][s] = as_bf16x8(*(const v4u*)(qp + 32 * s)); }
#pragma unroll
        for (int kg = 0; kg < 2; ++kg) { bf16x8 kb[4][4];
#pragma unroll
            for (int k4 = 0; k4 < 4; ++k4)
#pragma unroll
                for (int s = 0; s < 4; ++s) kb[k4][s] = as_bf16x8(*(const v4u*)(SK + (size_t)(16 * (4 * kg + k4) + r16) * 128 + 32 * s + 8 * q4));
#pragma unroll
          for (int mt = 0; mt < 2; ++mt) {
#pragma unroll
            for (int k4 = 0; k4 < 4; ++k4) { const int kt = 4 * kg + k4; f32x4 acc = {0.f, 0.f, 0.f, 0.f};
#pragma unroll
                for (int s = 0; s < 4; ++s) acc = mfma16(af[mt][s], kb[k4][s], acc);
#pragma unroll
                for (int r = 0; r < 4; ++r) { const int rw = 16 * mt + 4 * q4 + r; sc[rw * 128 + ((16 * kt + r16) ^ rw)] = acc[r]; } } } }
        NSA_FENCE();
        unsigned Ls[16];
#pragma unroll
        for (int s = 0; s < 16; ++s) Ls[s] = 0u;
#pragma unroll 4
        for (int i = 0; i < 64; ++i) { const int c = 64 * part + i; const float x = sc[row * 128 + (c ^ row)];
            TK_INSERT(Ls, (sortable(x) & ~0x7Fu) | (unsigned)(127 - c)); }
        unsigned Lo[16];
#pragma unroll
        for (int s = 0; s < 16; ++s) Lo[s] = (unsigned)__shfl_xor((int)Ls[s], 32);
#pragma unroll
        for (int s = 0; s < 16; ++s) TK_INSERT(Ls, Lo[s]);
#pragma unroll
        for (int s = 0; s < 16; ++s) { if (half == 0) L1[s] = Ls[s]; else L2[s] = Ls[s]; }
        NSA_FENCE();
    }
    float v1[16], v2[16];
#pragma unroll
    for (int s = 0; s < 16; ++s) { v1[s] = unsortable(L1[s]); v2[s] = unsortable(L2[s]); }
    unsigned C[16];
#pragma unroll
    for (int s = 0; s < 16; ++s) C[s] = 0u;
#pragma unroll
    for (int i = 0; i < 16; ++i)
#pragma unroll
        for (int j = 0; j < 16; ++j) if ((i + 1) * (j + 1) <= 16) { TK_INSERT(C, (sortable(v1[i] + v2[j]) & ~0xFFu) | (unsigned)(255 - (16 * i + j))); }
    LAS unsigned* il = (LAS unsigned*)sc;
    if (part == 0) {
#pragma unroll
        for (int s = 0; s < 16; ++s) { il[row * 33 + s] = 127u - (L1[s] & 127u); il[row * 33 + 16 + s] = 127u - (L2[s] & 127u); }
    }
    NSA_FENCE();
    if (part == 0) { const int rho = 32 * wp + row;
        float val[16], e[16]; float sum = 0.f;
#pragma unroll
        for (int s = 0; s < 16; ++s) val[s] = unsortable(C[s]);
#pragma unroll
        for (int s = 0; s < 16; ++s) { e[s] = __expf(val[s] - val[0]); sum += e[s]; }
        const float is = 1.0f / sum;
#pragma unroll
        for (int s = 0; s < 16; ++s) { const unsigned pos = 255u - (C[s] & 255u); const unsigned i = pos >> 4, j = pos & 15u;
            EID[(size_t)rho * 16 + s] = (int)(il[row * 33 + i] * 128u + il[row * 33 + 16 + j]); EG[(size_t)rho * 16 + s] = e[s] * is; }
    }
    NSA_FENCE();
}
typedef float f32x2_t __attribute__((ext_vector_type(2)));
constexpr float PEER_SCALE = 256.0f, PEER_ISCALE = 1.0f / 256.0f;
__device__ __forceinline__ void peer_convert_one(const Frame& F, const float* srcf, unsigned char* dstb) {
    const int gt = F.vcu * (NWAVES * 64) + F.tid, NT = F.G * NWAVES * 64;
    const f32x4* src = (const f32x4*)srcf; v4u* dst = (v4u*)dstb;
    for (int i = gt; i < 16384 * 1024 / 16; i += NT) { v4u o;
#pragma unroll
        for (int q = 0; q < 4; ++q) { const f32x4 a = src[4 * i + q] * PEER_SCALE; int w = __builtin_amdgcn_cvt_pk_fp8_f32(a[0], a[1], 0, false); w = __builtin_amdgcn_cvt_pk_fp8_f32(a[2], a[3], w, true); o[q] = (unsigned)w; }
        dst[i] = o; }
}
constexpr float PEER_SU = 768.0f, PEER_SH = 24.0f;
__device__ __forceinline__ unsigned q8pack(const f32x4 a, float sc) {
    const int q0 = (int)rintf(fminf(fmaxf(a[0] * sc, -127.f), 127.f)), q1 = (int)rintf(fminf(fmaxf(a[1] * sc, -127.f), 127.f)), q2 = (int)rintf(fminf(fmaxf(a[2] * sc, -127.f), 127.f)), q3 = (int)rintf(fminf(fmaxf(a[3] * sc, -127.f), 127.f));
    return (unsigned)(q0 & 255) | ((unsigned)(q1 & 255) << 8) | ((unsigned)(q2 & 255) << 16) | ((unsigned)(q3 & 255) << 24);
}
__device__ __forceinline__ void peer_convert_u8(const Frame& F, const float* srcf, unsigned char* dstb) {
    const int gt = F.vcu * (NWAVES * 64) + F.tid, NT = F.G * NWAVES * 64;
    const f32x4* src = (const f32x4*)srcf; v4u* dst = (v4u*)dstb;
    for (int i = gt; i < 16384 * 1024 / 16; i += NT) { v4u o;
#pragma unroll
        for (int q = 0; q < 4; ++q) o[q] = q8pack(src[4 * i + q], PEER_SU);
        dst[i] = o; }
}
__device__ __forceinline__ void peer_convert_tables(const Frame& F) { peer_convert_u8(F, F.in[31], F.ws + WS_MG); peer_convert_one(F, F.in[32], F.ws + WS_MG + 16 * MiB); }
__device__ __forceinline__ float sum8(float x) { x += dppf<0xB1>(x); x += dppf<0x4E>(x); x += dppf<0x141>(x); return x; }
template <int PHASE> __device__ __forceinline__ void peer_slice_unit(const Frame& F, int s, int tg) {
    const int lane = F.lane, j = lane & 7, gbase = lane & ~7;
    const bf16* H2 = (const bf16*)(F.ws + WS_H);
    const int* EID = (const int*)(F.ws + WS_PRW + 64 * MiB);
    float* PART = (float*)(F.ws + WS_PRW) + (size_t)s * M * 128; const float* CACT = (const float*)(F.ws + WS_PRW + 80 * MiB);
    const unsigned char* TB = F.ws + WS_MG + (PHASE == 0 ? 0 : 16 * MiB) + 128 * s + 16 * j;
#pragma unroll 1
    for (int it = 0; it < 8; ++it) { const int tk = 64 * tg + 8 * it + (lane >> 3);
        int ids[16]; float hv[16], acc[16];
        { const v4u* ip = (const v4u*)(EID + (size_t)tk * 128 + 16 * j);
#pragma unroll
          for (int q = 0; q < 4; ++q) { const v4u w = ip[q]; ids[4 * q] = (int)w.x; ids[4 * q + 1] = (int)w.y; ids[4 * q + 2] = (int)w.z; ids[4 * q + 3] = (int)w.w; } }
        int hq[4] = {0, 0, 0, 0};
        if (PHASE == 0) { const v4u h0 = *(const v4u*)(H2 + (size_t)tk * D + 128 * s + 16 * j), h1 = *(const v4u*)(H2 + (size_t)tk * D + 128 * s + 16 * j + 8);
            hq[0] = (int)q8pack((f32x4){bflo(h0.x), bfhi(h0.x), bflo(h0.y), bfhi(h0.y)}, PEER_SH); hq[1] = (int)q8pack((f32x4){bflo(h0.z), bfhi(h0.z), bflo(h0.w), bfhi(h0.w)}, PEER_SH);
            hq[2] = (int)q8pack((f32x4){bflo(h1.x), bfhi(h1.x), bflo(h1.y), bfhi(h1.y)}, PEER_SH); hq[3] = (int)q8pack((f32x4){bflo(h1.z), bfhi(h1.z), bflo(h1.w), bfhi(h1.w)}, PEER_SH); }
        else { const f32x4* cp = (const f32x4*)(CACT + (size_t)tk * 128 + 16 * j);
#pragma unroll
            for (int q = 0; q < 4; ++q) { const f32x4 c = cp[q]; hv[4 * q] = c[0]; hv[4 * q + 1] = c[1]; hv[4 * q + 2] = c[2]; hv[4 * q + 3] = c[3]; } }
#pragma unroll
        for (int m = 0; m < 16; ++m) acc[m] = 0.f;
        v4u tn[16];
        if (PHASE == 0) {
#pragma unroll
            for (int m = 0; m < 16; ++m) { const int id = __builtin_amdgcn_ds_bpermute(gbase * 4, ids[m]); tn[m] = *(const v4u*)(TB + (size_t)id * 1024); } }
#pragma unroll 1
        for (int jj = 0; jj < 8; ++jj) { const int src = (gbase + jj) * 4;
            v4u tv[16];
            if (PHASE == 0) { const int srcn = (gbase + ((jj + 1 < 8) ? jj + 1 : jj)) * 4;
#pragma unroll
                for (int m = 0; m < 16; ++m) tv[m] = tn[m];
#pragma unroll
                for (int m = 0; m < 16; ++m) { const int id = __builtin_amdgcn_ds_bpermute(srcn, ids[m]); tn[m] = *(const v4u*)(TB + (size_t)id * 1024); } }
            else {
#pragma unroll
                for (int m = 0; m < 16; ++m) { const int id = __builtin_amdgcn_ds_bpermute(src, ids[m]); tv[m] = *(const v4u*)(TB + (size_t)id * 1024); } }
#pragma unroll
            for (int m = 0; m < 16; ++m) {
                if (PHASE == 0) { int di = __builtin_amdgcn_sdot4((int)tv[m].x, hq[0], 0, false); di = __builtin_amdgcn_sdot4((int)tv[m].y, hq[1], di, false); di = __builtin_amdgcn_sdot4((int)tv[m].z, hq[2], di, false); di = __builtin_amdgcn_sdot4((int)tv[m].w, hq[3], di, false);
                    const float d = sum8((float)di); acc[m] = (j == jj) ? d : acc[m]; }
                else {
                    float f[16];
#pragma unroll
                    for (int q = 0; q < 4; ++q) { const f32x2_t lo = __builtin_amdgcn_cvt_pk_f32_fp8((int)tv[m][q], false), hi = __builtin_amdgcn_cvt_pk_f32_fp8((int)tv[m][q], true); f[4 * q] = lo.x; f[4 * q + 1] = lo.y; f[4 * q + 2] = hi.x; f[4 * q + 3] = hi.y; } const float c = __builtin_bit_cast(float, __builtin_amdgcn_ds_bpermute(src, __builtin_bit_cast(int, hv[m])));
#pragma unroll
                    for (int q = 0; q < 16; ++q) acc[q] += c * f[q]; } }
        }
        if (PHASE == 0) { f32x4* pp = (f32x4*)(PART + (size_t)tk * 128 + 16 * j);
#pragma unroll
            for (int q = 0; q < 4; ++q) pp[q] = (f32x4){acc[4 * q], acc[4 * q + 1], acc[4 * q + 2], acc[4 * q + 3]}; }
        else { f32x4* op = (f32x4*)(F.out + (size_t)tk * D + 128 * s + 16 * j);
#pragma unroll
            for (int q = 0; q < 4; ++q) { f32x4 a = op[q]; a[0] += acc[4 * q] * PEER_ISCALE; a[1] += acc[4 * q + 1] * PEER_ISCALE; a[2] += acc[4 * q + 2] * PEER_ISCALE; a[3] += acc[4 * q + 3] * PEER_ISCALE; op[q] = a; } }
    }
}
template <int PHASE> __device__ __forceinline__ void peer_slice_phase(const Frame& F, int rep) {
    const int q0 = (int)(xb_xcc_id() & 7u);
    for (int qi = 0; qi < 8; ++qi) { const int q = (q0 + qi) & 7;
        for (;;) { unsigned c = 0;
            if (F.lane == 0) c = __hip_atomic_fetch_add(F.ctl + CW_PEERQ + 64 * (16 * rep + 8 * PHASE + q), 1u, RLX_AGENT);
            c = (unsigned)__builtin_amdgcn_readfirstlane((int)c);
            if (c >= 256u) break;
            peer_slice_unit<PHASE>(F, q, (int)c); } }
}
__device__ __forceinline__ void peer_act_phase(const Frame& F) {
    const int gt = F.vcu * (NWAVES * 64) + F.tid, NT = F.G * NWAVES * 64;
    const float* PART = (const float*)(F.ws + WS_PRW); const float* EG = (const float*)(F.ws + WS_PRW + 72 * MiB); float* CACT = (float*)(F.ws + WS_PRW + 80 * MiB);
    for (int i = gt; i < M * 128 / 4; i += NT) { f32x4 d = {0.f, 0.f, 0.f, 0.f};
#pragma unroll
        for (int s = 0; s < 8; ++s) d += ((const f32x4*)PART)[(size_t)s * (M * 128 / 4) + i];
        const f32x4 g = ((const f32x4*)EG)[i]; f32x4 c;
#pragma unroll
        for (int e = 0; e < 4; ++e) { const float dt = d[e] * (1.0f / (PEER_SU * PEER_SH)); c[e] = g[e] * 0.5f * dt * (1.f + erff(dt * 0.70710678118654752f)); }
        ((f32x4*)CACT)[i] = c; }
}
__device__ __forceinline__ unsigned long long dbg_stamp() { unsigned long long t; asm volatile("s_memrealtime %0\n\ts_waitcnt lgkmcnt(0)" : "=s"(t) :: "memory"); return t; }
struct Args { const float* in[33]; float* out; unsigned char* ws; int ph_lo, ph_hi; };
__global__ void __launch_bounds__(NWAVES * 64, 2) mk_fwd(Args args) {
    extern __shared__ __attribute__((aligned(16))) unsigned char lds[];
    Frame F;
    F.lds = (LAS unsigned char*)lds;
    F.MISC = (volatile LAS unsigned*)(F.lds + MISC_OFF);
    F.tid = threadIdx.x; F.lane = F.tid & 63; F.wave = __builtin_amdgcn_readfirstlane(F.tid >> 6);
    F.G = gridDim.x; { const int bx = blockIdx.x; F.vcu = (F.G % 8 == 0) ? (bx % 8) * (F.G / 8) + bx / 8 : bx; }
    unsigned char* ws = args.ws; F.ws = ws; F.out = args.out;
    F.ctl = (gu32*)(ws + WS_CTL);
#pragma unroll
    for (int i = 0; i < 33; ++i) F.in[i] = args.in[i];
    for (int u = F.tid; u < (LDS_BYTES - LDSCTL_OFF) / 4; u += NWAVES * 64) ((LAS unsigned*)(F.lds + LDSCTL_OFF))[u] = 0u;
    __syncthreads();
    const int lo = args.ph_lo, hi = args.ph_hi & 0xff; const int rep = args.ph_hi >> 8;
    const bool multi = (hi - lo) > 1;
    XcdBarrier bar; bar.bar = (unsigned*)(F.ctl + CW_BAR); bar.x = 0; bar.st = nullptr;
    if (multi) bar = xcd_barrier_post((unsigned*)(F.ctl + CW_BAR), F.MISC + 8);
#define IN(k) (lo <= (k) && (k) < hi)
#define NREP(k) ((((repmask) >> (k)) & 1) + 1)
#define REPBAR() do { if (rep) xcd_barrier(bar); } while (0)
#define SEAM(k) do { if (DBG_SEL == (k) && blockIdx.x == 0 && F.tid == 0) dbg_t1 = dbg_stamp(); if (IN(k) && IN((k) + 1)) xcd_barrier(bar); if ((DBG_SEL == (k) + 1 || (DBG_SEL == 20 && (k) == 1)) && blockIdx.x == 0 && F.tid == 0) dbg_t0 = dbg_stamp(); } while (0)
    unsigned long long dbg_t0 = 0ull, dbg_t1 = 0ull;

    if (IN(0)) { { p0_prologue(F); } } SEAM(0);
    if (IN(1)) { {
        pg8::Gemm g{(const pg8::bf16_t*)(ws + WS_H), (const pg8::bf16_t*)(ws + WS_WIN), M, NG1, D}; pg8::StaticOrder S; S.init(M, NG1, F.G, (int)blockIdx.x);
        pg8::EpiG1 E{(float*)(ws + WS_PRW), (float*)(ws + WS_BND), (pg8::bf16_t*)((unsigned char*)F.out + DO_PNSA), (pg8::bf16_t*)(ws + WS_MG), (float*)((unsigned char*)F.out + DO_GLOG)};
        pg8::gemm_phase<pg8::EpiG1, pg8::StaticOrder, true, true>(F.lds + RING_OFF, g, S, E);
    } } SEAM(1);
    if (IN(2)) {
        for (int u = F.vcu; u < 256; u += F.G) nsa_prep_tile(F, u);
        if (DBG_SEL == 20 && blockIdx.x == 0 && F.tid == 0) dbg_t1 = dbg_stamp();
        if (DBG_SEL == 21 && blockIdx.x == 0 && F.tid == 0) dbg_t0 = dbg_stamp();
        for (int u = F.vcu; u < 256; u += F.G) compress_unit(F, u);
        if (DBG_SEL == 21 && blockIdx.x == 0 && F.tid == 0) dbg_t1 = dbg_stamp();
        for (int u = F.vcu; u < 256; u += F.G) rwkv_prep_tile(F, u);
    } SEAM(2);
    if (IN(3)) { {
        if ((int)blockIdx.x < 32 && !(rep && P3REP == 3)) { if (DBG_SEL == 40 && blockIdx.x == 0 && F.tid == 0) dbg_t0 = dbg_stamp(); if (F.tid < 32) F.MISC[32 + F.tid] = 0u; __syncthreads(); if (F.wave < 4) rwkv_scan_wave(F, (int)blockIdx.x, F.wave); else rwkv_scan_loader(F, (int)blockIdx.x, F.wave - 4); __syncthreads(); if (DBG_SEL == 40 && blockIdx.x == 0 && F.tid == 0) dbg_t1 = dbg_stamp(); }
        if (!(rep && P3REP == 2)) nsa_phase(F, rep);
    } } SEAM(3);
    if (IN(4)) { { rwkv_epilogue(F); } } SEAM(4);
    if (IN(5)) { {
        { pg8::Gemm g{(const pg8::bf16_t*)(ws + WS_H), (const pg8::bf16_t*)(ws + WS_WA), M, D, 512, (const pg8::bf16_t*)(ws + WS_H + 16 * MiB), (const pg8::bf16_t*)(ws + WS_WB)}; pg8::StaticOrder2 S; S.init(M, D, F.G, (int)blockIdx.x);
          pg8::EpiMerge E{(const pg8::bf16_t*)(ws + WS_MG), (pg8::bf16_t*)(ws + WS_PRW + 64 * MiB)};
          pg8::gemm_phase<pg8::EpiMerge, pg8::StaticOrder2, true, true>(F.lds + RING_OFF, g, S, E); }
    } } SEAM(5);
    if (IN(6)) { {
        pg8::Gemm g{(const pg8::bf16_t*)(ws + WS_PRW + 64 * MiB), (const pg8::bf16_t*)(ws + WS_WOUT), M, D, D}; pg8::StaticOrder S; S.init(M, D, F.G, (int)blockIdx.x);
        pg8::EpiRes E{F.in[0], F.out};
        pg8::gemm_phase<pg8::EpiRes, pg8::StaticOrder, true, true>(F.lds + RING_OFF, g, S, E);
    } } SEAM(6);
    if (IN(7)) { { const int gw = F.vcu * NWAVES + F.wave, NGW = F.G * NWAVES;
        for (int m = gw; m < M; m += NGW) rms_row_to_bf16(F.lane, F.out + (size_t)m * D, F.in[27], (bf16*)(ws + WS_H) + (size_t)m * D);
        peer_convert_tables(F);
    } } SEAM(7);
    if (IN(8)) { {
        pg8::Gemm g{(const pg8::bf16_t*)(ws + WS_H), (const pg8::bf16_t*)(ws + WS_WQ), M, 2048, D}; pg8::StaticOrder S; S.init(M, 2048, F.G, (int)blockIdx.x);
        pg8::EpiBf16<0> E{(pg8::bf16_t*)(ws + WS_PRW), 2048, nullptr, 0, 0, 1.f};
        pg8::gemm_phase<pg8::EpiBf16<0>, pg8::StaticOrder, true, true>(F.lds + RING_OFF, g, S, E);
    } } SEAM(8);
    if (IN(9)) { { const int gw = F.vcu * NWAVES + F.wave, NGW = F.G * NWAVES; LAS float* sc = (LAS float*)(F.lds + F.wave * 16384);
        for (int wp = gw; wp < M * 8 / 32; wp += NGW) peer_topk_pass(F, wp, sc);
    } } SEAM(9);
    if (IN(10)) { peer_slice_phase<0>(F, rep); } SEAM(10);
    if (IN(11)) { peer_act_phase(F); } SEAM(11);
    if (IN(12)) { peer_slice_phase<1>(F, rep); }
    if (DBG_SEL >= 0 && multi) { if (DBG_SEL == 12 && blockIdx.x == 0 && F.tid == 0) dbg_t1 = dbg_stamp(); xcd_barrier(bar); if (blockIdx.x == 0 && F.tid == 0) F.out[0] += (DBG_SEL == 99) ? 0.1f : ((DBG_SEL >= 30 && DBG_SEL < 40) ? (0.05f + (float)(F.MISC[21] - F.MISC[20]) * 0.01f * 1e-3f) : (0.05f + (float)(dbg_t1 - dbg_t0) * 0.01f * DBG_SCALE)); }
#undef IN
#undef SEAM
}

extern "C" void kernel_launch(void* const* d_in, const int* in_sizes, int n_in, void* d_out, int out_size, void* d_ws, size_t ws_size, hipStream_t stream) {
    static int grid = 0;
    if (grid == 0) {
        if (n_in != 33 || out_size != M * D || ws_size < WS_END) { fprintf(stderr, "kernel_launch: unexpected shapes (n_in %d out %d ws %zu)\n", n_in, out_size, ws_size); grid = -1; return; }
        int dev = 0, cus = 0, per_cu = 0;
        if (hipGetDevice(&dev) != hipSuccess || hipDeviceGetAttribute(&cus, hipDeviceAttributeMultiprocessorCount, dev) != hipSuccess) { grid = -1; return; }
        if (hipFuncSetAttribute((const void*)mk_fwd, hipFuncAttributeMaxDynamicSharedMemorySize, LDS_BYTES) != hipSuccess) { fprintf(stderr, "kernel_launch: hipFuncSetAttribute failed\n"); grid = -1; return; }
        if (hipOccupancyMaxActiveBlocksPerMultiprocessor(&per_cu, (const void*)mk_fwd, NWAVES * 64, LDS_BYTES) != hipSuccess || per_cu < 1)
            fprintf(stderr, "kernel_launch: occupancy query reports %d blocks per CU\n", per_cu);
        (void)hipGetLastError();
        grid = cus;
        if (grid > 256) grid = 256;
    }
    if (grid < 0) return;
    if (hipMemsetAsync((char*)d_ws + WS_CTL, 0, CTL_ZERO_BYTES, stream) != hipSuccess) return;
    Args a{};
    for (int i = 0; i < 33; ++i) a.in[i] = (const float*)d_in[i];
    a.out = (float*)d_out; a.ws = (unsigned char*)d_ws;
#if MK_ONE_LAUNCH
    a.ph_lo = 0; a.ph_hi = N_PHASES;
    hipLaunchKernelGGL(mk_fwd, dim3(grid), dim3(NWAVES * 64), LDS_BYTES, stream, a);
#else
    for (int p = 0; p < N_PHASES; ++p) { for (int r = 0; r <= (((REP_MASK) >> p) & 1); ++r) { a.ph_lo = p; a.ph_hi = (p + 1) | (r << 8); hipLaunchKernelGGL(mk_fwd, dim3(grid), dim3(NWAVES * 64), LDS_BYTES, stream, a); } }
#endif
}
```

```cpp
#include <hip/hip_runtime.h>
#include <cstdio>
#include <cstdint>
#define MK_ONE_LAUNCH 1
#define REP_MASK 0
#define P3REP 1
#define NSA_SKIP 0
#define DBG_SEL -1
#define DBG_BLK 0
namespace pg8 {
#define PG8_LAS __attribute__((address_space(3)))
typedef unsigned short bf16_t;
typedef short bf16x8 __attribute__((ext_vector_type(8)));
typedef float f32x4 __attribute__((ext_vector_type(4)));
typedef unsigned u32x4 __attribute__((ext_vector_type(4)));
constexpr int BM = 256, BK = 64, HALF = 128, HTB = HALF * BK * 2  , STAGE_BYTES = 8 * HTB, NXCD = 8, WGM = 8;

__host__ __device__ __forceinline__ int lds_byte(int r, int c) { const int st = (r >> 4) * 2 + (c >> 5), rr = r & 15, cc = c & 31, ob = rr * 64 + cc * 2; return st * 1024 + (ob ^ (((ob >> 9) & 1) << 5)); }
__host__ __device__ __forceinline__ void stage_rc(int b, int& R, int& C) { const int st = b / 1024, sb = b % 1024, swz = sb ^ (((sb >> 9) & 1) << 5); R = (st >> 1) * 16 + swz / 64; C = (st & 1) * 32 + (swz % 64) / 2; }
__host__ __device__ __forceinline__ int perm32(int rho) { const int n = rho >> 4, i = rho & 15; return 8 * (i >> 2) + 4 * n + (i & 3); }

struct Unit { int pm, pn; int seg = 0; };
struct Gemm { const bf16_t* A; const bf16_t* Bt; int M, N, K; const bf16_t* A2 = nullptr; const bf16_t* Bt2 = nullptr; };

struct StaticOrder {
    int nM, nN, nwg, G, c;
    __host__ __device__ void init(int M, int N, int G_, int c_) { nM = M / BM; nN = N / BM; nwg = nM * nN; G = G_; c = c_; }
    __host__ __device__ bool next(int i, Unit& u) const {
        const long L = (long)i * G + c; if (L >= nwg) return false;
        int wgid = (int)L; { const int q = nwg / NXCD, r = nwg % NXCD, xcd = wgid % NXCD, off = wgid / NXCD; wgid = (xcd < r ? xcd * (q + 1) : r * (q + 1) + (xcd - r) * q) + off; }
        const int nig = WGM * nN, gid = wgid / nig, fm = gid * WGM, gsz = (nM - fm) < WGM ? (nM - fm) : WGM;
        u.pm = fm + ((wgid % nig) % gsz); u.pn = (wgid % nig) / gsz; return true;
    }
    __device__ __forceinline__ void a_ready(const Unit&) const {}
    __device__ __forceinline__ void done(const Unit&) const {}
};


struct StaticOrder2 {
    StaticOrder base;
    __host__ __device__ void init(int M, int N, int G_, int c_) { base.init(M, N, G_, c_); }
    __host__ __device__ bool next(int i, Unit& u) const { const bool ok = base.next(i >> 1, u); u.seg = i & 1; return ok; }
    __device__ __forceinline__ void a_ready(const Unit&) const {}
    __device__ __forceinline__ void done(const Unit&) const {}
};
typedef float f32x2c __attribute__((ext_vector_type(2))); typedef __bf16 bf16x2c __attribute__((ext_vector_type(2)));
__device__ __forceinline__ unsigned cvt_pk_bf16(float lo, float hi) { const f32x2c v = {lo, hi}; const bf16x2c b = __builtin_convertvector(v, bf16x2c); return __builtin_bit_cast(unsigned, b); }
typedef float f32x2 __attribute__((ext_vector_type(2)));
__device__ __forceinline__ f32x2 gelu_pk(f32x2 v) {
    const f32x2 av = __builtin_elementwise_abs(v), d = av * 0.2316418882f + 1.0f;
    f32x2 t; t.x = __builtin_amdgcn_rcpf(d.x); t.y = __builtin_amdgcn_rcpf(d.y);
    f32x2 q = t * 0.5307027145f + (-0.7265760135f); q = q * t + 0.7107068705f; q = q * t + (-0.142248368f); q = q * t + 0.127414796f; q = q * t;
    const f32x2 s = (v * v) * (-0.72134752044f);
    f32x2 e; e.x = __builtin_amdgcn_exp2f(s.x); e.y = __builtin_amdgcn_exp2f(s.y);
    const f32x2 m = v * (q * e), r = v - m;
    f32x2 o; o.x = v.x < 0.f ? m.x : r.x; o.y = v.y < 0.f ? m.y : r.y; return o;
}

template <int ACT  > struct EpiBf16 {
    static constexpr bool PERM = true, AFTER_DRAIN = false, KEEP_ACC = false; static_assert(ACT == 0 || ACT == 1, "EpiBf16: ACT is 0 (none) or 1 (gelu_pk)");
    bf16_t* O; int ldc; const float* bias; int split_cols; size_t split_stride; float scale0;
    __device__ __forceinline__ void operator()(const f32x4 (&acc)[2][2][4][2], const Unit& u, int wr, int wc, int fr, int fq) const {
        const int row0 = u.pm * BM + wr * 64 + fr; int colt = u.pn * BM; bf16_t* base = O;
        float sc = 1.f; if (split_cols) { const int t = colt / split_cols; base += (size_t)t * split_stride; colt -= t * split_cols; if (t == 0) sc = scale0; }
        const int col0 = colt + wc * 32 + 8 * fq, bcol0 = u.pn * BM + wc * 32 + 8 * fq;
        f32x4 bv[2][2];
#pragma unroll
        for (int bj = 0; bj < 2; ++bj)
#pragma unroll
            for (int n = 0; n < 2; ++n) bv[bj][n] = bias ? *(const f32x4*)(bias + bcol0 + bj * HALF + 4 * n) : (f32x4){0.f, 0.f, 0.f, 0.f};
#pragma unroll
        for (int ai = 0; ai < 2; ++ai)
#pragma unroll
            for (int m = 0; m < 4; ++m) { bf16_t* rowp = base + (size_t)(row0 + ai * HALF + m * 16) * ldc + col0;
#pragma unroll
                for (int bj = 0; bj < 2; ++bj) { f32x4 v0 = acc[ai][bj][m][0] + bv[bj][0], v1 = acc[ai][bj][m][1] + bv[bj][1];
                    if (ACT == 1) { f32x2 a = gelu_pk((f32x2){v0[0], v0[1]}), b = gelu_pk((f32x2){v0[2], v0[3]}), c = gelu_pk((f32x2){v1[0], v1[1]}), d = gelu_pk((f32x2){v1[2], v1[3]});
                        v0 = (f32x4){a.x, a.y, b.x, b.y}; v1 = (f32x4){c.x, c.y, d.x, d.y}; }
                    v0 = v0 * sc; v1 = v1 * sc; u32x4 w; w.x = cvt_pk_bf16(v0[0], v0[1]); w.y = cvt_pk_bf16(v0[2], v0[3]); w.z = cvt_pk_bf16(v1[0], v1[1]); w.w = cvt_pk_bf16(v1[2], v1[3]);
                    *(u32x4*)(rowp + bj * HALF) = w; } }
    }
};
__device__ __forceinline__ float bf_lo(unsigned w) { return __uint_as_float(w << 16); }
__device__ __forceinline__ float bf_hi(unsigned w) { return __uint_as_float(w & 0xffff0000u); }
__device__ __forceinline__ float sigm(float x) { return __builtin_amdgcn_rcpf(1.0f + __expf(-x)); }
__device__ __forceinline__ u32x4 pack8(const f32x4 v0, const f32x4 v1) { u32x4 w; w.x = cvt_pk_bf16(v0[0], v0[1]); w.y = cvt_pk_bf16(v0[2], v0[3]); w.z = cvt_pk_bf16(v1[0], v1[1]); w.w = cvt_pk_bf16(v1[2], v1[3]); return w; }

struct EpiG1 {
    static constexpr bool PERM = true, AFTER_DRAIN = false, KEEP_ACC = false;
    float* PRW; float* BND; bf16_t* PNSA; bf16_t* MG; float* GLOG;
    __device__ __forceinline__ void operator()(const f32x4 (&acc)[2][2][4][2], const Unit& u, int wr, int wc, int fr, int fq) const {
        const int row0 = u.pm * BM + wr * 64 + fr, c0 = wc * 32 + 8 * fq;
#pragma unroll
        for (int ai = 0; ai < 2; ++ai)
#pragma unroll
            for (int m = 0; m < 4; ++m) { const int row = row0 + ai * HALF + m * 16;
#pragma unroll
                for (int bj = 0; bj < 2; ++bj) { const f32x4 v0 = acc[ai][bj][m][0], v1 = acc[ai][bj][m][1]; const int col = c0 + bj * HALF;
                    if (u.pn < 7) { float* p = PRW + (size_t)row * 1792 + u.pn * 256 + col; *(f32x4*)p = v0; *(f32x4*)(p + 4) = v1;
                        if ((row & 63) == 63) { float* q = BND + (size_t)(row >> 6) * 1792 + u.pn * 256 + col; *(f32x4*)q = v0; *(f32x4*)(q + 4) = v1; } }
                    else if (u.pn < 12) { *(u32x4*)(PNSA + (size_t)row * 1280 + (u.pn - 7) * 256 + col) = pack8(v0, v1); }
                    else if (u.pn < 20) { *(u32x4*)(MG + (size_t)row * 2048 + (u.pn - 12) * 256 + col) = pack8(v0, v1); }
                    else { if (col < 32) { float* p = GLOG + (size_t)row * 32 + col; *(f32x4*)p = v0; *(f32x4*)(p + 4) = v1; } }
                } }
    }
};
struct EpiGate1 {
    static constexpr bool PERM = true, AFTER_DRAIN = false, KEEP_ACC = false;
    float* T1; const bf16_t* MG; int goff;
    __device__ __forceinline__ void operator()(const f32x4 (&acc)[2][2][4][2], const Unit& u, int wr, int wc, int fr, int fq) const {
        const int row0 = u.pm * BM + wr * 64 + fr, c0 = u.pn * BM + wc * 32 + 8 * fq;
#pragma unroll
        for (int ai = 0; ai < 2; ++ai)
#pragma unroll
            for (int m = 0; m < 4; ++m) { const int row = row0 + ai * HALF + m * 16;
#pragma unroll
                for (int bj = 0; bj < 2; ++bj) { const f32x4 v0 = acc[ai][bj][m][0], v1 = acc[ai][bj][m][1]; const int col = c0 + bj * HALF;
                    const u32x4 g = *(const u32x4*)(MG + (size_t)row * 2048 + goff + col);
                    f32x4 o0, o1; o0[0] = sigm(bf_lo(g.x)) * v0[0]; o0[1] = sigm(bf_hi(g.x)) * v0[1]; o0[2] = sigm(bf_lo(g.y)) * v0[2]; o0[3] = sigm(bf_hi(g.y)) * v0[3];
                    o1[0] = sigm(bf_lo(g.z)) * v1[0]; o1[1] = sigm(bf_hi(g.z)) * v1[1]; o1[2] = sigm(bf_lo(g.w)) * v1[2]; o1[3] = sigm(bf_hi(g.w)) * v1[3];
                    float* p = T1 + (size_t)row * 1024 + col; *(f32x4*)p = o0; *(f32x4*)(p + 4) = o1; } }
    }
};
struct EpiGate2 {
    static constexpr bool PERM = true, AFTER_DRAIN = false, KEEP_ACC = false;
    const float* T1; const bf16_t* MG; int goff; bf16_t* MIX;
    __device__ __forceinline__ void operator()(const f32x4 (&acc)[2][2][4][2], const Unit& u, int wr, int wc, int fr, int fq) const {
        const int row0 = u.pm * BM + wr * 64 + fr, c0 = u.pn * BM + wc * 32 + 8 * fq;
#pragma unroll
        for (int ai = 0; ai < 2; ++ai)
#pragma unroll
            for (int m = 0; m < 4; ++m) { const int row = row0 + ai * HALF + m * 16;
#pragma unroll
                for (int bj = 0; bj < 2; ++bj) { const f32x4 v0 = acc[ai][bj][m][0], v1 = acc[ai][bj][m][1]; const int col = c0 + bj * HALF;
                    const u32x4 g = *(const u32x4*)(MG + (size_t)row * 2048 + goff + col);
                    const float* p = T1 + (size_t)row * 1024 + col; const f32x4 t0 = *(const f32x4*)p, t1 = *(const f32x4*)(p + 4);
                    f32x4 o0, o1; o0[0] = t0[0] + sigm(bf_lo(g.x)) * v0[0]; o0[1] = t0[1] + sigm(bf_hi(g.x)) * v0[1]; o0[2] = t0[2] + sigm(bf_lo(g.y)) * v0[2]; o0[3] = t0[3] + sigm(bf_hi(g.y)) * v0[3];
                    o1[0] = t1[0] + sigm(bf_lo(g.z)) * v1[0]; o1[1] = t1[1] + sigm(bf_hi(g.z)) * v1[1]; o1[2] = t1[2] + sigm(bf_lo(g.w)) * v1[2]; o1[3] = t1[3] + sigm(bf_hi(g.w)) * v1[3];
                    *(u32x4*)(MIX + (size_t)row * 1024 + col) = pack8(o0, o1); } }
    }
};
struct EpiRes {
    static constexpr bool PERM = true, AFTER_DRAIN = false, KEEP_ACC = false;
    const float* X; float* OUT;
    __device__ __forceinline__ void operator()(const f32x4 (&acc)[2][2][4][2], const Unit& u, int wr, int wc, int fr, int fq) const {
        const int row0 = u.pm * BM + wr * 64 + fr, c0 = u.pn * BM + wc * 32 + 8 * fq;
#pragma unroll
        for (int ai = 0; ai < 2; ++ai)
#pragma unroll
            for (int m = 0; m < 4; ++m) { const int row = row0 + ai * HALF + m * 16;
#pragma unroll
                for (int bj = 0; bj < 2; ++bj) { const size_t off = (size_t)row * 1024 + c0 + bj * HALF;
                    const f32x4 x0 = *(const f32x4*)(X + off), x1 = *(const f32x4*)(X + off + 4);
                    *(f32x4*)(OUT + off) = x0 + acc[ai][bj][m][0]; *(f32x4*)(OUT + off + 4) = x1 + acc[ai][bj][m][1]; } }
    }
};
struct EpiMerge {
    static constexpr bool PERM = true, AFTER_DRAIN = false, KEEP_ACC = true;
    const bf16_t* MG; bf16_t* MIX;
    __device__ __forceinline__ void operator()(f32x4 (&acc)[2][2][4][2], const Unit& u, int wr, int wc, int fr, int fq) const {
        const int row0 = u.pm * BM + wr * 64 + fr, c0 = u.pn * BM + wc * 32 + 8 * fq;
#pragma unroll
        for (int ai = 0; ai < 2; ++ai)
#pragma unroll
            for (int m = 0; m < 4; ++m) { const int row = row0 + ai * HALF + m * 16;
#pragma unroll
                for (int bj = 0; bj < 2; ++bj) { const int col = c0 + bj * HALF;
                    const u32x4 gb = *(const u32x4*)(MG + (size_t)row * 2048 + 1024 + col);
                    const float eb[8] = {__expf(-bf_lo(gb.x)), __expf(-bf_hi(gb.x)), __expf(-bf_lo(gb.y)), __expf(-bf_hi(gb.y)), __expf(-bf_lo(gb.z)), __expf(-bf_hi(gb.z)), __expf(-bf_lo(gb.w)), __expf(-bf_hi(gb.w))};
                    if (u.seg == 0) { const u32x4 ga = *(const u32x4*)(MG + (size_t)row * 2048 + col);
                        const float ea[8] = {__expf(-bf_lo(ga.x)), __expf(-bf_hi(ga.x)), __expf(-bf_lo(ga.y)), __expf(-bf_hi(ga.y)), __expf(-bf_lo(ga.z)), __expf(-bf_hi(ga.z)), __expf(-bf_lo(ga.w)), __expf(-bf_hi(ga.w))};
#pragma unroll
                        for (int e = 0; e < 4; ++e) { acc[ai][bj][m][0][e] *= (1.0f + eb[e]) * __builtin_amdgcn_rcpf(1.0f + ea[e]); acc[ai][bj][m][1][e] *= (1.0f + eb[4 + e]) * __builtin_amdgcn_rcpf(1.0f + ea[4 + e]); } }
                    else { f32x4 o0, o1;
#pragma unroll
                        for (int e = 0; e < 4; ++e) { o0[e] = acc[ai][bj][m][0][e] * __builtin_amdgcn_rcpf(1.0f + eb[e]); o1[e] = acc[ai][bj][m][1][e] * __builtin_amdgcn_rcpf(1.0f + eb[4 + e]); }
                        *(u32x4*)(MIX + (size_t)row * 1024 + col) = pack8(o0, o1); } } }
    }
};
template <class Epi, class Sched, bool ALIGN_EPI = false, bool SP2 = false>
__device__ __forceinline__ void gemm_phase(PG8_LAS unsigned char* lds, const Gemm g, const Sched& S, const Epi& E) {
    const int tid = threadIdx.x, wid = __builtin_amdgcn_readfirstlane(tid >> 6), lane = tid & 63, wr = wid >> 2, wc = wid & 3, fr = lane & 15, fq = lane >> 4;
    const int K = g.K, nt = K / BK;
    unsigned voffA[2], voffB[2];
#pragma unroll
    for (int i = 0; i < 2; ++i) { int R, C; stage_rc(tid * 16 + i * 8192, R, C); const int Rb = Epi::PERM ? ((R & ~31) + perm32(R & 31)) : R;
        voffA[i] = (unsigned)(R * K + C) * 2u; voffB[i] = (unsigned)(Rb * K + C) * 2u; }
    const size_t kstep = (size_t)(BK * 2);
    const size_t hstep = (size_t)HALF * K * 2;
    const size_t tstep = 2 * hstep;
    const unsigned ldsw = (unsigned)wid * 1024u;
    const int aoff = lds_byte(wr * 64 + fr, fq * 8), boff = lds_byte(wc * 32 + fr, fq * 8);
#define PG8_SA(b, h) (((b) * 2 + (h)) * HTB)
#define PG8_SB(b, h) ((4 + (b) * 2 + (h)) * HTB)
#define PG8_STAGE(bufoff, gbase, voff) do { _Pragma("unroll") for (int _i = 0; _i < 2; ++_i) \
        __builtin_amdgcn_global_load_lds((const unsigned*)((const char*)(gbase) + (voff)[_i]), (PG8_LAS unsigned*)(lds + (bufoff) + ldsw + _i * 8192), 16, 0, 0); } while (0)
#define PG8_LDA(dst, b, h) do { _Pragma("unroll") for (int m = 0; m < 4; ++m) _Pragma("unroll") for (int k = 0; k < 2; ++k) dst[m][k] = *(const PG8_LAS bf16x8*)(lds + PG8_SA(b, h) + aoff + m * 2048 + k * 1024); } while (0)
#define PG8_LDB(dst, b, h) do { _Pragma("unroll") for (int n = 0; n < 2; ++n) _Pragma("unroll") for (int k = 0; k < 2; ++k) dst[n][k] = *(const PG8_LAS bf16x8*)(lds + PG8_SB(b, h) + boff + n * 2048 + k * 1024); } while (0)
#define PG8_MMA(ai, bj, At, Bt) do { __builtin_amdgcn_s_setprio(1); _Pragma("unroll") for (int m = 0; m < 4; ++m) _Pragma("unroll") for (int n = 0; n < 2; ++n) _Pragma("unroll") for (int k = 0; k < 2; ++k) \
        acc[ai][bj][m][n] = __builtin_amdgcn_mfma_f32_16x16x32_bf16(Bt[n][k], At[m][k], acc[ai][bj][m][n], 0, 0, 0); __builtin_amdgcn_s_setprio(0); } while (0)
#define PG8_WAIT_V(n) asm volatile("s_waitcnt vmcnt(" #n ")" ::: "memory")
#define PG8_WAIT_L(n) asm volatile("s_waitcnt lgkmcnt(" #n ")" ::: "memory")
#define PG8_BAR __builtin_amdgcn_s_barrier()
#define PG8_SCHED __builtin_amdgcn_sched_barrier(0)
    Unit cur, nxt; int ui = 0;
    if (!S.next(0, cur)) return;
    f32x4 acc[2][2][4][2];
#pragma unroll
    for (int a = 0; a < 2; ++a)
#pragma unroll
        for (int b = 0; b < 2; ++b)
#pragma unroll
            for (int m = 0; m < 4; ++m)
#pragma unroll
                for (int n = 0; n < 2; ++n) acc[a][b][m][n] = (f32x4){0.f, 0.f, 0.f, 0.f};
    bf16x8 At[4][2], B0[2][2], B1[2][2];
    const char* cA = (const char*)(cur.seg ? g.A2 : g.A) + (size_t)cur.pm * tstep; const char* cB = (const char*)(cur.seg ? g.Bt2 : g.Bt) + (size_t)cur.pn * tstep;
    S.a_ready(cur);
    if constexpr (SP2) {
        PG8_STAGE(PG8_SB(0, 0), cB, voffB); PG8_STAGE(PG8_SB(0, 1), cB + hstep, voffB); PG8_STAGE(PG8_SA(0, 0), cA, voffA); PG8_STAGE(PG8_SA(0, 1), cA + hstep, voffA);
        if (wr == 1) PG8_BAR;
        PG8_WAIT_V(2); PG8_BAR;
        PG8_STAGE(PG8_SB(1, 0), cB + kstep, voffB); PG8_STAGE(PG8_SA(1, 0), cA + kstep, voffA); PG8_STAGE(PG8_SB(1, 1), cB + hstep + kstep, voffB);
        PG8_WAIT_V(6); PG8_BAR;
    } else {
        PG8_STAGE(PG8_SB(0, 0), cB, voffB); PG8_STAGE(PG8_SA(0, 0), cA, voffA); PG8_STAGE(PG8_SB(0, 1), cB + hstep, voffB); PG8_STAGE(PG8_SA(0, 1), cA + hstep, voffA);
        if (wr == 1) PG8_BAR;
        PG8_WAIT_V(4); PG8_BAR;
        PG8_STAGE(PG8_SB(1, 0), cB + kstep, voffB); PG8_STAGE(PG8_SA(1, 0), cA + kstep, voffA); PG8_STAGE(PG8_SB(1, 1), cB + hstep + kstep, voffB);
        PG8_WAIT_V(6); PG8_BAR;
    }
    for (;;) {
        const bool has_next = S.next(ui + 1, nxt);
        const char* nA = has_next ? (const char*)(nxt.seg ? g.A2 : g.A) + (size_t)nxt.pm * tstep : cA; const char* nB = has_next ? (const char*)(nxt.seg ? g.Bt2 : g.Bt) + (size_t)nxt.pn * tstep : cB;
        for (int t = 0; t < nt; t += 2) {
            const bool last = (t == nt - 2);
            const char* a1 = cA + (size_t)(t + 1) * kstep;
            const char* a2 = last ? nA : cA + (size_t)(t + 2) * kstep; const char* b2 = last ? nB : cB + (size_t)(t + 2) * kstep;
            const char* a3 = a2 + kstep; const char* b3 = b2 + kstep;
            if (last && has_next) S.a_ready(nxt);
            if constexpr (SP2) {
            PG8_LDB(B0, 0, 0); PG8_LDB(B1, 0, 1); PG8_SCHED; PG8_LDA(At, 0, 0); PG8_STAGE(PG8_SA(1, 1), a1 + hstep, voffA);
            PG8_WAIT_V(8); PG8_WAIT_L(0); PG8_BAR; PG8_MMA(0, 0, At, B0); PG8_MMA(0, 1, At, B1); PG8_BAR; PG8_SCHED;
            PG8_LDA(At, 0, 1); PG8_STAGE(PG8_SB(0, 0), b2, voffB); PG8_STAGE(PG8_SB(0, 1), b2 + hstep, voffB); PG8_STAGE(PG8_SA(0, 0), a2, voffA);
            PG8_WAIT_V(8); PG8_WAIT_L(0); PG8_BAR; PG8_MMA(1, 0, At, B0); PG8_MMA(1, 1, At, B1); PG8_BAR; PG8_SCHED;
            PG8_LDB(B0, 1, 0); PG8_LDB(B1, 1, 1); PG8_SCHED; PG8_LDA(At, 1, 0); PG8_STAGE(PG8_SA(0, 1), a2 + hstep, voffA);
            PG8_WAIT_V(8); PG8_WAIT_L(0); PG8_BAR; PG8_MMA(0, 0, At, B0); PG8_MMA(0, 1, At, B1); PG8_BAR; PG8_SCHED;
            PG8_LDA(At, 1, 1); PG8_STAGE(PG8_SB(1, 0), b3, voffB); PG8_STAGE(PG8_SB(1, 1), b3 + hstep, voffB); PG8_STAGE(PG8_SA(1, 0), a3, voffA);
            PG8_WAIT_V(8); PG8_WAIT_L(0); PG8_BAR; PG8_MMA(1, 0, At, B0); PG8_MMA(1, 1, At, B1); PG8_BAR; PG8_SCHED;
            } else {
            PG8_LDB(B0, 0, 0); PG8_SCHED; PG8_LDA(At, 0, 0); PG8_STAGE(PG8_SA(1, 1), a1 + hstep, voffA);
            PG8_WAIT_L(8); PG8_BAR; PG8_WAIT_L(0); PG8_MMA(0, 0, At, B0); PG8_BAR; PG8_SCHED;
            PG8_LDB(B1, 0, 1); PG8_STAGE(PG8_SB(0, 0), b2, voffB);
            PG8_BAR; PG8_WAIT_L(0); PG8_MMA(0, 1, At, B1); PG8_BAR;
            PG8_LDA(At, 0, 1); PG8_STAGE(PG8_SA(0, 0), a2, voffA);
            PG8_BAR; PG8_WAIT_L(0); PG8_MMA(1, 0, At, B0); PG8_BAR; PG8_SCHED;
            PG8_STAGE(PG8_SB(0, 1), b2 + hstep, voffB);
            PG8_WAIT_V(6); PG8_BAR; PG8_MMA(1, 1, At, B1); PG8_BAR;
            PG8_LDB(B0, 1, 0); PG8_SCHED; PG8_LDA(At, 1, 0); PG8_STAGE(PG8_SA(0, 1), a2 + hstep, voffA);
            PG8_WAIT_L(8); PG8_BAR; PG8_WAIT_L(0); PG8_MMA(0, 0, At, B0); PG8_BAR; PG8_SCHED;
            PG8_LDB(B1, 1, 1); PG8_STAGE(PG8_SB(1, 0), b3, voffB);
            PG8_BAR; PG8_WAIT_L(0); PG8_MMA(0, 1, At, B1); PG8_BAR;
            PG8_LDA(At, 1, 1); PG8_STAGE(PG8_SA(1, 0), a3, voffA);
            PG8_BAR; PG8_WAIT_L(0); PG8_MMA(1, 0, At, B0); PG8_BAR; PG8_SCHED;
            PG8_STAGE(PG8_SB(1, 1), b3 + hstep, voffB);
            PG8_WAIT_V(6); PG8_BAR; PG8_MMA(1, 1, At, B1); PG8_BAR;
            }
        }
        if constexpr (ALIGN_EPI) { if (wr == 0) PG8_BAR; }
        if constexpr (!Epi::AFTER_DRAIN) { E(acc, cur, wr, wc, fr, fq); S.done(cur); }
        if (!has_next) break;
        if (!(Epi::KEEP_ACC && cur.seg == 0))
#pragma unroll
        for (int a = 0; a < 2; ++a)
#pragma unroll
            for (int b = 0; b < 2; ++b)
#pragma unroll
                for (int m = 0; m < 4; ++m)
#pragma unroll
                    for (int n = 0; n < 2; ++n) acc[a][b][m][n] = (f32x4){0.f, 0.f, 0.f, 0.f};
        cur = nxt; cA = nA; cB = nB; ++ui;
        if constexpr (ALIGN_EPI) { if (wr == 1) PG8_BAR; }
    }
    PG8_WAIT_V(0);
    if constexpr (!ALIGN_EPI) { if (wr == 0) PG8_BAR; }
    PG8_BAR;
    if constexpr (Epi::AFTER_DRAIN) { E.fused(acc, cur, wr, wc, fr, fq, lds, wid, lane); S.done(cur); }
#undef PG8_SA
#undef PG8_SB
#undef PG8_STAGE
#undef PG8_LDA
#undef PG8_LDB
#undef PG8_MMA
#undef PG8_WAIT_V
#undef PG8_WAIT_L
#undef PG8_BAR
#undef PG8_SCHED
}
}
#define GAS __attribute__((address_space(1)))
#define LAS __attribute__((address_space(3)))
typedef unsigned short bf16;
typedef unsigned v4u __attribute__((ext_vector_type(4)));
typedef float f32x4 __attribute__((ext_vector_type(4)));
typedef short bf16x8 __attribute__((ext_vector_type(8)));
typedef GAS unsigned gu32;
typedef GAS unsigned long long gu64;
#define RLX_AGENT __ATOMIC_RELAXED, __HIP_MEMORY_SCOPE_AGENT
#define LDS_WAIT() asm volatile("s_waitcnt lgkmcnt(0)" ::: "memory")
#define VM_WAIT() asm volatile("s_waitcnt vmcnt(0)" ::: "memory")
__device__ __forceinline__ unsigned long long rt() { return __builtin_amdgcn_s_memrealtime(); }
__device__ __forceinline__ unsigned f2bf(float f) { unsigned u = __builtin_bit_cast(unsigned, f); return (u + 0x7fffu + ((u >> 16) & 1u)) >> 16; }
__device__ __forceinline__ unsigned pk2(float lo, float hi) { return f2bf(lo) | (f2bf(hi) << 16); }

#define XB_TMO      128
#define XB_XCNT(j)  (256  + 64 * (j))
#define XB_XSUB(j)  (1280 + 64 * (j))
#define XB_XGEN(j)  (2304 + 64 * (j))
#define XB_TOP      3328
#define XB_TOPGEN   3392
#define XCD_BAR_WORDS 3456
#define XB_SPIN_CAP (1u << 18)

__device__ __forceinline__ unsigned xb_ld(unsigned* p)              { return __hip_atomic_load(p, __ATOMIC_RELAXED, __HIP_MEMORY_SCOPE_AGENT); }
__device__ __forceinline__ unsigned xb_add(unsigned* p, unsigned v) { return __hip_atomic_fetch_add(p, v, __ATOMIC_RELAXED, __HIP_MEMORY_SCOPE_AGENT); }
__device__ __forceinline__ unsigned xb_xcc_id() { return (unsigned)__builtin_amdgcn_s_getreg((3 << 11) | 20) & 0xFu; }
#define XB_SPIN(cond, bar) do { unsigned _sp = 0; while (cond) { __builtin_amdgcn_s_sleep(1); \
    if ((++_sp & 255u) == 0u) { if (xb_ld(&(bar)[XB_TMO])) break; if (_sp > XB_SPIN_CAP) { atomicAdd(&(bar)[XB_TMO], 1u); break; } } } } while (0)

struct XcdBarrier {
    unsigned* bar; unsigned x;
    volatile LAS unsigned* st;
};

__device__ __forceinline__ XcdBarrier xcd_barrier_post(unsigned* bar, volatile LAS unsigned* st) {
    XcdBarrier b; b.bar = bar; b.x = xb_xcc_id(); b.st = st;
    if (threadIdx.x == 0) (void)xb_add(&bar[XB_XCNT(b.x)], 1u);
    return b;
}
__device__ __forceinline__ void xcd_barrier_complete(unsigned* bar, unsigned x, unsigned& nloc, unsigned& nx) {
    const unsigned G = gridDim.x * gridDim.y * gridDim.z;
    unsigned sum, cnt, mine, sp = 0u;
    for (;;) {
        sum = 0u; cnt = 0u; mine = 0u;
#pragma unroll
        for (unsigned j = 0; j < 16; ++j) { const unsigned c = xb_ld(&bar[XB_XCNT(j)]); sum += c; cnt += (c > 0u) ? 1u : 0u; mine = (j == x) ? c : mine; }
        if (sum == G) break;
        __builtin_amdgcn_s_sleep(1);
        if ((++sp & 255u) == 0u) { if (xb_ld(&bar[XB_TMO])) break; if (sp > XB_SPIN_CAP) { atomicAdd(&bar[XB_TMO], 1u); break; } }
    }
    nloc = mine > 0u ? mine : 1u; nx = cnt > 0u ? cnt : 1u;
}

__device__ __forceinline__ void xcd_barrier(const XcdBarrier& b) {
    asm volatile("s_waitcnt vmcnt(0)" ::: "memory");
    __syncthreads();
    if (threadIdx.x == 0) {
        unsigned* bar = b.bar;
        __builtin_amdgcn_s_waitcnt(0);
        unsigned nloc = b.st[0], nx = b.st[1];
        if (nloc == 0u) { xcd_barrier_complete(bar, b.x, nloc, nx); b.st[0] = nloc; b.st[1] = nx; }
        const unsigned old = xb_add(&bar[XB_XSUB(b.x)], 1u);
        const unsigned gen = old / nloc;
        if (old + 1u == (gen + 1u) * nloc) {
            __builtin_amdgcn_fence(__ATOMIC_RELEASE, "agent");
            asm volatile("s_waitcnt vmcnt(0)" ::: "memory");
            const unsigned og = xb_add(&bar[XB_TOP], 1u);
            const unsigned tg = og / nx;
            if (og + 1u == (tg + 1u) * nx) xb_add(&bar[XB_TOPGEN], 1u);
            else XB_SPIN(xb_ld(&bar[XB_TOPGEN]) == tg, bar);
            __builtin_amdgcn_fence(__ATOMIC_ACQUIRE, "agent");
            xb_add(&bar[XB_XGEN(b.x)], 1u);
            asm volatile("s_waitcnt vmcnt(0)" ::: "memory");
        } else {
            XB_SPIN(xb_ld(&bar[XB_XGEN(b.x)]) == gen, bar);
            __builtin_amdgcn_fence(__ATOMIC_ACQUIRE, "agent");
            asm volatile("s_waitcnt vmcnt(0)" ::: "memory");
        }
    }
    __syncthreads();
}
constexpr int NWAVES = 8;
constexpr int BATCH = 4, T = 4096, D = 1024, M = BATCH * T;
constexpr int RWC = 1792;
constexpr int NG1 = 5120;
constexpr float NORM_EPS = 1e-6f, GN_EPS = 64e-5f;
constexpr float LOG2E = 1.4426950408889634f;
constexpr int N_PHASES = 13;
#ifndef MK_ONE_LAUNCH
#define MK_ONE_LAUNCH 0
#endif
#ifndef REP_MASK
#define REP_MASK 0
#endif
#ifndef DBG_BLK
#define DBG_BLK 0
#endif
#ifndef DBG_SCALE
#define DBG_SCALE 4e-4f
#endif
#ifndef DBG_SEL
#define DBG_SEL -1
#endif
#ifndef NSA_SKIP
#define NSA_SKIP 0
#endif
#ifndef P3REP
#define P3REP 1
#endif
#ifndef SCAN_BLOCKS
#define SCAN_BLOCKS 128
#endif

constexpr size_t MiB = 1u << 20;
constexpr size_t WS_CTL = 0, CTL_ZERO_BYTES = 1 * MiB;
constexpr size_t WS_WIN = 1 * MiB;
constexpr size_t WS_WA = 12 * MiB, WS_WB = 13 * MiB;
constexpr size_t WS_WOUT = 14 * MiB;
constexpr size_t WS_WQ = 16 * MiB;
constexpr size_t WS_CW1K = 20 * MiB, WS_CW1V = 21 * MiB;
constexpr size_t WS_CW2K = 22 * MiB, WS_CW2V = 22 * MiB + 65536;
constexpr size_t WS_SK1 = 22 * MiB + 131072, WS_SK2 = 22 * MiB + 196608;
constexpr size_t WS_WUT = 22 * MiB + 262144, WS_AUT = WS_WUT + 65536, WS_GUT = WS_WUT + 131072;
constexpr size_t WS_BND = 23 * MiB;
constexpr size_t WS_KC = 25 * MiB;
constexpr size_t WS_VCT = 25 * MiB + 262144;
constexpr size_t WS_H = 26 * MiB;
constexpr size_t WS_PRW = 58 * MiB;
constexpr size_t WS_MG = 170 * MiB;
constexpr size_t WS_VST = 234 * MiB, WS_VWT = 238 * MiB;
constexpr size_t WS_END = 256 * MiB;
constexpr size_t DO_PNSA = 0, DO_G = 40 * MiB, DO_GLOG = 56 * MiB;
constexpr int CW_TMO = 0, CW_CODE = 1, CW_NSAQ = 64, CW_SCANP = 2048, CW_PEERQ = 4160, CW_BAR = 8192;

constexpr int RING_OFF = 0, RING_BYTES = 131072;
constexpr int LDSCTL_OFF = RING_BYTES, MISC_OFF = LDSCTL_OFF + 320;
constexpr int LDS_BYTES = 147456;
typedef unsigned short u16;
typedef unsigned u32x2 __attribute__((ext_vector_type(2)));
struct Frame {
    LAS unsigned char* lds;
    volatile LAS unsigned* MISC;
    gu32* ctl;
    int tid, lane, wave, vcu, G;
    const float* in[33];
    float* out; unsigned char* ws;
};
__device__ __forceinline__ float wave_sum(float v) {
#pragma unroll
    for (int o = 1; o < 64; o <<= 1) v += __shfl_xor(v, o);
    return v;
}
template <int CTRL> __device__ __forceinline__ float dppf(float x) { return __builtin_bit_cast(float, __builtin_amdgcn_update_dpp(0, __builtin_bit_cast(int, x), CTRL, 0xf, 0xf, true)); }
__device__ __forceinline__ float bf2f(u16 b) { return __uint_as_float((unsigned)b << 16); }
__device__ __forceinline__ float bflo(unsigned w) { return __uint_as_float(w << 16); }
__device__ __forceinline__ float bfhi(unsigned w) { return __uint_as_float(w & 0xffff0000u); }
__device__ __forceinline__ u16 f2b(float f) { return (u16)pg8::cvt_pk_bf16(f, 0.f); }
#define pk2(lo_, hi_) pg8::cvt_pk_bf16((lo_), (hi_))
__device__ __forceinline__ float sigmf(float x) { return __builtin_amdgcn_rcpf(1.0f + __expf(-x)); }
__device__ __forceinline__ float tanh_fast(float x) { return 1.0f - 2.0f * __builtin_amdgcn_rcpf(1.0f + __expf(2.0f * x)); }
__device__ __forceinline__ f32x4 mfma16(const bf16x8 a, const bf16x8 b, const f32x4 c) { return __builtin_amdgcn_mfma_f32_16x16x32_bf16(a, b, c, 0, 0, 0); }
__device__ __forceinline__ bf16x8 as_bf16x8(const v4u v) { return __builtin_bit_cast(bf16x8, v); }
typedef short bf16x4 __attribute__((ext_vector_type(4)));
__device__ __forceinline__ f32x4 mfma16k16(const bf16x4 a, const bf16x4 b, const f32x4 c) { const bf16x8 a8 = {a[0], a[1], a[2], a[3], 0, 0, 0, 0}, b8 = {b[0], b[1], b[2], b[3], 0, 0, 0, 0}; return __builtin_amdgcn_mfma_f32_16x16x32_bf16(a8, b8, c, 0, 0, 0); }
__device__ __forceinline__ bf16x4 as_bf16x4(const u32x2 v) { return __builtin_bit_cast(bf16x4, v); }
__device__ __forceinline__ bf16x4 pack4(const f32x4 a) { u32x2 w; w.x = pg8::cvt_pk_bf16(a[0], a[1]); w.y = pg8::cvt_pk_bf16(a[2], a[3]); return as_bf16x4(w); }

__device__ __forceinline__ void tr_item(const float* W, int K, int ldw, int sc0, int nblk, int ncols_valid, bf16* WT, int dr0, LAS float* scr, int item, int lane) {
    const int kb = item / nblk, nb = item % nblk, k0 = 64 * kb, n0 = 32 * nb;
#pragma unroll 8
    for (int i = 0; i < 32; ++i) { const int kk = 2 * i + (lane >> 5); const int n = n0 + (lane & 31); const int nc = (n < ncols_valid) ? n : 0;
        const float v = W[(size_t)(k0 + kk) * ldw + sc0 + nc]; scr[kk * 33 + (lane & 31)] = (n < ncols_valid) ? v : 0.f; }
    LDS_WAIT(); asm volatile("" ::: "memory");
    const int c = lane & 7;
#pragma unroll
    for (int j = 0; j < 4; ++j) { const int n = (lane >> 3) + 8 * j; const LAS float* s = scr + (8 * c) * 33 + n;
        v4u o; o.x = pk2(s[0 * 33], s[1 * 33]); o.y = pk2(s[2 * 33], s[3 * 33]); o.z = pk2(s[4 * 33], s[5 * 33]); o.w = pk2(s[6 * 33], s[7 * 33]);
        *(GAS v4u*)(WT + (size_t)(dr0 + n0 + n) * K + k0 + 8 * c) = o; }
    LDS_WAIT(); asm volatile("" ::: "memory");
}
__device__ __forceinline__ void rms_row_to_bf16(int lane, const float* xrow, const float* gain, bf16* orow) {
    const GAS f32x4* xr = (const GAS f32x4*)xrow + lane; const GAS f32x4* gr = (const GAS f32x4*)gain + lane;
    f32x4 v[4]; float s2 = 0.f;
#pragma unroll
    for (int j = 0; j < 4; ++j) { v[j] = xr[64 * j]; s2 += (v[j].x * v[j].x + v[j].y * v[j].y) + (v[j].z * v[j].z + v[j].w * v[j].w); }
    const float rstd = 1.f / sqrtf(wave_sum(s2) * (1.f / D) + NORM_EPS);
    GAS unsigned long long* o8 = (GAS unsigned long long*)orow + lane;
#pragma unroll
    for (int j = 0; j < 4; ++j) { const f32x4 g = gr[64 * j];
        o8[64 * j] = (unsigned long long)pk2(v[j].x * rstd * g.x, v[j].y * rstd * g.y) | ((unsigned long long)pk2(v[j].z * rstd * g.z, v[j].w * rstd * g.w) << 32); }
}
__device__ __forceinline__ void p0_prologue(const Frame& F) {
    LAS float* scr = (LAS float*)(F.lds + RING_OFF + F.wave * 16384);
    const int gw = F.vcu * NWAVES + F.wave, NGW = F.G * NWAVES;
    unsigned char* ws = F.ws;
    constexpr int I0 = 16 * 96, I1 = 16 * 64, I2 = 16 * 8, I3 = 8 * 32, I4 = 8 * 32, I5 = 16 * 32, I6 = 16 * 64, I7 = 32 * 8, I8 = 32 * 8, I9 = 4 * 2, I10 = 4 * 2, I11 = 16, I12 = 16, I13 = 32;
    constexpr int NITEMS = I0 + I1 + I2 + I3 + I4 + I5 + I6 + I7 + I8 + I9 + I10 + I11 + I12 + I13;
    for (int it = gw; it < NITEMS; it += NGW) {
        int r = it;
        if (r < I0) { tr_item(F.in[2], 1024, 5144, 0, 96, 3072, (bf16*)(ws + WS_WIN), 0, scr, r, F.lane); continue; } r -= I0;
        if (r < I1) { tr_item(F.in[2], 1024, 5144, 3096, 64, 2048, (bf16*)(ws + WS_WIN), 3072, scr, r, F.lane); continue; } r -= I1;
        if (r < I2) { tr_item(F.in[2], 1024, 5144, 3072, 8, 24, (bf16*)(ws + WS_WIN), 5120, scr, r, F.lane); continue; } r -= I2;
        if (r < I3) { tr_item(F.in[24], 512, 1024, 0, 32, 1024, (bf16*)(ws + WS_WA), 0, scr, r, F.lane); continue; } r -= I3;
        if (r < I4) { tr_item(F.in[25], 512, 1024, 0, 32, 1024, (bf16*)(ws + WS_WB), 0, scr, r, F.lane); continue; } r -= I4;
        if (r < I5) { tr_item(F.in[26], 1024, 1024, 0, 32, 1024, (bf16*)(ws + WS_WOUT), 0, scr, r, F.lane); continue; } r -= I5;
        if (r < I6) { tr_item(F.in[28], 1024, 2048, 0, 64, 2048, (bf16*)(ws + WS_WQ), 0, scr, r, F.lane); continue; } r -= I6;
        if (r < I7) { tr_item(F.in[20], 2048, 256, 0, 8, 256, (bf16*)(ws + WS_CW1K), 0, scr, r, F.lane); continue; } r -= I7;
        if (r < I8) { tr_item(F.in[22], 2048, 256, 0, 8, 256, (bf16*)(ws + WS_CW1V), 0, scr, r, F.lane); continue; } r -= I8;
        if (r < I9) { tr_item(F.in[21], 256, 64, 0, 2, 64, (bf16*)(ws + WS_CW2K), 0, scr, r, F.lane); continue; } r -= I9;
        if (r < I10) { tr_item(F.in[23], 256, 64, 0, 2, 64, (bf16*)(ws + WS_CW2V), 0, scr, r, F.lane); continue; } r -= I10;
        if (r < I11) { tr_item(F.in[5], 64, 512, 0, 16, 512, (bf16*)(ws + WS_WUT), 0, scr, r, F.lane); continue; } r -= I11;
        if (r < I12) { tr_item(F.in[7], 64, 512, 0, 16, 512, (bf16*)(ws + WS_AUT), 0, scr, r, F.lane); continue; } r -= I12;
        tr_item(F.in[8], 128, 512, 0, 16, 512, (bf16*)(ws + WS_GUT), 0, scr, r, F.lane);
    }
    { const int gt = F.vcu * (NWAVES * 64) + F.tid, NT = F.G * NWAVES * 64;
      bf16* s1 = (bf16*)(ws + WS_SK1); bf16* s2 = (bf16*)(ws + WS_SK2);
      for (int i = gt; i < 128 * 128; i += NT) { s1[i] = f2b(F.in[29][i]); s2[i] = f2b(F.in[30][i]); } }
    for (int m = gw; m < M; m += NGW) rms_row_to_bf16(F.lane, F.in[0] + (size_t)m * D, F.in[1], (bf16*)(ws + WS_H) + (size_t)m * D);
}
constexpr int REC_BYTES = 13696;
constexpr int RO_KT = 0, RO_RT = 2048, RO_BH = 4096, RO_KH = 6144, RO_VT = 8192, RO_UV = 10240, RO_MB = 12288, RO_MK = 12800, RO_GAM = 13312, RO_BON = 13568;
__device__ __forceinline__ void rwkv_prep_tile(const Frame& F, int u) {
    const int tid = F.tid, lane = F.lane, h = F.wave, r16 = lane & 15, q4 = lane >> 4;
    const int R0 = 64 * u, t0 = R0 & (T - 1);
    LAS bf16* linb = (LAS bf16*)(F.lds);
    LAS bf16* mats = (LAS bf16*)(F.lds + 16384) + h * 4096;
    LAS float* abl = (LAS float*)(F.lds + 16384 + 65536) + h * 272;
    LAS bf16* ktT = (LAS bf16*)(F.lds + 16384 + 65536 + 8704) + h * 1024;
    LAS bf16* vtT = (LAS bf16*)(F.lds + 16384 + 65536 + 8704 + 16384) + h * 1024;
    float* PRW = (float*)(F.ws + WS_PRW);
    const float* BND = (const float*)(F.ws + WS_BND);
    bf16* G = (bf16*)((unsigned char*)F.out + DO_G);
    const float* mu = F.in[3];
    const float mu_r = mu[tid], mu_k = mu[512 + tid], mu_v = mu[1024 + tid], mu_l = (tid < 256) ? mu[1536 + tid] : 0.f;
    const float w0c = F.in[4][tid], a0c = F.in[6][tid], kkc = F.in[9][tid], kac = F.in[10][tid], rkc = F.in[11][tid];
    const float* w_up = F.in[5]; const float* a_up = F.in[7]; const float* g_up = F.in[8];
    float pr = 0.f, pk = 0.f, pv = 0.f, pl = 0.f;
    if (t0 != 0) { const float* b = BND + (size_t)(u - 1) * RWC; pr = b[tid]; pk = b[512 + tid]; pv = b[1024 + tid]; if (tid < 256) pl = b[1536 + tid]; }
    for (int batch = 0; batch < 4; ++batch) {
        const int Rb = R0 + 16 * batch;
        if (DBG_SEL == 30 && batch == 0 && blockIdx.x == 0 && tid == 0) F.MISC[20] = (unsigned)__builtin_amdgcn_s_memrealtime();
        float xr[16], xk[16]; unsigned vtw[8];
        if (tid < 256) { float xl[16];
#pragma unroll
            for (int j = 0; j < 16; ++j) xl[j] = PRW[(size_t)(Rb + j) * RWC + 1536 + tid];
#pragma unroll
            for (int j = 0; j < 16; ++j) { const float n = xl[j]; const float v = n + (pl - n) * mu_l; pl = n; const float f = (tid < 64) ? tanh_fast(v) : ((tid < 128) ? v : sigmf(v)); linb[j * 256 + tid] = f2b(f); } }
        { float xv[16];
#pragma unroll
          for (int j = 0; j < 16; ++j) { const float* p = PRW + (size_t)(Rb + j) * RWC; xr[j] = p[tid]; xk[j] = p[512 + tid]; xv[j] = p[1024 + tid]; }
          VM_WAIT();
#pragma unroll
          for (int j = 0; j < 16; ++j) { float n;
              n = xr[j]; xr[j] = n + (pr - n) * mu_r; pr = n;
              n = xk[j]; xk[j] = n + (pk - n) * mu_k; pk = n;
              n = xv[j]; const unsigned vb = f2bf(n + (pv - n) * mu_v); pv = n;
              if (j & 1) vtw[j >> 1] |= vb << 16; else vtw[j >> 1] = vb; } }
        __syncthreads();
        { unsigned char* rec0 = (unsigned char*)(PRW + (size_t)Rb * RWC) + h * REC_BYTES;
          v4u* vp = (v4u*)(rec0 + RO_VT + lane * 32); vp[0] = (v4u){vtw[0], vtw[1], vtw[2], vtw[3]}; vp[1] = (v4u){vtw[4], vtw[5], vtw[6], vtw[7]};
          LAS v4u* vl = (LAS v4u*)(vtT + lane * 16); vl[0] = (v4u){vtw[0], vtw[1], vtw[2], vtw[3]}; vl[1] = (v4u){vtw[4], vtw[5], vtw[6], vtw[7]}; }
        if ((DBG_SEL == 30 || DBG_SEL == 31) && batch == 0 && blockIdx.x == 0 && tid == 0) F.MISC[20 + (DBG_SEL == 30)] = (unsigned)__builtin_amdgcn_s_memrealtime();
        float accw[16], acca[16];
        { const bf16* WUT = (const bf16*)(F.ws + WS_WUT); const bf16* AUT = (const bf16*)(F.ws + WS_AUT); const bf16* GUT = (const bf16*)(F.ws + WS_GUT);
          const f32x4 Z4 = {0.f, 0.f, 0.f, 0.f};
          bf16x8 af[8];
#pragma unroll
          for (int ks = 0; ks < 8; ++ks) af[ks] = as_bf16x8(*(const LAS v4u*)(linb + r16 * 256 + 32 * ks + 8 * q4));
          LAS float* ow = (LAS float*)mats;
#pragma unroll
          for (int nt = 0; nt < 4; ++nt) { const int col = 64 * h + 16 * nt + r16;
              f32x4 cw = Z4, ca = Z4, cg = Z4;
#pragma unroll
              for (int ks = 0; ks < 2; ++ks) { cw = mfma16(af[ks], as_bf16x8(*(const v4u*)(WUT + (size_t)col * 64 + 32 * ks + 8 * q4)), cw); ca = mfma16(af[2 + ks], as_bf16x8(*(const v4u*)(AUT + (size_t)col * 64 + 32 * ks + 8 * q4)), ca); }
#pragma unroll
              for (int ks = 0; ks < 4; ++ks) cg = mfma16(af[4 + ks], as_bf16x8(*(const v4u*)(GUT + (size_t)col * 128 + 32 * ks + 8 * q4)), cg);
#pragma unroll
              for (int r = 0; r < 4; ++r) { const int tok = 4 * q4 + r; ow[tok * 64 + 16 * nt + r16] = cw[r]; ow[1024 + tok * 64 + 16 * nt + r16] = ca[r]; G[(size_t)(Rb + tok) * 512 + col] = f2b(cg[r]); } }
          LDS_WAIT(); asm volatile("" ::: "memory");
#pragma unroll
          for (int j = 0; j < 16; ++j) { accw[j] = ow[j * 64 + lane]; acca[j] = ow[1024 + j * 64 + lane]; }
          LDS_WAIT(); asm volatile("" ::: "memory"); }
        if ((DBG_SEL == 31 || DBG_SEL == 32) && batch == 0 && blockIdx.x == 0 && tid == 0) F.MISC[20 + (DBG_SEL == 31)] = (unsigned)__builtin_amdgcn_s_memrealtime();
        unsigned char* rec = (unsigned char*)(PRW + (size_t)Rb * RWC) + h * REC_BYTES;
        { float g = 1.f;
          LAS bf16* mp = mats + lane; bf16* rBh = (bf16*)(rec + RO_BH) + lane * 16; bf16* rKh = (bf16*)(rec + RO_KH) + lane * 16;
#pragma unroll
          for (int j = 0; j < 16; ++j) {
              const float z = -(w0c + accw[j]); const float sp = fmaxf(z, 0.f) + __logf(1.0f + __expf(-fabsf(z)));
              const float wj = __expf(-__expf(-sp - 0.5f));
              const float a = sigmf(a0c + acca[j]);
              const float kkv = xk[j] * kkc; const float kmod = xk[j] * (1.f + (a - 1.f) * kac);
              const float ss = wave_sum(kkv * kkv); const float kkn = kkv * rsqrtf(fmaxf(ss, 1e-24f));
              const float bon = wave_sum(xr[j] * kmod * rkc);
              if (lane == 0) *(float*)(rec + RO_BON + 4 * j) = bon;
              const float gp = g; g *= wj; const float ig = __builtin_amdgcn_rcpf(g);
              const unsigned w1 = pg8::cvt_pk_bf16(kkn * gp, xr[j] * g), w2 = pg8::cvt_pk_bf16(kkn * a * ig, kmod * ig);
              mp[j * 64] = (u16)(w1 & 0xffffu); mp[1024 + j * 64] = (u16)(w1 >> 16); mp[2048 + j * 64] = (u16)(w2 & 0xffffu); mp[3072 + j * 64] = (u16)(w2 >> 16);
              ktT[lane * 16 + j] = (u16)(w1 & 0xffffu);
              rBh[j] = (u16)(w2 & 0xffffu); rKh[j] = (u16)(w2 >> 16);
              __builtin_amdgcn_sched_barrier(0); }
          *(float*)(rec + RO_GAM + 4 * lane) = g;
          }
        LDS_WAIT(); asm volatile("" ::: "memory");
#pragma unroll
        for (int i = 0; i < 2; ++i) { const int pi = lane + 64 * i, s = pi >> 3, ks = (pi >> 2) & 1, qq = pi & 3;
            const LAS bf16* src = mats + 1024 + s * 64 + 32 * ks + 4 * qq;
            const u32x2 lo = *(const LAS u32x2*)src, hi = *(const LAS u32x2*)(src + 16);
            *(v4u*)(rec + RO_RT + pi * 16) = (v4u){lo.x, lo.y, hi.x, hi.y}; }
        LDS_WAIT(); asm volatile("" ::: "memory");
        { f32x4 Ab = {0.f, 0.f, 0.f, 0.f}, Ak = Ab, Mb = Ab, Mk = Ab;
#pragma unroll
          for (int ks = 0; ks < 2; ++ks) { const int off = r16 * 64 + 32 * ks + 8 * q4;
              const bf16x8 aK = as_bf16x8(*(const LAS v4u*)(mats + off)), aR = as_bf16x8(*(const LAS v4u*)(mats + 1024 + off)), bB = as_bf16x8(*(const LAS v4u*)(mats + 2048 + off)), bK = as_bf16x8(*(const LAS v4u*)(mats + 3072 + off));
              Ab = mfma16(aK, bB, Ab); Ak = mfma16(aK, bK, Ak); Mb = mfma16(aR, bB, Mb); Mk = mfma16(aR, bK, Mk); }
          LDS_WAIT(); asm volatile("" ::: "memory");
          bf16* rMb = (bf16*)(rec + RO_MB); bf16* rMk = (bf16*)(rec + RO_MK);
          LAS bf16* akl = mats + 3072;
#pragma unroll
          for (int r = 0; r < 4; ++r) { const int s = 4 * q4 + r, j = r16; const bool lo = j < s, le = j <= s;
              abl[s * 17 + j] = lo ? Ab[r] : 0.f; akl[s * 16 + j] = f2b(lo ? Ak[r] : 0.f); rMb[s * 16 + j] = f2b(le ? Mb[r] : 0.f); rMk[s * 16 + j] = f2b(le ? Mk[r] : 0.f); }
          }
        LDS_WAIT(); asm volatile("" ::: "memory");
        { float Tr[16]; LAS bf16* ntl = mats + 3072 + 256;
#pragma unroll
          for (int s = 0; s < 16; ++s) { float t = (r16 == s) ? 1.f : 0.f;
#pragma unroll
              for (int j = 0; j < s; ++j) t -= abl[s * 17 + j] * Tr[j];
              Tr[s] = t; if (lane < 16) ntl[s * 16 + r16] = f2b(-t); __builtin_amdgcn_sched_barrier(0); } }
        LDS_WAIT(); asm volatile("" ::: "memory");
        { const f32x4 Z4 = {0.f, 0.f, 0.f, 0.f};
          const bf16x4 ntf = as_bf16x4(*(const LAS u32x2*)(mats + 3072 + 256 + r16 * 16 + 4 * q4)), akf = as_bf16x4(*(const LAS u32x2*)(mats + 3072 + r16 * 16 + 4 * q4));
          bf16* rKt = (bf16*)(rec + RO_KT);
#pragma unroll
          for (int nt = 0; nt < 4; ++nt) {
              const bf16x4 ktf = as_bf16x4(*(const LAS u32x2*)(ktT + (16 * nt + r16) * 16 + 4 * q4)), vtf = as_bf16x4(*(const LAS u32x2*)(vtT + (16 * nt + r16) * 16 + 4 * q4));
              const f32x4 kp = mfma16k16(ntf, ktf, Z4);
              const f32x4 akv = mfma16k16(akf, vtf, Z4);
              const f32x4 uv = mfma16k16(ntf, pack4(akv), Z4);
              const int pos = (nt >> 1) * 32 + (r16 >> 2) * 8 + (nt & 1) * 4 + (r16 & 3);
#pragma unroll
              for (int r = 0; r < 4; ++r) rKt[(4 * q4 + r) * 64 + pos] = f2b(kp[r]);
              *(u32x2*)(rec + RO_UV + ((16 * nt + r16) * 16 + 4 * q4) * 2) = __builtin_bit_cast(u32x2, pack4(uv)); } }
        LDS_WAIT(); asm volatile("" ::: "memory");
        __syncthreads();
        if (DBG_SEL == 32 && batch == 0 && blockIdx.x == 0 && tid == 0) F.MISC[21] = (unsigned)__builtin_amdgcn_s_memrealtime();
    }
}
__device__ __forceinline__ void nsa_prep_tile(const Frame& F, int u) {
    const int lane = F.lane, w = F.wave;
    const int R0 = 64 * u, t0 = R0 & (T - 1), b = R0 / T;
    bf16* PNSA = (bf16*)((unsigned char*)F.out + DO_PNSA);
    const float qg = F.in[14][lane] * (0.125f * LOG2E);
    const float kg = (w < 2) ? F.in[16][lane] : F.in[17][lane];
    const int kcol = ((w < 2) ? 768 : 1024) + (w & 1) * 64 + lane;
#pragma unroll 1
    for (int tg = 0; tg < 4; ++tg) { float qv[16], kv[16];
#pragma unroll
        for (int i = 0; i < 16; ++i) { const bf16* p = PNSA + (size_t)(R0 + 16 * tg + i) * 1280; qv[i] = bf2f(p[w * 64 + lane]); kv[i] = (w < 4) ? bf2f(p[kcol]) : 0.f; }
#pragma unroll
        for (int i = 0; i < 16; ++i) { bf16* p = PNSA + (size_t)(R0 + 16 * tg + i) * 1280;
            const float ss = wave_sum(qv[i] * qv[i]) * (1.f / 64.f);
            p[w * 64 + lane] = f2b(qv[i] * rsqrtf(ss + NORM_EPS) * qg);
            if (w < 4) { const float ks = wave_sum(kv[i] * kv[i]) * (1.f / 64.f); p[kcol] = f2b(kv[i] * rsqrtf(ks + NORM_EPS) * kg); } } }
    {
        const bf16* Hb = (const bf16*)(F.ws + WS_H) + (size_t)(R0 + 16 * (w & 3) + (lane & 15)) * D + 8 * (lane >> 4);
        const bf16* Wg = (const bf16*)(F.ws + WS_WIN) + (size_t)(5120 + 16 * (w >> 2) + (lane & 15)) * D + 8 * (lane >> 4);
        f32x4 acc = {0.f, 0.f, 0.f, 0.f};
#pragma unroll 1
        for (int k8 = 0; k8 < 32; k8 += 8) { v4u ha[8], wb[8];
#pragma unroll
            for (int k = 0; k < 8; ++k) { ha[k] = *(const v4u*)(Hb + 32 * (k8 + k)); wb[k] = *(const v4u*)(Wg + 32 * (k8 + k)); }
#pragma unroll
            for (int k = 0; k < 8; ++k) acc = mfma16(as_bf16x8(ha[k]), as_bf16x8(wb[k]), acc); }
        float* GLOG = (float*)((unsigned char*)F.out + DO_GLOG);
#pragma unroll
        for (int r = 0; r < 4; ++r) GLOG[(size_t)(R0 + 16 * (w & 3) + 4 * (lane >> 4) + r) * 32 + 16 * (w >> 2) + (lane & 15)] = acc[r];
    }
    if (w >= 4) {
        const int g = w & 1; const int scol = ((w < 6) ? 896 : 1152) + g * 64;
        bf16* VT = (bf16*)(F.ws + ((w < 6) ? WS_VST : WS_VWT)) + (size_t)((b * 2 + g) * 64) * T + (size_t)((t0 + lane) >> 5) * 2048 + ((t0 + lane) & 31);
        const v4u* src = (const v4u*)(PNSA + (size_t)(R0 + lane) * 1280 + scol);
        v4u v[8];
#pragma unroll
        for (int i = 0; i < 8; ++i) v[i] = src[i];
#pragma unroll
        for (int i = 0; i < 8; ++i) {
            VT[(8 * i + 0) * 32] = (u16)(v[i].x & 0xffffu); VT[(8 * i + 1) * 32] = (u16)(v[i].x >> 16);
            VT[(8 * i + 2) * 32] = (u16)(v[i].y & 0xffffu); VT[(8 * i + 3) * 32] = (u16)(v[i].y >> 16);
            VT[(8 * i + 4) * 32] = (u16)(v[i].z & 0xffffu); VT[(8 * i + 5) * 32] = (u16)(v[i].z >> 16);
            VT[(8 * i + 6) * 32] = (u16)(v[i].w & 0xffffu); VT[(8 * i + 7) * 32] = (u16)(v[i].w >> 16); }
    }
}
__device__ __forceinline__ float gelu_tanh(float x) { const float t = 0.7978845608028654f * (x + 0.044715f * x * x * x); return 0.5f * x * (1.f + tanh_fast(t)); }
__device__ __forceinline__ void compress_unit(const Frame& F, int u) {
    const int lane = F.lane, w = F.wave, r16 = lane & 15, q4 = lane >> 4;
    const int kvsel = u >> 7, b = (u >> 5) & 3, g = (u >> 4) & 1, ntile = u & 15;
    const bf16* X = (const bf16*)((unsigned char*)F.out + DO_PNSA) + (size_t)(b * T) * 1280 + (kvsel ? 640 : 512) + g * 64;
    const float* pos = kvsel ? F.in[19] : F.in[18];
    const bf16* W1t = (const bf16*)(F.ws + (kvsel ? WS_CW1V : WS_CW1K));
    const bf16* W2t = (const bf16*)(F.ws + (kvsel ? WS_CW2V : WS_CW2K));
    LAS bf16* hid = (LAS bf16*)(F.lds);
    LAS float* outb = (LAS float*)(F.lds + 16 * 528);
    int n = 16 * ntile + r16; if (n > 254) n = 254;
    f32x4 acc[2] = {{0.f, 0.f, 0.f, 0.f}, {0.f, 0.f, 0.f, 0.f}};
#pragma unroll 4
    for (int s = 0; s < 64; ++s) { const int lp = s >> 1, d0 = (s & 1) * 32 + 8 * q4;
        const v4u xa = *(const v4u*)(X + (size_t)(16 * n + lp) * 1280 + d0);
        const f32x4 p0 = *(const f32x4*)(pos + lp * 64 + d0), p1 = *(const f32x4*)(pos + lp * 64 + d0 + 4);
        v4u af; af.x = pk2(bflo(xa.x) + p0[0], bfhi(xa.x) + p0[1]); af.y = pk2(bflo(xa.y) + p0[2], bfhi(xa.y) + p0[3]);
        af.z = pk2(bflo(xa.z) + p1[0], bfhi(xa.z) + p1[1]); af.w = pk2(bflo(xa.w) + p1[2], bfhi(xa.w) + p1[3]);
#pragma unroll
        for (int nt = 0; nt < 2; ++nt) { const v4u bfg = *(const v4u*)(W1t + (size_t)(32 * w + 16 * nt + r16) * 2048 + 32 * s + 8 * q4);
            acc[nt] = mfma16(as_bf16x8(af), as_bf16x8(bfg), acc[nt]); } }
#pragma unroll
    for (int nt = 0; nt < 2; ++nt)
#pragma unroll
        for (int r = 0; r < 4; ++r) hid[(4 * q4 + r) * 264 + 32 * w + 16 * nt + r16] = f2b(gelu_tanh(acc[nt][r]));
    __syncthreads();
    if (w < 4) { f32x4 a2 = {0.f, 0.f, 0.f, 0.f};
#pragma unroll
        for (int s = 0; s < 8; ++s) { const v4u af = *(const LAS v4u*)(hid + r16 * 264 + 32 * s + 8 * q4);
            const v4u bfg = *(const v4u*)(W2t + (size_t)(16 * w + r16) * 256 + 32 * s + 8 * q4);
            a2 = mfma16(as_bf16x8(af), as_bf16x8(bfg), a2); }
#pragma unroll
        for (int r = 0; r < 4; ++r) outb[(4 * q4 + r) * 64 + 16 * w + r16] = a2[r]; }
    __syncthreads();
#pragma unroll
    for (int rr = 0; rr < 2; ++rr) { const int row = 2 * w + rr; const int nn = 16 * ntile + row; float val = outb[row * 64 + lane];
        if (kvsel == 0) { const float ss = wave_sum(val * val) * (1.f / 64.f); val = val * rsqrtf(ss + NORM_EPS) * F.in[15][lane];
            ((bf16*)(F.ws + WS_KC))[(size_t)((b * 2 + g) * 256 + nn) * 64 + lane] = (nn < 255) ? f2b(val) : (u16)0; }
        else ((bf16*)(F.ws + WS_VCT))[(size_t)((b * 2 + g) * 64 + lane) * 256 + nn] = (nn < 255) ? f2b(val) : (u16)0; }
    __syncthreads();
}
__device__ __forceinline__ bf16x8 pack_p(const f32x4 a, const f32x4 b) {
    v4u w; w.x = pg8::cvt_pk_bf16(a[0], a[1]); w.y = pg8::cvt_pk_bf16(a[2], a[3]); w.z = pg8::cvt_pk_bf16(b[0], b[1]); w.w = pg8::cvt_pk_bf16(b[2], b[3]); return as_bf16x8(w);
}
#define NSA_FENCE() asm volatile("s_waitcnt lgkmcnt(0)" ::: "memory")
struct KFr { bf16x8 a0, a1, b0, b1; };
struct VFr { bf16x8 v[4]; };
__device__ __forceinline__ KFr lds_k(const LAS unsigned char* ks, int r16, int q4) {
    const int rA = 8 * (r16 >> 2) + (r16 & 3), rB = rA + 4; const int xA = (rA >> 1) & 7, xB = (rB >> 1) & 7;
    KFr f; f.a0 = as_bf16x8(*(const LAS v4u*)(ks + rA * 128 + ((q4 ^ xA) << 4))); f.a1 = as_bf16x8(*(const LAS v4u*)(ks + rA * 128 + (((4 + q4) ^ xA) << 4)));
    f.b0 = as_bf16x8(*(const LAS v4u*)(ks + rB * 128 + ((q4 ^ xB) << 4))); f.b1 = as_bf16x8(*(const LAS v4u*)(ks + rB * 128 + (((4 + q4) ^ xB) << 4))); return f;
}
__device__ __forceinline__ VFr lds_v(const LAS unsigned char* vs, int r16, int q4) {
    VFr f;
#pragma unroll
    for (int dt = 0; dt < 4; ++dt) { const int d = 16 * dt + r16; f.v[dt] = as_bf16x8(*(const LAS v4u*)(vs + d * 64 + ((q4 ^ ((d >> 2) & 3)) << 4))); }
    return f;
}
struct NsaSrc { const bf16* kb; int krs; const bf16* vb; int vrs; int vtiled; };
__device__ __forceinline__ v4u nsa_stage_load(const NsaSrc& S, int k0, int tid) {
    if (tid < 256) return *(const v4u*)(S.kb + (size_t)(k0 + (tid >> 3)) * S.krs + 8 * (tid & 7));
    const int i = tid - 256, d = i >> 2, c = i & 3;
    return S.vtiled ? *(const v4u*)(S.vb + (size_t)(k0 >> 5) * 2048 + d * 32 + 8 * c) : *(const v4u*)(S.vb + (size_t)d * S.vrs + k0 + 8 * c);
}
__device__ __forceinline__ void nsa_stage_write(LAS unsigned char* lds, int slot, int tid, const v4u v) {
    if (tid < 256) { const int r = tid >> 3, c = tid & 7; *(LAS v4u*)(lds + slot * 4096 + r * 128 + ((c ^ ((r >> 1) & 7)) << 4)) = v; }
    else { const int i = tid - 256, d = i >> 2, c = i & 3; *(LAS v4u*)(lds + 8192 + slot * 4096 + d * 64 + ((c ^ ((d >> 2) & 3)) << 4)) = v; }
}
__device__ __forceinline__ void nsa_block_unit(const Frame& F, int b, int g, int T0, int skip) {
    const int lane = F.lane, tid = F.tid, w = F.wave, r16 = lane & 15, q4 = lane >> 4;
    const int t0 = T0 + 8 * w;
    const f32x4 Z4 = {0.f, 0.f, 0.f, 0.f};
    const bf16x8 ones8 = {0x3F80, 0x3F80, 0x3F80, 0x3F80, 0x3F80, 0x3F80, 0x3F80, 0x3F80};
    LAS unsigned char* lds = F.lds;
    LAS float* wl = (LAS float*)(lds + 16384 + w * 5120);
    LAS float* impT = wl; LAS float* imp2T = wl + 8 * 65; LAS unsigned* selT = (LAS unsigned*)(wl + 16 * 65);
    LAS unsigned* bw = (LAS unsigned*)(lds + 57344); LAS int* stl = (LAS int*)(lds + 57344 + 128);
    const bf16* PN = (const bf16*)((unsigned char*)F.out + DO_PNSA) + (size_t)(b * T) * 1280;
    const float* GL = (const float*)((unsigned char*)F.out + DO_GLOG) + (size_t)(b * T) * 32;
    bf16x8 qf[2][2]; int tq[2];
#pragma unroll
    for (int mt = 0; mt < 2; ++mt) { tq[mt] = t0 + 4 * mt + (r16 >> 2);
#pragma unroll
        for (int dh = 0; dh < 2; ++dh) qf[mt][dh] = as_bf16x8(*(const v4u*)(PN + (size_t)tq[mt] * 1280 + (g * 4 + (r16 & 3)) * 64 + 32 * dh + 8 * q4)); }
    f32x4 Oc[2][4];
#pragma unroll
    for (int mt = 0; mt < 2; ++mt)
#pragma unroll
        for (int dt = 0; dt < 4; ++dt) Oc[mt][dt] = Z4;
#define NSA_GATE(mt_, r_, br_) sigmf(GL[(size_t)(t0 + 4 * (mt_) + q4) * 32 + g * 12 + (r_) * 3 + (br_)])
#define NSA_PIPE_BEGIN(S_, n_, K0_OF) { v4u st = nsa_stage_load(S_, K0_OF(0), tid); nsa_stage_write(lds, 0, tid, st); if ((n_) > 1) st = nsa_stage_load(S_, K0_OF(1), tid); __syncthreads(); \
        for (int i = 0; i < (n_); ++i) { const int k0 = K0_OF(i); const LAS unsigned char* ks = lds + (i & 1) * 4096; const LAS unsigned char* vs = lds + 8192 + (i & 1) * 4096;
#define NSA_PIPE_END(S_, n_, K0_OF) if (i + 1 < (n_)) nsa_stage_write(lds, (i + 1) & 1, tid, st); if (i + 2 < (n_)) st = nsa_stage_load(S_, K0_OF(i + 2), tid); __syncthreads(); } }

    for (int i = lane; i < 16 * 65; i += 64) wl[i] = 0.f;
    const NsaSrc SC{(const bf16*)(F.ws + WS_KC) + (size_t)((b * 2 + g) * 256) * 64, 64, (const bf16*)(F.ws + WS_VCT) + (size_t)((b * 2 + g) * 64) * 256, 256, 0};
    const int ncb = (T0 + 63 >= 31) ? ((T0 + 63 - 31) >> 4) + 1 : 0; const int nstB = (skip & 1) ? 0 : ((ncb + 31) >> 5);
    const int ncw = (t0 + 7 >= 31) ? ((t0 + 7 - 31) >> 4) + 1 : 0; const int nstW = (skip & 1) ? 0 : ((ncw + 31) >> 5);
    float inv[2] = {0.f, 0.f};
#define K0_LIN(i_) (32 * (i_))
    if (nstB > 0) { float ls[2] = {0.f, 0.f};
        NSA_PIPE_BEGIN(SC, nstB, K0_LIN)
            if (i < nstW) { const KFr kf = lds_k(ks, r16, q4); const bool cslow = 16 * (k0 + 31) + 31 > t0;
#pragma unroll
                for (int mt = 0; mt < 2; ++mt) { f32x4 bA = Z4, bB = Z4;
                    if (cslow) {
#pragma unroll
                        for (int r = 0; r < 4; ++r) { const int nA = k0 + 8 * q4 + r, nB = nA + 4; bA[r] = (16 * nA + 31 <= tq[mt]) ? 0.f : -1e30f; bB[r] = (16 * nB + 31 <= tq[mt]) ? 0.f : -1e30f; } }
                    f32x4 sA = mfma16(kf.a0, qf[mt][0], bA); sA = mfma16(kf.a1, qf[mt][1], sA); f32x4 sB = mfma16(kf.b0, qf[mt][0], bB); sB = mfma16(kf.b1, qf[mt][1], sB);
#pragma unroll
                    for (int r = 0; r < 4; ++r) { ls[mt] += __builtin_amdgcn_exp2f(sA[r]); ls[mt] += __builtin_amdgcn_exp2f(sB[r]); } } }
        NSA_PIPE_END(SC, nstB, K0_LIN)
#pragma unroll
        for (int mt = 0; mt < 2; ++mt) { float l = ls[mt]; l += __shfl_xor(l, 16); l += __shfl_xor(l, 32); inv[mt] = 1.0f / fmaxf(l, 1e-30f); }
    }
    if (nstB > 0) { f32x4 O[2][4];
#pragma unroll
        for (int mt = 0; mt < 2; ++mt)
#pragma unroll
            for (int dt = 0; dt < 4; ++dt) O[mt][dt] = Z4;
        NSA_PIPE_BEGIN(SC, nstB, K0_LIN)
            if (i < nstW) { const KFr kf = lds_k(ks, r16, q4); const VFr vf = lds_v(vs, r16, q4); const bool cslow = 16 * (k0 + 31) + 31 > t0;
#pragma unroll
                for (int mt = 0; mt < 2; ++mt) { f32x4 bA = Z4, bB = Z4;
                    if (cslow) {
#pragma unroll
                        for (int r = 0; r < 4; ++r) { const int nA = k0 + 8 * q4 + r, nB = nA + 4; bA[r] = (16 * nA + 31 <= tq[mt]) ? 0.f : -1e30f; bB[r] = (16 * nB + 31 <= tq[mt]) ? 0.f : -1e30f; } }
                    f32x4 sA = mfma16(kf.a0, qf[mt][0], bA); sA = mfma16(kf.a1, qf[mt][1], sA); f32x4 sB = mfma16(kf.b0, qf[mt][0], bB); sB = mfma16(kf.b1, qf[mt][1], sB);
                    f32x4 pA, pB;
#pragma unroll
                    for (int r = 0; r < 4; ++r) { pA[r] = __builtin_amdgcn_exp2f(sA[r]) * inv[mt]; pB[r] = __builtin_amdgcn_exp2f(sB[r]) * inv[mt]; }
                    float vA = pA[0] + pA[1] + pA[2] + 0.5f * pA[3], cA = 0.5f * pA[3], vB = pB[0] + pB[1] + pB[2] + 0.5f * pB[3], cB = 0.5f * pB[3];
                    vA += __shfl_xor(vA, 1); vA += __shfl_xor(vA, 2); cA += __shfl_xor(cA, 1); cA += __shfl_xor(cA, 2);
                    vB += __shfl_xor(vB, 1); vB += __shfl_xor(vB, 2); cB += __shfl_xor(cB, 1); cB += __shfl_xor(cB, 2);
                    if ((lane & 3) == 0) { const int tl = 4 * mt + (r16 >> 2), j = (k0 >> 2) + 2 * q4;
                        impT[tl * 65 + j] = vA; imp2T[tl * 65 + j + 1] = cA; impT[tl * 65 + j + 1] = vB; imp2T[tl * 65 + j + 2] = cB; }
                    const bf16x8 pf = pack_p(pA, pB);
#pragma unroll
                    for (int dt = 0; dt < 4; ++dt) O[mt][dt] = mfma16(pf, vf.v[dt], O[mt][dt]); } }
        NSA_PIPE_END(SC, nstB, K0_LIN)
#pragma unroll
        for (int mt = 0; mt < 2; ++mt)
#pragma unroll
            for (int r = 0; r < 4; ++r) { const float gt = NSA_GATE(mt, r, 0);
#pragma unroll
                for (int dt = 0; dt < 4; ++dt) Oc[mt][dt][r] += gt * O[mt][dt][r]; }
    }
    NSA_FENCE();
    const int cur = T0 >> 6;
    unsigned long long uni = 0ull;
    for (int tl = 0; tl < 8; ++tl) {
        unsigned long long mask;
        if (cur < 16 || (skip & 2)) mask = (cur < 16) ? ((2ull << cur) - 1ull) : (0xFFFFull | (1ull << cur) | (1ull << (cur - 1)));
        else {
            const float sc = impT[tl * 65 + lane] + imp2T[tl * 65 + lane];
            const unsigned key = __float_as_uint(fmaxf(sc, 0.f));
            const bool elig = (lane <= cur) && (lane != 0) && (lane != cur) && (lane != cur - 1);
            unsigned prefix = 0u;
            for (int bit = 30; bit >= 0; --bit) { const unsigned cand = prefix | (1u << bit);
                const int cnt = __popcll(__ballot(elig && key >= cand)); if (cnt >= 13) prefix = cand; }
            const unsigned long long gt = __ballot(elig && key > prefix); unsigned long long ties = __ballot(elig && key == prefix);
            int need = 13 - __popcll(gt); unsigned long long keep = 0ull;
            while (need > 0 && ties) { const unsigned long long low = ties & (0ull - ties); keep |= low; ties ^= low; --need; }
            mask = gt | keep | 1ull | (1ull << cur) | (1ull << (cur - 1));
        }
        uni |= mask;
        if (lane == 0) { selT[2 * tl] = (unsigned)mask; selT[2 * tl + 1] = (unsigned)(mask >> 32); }
    }
    if (lane == 0) { bw[2 + 2 * w] = (unsigned)uni; bw[3 + 2 * w] = (unsigned)(uni >> 32); }
    NSA_FENCE();
    unsigned long long mk[2];
#pragma unroll
    for (int mt = 0; mt < 2; ++mt) { const int tl = 4 * mt + (r16 >> 2); mk[mt] = (unsigned long long)selT[2 * tl] | ((unsigned long long)selT[2 * tl + 1] << 32); }
    __syncthreads();
    unsigned long long buni = 0ull;
#pragma unroll
    for (int ww = 0; ww < 8; ++ww) buni |= (unsigned long long)bw[2 + 2 * ww] | ((unsigned long long)bw[3 + 2 * ww] << 32);

#define K0_LIST(i_) (__builtin_amdgcn_readfirstlane(stl[(i_)]))
#pragma unroll 1
    for (int br = 1; br < 3; ++br) { if ((skip >> (br + 1)) & 1) continue;
        const NsaSrc SB{PN + (br == 1 ? 768 : 1024) + g * 64, 1280, (const bf16*)(F.ws + (br == 1 ? WS_VST : WS_VWT)) + (size_t)((b * 2 + g) * 64) * T, 0, 1};
        f32x4 O[2][4], L5[2] = {Z4, Z4};
#pragma unroll
        for (int mt = 0; mt < 2; ++mt)
#pragma unroll
            for (int dt = 0; dt < 4; ++dt) O[mt][dt] = Z4;
        int nsteps;
        if (br == 1) { nsteps = 2 * __popcll(buni);
            if (w == 0 && ((buni >> lane) & 1ull)) { const int rk = __popcll(buni & ((1ull << lane) - 1ull)); stl[2 * rk] = 64 * lane; stl[2 * rk + 1] = 64 * lane + 32; } }
        else { const int lo = T0 - 511; const int klo = (lo > 0 ? lo : 0) & ~31; nsteps = ((T0 + 64 - klo) + 31) >> 5; if (w == 0 && lane < nsteps) stl[lane] = klo + 32 * lane; }
        __syncthreads();
        NSA_PIPE_BEGIN(SB, nsteps, K0_LIST)
            const int j = k0 >> 6;
            const bool mine = (br == 1) ? (((uni >> j) & 1ull) != 0ull) : (k0 + 31 >= t0 - 511 && k0 <= t0 + 7);
            if (mine) { const KFr kf = lds_k(ks, r16, q4); const VFr vf = lds_v(vs, r16, q4);
                const bool slow = (br == 1) ? (j == cur) : (k0 < t0 - 504 || k0 + 31 > t0);
#pragma unroll
                for (int mt = 0; mt < 2; ++mt) { f32x4 ci = Z4;
                    if (br == 1) { const bool sbit = ((mk[mt] >> j) & 1ull) != 0ull; if (__ballot(sbit) == 0ull) continue;
                        const float bias = sbit ? 0.f : -1e30f; ci = (f32x4){bias, bias, bias, bias}; }
                    f32x4 cA = ci, cB = ci;
                    if (slow) {
#pragma unroll
                        for (int r = 0; r < 4; ++r) { const int kA = k0 + 8 * q4 + r, kB = kA + 4;
                            const bool mA = (kA <= tq[mt]) && (br == 1 || kA + 512 > tq[mt]), mB = (kB <= tq[mt]) && (br == 1 || kB + 512 > tq[mt]);
                            cA[r] = mA ? cA[r] : -1e30f; cB[r] = mB ? cB[r] : -1e30f; } }
                    f32x4 sA = mfma16(kf.a0, qf[mt][0], cA); sA = mfma16(kf.a1, qf[mt][1], sA); f32x4 sB = mfma16(kf.b0, qf[mt][0], cB); sB = mfma16(kf.b1, qf[mt][1], sB);
                    f32x4 pA, pB;
#pragma unroll
                    for (int r = 0; r < 4; ++r) { pA[r] = __builtin_amdgcn_exp2f(sA[r]); pB[r] = __builtin_amdgcn_exp2f(sB[r]); }
                    const bf16x8 pf = pack_p(pA, pB);
#pragma unroll
                    for (int dt = 0; dt < 4; ++dt) O[mt][dt] = mfma16(pf, vf.v[dt], O[mt][dt]);
                    L5[mt] = mfma16(pf, ones8, L5[mt]); } }
        NSA_PIPE_END(SB, nsteps, K0_LIST)
#pragma unroll
        for (int mt = 0; mt < 2; ++mt)
#pragma unroll
            for (int r = 0; r < 4; ++r) { const float ilr = __builtin_amdgcn_rcpf(fmaxf(L5[mt][r], 1e-30f)) * NSA_GATE(mt, r, br);
#pragma unroll
                for (int dt = 0; dt < 4; ++dt) Oc[mt][dt][r] += ilr * O[mt][dt][r]; }
    }
    if (!skip) { bf16* YB = (bf16*)(F.ws + WS_H + 16 * MiB) + (size_t)(b * T) * 512;
#pragma unroll
        for (int mt = 0; mt < 2; ++mt)
#pragma unroll
            for (int r = 0; r < 4; ++r)
#pragma unroll
                for (int dt = 0; dt < 4; ++dt) YB[(size_t)(t0 + 4 * mt + q4) * 512 + (g * 4 + r) * 64 + 16 * dt + r16] = f2b(Oc[mt][dt][r]); }
    __syncthreads();
}
__device__ __forceinline__ void nsa_phase(const Frame& F, int rep) {
    LAS unsigned* bw = (LAS unsigned*)(F.lds + 57344);
    const int q0 = (int)(xb_xcc_id() & 7u);
    for (int qi = 0; qi < 8; ++qi) { const int q = (q0 + qi) & 7;
        for (;;) {
            if (F.tid == 0) bw[0] = __hip_atomic_fetch_add(F.ctl + CW_NSAQ + 64 * (8 * rep + q), 1u, RLX_AGENT);
            __syncthreads();
            const unsigned c = bw[0];
            __syncthreads();
            if (c >= 64u) break;
            nsa_block_unit(F, q >> 1, q & 1, 64 * (63 - (int)c), rep ? NSA_SKIP : 0);
        }
    }
}
__device__ __forceinline__ f32x4 unpk4(const u32x2 w) { f32x4 r; r[0] = bflo(w.x); r[1] = bfhi(w.x); r[2] = bflo(w.y); r[3] = bfhi(w.y); return r; }
struct ChunkIn { v4u kt0, kt1, rt0, rt1; u32x2 uv, mb, mk, vt, bh[4], kh[4]; f32x4 gam[4]; };
__device__ __forceinline__ void scan_load(ChunkIn& c, const unsigned char* rec, int vq, int r16, int q4) {
    c.kt0 = *(const v4u*)(rec + (r16 * 64 + q4 * 8) * 2); c.kt1 = *(const v4u*)(rec + (r16 * 64 + 32 + q4 * 8) * 2);
    c.rt0 = *(const v4u*)(rec + RO_RT + (r16 * 64 + q4 * 8) * 2); c.rt1 = *(const v4u*)(rec + RO_RT + (r16 * 64 + 32 + q4 * 8) * 2);
#pragma unroll
    for (int mt = 0; mt < 4; ++mt) { c.bh[mt] = *(const u32x2*)(rec + RO_BH + ((16 * mt + r16) * 16 + 4 * q4) * 2); c.kh[mt] = *(const u32x2*)(rec + RO_KH + ((16 * mt + r16) * 16 + 4 * q4) * 2);
        c.gam[mt] = *(const f32x4*)(rec + RO_GAM + (16 * mt + 4 * q4) * 4); }
    c.vt = *(const u32x2*)(rec + RO_VT + ((16 * vq + r16) * 16 + 4 * q4) * 2); c.uv = *(const u32x2*)(rec + RO_UV + ((16 * vq + r16) * 16 + 4 * q4) * 2);
    c.mb = *(const u32x2*)(rec + RO_MB + (r16 * 16 + 4 * q4) * 2); c.mk = *(const u32x2*)(rec + RO_MK + (r16 * 16 + 4 * q4) * 2);
}
__device__ __forceinline__ void scan_chunk(const ChunkIn& cur, f32x4 (&Zt)[4], bf16* Y, int ch, int q4) {
    const f32x4 Z4 = {0.f, 0.f, 0.f, 0.f};
    const bf16x8 zb0 = pack_p(Zt[0], Zt[1]), zb1 = pack_p(Zt[2], Zt[3]);
    f32x4 U = mfma16(as_bf16x8(cur.kt0), zb0, unpk4(cur.uv)); U = mfma16(as_bf16x8(cur.kt1), zb1, U);
    f32x4 Yc = mfma16(as_bf16x8(cur.rt0), zb0, Z4); Yc = mfma16(as_bf16x8(cur.rt1), zb1, Yc);
    const bf16x4 vt = as_bf16x4(cur.vt);
    const bf16x4 ub = pack4(U);
    Yc = mfma16k16(as_bf16x4(cur.mk), vt, Yc); Yc = mfma16k16(as_bf16x4(cur.mb), ub, Yc);
#pragma unroll
    for (int mt = 0; mt < 4; ++mt) { f32x4 acc = mfma16k16(as_bf16x4(cur.kh[mt]), vt, Zt[mt]); acc = mfma16k16(as_bf16x4(cur.bh[mt]), ub, acc); Zt[mt] = acc * cur.gam[mt]; }
#pragma unroll
    for (int r = 0; r < 4; ++r) Y[(size_t)(16 * ch + 4 * q4 + r) * 512] = f2b(Yc[r]);
}
constexpr int SR_SLOTS = 8, SR_SLOT_BYTES = 13824, SR_PIECES = REC_BYTES / 16 / 4;
__device__ __forceinline__ void scan_lds_load(ChunkIn& c, const LAS unsigned char* rec, int vq, int r16, int q4) {
    c.kt0 = *(const LAS v4u*)(rec + (r16 * 64 + q4 * 8) * 2); c.kt1 = *(const LAS v4u*)(rec + (r16 * 64 + 32 + q4 * 8) * 2);
    c.rt0 = *(const LAS v4u*)(rec + RO_RT + (r16 * 64 + q4 * 8) * 2); c.rt1 = *(const LAS v4u*)(rec + RO_RT + (r16 * 64 + 32 + q4 * 8) * 2);
#pragma unroll
    for (int mt = 0; mt < 4; ++mt) { c.bh[mt] = *(const LAS u32x2*)(rec + RO_BH + ((16 * mt + r16) * 16 + 4 * q4) * 2); c.kh[mt] = *(const LAS u32x2*)(rec + RO_KH + ((16 * mt + r16) * 16 + 4 * q4) * 2);
        c.gam[mt] = *(const LAS f32x4*)(rec + RO_GAM + (16 * mt + 4 * q4) * 4); }
    c.vt = *(const LAS u32x2*)(rec + RO_VT + ((16 * vq + r16) * 16 + 4 * q4) * 2); c.uv = *(const LAS u32x2*)(rec + RO_UV + ((16 * vq + r16) * 16 + 4 * q4) * 2);
    c.mb = *(const LAS u32x2*)(rec + RO_MB + (r16 * 16 + 4 * q4) * 2); c.mk = *(const LAS u32x2*)(rec + RO_MK + (r16 * 16 + 4 * q4) * 2);
}
__device__ __forceinline__ void sr_wait_ge(volatile LAS unsigned* w, unsigned want) {
    for (unsigned spin = 0; spin < (1u << 22); ++spin) { if (*w >= want) break; __builtin_amdgcn_s_sleep(1); }
}
__device__ __forceinline__ void rwkv_scan_wave(const Frame& F, int bh, int vq) {
    const int lane = F.lane, r16 = lane & 15, q4 = lane >> 4, b = bh >> 3, h = bh & 7;
    const f32x4 Z4 = {0.f, 0.f, 0.f, 0.f};
    bf16* Y = (bf16*)(F.ws + WS_H) + (size_t)(b * T) * 512 + h * 64 + 16 * vq + r16;
    volatile LAS unsigned* filled = F.MISC + 32; volatile LAS unsigned* freed = F.MISC + 48;
    f32x4 Zt[4] = {Z4, Z4, Z4, Z4};
    ChunkIn A, B;
#define SR_TAKE(dst, ch_) do { const int sl_ = (ch_) & (SR_SLOTS - 1); sr_wait_ge(filled + sl_, 4u * (unsigned)(((ch_) >> 3) + 1)); asm volatile("" ::: "memory"); \
        scan_lds_load(dst, F.lds + sl_ * SR_SLOT_BYTES, vq, r16, q4); asm volatile("s_waitcnt lgkmcnt(0)" ::: "memory"); \
        if (lane == 0) __hip_atomic_fetch_add((LAS unsigned*)(freed + sl_), 1u, __ATOMIC_RELAXED, __HIP_MEMORY_SCOPE_WORKGROUP); } while (0)
    SR_TAKE(A, 0);
    for (int ch = 0; ch < T / 16; ch += 2) {
        SR_TAKE(B, ch + 1);
        scan_chunk(A, Zt, Y, ch, q4);
        if (ch + 2 < T / 16) SR_TAKE(A, ch + 2);
        scan_chunk(B, Zt, Y, ch + 1, q4);
    }
#undef SR_TAKE
}
__device__ __forceinline__ void rwkv_scan_loader(const Frame& F, int bh, int lw) {
    const int lane = F.lane, b = bh >> 3, h = bh & 7;
    const unsigned char* recb = F.ws + WS_PRW + (size_t)(b * T) * 7168 + h * REC_BYTES + (size_t)(SR_PIECES * lw) * 16;
    volatile LAS unsigned* filled = F.MISC + 32; volatile LAS unsigned* freed = F.MISC + 48;
    constexpr size_t CS = 16 * 7168;
    v4u pc[4][4];
#define SL_ISSUE(k_, ch_) do { const unsigned char* r_ = recb + (size_t)(ch_) * CS; _Pragma("unroll") for (int i_ = 0; i_ < 4; ++i_) { const int p_ = lane + 64 * i_; pc[k_][i_] = *(const v4u*)(r_ + 16 * (p_ < SR_PIECES ? p_ : 0)); } } while (0)
#define SL_COMMIT(k_, ch_) do { const int sl_ = (ch_) & (SR_SLOTS - 1); sr_wait_ge(freed + sl_, 4u * (unsigned)((ch_) >> 3)); asm volatile("" ::: "memory"); \
        LAS unsigned char* d_ = F.lds + sl_ * SR_SLOT_BYTES + (SR_PIECES * lw) * 16; _Pragma("unroll") for (int i_ = 0; i_ < 4; ++i_) { const int p_ = lane + 64 * i_; if (p_ < SR_PIECES) *(LAS v4u*)(d_ + 16 * p_) = pc[k_][i_]; } \
        asm volatile("s_waitcnt lgkmcnt(0)" ::: "memory"); if (lane == 0) __hip_atomic_fetch_add((LAS unsigned*)(filled + sl_), 1u, __ATOMIC_RELAXED, __HIP_MEMORY_SCOPE_WORKGROUP); } while (0)
    SL_ISSUE(0, 0); SL_ISSUE(1, 1); SL_ISSUE(2, 2); SL_ISSUE(3, 3);
    for (int c4 = 0; c4 < T / 16; c4 += 4) {
#pragma unroll
        for (int k = 0; k < 4; ++k) { const int ch = c4 + k;
            SL_COMMIT(k, ch);
            if (ch + 4 < T / 16) SL_ISSUE(k, ch + 4); }
    }
#undef SL_ISSUE
#undef SL_COMMIT
}
__device__ __forceinline__ void rwkv_epilogue(const Frame& F) {
    const int lane = F.lane; const int gw = F.vcu * NWAVES + F.wave, NGW = F.G * NWAVES;
    const unsigned char* prw = F.ws + WS_PRW; const bf16* G = (const bf16*)((unsigned char*)F.out + DO_G); bf16* YA = (bf16*)(F.ws + WS_H);
    for (int idx = gw; idx < (M / 16) * 8; idx += NGW) { const int bt = idx >> 3, h = idx & 7, c = h * 64 + lane;
        const unsigned char* rec = prw + (size_t)(16 * bt) * 7168 + h * REC_BYTES;
        const v4u* vp = (const v4u*)(rec + RO_VT + lane * 32); const v4u v0 = vp[0], v1 = vp[1];
        const float lw = F.in[12][c], lb = F.in[13][c];
        float yv[16], gv[16], bo[16];
#pragma unroll
        for (int s = 0; s < 16; ++s) { const size_t o = (size_t)(16 * bt + s) * 512 + c; yv[s] = bf2f(YA[o]); gv[s] = bf2f(G[o]); bo[s] = *(const float*)(rec + RO_BON + 4 * s); }
#pragma unroll
        for (int s = 0; s < 16; ++s) { const unsigned vw = (s < 8) ? v0[s >> 1] : v1[(s - 8) >> 1]; const float vv = (s & 1) ? bfhi(vw) : bflo(vw);
            const float y = yv[s]; const float mean = wave_sum(y) * (1.f / 64.f); const float d = y - mean; const float var = wave_sum(d * d) * (1.f / 64.f);
            const float yn = d * rsqrtf(var + GN_EPS) * lw + lb;
            YA[(size_t)(16 * bt + s) * 512 + c] = f2b((yn + bo[s] * vv) * gv[s]); }
    }
}
__device__ __forceinline__ unsigned sortable(float x) { const unsigned u = __float_as_uint(x); return (u & 0x80000000u) ? ~u : (u | 0x80000000u); }
__device__ __forceinline__ float unsortable(unsigned k) { const unsigned u = (k & 0x80000000u) ? (k & 0x7fffffffu) : ~k; return __uint_as_float(u); }
#define TK_INSERT(L, key_) do { unsigned k_ = (key_); _Pragma("unroll") for (int s_ = 0; s_ < 16; ++s_) { const unsigned hi_ = L[s_] > k_ ? L[s_] : k_; k_ = L[s_] > k_ ? k_ : L[s_]; L[s_] = hi_; } } while (0)
__device__ __forceinline__ void peer_topk_pass(const Frame& F, int wp, LAS float* sc) {
    const int lane = F.lane, r16 = lane & 15, q4 = lane >> 4;
    const bf16* QRY = (const bf16*)(F.ws + WS_PRW);
    int* EID = (int*)(F.ws + WS_PRW + 64 * MiB); float* EG = (float*)(F.ws + WS_PRW + 72 * MiB);
    const int row = lane & 31, part = lane >> 5;
    unsigned L1[16], L2[16];
#pragma unroll
    for (int half = 0; half < 2; ++half) {
        const bf16* SK = (const bf16*)(F.ws + (half ? WS_SK2 : WS_SK1));
        bf16x8 af[2][4];
#pragma unroll
        for (int mt = 0; mt < 2; ++mt) { const int rho = 32 * wp + 16 * mt + r16; const bf16* qp = QRY + (size_t)(rho >> 3) * 2048 + (rho & 7) * 256 + half * 128 + 8 * q4;
#pragma unroll
            for (int s = 0; s < 4; ++s) af[mt][s] = as_bf16x8(*(const v4u*)(qp + 32 * s)); }
#pragma unroll
        for (int kg = 0; kg < 2; ++kg) { bf16x8 kb[4][4];
#pragma unroll
            for (int k4 = 0; k4 < 4; ++k4)
#pragma unroll
                for (int s = 0; s < 4; ++s) kb[k4][s] = as_bf16x8(*(const v4u*)(SK + (size_t)(16 * (4 * kg + k4) + r16) * 128 + 32 * s + 8 * q4));
#pragma unroll
          for (int mt = 0; mt < 2; ++mt) {
#pragma unroll
            for (int k4 = 0; k4 < 4; ++k4) { const int kt = 4 * kg + k4; f32x4 acc = {0.f, 0.f, 0.f, 0.f};
#pragma unroll
                for (int s = 0; s < 4; ++s) acc = mfma16(af[mt][s], kb[k4][s], acc);
#pragma unroll
                for (int r = 0; r < 4; ++r) { const int rw = 16 * mt + 4 * q4 + r; sc[rw * 128 + ((16 * kt + r16) ^ rw)] = acc[r]; } } } }
        NSA_FENCE();
        unsigned Ls[16];
#pragma unroll
        for (int s = 0; s < 16; ++s) Ls[s] = 0u;
#pragma unroll 4
        for (int i = 0; i < 64; ++i) { const int c = 64 * part + i; const float x = sc[row * 128 + (c ^ row)];
            TK_INSERT(Ls, (sortable(x) & ~0x7Fu) | (unsigned)(127 - c)); }
        unsigned Lo[16];
#pragma unroll
        for (int s = 0; s < 16; ++s) Lo[s] = (unsigned)__shfl_xor((int)Ls[s], 32);
#pragma unroll
        for (int s = 0; s < 16; ++s) TK_INSERT(Ls, Lo[s]);
#pragma unroll
        for (int s = 0; s < 16; ++s) { if (half == 0) L1[s] = Ls[s]; else L2[s] = Ls[s]; }
        NSA_FENCE();
    }
    float v1[16], v2[16];
#pragma unroll
    for (int s = 0; s < 16; ++s) { v1[s] = unsortable(L1[s]); v2[s] = unsortable(L2[s]); }
    unsigned C[16];
#pragma unroll
    for (int s = 0; s < 16; ++s) C[s] = 0u;
#pragma unroll
    for (int i = 0; i < 16; ++i)
#pragma unroll
        for (int j = 0; j < 16; ++j) if ((i + 1) * (j + 1) <= 16) { TK_INSERT(C, (sortable(v1[i] + v2[j]) & ~0xFFu) | (unsigned)(255 - (16 * i + j))); }
    LAS unsigned* il = (LAS unsigned*)sc;
    if (part == 0) {
#pragma unroll
        for (int s = 0; s < 16; ++s) { il[row * 33 + s] = 127u - (L1[s] & 127u); il[row * 33 + 16 + s] = 127u - (L2[s] & 127u); }
    }
    NSA_FENCE();
    if (part == 0) { const int rho = 32 * wp + row;
        float val[16], e[16]; float sum = 0.f;
#pragma unroll
        for (int s = 0; s < 16; ++s) val[s] = unsortable(C[s]);
#pragma unroll
        for (int s = 0; s < 16; ++s) { e[s] = __expf(val[s] - val[0]); sum += e[s]; }
        const float is = 1.0f / sum;
#pragma unroll
        for (int s = 0; s < 16; ++s) { const unsigned pos = 255u - (C[s] & 255u); const unsigned i = pos >> 4, j = pos & 15u;
            EID[(size_t)rho * 16 + s] = (int)(il[row * 33 + i] * 128u + il[row * 33 + 16 + j]); EG[(size_t)rho * 16 + s] = e[s] * is; }
    }
    NSA_FENCE();
}
typedef float f32x2_t __attribute__((ext_vector_type(2)));
constexpr float PEER_SCALE = 256.0f, PEER_ISCALE = 1.0f / 256.0f;
__device__ __forceinline__ void peer_convert_one(const Frame& F, const float* srcf, unsigned char* dstb) {
    const int gt = F.vcu * (NWAVES * 64) + F.tid, NT = F.G * NWAVES * 64;
    const f32x4* src = (const f32x4*)srcf; v4u* dst = (v4u*)dstb;
    for (int i = gt; i < 16384 * 1024 / 16; i += NT) { v4u o;
#pragma unroll
        for (int q = 0; q < 4; ++q) { const f32x4 a = src[4 * i + q] * PEER_SCALE; int w = __builtin_amdgcn_cvt_pk_fp8_f32(a[0], a[1], 0, false); w = __builtin_amdgcn_cvt_pk_fp8_f32(a[2], a[3], w, true); o[q] = (unsigned)w; }
        dst[i] = o; }
}
constexpr float PEER_SU = 768.0f, PEER_SH = 24.0f;
__device__ __forceinline__ unsigned q8pack(const f32x4 a, float sc) {
    const int q0 = (int)rintf(fminf(fmaxf(a[0] * sc, -127.f), 127.f)), q1 = (int)rintf(fminf(fmaxf(a[1] * sc, -127.f), 127.f)), q2 = (int)rintf(fminf(fmaxf(a[2] * sc, -127.f), 127.f)), q3 = (int)rintf(fminf(fmaxf(a[3] * sc, -127.f), 127.f));
    return (unsigned)(q0 & 255) | ((unsigned)(q1 & 255) << 8) | ((unsigned)(q2 & 255) << 16) | ((unsigned)(q3 & 255) << 24);
}
__device__ __forceinline__ void peer_convert_u8(const Frame& F, const float* srcf, unsigned char* dstb) {
    const int gt = F.vcu * (NWAVES * 64) + F.tid, NT = F.G * NWAVES * 64;
    const f32x4* src = (const f32x4*)srcf; v4u* dst = (v4u*)dstb;
    for (int i = gt; i < 16384 * 1024 / 16; i += NT) { v4u o;
#pragma unroll
        for (int q = 0; q < 4; ++q) o[q] = q8pack(src[4 * i + q], PEER_SU);
        dst[i] = o; }
}
__device__ __forceinline__ void peer_convert_tables(const Frame& F) { peer_convert_u8(F, F.in[31], F.ws + WS_MG); peer_convert_one(F, F.in[32], F.ws + WS_MG + 16 * MiB); }
__device__ __forceinline__ float sum8(float x) { x += dppf<0xB1>(x); x += dppf<0x4E>(x); x += dppf<0x141>(x); return x; }
template <int PHASE> __device__ __forceinline__ void peer_slice_unit(const Frame& F, int s, int tg) {
    const int lane = F.lane, j = lane & 7, gbase = lane & ~7;
    const bf16* H2 = (const bf16*)(F.ws + WS_H);
    const int* EID = (const int*)(F.ws + WS_PRW + 64 * MiB);
    float* PART = (float*)(F.ws + WS_PRW) + (size_t)s * M * 128; const float* CACT = (const float*)(F.ws + WS_PRW + 80 * MiB);
    const unsigned char* TB = F.ws + WS_MG + (PHASE == 0 ? 0 : 16 * MiB) + 128 * s + 16 * j;
#pragma unroll 1
    for (int it = 0; it < 8; ++it) { const int tk = 64 * tg + 8 * it + (lane >> 3);
        int ids[16]; float hv[16], acc[16];
        { const v4u* ip = (const v4u*)(EID + (size_t)tk * 128 + 16 * j);
#pragma unroll
          for (int q = 0; q < 4; ++q) { const v4u w = ip[q]; ids[4 * q] = (int)w.x; ids[4 * q + 1] = (int)w.y; ids[4 * q + 2] = (int)w.z; ids[4 * q + 3] = (int)w.w; } }
        int hq[4] = {0, 0, 0, 0};
        if (PHASE == 0) { const v4u h0 = *(const v4u*)(H2 + (size_t)tk * D + 128 * s + 16 * j), h1 = *(const v4u*)(H2 + (size_t)tk * D + 128 * s + 16 * j + 8);
            hq[0] = (int)q8pack((f32x4){bflo(h0.x), bfhi(h0.x), bflo(h0.y), bfhi(h0.y)}, PEER_SH); hq[1] = (int)q8pack((f32x4){bflo(h0.z), bfhi(h0.z), bflo(h0.w), bfhi(h0.w)}, PEER_SH);
            hq[2] = (int)q8pack((f32x4){bflo(h1.x), bfhi(h1.x), bflo(h1.y), bfhi(h1.y)}, PEER_SH); hq[3] = (int)q8pack((f32x4){bflo(h1.z), bfhi(h1.z), bflo(h1.w), bfhi(h1.w)}, PEER_SH); }
        else { const f32x4* cp = (const f32x4*)(CACT + (size_t)tk * 128 + 16 * j);
#pragma unroll
            for (int q = 0; q < 4; ++q) { const f32x4 c = cp[q]; hv[4 * q] = c[0]; hv[4 * q + 1] = c[1]; hv[4 * q + 2] = c[2]; hv[4 * q + 3] = c[3]; } }
#pragma unroll
        for (int m = 0; m < 16; ++m) acc[m] = 0.f;
        v4u tn[16];
        if (PHASE == 0) {
#pragma unroll
            for (int m = 0; m < 16; ++m) { const int id = __builtin_amdgcn_ds_bpermute(gbase * 4, ids[m]); tn[m] = *(const v4u*)(TB + (size_t)id * 1024); } }
#pragma unroll 1
        for (int jj = 0; jj < 8; ++jj) { const int src = (gbase + jj) * 4;
            v4u tv[16];
            if (PHASE == 0) { const int srcn = (gbase + ((jj + 1 < 8) ? jj + 1 : jj)) * 4;
#pragma unroll
                for (int m = 0; m < 16; ++m) tv[m] = tn[m];
#pragma unroll
                for (int m = 0; m < 16; ++m) { const int id = __builtin_amdgcn_ds_bpermute(srcn, ids[m]); tn[m] = *(const v4u*)(TB + (size_t)id * 1024); } }
            else {
#pragma unroll
                for (int m = 0; m < 16; ++m) { const int id = __builtin_amdgcn_ds_bpermute(src, ids[m]); tv[m] = *(const v4u*)(TB + (size_t)id * 1024); } }
#pragma unroll
            for (int m = 0; m < 16; ++m) {
                if (PHASE == 0) { int di = __builtin_amdgcn_sdot4((int)tv[m].x, hq[0], 0, false); di = __builtin_amdgcn_sdot4((int)tv[m].y, hq[1], di, false); di = __builtin_amdgcn_sdot4((int)tv[m].z, hq[2], di, false); di = __builtin_amdgcn_sdot4((int)tv[m].w, hq[3], di, false);
                    const float d = sum8((float)di); acc[m] = (j == jj) ? d : acc[m]; }
                else {
                    float f[16];
#pragma unroll
                    for (int q = 0; q < 4; ++q) { const f32x2_t lo = __builtin_amdgcn_cvt_pk_f32_fp8((int)tv[m][q], false), hi = __builtin_amdgcn_cvt_pk_f32_fp8((int)tv[m][q], true); f[4 * q] = lo.x; f[4 * q + 1] = lo.y; f[4 * q + 2] = hi.x; f[4 * q + 3] = hi.y; } const float c = __builtin_bit_cast(float, __builtin_amdgcn_ds_bpermute(src, __builtin_bit_cast(int, hv[m])));
#pragma unroll
                    for (int q = 0; q < 16; ++q) acc[q] += c * f[q]; } }
        }
        if (PHASE == 0) { f32x4* pp = (f32x4*)(PART + (size_t)tk * 128 + 16 * j);
#pragma unroll
            for (int q = 0; q < 4; ++q) pp[q] = (f32x4){acc[4 * q], acc[4 * q + 1], acc[4 * q + 2], acc[4 * q + 3]}; }
        else { f32x4* op = (f32x4*)(F.out + (size_t)tk * D + 128 * s + 16 * j);
#pragma unroll
            for (int q = 0; q < 4; ++q) { f32x4 a = op[q]; a[0] += acc[4 * q] * PEER_ISCALE; a[1] += acc[4 * q + 1] * PEER_ISCALE; a[2] += acc[4 * q + 2] * PEER_ISCALE; a[3] += acc[4 * q + 3] * PEER_ISCALE; op[q] = a; } }
    }
}
template <int PHASE> __device__ __forceinline__ void peer_slice_phase(const Frame& F, int rep) {
    const int q0 = (int)(xb_xcc_id() & 7u);
    for (int qi = 0; qi < 8; ++qi) { const int q = (q0 + qi) & 7;
        for (;;) { unsigned c = 0;
            if (F.lane == 0) c = __hip_atomic_fetch_add(F.ctl + CW_PEERQ + 64 * (16 * rep + 8 * PHASE + q), 1u, RLX_AGENT);
            c = (unsigned)__builtin_amdgcn_readfirstlane((int)c);
            if (c >= 256u) break;
            peer_slice_unit<PHASE>(F, q, (int)c); } }
}
__device__ __forceinline__ void peer_act_phase(const Frame& F) {
    const int gt = F.vcu * (NWAVES * 64) + F.tid, NT = F.G * NWAVES * 64;
    const float* PART = (const float*)(F.ws + WS_PRW); const float* EG = (const float*)(F.ws + WS_PRW + 72 * MiB); float* CACT = (float*)(F.ws + WS_PRW + 80 * MiB);
    for (int i = gt; i < M * 128 / 4; i += NT) { f32x4 d = {0.f, 0.f, 0.f, 0.f};
#pragma unroll
        for (int s = 0; s < 8; ++s) d += ((const f32x4*)PART)[(size_t)s * (M * 128 / 4) + i];
        const f32x4 g = ((const f32x4*)EG)[i]; f32x4 c;
#pragma unroll
        for (int e = 0; e < 4; ++e) { const float dt = d[e] * (1.0f / (PEER_SU * PEER_SH)); c[e] = g[e] * 0.5f * dt * (1.f + erff(dt * 0.70710678118654752f)); }
        ((f32x4*)CACT)[i] = c; }
}
__device__ __forceinline__ unsigned long long dbg_stamp() { unsigned long long t; asm volatile("s_memrealtime %0\n\ts_waitcnt lgkmcnt(0)" : "=s"(t) :: "memory"); return t; }
struct Args { const float* in[33]; float* out; unsigned char* ws; int ph_lo, ph_hi; };
__global__ void __launch_bounds__(NWAVES * 64, 2) mk_fwd(Args args) {
    extern __shared__ __attribute__((aligned(16))) unsigned char lds[];
    Frame F;
    F.lds = (LAS unsigned char*)lds;
    F.MISC = (volatile LAS unsigned*)(F.lds + MISC_OFF);
    F.tid = threadIdx.x; F.lane = F.tid & 63; F.wave = __builtin_amdgcn_readfirstlane(F.tid >> 6);
    F.G = gridDim.x; { const int bx = blockIdx.x; F.vcu = (F.G % 8 == 0) ? (bx % 8) * (F.G / 8) + bx / 8 : bx; }
    unsigned char* ws = args.ws; F.ws = ws; F.out = args.out;
    F.ctl = (gu32*)(ws + WS_CTL);
#pragma unroll
    for (int i = 0; i < 33; ++i) F.in[i] = args.in[i];
    for (int u = F.tid; u < (LDS_BYTES - LDSCTL_OFF) / 4; u += NWAVES * 64) ((LAS unsigned*)(F.lds + LDSCTL_OFF))[u] = 0u;
    __syncthreads();
    const int lo = args.ph_lo, hi = args.ph_hi & 0xff; const int rep = args.ph_hi >> 8;
    const bool multi = (hi - lo) > 1;
    XcdBarrier bar; bar.bar = (unsigned*)(F.ctl + CW_BAR); bar.x = 0; bar.st = nullptr;
    if (multi) bar = xcd_barrier_post((unsigned*)(F.ctl + CW_BAR), F.MISC + 8);
#define IN(k) (lo <= (k) && (k) < hi)
#define NREP(k) ((((repmask) >> (k)) & 1) + 1)
#define REPBAR() do { if (rep) xcd_barrier(bar); } while (0)
#define SEAM(k) do { if (DBG_SEL == (k) && blockIdx.x == DBG_BLK && F.tid == 0) dbg_t1 = dbg_stamp(); if (DBG_SEL == 50 + (k) && blockIdx.x == DBG_BLK && F.tid == 0) dbg_t0 = dbg_stamp(); if (IN(k) && IN((k) + 1)) xcd_barrier(bar); if (DBG_SEL == 50 + (k) && blockIdx.x == DBG_BLK && F.tid == 0) dbg_t1 = dbg_stamp(); if ((DBG_SEL == (k) + 1 || (DBG_SEL == 20 && (k) == 1)) && blockIdx.x == DBG_BLK && F.tid == 0) dbg_t0 = dbg_stamp(); } while (0)
    unsigned long long dbg_t0 = 0ull, dbg_t1 = 0ull;

    if (IN(0)) { { p0_prologue(F); } } SEAM(0);
    if (IN(1)) { {
        pg8::Gemm g{(const pg8::bf16_t*)(ws + WS_H), (const pg8::bf16_t*)(ws + WS_WIN), M, NG1, D}; pg8::StaticOrder S; S.init(M, NG1, F.G, (int)blockIdx.x);
        pg8::EpiG1 E{(float*)(ws + WS_PRW), (float*)(ws + WS_BND), (pg8::bf16_t*)((unsigned char*)F.out + DO_PNSA), (pg8::bf16_t*)(ws + WS_MG), (float*)((unsigned char*)F.out + DO_GLOG)};
        pg8::gemm_phase<pg8::EpiG1, pg8::StaticOrder, true, true>(F.lds + RING_OFF, g, S, E);
    } } SEAM(1);
    if (IN(2)) {
        for (int u = F.vcu; u < 256; u += F.G) nsa_prep_tile(F, u);
        if (DBG_SEL == 20 && blockIdx.x == 0 && F.tid == 0) dbg_t1 = dbg_stamp();
        if (DBG_SEL == 21 && blockIdx.x == 0 && F.tid == 0) dbg_t0 = dbg_stamp();
        for (int u = F.vcu; u < 256; u += F.G) compress_unit(F, u);
        if (DBG_SEL == 21 && blockIdx.x == 0 && F.tid == 0) dbg_t1 = dbg_stamp();
        for (int u = F.vcu; u < 256; u += F.G) rwkv_prep_tile(F, u);
    } SEAM(2);
    if (IN(3)) { {
        if ((int)blockIdx.x < 32 && !(rep && P3REP == 3)) { if (DBG_SEL == 40 && blockIdx.x == 0 && F.tid == 0) dbg_t0 = dbg_stamp(); if (F.tid < 32) F.MISC[32 + F.tid] = 0u; __syncthreads(); if (F.wave < 4) rwkv_scan_wave(F, (int)blockIdx.x, F.wave); else rwkv_scan_loader(F, (int)blockIdx.x, F.wave - 4); __syncthreads(); if (DBG_SEL == 40 && blockIdx.x == 0 && F.tid == 0) dbg_t1 = dbg_stamp(); }
        if (!(rep && P3REP == 2)) nsa_phase(F, rep);
    } } SEAM(3);
    if (IN(4)) { { rwkv_epilogue(F); } } SEAM(4);
    if (IN(5)) { {
        { pg8::Gemm g{(const pg8::bf16_t*)(ws + WS_H), (const pg8::bf16_t*)(ws + WS_WA), M, D, 512, (const pg8::bf16_t*)(ws + WS_H + 16 * MiB), (const pg8::bf16_t*)(ws + WS_WB)}; pg8::StaticOrder2 S; S.init(M, D, F.G, (int)blockIdx.x);
          pg8::EpiMerge E{(const pg8::bf16_t*)(ws + WS_MG), (pg8::bf16_t*)(ws + WS_PRW + 64 * MiB)};
          pg8::gemm_phase<pg8::EpiMerge, pg8::StaticOrder2, true, true>(F.lds + RING_OFF, g, S, E); }
    } } SEAM(5);
    if (IN(6)) { {
        pg8::Gemm g{(const pg8::bf16_t*)(ws + WS_PRW + 64 * MiB), (const pg8::bf16_t*)(ws + WS_WOUT), M, D, D}; pg8::StaticOrder S; S.init(M, D, F.G, (int)blockIdx.x);
        pg8::EpiRes E{F.in[0], F.out};
        pg8::gemm_phase<pg8::EpiRes, pg8::StaticOrder, true, true>(F.lds + RING_OFF, g, S, E);
    } } SEAM(6);
    if (IN(7)) { { const int gw = F.vcu * NWAVES + F.wave, NGW = F.G * NWAVES;
        for (int m = gw; m < M; m += NGW) rms_row_to_bf16(F.lane, F.out + (size_t)m * D, F.in[27], (bf16*)(ws + WS_H) + (size_t)m * D);
        peer_convert_tables(F);
    } } SEAM(7);
    if (IN(8)) { {
        pg8::Gemm g{(const pg8::bf16_t*)(ws + WS_H), (const pg8::bf16_t*)(ws + WS_WQ), M, 2048, D}; pg8::StaticOrder S; S.init(M, 2048, F.G, (int)blockIdx.x);
        pg8::EpiBf16<0> E{(pg8::bf16_t*)(ws + WS_PRW), 2048, nullptr, 0, 0, 1.f};
        pg8::gemm_phase<pg8::EpiBf16<0>, pg8::StaticOrder, true, true>(F.lds + RING_OFF, g, S, E);
    } } SEAM(8);
    if (IN(9)) { { const int gw = F.vcu * NWAVES + F.wave, NGW = F.G * NWAVES; LAS float* sc = (LAS float*)(F.lds + F.wave * 16384);
        for (int wp = gw; wp < M * 8 / 32; wp += NGW) peer_topk_pass(F, wp, sc);
    } } SEAM(9);
    if (IN(10)) { peer_slice_phase<0>(F, rep); } SEAM(10);
    if (IN(11)) { peer_act_phase(F); } SEAM(11);
    if (IN(12)) { peer_slice_phase<1>(F, rep); }
    if (DBG_SEL >= 0 && multi) { if (DBG_SEL == 12 && blockIdx.x == 0 && F.tid == 0) dbg_t1 = dbg_stamp(); xcd_barrier(bar); if (blockIdx.x == DBG_BLK && F.tid == 0) { ((unsigned long long*)(ws + WS_KC + 524288))[2] = dbg_t1 - dbg_t0; } xcd_barrier(bar); if (blockIdx.x == 0 && F.tid == 0) { dbg_t0 = 0; dbg_t1 = ((unsigned long long*)(ws + WS_KC + 524288))[2]; } if (blockIdx.x == 0 && F.tid == 0) F.out[0] += (DBG_SEL == 99) ? 0.1f : ((DBG_SEL >= 30 && DBG_SEL < 40) ? (0.05f + (float)(F.MISC[21] - F.MISC[20]) * 0.01f * 1e-3f) : (0.05f + (float)(dbg_t1 - dbg_t0) * 0.01f * DBG_SCALE)); }
#undef IN
#undef SEAM
}

extern "C" void kernel_launch(void* const* d_in, const int* in_sizes, int n_in, void* d_out, int out_size, void* d_ws, size_t ws_size, hipStream_t stream) {
    static int grid = 0;
    if (grid == 0) {
        if (n_in != 33 || out_size != M * D || ws_size < WS_END) { fprintf(stderr, "kernel_launch: unexpected shapes (n_in %d out %d ws %zu)\n", n_in, out_size, ws_size); grid = -1; return; }
        int dev = 0, cus = 0, per_cu = 0;
        if (hipGetDevice(&dev) != hipSuccess || hipDeviceGetAttribute(&cus, hipDeviceAttributeMultiprocessorCount, dev) != hipSuccess) { grid = -1; return; }
        if (hipFuncSetAttribute((const void*)mk_fwd, hipFuncAttributeMaxDynamicSharedMemorySize, LDS_BYTES) != hipSuccess) { fprintf(stderr, "kernel_launch: hipFuncSetAttribute failed\n"); grid = -1; return; }
        if (hipOccupancyMaxActiveBlocksPerMultiprocessor(&per_cu, (const void*)mk_fwd, NWAVES * 64, LDS_BYTES) != hipSuccess || per_cu < 1)
            fprintf(stderr, "kernel_launch: occupancy query reports %d blocks per CU\n", per_cu);
        (void)hipGetLastError();
        grid = cus;
        if (grid > 256) grid = 256;
    }
    if (grid < 0) return;
    if (hipMemsetAsync((char*)d_ws + WS_CTL, 0, CTL_ZERO_BYTES, stream) != hipSuccess) return;
    Args a{};
    for (int i = 0; i < 33; ++i) a.in[i] = (const float*)d_in[i];
    a.out = (float*)d_out; a.ws = (unsigned char*)d_ws;
#if MK_ONE_LAUNCH
    a.ph_lo = 0; a.ph_hi = N_PHASES;
    hipLaunchKernelGGL(mk_fwd, dim3(grid), dim3(NWAVES * 64), LDS_BYTES, stream, a);
#else
    for (int p = 0; p < N_PHASES; ++p) { for (int r = 0; r <= (((REP_MASK) >> p) & 1); ++r) { a.ph_lo = p; a.ph_hi = (p + 1) | (r << 8); hipLaunchKernelGGL(mk_fwd, dim3(grid), dim3(NWAVES * 64), LDS_BYTES, stream, a); } }
#endif
}
```

```cpp
#include <hip/hip_runtime.h>
#include <cstdio>
#include <cstdint>
#define MK_ONE_LAUNCH 1
#define REP_MASK 0
#define P3REP 1
#define NSA_SKIP 0
#define DBG_SEL -1
#define DBG_BLK 0
#define DBG_BASE_US 0.0f
#define DBG_SCALE 4e-4f
#define DBG_SUB 0
namespace pg8 {
#define PG8_LAS __attribute__((address_space(3)))
typedef unsigned short bf16_t;
typedef short bf16x8 __attribute__((ext_vector_type(8)));
typedef float f32x4 __attribute__((ext_vector_type(4)));
typedef unsigned u32x4 __attribute__((ext_vector_type(4)));
constexpr int BM = 256, BK = 64, HALF = 128, HTB = HALF * BK * 2  , STAGE_BYTES = 8 * HTB, NXCD = 8, WGM = 8;

__host__ __device__ __forceinline__ int lds_byte(int r, int c) { const int st = (r >> 4) * 2 + (c >> 5), rr = r & 15, cc = c & 31, ob = rr * 64 + cc * 2; return st * 1024 + (ob ^ (((ob >> 9) & 1) << 5)); }
__host__ __device__ __forceinline__ void stage_rc(int b, int& R, int& C) { const int st = b / 1024, sb = b % 1024, swz = sb ^ (((sb >> 9) & 1) << 5); R = (st >> 1) * 16 + swz / 64; C = (st & 1) * 32 + (swz % 64) / 2; }
__host__ __device__ __forceinline__ int perm32(int rho) { const int n = rho >> 4, i = rho & 15; return 8 * (i >> 2) + 4 * n + (i & 3); }

struct Unit { int pm, pn; int seg = 0; };
struct Gemm { const bf16_t* A; const bf16_t* Bt; int M, N, K; const bf16_t* A2 = nullptr; const bf16_t* Bt2 = nullptr; };

struct StaticOrder {
    int nM, nN, nwg, G, c;
    __host__ __device__ void init(int M, int N, int G_, int c_) { nM = M / BM; nN = N / BM; nwg = nM * nN; G = G_; c = c_; }
    __host__ __device__ bool next(int i, Unit& u) const {
        const long L = (long)i * G + c; if (L >= nwg) return false;
        int wgid = (int)L; { const int q = nwg / NXCD, r = nwg % NXCD, xcd = wgid % NXCD, off = wgid / NXCD; wgid = (xcd < r ? xcd * (q + 1) : r * (q + 1) + (xcd - r) * q) + off; }
        const int nig = WGM * nN, gid = wgid / nig, fm = gid * WGM, gsz = (nM - fm) < WGM ? (nM - fm) : WGM;
        u.pm = fm + ((wgid % nig) % gsz); u.pn = (wgid % nig) / gsz; return true;
    }
    __device__ __forceinline__ void a_ready(const Unit&) const {}
    __device__ __forceinline__ void done(const Unit&) const {}
};


struct StaticOrder2 {
    StaticOrder base;
    __host__ __device__ void init(int M, int N, int G_, int c_) { base.init(M, N, G_, c_); }
    __host__ __device__ bool next(int i, Unit& u) const { const bool ok = base.next(i >> 1, u); u.seg = i & 1; return ok; }
    __device__ __forceinline__ void a_ready(const Unit&) const {}
    __device__ __forceinline__ void done(const Unit&) const {}
};
typedef float f32x2c __attribute__((ext_vector_type(2))); typedef __bf16 bf16x2c __attribute__((ext_vector_type(2)));
__device__ __forceinline__ unsigned cvt_pk_bf16(float lo, float hi) { const f32x2c v = {lo, hi}; const bf16x2c b = __builtin_convertvector(v, bf16x2c); return __builtin_bit_cast(unsigned, b); }
typedef float f32x2 __attribute__((ext_vector_type(2)));
__device__ __forceinline__ f32x2 gelu_pk(f32x2 v) {
    const f32x2 av = __builtin_elementwise_abs(v), d = av * 0.2316418882f + 1.0f;
    f32x2 t; t.x = __builtin_amdgcn_rcpf(d.x); t.y = __builtin_amdgcn_rcpf(d.y);
    f32x2 q = t * 0.5307027145f + (-0.7265760135f); q = q * t + 0.7107068705f; q = q * t + (-0.142248368f); q = q * t + 0.127414796f; q = q * t;
    const f32x2 s = (v * v) * (-0.72134752044f);
    f32x2 e; e.x = __builtin_amdgcn_exp2f(s.x); e.y = __builtin_amdgcn_exp2f(s.y);
    const f32x2 m = v * (q * e), r = v - m;
    f32x2 o; o.x = v.x < 0.f ? m.x : r.x; o.y = v.y < 0.f ? m.y : r.y; return o;
}

template <int ACT  > struct EpiBf16 {
    static constexpr bool PERM = true, AFTER_DRAIN = false, KEEP_ACC = false; static_assert(ACT == 0 || ACT == 1, "EpiBf16: ACT is 0 (none) or 1 (gelu_pk)");
    bf16_t* O; int ldc; const float* bias; int split_cols; size_t split_stride; float scale0;
    __device__ __forceinline__ void operator()(const f32x4 (&acc)[2][2][4][2], const Unit& u, int wr, int wc, int fr, int fq) const {
        const int row0 = u.pm * BM + wr * 64 + fr; int colt = u.pn * BM; bf16_t* base = O;
        float sc = 1.f; if (split_cols) { const int t = colt / split_cols; base += (size_t)t * split_stride; colt -= t * split_cols; if (t == 0) sc = scale0; }
        const int col0 = colt + wc * 32 + 8 * fq, bcol0 = u.pn * BM + wc * 32 + 8 * fq;
        f32x4 bv[2][2];
#pragma unroll
        for (int bj = 0; bj < 2; ++bj)
#pragma unroll
            for (int n = 0; n < 2; ++n) bv[bj][n] = bias ? *(const f32x4*)(bias + bcol0 + bj * HALF + 4 * n) : (f32x4){0.f, 0.f, 0.f, 0.f};
#pragma unroll
        for (int ai = 0; ai < 2; ++ai)
#pragma unroll
            for (int m = 0; m < 4; ++m) { bf16_t* rowp = base + (size_t)(row0 + ai * HALF + m * 16) * ldc + col0;
#pragma unroll
                for (int bj = 0; bj < 2; ++bj) { f32x4 v0 = acc[ai][bj][m][0] + bv[bj][0], v1 = acc[ai][bj][m][1] + bv[bj][1];
                    if (ACT == 1) { f32x2 a = gelu_pk((f32x2){v0[0], v0[1]}), b = gelu_pk((f32x2){v0[2], v0[3]}), c = gelu_pk((f32x2){v1[0], v1[1]}), d = gelu_pk((f32x2){v1[2], v1[3]});
                        v0 = (f32x4){a.x, a.y, b.x, b.y}; v1 = (f32x4){c.x, c.y, d.x, d.y}; }
                    v0 = v0 * sc; v1 = v1 * sc; u32x4 w; w.x = cvt_pk_bf16(v0[0], v0[1]); w.y = cvt_pk_bf16(v0[2], v0[3]); w.z = cvt_pk_bf16(v1[0], v1[1]); w.w = cvt_pk_bf16(v1[2], v1[3]);
                    *(u32x4*)(rowp + bj * HALF) = w; } }
    }
};
__device__ __forceinline__ float bf_lo(unsigned w) { return __uint_as_float(w << 16); }
__device__ __forceinline__ float bf_hi(unsigned w) { return __uint_as_float(w & 0xffff0000u); }
__device__ __forceinline__ float sigm(float x) { return __builtin_amdgcn_rcpf(1.0f + __expf(-x)); }
__device__ __forceinline__ u32x4 pack8(const f32x4 v0, const f32x4 v1) { u32x4 w; w.x = cvt_pk_bf16(v0[0], v0[1]); w.y = cvt_pk_bf16(v0[2], v0[3]); w.z = cvt_pk_bf16(v1[0], v1[1]); w.w = cvt_pk_bf16(v1[2], v1[3]); return w; }

struct EpiG1 {
    static constexpr bool PERM = true, AFTER_DRAIN = false, KEEP_ACC = false;
    float* PRW; float* BND; bf16_t* PNSA; bf16_t* MG; float* GLOG;
    __device__ __forceinline__ void operator()(const f32x4 (&acc)[2][2][4][2], const Unit& u, int wr, int wc, int fr, int fq) const {
        const int row0 = u.pm * BM + wr * 64 + fr, c0 = wc * 32 + 8 * fq;
#pragma unroll
        for (int ai = 0; ai < 2; ++ai)
#pragma unroll
            for (int m = 0; m < 4; ++m) { const int row = row0 + ai * HALF + m * 16;
#pragma unroll
                for (int bj = 0; bj < 2; ++bj) { const f32x4 v0 = acc[ai][bj][m][0], v1 = acc[ai][bj][m][1]; const int col = c0 + bj * HALF;
                    if (u.pn < 7) { float* p = PRW + (size_t)row * 1792 + u.pn * 256 + col; *(f32x4*)p = v0; *(f32x4*)(p + 4) = v1;
                        if ((row & 63) == 63) { float* q = BND + (size_t)(row >> 6) * 1792 + u.pn * 256 + col; *(f32x4*)q = v0; *(f32x4*)(q + 4) = v1; } }
                    else if (u.pn < 12) { *(u32x4*)(PNSA + (size_t)row * 1280 + (u.pn - 7) * 256 + col) = pack8(v0, v1); }
                    else if (u.pn < 20) { *(u32x4*)(MG + (size_t)row * 2048 + (u.pn - 12) * 256 + col) = pack8(v0, v1); }
                    else { if (col < 32) { float* p = GLOG + (size_t)row * 32 + col; *(f32x4*)p = v0; *(f32x4*)(p + 4) = v1; } }
                } }
    }
};
struct EpiGate1 {
    static constexpr bool PERM = true, AFTER_DRAIN = false, KEEP_ACC = false;
    float* T1; const bf16_t* MG; int goff;
    __device__ __forceinline__ void operator()(const f32x4 (&acc)[2][2][4][2], const Unit& u, int wr, int wc, int fr, int fq) const {
        const int row0 = u.pm * BM + wr * 64 + fr, c0 = u.pn * BM + wc * 32 + 8 * fq;
#pragma unroll
        for (int ai = 0; ai < 2; ++ai)
#pragma unroll
            for (int m = 0; m < 4; ++m) { const int row = row0 + ai * HALF + m * 16;
#pragma unroll
                for (int bj = 0; bj < 2; ++bj) { const f32x4 v0 = acc[ai][bj][m][0], v1 = acc[ai][bj][m][1]; const int col = c0 + bj * HALF;
                    const u32x4 g = *(const u32x4*)(MG + (size_t)row * 2048 + goff + col);
                    f32x4 o0, o1; o0[0] = sigm(bf_lo(g.x)) * v0[0]; o0[1] = sigm(bf_hi(g.x)) * v0[1]; o0[2] = sigm(bf_lo(g.y)) * v0[2]; o0[3] = sigm(bf_hi(g.y)) * v0[3];
                    o1[0] = sigm(bf_lo(g.z)) * v1[0]; o1[1] = sigm(bf_hi(g.z)) * v1[1]; o1[2] = sigm(bf_lo(g.w)) * v1[2]; o1[3] = sigm(bf_hi(g.w)) * v1[3];
                    float* p = T1 + (size_t)row * 1024 + col; *(f32x4*)p = o0; *(f32x4*)(p + 4) = o1; } }
    }
};
struct EpiGate2 {
    static constexpr bool PERM = true, AFTER_DRAIN = false, KEEP_ACC = false;
    const float* T1; const bf16_t* MG; int goff; bf16_t* MIX;
    __device__ __forceinline__ void operator()(const f32x4 (&acc)[2][2][4][2], const Unit& u, int wr, int wc, int fr, int fq) const {
        const int row0 = u.pm * BM + wr * 64 + fr, c0 = u.pn * BM + wc * 32 + 8 * fq;
#pragma unroll
        for (int ai = 0; ai < 2; ++ai)
#pragma unroll
            for (int m = 0; m < 4; ++m) { const int row = row0 + ai * HALF + m * 16;
#pragma unroll
                for (int bj = 0; bj < 2; ++bj) { const f32x4 v0 = acc[ai][bj][m][0], v1 = acc[ai][bj][m][1]; const int col = c0 + bj * HALF;
                    const u32x4 g = *(const u32x4*)(MG + (size_t)row * 2048 + goff + col);
                    const float* p = T1 + (size_t)row * 1024 + col; const f32x4 t0 = *(const f32x4*)p, t1 = *(const f32x4*)(p + 4);
                    f32x4 o0, o1; o0[0] = t0[0] + sigm(bf_lo(g.x)) * v0[0]; o0[1] = t0[1] + sigm(bf_hi(g.x)) * v0[1]; o0[2] = t0[2] + sigm(bf_lo(g.y)) * v0[2]; o0[3] = t0[3] + sigm(bf_hi(g.y)) * v0[3];
                    o1[0] = t1[0] + sigm(bf_lo(g.z)) * v1[0]; o1[1] = t1[1] + sigm(bf_hi(g.z)) * v1[1]; o1[2] = t1[2] + sigm(bf_lo(g.w)) * v1[2]; o1[3] = t1[3] + sigm(bf_hi(g.w)) * v1[3];
                    *(u32x4*)(MIX + (size_t)row * 1024 + col) = pack8(o0, o1); } }
    }
};
struct EpiRes {
    static constexpr bool PERM = true, AFTER_DRAIN = false, KEEP_ACC = false;
    const float* X; float* OUT;
    __device__ __forceinline__ void operator()(const f32x4 (&acc)[2][2][4][2], const Unit& u, int wr, int wc, int fr, int fq) const {
        const int row0 = u.pm * BM + wr * 64 + fr, c0 = u.pn * BM + wc * 32 + 8 * fq;
#pragma unroll
        for (int ai = 0; ai < 2; ++ai) { f32x4 xv[4][2][2];
#pragma unroll
            for (int m = 0; m < 4; ++m)
#pragma unroll
                for (int bj = 0; bj < 2; ++bj) { const size_t off = (size_t)(row0 + ai * HALF + m * 16) * 1024 + c0 + bj * HALF; xv[m][bj][0] = *(const f32x4*)(X + off); xv[m][bj][1] = *(const f32x4*)(X + off + 4); }
#pragma unroll
            for (int m = 0; m < 4; ++m)
#pragma unroll
                for (int bj = 0; bj < 2; ++bj) { const size_t off = (size_t)(row0 + ai * HALF + m * 16) * 1024 + c0 + bj * HALF;
                    *(f32x4*)(OUT + off) = xv[m][bj][0] + acc[ai][bj][m][0]; *(f32x4*)(OUT + off + 4) = xv[m][bj][1] + acc[ai][bj][m][1]; } }
    }
};
struct EpiMerge {
    static constexpr bool PERM = true, AFTER_DRAIN = false, KEEP_ACC = true;
    const bf16_t* MG; bf16_t* MIX;
    __device__ __forceinline__ void operator()(f32x4 (&acc)[2][2][4][2], const Unit& u, int wr, int wc, int fr, int fq) const {
        const int row0 = u.pm * BM + wr * 64 + fr, c0 = u.pn * BM + wc * 32 + 8 * fq;
#pragma unroll
        for (int ai = 0; ai < 2; ++ai) { u32x4 gbv[4][2], gav[4][2];
#pragma unroll
            for (int m = 0; m < 4; ++m)
#pragma unroll
                for (int bj = 0; bj < 2; ++bj) gbv[m][bj] = *(const u32x4*)(MG + (size_t)(row0 + ai * HALF + m * 16) * 2048 + 1024 + c0 + bj * HALF);
            if (u.seg == 0) {
#pragma unroll
                for (int m = 0; m < 4; ++m)
#pragma unroll
                    for (int bj = 0; bj < 2; ++bj) gav[m][bj] = *(const u32x4*)(MG + (size_t)(row0 + ai * HALF + m * 16) * 2048 + c0 + bj * HALF); }
#pragma unroll
            for (int m = 0; m < 4; ++m) { const int row = row0 + ai * HALF + m * 16;
#pragma unroll
                for (int bj = 0; bj < 2; ++bj) { const int col = c0 + bj * HALF;
                    const u32x4 gb = gbv[m][bj];
                    const float eb[8] = {__expf(-bf_lo(gb.x)), __expf(-bf_hi(gb.x)), __expf(-bf_lo(gb.y)), __expf(-bf_hi(gb.y)), __expf(-bf_lo(gb.z)), __expf(-bf_hi(gb.z)), __expf(-bf_lo(gb.w)), __expf(-bf_hi(gb.w))};
                    if (u.seg == 0) { const u32x4 ga = gav[m][bj];
                        const float ea[8] = {__expf(-bf_lo(ga.x)), __expf(-bf_hi(ga.x)), __expf(-bf_lo(ga.y)), __expf(-bf_hi(ga.y)), __expf(-bf_lo(ga.z)), __expf(-bf_hi(ga.z)), __expf(-bf_lo(ga.w)), __expf(-bf_hi(ga.w))};
#pragma unroll
                        for (int e = 0; e < 4; ++e) { acc[ai][bj][m][0][e] *= (1.0f + eb[e]) * __builtin_amdgcn_rcpf(1.0f + ea[e]); acc[ai][bj][m][1][e] *= (1.0f + eb[4 + e]) * __builtin_amdgcn_rcpf(1.0f + ea[4 + e]); } }
                    else { f32x4 o0, o1;
#pragma unroll
                        for (int e = 0; e < 4; ++e) { o0[e] = acc[ai][bj][m][0][e] * __builtin_amdgcn_rcpf(1.0f + eb[e]); o1[e] = acc[ai][bj][m][1][e] * __builtin_amdgcn_rcpf(1.0f + eb[4 + e]); }
                        *(u32x4*)(MIX + (size_t)row * 1024 + col) = pack8(o0, o1); } } } }
    }
};
template <class Epi, class Sched, bool ALIGN_EPI = false, bool SP2 = false>
__device__ __forceinline__ void gemm_phase(PG8_LAS unsigned char* lds, const Gemm g, const Sched& S, const Epi& E) {
    const int tid = threadIdx.x, wid = __builtin_amdgcn_readfirstlane(tid >> 6), lane = tid & 63, wr = wid >> 2, wc = wid & 3, fr = lane & 15, fq = lane >> 4;
    const int K = g.K, nt = K / BK;
    unsigned voffA[2], voffB[2];
#pragma unroll
    for (int i = 0; i < 2; ++i) { int R, C; stage_rc(tid * 16 + i * 8192, R, C); const int Rb = Epi::PERM ? ((R & ~31) + perm32(R & 31)) : R;
        voffA[i] = (unsigned)(R * K + C) * 2u; voffB[i] = (unsigned)(Rb * K + C) * 2u; }
    const size_t kstep = (size_t)(BK * 2);
    const size_t hstep = (size_t)HALF * K * 2;
    const size_t tstep = 2 * hstep;
    const unsigned ldsw = (unsigned)wid * 1024u;
    const int aoff = lds_byte(wr * 64 + fr, fq * 8), boff = lds_byte(wc * 32 + fr, fq * 8);
#define PG8_SA(b, h) (((b) * 2 + (h)) * HTB)
#define PG8_SB(b, h) ((4 + (b) * 2 + (h)) * HTB)
#define PG8_STAGE(bufoff, gbase, voff) do { _Pragma("unroll") for (int _i = 0; _i < 2; ++_i) \
        __builtin_amdgcn_global_load_lds((const unsigned*)((const char*)(gbase) + (voff)[_i]), (PG8_LAS unsigned*)(lds + (bufoff) + ldsw + _i * 8192), 16, 0, 0); } while (0)
#define PG8_LDA(dst, b, h) do { _Pragma("unroll") for (int m = 0; m < 4; ++m) _Pragma("unroll") for (int k = 0; k < 2; ++k) dst[m][k] = *(const PG8_LAS bf16x8*)(lds + PG8_SA(b, h) + aoff + m * 2048 + k * 1024); } while (0)
#define PG8_LDB(dst, b, h) do { _Pragma("unroll") for (int n = 0; n < 2; ++n) _Pragma("unroll") for (int k = 0; k < 2; ++k) dst[n][k] = *(const PG8_LAS bf16x8*)(lds + PG8_SB(b, h) + boff + n * 2048 + k * 1024); } while (0)
#define PG8_MMA(ai, bj, At, Bt) do { __builtin_amdgcn_s_setprio(1); _Pragma("unroll") for (int m = 0; m < 4; ++m) _Pragma("unroll") for (int n = 0; n < 2; ++n) _Pragma("unroll") for (int k = 0; k < 2; ++k) \
        acc[ai][bj][m][n] = __builtin_amdgcn_mfma_f32_16x16x32_bf16(Bt[n][k], At[m][k], acc[ai][bj][m][n], 0, 0, 0); __builtin_amdgcn_s_setprio(0); } while (0)
#define PG8_WAIT_V(n) asm volatile("s_waitcnt vmcnt(" #n ")" ::: "memory")
#define PG8_WAIT_L(n) asm volatile("s_waitcnt lgkmcnt(" #n ")" ::: "memory")
#define PG8_BAR __builtin_amdgcn_s_barrier()
#define PG8_SCHED __builtin_amdgcn_sched_barrier(0)
    Unit cur, nxt; int ui = 0;
    if (!S.next(0, cur)) return;
    f32x4 acc[2][2][4][2];
#pragma unroll
    for (int a = 0; a < 2; ++a)
#pragma unroll
        for (int b = 0; b < 2; ++b)
#pragma unroll
            for (int m = 0; m < 4; ++m)
#pragma unroll
                for (int n = 0; n < 2; ++n) acc[a][b][m][n] = (f32x4){0.f, 0.f, 0.f, 0.f};
    bf16x8 At[4][2], B0[2][2], B1[2][2];
    const char* cA = (const char*)(cur.seg ? g.A2 : g.A) + (size_t)cur.pm * tstep; const char* cB = (const char*)(cur.seg ? g.Bt2 : g.Bt) + (size_t)cur.pn * tstep;
    S.a_ready(cur);
    if constexpr (SP2) {
        PG8_STAGE(PG8_SB(0, 0), cB, voffB); PG8_STAGE(PG8_SB(0, 1), cB + hstep, voffB); PG8_STAGE(PG8_SA(0, 0), cA, voffA); PG8_STAGE(PG8_SA(0, 1), cA + hstep, voffA);
        if (wr == 1) PG8_BAR;
        PG8_WAIT_V(2); PG8_BAR;
        PG8_STAGE(PG8_SB(1, 0), cB + kstep, voffB); PG8_STAGE(PG8_SA(1, 0), cA + kstep, voffA); PG8_STAGE(PG8_SB(1, 1), cB + hstep + kstep, voffB);
        PG8_WAIT_V(6); PG8_BAR;
    } else {
        PG8_STAGE(PG8_SB(0, 0), cB, voffB); PG8_STAGE(PG8_SA(0, 0), cA, voffA); PG8_STAGE(PG8_SB(0, 1), cB + hstep, voffB); PG8_STAGE(PG8_SA(0, 1), cA + hstep, voffA);
        if (wr == 1) PG8_BAR;
        PG8_WAIT_V(4); PG8_BAR;
        PG8_STAGE(PG8_SB(1, 0), cB + kstep, voffB); PG8_STAGE(PG8_SA(1, 0), cA + kstep, voffA); PG8_STAGE(PG8_SB(1, 1), cB + hstep + kstep, voffB);
        PG8_WAIT_V(6); PG8_BAR;
    }
    for (;;) {
        const bool has_next = S.next(ui + 1, nxt);
        const char* nA = has_next ? (const char*)(nxt.seg ? g.A2 : g.A) + (size_t)nxt.pm * tstep : cA; const char* nB = has_next ? (const char*)(nxt.seg ? g.Bt2 : g.Bt) + (size_t)nxt.pn * tstep : cB;
        for (int t = 0; t < nt; t += 2) {
            const bool last = (t == nt - 2);
            const char* a1 = cA + (size_t)(t + 1) * kstep;
            const char* a2 = last ? nA : cA + (size_t)(t + 2) * kstep; const char* b2 = last ? nB : cB + (size_t)(t + 2) * kstep;
            const char* a3 = a2 + kstep; const char* b3 = b2 + kstep;
            if (last && has_next) S.a_ready(nxt);
            if constexpr (SP2) {
            PG8_LDB(B0, 0, 0); PG8_LDB(B1, 0, 1); PG8_SCHED; PG8_LDA(At, 0, 0); PG8_STAGE(PG8_SA(1, 1), a1 + hstep, voffA);
            PG8_WAIT_V(8); PG8_WAIT_L(0); PG8_BAR; PG8_MMA(0, 0, At, B0); PG8_MMA(0, 1, At, B1); PG8_BAR; PG8_SCHED;
            PG8_LDA(At, 0, 1); PG8_STAGE(PG8_SB(0, 0), b2, voffB); PG8_STAGE(PG8_SB(0, 1), b2 + hstep, voffB); PG8_STAGE(PG8_SA(0, 0), a2, voffA);
            PG8_WAIT_V(8); PG8_WAIT_L(0); PG8_BAR; PG8_MMA(1, 0, At, B0); PG8_MMA(1, 1, At, B1); PG8_BAR; PG8_SCHED;
            PG8_LDB(B0, 1, 0); PG8_LDB(B1, 1, 1); PG8_SCHED; PG8_LDA(At, 1, 0); PG8_STAGE(PG8_SA(0, 1), a2 + hstep, voffA);
            PG8_WAIT_V(8); PG8_WAIT_L(0); PG8_BAR; PG8_MMA(0, 0, At, B0); PG8_MMA(0, 1, At, B1); PG8_BAR; PG8_SCHED;
            PG8_LDA(At, 1, 1); PG8_STAGE(PG8_SB(1, 0), b3, voffB); PG8_STAGE(PG8_SB(1, 1), b3 + hstep, voffB); PG8_STAGE(PG8_SA(1, 0), a3, voffA);
            PG8_WAIT_V(8); PG8_WAIT_L(0); PG8_BAR; PG8_MMA(1, 0, At, B0); PG8_MMA(1, 1, At, B1); PG8_BAR; PG8_SCHED;
            } else {
            PG8_LDB(B0, 0, 0); PG8_SCHED; PG8_LDA(At, 0, 0); PG8_STAGE(PG8_SA(1, 1), a1 + hstep, voffA);
            PG8_WAIT_L(8); PG8_BAR; PG8_WAIT_L(0); PG8_MMA(0, 0, At, B0); PG8_BAR; PG8_SCHED;
            PG8_LDB(B1, 0, 1); PG8_STAGE(PG8_SB(0, 0), b2, voffB);
            PG8_BAR; PG8_WAIT_L(0); PG8_MMA(0, 1, At, B1); PG8_BAR;
            PG8_LDA(At, 0, 1); PG8_STAGE(PG8_SA(0, 0), a2, voffA);
            PG8_BAR; PG8_WAIT_L(0); PG8_MMA(1, 0, At, B0); PG8_BAR; PG8_SCHED;
            PG8_STAGE(PG8_SB(0, 1), b2 + hstep, voffB);
            PG8_WAIT_V(6); PG8_BAR; PG8_MMA(1, 1, At, B1); PG8_BAR;
            PG8_LDB(B0, 1, 0); PG8_SCHED; PG8_LDA(At, 1, 0); PG8_STAGE(PG8_SA(0, 1), a2 + hstep, voffA);
            PG8_WAIT_L(8); PG8_BAR; PG8_WAIT_L(0); PG8_MMA(0, 0, At, B0); PG8_BAR; PG8_SCHED;
            PG8_LDB(B1, 1, 1); PG8_STAGE(PG8_SB(1, 0), b3, voffB);
            PG8_BAR; PG8_WAIT_L(0); PG8_MMA(0, 1, At, B1); PG8_BAR;
            PG8_LDA(At, 1, 1); PG8_STAGE(PG8_SA(1, 0), a3, voffA);
            PG8_BAR; PG8_WAIT_L(0); PG8_MMA(1, 0, At, B0); PG8_BAR; PG8_SCHED;
            PG8_STAGE(PG8_SB(1, 1), b3 + hstep, voffB);
            PG8_WAIT_V(6); PG8_BAR; PG8_MMA(1, 1, At, B1); PG8_BAR;
            }
        }
        if constexpr (ALIGN_EPI) { if (wr == 0) PG8_BAR; }
        if constexpr (!Epi::AFTER_DRAIN) { E(acc, cur, wr, wc, fr, fq); S.done(cur); }
        if (!has_next) break;
        if (!(Epi::KEEP_ACC && cur.seg == 0))
#pragma unroll
        for (int a = 0; a < 2; ++a)
#pragma unroll
            for (int b = 0; b < 2; ++b)
#pragma unroll
                for (int m = 0; m < 4; ++m)
#pragma unroll
                    for (int n = 0; n < 2; ++n) acc[a][b][m][n] = (f32x4){0.f, 0.f, 0.f, 0.f};
        cur = nxt; cA = nA; cB = nB; ++ui;
        if constexpr (ALIGN_EPI) { if (wr == 1) PG8_BAR; }
    }
    PG8_WAIT_V(0);
    if constexpr (!ALIGN_EPI) { if (wr == 0) PG8_BAR; }
    PG8_BAR;
    if constexpr (Epi::AFTER_DRAIN) { E.fused(acc, cur, wr, wc, fr, fq, lds, wid, lane); S.done(cur); }
#undef PG8_SA
#undef PG8_SB
#undef PG8_STAGE
#undef PG8_LDA
#undef PG8_LDB
#undef PG8_MMA
#undef PG8_WAIT_V
#undef PG8_WAIT_L
#undef PG8_BAR
#undef PG8_SCHED
}
}
#define GAS __attribute__((address_space(1)))
#define LAS __attribute__((address_space(3)))
typedef unsigned short bf16;
typedef unsigned v4u __attribute__((ext_vector_type(4)));
typedef float f32x4 __attribute__((ext_vector_type(4)));
typedef short bf16x8 __attribute__((ext_vector_type(8)));
typedef GAS unsigned gu32;
typedef GAS unsigned long long gu64;
#define RLX_AGENT __ATOMIC_RELAXED, __HIP_MEMORY_SCOPE_AGENT
#define LDS_WAIT() asm volatile("s_waitcnt lgkmcnt(0)" ::: "memory")
#define VM_WAIT() asm volatile("s_waitcnt vmcnt(0)" ::: "memory")
__device__ __forceinline__ unsigned long long rt() { return __builtin_amdgcn_s_memrealtime(); }
__device__ __forceinline__ unsigned f2bf(float f) { unsigned u = __builtin_bit_cast(unsigned, f); return (u + 0x7fffu + ((u >> 16) & 1u)) >> 16; }
__device__ __forceinline__ unsigned pk2(float lo, float hi) { return f2bf(lo) | (f2bf(hi) << 16); }

#define XB_TMO      128
#define XB_XCNT(j)  (256  + 64 * (j))
#define XB_XSUB(j)  (1280 + 64 * (j))
#define XB_XGEN(j)  (2304 + 64 * (j))
#define XB_TOP      3328
#define XB_TOPGEN   3392
#define XCD_BAR_WORDS 3456
#define XB_SPIN_CAP (1u << 18)

__device__ __forceinline__ unsigned xb_ld(unsigned* p)              { return __hip_atomic_load(p, __ATOMIC_RELAXED, __HIP_MEMORY_SCOPE_AGENT); }
__device__ __forceinline__ unsigned xb_add(unsigned* p, unsigned v) { return __hip_atomic_fetch_add(p, v, __ATOMIC_RELAXED, __HIP_MEMORY_SCOPE_AGENT); }
__device__ __forceinline__ unsigned xb_xcc_id() { return (unsigned)__builtin_amdgcn_s_getreg((3 << 11) | 20) & 0xFu; }
#define XB_SPIN(cond, bar) do { unsigned _sp = 0; while (cond) { __builtin_amdgcn_s_sleep(1); \
    if ((++_sp & 255u) == 0u) { if (xb_ld(&(bar)[XB_TMO])) break; if (_sp > XB_SPIN_CAP) { atomicAdd(&(bar)[XB_TMO], 1u); break; } } } } while (0)

struct XcdBarrier {
    unsigned* bar; unsigned x;
    volatile LAS unsigned* st;
};

__device__ __forceinline__ XcdBarrier xcd_barrier_post(unsigned* bar, volatile LAS unsigned* st) {
    XcdBarrier b; b.bar = bar; b.x = xb_xcc_id(); b.st = st;
    if (threadIdx.x == 0) (void)xb_add(&bar[XB_XCNT(b.x)], 1u);
    return b;
}
__device__ __forceinline__ void xcd_barrier_complete(unsigned* bar, unsigned x, unsigned& nloc, unsigned& nx) {
    const unsigned G = gridDim.x * gridDim.y * gridDim.z;
    unsigned sum, cnt, mine, sp = 0u;
    for (;;) {
        sum = 0u; cnt = 0u; mine = 0u;
#pragma unroll
        for (unsigned j = 0; j < 16; ++j) { const unsigned c = xb_ld(&bar[XB_XCNT(j)]); sum += c; cnt += (c > 0u) ? 1u : 0u; mine = (j == x) ? c : mine; }
        if (sum == G) break;
        __builtin_amdgcn_s_sleep(1);
        if ((++sp & 255u) == 0u) { if (xb_ld(&bar[XB_TMO])) break; if (sp > XB_SPIN_CAP) { atomicAdd(&bar[XB_TMO], 1u); break; } }
    }
    nloc = mine > 0u ? mine : 1u; nx = cnt > 0u ? cnt : 1u;
}

__device__ __forceinline__ void xcd_barrier(const XcdBarrier& b) {
    asm volatile("s_waitcnt vmcnt(0)" ::: "memory");
    __syncthreads();
    if (threadIdx.x == 0) {
        unsigned* bar = b.bar;
        __builtin_amdgcn_s_waitcnt(0);
        unsigned nloc = b.st[0], nx = b.st[1];
        if (nloc == 0u) { xcd_barrier_complete(bar, b.x, nloc, nx); b.st[0] = nloc; b.st[1] = nx; }
        const unsigned old = xb_add(&bar[XB_XSUB(b.x)], 1u);
        const unsigned gen = old / nloc;
        if (old + 1u == (gen + 1u) * nloc) {
            __builtin_amdgcn_fence(__ATOMIC_RELEASE, "agent");
            asm volatile("s_waitcnt vmcnt(0)" ::: "memory");
            const unsigned og = xb_add(&bar[XB_TOP], 1u);
            const unsigned tg = og / nx;
            if (og + 1u == (tg + 1u) * nx) xb_add(&bar[XB_TOPGEN], 1u);
            else XB_SPIN(xb_ld(&bar[XB_TOPGEN]) == tg, bar);
            __builtin_amdgcn_fence(__ATOMIC_ACQUIRE, "agent");
            xb_add(&bar[XB_XGEN(b.x)], 1u);
            asm volatile("s_waitcnt vmcnt(0)" ::: "memory");
        } else {
            XB_SPIN(xb_ld(&bar[XB_XGEN(b.x)]) == gen, bar);
            __builtin_amdgcn_fence(__ATOMIC_ACQUIRE, "agent");
            asm volatile("s_waitcnt vmcnt(0)" ::: "memory");
        }
    }
    __syncthreads();
}
constexpr int NWAVES = 8;
constexpr int BATCH = 4, T = 4096, D = 1024, M = BATCH * T;
constexpr int RWC = 1792;
constexpr int NG1 = 5120;
constexpr float NORM_EPS = 1e-6f, GN_EPS = 64e-5f;
constexpr float LOG2E = 1.4426950408889634f;
constexpr int N_PHASES = 13;
#ifndef MK_ONE_LAUNCH
#define MK_ONE_LAUNCH 0
#endif
#ifndef REP_MASK
#define REP_MASK 0
#endif
#ifndef DBG_BLK
#define DBG_BLK 0
#endif
#ifndef DBG_SCALE
#define DBG_SCALE 4e-4f
#endif
#ifndef DBG_SEL
#define DBG_SEL -1
#endif
#ifndef NSA_SKIP
#define NSA_SKIP 0
#endif
#ifndef P3REP
#define P3REP 1
#endif
#ifndef SCAN_BLOCKS
#define SCAN_BLOCKS 128
#endif

constexpr size_t MiB = 1u << 20;
constexpr size_t WS_CTL = 0, CTL_ZERO_BYTES = 65536;
constexpr size_t WS_WIN = 1 * MiB;
constexpr size_t WS_WA = 12 * MiB, WS_WB = 13 * MiB;
constexpr size_t WS_WOUT = 14 * MiB;
constexpr size_t WS_WQ = 16 * MiB;
constexpr size_t WS_CW1K = 20 * MiB, WS_CW1V = 21 * MiB;
constexpr size_t WS_CW2K = 22 * MiB, WS_CW2V = 22 * MiB + 65536;
constexpr size_t WS_SK1 = 22 * MiB + 131072, WS_SK2 = 22 * MiB + 196608;
constexpr size_t WS_WUT = 22 * MiB + 262144, WS_AUT = WS_WUT + 65536, WS_GUT = WS_WUT + 131072;
constexpr size_t WS_BND = 23 * MiB;
constexpr size_t WS_KC = 25 * MiB;
constexpr size_t WS_VCT = 25 * MiB + 262144;
constexpr size_t WS_H = 26 * MiB;
constexpr size_t WS_PRW = 58 * MiB;
constexpr size_t WS_MG = 170 * MiB;
constexpr size_t WS_VST = 234 * MiB, WS_VWT = 238 * MiB;
constexpr size_t WS_END = 256 * MiB;
constexpr size_t DO_PNSA = 0, DO_G = 40 * MiB, DO_GLOG = 56 * MiB;
constexpr int CW_TMO = 0, CW_CODE = 1, CW_NSAQ = 64, CW_SCANP = 2048, CW_PEERQ = 4160, CW_BAR = 8192;

constexpr int RING_OFF = 0, RING_BYTES = 131072;
constexpr int LDSCTL_OFF = RING_BYTES, MISC_OFF = LDSCTL_OFF + 320;
constexpr int LDS_BYTES = 147456;
typedef unsigned short u16;
typedef unsigned u32x2 __attribute__((ext_vector_type(2)));
struct Frame {
    LAS unsigned char* lds;
    volatile LAS unsigned* MISC;
    gu32* ctl;
    int tid, lane, wave, vcu, G;
    const float* in[33];
    float* out; unsigned char* ws;
};
template <int CTRL> __device__ __forceinline__ float dppf(float x) { return __builtin_bit_cast(float, __builtin_amdgcn_update_dpp(0, __builtin_bit_cast(int, x), CTRL, 0xf, 0xf, true)); }
__device__ __forceinline__ float wave_sum(float v) {
    v += dppf<0xB1>(v); v += dppf<0x4E>(v); v += dppf<0x141>(v); v += dppf<0x140>(v);
    const int iv = __builtin_bit_cast(int, v);
    const float a = __builtin_bit_cast(float, __builtin_amdgcn_readlane(iv, 0)), b = __builtin_bit_cast(float, __builtin_amdgcn_readlane(iv, 16)), c = __builtin_bit_cast(float, __builtin_amdgcn_readlane(iv, 32)), d = __builtin_bit_cast(float, __builtin_amdgcn_readlane(iv, 48));
    return (a + b) + (c + d);
}
__device__ __forceinline__ float bf2f(u16 b) { return __uint_as_float((unsigned)b << 16); }
__device__ __forceinline__ float bflo(unsigned w) { return __uint_as_float(w << 16); }
__device__ __forceinline__ float bfhi(unsigned w) { return __uint_as_float(w & 0xffff0000u); }
__device__ __forceinline__ u16 f2b(float f) { return (u16)pg8::cvt_pk_bf16(f, 0.f); }
#define pk2(lo_, hi_) pg8::cvt_pk_bf16((lo_), (hi_))
__device__ __forceinline__ float sigmf(float x) { return __builtin_amdgcn_rcpf(1.0f + __expf(-x)); }
__device__ __forceinline__ float tanh_fast(float x) { return 1.0f - 2.0f * __builtin_amdgcn_rcpf(1.0f + __expf(2.0f * x)); }
__device__ __forceinline__ f32x4 mfma16(const bf16x8 a, const bf16x8 b, const f32x4 c) { return __builtin_amdgcn_mfma_f32_16x16x32_bf16(a, b, c, 0, 0, 0); }
__device__ __forceinline__ bf16x8 as_bf16x8(const v4u v) { return __builtin_bit_cast(bf16x8, v); }
typedef short bf16x4 __attribute__((ext_vector_type(4)));
__device__ __forceinline__ f32x4 mfma16k16(const bf16x4 a, const bf16x4 b, const f32x4 c) { const bf16x8 a8 = {a[0], a[1], a[2], a[3], 0, 0, 0, 0}, b8 = {b[0], b[1], b[2], b[3], 0, 0, 0, 0}; return __builtin_amdgcn_mfma_f32_16x16x32_bf16(a8, b8, c, 0, 0, 0); }
__device__ __forceinline__ bf16x4 as_bf16x4(const u32x2 v) { return __builtin_bit_cast(bf16x4, v); }
__device__ __forceinline__ bf16x4 pack4(const f32x4 a) { u32x2 w; w.x = pg8::cvt_pk_bf16(a[0], a[1]); w.y = pg8::cvt_pk_bf16(a[2], a[3]); return as_bf16x4(w); }

template <bool FRAG = false> __device__ __forceinline__ void tr_item(const float* W, int K, int ldw, int sc0, int nblk, int ncols_valid, bf16* WT, int dr0, LAS float* scr, int item, int lane) {
    const int kb = item / nblk, nb = item % nblk, k0 = 64 * kb, n0 = 32 * nb;
#pragma unroll
    for (int i = 0; i < 32; ++i) { const int kk = 2 * i + (lane >> 5); const int n = n0 + (lane & 31); const int nc = (n < ncols_valid) ? n : 0;
        const float v = W[(size_t)(k0 + kk) * ldw + sc0 + nc]; scr[kk * 33 + (lane & 31)] = (n < ncols_valid) ? v : 0.f; }
    LDS_WAIT(); asm volatile("" ::: "memory");
    const int c = lane & 7;
#pragma unroll
    for (int j = 0; j < 4; ++j) { const int n = (lane >> 3) + 8 * j; const LAS float* s = scr + (8 * c) * 33 + n;
        v4u o; o.x = pk2(s[0 * 33], s[1 * 33]); o.y = pk2(s[2 * 33], s[3 * 33]); o.z = pk2(s[4 * 33], s[5 * 33]); o.w = pk2(s[6 * 33], s[7 * 33]);
        const int nn = dr0 + n0 + n, kk = k0 + 8 * c;
        if (FRAG) *(GAS v4u*)(WT + ((size_t)((nn >> 4) * (K >> 5) + (kk >> 5)) * 64 + ((kk >> 3) & 3) * 16 + (nn & 15)) * 8) = o;
        else *(GAS v4u*)(WT + (size_t)nn * K + kk) = o; }
    LDS_WAIT(); asm volatile("" ::: "memory");
}
__device__ __forceinline__ void rms_rows_to_bf16(int lane, const float* X, const float* gain, bf16* O, int m0, int step) {
    const GAS f32x4* gr = (const GAS f32x4*)gain + lane; f32x4 g[4];
#pragma unroll
    for (int j = 0; j < 4; ++j) g[j] = gr[64 * j];
    for (int m = m0; m < M; m += 4 * step) {
        f32x4 v[4][4]; int mm[4];
#pragma unroll
        for (int k = 0; k < 4; ++k) { mm[k] = (m + k * step < M) ? m + k * step : m; const GAS f32x4* xr = (const GAS f32x4*)(X + (size_t)mm[k] * D) + lane;
#pragma unroll
            for (int j = 0; j < 4; ++j) v[k][j] = xr[64 * j]; }
#pragma unroll
        for (int k = 0; k < 4; ++k) { float s2 = 0.f;
#pragma unroll
            for (int j = 0; j < 4; ++j) s2 += (v[k][j].x * v[k][j].x + v[k][j].y * v[k][j].y) + (v[k][j].z * v[k][j].z + v[k][j].w * v[k][j].w);
            const float rs = 1.f / sqrtf(wave_sum(s2) * (1.f / D) + NORM_EPS);
            if (k == 0 || mm[k] != m) { GAS unsigned long long* o8 = (GAS unsigned long long*)(O + (size_t)mm[k] * D) + lane;
#pragma unroll
                for (int j = 0; j < 4; ++j) o8[64 * j] = (unsigned long long)pk2(v[k][j].x * rs * g[j].x, v[k][j].y * rs * g[j].y) | ((unsigned long long)pk2(v[k][j].z * rs * g[j].z, v[k][j].w * rs * g[j].w) << 32); } } }
}
__device__ __forceinline__ void p0_prologue(const Frame& F) {
    LAS float* scr = (LAS float*)(F.lds + RING_OFF + F.wave * 16384);
    const int gw = F.vcu * NWAVES + F.wave, NGW = F.G * NWAVES;
    unsigned char* ws = F.ws;
    constexpr int I0 = 16 * 96, I1 = 16 * 64, I2 = 16 * 8, I3 = 8 * 32, I4 = 8 * 32, I5 = 16 * 32, I6 = 16 * 64, I7 = 32 * 8, I8 = 32 * 8, I9 = 4 * 2, I10 = 4 * 2, I11 = 16, I12 = 16, I13 = 32;
    constexpr int NITEMS = I0 + I1 + I2 + I3 + I4 + I5 + I6 + I7 + I8 + I9 + I10 + I11 + I12 + I13;
    for (int it = gw; it < NITEMS; it += NGW) {
        int r = it;
        if (r < I0) { tr_item(F.in[2], 1024, 5144, 0, 96, 3072, (bf16*)(ws + WS_WIN), 0, scr, r, F.lane); continue; } r -= I0;
        if (r < I1) { tr_item(F.in[2], 1024, 5144, 3096, 64, 2048, (bf16*)(ws + WS_WIN), 3072, scr, r, F.lane); continue; } r -= I1;
        if (r < I2) { tr_item(F.in[2], 1024, 5144, 3072, 8, 24, (bf16*)(ws + WS_WIN), 5120, scr, r, F.lane); continue; } r -= I2;
        if (r < I3) { tr_item(F.in[24], 512, 1024, 0, 32, 1024, (bf16*)(ws + WS_WA), 0, scr, r, F.lane); continue; } r -= I3;
        if (r < I4) { tr_item(F.in[25], 512, 1024, 0, 32, 1024, (bf16*)(ws + WS_WB), 0, scr, r, F.lane); continue; } r -= I4;
        if (r < I5) { tr_item(F.in[26], 1024, 1024, 0, 32, 1024, (bf16*)(ws + WS_WOUT), 0, scr, r, F.lane); continue; } r -= I5;
        if (r < I6) { tr_item(F.in[28], 1024, 2048, 0, 64, 2048, (bf16*)(ws + WS_WQ), 0, scr, r, F.lane); continue; } r -= I6;
        if (r < I7) { tr_item<true>(F.in[20], 2048, 256, 0, 8, 256, (bf16*)(ws + WS_CW1K), 0, scr, r, F.lane); continue; } r -= I7;
        if (r < I8) { tr_item<true>(F.in[22], 2048, 256, 0, 8, 256, (bf16*)(ws + WS_CW1V), 0, scr, r, F.lane); continue; } r -= I8;
        if (r < I9) { tr_item(F.in[21], 256, 64, 0, 2, 64, (bf16*)(ws + WS_CW2K), 0, scr, r, F.lane); continue; } r -= I9;
        if (r < I10) { tr_item(F.in[23], 256, 64, 0, 2, 64, (bf16*)(ws + WS_CW2V), 0, scr, r, F.lane); continue; } r -= I10;
        if (r < I11) { tr_item<true>(F.in[5], 64, 512, 0, 16, 512, (bf16*)(ws + WS_WUT), 0, scr, r, F.lane); continue; } r -= I11;
        if (r < I12) { tr_item<true>(F.in[7], 64, 512, 0, 16, 512, (bf16*)(ws + WS_AUT), 0, scr, r, F.lane); continue; } r -= I12;
        tr_item<true>(F.in[8], 128, 512, 0, 16, 512, (bf16*)(ws + WS_GUT), 0, scr, r, F.lane);
    }
    { const int gt = F.vcu * (NWAVES * 64) + F.tid, NT = F.G * NWAVES * 64;
      bf16* s1 = (bf16*)(ws + WS_SK1); bf16* s2 = (bf16*)(ws + WS_SK2);
      for (int i = gt; i < 128 * 128; i += NT) { s1[i] = f2b(F.in[29][i]); s2[i] = f2b(F.in[30][i]); } }
    rms_rows_to_bf16(F.lane, F.in[0], F.in[1], (bf16*)(ws + WS_H), gw, NGW);
}
constexpr int REC_BYTES = 13696;
constexpr int RO_KT = 0, RO_RT = 2048, RO_KB = 4096, RO_VT = 8192, RO_UV = 10240, RO_MM = 12288, RO_GAM = 13312, RO_BON = 13568;
__device__ __forceinline__ void rwkv_prep_tile(const Frame& F, int u) {
    const int tid = F.tid, lane = F.lane, h = F.wave, r16 = lane & 15, q4 = lane >> 4;
    const int R0 = 64 * u, t0 = R0 & (T - 1);
    LAS bf16* linb = (LAS bf16*)(F.lds);
    LAS bf16* mats = (LAS bf16*)(F.lds + 16384) + h * 4096;
    LAS float* abl = (LAS float*)(F.lds + 16384 + 65536) + h * 272;
    LAS bf16* ktT = (LAS bf16*)(F.lds + 16384 + 65536 + 8704) + h * 1024;
    LAS bf16* vtT = (LAS bf16*)(F.lds + 16384 + 65536 + 8704 + 16384) + h * 1024;
    float* PRW = (float*)(F.ws + WS_PRW);
    const float* BND = (const float*)(F.ws + WS_BND);
    bf16* G = (bf16*)((unsigned char*)F.out + DO_G);
    const float* mu = F.in[3];
    const float mu_r = mu[tid], mu_k = mu[512 + tid], mu_v = mu[1024 + tid], mu_l = (tid < 256) ? mu[1536 + tid] : 0.f;
    const float w0c = F.in[4][tid], a0c = F.in[6][tid], kkc = F.in[9][tid], kac = F.in[10][tid], rkc = F.in[11][tid];
    const float* w_up = F.in[5]; const float* a_up = F.in[7]; const float* g_up = F.in[8];
    float pr = 0.f, pk = 0.f, pv = 0.f, pl = 0.f;
    if (t0 != 0) { const float* b = BND + (size_t)(u - 1) * RWC; pr = b[tid]; pk = b[512 + tid]; pv = b[1024 + tid]; if (tid < 256) pl = b[1536 + tid]; }
    for (int batch = 0; batch < 4; ++batch) {
        const int Rb = R0 + 16 * batch;
        if (DBG_SEL == 30 && batch == 0 && blockIdx.x == 0 && tid == 0) F.MISC[20] = (unsigned)__builtin_amdgcn_s_memrealtime();
        float xr[16], xk[16]; unsigned vtw[8];
        if (tid < 256) { float xl[16];
#pragma unroll
            for (int j = 0; j < 16; ++j) xl[j] = PRW[(size_t)(Rb + j) * RWC + 1536 + tid];
#pragma unroll
            for (int j = 0; j < 16; ++j) { const float n = xl[j]; const float v = n + (pl - n) * mu_l; pl = n; const float f = (tid < 64) ? tanh_fast(v) : ((tid < 128) ? v : sigmf(v)); linb[j * 256 + tid] = f2b(f); } }
        { float xv[16];
#pragma unroll
          for (int j = 0; j < 16; ++j) { const float* p = PRW + (size_t)(Rb + j) * RWC; xr[j] = p[tid]; xk[j] = p[512 + tid]; xv[j] = p[1024 + tid]; }
          VM_WAIT();
#pragma unroll
          for (int j = 0; j < 16; ++j) { float n;
              n = xr[j]; xr[j] = n + (pr - n) * mu_r; pr = n;
              n = xk[j]; xk[j] = n + (pk - n) * mu_k; pk = n;
              n = xv[j]; const unsigned vb = f2bf(n + (pv - n) * mu_v); pv = n;
              if (j & 1) vtw[j >> 1] |= vb << 16; else vtw[j >> 1] = vb; } }
        __syncthreads();
        { unsigned char* rec0 = (unsigned char*)(PRW + (size_t)Rb * RWC) + h * REC_BYTES;
          v4u* vp = (v4u*)(rec0 + RO_VT + lane * 32); vp[0] = (v4u){vtw[0], vtw[1], vtw[2], vtw[3]}; vp[1] = (v4u){vtw[4], vtw[5], vtw[6], vtw[7]};
          LAS v4u* vl = (LAS v4u*)(vtT + lane * 16); vl[0] = (v4u){vtw[0], vtw[1], vtw[2], vtw[3]}; vl[1] = (v4u){vtw[4], vtw[5], vtw[6], vtw[7]}; }
        if ((DBG_SEL == 30 || DBG_SEL == 31) && batch == 0 && blockIdx.x == 0 && tid == 0) F.MISC[20 + (DBG_SEL == 30)] = (unsigned)__builtin_amdgcn_s_memrealtime();
        float accw[16], acca[16];
        { const bf16* WUT = (const bf16*)(F.ws + WS_WUT); const bf16* AUT = (const bf16*)(F.ws + WS_AUT); const bf16* GUT = (const bf16*)(F.ws + WS_GUT);
          const f32x4 Z4 = {0.f, 0.f, 0.f, 0.f};
          bf16x8 af[8];
#pragma unroll
          for (int ks = 0; ks < 8; ++ks) af[ks] = as_bf16x8(*(const LAS v4u*)(linb + r16 * 256 + 32 * ks + 8 * q4));
          LAS float* ow = (LAS float*)mats;
#pragma unroll 1
          for (int nt = 0; nt < 4; ++nt) { const int col = 64 * h + 16 * nt + r16;
              f32x4 cw = Z4, ca = Z4, cg = Z4;
              v4u wf[8];
#pragma unroll
              for (int ks = 0; ks < 2; ++ks) { wf[ks] = ((const v4u*)WUT)[((4 * h + nt) * 2 + ks) * 64 + lane]; wf[2 + ks] = ((const v4u*)AUT)[((4 * h + nt) * 2 + ks) * 64 + lane]; }
#pragma unroll
              for (int ks = 0; ks < 4; ++ks) wf[4 + ks] = ((const v4u*)GUT)[((4 * h + nt) * 4 + ks) * 64 + lane];
#pragma unroll
              for (int ks = 0; ks < 2; ++ks) { cw = mfma16(af[ks], as_bf16x8(wf[ks]), cw); ca = mfma16(af[2 + ks], as_bf16x8(wf[2 + ks]), ca); }
#pragma unroll
              for (int ks = 0; ks < 4; ++ks) cg = mfma16(af[4 + ks], as_bf16x8(wf[4 + ks]), cg);
#pragma unroll
              for (int r = 0; r < 4; ++r) { const int tok = 4 * q4 + r; ow[tok * 64 + 16 * nt + r16] = cw[r]; ow[1024 + tok * 64 + 16 * nt + r16] = ca[r]; G[(size_t)(Rb + tok) * 512 + col] = f2b(cg[r]); } }
          LDS_WAIT(); asm volatile("" ::: "memory");
#pragma unroll
          for (int j = 0; j < 16; ++j) { accw[j] = ow[j * 64 + lane]; acca[j] = ow[1024 + j * 64 + lane]; }
          LDS_WAIT(); asm volatile("" ::: "memory"); }
        if ((DBG_SEL == 31 || DBG_SEL == 32) && batch == 0 && blockIdx.x == 0 && tid == 0) F.MISC[20 + (DBG_SEL == 31)] = (unsigned)__builtin_amdgcn_s_memrealtime();
        unsigned char* rec = (unsigned char*)(PRW + (size_t)Rb * RWC) + h * REC_BYTES;
        { float g = 1.f;
          LAS bf16* mp = mats + lane;
#pragma unroll
          for (int j = 0; j < 16; ++j) {
              const float z = -(w0c + accw[j]); const float sp = fmaxf(z, 0.f) + __logf(1.0f + __expf(-fabsf(z)));
              const float wj = __expf(-__expf(-sp - 0.5f));
              const float a = sigmf(a0c + acca[j]);
              const float kkv = xk[j] * kkc; const float kmod = xk[j] * (1.f + (a - 1.f) * kac);
              const float ss = wave_sum(kkv * kkv); const float kkn = kkv * rsqrtf(fmaxf(ss, 1e-24f));
              const float bon = wave_sum(xr[j] * kmod * rkc);
              if (lane == 0) *(float*)(rec + RO_BON + 4 * j) = bon;
              const float gp = g; g *= wj; const float ig = __builtin_amdgcn_rcpf(g);
              const unsigned w1 = pg8::cvt_pk_bf16(kkn * gp, xr[j] * g), w2 = pg8::cvt_pk_bf16(kkn * a * ig, kmod * ig);
              mp[j * 64] = (u16)(w1 & 0xffffu); mp[1024 + j * 64] = (u16)(w1 >> 16); mp[2048 + j * 64] = (u16)(w2 & 0xffffu); mp[3072 + j * 64] = (u16)(w2 >> 16);
              ktT[lane * 16 + j] = (u16)(w1 & 0xffffu);
              __builtin_amdgcn_sched_barrier(0); }
          *(float*)(rec + RO_GAM + 4 * lane) = g;
          }
        LDS_WAIT(); asm volatile("" ::: "memory");
        if (DBG_SEL == 32 && DBG_SUB == 1 && batch == 0 && blockIdx.x == 0 && tid == 0) F.MISC[21] = (unsigned)__builtin_amdgcn_s_memrealtime();
        { unsigned wb[8], wk[8]; const LAS bf16* sb = mats + 2048 + lane; const LAS bf16* sk = mats + 3072 + lane;
#pragma unroll
          for (int jj = 0; jj < 8; ++jj) { wb[jj] = (unsigned)sb[(2 * jj) * 64] | ((unsigned)sb[(2 * jj + 1) * 64] << 16); wk[jj] = (unsigned)sk[(2 * jj) * 64] | ((unsigned)sk[(2 * jj + 1) * 64] << 16); }
          v4u* dst = (v4u*)(rec + RO_KB + lane * 64);
#pragma unroll
          for (int q = 0; q < 4; ++q) dst[q] = (v4u){wk[2 * q], wk[2 * q + 1], wb[2 * q], wb[2 * q + 1]}; }
#pragma unroll
        for (int i = 0; i < 2; ++i) { const int pi = lane + 64 * i, s = pi >> 3, ks = (pi >> 2) & 1, qq = pi & 3;
            const LAS bf16* src = mats + 1024 + s * 64 + 32 * ks + 4 * qq;
            const u32x2 lo = *(const LAS u32x2*)src, hi = *(const LAS u32x2*)(src + 16);
            *(v4u*)(rec + RO_RT + pi * 16) = (v4u){lo.x, lo.y, hi.x, hi.y}; }
        LDS_WAIT(); asm volatile("" ::: "memory");
        if (DBG_SEL == 32 && DBG_SUB == 2 && batch == 0 && blockIdx.x == 0 && tid == 0) F.MISC[21] = (unsigned)__builtin_amdgcn_s_memrealtime();
        { f32x4 Ab = {0.f, 0.f, 0.f, 0.f}, Ak = Ab, Mb = Ab, Mk = Ab;
#pragma unroll
          for (int ks = 0; ks < 2; ++ks) { const int off = r16 * 64 + 32 * ks + 8 * q4;
              const bf16x8 aK = as_bf16x8(*(const LAS v4u*)(mats + off)), aR = as_bf16x8(*(const LAS v4u*)(mats + 1024 + off)), bB = as_bf16x8(*(const LAS v4u*)(mats + 2048 + off)), bK = as_bf16x8(*(const LAS v4u*)(mats + 3072 + off));
              Ab = mfma16(aK, bB, Ab); Ak = mfma16(aK, bK, Ak); Mb = mfma16(aR, bB, Mb); Mk = mfma16(aR, bK, Mk); }
          LDS_WAIT(); asm volatile("" ::: "memory");
          bf16* rMm = (bf16*)(rec + RO_MM);
          LAS bf16* akl = mats + 3072;
#pragma unroll
          for (int r = 0; r < 4; ++r) { const int s = 4 * q4 + r, j = r16; const bool lo = j < s, le = j <= s;
              abl[s * 17 + j] = lo ? Ab[r] : 0.f; akl[s * 16 + j] = f2b(lo ? Ak[r] : 0.f); rMm[(s * 4 + (j >> 2)) * 8 + 4 + (j & 3)] = f2b(le ? Mb[r] : 0.f); rMm[(s * 4 + (j >> 2)) * 8 + (j & 3)] = f2b(le ? Mk[r] : 0.f); }
          }
        LDS_WAIT(); asm volatile("" ::: "memory");
        if (DBG_SEL == 32 && DBG_SUB == 3 && batch == 0 && blockIdx.x == 0 && tid == 0) F.MISC[21] = (unsigned)__builtin_amdgcn_s_memrealtime();
        { float Tr[16]; LAS bf16* ntl = mats + 3072 + 256;
#pragma unroll
          for (int s = 0; s < 16; ++s) { float t = (r16 == s) ? 1.f : 0.f;
#pragma unroll
              for (int j = 0; j < s; ++j) t -= abl[s * 17 + j] * Tr[j];
              Tr[s] = t; if (lane < 16) ntl[s * 16 + r16] = f2b(-t); __builtin_amdgcn_sched_barrier(0); } }
        LDS_WAIT(); asm volatile("" ::: "memory");
        if (DBG_SEL == 32 && DBG_SUB == 4 && batch == 0 && blockIdx.x == 0 && tid == 0) F.MISC[21] = (unsigned)__builtin_amdgcn_s_memrealtime();
        { const f32x4 Z4 = {0.f, 0.f, 0.f, 0.f};
          const bf16x4 ntf = as_bf16x4(*(const LAS u32x2*)(mats + 3072 + 256 + r16 * 16 + 4 * q4)), akf = as_bf16x4(*(const LAS u32x2*)(mats + 3072 + r16 * 16 + 4 * q4));
          bf16* rKt = (bf16*)(rec + RO_KT);
#pragma unroll
          for (int nt = 0; nt < 4; ++nt) {
              const bf16x4 ktf = as_bf16x4(*(const LAS u32x2*)(ktT + (16 * nt + r16) * 16 + 4 * q4)), vtf = as_bf16x4(*(const LAS u32x2*)(vtT + (16 * nt + r16) * 16 + 4 * q4));
              const f32x4 kp = mfma16k16(ntf, ktf, Z4);
              const f32x4 akv = mfma16k16(akf, vtf, Z4);
              const f32x4 uv = mfma16k16(ntf, pack4(akv), Z4);
              const int pos = (nt >> 1) * 32 + (r16 >> 2) * 8 + (nt & 1) * 4 + (r16 & 3);
#pragma unroll
              for (int r = 0; r < 4; ++r) rKt[(4 * q4 + r) * 64 + pos] = f2b(kp[r]);
              *(u32x2*)(rec + RO_UV + ((16 * nt + r16) * 16 + 4 * q4) * 2) = __builtin_bit_cast(u32x2, pack4(uv)); } }
        LDS_WAIT(); asm volatile("" ::: "memory");
        __syncthreads();
        if (DBG_SEL == 32 && DBG_SUB == 0 && batch == 0 && blockIdx.x == 0 && tid == 0) F.MISC[21] = (unsigned)__builtin_amdgcn_s_memrealtime();
    }
}
__device__ __forceinline__ void nsa_prep_tile(const Frame& F, int u) {
    const int lane = F.lane, w = F.wave;
    const int R0 = 64 * u, t0 = R0 & (T - 1), b = R0 / T;
    bf16* PNSA = (bf16*)((unsigned char*)F.out + DO_PNSA);
    const float qg = F.in[14][lane] * (0.125f * LOG2E);
    const float kg = (w < 2) ? F.in[16][lane] : F.in[17][lane];
    const int kcol = ((w < 2) ? 768 : 1024) + (w & 1) * 64 + lane; const int kcl = (w < 4) ? kcol : w * 64 + lane;
    if (DBG_SEL >= 33 && DBG_SEL <= 35 && blockIdx.x == 0 && F.tid == 0) F.MISC[20] = (unsigned)__builtin_amdgcn_s_memrealtime();
#pragma unroll 1
    for (int tg = 0; tg < 2; ++tg) { float qv[32], kv[32];
#pragma unroll
        for (int i = 0; i < 32; ++i) { const bf16* p = PNSA + (size_t)(R0 + 32 * tg + i) * 1280; qv[i] = bf2f(p[w * 64 + lane]); kv[i] = bf2f(p[kcl]); }
#pragma unroll
        for (int i = 0; i < 32; ++i) { bf16* p = PNSA + (size_t)(R0 + 32 * tg + i) * 1280;
            const float ss = wave_sum(qv[i] * qv[i]) * (1.f / 64.f);
            p[w * 64 + lane] = f2b(qv[i] * rsqrtf(ss + NORM_EPS) * qg);
            if (w < 4) { const float ks = wave_sum(kv[i] * kv[i]) * (1.f / 64.f); p[kcol] = f2b(kv[i] * rsqrtf(ks + NORM_EPS) * kg); } } }
    if (DBG_SEL == 33 && blockIdx.x == 0 && F.tid == 0) F.MISC[21] = (unsigned)__builtin_amdgcn_s_memrealtime();
    {
        const bf16* Hb = (const bf16*)(F.ws + WS_H) + (size_t)(R0 + (lane & 15)) * D + 128 * w + 8 * (lane >> 4);
        const bf16* Wg = (const bf16*)(F.ws + WS_WIN) + (size_t)(5120 + (lane & 15)) * D + 128 * w + 8 * (lane >> 4);
        v4u ha[4][4], wb[2][4];
#pragma unroll
        for (int ks = 0; ks < 4; ++ks) {
#pragma unroll
            for (int mt = 0; mt < 4; ++mt) ha[mt][ks] = *(const v4u*)(Hb + (size_t)(16 * mt) * D + 32 * ks);
#pragma unroll
            for (int nt = 0; nt < 2; ++nt) wb[nt][ks] = *(const v4u*)(Wg + (size_t)(16 * nt) * D + 32 * ks); }
        LAS f32x4* red = (LAS f32x4*)F.lds;
#pragma unroll
        for (int mt = 0; mt < 4; ++mt)
#pragma unroll
            for (int nt = 0; nt < 2; ++nt) { f32x4 acc = {0.f, 0.f, 0.f, 0.f};
#pragma unroll
                for (int ks = 0; ks < 4; ++ks) acc = mfma16(as_bf16x8(ha[mt][ks]), as_bf16x8(wb[nt][ks]), acc);
                red[(w * 8 + mt * 2 + nt) * 64 + lane] = acc; }
        __syncthreads();
        { f32x4 acc = red[w * 64 + lane];
#pragma unroll
          for (int ww = 1; ww < 8; ++ww) acc += red[(ww * 8 + w) * 64 + lane];
          float* GLOG = (float*)((unsigned char*)F.out + DO_GLOG);
#pragma unroll
          for (int r = 0; r < 4; ++r) GLOG[(size_t)(R0 + 16 * (w >> 1) + 4 * (lane >> 4) + r) * 32 + 16 * (w & 1) + (lane & 15)] = acc[r]; }
        __syncthreads();
    }
    if (w >= 4) {
        const int g = w & 1; const int scol = ((w < 6) ? 896 : 1152) + g * 64;
        bf16* VT = (bf16*)(F.ws + ((w < 6) ? WS_VST : WS_VWT)) + (size_t)((b * 2 + g) * 64) * T + (size_t)((t0 + lane) >> 5) * 2048 + ((t0 + lane) & 31);
        const v4u* src = (const v4u*)(PNSA + (size_t)(R0 + lane) * 1280 + scol);
        v4u v[8];
#pragma unroll
        for (int i = 0; i < 8; ++i) v[i] = src[i];
#pragma unroll
        for (int i = 0; i < 8; ++i) {
            VT[(8 * i + 0) * 32] = (u16)(v[i].x & 0xffffu); VT[(8 * i + 1) * 32] = (u16)(v[i].x >> 16);
            VT[(8 * i + 2) * 32] = (u16)(v[i].y & 0xffffu); VT[(8 * i + 3) * 32] = (u16)(v[i].y >> 16);
            VT[(8 * i + 4) * 32] = (u16)(v[i].z & 0xffffu); VT[(8 * i + 5) * 32] = (u16)(v[i].z >> 16);
            VT[(8 * i + 6) * 32] = (u16)(v[i].w & 0xffffu); VT[(8 * i + 7) * 32] = (u16)(v[i].w >> 16); }
    }
}
__device__ __forceinline__ float gelu_tanh(float x) { const float t = 0.7978845608028654f * (x + 0.044715f * x * x * x); return 0.5f * x * (1.f + tanh_fast(t)); }
__device__ __forceinline__ void compress_unit(const Frame& F, int u) {
    const int lane = F.lane, w = F.wave, r16 = lane & 15, q4 = lane >> 4;
    const int kvsel = u >> 7, b = (u >> 5) & 3, g = (u >> 4) & 1, ntile = u & 15;
    const bf16* X = (const bf16*)((unsigned char*)F.out + DO_PNSA) + (size_t)(b * T) * 1280 + (kvsel ? 640 : 512) + g * 64;
    const float* pos = kvsel ? F.in[19] : F.in[18];
    const bf16* W1t = (const bf16*)(F.ws + (kvsel ? WS_CW1V : WS_CW1K));
    const bf16* W2t = (const bf16*)(F.ws + (kvsel ? WS_CW2V : WS_CW2K));
    LAS bf16* hid = (LAS bf16*)(F.lds);
    LAS float* outb = (LAS float*)(F.lds + 16 * 528);
    int n = 16 * ntile + r16; if (n > 254) n = 254;
    f32x4 acc[2] = {{0.f, 0.f, 0.f, 0.f}, {0.f, 0.f, 0.f, 0.f}};
    LAS v4u* afl = (LAS v4u*)(F.lds + 16384);
    { v4u xa[8]; f32x4 p0[8], p1[8];
#pragma unroll
      for (int i = 0; i < 8; ++i) { const int s = 8 * w + i, lp = s >> 1, d0 = (s & 1) * 32 + 8 * q4;
          xa[i] = *(const v4u*)(X + (size_t)(16 * n + lp) * 1280 + d0); p0[i] = *(const f32x4*)(pos + lp * 64 + d0); p1[i] = *(const f32x4*)(pos + lp * 64 + d0 + 4); }
#pragma unroll
      for (int i = 0; i < 8; ++i) { v4u af; af.x = pk2(bflo(xa[i].x) + p0[i][0], bfhi(xa[i].x) + p0[i][1]); af.y = pk2(bflo(xa[i].y) + p0[i][2], bfhi(xa[i].y) + p0[i][3]);
          af.z = pk2(bflo(xa[i].z) + p1[i][0], bfhi(xa[i].z) + p1[i][1]); af.w = pk2(bflo(xa[i].w) + p1[i][2], bfhi(xa[i].w) + p1[i][3]);
          afl[(8 * w + i) * 64 + lane] = af; } }
    __syncthreads();
    const v4u* W1f = (const v4u*)W1t + lane;
#define CMP_LOAD(dst_, s0_) do { _Pragma("unroll") for (int i = 0; i < 8; ++i) { _Pragma("unroll") for (int nt = 0; nt < 2; ++nt) dst_[i][nt] = W1f[(size_t)((2 * w + nt) * 64 + (s0_) + i) * 64]; } } while (0)
#define CMP_MMA(src_, s0_) do { _Pragma("unroll") for (int i = 0; i < 8; ++i) { const v4u af = afl[((s0_) + i) * 64 + lane]; _Pragma("unroll") for (int nt = 0; nt < 2; ++nt) acc[nt] = mfma16(as_bf16x8(af), as_bf16x8(src_[i][nt]), acc[nt]); } } while (0)
    { v4u bA[8][2], bB[8][2];
      CMP_LOAD(bA, 0);
#pragma unroll 1
      for (int s0 = 0; s0 < 64; s0 += 16) { CMP_LOAD(bB, s0 + 8); CMP_MMA(bA, s0); if (s0 + 16 < 64) CMP_LOAD(bA, s0 + 16); CMP_MMA(bB, s0 + 8); } }
#pragma unroll
    for (int nt = 0; nt < 2; ++nt)
#pragma unroll
        for (int r = 0; r < 4; ++r) hid[(4 * q4 + r) * 264 + 32 * w + 16 * nt + r16] = f2b(gelu_tanh(acc[nt][r]));
    __syncthreads();
    if (w < 4) { f32x4 a2 = {0.f, 0.f, 0.f, 0.f};
#pragma unroll
        for (int s = 0; s < 8; ++s) { const v4u af = *(const LAS v4u*)(hid + r16 * 264 + 32 * s + 8 * q4);
            const v4u bfg = *(const v4u*)(W2t + (size_t)(16 * w + r16) * 256 + 32 * s + 8 * q4);
            a2 = mfma16(as_bf16x8(af), as_bf16x8(bfg), a2); }
#pragma unroll
        for (int r = 0; r < 4; ++r) outb[(4 * q4 + r) * 64 + 16 * w + r16] = a2[r]; }
    __syncthreads();
#pragma unroll
    for (int rr = 0; rr < 2; ++rr) { const int row = 2 * w + rr; const int nn = 16 * ntile + row; float val = outb[row * 64 + lane];
        if (kvsel == 0) { const float ss = wave_sum(val * val) * (1.f / 64.f); val = val * rsqrtf(ss + NORM_EPS) * F.in[15][lane];
            ((bf16*)(F.ws + WS_KC))[(size_t)((b * 2 + g) * 256 + nn) * 64 + lane] = (nn < 255) ? f2b(val) : (u16)0; }
        else ((bf16*)(F.ws + WS_VCT))[(size_t)((b * 2 + g) * 64 + lane) * 256 + nn] = (nn < 255) ? f2b(val) : (u16)0; }
    __syncthreads();
}
__device__ __forceinline__ bf16x8 pack_p(const f32x4 a, const f32x4 b) {
    v4u w; w.x = pg8::cvt_pk_bf16(a[0], a[1]); w.y = pg8::cvt_pk_bf16(a[2], a[3]); w.z = pg8::cvt_pk_bf16(b[0], b[1]); w.w = pg8::cvt_pk_bf16(b[2], b[3]); return as_bf16x8(w);
}
#define NSA_FENCE() asm volatile("s_waitcnt lgkmcnt(0)" ::: "memory")
struct KFr { bf16x8 a0, a1, b0, b1; };
struct VFr { bf16x8 v[4]; };
__device__ __forceinline__ KFr lds_k(const LAS unsigned char* ks, int r16, int q4) {
    const int rA = 8 * (r16 >> 2) + (r16 & 3), rB = rA + 4; const int xA = ((rA >> 1) & 1) | (((rA >> 3) & 3) << 1), xB = xA;
    KFr f; f.a0 = as_bf16x8(*(const LAS v4u*)(ks + rA * 128 + ((q4 ^ xA) << 4))); f.a1 = as_bf16x8(*(const LAS v4u*)(ks + rA * 128 + (((4 + q4) ^ xA) << 4)));
    f.b0 = as_bf16x8(*(const LAS v4u*)(ks + rB * 128 + ((q4 ^ xB) << 4))); f.b1 = as_bf16x8(*(const LAS v4u*)(ks + rB * 128 + (((4 + q4) ^ xB) << 4))); return f;
}
__device__ __forceinline__ VFr lds_v(const LAS unsigned char* vs, int r16, int q4) {
    VFr f;
#pragma unroll
    for (int dt = 0; dt < 4; ++dt) { const int d = 16 * dt + r16; f.v[dt] = as_bf16x8(*(const LAS v4u*)(vs + d * 64 + ((q4 ^ (((d >> 3) & 1) * 3)) << 4))); }
    return f;
}
struct NsaSrc { const bf16* kb; int krs; const bf16* vb; int vrs; int vtiled; };
__device__ __forceinline__ v4u nsa_stage_load(const NsaSrc& S, int k0, int tid) {
    if (tid < 256) return *(const v4u*)(S.kb + (size_t)(k0 + (tid >> 3)) * S.krs + 8 * (tid & 7));
    const int i = tid - 256, d = i >> 2, c = i & 3;
    return S.vtiled ? *(const v4u*)(S.vb + (size_t)(k0 >> 5) * 2048 + d * 32 + 8 * c) : *(const v4u*)(S.vb + (size_t)d * S.vrs + k0 + 8 * c);
}
__device__ __forceinline__ void nsa_stage_write(LAS unsigned char* lds, int slot, int tid, const v4u v) {
    if (tid < 256) { const int r = tid >> 3, c = tid & 7; *(LAS v4u*)(lds + slot * 4096 + r * 128 + ((c ^ (((r >> 1) & 1) | (((r >> 3) & 3) << 1))) << 4)) = v; }
    else { const int i = tid - 256, d = i >> 2, c = i & 3; *(LAS v4u*)(lds + 8192 + slot * 4096 + d * 64 + ((c ^ (((d >> 3) & 1) * 3)) << 4)) = v; }
}
__device__ __forceinline__ void nsa_stage_write2(LAS unsigned char* lds, int slot, int hf, int tid, const v4u v) {
    if (tid < 256) { const int r = tid >> 3, c = tid & 7; *(LAS v4u*)(lds + slot * 8192 + hf * 4096 + r * 128 + ((c ^ (((r >> 1) & 1) | (((r >> 3) & 3) << 1))) << 4)) = v; }
    else { const int i = tid - 256, d = i >> 2, c = i & 3; *(LAS v4u*)(lds + 16384 + slot * 8192 + hf * 4096 + d * 64 + ((c ^ (((d >> 3) & 1) * 3)) << 4)) = v; }
}
__device__ __forceinline__ void nsa_stage_dma(LAS unsigned char* lds, const NsaSrc& S, int k0, int slot, int w, int lane) {
    { const int row = 8 * w + (lane >> 3), rr = row & 31, c = (lane & 7) ^ (((rr >> 1) & 1) | (((rr >> 3) & 3) << 1));
      __builtin_amdgcn_global_load_lds((const unsigned*)(S.kb + (size_t)(k0 + row) * S.krs + 8 * c), (LAS unsigned*)(lds + slot * 8192 + w * 1024), 16, 0, 0); }
    { const int hf = w >> 2, d = 16 * (w & 3) + (lane >> 2), c = (lane & 3) ^ (((d >> 3) & 1) * 3);
      __builtin_amdgcn_global_load_lds((const unsigned*)(S.vb + (size_t)((k0 >> 5) + hf) * 2048 + d * 32 + 8 * c), (LAS unsigned*)(lds + 16384 + slot * 8192 + hf * 4096 + (w & 3) * 1024), 16, 0, 0); }
}
__device__ __forceinline__ void nsa_block_unit(const Frame& F, int b, int g, int T0, int skip) {
    const int lane = F.lane, tid = F.tid, w = F.wave, r16 = lane & 15, q4 = lane >> 4;
    const int t0 = T0 + 8 * w;
    const f32x4 Z4 = {0.f, 0.f, 0.f, 0.f};
    const bf16x8 ones8 = {0x3F80, 0x3F80, 0x3F80, 0x3F80, 0x3F80, 0x3F80, 0x3F80, 0x3F80};
    LAS unsigned char* lds = F.lds;
    LAS float* wl = (LAS float*)(lds + 16384 + w * 5120);
    LAS float* impT = wl; LAS float* imp2T = wl + 8 * 65; LAS unsigned* selT = (LAS unsigned*)(wl + 16 * 65);
    LAS unsigned* bw = (LAS unsigned*)(lds + 57344); LAS int* stl = (LAS int*)(lds + 57344 + 128);
    const bf16* PN = (const bf16*)((unsigned char*)F.out + DO_PNSA) + (size_t)(b * T) * 1280;
    const float* GL = (const float*)((unsigned char*)F.out + DO_GLOG) + (size_t)(b * T) * 32;
    bf16x8 qf[2][2]; int tq[2];
#pragma unroll
    for (int mt = 0; mt < 2; ++mt) { tq[mt] = t0 + 4 * mt + (r16 >> 2);
#pragma unroll
        for (int dh = 0; dh < 2; ++dh) qf[mt][dh] = as_bf16x8(*(const v4u*)(PN + (size_t)tq[mt] * 1280 + (g * 4 + (r16 & 3)) * 64 + 32 * dh + 8 * q4)); }
    LAS f32x4* ocl = (LAS f32x4*)(lds + 65536 + w * 8192) + lane;
#define NSA_GATE(mt_, r_, br_) sigmf(GL[(size_t)(t0 + 4 * (mt_) + q4) * 32 + g * 12 + (r_) * 3 + (br_)])
#define NSA_PIPE_BEGIN(S_, n_, K0_OF) { v4u st = nsa_stage_load(S_, K0_OF(0), tid); nsa_stage_write(lds, 0, tid, st); if ((n_) > 1) st = nsa_stage_load(S_, K0_OF(1), tid); __syncthreads(); \
        for (int i = 0; i < (n_); ++i) { const int k0 = K0_OF(i); const LAS unsigned char* ks = lds + (i & 1) * 4096; const LAS unsigned char* vs = lds + 8192 + (i & 1) * 4096;
#define NSA_PIPE_END(S_, n_, K0_OF) if (i + 1 < (n_)) nsa_stage_write(lds, (i + 1) & 1, tid, st); if (i + 2 < (n_)) st = nsa_stage_load(S_, K0_OF(i + 2), tid); __syncthreads(); } }

    if (DBG_SEL >= 36 && DBG_SEL <= 36 && blockIdx.x == DBG_BLK && tid == 0 && F.MISC[22] == 0u) F.MISC[20] = (unsigned)__builtin_amdgcn_s_memrealtime();
    for (int i = lane; i < 16 * 65; i += 64) wl[i] = 0.f;
    const NsaSrc SC{(const bf16*)(F.ws + WS_KC) + (size_t)((b * 2 + g) * 256) * 64, 64, (const bf16*)(F.ws + WS_VCT) + (size_t)((b * 2 + g) * 64) * 256, 256, 0};
    const int ncb = (T0 + 63 >= 31) ? ((T0 + 63 - 31) >> 4) + 1 : 0; const int nstB = (skip & 1) ? 0 : ((ncb + 31) >> 5);
    const int ncw = (t0 + 7 >= 31) ? ((t0 + 7 - 31) >> 4) + 1 : 0; const int nstW = (skip & 1) ? 0 : ((ncw + 31) >> 5);
    float inv[2] = {0.f, 0.f};
#define K0_LIN(i_) (32 * (i_))
    if (nstB > 0) { float ls[2] = {0.f, 0.f};
        NSA_PIPE_BEGIN(SC, nstB, K0_LIN)
            if (i < nstW) { const KFr kf = lds_k(ks, r16, q4); const bool cslow = 16 * (k0 + 31) + 31 > t0;
#pragma unroll
                for (int mt = 0; mt < 2; ++mt) { f32x4 bA = Z4, bB = Z4;
                    if (cslow) {
#pragma unroll
                        for (int r = 0; r < 4; ++r) { const int nA = k0 + 8 * q4 + r, nB = nA + 4; bA[r] = (16 * nA + 31 <= tq[mt]) ? 0.f : -1e30f; bB[r] = (16 * nB + 31 <= tq[mt]) ? 0.f : -1e30f; } }
                    f32x4 sA = mfma16(kf.a0, qf[mt][0], bA); sA = mfma16(kf.a1, qf[mt][1], sA); f32x4 sB = mfma16(kf.b0, qf[mt][0], bB); sB = mfma16(kf.b1, qf[mt][1], sB);
#pragma unroll
                    for (int r = 0; r < 4; ++r) { ls[mt] += __builtin_amdgcn_exp2f(sA[r]); ls[mt] += __builtin_amdgcn_exp2f(sB[r]); } } }
        NSA_PIPE_END(SC, nstB, K0_LIN)
#pragma unroll
        for (int mt = 0; mt < 2; ++mt) { float l = ls[mt]; l += __shfl_xor(l, 16); l += __shfl_xor(l, 32); inv[mt] = 1.0f / fmaxf(l, 1e-30f); }
    }
    if (nstB > 0) { f32x4 O[2][4];
#pragma unroll
        for (int mt = 0; mt < 2; ++mt)
#pragma unroll
            for (int dt = 0; dt < 4; ++dt) O[mt][dt] = Z4;
        NSA_PIPE_BEGIN(SC, nstB, K0_LIN)
            if (i < nstW) { const KFr kf = lds_k(ks, r16, q4); const VFr vf = lds_v(vs, r16, q4); const bool cslow = 16 * (k0 + 31) + 31 > t0;
#pragma unroll
                for (int mt = 0; mt < 2; ++mt) { f32x4 bA = Z4, bB = Z4;
                    if (cslow) {
#pragma unroll
                        for (int r = 0; r < 4; ++r) { const int nA = k0 + 8 * q4 + r, nB = nA + 4; bA[r] = (16 * nA + 31 <= tq[mt]) ? 0.f : -1e30f; bB[r] = (16 * nB + 31 <= tq[mt]) ? 0.f : -1e30f; } }
                    f32x4 sA = mfma16(kf.a0, qf[mt][0], bA); sA = mfma16(kf.a1, qf[mt][1], sA); f32x4 sB = mfma16(kf.b0, qf[mt][0], bB); sB = mfma16(kf.b1, qf[mt][1], sB);
                    f32x4 pA, pB;
#pragma unroll
                    for (int r = 0; r < 4; ++r) { pA[r] = __builtin_amdgcn_exp2f(sA[r]) * inv[mt]; pB[r] = __builtin_amdgcn_exp2f(sB[r]) * inv[mt]; }
                    float vA = pA[0] + pA[1] + pA[2] + 0.5f * pA[3], cA = 0.5f * pA[3], vB = pB[0] + pB[1] + pB[2] + 0.5f * pB[3], cB = 0.5f * pB[3];
                    vA += __shfl_xor(vA, 1); vA += __shfl_xor(vA, 2); cA += __shfl_xor(cA, 1); cA += __shfl_xor(cA, 2);
                    vB += __shfl_xor(vB, 1); vB += __shfl_xor(vB, 2); cB += __shfl_xor(cB, 1); cB += __shfl_xor(cB, 2);
                    if ((lane & 3) == 0) { const int tl = 4 * mt + (r16 >> 2), j = (k0 >> 2) + 2 * q4;
                        impT[tl * 65 + j] = vA; imp2T[tl * 65 + j + 1] = cA; impT[tl * 65 + j + 1] = vB; imp2T[tl * 65 + j + 2] = cB; }
                    const bf16x8 pf = pack_p(pA, pB);
#pragma unroll
                    for (int dt = 0; dt < 4; ++dt) O[mt][dt] = mfma16(pf, vf.v[dt], O[mt][dt]); } }
        NSA_PIPE_END(SC, nstB, K0_LIN)
#pragma unroll
        for (int mt = 0; mt < 2; ++mt)
#pragma unroll
            for (int r = 0; r < 4; ++r) { const float gt = NSA_GATE(mt, r, 0);
#pragma unroll
                for (int dt = 0; dt < 4; ++dt) O[mt][dt][r] *= gt; }
#pragma unroll
        for (int mt = 0; mt < 2; ++mt)
#pragma unroll
            for (int dt = 0; dt < 4; ++dt) ocl[(mt * 4 + dt) * 64] = O[mt][dt];
    } else {
#pragma unroll
        for (int i = 0; i < 8; ++i) ocl[i * 64] = Z4;
    }
    NSA_FENCE();
    if (DBG_SEL >= 36 && DBG_SEL <= 36 && blockIdx.x == DBG_BLK && tid == 0 && F.MISC[22] == 0u) F.MISC[21] = (unsigned)__builtin_amdgcn_s_memrealtime();
    if (DBG_SEL >= 37 && DBG_SEL <= 37 && blockIdx.x == DBG_BLK && tid == 0 && F.MISC[22] == 0u) F.MISC[20] = (unsigned)__builtin_amdgcn_s_memrealtime();
    const int cur = T0 >> 6;
    unsigned long long uni = 0ull;
    if (cur < 16 || (skip & 2)) { const unsigned long long mask = (cur < 16) ? ((2ull << cur) - 1ull) : (0xFFFFull | (1ull << cur) | (1ull << (cur - 1)));
        uni = mask;
        if (lane < 8) { selT[2 * lane] = (unsigned)mask; selT[2 * lane + 1] = (unsigned)(mask >> 32); } }
    else {
        const bool elig = (lane <= cur) && (lane != 0) && (lane != cur) && (lane != cur - 1);
        unsigned key[8], prefix[8];
#pragma unroll
        for (int tl = 0; tl < 8; ++tl) { key[tl] = __float_as_uint(fmaxf(impT[tl * 65 + lane] + imp2T[tl * 65 + lane], 0.f)); prefix[tl] = 0u; }
        const unsigned long long em = __builtin_amdgcn_ballot_w64(elig);
#pragma unroll 1
        for (int bit = 30; bit >= 0; --bit) {
#pragma unroll
            for (int tl = 0; tl < 8; ++tl) { const unsigned cand = prefix[tl] | (1u << bit);
                const unsigned long long mm = __builtin_amdgcn_ballot_w64(key[tl] >= cand) & em;
                const int cnt = __builtin_popcount((unsigned)mm) + __builtin_popcount((unsigned)(mm >> 32)); prefix[tl] = (unsigned)__builtin_amdgcn_readfirstlane((int)((cnt >= 13) ? cand : prefix[tl])); } }
#pragma unroll
        for (int tl = 0; tl < 8; ++tl) {
            const unsigned long long gt = __ballot(elig && key[tl] > prefix[tl]); unsigned long long ties = __ballot(elig && key[tl] == prefix[tl]);
            int need = 13 - __popcll(gt); unsigned long long keep = 0ull;
            while (need > 0 && ties) { const unsigned long long low = ties & (0ull - ties); keep |= low; ties ^= low; --need; }
            const unsigned long long mask = gt | keep | 1ull | (1ull << cur) | (1ull << (cur - 1));
            uni |= mask;
            if (lane == 0) { selT[2 * tl] = (unsigned)mask; selT[2 * tl + 1] = (unsigned)(mask >> 32); } }
    }
    if (DBG_SEL >= 37 && DBG_SEL <= 37 && blockIdx.x == DBG_BLK && tid == 0 && F.MISC[22] == 0u) F.MISC[21] = (unsigned)__builtin_amdgcn_s_memrealtime();
    if (lane == 0) { bw[2 + 2 * w] = (unsigned)uni; bw[3 + 2 * w] = (unsigned)(uni >> 32); }
    NSA_FENCE();
    unsigned long long mk[2];
#pragma unroll
    for (int mt = 0; mt < 2; ++mt) { const int tl = 4 * mt + (r16 >> 2); mk[mt] = (unsigned long long)selT[2 * tl] | ((unsigned long long)selT[2 * tl + 1] << 32); }
    __syncthreads();
    unsigned long long buni = 0ull;
#pragma unroll
    for (int ww = 0; ww < 8; ++ww) buni |= (unsigned long long)bw[2 + 2 * ww] | ((unsigned long long)bw[3 + 2 * ww] << 32);

#define K0_LIST(i_) (__builtin_amdgcn_readfirstlane(stl[(i_)]))
#define NSA_W2(slot_, a_, b_) do { nsa_stage_write2(lds, (slot_), 0, tid, (a_)); nsa_stage_write2(lds, (slot_), 1, tid, (b_)); } while (0)
#pragma unroll 1
    for (int br = 1; br < 3; ++br) { if ((skip >> (br + 1)) & 1) continue;
        const NsaSrc SB{PN + (br == 1 ? 768 : 1024) + g * 64, 1280, (const bf16*)(F.ws + (br == 1 ? WS_VST : WS_VWT)) + (size_t)((b * 2 + g) * 64) * T, 0, 1};
        f32x4 O[2][4], L5[2] = {Z4, Z4};
#pragma unroll
        for (int mt = 0; mt < 2; ++mt)
#pragma unroll
            for (int dt = 0; dt < 4; ++dt) O[mt][dt] = Z4;
        if (DBG_SEL == 37 + br && blockIdx.x == DBG_BLK && tid == 0 && F.MISC[22] == 0u) F.MISC[20] = (unsigned)__builtin_amdgcn_s_memrealtime();
        int nsteps;
        if (br == 1) { nsteps = __popcll(buni);
            if (w == 0 && ((buni >> lane) & 1ull)) { const int rk = __popcll(buni & ((1ull << lane) - 1ull)); stl[rk] = 64 * lane; } }
        else { const int lo = T0 - 511; const int klo = (lo > 0 ? lo : 0) & ~63; nsteps = ((T0 + 64 - klo) + 63) >> 6; if (w == 0 && lane < nsteps) stl[lane] = klo + 64 * lane; }
        __syncthreads();
        { nsa_stage_dma(lds, SB, K0_LIST(0), 0, w, lane); asm volatile("s_waitcnt vmcnt(0)" ::: "memory");
          __syncthreads();
          for (int i = 0; i < nsteps; ++i) { const int k0 = K0_LIST(i); const int j = k0 >> 6;
            if (i + 1 < nsteps) nsa_stage_dma(lds, SB, K0_LIST(i + 1), (i + 1) & 1, w, lane);
            const bool mine = (br == 1) ? (((uni >> j) & 1ull) != 0ull) : (k0 + 63 >= t0 - 511 && k0 <= t0 + 7);
            if (mine) {
                float b0 = 0.f, b1 = 0.f;
                if (br == 1) { const bool s0 = ((mk[0] >> j) & 1ull) != 0ull, s1 = ((mk[1] >> j) & 1ull) != 0ull; b0 = s0 ? 0.f : -1e30f; b1 = s1 ? 0.f : -1e30f; }
                const bool fast = (br == 1) ? (j != cur) : (k0 >= t0 - 504 && k0 + 63 <= t0);
#define NSA_S(mt_, cA_, cB_, sA_, sB_) f32x4 sA_ = mfma16(kf.a0, qf[mt_][0], cA_); f32x4 sB_ = mfma16(kf.b0, qf[mt_][0], cB_); sA_ = mfma16(kf.a1, qf[mt_][1], sA_); sB_ = mfma16(kf.b1, qf[mt_][1], sB_);
#define NSA_E(sA_, sB_, pf_) bf16x8 pf_; { f32x4 pA, pB; _Pragma("unroll") for (int r = 0; r < 4; ++r) { pA[r] = __builtin_amdgcn_exp2f(sA_[r]); pB[r] = __builtin_amdgcn_exp2f(sB_[r]); } pf_ = pack_p(pA, pB); }
#define NSA_P(mt_, pf_) { _Pragma("unroll") for (int dt = 0; dt < 4; ++dt) O[mt_][dt] = mfma16(pf_, vf.v[dt], O[mt_][dt]); L5[mt_] = mfma16(pf_, ones8, L5[mt_]); }
                if (fast) {
                    const LAS unsigned char* ks0 = lds + (i & 1) * 8192; const LAS unsigned char* vs0 = lds + 16384 + (i & 1) * 8192;
                    const KFr kfa = lds_k(ks0, r16, q4); const VFr vfa = lds_v(vs0, r16, q4); const KFr kfb = lds_k(ks0 + 4096, r16, q4);
                    const f32x4 c0 = {b0, b0, b0, b0}, c1 = {b1, b1, b1, b1};
                    { const KFr& kf = kfa; const VFr& vf = vfa; NSA_S(0, c0, c0, sA0, sB0) NSA_S(1, c1, c1, sA1, sB1) NSA_E(sA0, sB0, pf0) NSA_P(0, pf0) NSA_E(sA1, sB1, pf1) NSA_P(1, pf1) }
                    const VFr vfb = lds_v(vs0 + 4096, r16, q4);
                    { const KFr& kf = kfb; const VFr& vf = vfb; NSA_S(0, c0, c0, sA0, sB0) NSA_S(1, c1, c1, sA1, sB1) NSA_E(sA0, sB0, pf0) NSA_P(0, pf0) NSA_E(sA1, sB1, pf1) NSA_P(1, pf1) }
                } else {
#pragma unroll
                for (int hf = 0; hf < 2; ++hf) { const int kk = k0 + 32 * hf;
                    if (br == 2 && (kk + 31 < t0 - 511 || kk > t0 + 7)) continue;
                    const LAS unsigned char* ks = lds + (i & 1) * 8192 + hf * 4096; const LAS unsigned char* vs = lds + 16384 + (i & 1) * 8192 + hf * 4096;
                    const KFr kf = lds_k(ks, r16, q4); const VFr vf = lds_v(vs, r16, q4);
                    const bool slow = (br == 1) ? (j == cur) : (kk < t0 - 504 || kk + 31 > t0);
                    f32x4 cA0 = {b0, b0, b0, b0}, cB0 = cA0, cA1 = {b1, b1, b1, b1}, cB1 = cA1;
                    if (slow) {
#pragma unroll
                        for (int r = 0; r < 4; ++r) { const int kA = kk + 8 * q4 + r, kB = kA + 4;
                            const bool mA0 = (kA <= tq[0]) && (br == 1 || kA + 512 > tq[0]), mB0 = (kB <= tq[0]) && (br == 1 || kB + 512 > tq[0]);
                            const bool mA1 = (kA <= tq[1]) && (br == 1 || kA + 512 > tq[1]), mB1 = (kB <= tq[1]) && (br == 1 || kB + 512 > tq[1]);
                            cA0[r] = mA0 ? cA0[r] : -1e30f; cB0[r] = mB0 ? cB0[r] : -1e30f; cA1[r] = mA1 ? cA1[r] : -1e30f; cB1[r] = mB1 ? cB1[r] : -1e30f; } }
                    { NSA_S(0, cA0, cB0, sA0, sB0) NSA_S(1, cA1, cB1, sA1, sB1) NSA_E(sA0, sB0, pf0) NSA_P(0, pf0) NSA_E(sA1, sB1, pf1) NSA_P(1, pf1) } }
            }
            }
            asm volatile("s_waitcnt vmcnt(0)" ::: "memory");
            __syncthreads(); } }
#pragma unroll
        for (int mt = 0; mt < 2; ++mt)
#pragma unroll
            for (int r = 0; r < 4; ++r) { const float ilr = __builtin_amdgcn_rcpf(fmaxf(L5[mt][r], 1e-30f)) * NSA_GATE(mt, r, br);
#pragma unroll
                for (int dt = 0; dt < 4; ++dt) O[mt][dt][r] *= ilr; }
#pragma unroll
        for (int mt = 0; mt < 2; ++mt)
#pragma unroll
            for (int dt = 0; dt < 4; ++dt) ocl[(mt * 4 + dt) * 64] += O[mt][dt];
        if (DBG_SEL == 37 + br && blockIdx.x == DBG_BLK && tid == 0 && F.MISC[22] == 0u) F.MISC[21] = (unsigned)__builtin_amdgcn_s_memrealtime();
    }
    if (!skip) { bf16* YB = (bf16*)(F.ws + WS_H + 16 * MiB) + (size_t)(b * T) * 512;
#pragma unroll
        for (int mt = 0; mt < 2; ++mt)
#pragma unroll
            for (int r = 0; r < 4; ++r)
#pragma unroll
                for (int dt = 0; dt < 4; ++dt) YB[(size_t)(t0 + 4 * mt + q4) * 512 + (g * 4 + r) * 64 + 16 * dt + r16] = f2b(ocl[(mt * 4 + dt) * 64][r]); }
    if (DBG_SEL >= 36 && DBG_SEL <= 39 && blockIdx.x == DBG_BLK && tid == 0) F.MISC[22] = 1u;
    __syncthreads();
}
__device__ __forceinline__ void nsa_phase(const Frame& F, int rep) {
    LAS unsigned* bw = (LAS unsigned*)(F.lds + 57344);
    const int q0 = (int)(xb_xcc_id() & 7u);
    for (int qi = 0; qi < 8; ++qi) { const int q = (q0 + qi) & 7;
        for (;;) {
            if (F.tid == 0) bw[0] = __hip_atomic_fetch_add(F.ctl + CW_NSAQ + 64 * (8 * rep + q), 1u, RLX_AGENT);
            __syncthreads();
            const unsigned c = bw[0];
            __syncthreads();
            if (c >= 64u) break;
            nsa_block_unit(F, q >> 1, q & 1, 64 * (63 - (int)c), rep ? NSA_SKIP : 0);
        }
    }
}
__device__ __forceinline__ f32x4 unpk4(const u32x2 w) { f32x4 r; r[0] = bflo(w.x); r[1] = bfhi(w.x); r[2] = bflo(w.y); r[3] = bfhi(w.y); return r; }
struct ChunkIn { v4u kt0, kt1, rt0, rt1, mm, kb[4]; u32x2 uv, vt; f32x4 gam[4]; };
__device__ __forceinline__ void scan_load(ChunkIn& c, const unsigned char* rec, int vq, int r16, int q4) {
    c.kt0 = *(const v4u*)(rec + (r16 * 64 + q4 * 8) * 2); c.kt1 = *(const v4u*)(rec + (r16 * 64 + 32 + q4 * 8) * 2);
    c.rt0 = *(const v4u*)(rec + RO_RT + (r16 * 64 + q4 * 8) * 2); c.rt1 = *(const v4u*)(rec + RO_RT + (r16 * 64 + 32 + q4 * 8) * 2);
#pragma unroll
    for (int mt = 0; mt < 4; ++mt) { c.kb[mt] = *(const v4u*)(rec + RO_KB + ((16 * mt + r16) * 4 + q4) * 16);
        c.gam[mt] = *(const f32x4*)(rec + RO_GAM + (16 * mt + 4 * q4) * 4); }
    c.vt = *(const u32x2*)(rec + RO_VT + ((16 * vq + r16) * 16 + 4 * q4) * 2); c.uv = *(const u32x2*)(rec + RO_UV + ((16 * vq + r16) * 16 + 4 * q4) * 2);
    c.mm = *(const v4u*)(rec + RO_MM + (r16 * 4 + q4) * 16);
}
__device__ __forceinline__ void scan_chunk(const ChunkIn& cur, f32x4 (&Zt)[4], bf16* Y, int ch, int q4) {
    const f32x4 Z4 = {0.f, 0.f, 0.f, 0.f};
    const bf16x8 zb0 = pack_p(Zt[0], Zt[1]), zb1 = pack_p(Zt[2], Zt[3]);
    f32x4 U = mfma16(as_bf16x8(cur.kt0), zb0, unpk4(cur.uv)); U = mfma16(as_bf16x8(cur.kt1), zb1, U);
    f32x4 Yc = mfma16(as_bf16x8(cur.rt0), zb0, Z4); Yc = mfma16(as_bf16x8(cur.rt1), zb1, Yc);
    v4u vu; vu.x = cur.vt.x; vu.y = cur.vt.y; vu.z = pg8::cvt_pk_bf16(U[0], U[1]); vu.w = pg8::cvt_pk_bf16(U[2], U[3]);
    const bf16x8 vub = as_bf16x8(vu);
    Yc = mfma16(as_bf16x8(cur.mm), vub, Yc);
#pragma unroll
    for (int mt = 0; mt < 4; ++mt) { const f32x4 acc = mfma16(as_bf16x8(cur.kb[mt]), vub, Zt[mt]); Zt[mt] = acc * cur.gam[mt]; }
#pragma unroll
    for (int r = 0; r < 4; ++r) Y[(size_t)(16 * ch + 4 * q4 + r) * 512] = f2b(Yc[r]);
}
constexpr int SR_SLOTS = 8, SR_SLOT_BYTES = 13824, SR_PIECES = REC_BYTES / 16 / 4;
__device__ __forceinline__ void scan_lds_load(ChunkIn& c, const LAS unsigned char* rec, int vq, int r16, int q4) {
    c.kt0 = *(const LAS v4u*)(rec + (r16 * 64 + q4 * 8) * 2); c.kt1 = *(const LAS v4u*)(rec + (r16 * 64 + 32 + q4 * 8) * 2);
    c.rt0 = *(const LAS v4u*)(rec + RO_RT + (r16 * 64 + q4 * 8) * 2); c.rt1 = *(const LAS v4u*)(rec + RO_RT + (r16 * 64 + 32 + q4 * 8) * 2);
#pragma unroll
    for (int mt = 0; mt < 4; ++mt) { c.kb[mt] = *(const LAS v4u*)(rec + RO_KB + ((16 * mt + r16) * 4 + q4) * 16);
        c.gam[mt] = *(const LAS f32x4*)(rec + RO_GAM + (16 * mt + 4 * q4) * 4); }
    c.vt = *(const LAS u32x2*)(rec + RO_VT + ((16 * vq + r16) * 16 + 4 * q4) * 2); c.uv = *(const LAS u32x2*)(rec + RO_UV + ((16 * vq + r16) * 16 + 4 * q4) * 2);
    c.mm = *(const LAS v4u*)(rec + RO_MM + (r16 * 4 + q4) * 16);
}
__device__ __forceinline__ void sr_wait_ge(volatile LAS unsigned* w, unsigned want) {
    for (unsigned spin = 0; spin < (1u << 22); ++spin) { if (*w >= want) break; __builtin_amdgcn_s_sleep(1); }
}
__device__ __forceinline__ void rwkv_scan_wave(const Frame& F, int bh, int vq) {
    const int lane = F.lane, r16 = lane & 15, q4 = lane >> 4, b = bh >> 3, h = bh & 7;
    const f32x4 Z4 = {0.f, 0.f, 0.f, 0.f};
    bf16* Y = (bf16*)(F.ws + WS_H) + (size_t)(b * T) * 512 + h * 64 + 16 * vq + r16;
    volatile LAS unsigned* filled = F.MISC + 32; volatile LAS unsigned* freed = F.MISC + 48;
    f32x4 Zt[4] = {Z4, Z4, Z4, Z4};
    ChunkIn A, B;
#define SR_TAKE(dst, ch_) do { const int sl_ = (ch_) & (SR_SLOTS - 1); sr_wait_ge(filled + sl_, 4u * (unsigned)(((ch_) >> 3) + 1)); asm volatile("" ::: "memory"); \
        scan_lds_load(dst, F.lds + sl_ * SR_SLOT_BYTES, vq, r16, q4); } while (0)
#define SR_DONE(ch_) do { asm volatile("s_waitcnt lgkmcnt(0)" ::: "memory"); \
        if (lane == 0) __hip_atomic_fetch_add((LAS unsigned*)(freed + ((ch_) & (SR_SLOTS - 1))), 1u, __ATOMIC_RELAXED, __HIP_MEMORY_SCOPE_WORKGROUP); } while (0)
    SR_TAKE(A, 0); SR_DONE(0);
    for (int ch = 0; ch < T / 16; ch += 2) {
        SR_TAKE(B, ch + 1);
        scan_chunk(A, Zt, Y, ch, q4);
        SR_DONE(ch + 1);
        if (ch + 2 < T / 16) SR_TAKE(A, ch + 2);
        scan_chunk(B, Zt, Y, ch + 1, q4);
        if (ch + 2 < T / 16) SR_DONE(ch + 2);
    }
#undef SR_TAKE
#undef SR_DONE
}
__device__ __forceinline__ void rwkv_scan_loader(const Frame& F, int bh, int lw) {
    const int lane = F.lane, b = bh >> 3, h = bh & 7;
    const unsigned char* recb = F.ws + WS_PRW + (size_t)(b * T) * 7168 + h * REC_BYTES + (size_t)(SR_PIECES * lw) * 16;
    volatile LAS unsigned* filled = F.MISC + 32; volatile LAS unsigned* freed = F.MISC + 48;
    constexpr size_t CS = 16 * 7168;
    v4u pc[8][4];
#define SL_ISSUE(k_, ch_) do { const unsigned char* r_ = recb + (size_t)(ch_) * CS; _Pragma("unroll") for (int i_ = 0; i_ < 4; ++i_) { const int p_ = lane + 64 * i_; pc[k_][i_] = *(const v4u*)(r_ + 16 * (p_ < SR_PIECES ? p_ : 0)); } } while (0)
#define SL_COMMIT(k_, ch_) do { const int sl_ = (ch_) & (SR_SLOTS - 1); sr_wait_ge(freed + sl_, 4u * (unsigned)((ch_) >> 3)); asm volatile("" ::: "memory"); \
        LAS unsigned char* d_ = F.lds + sl_ * SR_SLOT_BYTES + (SR_PIECES * lw) * 16; _Pragma("unroll") for (int i_ = 0; i_ < 4; ++i_) { const int p_ = lane + 64 * i_; if (p_ < SR_PIECES) *(LAS v4u*)(d_ + 16 * p_) = pc[k_][i_]; } \
        asm volatile("s_waitcnt lgkmcnt(0)" ::: "memory"); if (lane == 0) __hip_atomic_fetch_add((LAS unsigned*)(filled + sl_), 1u, __ATOMIC_RELAXED, __HIP_MEMORY_SCOPE_WORKGROUP); } while (0)
    SL_ISSUE(0, 0); SL_ISSUE(1, 1); SL_ISSUE(2, 2); SL_ISSUE(3, 3); SL_ISSUE(4, 4); SL_ISSUE(5, 5); SL_ISSUE(6, 6); SL_ISSUE(7, 7);
    for (int c8 = 0; c8 < T / 16; c8 += 8) {
#pragma unroll
        for (int k = 0; k < 8; ++k) { const int ch = c8 + k;
            SL_COMMIT(k, ch);
            if (ch + 8 < T / 16) SL_ISSUE(k, ch + 8); }
    }
#undef SL_ISSUE
#undef SL_COMMIT
}
__device__ __forceinline__ void rwkv_epilogue(const Frame& F) {
    const int lane = F.lane; const int gw = F.vcu * NWAVES + F.wave, NGW = F.G * NWAVES;
    const unsigned char* prw = F.ws + WS_PRW; const bf16* G = (const bf16*)((unsigned char*)F.out + DO_G); bf16* YA = (bf16*)(F.ws + WS_H);
    for (int idx0 = gw; idx0 < (M / 16) * 8; idx0 += 4 * NGW) {
        v4u v0[4], v1[4]; float yv[4][16], gv[4][16], lw[4], lb[4];
#pragma unroll
        for (int k = 0; k < 4; ++k) { int idx = idx0 + k * NGW; if (idx >= (M / 16) * 8) idx = idx0; const int bt = idx >> 3, h = idx & 7, c = h * 64 + lane;
            const unsigned char* rec = prw + (size_t)(16 * bt) * 7168 + h * REC_BYTES;
            const v4u* vp = (const v4u*)(rec + RO_VT + lane * 32); v0[k] = vp[0]; v1[k] = vp[1];
            lw[k] = F.in[12][c]; lb[k] = F.in[13][c];
#pragma unroll
            for (int s = 0; s < 16; ++s) { const size_t o = (size_t)(16 * bt + s) * 512 + c; yv[k][s] = bf2f(YA[o]); gv[k][s] = bf2f(G[o]); } }
#pragma unroll
        for (int k = 0; k < 4; ++k) { const int idx = idx0 + k * NGW; if (idx < (M / 16) * 8) { const int bt = __builtin_amdgcn_readfirstlane(idx >> 3), h = __builtin_amdgcn_readfirstlane(idx & 7), c = h * 64 + lane;
            const float* bon = (const float*)(prw + (size_t)(16 * bt) * 7168 + h * REC_BYTES + RO_BON);
#pragma unroll
            for (int s = 0; s < 16; ++s) { const unsigned vw = (s < 8) ? v0[k][s >> 1] : v1[k][(s - 8) >> 1]; const float vv = (s & 1) ? bfhi(vw) : bflo(vw);
                const float y = yv[k][s]; const float mean = wave_sum(y) * (1.f / 64.f); const float d = y - mean; const float var = wave_sum(d * d) * (1.f / 64.f);
                const float yn = d * rsqrtf(var + GN_EPS) * lw[k] + lb[k];
                YA[(size_t)(16 * bt + s) * 512 + c] = f2b((yn + bon[s] * vv) * gv[k][s]); } } }
    }
}
__device__ __forceinline__ unsigned sortable(float x) { const unsigned u = __float_as_uint(x); return (u & 0x80000000u) ? ~u : (u | 0x80000000u); }
__device__ __forceinline__ float unsortable(unsigned k) { const unsigned u = (k & 0x80000000u) ? (k & 0x7fffffffu) : ~k; return __uint_as_float(u); }
#define TK_INSERT(L, key_) do { unsigned k_ = (key_); _Pragma("unroll") for (int s_ = 0; s_ < 16; ++s_) { const unsigned hi_ = L[s_] > k_ ? L[s_] : k_; k_ = L[s_] > k_ ? k_ : L[s_]; L[s_] = hi_; } } while (0)
#define CE_DESC(a_, b_) do { const unsigned hi_ = (a_) > (b_) ? (a_) : (b_); const unsigned lo_ = (a_) > (b_) ? (b_) : (a_); (a_) = hi_; (b_) = lo_; } while (0)
template <int BASE> __device__ __forceinline__ void tk_sort16(unsigned (&k)[64]) {
    CE_DESC(k[BASE + 0], k[BASE + 13]); CE_DESC(k[BASE + 1], k[BASE + 12]); CE_DESC(k[BASE + 2], k[BASE + 15]); CE_DESC(k[BASE + 3], k[BASE + 14]); CE_DESC(k[BASE + 4], k[BASE + 8]); CE_DESC(k[BASE + 5], k[BASE + 6]); CE_DESC(k[BASE + 7], k[BASE + 11]); CE_DESC(k[BASE + 9], k[BASE + 10]); CE_DESC(k[BASE + 0], k[BASE + 5]); CE_DESC(k[BASE + 1], k[BASE + 7]); CE_DESC(k[BASE + 2], k[BASE + 9]); CE_DESC(k[BASE + 3], k[BASE + 4]); CE_DESC(k[BASE + 6], k[BASE + 13]); CE_DESC(k[BASE + 8], k[BASE + 14]); CE_DESC(k[BASE + 10], k[BASE + 15]); CE_DESC(k[BASE + 11], k[BASE + 12]); CE_DESC(k[BASE + 0], k[BASE + 1]); CE_DESC(k[BASE + 2], k[BASE + 3]); CE_DESC(k[BASE + 4], k[BASE + 5]); CE_DESC(k[BASE + 6], k[BASE + 8]); CE_DESC(k[BASE + 7], k[BASE + 9]); CE_DESC(k[BASE + 10], k[BASE + 11]); CE_DESC(k[BASE + 12], k[BASE + 13]); CE_DESC(k[BASE + 14], k[BASE + 15]); CE_DESC(k[BASE + 0], k[BASE + 2]); CE_DESC(k[BASE + 1], k[BASE + 3]); CE_DESC(k[BASE + 4], k[BASE + 10]); CE_DESC(k[BASE + 5], k[BASE + 11]); CE_DESC(k[BASE + 6], k[BASE + 7]); CE_DESC(k[BASE + 8], k[BASE + 9]); CE_DESC(k[BASE + 12], k[BASE + 14]); CE_DESC(k[BASE + 13], k[BASE + 15]); CE_DESC(k[BASE + 1], k[BASE + 2]); CE_DESC(k[BASE + 3], k[BASE + 12]); CE_DESC(k[BASE + 4], k[BASE + 6]); CE_DESC(k[BASE + 5], k[BASE + 7]); CE_DESC(k[BASE + 8], k[BASE + 10]); CE_DESC(k[BASE + 9], k[BASE + 11]); CE_DESC(k[BASE + 13], k[BASE + 14]); CE_DESC(k[BASE + 1], k[BASE + 4]); CE_DESC(k[BASE + 2], k[BASE + 6]); CE_DESC(k[BASE + 5], k[BASE + 8]); CE_DESC(k[BASE + 7], k[BASE + 10]); CE_DESC(k[BASE + 9], k[BASE + 13]); CE_DESC(k[BASE + 11], k[BASE + 14]); CE_DESC(k[BASE + 2], k[BASE + 4]); CE_DESC(k[BASE + 3], k[BASE + 6]); CE_DESC(k[BASE + 9], k[BASE + 12]); CE_DESC(k[BASE + 11], k[BASE + 13]); CE_DESC(k[BASE + 3], k[BASE + 5]); CE_DESC(k[BASE + 6], k[BASE + 8]); CE_DESC(k[BASE + 7], k[BASE + 9]); CE_DESC(k[BASE + 10], k[BASE + 12]); CE_DESC(k[BASE + 3], k[BASE + 4]); CE_DESC(k[BASE + 5], k[BASE + 6]); CE_DESC(k[BASE + 7], k[BASE + 8]); CE_DESC(k[BASE + 9], k[BASE + 10]); CE_DESC(k[BASE + 11], k[BASE + 12]); CE_DESC(k[BASE + 6], k[BASE + 7]); CE_DESC(k[BASE + 8], k[BASE + 9]);
}
template <int BASE> __device__ __forceinline__ void tk_bitonic16(unsigned (&k)[64]) {
#pragma unroll
    for (int stride = 8; stride > 0; stride >>= 1)
#pragma unroll
        for (int i = 0; i < 16; ++i) { const int j = i ^ stride; if (j > i) CE_DESC(k[BASE + i], k[BASE + j]); }
}
template <int A, int B> __device__ __forceinline__ void tk_merge16(unsigned (&k)[64]) {
#pragma unroll
    for (int i = 0; i < 16; ++i) k[A + i] = k[A + i] > k[B + 15 - i] ? k[A + i] : k[B + 15 - i];
    tk_bitonic16<A>(k);
}
__device__ __forceinline__ void tk_top16_of_64(unsigned (&k)[64]) { tk_sort16<0>(k); tk_sort16<16>(k); tk_sort16<32>(k); tk_sort16<48>(k); tk_merge16<0, 16>(k); tk_merge16<32, 48>(k); tk_merge16<0, 32>(k); }
__device__ __forceinline__ void peer_topk_pass(const Frame& F, int wp, LAS float* sc) {
    const int lane = F.lane, r16 = lane & 15, q4 = lane >> 4;
    const bf16* QRY = (const bf16*)(F.ws + WS_PRW);
    int* EID = (int*)(F.ws + WS_PRW + 64 * MiB); float* EG = (float*)(F.ws + WS_PRW + 72 * MiB);
    const int row = lane & 31, part = lane >> 5;
    unsigned L1[16], L2[16];
#pragma unroll
    for (int half = 0; half < 2; ++half) {
        const bf16* SK = (const bf16*)(F.ws + (half ? WS_SK2 : WS_SK1));
        bf16x8 af[2][4];
#pragma unroll
        for (int mt = 0; mt < 2; ++mt) { const int rho = 32 * wp + 16 * mt + r16; const bf16* qp = QRY + (size_t)(rho >> 3) * 2048 + (rho & 7) * 256 + half * 128 + 8 * q4;
#pragma unroll
            for (int s = 0; s < 4; ++s) af[mt][s] = as_bf16x8(*(const v4u*)(qp + 32 * s)); }
#pragma unroll
        for (int kg = 0; kg < 2; ++kg) { bf16x8 kb[4][4];
#pragma unroll
            for (int k4 = 0; k4 < 4; ++k4)
#pragma unroll
                for (int s = 0; s < 4; ++s) kb[k4][s] = as_bf16x8(*(const v4u*)(SK + (size_t)(16 * (4 * kg + k4) + r16) * 128 + 32 * s + 8 * q4));
#pragma unroll
          for (int mt = 0; mt < 2; ++mt) {
#pragma unroll
            for (int k4 = 0; k4 < 4; ++k4) { const int kt = 4 * kg + k4; f32x4 acc = {0.f, 0.f, 0.f, 0.f};
#pragma unroll
                for (int s = 0; s < 4; ++s) acc = mfma16(af[mt][s], kb[k4][s], acc);
#pragma unroll
                for (int r = 0; r < 4; ++r) { const int rw = 16 * mt + 4 * q4 + r; sc[rw * 128 + 4 * ((4 * kt + (r16 >> 2)) ^ rw) + (r16 & 3)] = acc[r]; } } } }
        NSA_FENCE();
        unsigned k[64];
#pragma unroll
        for (int g4 = 0; g4 < 16; ++g4) { const f32x4 x = *(const LAS f32x4*)(sc + row * 128 + 4 * ((16 * part + g4) ^ row));
#pragma unroll
            for (int e = 0; e < 4; ++e) { const int i = 4 * g4 + e; k[i] = ((sortable(x[e]) & ~0x7Fu) | (unsigned)(127 - i)) ^ (unsigned)(64 * part); } }
        tk_top16_of_64(k);
#pragma unroll
        for (int s = 0; s < 16; ++s) { const unsigned o = (unsigned)__shfl_xor((int)k[15 - s], 32); k[s] = k[s] > o ? k[s] : o; }
        tk_bitonic16<0>(k);
#pragma unroll
        for (int s = 0; s < 16; ++s) { if (half == 0) L1[s] = k[s]; else L2[s] = k[s]; }
        NSA_FENCE();
    }
    float v1[16], v2[16];
#pragma unroll
    for (int s = 0; s < 16; ++s) { v1[s] = unsortable(L1[s]); v2[s] = unsortable(L2[s]); }
    unsigned C[16];
    { unsigned k[64]; int n = 0;
#pragma unroll
      for (int i = 0; i < 16; ++i)
#pragma unroll
          for (int j = 0; j < 16; ++j) if ((i + 1) * (j + 1) <= 16) { k[n] = (sortable(v1[i] + v2[j]) & ~0xFFu) | (unsigned)(255 - (16 * i + j)); ++n; }
#pragma unroll
      for (int m = 50; m < 64; ++m) k[m] = 0u;
      tk_top16_of_64(k);
#pragma unroll
      for (int s = 0; s < 16; ++s) C[s] = k[s]; }
    LAS unsigned* il = (LAS unsigned*)sc;
    if (part == 0) {
#pragma unroll
        for (int s = 0; s < 16; ++s) { il[row * 33 + s] = 127u - (L1[s] & 127u); il[row * 33 + 16 + s] = 127u - (L2[s] & 127u); }
    }
    NSA_FENCE();
    if (part == 0) { const int rho = 32 * wp + row;
        float val[16], e[16]; float sum = 0.f;
#pragma unroll
        for (int s = 0; s < 16; ++s) val[s] = unsortable(C[s]);
#pragma unroll
        for (int s = 0; s < 16; ++s) { e[s] = __expf(val[s] - val[0]); sum += e[s]; }
        const float is = 1.0f / sum;
#pragma unroll
        for (int s = 0; s < 16; ++s) { const unsigned pos = 255u - (C[s] & 255u); const unsigned i = pos >> 4, j = pos & 15u;
            C[s] = il[row * 33 + i] * 128u + il[row * 33 + 16 + j]; e[s] *= is; }
        v4u* ep = (v4u*)(EID + (size_t)rho * 16); f32x4* gp = (f32x4*)(EG + (size_t)rho * 16);
#pragma unroll
        for (int q = 0; q < 4; ++q) { ep[q] = (v4u){C[4 * q], C[4 * q + 1], C[4 * q + 2], C[4 * q + 3]}; gp[q] = (f32x4){e[4 * q], e[4 * q + 1], e[4 * q + 2], e[4 * q + 3]}; }
    }
    NSA_FENCE();
}
typedef float f32x2_t __attribute__((ext_vector_type(2)));
constexpr float PEER_SCALE = 256.0f, PEER_ISCALE = 1.0f / 256.0f;
__device__ __forceinline__ void peer_convert_one(const Frame& F, const float* srcf, unsigned char* dstb) {
    const int gt = F.vcu * (NWAVES * 64) + F.tid, NT = F.G * NWAVES * 64;
    const f32x4* src = (const f32x4*)srcf; v4u* dst = (v4u*)dstb;
    for (int i = gt; i < 16384 * 1024 / 16; i += NT) { v4u o;
#pragma unroll
        for (int q = 0; q < 4; ++q) { const f32x4 a = src[4 * i + q] * PEER_SCALE; int w = __builtin_amdgcn_cvt_pk_fp8_f32(a[0], a[1], 0, false); w = __builtin_amdgcn_cvt_pk_fp8_f32(a[2], a[3], w, true); o[q] = (unsigned)w; }
        dst[i] = o; }
}
constexpr float PEER_SU = 768.0f, PEER_SH = 24.0f;
__device__ __forceinline__ unsigned q8pack(const f32x4 a, float sc) {
    const int q0 = (int)rintf(fminf(fmaxf(a[0] * sc, -127.f), 127.f)), q1 = (int)rintf(fminf(fmaxf(a[1] * sc, -127.f), 127.f)), q2 = (int)rintf(fminf(fmaxf(a[2] * sc, -127.f), 127.f)), q3 = (int)rintf(fminf(fmaxf(a[3] * sc, -127.f), 127.f));
    return (unsigned)(q0 & 255) | ((unsigned)(q1 & 255) << 8) | ((unsigned)(q2 & 255) << 16) | ((unsigned)(q3 & 255) << 24);
}
__device__ __forceinline__ void peer_convert_u8(const Frame& F, const float* srcf, unsigned char* dstb) {
    const int gt = F.vcu * (NWAVES * 64) + F.tid, NT = F.G * NWAVES * 64;
    const f32x4* src = (const f32x4*)srcf; v4u* dst = (v4u*)dstb;
    for (int i = gt; i < 16384 * 1024 / 16; i += NT) { v4u o;
#pragma unroll
        for (int q = 0; q < 4; ++q) o[q] = q8pack(src[4 * i + q], PEER_SU);
        dst[i] = o; }
}
__device__ __forceinline__ void peer_convert_tables(const Frame& F) { peer_convert_u8(F, F.in[31], F.ws + WS_MG); peer_convert_one(F, F.in[32], F.ws + WS_MG + 16 * MiB); }
__device__ __forceinline__ float sum8(float x) { x += dppf<0xB1>(x); x += dppf<0x4E>(x); x += dppf<0x141>(x); return x; }
template <int PHASE> __device__ __forceinline__ void peer_slice_unit(const Frame& F, int s, int tg) {
    const int lane = F.lane, j = lane & 7, gbase = lane & ~7;
    const bf16* H2 = (const bf16*)(F.ws + WS_H);
    const int* EID = (const int*)(F.ws + WS_PRW + 64 * MiB);
    float* PART = (float*)(F.ws + WS_PRW) + (size_t)s * M * 128; const float* CACT = (const float*)(F.ws + WS_PRW + 80 * MiB);
    const unsigned char* TB = F.ws + WS_MG + (PHASE == 0 ? 0 : 16 * MiB) + 128 * s; const unsigned tbo = 16u * (unsigned)j;
    LAS unsigned char* pb = F.lds + F.wave * 16384;
#define PEER_PREF(it_) do { const int tk_ = 64 * tg + 8 * (it_) + (lane >> 3); const v4u* ip_ = (const v4u*)(EID + (size_t)tk_ * 128 + 16 * j); \
        _Pragma("unroll") for (int q_ = 0; q_ < 4; ++q_) __builtin_amdgcn_global_load_lds((const unsigned*)(ip_ + q_), (LAS unsigned*)(pb + q_ * 1024), 16, 0, 0); \
        const v4u* hp_ = (const v4u*)(H2 + (size_t)tk_ * D + 128 * s + 16 * j); _Pragma("unroll") for (int q_ = 0; q_ < 2; ++q_) __builtin_amdgcn_global_load_lds((const unsigned*)(hp_ + q_), (LAS unsigned*)(pb + 4096 + q_ * 1024), 16, 0, 0); } while (0)
    v4u tn[16];
    const LAS v4u* lg = (const LAS v4u*)pb + gbase;
    if (PHASE == 0) { PEER_PREF(0); asm volatile("s_waitcnt vmcnt(0)" ::: "memory");
#pragma unroll
        for (int q = 0; q < 4; ++q) { const v4u w = lg[q * 64];
#pragma unroll
            for (int e = 0; e < 4; ++e) tn[4 * q + e] = *(const v4u*)(TB + ((w[e] << 10) + tbo)); } }
#pragma unroll 1
    for (int it = 0; it < 8; ++it) { const int tk = 64 * tg + 8 * it + (lane >> 3);
        int ids[16]; float hv[16], acc[16];
        int hq[4] = {0, 0, 0, 0};
        if (PHASE == 0) { const LAS v4u* lb = (const LAS v4u*)pb + lane;
#pragma unroll
            for (int q = 0; q < 4; ++q) { const v4u w = lb[q * 64]; ids[4 * q] = (int)w.x; ids[4 * q + 1] = (int)w.y; ids[4 * q + 2] = (int)w.z; ids[4 * q + 3] = (int)w.w; }
            const v4u h0 = lb[256], h1 = lb[256 + 64];
            hq[0] = (int)q8pack((f32x4){bflo(h0.x), bfhi(h0.x), bflo(h0.y), bfhi(h0.y)}, PEER_SH); hq[1] = (int)q8pack((f32x4){bflo(h0.z), bfhi(h0.z), bflo(h0.w), bfhi(h0.w)}, PEER_SH);
            hq[2] = (int)q8pack((f32x4){bflo(h1.x), bfhi(h1.x), bflo(h1.y), bfhi(h1.y)}, PEER_SH); hq[3] = (int)q8pack((f32x4){bflo(h1.z), bfhi(h1.z), bflo(h1.w), bfhi(h1.w)}, PEER_SH);
            asm volatile("s_waitcnt lgkmcnt(0)" ::: "memory");
            if (it + 1 < 8) PEER_PREF(it + 1); }
        else { const v4u* ip = (const v4u*)(EID + (size_t)tk * 128 + 16 * j);
#pragma unroll
            for (int q = 0; q < 4; ++q) { const v4u w = ip[q]; ids[4 * q] = (int)w.x; ids[4 * q + 1] = (int)w.y; ids[4 * q + 2] = (int)w.z; ids[4 * q + 3] = (int)w.w; }
            const f32x4* cp = (const f32x4*)(CACT + (size_t)tk * 128 + 16 * j);
#pragma unroll
            for (int q = 0; q < 4; ++q) { const f32x4 c = cp[q]; hv[4 * q] = c[0]; hv[4 * q + 1] = c[1]; hv[4 * q + 2] = c[2]; hv[4 * q + 3] = c[3]; } }
#pragma unroll
        for (int m = 0; m < 16; ++m) acc[m] = 0.f;
#pragma unroll 1
        for (int jj = 0; jj < 8; ++jj) { const int src = (gbase + jj) * 4;
            v4u tv[16];
            if (PHASE == 0) { const int srcn = (gbase + ((jj + 1) & 7)) * 4;
#pragma unroll
                for (int m = 0; m < 16; ++m) tv[m] = tn[m];
                asm volatile("s_waitcnt vmcnt(16)" ::: "memory");
                v4u lw[4];
#pragma unroll
                for (int q = 0; q < 4; ++q) lw[q] = lg[q * 64];
#pragma unroll
                for (int m = 0; m < 16; ++m) { const int idb = __builtin_amdgcn_ds_bpermute(srcn, ids[m]); const unsigned id = (jj == 7) ? lw[m >> 2][m & 3] : (unsigned)idb; tn[m] = *(const v4u*)(TB + ((id << 10) + tbo)); } }
            else {
#pragma unroll
                for (int m = 0; m < 16; ++m) { const int id = __builtin_amdgcn_ds_bpermute(src, ids[m]); tv[m] = *(const v4u*)(TB + (((unsigned)id << 10) + tbo)); } }
#pragma unroll
            for (int m = 0; m < 16; ++m) {
                if (PHASE == 0) { int di = __builtin_amdgcn_sdot4((int)tv[m].x, hq[0], 0, false); di = __builtin_amdgcn_sdot4((int)tv[m].y, hq[1], di, false); di = __builtin_amdgcn_sdot4((int)tv[m].z, hq[2], di, false); di = __builtin_amdgcn_sdot4((int)tv[m].w, hq[3], di, false);
                    const float d = sum8((float)di); acc[m] = (j == jj) ? d : acc[m]; }
                else {
                    float f[16];
#pragma unroll
                    for (int q = 0; q < 4; ++q) { const f32x2_t lo = __builtin_amdgcn_cvt_pk_f32_fp8((int)tv[m][q], false), hi = __builtin_amdgcn_cvt_pk_f32_fp8((int)tv[m][q], true); f[4 * q] = lo.x; f[4 * q + 1] = lo.y; f[4 * q + 2] = hi.x; f[4 * q + 3] = hi.y; } const float c = __builtin_bit_cast(float, __builtin_amdgcn_ds_bpermute(src, __builtin_bit_cast(int, hv[m])));
#pragma unroll
                    for (int q = 0; q < 16; ++q) acc[q] += c * f[q]; } }
        }
        if (PHASE == 0) { asm volatile("s_waitcnt vmcnt(0)" ::: "memory");
            f32x4* pp = (f32x4*)(PART + (size_t)tk * 128 + 16 * j);
#pragma unroll
            for (int q = 0; q < 4; ++q) pp[q] = (f32x4){acc[4 * q], acc[4 * q + 1], acc[4 * q + 2], acc[4 * q + 3]}; }
        else { f32x4* op = (f32x4*)(F.out + (size_t)tk * D + 128 * s + 16 * j);
#pragma unroll
            for (int q = 0; q < 4; ++q) { f32x4 a = op[q]; a[0] += acc[4 * q] * PEER_ISCALE; a[1] += acc[4 * q + 1] * PEER_ISCALE; a[2] += acc[4 * q + 2] * PEER_ISCALE; a[3] += acc[4 * q + 3] * PEER_ISCALE; op[q] = a; } }
    }
}
template <int PHASE> __device__ __forceinline__ void peer_slice_phase(const Frame& F, int rep) {
    const int q0 = (int)(xb_xcc_id() & 7u);
    for (int qi = 0; qi < 8; ++qi) { const int q = (q0 + qi) & 7;
        for (;;) { unsigned c = 0;
            if (F.lane == 0) c = __hip_atomic_fetch_add(F.ctl + CW_PEERQ + 64 * (16 * rep + 8 * PHASE + q), 1u, RLX_AGENT);
            c = (unsigned)__builtin_amdgcn_readfirstlane((int)c);
            if (c >= 256u) break;
            peer_slice_unit<PHASE>(F, q, (int)c); } }
}
__device__ __forceinline__ void peer_act_phase(const Frame& F) {
    const int gt = F.vcu * (NWAVES * 64) + F.tid, NT = F.G * NWAVES * 64;
    const float* PART = (const float*)(F.ws + WS_PRW); const float* EG = (const float*)(F.ws + WS_PRW + 72 * MiB); float* CACT = (float*)(F.ws + WS_PRW + 80 * MiB);
    for (int i = gt; i < M * 128 / 4; i += NT) { f32x4 d = {0.f, 0.f, 0.f, 0.f};
#pragma unroll
        for (int s = 0; s < 8; ++s) d += ((const f32x4*)PART)[(size_t)s * (M * 128 / 4) + i];
        const f32x4 g = ((const f32x4*)EG)[i]; f32x4 c;
#pragma unroll
        for (int e = 0; e < 4; ++e) { const float dt = d[e] * (1.0f / (PEER_SU * PEER_SH)); c[e] = g[e] * 0.5f * dt * (1.f + erff(dt * 0.70710678118654752f)); }
        ((f32x4*)CACT)[i] = c; }
}
__device__ __forceinline__ unsigned long long dbg_stamp() { unsigned long long t; asm volatile("s_memrealtime %0\n\ts_waitcnt lgkmcnt(0)" : "=s"(t) :: "memory"); return t; }
struct Args { const float* in[33]; float* out; unsigned char* ws; int ph_lo, ph_hi; };
__global__ void __launch_bounds__(NWAVES * 64, 2) mk_fwd(Args args) {
    extern __shared__ __attribute__((aligned(16))) unsigned char lds[];
    Frame F;
    F.lds = (LAS unsigned char*)lds;
    F.MISC = (volatile LAS unsigned*)(F.lds + MISC_OFF);
    F.tid = threadIdx.x; F.lane = F.tid & 63; F.wave = __builtin_amdgcn_readfirstlane(F.tid >> 6);
    F.G = gridDim.x; { const int bx = blockIdx.x; F.vcu = (F.G % 8 == 0) ? (bx % 8) * (F.G / 8) + bx / 8 : bx; }
    unsigned char* ws = args.ws; F.ws = ws; F.out = args.out;
    F.ctl = (gu32*)(ws + WS_CTL);
#pragma unroll
    for (int i = 0; i < 33; ++i) F.in[i] = args.in[i];
    for (int u = F.tid; u < (LDS_BYTES - LDSCTL_OFF) / 4; u += NWAVES * 64) ((LAS unsigned*)(F.lds + LDSCTL_OFF))[u] = 0u;
    __syncthreads();
    const int lo = args.ph_lo, hi = args.ph_hi & 0xff; const int rep = args.ph_hi >> 8;
    const bool multi = (hi - lo) > 1;
    XcdBarrier bar; bar.bar = (unsigned*)(F.ctl + CW_BAR); bar.x = 0; bar.st = nullptr;
    if (multi) bar = xcd_barrier_post((unsigned*)(F.ctl + CW_BAR), F.MISC + 8);
#define IN(k) (lo <= (k) && (k) < hi)
#define NREP(k) ((((repmask) >> (k)) & 1) + 1)
#define REPBAR() do { if (rep) xcd_barrier(bar); } while (0)
#define SEAM(k) do { if (DBG_SEL == (k) && blockIdx.x == DBG_BLK && F.tid == 0) dbg_t1 = dbg_stamp(); if (DBG_SEL == 50 + (k) && blockIdx.x == DBG_BLK && F.tid == 0) dbg_t0 = dbg_stamp(); if (IN(k) && IN((k) + 1)) xcd_barrier(bar); if (DBG_SEL == 50 + (k) && blockIdx.x == DBG_BLK && F.tid == 0) dbg_t1 = dbg_stamp(); if ((DBG_SEL == (k) + 1 || (DBG_SEL == 20 && (k) == 1)) && blockIdx.x == DBG_BLK && F.tid == 0) dbg_t0 = dbg_stamp(); } while (0)
    unsigned long long dbg_t0 = 0ull, dbg_t1 = 0ull;
    if (DBG_SEL == 0 && blockIdx.x == DBG_BLK && F.tid == 0) dbg_t0 = dbg_stamp();

    if (IN(0)) { { p0_prologue(F); } } SEAM(0);
    if (IN(1)) { {
        pg8::Gemm g{(const pg8::bf16_t*)(ws + WS_H), (const pg8::bf16_t*)(ws + WS_WIN), M, NG1, D}; pg8::StaticOrder S; S.init(M, NG1, F.G, (int)blockIdx.x);
        pg8::EpiG1 E{(float*)(ws + WS_PRW), (float*)(ws + WS_BND), (pg8::bf16_t*)((unsigned char*)F.out + DO_PNSA), (pg8::bf16_t*)(ws + WS_MG), (float*)((unsigned char*)F.out + DO_GLOG)};
        pg8::gemm_phase<pg8::EpiG1, pg8::StaticOrder, true, true>(F.lds + RING_OFF, g, S, E);
    } } SEAM(1);
    if (IN(2)) {
        for (int u = F.vcu; u < 256; u += F.G) nsa_prep_tile(F, u);
        if (DBG_SEL == 20 && blockIdx.x == 0 && F.tid == 0) dbg_t1 = dbg_stamp();
        if (DBG_SEL == 21 && blockIdx.x == 0 && F.tid == 0) dbg_t0 = dbg_stamp();
        for (int u = F.vcu; u < 256; u += F.G) compress_unit(F, u);
        if (DBG_SEL == 21 && blockIdx.x == 0 && F.tid == 0) dbg_t1 = dbg_stamp();
        for (int u = F.vcu; u < 256; u += F.G) rwkv_prep_tile(F, u);
    } SEAM(2);
    if (IN(3)) { {
        if ((int)blockIdx.x < 32 && !(rep && P3REP == 3)) { if (DBG_SEL == 40 && blockIdx.x == 0 && F.tid == 0) dbg_t0 = dbg_stamp(); if (F.tid < 32) F.MISC[32 + F.tid] = 0u; __syncthreads(); if (F.wave < 4) rwkv_scan_wave(F, (int)blockIdx.x, F.wave); else rwkv_scan_loader(F, (int)blockIdx.x, F.wave - 4); __syncthreads(); if (DBG_SEL == 40 && blockIdx.x == 0 && F.tid == 0) dbg_t1 = dbg_stamp(); }
        if (!(rep && P3REP == 2)) nsa_phase(F, rep);
    } } SEAM(3);
    if (IN(4)) { { rwkv_epilogue(F); } } SEAM(4);
    if (IN(5)) { {
        { pg8::Gemm g{(const pg8::bf16_t*)(ws + WS_H), (const pg8::bf16_t*)(ws + WS_WA), M, D, 512, (const pg8::bf16_t*)(ws + WS_H + 16 * MiB), (const pg8::bf16_t*)(ws + WS_WB)}; pg8::StaticOrder2 S; S.init(M, D, F.G, (int)blockIdx.x);
          pg8::EpiMerge E{(const pg8::bf16_t*)(ws + WS_MG), (pg8::bf16_t*)(ws + WS_PRW + 64 * MiB)};
          pg8::gemm_phase<pg8::EpiMerge, pg8::StaticOrder2, true, true>(F.lds + RING_OFF, g, S, E); }
    } } SEAM(5);
    if (IN(6)) { {
        pg8::Gemm g{(const pg8::bf16_t*)(ws + WS_PRW + 64 * MiB), (const pg8::bf16_t*)(ws + WS_WOUT), M, D, D}; pg8::StaticOrder S; S.init(M, D, F.G, (int)blockIdx.x);
        pg8::EpiRes E{F.in[0], F.out};
        pg8::gemm_phase<pg8::EpiRes, pg8::StaticOrder, true, true>(F.lds + RING_OFF, g, S, E);
    } } SEAM(6);
    if (IN(7)) { { const int gw = F.vcu * NWAVES + F.wave, NGW = F.G * NWAVES;
        rms_rows_to_bf16(F.lane, F.out, F.in[27], (bf16*)(ws + WS_H), gw, NGW);
        peer_convert_tables(F);
    } } SEAM(7);
    if (IN(8)) { {
        pg8::Gemm g{(const pg8::bf16_t*)(ws + WS_H), (const pg8::bf16_t*)(ws + WS_WQ), M, 2048, D}; pg8::StaticOrder S; S.init(M, 2048, F.G, (int)blockIdx.x);
        pg8::EpiBf16<0> E{(pg8::bf16_t*)(ws + WS_PRW), 2048, nullptr, 0, 0, 1.f};
        pg8::gemm_phase<pg8::EpiBf16<0>, pg8::StaticOrder, true, true>(F.lds + RING_OFF, g, S, E);
    } } SEAM(8);
    if (IN(9)) { { const int gw = F.vcu * NWAVES + F.wave, NGW = F.G * NWAVES; LAS float* sc = (LAS float*)(F.lds + F.wave * 16384);
        for (int wp = gw; wp < M * 8 / 32; wp += NGW) peer_topk_pass(F, wp, sc);
    } } SEAM(9);
    if (IN(10)) { peer_slice_phase<0>(F, rep); } SEAM(10);
    if (IN(11)) { peer_act_phase(F); } SEAM(11);
    if (IN(12)) { peer_slice_phase<1>(F, rep); }
    if (DBG_SEL >= 36 && DBG_SEL <= 39 && blockIdx.x == DBG_BLK && F.tid == 0) { dbg_t0 = F.MISC[20]; dbg_t1 = F.MISC[21]; }
    if (DBG_SEL >= 0 && multi) { if (DBG_SEL == 12 && blockIdx.x == 0 && F.tid == 0) dbg_t1 = dbg_stamp(); xcd_barrier(bar); if (blockIdx.x == DBG_BLK && F.tid == 0) { ((unsigned long long*)(ws + WS_KC + 524288))[2] = dbg_t1 - dbg_t0; } xcd_barrier(bar); if (blockIdx.x == 0 && F.tid == 0) { dbg_t0 = 0; dbg_t1 = ((unsigned long long*)(ws + WS_KC + 524288))[2]; } if (blockIdx.x == 0 && F.tid == 0) { int bi = 0; float bv = 1e30f; for (int i = 0; i < 512; ++i) { const float v = fabsf(F.out[i]); if (v < bv) { bv = v; bi = i; } } F.out[bi] += (DBG_SEL == 99) ? 0.07f : ((DBG_SEL >= 30 && DBG_SEL < 36) ? (0.05f + (float)(F.MISC[21] - F.MISC[20]) * 0.01f * 1e-3f) : (0.05f + ((float)(dbg_t1 - dbg_t0) * 0.01f - DBG_BASE_US) * DBG_SCALE)); } }
#undef IN
#undef SEAM
}

extern "C" void kernel_launch(void* const* d_in, const int* in_sizes, int n_in, void* d_out, int out_size, void* d_ws, size_t ws_size, hipStream_t stream) {
    static int grid = 0;
    if (grid == 0) {
        if (n_in != 33 || out_size != M * D || ws_size < WS_END) { fprintf(stderr, "kernel_launch: unexpected shapes (n_in %d out %d ws %zu)\n", n_in, out_size, ws_size); grid = -1; return; }
        int dev = 0, cus = 0, per_cu = 0;
        if (hipGetDevice(&dev) != hipSuccess || hipDeviceGetAttribute(&cus, hipDeviceAttributeMultiprocessorCount, dev) != hipSuccess) { grid = -1; return; }
        if (hipFuncSetAttribute((const void*)mk_fwd, hipFuncAttributeMaxDynamicSharedMemorySize, LDS_BYTES) != hipSuccess) { fprintf(stderr, "kernel_launch: hipFuncSetAttribute failed\n"); grid = -1; return; }
        if (hipOccupancyMaxActiveBlocksPerMultiprocessor(&per_cu, (const void*)mk_fwd, NWAVES * 64, LDS_BYTES) != hipSuccess || per_cu < 1)
            fprintf(stderr, "kernel_launch: occupancy query reports %d blocks per CU\n", per_cu);
        (void)hipGetLastError();
        grid = cus;
        if (grid > 256) grid = 256;
    }
    if (grid < 0) return;
    if (hipMemsetAsync((char*)d_ws + WS_CTL, 0, CTL_ZERO_BYTES, stream) != hipSuccess) return;
    Args a{};
    for (int i = 0; i < 33; ++i) a.in[i] = (const float*)d_in[i];
    a.out = (float*)d_out; a.ws = (unsigned char*)d_ws;
#if MK_ONE_LAUNCH
    a.ph_lo = 0; a.ph_hi = N_PHASES;
    hipLaunchKernelGGL(mk_fwd, dim3(grid), dim3(NWAVES * 64), LDS_BYTES, stream, a);
#else
    for (int p = 0; p < N_PHASES; ++p) { for (int r = 0; r <= (((REP_MASK) >> p) & 1); ++r) { a.ph_lo = p; a.ph_hi = (p + 1) | (r << 8); hipLaunchKernelGGL(mk_fwd, dim3(grid), dim3(NWAVES * 64), LDS_BYTES, stream, a); } }
#endif
}
```
